# Optimizing an MI355X kernel written in HIP

```python
import math
import numpy as np
import jax
import jax.numpy as jnp
from jax import lax

D_MODEL = 1024
BATCH = 4
SEQ = 4096
DEPTH = 1
DEC_BATCH = 128
DEC_SEQ = 1
PAST_LEN = 2048
PAGE_SIZE = 128

SSM_EXPAND = 2
D_INNER = SSM_EXPAND * D_MODEL
SSM_HEAD_DIM = 64
N_SSM_HEADS = D_INNER // SSM_HEAD_DIM
SSM_GROUPS = 4
SSM_STATE = 128
SSM_CONV = 4
CONV_DIM = D_INNER + 2 * SSM_GROUPS * SSM_STATE
SSD_CHUNK = 128
N_ATT_HEADS = 16
ATT_HEAD_DIM = 64
N_KV_HEADS = 4
Q_PER_KV = N_ATT_HEADS // N_KV_HEADS
ATT_WIDTH = N_ATT_HEADS * ATT_HEAD_DIM
ATT_SCALE = ATT_HEAD_DIM ** -0.5
ROPE_DIM = ATT_HEAD_DIM // 4
ROPE_THETA = 500000.0
CMP_LEN = 32
CMP_STRIDE = 16
CMP_HIDDEN = 2 * ATT_HEAD_DIM
SEL_LEN = 64
SEL_TOPK = 16
WINDOW = 512
Q_BLOCK = 128
N_KV_STREAMS = 4
N_KV_PROJ = 6
D_FF = 2816
FFN_CONV = 3
EPS = 1e-6
NEG = -1e30
BIG = 1e30
TINY = 1e-30
IN_SIZES = (D_INNER, CONV_DIM, N_SSM_HEADS, ATT_WIDTH, N_KV_PROJ * N_KV_HEADS * ATT_HEAD_DIM, 3 * N_ATT_HEADS, 2 * D_MODEL)
D_IN_PROJ = sum(IN_SIZES)

kernel_name = "hybrid_ssd_nsa_convffn_adaln_step"


def _rmsnorm(x, w):
    x32 = x.astype(jnp.float32)
    y = x32 * lax.rsqrt(jnp.mean(x32 * x32, axis=-1, keepdims=True) + EPS)
    return y.astype(x.dtype) * w


def _rope(x, pos):
    half = ROPE_DIM // 2
    inv_freq = ROPE_THETA ** (-jnp.arange(half, dtype=jnp.float32) / half)
    ang = pos.astype(jnp.float32)[:, None] * inv_freq[None, :]
    shape = (pos.shape[0],) + (1,) * (x.ndim - 3) + (half,)
    cos = jnp.cos(ang).reshape(shape)
    sin = jnp.sin(ang).reshape(shape)
    x1 = x[..., :half].astype(jnp.float32)
    x2 = x[..., half:ROPE_DIM].astype(jnp.float32)
    rot = jnp.concatenate([x1 * cos - x2 * sin, x2 * cos + x1 * sin], axis=-1).astype(x.dtype)
    return jnp.concatenate([rot, x[..., ROPE_DIM:]], axis=-1)


def _causal_dwconv(xp, w, b):
    k = w.shape[0]
    t = xp.shape[1] - k + 1
    out = xp[:, 0:t] * w[0]
    for i in range(1, k):
        out = out + xp[:, i:i + t] * w[i]
    return out + b


def _masked_softmax(s, mask):
    s = jnp.where(mask, s.astype(jnp.float32), NEG)
    e = jnp.where(mask, jnp.exp(s - jnp.max(s, axis=-1, keepdims=True)), 0.0)
    return e / jnp.maximum(jnp.sum(e, axis=-1, keepdims=True), TINY)


def _ssd(x, dt, a, bm, cm, h0):
    b, t, nh, hp = x.shape
    g, n = bm.shape[2], bm.shape[3]
    r = nh // g
    l = SSD_CHUNK if t % SSD_CHUNK == 0 else t
    nc = t // l
    xdt = (x.astype(jnp.float32) * dt[..., None]).reshape(b, nc, l, g, r, hp)
    cs = jnp.cumsum((dt * a).reshape(b, nc, l, g, r), axis=2)
    bc = bm.astype(jnp.float32).reshape(b, nc, l, g, n)
    cc = cm.astype(jnp.float32).reshape(b, nc, l, g, n)
    causal = jnp.tril(jnp.ones((l, l), dtype=bool))[None, None, :, :, None, None]
    seg = cs[:, :, :, None] - cs[:, :, None, :]
    lmat = jnp.exp(jnp.where(causal, seg, -jnp.inf))
    cb = jnp.einsum("bclgn,bcsgn->bclsg", cc, bc)
    y_diag = jnp.einsum("bclsgr,bcsgrp->bclgrp", cb[..., None] * lmat, xdt)
    decay = jnp.exp(cs[:, :, -1:] - cs)
    states = jnp.einsum("bclgn,bclgrp->bcgrpn", bc, xdt * decay[..., None])
    chunk_decay = jnp.exp(cs[:, :, -1])

    def step(h, inp):
        st, dec = inp
        return h * dec[..., None, None] + st, h

    h_last, h_prev = lax.scan(step, h0.astype(jnp.float32).reshape(b, g, r, hp, n),
                              (jnp.moveaxis(states, 1, 0), jnp.moveaxis(chunk_decay, 1, 0)))
    h_prev = jnp.moveaxis(h_prev, 0, 1)
    y_off = jnp.einsum("bclgn,bcgrpn->bclgrp", cc, h_prev) * jnp.exp(cs)[..., None]
    y = (y_diag + y_off).reshape(b, t, nh, hp).astype(x.dtype)
    return y, h_last.reshape(b, nh, hp, n).astype(x.dtype)


def _mamba(z, xbc, dt_raw, conv_buf, h0, p):
    gn = SSM_GROUPS * SSM_STATE
    xp = jnp.concatenate([conv_buf.astype(xbc.dtype), xbc], axis=1)
    new_buf = xp[:, xp.shape[1] - (SSM_CONV - 1):]
    xc = jax.nn.silu(_causal_dwconv(xp, p["ssm_conv_w"], p["ssm_conv_b"]))
    b, t = xc.shape[0], xc.shape[1]
    xs = xc[..., :D_INNER].reshape(b, t, N_SSM_HEADS, SSM_HEAD_DIM)
    bm = xc[..., D_INNER:D_INNER + gn].reshape(b, t, SSM_GROUPS, SSM_STATE)
    cm = xc[..., D_INNER + gn:].reshape(b, t, SSM_GROUPS, SSM_STATE)
    dt = jax.nn.softplus((dt_raw + p["ssm_dt_bias"]).astype(jnp.float32))
    a = -jnp.exp(p["ssm_A_log"].astype(jnp.float32))
    y, h = _ssd(xs, dt, a, bm, cm, h0)
    y = (y + xs * p["ssm_D"][:, None]).reshape(b, t, D_INNER)
    y = _rmsnorm(y * jax.nn.silu(z), p["ssm_norm_w"])
    return y, new_buf, h


def _compress(k, pe, w1, w2):
    b, length = k.shape[0], k.shape[1]
    nc = (length - CMP_LEN) // CMP_STRIDE + 1
    nsub = CMP_LEN // CMP_STRIDE
    nj = nc + nsub - 1
    sub = k[:, :nj * CMP_STRIDE].reshape(b, nj, CMP_STRIDE, N_KV_HEADS, ATT_HEAD_DIM)
    hid = jnp.einsum("ld,lde->e", pe, w1)
    for r in range(nsub):
        part = jnp.einsum("bjshd,sde->bjhe", sub, w1[r * CMP_STRIDE:(r + 1) * CMP_STRIDE])
        hid = hid + part[:, r:r + nc]
    return jnp.einsum("bnhe,ed->bnhd", jax.nn.silu(hid), w2)


def _overlap_matrix(nc, ns):
    cst = np.arange(nc)[:, None] * CMP_STRIDE
    sst = np.arange(ns)[None, :] * SEL_LEN
    ov = np.clip(np.minimum(cst + CMP_LEN, sst + SEL_LEN) - np.maximum(cst, sst), 0, None)
    return jnp.asarray(ov / CMP_STRIDE, dtype=jnp.float32)


def _nsa_global(q, t, kc, vc, ks, vs):
    b, nq = q.shape[0], q.shape[1]
    nc = kc.shape[1]
    cmp_end = jnp.arange(nc) * CMP_STRIDE + (CMP_LEN - 1)
    mask_c = (cmp_end[None, :] <= t[:, None])[None, :, None, None, :]
    p_c = _masked_softmax(jnp.einsum("bqhgd,bnhd->bqhgn", q, kc) * ATT_SCALE, mask_c)
    o_c = jnp.einsum("bqhgn,bnhd->bqhgd", p_c.astype(vc.dtype), vc)
    length = ks.shape[1]
    ns = -(-length // SEL_LEN)
    pad = ((0, 0), (0, ns * SEL_LEN - length), (0, 0), (0, 0))
    ks = jnp.pad(ks, pad)
    vs = jnp.pad(vs, pad)
    imp = jnp.einsum("bqhn,nj->bqhj", jnp.sum(p_c, axis=3), _overlap_matrix(nc, ns))
    blk = jnp.arange(ns)[None, :]
    cur = (t // SEL_LEN)[:, None]
    valid = blk * SEL_LEN <= t[:, None]
    forced = (blk == 0) | (blk == cur) | (blk == cur - 1)
    imp = jnp.where(valid[None, :, None, :], jnp.where(forced[None, :, None, :], BIG, imp), -BIG)
    n_top = min(SEL_TOPK, ns)
    _, idx = lax.top_k(imp, n_top)
    kb = ks.reshape(b, ns, SEL_LEN, N_KV_HEADS, ATT_HEAD_DIM).transpose(0, 3, 1, 2, 4)
    vb = vs.reshape(b, ns, SEL_LEN, N_KV_HEADS, ATT_HEAD_DIM).transpose(0, 3, 1, 2, 4)
    bi = jnp.arange(b)[:, None, None, None]
    hi = jnp.arange(N_KV_HEADS)[None, None, :, None]
    m = n_top * SEL_LEN
    kg = kb[bi, hi, idx].reshape(b, nq, N_KV_HEADS, m, ATT_HEAD_DIM)
    vg = vb[bi, hi, idx].reshape(b, nq, N_KV_HEADS, m, ATT_HEAD_DIM)
    kpos = (idx[..., None] * SEL_LEN + jnp.arange(SEL_LEN)).reshape(b, nq, N_KV_HEADS, m)
    mask_s = (kpos <= t[None, :, None, None])[:, :, :, None, :]
    p_s = _masked_softmax(jnp.einsum("bqhgd,bqhmd->bqhgm", q, kg) * ATT_SCALE, mask_s)
    o_s = jnp.einsum("bqhgm,bqhmd->bqhgd", p_s.astype(vg.dtype), vg)
    return o_c, o_s


def _nsa_window(q, t, kw, vw, kpos):
    d = t[:, None] - kpos[None, :]
    mask = ((d >= 0) & (d < WINDOW) & (kpos >= 0)[None, :])[None, :, None, None, :]
    p = _masked_softmax(jnp.einsum("bqhgd,bkhd->bqhgk", q, kw) * ATT_SCALE, mask)
    return jnp.einsum("bqhgk,bkhd->bqhgd", p.astype(vw.dtype), vw)


def _nsa_merge(o_c, o_s, o_w, gates):
    b, t = gates.shape[0], gates.shape[1]
    g = jax.nn.sigmoid(gates).reshape(b, t, N_KV_HEADS, Q_PER_KV, 3)
    o = g[..., 0:1] * o_c + g[..., 1:2] * o_s + g[..., 2:3] * o_w
    return o.reshape(b, t, ATT_WIDTH)


def _nsa_prompt(q, kv, gates, p):
    b, t = q.shape[0], q.shape[1]
    kc = _compress(kv[:, :, 0], p["cmp_pe_k"], p["cmp_w1_k"], p["cmp_w2_k"])
    vc = _compress(kv[:, :, 1], p["cmp_pe_v"], p["cmp_w1_v"], p["cmp_w2_v"])
    ks = kv[:, :, 2]
    vs = kv[:, :, 3]
    pad_w = ((0, 0), (WINDOW, 0), (0, 0), (0, 0))
    kw = jnp.pad(kv[:, :, 4], pad_w)
    vw = jnp.pad(kv[:, :, 5], pad_w)

    def one_block(i):
        q0 = i * Q_BLOCK
        qb = lax.dynamic_slice_in_dim(q, q0, Q_BLOCK, axis=1)
        gb = lax.dynamic_slice_in_dim(gates, q0, Q_BLOCK, axis=1)
        tq = q0 + jnp.arange(Q_BLOCK, dtype=jnp.int32)
        o_c, o_s = _nsa_global(qb, tq, kc, vc, ks, vs)
        kpos = q0 - WINDOW + jnp.arange(WINDOW + Q_BLOCK, dtype=jnp.int32)
        kwb = lax.dynamic_slice_in_dim(kw, q0, WINDOW + Q_BLOCK, axis=1)
        vwb = lax.dynamic_slice_in_dim(vw, q0, WINDOW + Q_BLOCK, axis=1)
        o_w = _nsa_window(qb, tq, kwb, vwb, kpos)
        return _nsa_merge(o_c, o_s, o_w, gb)

    out = lax.map(one_block, jnp.arange(t // Q_BLOCK, dtype=jnp.int32))
    out = jnp.moveaxis(out, 0, 1).reshape(b, t, ATT_WIDTH)
    win_buf = min(WINDOW, PAST_LEN)
    win_state = jnp.stack([kw[:, kw.shape[1] - win_buf:], vw[:, vw.shape[1] - win_buf:]], axis=2)
    return out, kv[:, :, :N_KV_STREAMS], win_state


def _nsa_sample(q, kv, gates, cache_nsa_kv, page_table, cache_win_kv, p):
    b, t = q.shape[0], q.shape[1]
    n_pages = page_table.shape[1]
    past_len = n_pages * PAGE_SIZE
    past = cache_nsa_kv[page_table].reshape(b, past_len, N_KV_STREAMS, N_KV_HEADS, ATT_HEAD_DIM)
    kv_rows = kv[:, :, :N_KV_STREAMS]
    full = jnp.concatenate([past.astype(kv.dtype), kv_rows], axis=1)
    kc = _compress(full[:, :, 0], p["cmp_pe_k"], p["cmp_w1_k"], p["cmp_w2_k"])
    vc = _compress(full[:, :, 1], p["cmp_pe_v"], p["cmp_w1_v"], p["cmp_w2_v"])
    tq = past_len + jnp.arange(t, dtype=jnp.int32)
    o_c, o_s = _nsa_global(q, tq, kc, vc, full[:, :, 2], full[:, :, 3])
    win_buf = cache_win_kv.shape[1]
    win = jnp.concatenate([cache_win_kv.astype(kv.dtype), kv[:, :, 4:]], axis=1)
    kpos = past_len - win_buf + jnp.arange(win_buf + t, dtype=jnp.int32)
    o_w = _nsa_window(q, tq, win[:, :, 0], win[:, :, 1], kpos)
    return _nsa_merge(o_c, o_s, o_w, gates), kv_rows, win[:, t:]


def _layer(x, c, pos, conv_buf, h0, ffn_buf, nsa_fn, p):
    mod = jnp.einsum("bd,de->be", jax.nn.silu(c), p["ada_w"]) + p["ada_b"]
    sh1, sc1, g1, sh2, sc2, g2 = jnp.split(mod[:, None, :], 6, axis=-1)
    h = _rmsnorm(x, p["norm1_w"]) * (1.0 + sc1) + sh1
    proj = h @ p["w_in"]
    z, xbc, dt_raw, q, kv, att_g, merge_g = jnp.split(proj, np.cumsum(IN_SIZES)[:-1].tolist(), axis=-1)
    b, t = x.shape[0], x.shape[1]
    y_ssm, conv_new, h_new = _mamba(z, xbc, dt_raw, conv_buf, h0, p)
    q = _rope(q.reshape(b, t, N_ATT_HEADS, ATT_HEAD_DIM), pos).reshape(b, t, N_KV_HEADS, Q_PER_KV, ATT_HEAD_DIM)
    kv = kv.reshape(b, t, N_KV_PROJ, N_KV_HEADS, ATT_HEAD_DIM)
    kv = kv.at[:, :, 0::2].set(_rope(kv[:, :, 0::2], pos))
    y_att, kv_rows, win_state = nsa_fn(q, kv, att_g)
    gm = jax.nn.sigmoid(merge_g)
    merged = gm[..., :D_MODEL] * (y_ssm @ p["w_ssm_out"]) + gm[..., D_MODEL:] * (y_att @ p["w_att_out"])
    x = x + g1 * (merged @ p["w_out"])
    h2 = _rmsnorm(x, p["norm2_w"]) * (1.0 + sc2) + sh2
    u = h2 @ p["ffn_w_up"]
    up = jnp.concatenate([ffn_buf.astype(u.dtype), u], axis=1)
    ffn_new = up[:, up.shape[1] - (FFN_CONV - 1):]
    u = _causal_dwconv(up, p["ffn_conv_w"], p["ffn_conv_b"])
    f = (jax.nn.silu(u[..., :D_FF]) * u[..., D_FF:]) @ p["ffn_w_down"]
    x = x + g2 * f
    return x, kv_rows, win_state, conv_new, h_new, ffn_new


def setup_inputs(seed: int = 0) -> dict:
    key = jax.random.key(seed)
    k = jax.random.split(key, 40)
    f32 = jnp.float32

    def nrm(kk, shape, scale):
        return jax.random.normal(kk, shape, f32) * scale

    n_pages = PAST_LEN // PAGE_SIZE
    n_used = DEC_BATCH * n_pages
    n_pool = (n_used * 5 + 3) // 4
    win_buf = min(WINDOW, PAST_LEN)
    page_table = jax.random.permutation(k[5], n_pool)[:n_used].reshape(DEC_BATCH, n_pages).astype(jnp.int32)
    dt_col = D_INNER + CONV_DIM
    w_in = nrm(k[10], (D_MODEL, D_IN_PROJ), D_MODEL ** -0.5)
    w_in = w_in.at[:, dt_col:dt_col + N_SSM_HEADS].multiply(0.1)
    dt0 = jnp.exp(jax.random.uniform(k[12], (N_SSM_HEADS,), f32, math.log(1e-3), math.log(1e-1)))
    return {
        "x_prompt": nrm(k[0], (BATCH, SEQ, D_MODEL), 1.0),
        "x_sample": nrm(k[1], (DEC_BATCH, DEC_SEQ, D_MODEL), 1.0),
        "c_prompt": nrm(k[2], (BATCH, D_MODEL), 1.0),
        "c_sample": nrm(k[3], (DEC_BATCH, D_MODEL), 1.0),
        "cache_nsa_kv": nrm(k[4], (n_pool, PAGE_SIZE, N_KV_STREAMS, N_KV_HEADS, ATT_HEAD_DIM), 1.0),
        "page_table": page_table,
        "cache_win_kv": nrm(k[6], (DEC_BATCH, win_buf, 2, N_KV_HEADS, ATT_HEAD_DIM), 1.0),
        "state_ssm": nrm(k[7], (DEC_BATCH, N_SSM_HEADS, SSM_HEAD_DIM, SSM_STATE), 0.3),
        "state_ssm_conv": nrm(k[8], (DEC_BATCH, SSM_CONV - 1, CONV_DIM), 1.0),
        "state_ffn_conv": nrm(k[9], (DEC_BATCH, FFN_CONV - 1, 2 * D_FF), 1.0),
        "ada_w": nrm(k[11], (D_MODEL, 6 * D_MODEL), 0.5 * D_MODEL ** -0.5),
        "ada_b": nrm(k[13], (6 * D_MODEL,), 0.01),
        "norm1_w": 1.0 + nrm(k[14], (D_MODEL,), 0.1),
        "norm2_w": 1.0 + nrm(k[15], (D_MODEL,), 0.1),
        "final_norm_w": 1.0 + nrm(k[16], (D_MODEL,), 0.1),
        "w_in": w_in,
        "ssm_conv_w": nrm(k[17], (SSM_CONV, CONV_DIM), 0.5),
        "ssm_conv_b": nrm(k[18], (CONV_DIM,), 0.01),
        "ssm_dt_bias": dt0 + jnp.log(-jnp.expm1(-dt0)),
        "ssm_A_log": jnp.log(jax.random.uniform(k[19], (N_SSM_HEADS,), f32, 1.0, 16.0)),
        "ssm_D": 1.0 + nrm(k[20], (N_SSM_HEADS,), 0.1),
        "ssm_norm_w": 1.0 + nrm(k[21], (D_INNER,), 0.1),
        "cmp_pe_k": nrm(k[22], (CMP_LEN, ATT_HEAD_DIM), 0.5),
        "cmp_w1_k": nrm(k[23], (CMP_LEN, ATT_HEAD_DIM, CMP_HIDDEN), (CMP_LEN * ATT_HEAD_DIM) ** -0.5),
        "cmp_w2_k": nrm(k[24], (CMP_HIDDEN, ATT_HEAD_DIM), 2.0 * CMP_HIDDEN ** -0.5),
        "cmp_pe_v": nrm(k[25], (CMP_LEN, ATT_HEAD_DIM), 0.5),
        "cmp_w1_v": nrm(k[26], (CMP_LEN, ATT_HEAD_DIM, CMP_HIDDEN), (CMP_LEN * ATT_HEAD_DIM) ** -0.5),
        "cmp_w2_v": nrm(k[27], (CMP_HIDDEN, ATT_HEAD_DIM), 2.0 * CMP_HIDDEN ** -0.5),
        "w_ssm_out": nrm(k[28], (D_INNER, D_MODEL), D_INNER ** -0.5),
        "w_att_out": nrm(k[29], (ATT_WIDTH, D_MODEL), ATT_WIDTH ** -0.5),
        "w_out": nrm(k[30], (D_MODEL, D_MODEL), D_MODEL ** -0.5),
        "ffn_w_up": nrm(k[31], (D_MODEL, 2 * D_FF), D_MODEL ** -0.5),
        "ffn_conv_w": nrm(k[32], (FFN_CONV, 2 * D_FF), 0.6),
        "ffn_conv_b": nrm(k[33], (2 * D_FF,), 0.01),
        "ffn_w_down": nrm(k[34], (D_FF, D_MODEL), D_FF ** -0.5),
    }


def reference(x_prompt, x_sample, c_prompt, c_sample, cache_nsa_kv, page_table, cache_win_kv, state_ssm,
              state_ssm_conv, state_ffn_conv, ada_w, ada_b, norm1_w, norm2_w, final_norm_w, w_in,
              ssm_conv_w, ssm_conv_b, ssm_dt_bias, ssm_A_log, ssm_D, ssm_norm_w,
              cmp_pe_k, cmp_w1_k, cmp_w2_k, cmp_pe_v, cmp_w1_v, cmp_w2_v,
              w_ssm_out, w_att_out, w_out, ffn_w_up, ffn_conv_w, ffn_conv_b, ffn_w_down):
    p = {
        "ada_w": ada_w, "ada_b": ada_b, "norm1_w": norm1_w, "norm2_w": norm2_w, "w_in": w_in,
        "ssm_conv_w": ssm_conv_w, "ssm_conv_b": ssm_conv_b, "ssm_dt_bias": ssm_dt_bias,
        "ssm_A_log": ssm_A_log, "ssm_D": ssm_D, "ssm_norm_w": ssm_norm_w,
        "cmp_pe_k": cmp_pe_k, "cmp_w1_k": cmp_w1_k, "cmp_w2_k": cmp_w2_k,
        "cmp_pe_v": cmp_pe_v, "cmp_w1_v": cmp_w1_v, "cmp_w2_v": cmp_w2_v,
        "w_ssm_out": w_ssm_out, "w_att_out": w_att_out, "w_out": w_out,
        "ffn_w_up": ffn_w_up, "ffn_conv_w": ffn_conv_w, "ffn_conv_b": ffn_conv_b, "ffn_w_down": ffn_w_down,
    }
    b, t = x_prompt.shape[0], x_prompt.shape[1]
    ds = x_sample.shape[1]
    past_len = page_table.shape[1] * PAGE_SIZE
    pos_p = jnp.arange(t, dtype=jnp.int32)
    pos_s = past_len + jnp.arange(ds, dtype=jnp.int32)
    dtype = x_prompt.dtype
    hp = x_prompt
    hs = x_sample
    for _ in range(DEPTH):
        hp, kv_p, win_p, conv_p, ssm_p, ffn_p = _layer(
            hp, c_prompt, pos_p,
            jnp.zeros((b, SSM_CONV - 1, CONV_DIM), dtype),
            jnp.zeros((b, N_SSM_HEADS, SSM_HEAD_DIM, SSM_STATE), dtype),
            jnp.zeros((b, FFN_CONV - 1, 2 * D_FF), dtype),
            lambda qq, kk, gg: _nsa_prompt(qq, kk, gg, p), p)
        hs, kv_s, win_s, conv_s, ssm_s, ffn_s = _layer(
            hs, c_sample, pos_s, state_ssm_conv, state_ssm, state_ffn_conv,
            lambda qq, kk, gg: _nsa_sample(qq, kk, gg, cache_nsa_kv, page_table, cache_win_kv, p), p)
    y_prompt = _rmsnorm(hp, final_norm_w)
    y_sample = _rmsnorm(hs, final_norm_w)
    return (y_prompt, y_sample, kv_p, kv_s, win_p, win_s, ssm_p, ssm_s, conv_p, conv_s, ffn_p, ffn_s)
```

```cpp
#include <hip/hip_runtime.h>
#include <cstdio>
#include <cstdint>
namespace pg8 {
#define PG8_LAS __attribute__((address_space(3)))
typedef unsigned short bf16_t;
typedef short bf16x8 __attribute__((ext_vector_type(8)));
typedef float f32x4 __attribute__((ext_vector_type(4)));
typedef unsigned u32x4 __attribute__((ext_vector_type(4)));
constexpr int BM = 256, BK = 64, HALF = 128, HTB = HALF * BK * 2  , STAGE_BYTES = 8 * HTB, NXCD = 8, WGM = 8;

__host__ __device__ __forceinline__ int lds_byte(int r, int c) { const int st = (r >> 4) * 2 + (c >> 5), rr = r & 15, cc = c & 31, ob = rr * 64 + cc * 2; return st * 1024 + (ob ^ (((ob >> 9) & 1) << 5)); }
__host__ __device__ __forceinline__ void stage_rc(int b, int& R, int& C) { const int st = b / 1024, sb = b % 1024, swz = sb ^ (((sb >> 9) & 1) << 5); R = (st >> 1) * 16 + swz / 64; C = (st & 1) * 32 + (swz % 64) / 2; }
__host__ __device__ __forceinline__ int perm32(int rho) { const int n = rho >> 4, i = rho & 15; return 8 * (i >> 2) + 4 * n + (i & 3); }

struct Unit { int pm, pn; };
struct Gemm { const bf16_t* A; const bf16_t* Bt; int M, N, K; };

struct StaticOrder {
    int nM, nN, nwg, G, c;
    __host__ __device__ void init(int M, int N, int G_, int c_) { nM = M / BM; nN = N / BM; nwg = nM * nN; G = G_; c = c_; }
    __host__ __device__ bool next(int i, Unit& u) const {
        const long L = (long)i * G + c; if (L >= nwg) return false;
        int wgid = (int)L; { const int q = nwg / NXCD, r = nwg % NXCD, xcd = wgid % NXCD, off = wgid / NXCD; wgid = (xcd < r ? xcd * (q + 1) : r * (q + 1) + (xcd - r) * q) + off; }
        const int nig = WGM * nN, gid = wgid / nig, fm = gid * WGM, gsz = (nM - fm) < WGM ? (nM - fm) : WGM;
        u.pm = fm + ((wgid % nig) % gsz); u.pn = (wgid % nig) / gsz; return true;
    }
    __device__ __forceinline__ void a_ready(const Unit&) const {}
    __device__ __forceinline__ void done(const Unit&) const {}
};
__device__ __forceinline__ unsigned cvt_pk_bf16(float lo, float hi) { unsigned r; asm volatile("v_cvt_pk_bf16_f32 %0, %1, %2" : "=v"(r) : "v"(lo), "v"(hi)); return r; }
typedef float f32x2 __attribute__((ext_vector_type(2)));
struct EpiF32 {
    static constexpr bool PERM = false, AFTER_DRAIN = false;
    float* C; int ldc; const float* bias;
    __device__ __forceinline__ void operator()(const f32x4 (&acc)[2][2][4][2], const Unit& u, int wr, int wc, int fr, int fq) const {
        const int row0 = u.pm * BM + wr * 64 + fr, col0 = u.pn * BM + wc * 32 + 4 * fq;
        f32x4 bv[2][2];
#pragma unroll
        for (int bj = 0; bj < 2; ++bj)
#pragma unroll
            for (int n = 0; n < 2; ++n) bv[bj][n] = bias ? *(const f32x4*)(bias + col0 + bj * HALF + n * 16) : (f32x4){0.f, 0.f, 0.f, 0.f};
#pragma unroll
        for (int ai = 0; ai < 2; ++ai)
#pragma unroll
            for (int m = 0; m < 4; ++m) { float* rowp = C + (size_t)(row0 + ai * HALF + m * 16) * ldc + col0;
#pragma unroll
                for (int bj = 0; bj < 2; ++bj)
#pragma unroll
                    for (int n = 0; n < 2; ++n) *(f32x4*)(rowp + bj * HALF + n * 16) = acc[ai][bj][m][n] + bv[bj][n]; }
    }
};
template <class Epi, class Sched, bool ALIGN_EPI = false, bool SP2 = false>
__device__ __forceinline__ void gemm_phase(PG8_LAS unsigned char* lds, const Gemm g, const Sched& S, const Epi& E) {
    const int tid = threadIdx.x, wid = __builtin_amdgcn_readfirstlane(tid >> 6), lane = tid & 63, wr = wid >> 2, wc = wid & 3, fr = lane & 15, fq = lane >> 4;
    const int K = g.K, nt = K / BK;
    unsigned voffA[2], voffB[2];
#pragma unroll
    for (int i = 0; i < 2; ++i) { int R, C; stage_rc(tid * 16 + i * 8192, R, C); const int Rb = Epi::PERM ? ((R & ~31) + perm32(R & 31)) : R;
        voffA[i] = (unsigned)(R * K + C) * 2u; voffB[i] = (unsigned)(Rb * K + C) * 2u; }
    const size_t kstep = (size_t)(BK * 2);
    const size_t hstep = (size_t)HALF * K * 2;
    const size_t tstep = 2 * hstep;
    const unsigned ldsw = (unsigned)wid * 1024u;
    const int aoff = lds_byte(wr * 64 + fr, fq * 8), boff = lds_byte(wc * 32 + fr, fq * 8);
#define PG8_SA(b, h) (((b) * 2 + (h)) * HTB)
#define PG8_SB(b, h) ((4 + (b) * 2 + (h)) * HTB)
#define PG8_STAGE(bufoff, gbase, voff) do { _Pragma("unroll") for (int _i = 0; _i < 2; ++_i) \
        __builtin_amdgcn_global_load_lds((const unsigned*)((const char*)(gbase) + (voff)[_i]), (PG8_LAS unsigned*)(lds + (bufoff) + ldsw + _i * 8192), 16, 0, 0); } while (0)
#define PG8_LDA(dst, b, h) do { _Pragma("unroll") for (int m = 0; m < 4; ++m) _Pragma("unroll") for (int k = 0; k < 2; ++k) dst[m][k] = *(const PG8_LAS bf16x8*)(lds + PG8_SA(b, h) + aoff + m * 2048 + k * 1024); } while (0)
#define PG8_LDB(dst, b, h) do { _Pragma("unroll") for (int n = 0; n < 2; ++n) _Pragma("unroll") for (int k = 0; k < 2; ++k) dst[n][k] = *(const PG8_LAS bf16x8*)(lds + PG8_SB(b, h) + boff + n * 2048 + k * 1024); } while (0)
#define PG8_MMA(ai, bj, At, Bt) do { __builtin_amdgcn_s_setprio(1); _Pragma("unroll") for (int m = 0; m < 4; ++m) _Pragma("unroll") for (int n = 0; n < 2; ++n) _Pragma("unroll") for (int k = 0; k < 2; ++k) \
        acc[ai][bj][m][n] = __builtin_amdgcn_mfma_f32_16x16x32_bf16(Bt[n][k], At[m][k], acc[ai][bj][m][n], 0, 0, 0); __builtin_amdgcn_s_setprio(0); } while (0)
#define PG8_WAIT_V(n) asm volatile("s_waitcnt vmcnt(" #n ")" ::: "memory")
#define PG8_WAIT_L(n) asm volatile("s_waitcnt lgkmcnt(" #n ")" ::: "memory")
#define PG8_BAR __builtin_amdgcn_s_barrier()
#define PG8_SCHED __builtin_amdgcn_sched_barrier(0)
    Unit cur, nxt; int ui = 0;
    if (!S.next(0, cur)) return;
    f32x4 acc[2][2][4][2];
#pragma unroll
    for (int a = 0; a < 2; ++a)
#pragma unroll
        for (int b = 0; b < 2; ++b)
#pragma unroll
            for (int m = 0; m < 4; ++m)
#pragma unroll
                for (int n = 0; n < 2; ++n) acc[a][b][m][n] = (f32x4){0.f, 0.f, 0.f, 0.f};
    bf16x8 At[4][2], B0[2][2], B1[2][2];
    const char* cA = (const char*)g.A + (size_t)cur.pm * tstep; const char* cB = (const char*)g.Bt + (size_t)cur.pn * tstep;
    S.a_ready(cur);
    if constexpr (SP2) {
        PG8_STAGE(PG8_SB(0, 0), cB, voffB); PG8_STAGE(PG8_SB(0, 1), cB + hstep, voffB); PG8_STAGE(PG8_SA(0, 0), cA, voffA); PG8_STAGE(PG8_SA(0, 1), cA + hstep, voffA);
        if (wr == 1) PG8_BAR;
        PG8_WAIT_V(2); PG8_BAR;
        PG8_STAGE(PG8_SB(1, 0), cB + kstep, voffB); PG8_STAGE(PG8_SA(1, 0), cA + kstep, voffA); PG8_STAGE(PG8_SB(1, 1), cB + hstep + kstep, voffB);
        PG8_WAIT_V(6); PG8_BAR;
    } else {
        PG8_STAGE(PG8_SB(0, 0), cB, voffB); PG8_STAGE(PG8_SA(0, 0), cA, voffA); PG8_STAGE(PG8_SB(0, 1), cB + hstep, voffB); PG8_STAGE(PG8_SA(0, 1), cA + hstep, voffA);
        if (wr == 1) PG8_BAR;
        PG8_WAIT_V(4); PG8_BAR;
        PG8_STAGE(PG8_SB(1, 0), cB + kstep, voffB); PG8_STAGE(PG8_SA(1, 0), cA + kstep, voffA); PG8_STAGE(PG8_SB(1, 1), cB + hstep + kstep, voffB);
        PG8_WAIT_V(6); PG8_BAR;
    }
    for (;;) {
        const bool has_next = S.next(ui + 1, nxt);
        const char* nA = has_next ? (const char*)g.A + (size_t)nxt.pm * tstep : cA; const char* nB = has_next ? (const char*)g.Bt + (size_t)nxt.pn * tstep : cB;
        for (int t = 0; t < nt; t += 2) {
            const bool last = (t == nt - 2);
            const char* a1 = cA + (size_t)(t + 1) * kstep;
            const char* a2 = last ? nA : cA + (size_t)(t + 2) * kstep; const char* b2 = last ? nB : cB + (size_t)(t + 2) * kstep;
            const char* a3 = a2 + kstep; const char* b3 = b2 + kstep;
            if (last && has_next) S.a_ready(nxt);
            if constexpr (SP2) {
            PG8_LDB(B0, 0, 0); PG8_LDB(B1, 0, 1); PG8_SCHED; PG8_LDA(At, 0, 0); PG8_STAGE(PG8_SA(1, 1), a1 + hstep, voffA);
            PG8_WAIT_V(8); PG8_WAIT_L(0); PG8_BAR; PG8_MMA(0, 0, At, B0); PG8_MMA(0, 1, At, B1); PG8_BAR; PG8_SCHED;
            PG8_LDA(At, 0, 1); PG8_STAGE(PG8_SB(0, 0), b2, voffB); PG8_STAGE(PG8_SB(0, 1), b2 + hstep, voffB); PG8_STAGE(PG8_SA(0, 0), a2, voffA);
            PG8_WAIT_V(8); PG8_WAIT_L(0); PG8_BAR; PG8_MMA(1, 0, At, B0); PG8_MMA(1, 1, At, B1); PG8_BAR; PG8_SCHED;
            PG8_LDB(B0, 1, 0); PG8_LDB(B1, 1, 1); PG8_SCHED; PG8_LDA(At, 1, 0); PG8_STAGE(PG8_SA(0, 1), a2 + hstep, voffA);
            PG8_WAIT_V(8); PG8_WAIT_L(0); PG8_BAR; PG8_MMA(0, 0, At, B0); PG8_MMA(0, 1, At, B1); PG8_BAR; PG8_SCHED;
            PG8_LDA(At, 1, 1); PG8_STAGE(PG8_SB(1, 0), b3, voffB); PG8_STAGE(PG8_SB(1, 1), b3 + hstep, voffB); PG8_STAGE(PG8_SA(1, 0), a3, voffA);
            PG8_WAIT_V(8); PG8_WAIT_L(0); PG8_BAR; PG8_MMA(1, 0, At, B0); PG8_MMA(1, 1, At, B1); PG8_BAR; PG8_SCHED;
            } else {
            PG8_LDB(B0, 0, 0); PG8_SCHED; PG8_LDA(At, 0, 0); PG8_STAGE(PG8_SA(1, 1), a1 + hstep, voffA);
            PG8_WAIT_L(8); PG8_BAR; PG8_WAIT_L(0); PG8_MMA(0, 0, At, B0); PG8_BAR; PG8_SCHED;
            PG8_LDB(B1, 0, 1); PG8_STAGE(PG8_SB(0, 0), b2, voffB);
            PG8_BAR; PG8_WAIT_L(0); PG8_MMA(0, 1, At, B1); PG8_BAR;
            PG8_LDA(At, 0, 1); PG8_STAGE(PG8_SA(0, 0), a2, voffA);
            PG8_BAR; PG8_WAIT_L(0); PG8_MMA(1, 0, At, B0); PG8_BAR; PG8_SCHED;
            PG8_STAGE(PG8_SB(0, 1), b2 + hstep, voffB);
            PG8_WAIT_V(6); PG8_BAR; PG8_MMA(1, 1, At, B1); PG8_BAR;
            PG8_LDB(B0, 1, 0); PG8_SCHED; PG8_LDA(At, 1, 0); PG8_STAGE(PG8_SA(0, 1), a2 + hstep, voffA);
            PG8_WAIT_L(8); PG8_BAR; PG8_WAIT_L(0); PG8_MMA(0, 0, At, B0); PG8_BAR; PG8_SCHED;
            PG8_LDB(B1, 1, 1); PG8_STAGE(PG8_SB(1, 0), b3, voffB);
            PG8_BAR; PG8_WAIT_L(0); PG8_MMA(0, 1, At, B1); PG8_BAR;
            PG8_LDA(At, 1, 1); PG8_STAGE(PG8_SA(1, 0), a3, voffA);
            PG8_BAR; PG8_WAIT_L(0); PG8_MMA(1, 0, At, B0); PG8_BAR; PG8_SCHED;
            PG8_STAGE(PG8_SB(1, 1), b3 + hstep, voffB);
            PG8_WAIT_V(6); PG8_BAR; PG8_MMA(1, 1, At, B1); PG8_BAR;
            }
        }
        if constexpr (ALIGN_EPI) { if (wr == 0) PG8_BAR; }
        if constexpr (!Epi::AFTER_DRAIN) { E(acc, cur, wr, wc, fr, fq); S.done(cur); }
        if (!has_next) break;
#pragma unroll
        for (int a = 0; a < 2; ++a)
#pragma unroll
            for (int b = 0; b < 2; ++b)
#pragma unroll
                for (int m = 0; m < 4; ++m)
#pragma unroll
                    for (int n = 0; n < 2; ++n) acc[a][b][m][n] = (f32x4){0.f, 0.f, 0.f, 0.f};
        cur = nxt; cA = nA; cB = nB; ++ui;
        if constexpr (ALIGN_EPI) { if (wr == 1) PG8_BAR; }
    }
    PG8_WAIT_V(0);
    if constexpr (!ALIGN_EPI) { if (wr == 0) PG8_BAR; }
    PG8_BAR;
    if constexpr (Epi::AFTER_DRAIN) { E.fused(acc, cur, wr, wc, fr, fq, lds, wid, lane); S.done(cur); }
#undef PG8_SA
#undef PG8_SB
#undef PG8_STAGE
#undef PG8_LDA
#undef PG8_LDB
#undef PG8_MMA
#undef PG8_WAIT_V
#undef PG8_WAIT_L
#undef PG8_BAR
#undef PG8_SCHED
}
}
#define GAS __attribute__((address_space(1)))
#define LAS __attribute__((address_space(3)))
typedef unsigned short bf16;
typedef float f32x4 __attribute__((ext_vector_type(4)));
typedef float f32x2 __attribute__((ext_vector_type(2)));
typedef short bf16x8 __attribute__((ext_vector_type(8)));
typedef short bf16x4 __attribute__((ext_vector_type(4)));
typedef unsigned u32x4 __attribute__((ext_vector_type(4)));
typedef unsigned u32x2 __attribute__((ext_vector_type(2)));
#define MFMA16(a, b, c) __builtin_amdgcn_mfma_f32_16x16x32_bf16((a), (b), (c), 0, 0, 0)

constexpr int NWAVES = 8, NTHR = 512;
constexpr int DM = 1024, SEQ = 4096, NB = 4, MP = NB * SEQ, MS = 128, MALL = MP + MS, MPAD = 16640;
constexpr int DI = 2048, CONVD = 3072, NH = 32, NG = 4, NST = 128;
constexpr int NPROJ = 9984;
constexpr int DFF = 2816, DFF2 = 5632;
constexpr int NPAGES = 16, PAST = 2048;
constexpr float EPS = 1e-6f, NEGF = -1e30f, BIGF = 1e30f, TINYF = 1e-30f;
constexpr int T_Z = 0, T_XBC = 8, T_Q = 20, T_KV = 24, T_MG = 30, T_MISC = 38;

constexpr size_t O_YP = 0;
constexpr size_t O_YS = O_YP + (size_t)MP * DM;
constexpr size_t O_KVP = O_YS + (size_t)MS * DM;
constexpr size_t O_KVS = O_KVP + (size_t)MP * 1024;
constexpr size_t O_WINP = O_KVS + (size_t)MS * 1024;
constexpr size_t O_WINS = O_WINP + (size_t)NB * 512 * 512;
constexpr size_t O_SSMP = O_WINS + (size_t)MS * 512 * 512;
constexpr size_t O_SSMS = O_SSMP + (size_t)NB * NH * 64 * 128;
constexpr size_t O_CONVP = O_SSMS + (size_t)MS * NH * 64 * 128;
constexpr size_t O_CONVS = O_CONVP + (size_t)NB * 3 * CONVD;
constexpr size_t O_FFNP = O_CONVS + (size_t)MS * 3 * CONVD;
constexpr size_t O_FFNS = O_FFNP + (size_t)NB * 2 * DFF2;
constexpr size_t O_END = O_FFNS + (size_t)MS * 2 * DFF2;
static_assert(O_END == 105725952, "output size");

constexpr size_t al256(size_t x) { return (x + 255) & ~(size_t)255; }
constexpr size_t WS_CTL = 0, CTL_ZERO_BYTES = 1u << 20;
constexpr size_t WS_WIN = CTL_ZERO_BYTES;
constexpr size_t WS_WSSM = WS_WIN + al256((size_t)NPROJ * 1024 * 2);
constexpr size_t WS_WATT = WS_WSSM + al256((size_t)1024 * 2048 * 2);
constexpr size_t WS_WOUT = WS_WATT + al256((size_t)1024 * 1024 * 2);
constexpr size_t WS_WUP = WS_WOUT + al256((size_t)1024 * 1024 * 2);
constexpr size_t WS_WDN = WS_WUP + al256((size_t)DFF2 * 1024 * 2);
constexpr size_t WS_WADA = WS_WDN + al256((size_t)1024 * DFF * 2);
constexpr size_t WS_W1K = WS_WADA + al256((size_t)6144 * 1024 * 2);
constexpr size_t WS_W1V = WS_W1K + al256((size_t)256 * 1024 * 2);
constexpr size_t WS_SC = WS_W1V + al256((size_t)256 * 1024 * 2);
constexpr size_t WS_MOD = WS_SC + al256((size_t)256 * 1024 * 2);
constexpr size_t WS_ROPE = WS_MOD + al256((size_t)256 * 6144 * 4);
constexpr size_t WS_PET = WS_ROPE + al256((size_t)4096 * 16 * 4);
constexpr size_t WS_H = WS_PET + al256(2 * 128 * 4);
constexpr size_t WS_Z = WS_H + al256((size_t)MPAD * 1024 * 2);
constexpr size_t WS_XBC = WS_Z + al256((size_t)MPAD * 2048 * 2);
constexpr size_t WS_Q = WS_XBC + al256((size_t)MPAD * 3072 * 2);
constexpr size_t WS_MG = WS_Q + al256((size_t)MPAD * 1024 * 2);
constexpr size_t WS_MISC = WS_MG + al256((size_t)MPAD * 2048 * 2);
constexpr size_t WS_KVH = WS_MISC + al256((size_t)MPAD * 128 * 4);
constexpr size_t WS_VT = WS_KVH + al256((size_t)6 * 16 * 4096 * 64 * 2);
constexpr size_t WS_XT = WS_VT + al256((size_t)2 * 16 * 64 * 4096 * 2);
constexpr size_t WS_BN = WS_XT + al256((size_t)4 * 32 * 64 * 4096 * 2);
constexpr size_t WS_CN = WS_BN + al256((size_t)16 * 4096 * 128 * 2);
constexpr size_t WS_BT = WS_CN + al256((size_t)16 * 4096 * 128 * 2);
constexpr size_t WS_DT = WS_BT + al256((size_t)16 * 4096 * 128 * 2);
constexpr size_t WS_CS = WS_DT + al256((size_t)128 * 4096 * 4);
constexpr size_t WS_STATES = WS_CS + al256((size_t)128 * 4096 * 4);
constexpr size_t WS_HPREV = WS_STATES + al256((size_t)4096 * 8192 * 4);
constexpr size_t WS_YSSM = WS_HPREV + al256((size_t)4096 * 8192 * 2);
constexpr size_t WS_SSQ = WS_YSSM + al256((size_t)MPAD * 2048 * 2);
constexpr size_t WS_PARTK = WS_SSQ + al256((size_t)MPAD * 4 * 4);
constexpr size_t WS_PARTV = WS_PARTK + al256((size_t)4096 * 256 * 4);
constexpr size_t WS_KC = WS_PARTV + al256((size_t)4096 * 256 * 4);
constexpr size_t WS_VCT = WS_KC + al256((size_t)16 * 256 * 64 * 2);
constexpr size_t WS_YATTF = WS_VCT + al256((size_t)16 * 256 * 64 * 2);
constexpr size_t WS_YATT = WS_YATTF + al256((size_t)MPAD * 1024 * 4);
constexpr size_t WS_TMPM = WS_YATT + al256((size_t)MPAD * 1024 * 2);
constexpr size_t WS_MERGED = WS_TMPM + al256((size_t)MPAD * 1024 * 4);
constexpr size_t WS_X1 = WS_MERGED + al256((size_t)MPAD * 1024 * 2);
constexpr size_t WS_U = WS_X1 + al256((size_t)MPAD * 1024 * 4);
constexpr size_t WS_ACT = WS_U + al256((size_t)MPAD * DFF2 * 2);
constexpr size_t WS_CKB = WS_ACT + al256((size_t)MPAD * DFF * 2);
constexpr size_t WS_CVB = WS_CKB + al256((size_t)128 * 4 * 2048 * 64 * 2);
constexpr size_t WS_PARTSK = WS_CVB + al256((size_t)128 * 4 * 2048 * 64 * 2);
constexpr size_t WS_PARTSV = WS_PARTSK + al256((size_t)65536 * 256 * 4);
constexpr size_t WS_KCS = WS_PARTSV + al256((size_t)65536 * 256 * 4);
constexpr size_t WS_VCS = WS_KCS + al256((size_t)128 * 4 * 128 * 64 * 4);
constexpr size_t WS_XCS = WS_VCS + al256((size_t)128 * 4 * 128 * 64 * 4);
constexpr size_t WS_DTS = WS_XCS + al256((size_t)128 * 3072 * 4);
constexpr size_t WS_END = WS_DTS + al256((size_t)128 * 32 * 4);

constexpr int CW_BAR = 4096;

constexpr int RING_BYTES = 131072;
constexpr int LDSCTL_OFF = RING_BYTES, MISC_OFF = LDSCTL_OFF + 320;
constexpr int LDS_BYTES = 147456;

__device__ __forceinline__ unsigned f2bf(float f) { unsigned u = __builtin_bit_cast(unsigned, f); return (u + 0x7fffu + ((u >> 16) & 1u)) >> 16; }
__device__ __forceinline__ unsigned pk2(float lo, float hi) { return pg8::cvt_pk_bf16(lo, hi); }
__device__ __forceinline__ float bf2f(unsigned h) { return __builtin_bit_cast(float, h << 16); }
__device__ __forceinline__ float bflo(unsigned w) { return __builtin_bit_cast(float, w << 16); }
__device__ __forceinline__ float bfhi(unsigned w) { return __builtin_bit_cast(float, w & 0xffff0000u); }
__device__ __forceinline__ float wave_sum(float v) {
#pragma unroll
    for (int o = 1; o < 64; o <<= 1) v += __shfl_xor(v, o);
    return v;
}
__device__ __forceinline__ float siluf(float x) { return x / (1.f + __expf(-x)); }
__device__ __forceinline__ float sigmf(float x) { return 1.f / (1.f + __expf(-x)); }
__device__ __forceinline__ float softplusf(float x) { return x > 20.f ? x : log1pf(__expf(x)); }
#define LDS_WAIT() asm volatile("s_waitcnt lgkmcnt(0)" ::: "memory")

struct Args { const void* in[35]; float* out; unsigned char* ws; int ph_lo, ph_hi; };
#define INF(i) ((const float*)args.in[i])
#define XB_TMO      128
#define XB_XCNT(j)  (256  + 64 * (j))
#define XB_XSUB(j)  (1280 + 64 * (j))
#define XB_XGEN(j)  (2304 + 64 * (j))
#define XB_TOP      3328
#define XB_TOPGEN   3392
#define XCD_BAR_WORDS 3456
#define XB_SPIN_CAP (1u << 18)

__device__ __forceinline__ unsigned xb_ld(unsigned* p)              { return __hip_atomic_load(p, __ATOMIC_RELAXED, __HIP_MEMORY_SCOPE_AGENT); }
__device__ __forceinline__ unsigned xb_add(unsigned* p, unsigned v) { return __hip_atomic_fetch_add(p, v, __ATOMIC_RELAXED, __HIP_MEMORY_SCOPE_AGENT); }
__device__ __forceinline__ unsigned xb_xcc_id() { return (unsigned)__builtin_amdgcn_s_getreg((3 << 11) | 20) & 0xFu; }
#define XB_SPIN(cond, bar) do { unsigned _sp = 0; while (cond) { __builtin_amdgcn_s_sleep(1); \
    if ((++_sp & 255u) == 0u) { if (xb_ld(&(bar)[XB_TMO])) break; if (_sp > XB_SPIN_CAP) { atomicAdd(&(bar)[XB_TMO], 1u); break; } } } } while (0)

struct XcdBarrier {
    unsigned* bar; unsigned x;
    volatile LAS unsigned* st;
};

__device__ __forceinline__ XcdBarrier xcd_barrier_post(unsigned* bar, volatile LAS unsigned* st) {
    XcdBarrier b; b.bar = bar; b.x = xb_xcc_id(); b.st = st;
    if (threadIdx.x == 0) (void)xb_add(&bar[XB_XCNT(b.x)], 1u);
    return b;
}
__device__ __forceinline__ void xcd_barrier_complete(unsigned* bar, unsigned x, unsigned& nloc, unsigned& nx) {
    const unsigned G = gridDim.x * gridDim.y * gridDim.z;
    unsigned sum, cnt, mine, sp = 0u;
    for (;;) {
        sum = 0u; cnt = 0u; mine = 0u;
#pragma unroll
        for (unsigned j = 0; j < 16; ++j) { const unsigned c = xb_ld(&bar[XB_XCNT(j)]); sum += c; cnt += (c > 0u) ? 1u : 0u; mine = (j == x) ? c : mine; }
        if (sum == G) break;
        __builtin_amdgcn_s_sleep(1);
        if ((++sp & 255u) == 0u) { if (xb_ld(&bar[XB_TMO])) break; if (sp > XB_SPIN_CAP) { atomicAdd(&bar[XB_TMO], 1u); break; } }
    }
    nloc = mine > 0u ? mine : 1u; nx = cnt > 0u ? cnt : 1u;
}

__device__ __forceinline__ void xcd_barrier(const XcdBarrier& b) {
    asm volatile("s_waitcnt vmcnt(0)" ::: "memory");
    __syncthreads();
    if (threadIdx.x == 0) {
        unsigned* bar = b.bar;
        __builtin_amdgcn_s_waitcnt(0);
        unsigned nloc = b.st[0], nx = b.st[1];
        if (nloc == 0u) { xcd_barrier_complete(bar, b.x, nloc, nx); b.st[0] = nloc; b.st[1] = nx; }
        const unsigned old = xb_add(&bar[XB_XSUB(b.x)], 1u);
        const unsigned gen = old / nloc;
        if (old + 1u == (gen + 1u) * nloc) {
            __builtin_amdgcn_fence(__ATOMIC_RELEASE, "agent");
            asm volatile("s_waitcnt vmcnt(0)" ::: "memory");
            const unsigned og = xb_add(&bar[XB_TOP], 1u);
            const unsigned tg = og / nx;
            if (og + 1u == (tg + 1u) * nx) xb_add(&bar[XB_TOPGEN], 1u);
            else XB_SPIN(xb_ld(&bar[XB_TOPGEN]) == tg, bar);
            __builtin_amdgcn_fence(__ATOMIC_ACQUIRE, "agent");
            xb_add(&bar[XB_XGEN(b.x)], 1u);
            asm volatile("s_waitcnt vmcnt(0)" ::: "memory");
        } else {
            XB_SPIN(xb_ld(&bar[XB_XGEN(b.x)]) == gen, bar);
            __builtin_amdgcn_fence(__ATOMIC_ACQUIRE, "agent");
            asm volatile("s_waitcnt vmcnt(0)" ::: "memory");
        }
    }
    __syncthreads();
}
__device__ __forceinline__ int inproj_src_col(int n) {
    if (n < 5120) return n;
    if (n < 6144) return n - 5120 + 5152;
    if (n < 7680) return n - 6144 + 6176;
    if (n < 9728) return n - 7680 + 7760;
    const int i = n - 9728;
    if (i < 32) return 5120 + i;
    if (i < 80) return 7712 + (i - 32);
    return -1;
}
template <int MODE>
__device__ __forceinline__ void transpose_item(const float* W, int K, int ldw, int nblk, bf16* WT, int row_off, LAS float* scr, int item, int lane) {
    const int kb = item / nblk, nb = item % nblk, k0 = 64 * kb, n0 = 32 * nb;
    const int n = n0 + (lane & 31);
    const int sc = (MODE == 1) ? inproj_src_col(n) : n;
#pragma unroll 8
    for (int i = 0; i < 32; ++i) { const int kk = 2 * i + (lane >> 5); scr[kk * 33 + (lane & 31)] = (sc >= 0) ? W[(size_t)(k0 + kk) * ldw + sc] : 0.f; }
    LDS_WAIT(); asm volatile("" ::: "memory");
    const int c = lane & 7;
#pragma unroll
    for (int j = 0; j < 4; ++j) { const int nn = (lane >> 3) + 8 * j; const LAS float* s = scr + (8 * c) * 33 + nn;
        u32x4 o; o.x = pk2(s[0 * 33], s[1 * 33]); o.y = pk2(s[2 * 33], s[3 * 33]); o.z = pk2(s[4 * 33], s[5 * 33]); o.w = pk2(s[6 * 33], s[7 * 33]);
        *(u32x4*)(WT + (size_t)(row_off + n0 + nn) * K + k0 + 8 * c) = o; }
    LDS_WAIT(); asm volatile("" ::: "memory");
}

__device__ __forceinline__ void p0_prologue(const Args& args, LAS unsigned char* lds, int gw, int NGW, int lane, int wave) {
    unsigned char* ws = args.ws;
    LAS float* scr = (LAS float*)(lds + wave * 16384);
    constexpr int I_IN = 16 * (NPROJ / 32), I_SSM = 32 * 32, I_ATT = 16 * 32, I_OUT = 16 * 32, I_UP = 16 * (DFF2 / 32), I_DN = (DFF / 64) * 32, I_ADA = 16 * (6144 / 32), I_W1 = 16 * 4;
    constexpr int NITEMS = I_IN + I_SSM + I_ATT + I_OUT + I_UP + I_DN + I_ADA + 4 * I_W1;
    for (int it = gw; it < NITEMS; it += NGW) {
        int r = it;
        if (r < I_ADA) { transpose_item<0>(INF(10), 1024, 6144, 6144 / 32, (bf16*)(ws + WS_WADA), 0, scr, r, lane); continue; } r -= I_ADA;
        if (r < I_IN) { transpose_item<1>(INF(15), 1024, 9808, NPROJ / 32, (bf16*)(ws + WS_WIN), 0, scr, r, lane); continue; } r -= I_IN;
        if (r < I_SSM) { transpose_item<0>(INF(28), 2048, 1024, 32, (bf16*)(ws + WS_WSSM), 0, scr, r, lane); continue; } r -= I_SSM;
        if (r < I_ATT) { transpose_item<0>(INF(29), 1024, 1024, 32, (bf16*)(ws + WS_WATT), 0, scr, r, lane); continue; } r -= I_ATT;
        if (r < I_OUT) { transpose_item<0>(INF(30), 1024, 1024, 32, (bf16*)(ws + WS_WOUT), 0, scr, r, lane); continue; } r -= I_OUT;
        if (r < I_UP) { transpose_item<0>(INF(31), 1024, DFF2, DFF2 / 32, (bf16*)(ws + WS_WUP), 0, scr, r, lane); continue; } r -= I_UP;
        if (r < I_DN) { transpose_item<0>(INF(34), DFF, 1024, 32, (bf16*)(ws + WS_WDN), 0, scr, r, lane); continue; } r -= I_DN;
        { const int which = r / I_W1, rr = r % I_W1; const int st = which >> 1, r2 = which & 1;
          transpose_item<0>(INF(st ? 26 : 23) + (size_t)r2 * 16 * 64 * 128, 1024, 128, 4, (bf16*)(ws + (st ? WS_W1V : WS_W1K)), r2 * 128, scr, rr, lane); }
    }
    for (int r = gw; r < 256; r += NGW) {
        bf16* o = (bf16*)(ws + WS_SC) + (size_t)r * 1024;
        const float* src = r < 4 ? INF(2) + (size_t)r * 1024 : (r < 132 ? INF(3) + (size_t)(r - 4) * 1024 : nullptr);
#pragma unroll
        for (int j = 0; j < 4; ++j) { const int c0 = (j * 64 + lane) * 4; f32x4 v = src ? *(const f32x4*)(src + c0) : (f32x4){0.f, 0.f, 0.f, 0.f};
            u32x2 w; w.x = pk2(src ? siluf(v.x) : 0.f, src ? siluf(v.y) : 0.f); w.y = pk2(src ? siluf(v.z) : 0.f, src ? siluf(v.w) : 0.f); *(u32x2*)(o + c0) = w; }
    }
    for (int i = gw * 64 + lane; i < 4096 * 8; i += NGW * 64) {
        const int pos = i >> 3, k = i & 7;
        const float invf[8] = {1.0f, 0.1939227432012558f, 0.03760603070259094f, 0.007292664609849453f, 0.0014142135623842478f, 0.00027424818836152554f, 5.318296098266728e-05f, 1.0313386155758053e-05f};
        float fr = 1.0f;
#pragma unroll
        for (int q = 0; q < 8; ++q) fr = (k == q) ? invf[q] : fr;
        const float ang = (float)pos * fr;
        const double ad = (double)ang, rev = ad * 0.15915494309189535;
        const float fracrev = (float)(rev - __builtin_floor(rev));
        float* o = (float*)(ws + WS_ROPE) + (size_t)pos * 16;
        o[k] = __builtin_amdgcn_cosf(fracrev); o[8 + k] = __builtin_amdgcn_sinf(fracrev);
    }
    for (int it = gw; it < 256; it += NGW) {
        const int st = it >> 7, e = it & 127; const float* pe = INF(st ? 25 : 22); const float* w1 = INF(st ? 26 : 23);
        float s = 0.f;
        for (int i = 0; i < 32; ++i) { const int idx = lane + 64 * i; s += pe[idx] * w1[(size_t)idx * 128 + e]; }
        s = wave_sum(s);
        if (lane == 0) ((float*)(ws + WS_PET))[it] = s;
    }
    {
        const int* pt = (const int*)args.in[5]; const float* cache = INF(4);
        for (int it = gw; it < 128 * 2048 * 2; it += NGW) {
            const int s = it & 1, t = (it >> 1) & 2047, b = it >> 12;
            const int page = pt[b * NPAGES + (t >> 7)];
            const f32x4 v = *(const f32x4*)(cache + (((size_t)page * 128 + (t & 127)) * 4 + s) * 256 + lane * 4);
            const int h = lane >> 4, d = (lane & 15) * 4;
            bf16* dst = (bf16*)(ws + (s ? WS_CVB : WS_CKB)) + (((size_t)(b * 4 + h) * 2048 + t) * 64 + d);
            u32x2 w; w.x = pk2(v.x, v.y); w.y = pk2(v.z, v.w); *(u32x2*)dst = w;
        }
    }
}

template <int WHICH>
__device__ __forceinline__ void norm_mod_phase(const Args& args, int gw, int NGW, int lane) {
    unsigned char* ws = args.ws; const float* MOD = (const float*)(ws + WS_MOD); bf16* H = (bf16*)(ws + WS_H);
    const float* nw = INF(WHICH ? 13 : 12);
    constexpr int SH = WHICH ? 3072 : 0, SCo = WHICH ? 4096 : 1024;
    for (int m = gw; m < MPAD; m += NGW) {
        u32x2* o = (u32x2*)(H + (size_t)m * 1024);
        if (m >= MALL) {
#pragma unroll
            for (int j = 0; j < 4; ++j) o[j * 64 + lane] = (u32x2){0u, 0u};
            continue; }
        const float* xr = WHICH ? (const float*)(ws + WS_X1) + (size_t)m * 1024 : (m < MP ? INF(0) + (size_t)m * 1024 : INF(1) + (size_t)(m - MP) * 1024);
        const float* mr = MOD + (size_t)(m < MP ? (m >> 12) : 4 + (m - MP)) * 6144;
        f32x4 v[4]; float s = 0.f;
#pragma unroll
        for (int j = 0; j < 4; ++j) { v[j] = *(const f32x4*)(xr + (j * 64 + lane) * 4); s += (v[j].x * v[j].x + v[j].y * v[j].y) + (v[j].z * v[j].z + v[j].w * v[j].w); }
        const float rstd = 1.f / sqrtf(wave_sum(s) * (1.f / 1024.f) + EPS);
#pragma unroll
        for (int j = 0; j < 4; ++j) { const int c0 = (j * 64 + lane) * 4;
            const f32x4 w = *(const f32x4*)(nw + c0), sc = *(const f32x4*)(mr + SCo + c0), sh = *(const f32x4*)(mr + SH + c0);
            const f32x4 r = (v[j] * rstd) * w * (sc + 1.f) + sh;
            u32x2 p; p.x = pk2(r.x, r.y); p.y = pk2(r.z, r.w); o[j * 64 + lane] = p; }
    }
}
namespace epi {
using pg8::Unit; using pg8::f32x4;
typedef unsigned u32x4 __attribute__((ext_vector_type(4)));
__device__ __forceinline__ u32x4 pack8(const f32x4& a, const f32x4& b) { u32x4 w; w.x = pg8::cvt_pk_bf16(a[0], a[1]); w.y = pg8::cvt_pk_bf16(a[2], a[3]); w.z = pg8::cvt_pk_bf16(b[0], b[1]); w.w = pg8::cvt_pk_bf16(b[2], b[3]); return w; }

struct InProj {
    static constexpr bool PERM = true, AFTER_DRAIN = false;
    unsigned char* ws; float* out;
    __device__ __forceinline__ void operator()(const f32x4 (&acc)[2][2][4][2], const Unit& u, int wr, int wc, int fr, int fq) const {
        const int pn = u.pn;
        const int rowb = u.pm * 256 + wr * 64 + fr;
        const int cl = wc * 32 + 8 * fq;
        if (pn < T_XBC || (pn >= T_MG && pn < T_MISC)) {
            bf16* base = pn < T_XBC ? (bf16*)(ws + WS_Z) : (bf16*)(ws + WS_MG);
            const int colt = (pn < T_XBC ? pn : pn - T_MG) * 256 + cl;
#pragma unroll
            for (int ai = 0; ai < 2; ++ai)
#pragma unroll
                for (int m = 0; m < 4; ++m) { const int row = rowb + ai * 128 + m * 16;
#pragma unroll
                    for (int bj = 0; bj < 2; ++bj) *(u32x4*)(base + (size_t)row * 2048 + colt + bj * 128) = pack8(acc[ai][bj][m][0], acc[ai][bj][m][1]); }
        } else if (pn < T_Q) {
            bf16* base = (bf16*)(ws + WS_XBC); const int colt = (pn - T_XBC) * 256 + cl;
#pragma unroll
            for (int ai = 0; ai < 2; ++ai)
#pragma unroll
                for (int m = 0; m < 4; ++m) { const int row = rowb + ai * 128 + m * 16;
                    float* fo = nullptr;
                    if (row < MP) { const int t = row & 4095; if (t >= 4093) fo = out + O_CONVP + ((size_t)(row >> 12) * 3 + (t - 4093)) * CONVD; }
                    else if (row < MALL) fo = out + O_CONVS + ((size_t)(row - MP) * 3 + 2) * CONVD;
#pragma unroll
                    for (int bj = 0; bj < 2; ++bj) { const int col = colt + bj * 128;
                        *(u32x4*)(base + (size_t)row * CONVD + col) = pack8(acc[ai][bj][m][0], acc[ai][bj][m][1]);
                        if (fo) { *(f32x4*)(fo + col) = acc[ai][bj][m][0]; *(f32x4*)(fo + col + 4) = acc[ai][bj][m][1]; } } }
        } else if (pn < T_MG) {
            const bool isq = pn < T_KV; const int s = pn - T_KV;
            const bool dorope = (isq || !(s & 1)) && !(wc & 1);
            const float* rope = (const float*)(ws + WS_ROPE);
#pragma unroll
            for (int ai = 0; ai < 2; ++ai)
#pragma unroll
                for (int m = 0; m < 4; ++m) { const int row = rowb + ai * 128 + m * 16;
                    const int pos = row < MP ? (row & 4095) : PAST;
#pragma unroll
                    for (int bj = 0; bj < 2; ++bj) {
                        f32x4 v0 = acc[ai][bj][m][0], v1 = acc[ai][bj][m][1];
                        if (dorope) {
                            f32x4 o0, o1;
#pragma unroll
                            for (int i = 0; i < 4; ++i) { o0[i] = __shfl_xor(v0[i], 16); o1[i] = __shfl_xor(v1[i], 16); }
                            if (fq < 2) {
                                const f32x4 c0 = *(const f32x4*)(rope + pos * 16), c1 = *(const f32x4*)(rope + pos * 16 + 4), s0 = *(const f32x4*)(rope + pos * 16 + 8), s1 = *(const f32x4*)(rope + pos * 16 + 12);
                                if (fq == 0) { v0 = v0 * c0 - o0 * s0; v1 = v1 * c1 - o1 * s1; }
                                else         { v0 = v0 * c0 + o0 * s0; v1 = v1 * c1 + o1 * s1; }
                            }
                        }
                        const int col = cl + bj * 128;
                        const u32x4 pk = pack8(v0, v1);
                        if (isq) { *(u32x4*)((bf16*)(ws + WS_Q) + (size_t)row * 1024 + (pn - T_Q) * 256 + col) = pk; }
                        else {
                            const int h = col >> 6, d = col & 63;
                            if (row < MP) {
                                const int b = row >> 12, t = row & 4095;
                                *(u32x4*)((bf16*)(ws + WS_KVH) + ((((size_t)s * 4 + b) * 4 + h) * 4096 + t) * 64 + d) = pk;
                                if (s < 4) { float* fo = out + O_KVP + ((size_t)row * 4 + s) * 256 + col; *(f32x4*)fo = v0; *(f32x4*)(fo + 4) = v1; }
                                else if (t >= 3584) { float* fo = out + O_WINP + (((size_t)b * 512 + (t - 3584)) * 2 + (s - 4)) * 256 + col; *(f32x4*)fo = v0; *(f32x4*)(fo + 4) = v1; }
                                if (s == 3 || s == 5) {
                                    bf16* vt = (bf16*)(ws + WS_VT) + ((((size_t)(s == 5) * 4 + b) * 4 + h) * 64 + d) * 4096 + t;
                                    vt[0 * 4096] = (bf16)(pk.x & 0xffffu); vt[1 * 4096] = (bf16)(pk.x >> 16); vt[2 * 4096] = (bf16)(pk.y & 0xffffu); vt[3 * 4096] = (bf16)(pk.y >> 16);
                                    vt[4 * 4096] = (bf16)(pk.z & 0xffffu); vt[5 * 4096] = (bf16)(pk.z >> 16); vt[6 * 4096] = (bf16)(pk.w & 0xffffu); vt[7 * 4096] = (bf16)(pk.w >> 16);
                                }
                            } else if (row < MALL) {
                                const int bs = row - MP;
                                float* fo = s < 4 ? out + O_KVS + ((size_t)bs * 4 + s) * 256 + col : out + O_WINS + (((size_t)bs * 512 + 511) * 2 + (s - 4)) * 256 + col;
                                *(f32x4*)fo = v0; *(f32x4*)(fo + 4) = v1;
                            }
                        }
                    } }
        } else {
            float* base = (float*)(ws + WS_MISC);
#pragma unroll
            for (int ai = 0; ai < 2; ++ai)
#pragma unroll
                for (int m = 0; m < 4; ++m) { const int row = rowb + ai * 128 + m * 16;
                    *(f32x4*)(base + (size_t)row * 128 + cl) = acc[ai][0][m][0]; *(f32x4*)(base + (size_t)row * 128 + cl + 4) = acc[ai][0][m][1]; }
        }
    }
};

struct Merge1 {
    static constexpr bool PERM = true, AFTER_DRAIN = false;
    unsigned char* ws;
    __device__ __forceinline__ void operator()(const f32x4 (&acc)[2][2][4][2], const Unit& u, int wr, int wc, int fr, int fq) const {
        const int rowb = u.pm * 256 + wr * 64 + fr, colb = u.pn * 256 + wc * 32 + 8 * fq;
        const bf16* MG = (const bf16*)(ws + WS_MG); const float* SSQ = (const float*)(ws + WS_SSQ); float* T = (float*)(ws + WS_TMPM);
#pragma unroll
        for (int ai = 0; ai < 2; ++ai)
#pragma unroll
            for (int m = 0; m < 4; ++m) { const int row = rowb + ai * 128 + m * 16;
                const f32x4 sq = *(const f32x4*)(SSQ + (size_t)row * 4);
                const float rstd = 1.f / sqrtf(((sq.x + sq.y) + (sq.z + sq.w)) * (1.f / 2048.f) + EPS);
#pragma unroll
                for (int bj = 0; bj < 2; ++bj) { const int col = colb + bj * 128;
                    const u32x4 g = *(const u32x4*)(MG + (size_t)row * 2048 + col);
                    f32x4 o0, o1;
                    o0[0] = sigmf(bflo(g.x)) * rstd * acc[ai][bj][m][0][0]; o0[1] = sigmf(bfhi(g.x)) * rstd * acc[ai][bj][m][0][1];
                    o0[2] = sigmf(bflo(g.y)) * rstd * acc[ai][bj][m][0][2]; o0[3] = sigmf(bfhi(g.y)) * rstd * acc[ai][bj][m][0][3];
                    o1[0] = sigmf(bflo(g.z)) * rstd * acc[ai][bj][m][1][0]; o1[1] = sigmf(bfhi(g.z)) * rstd * acc[ai][bj][m][1][1];
                    o1[2] = sigmf(bflo(g.w)) * rstd * acc[ai][bj][m][1][2]; o1[3] = sigmf(bfhi(g.w)) * rstd * acc[ai][bj][m][1][3];
                    *(f32x4*)(T + (size_t)row * 1024 + col) = o0; *(f32x4*)(T + (size_t)row * 1024 + col + 4) = o1; } }
    }
};
struct Merge2 {
    static constexpr bool PERM = true, AFTER_DRAIN = false;
    unsigned char* ws;
    __device__ __forceinline__ void operator()(const f32x4 (&acc)[2][2][4][2], const Unit& u, int wr, int wc, int fr, int fq) const {
        const int rowb = u.pm * 256 + wr * 64 + fr, colb = u.pn * 256 + wc * 32 + 8 * fq;
        const bf16* MG = (const bf16*)(ws + WS_MG); const float* T = (const float*)(ws + WS_TMPM); bf16* O = (bf16*)(ws + WS_MERGED);
#pragma unroll
        for (int ai = 0; ai < 2; ++ai)
#pragma unroll
            for (int m = 0; m < 4; ++m) { const int row = rowb + ai * 128 + m * 16;
#pragma unroll
                for (int bj = 0; bj < 2; ++bj) { const int col = colb + bj * 128;
                    const u32x4 g = *(const u32x4*)(MG + (size_t)row * 2048 + 1024 + col);
                    f32x4 o0 = *(const f32x4*)(T + (size_t)row * 1024 + col), o1 = *(const f32x4*)(T + (size_t)row * 1024 + col + 4);
                    o0[0] += sigmf(bflo(g.x)) * acc[ai][bj][m][0][0]; o0[1] += sigmf(bfhi(g.x)) * acc[ai][bj][m][0][1];
                    o0[2] += sigmf(bflo(g.y)) * acc[ai][bj][m][0][2]; o0[3] += sigmf(bfhi(g.y)) * acc[ai][bj][m][0][3];
                    o1[0] += sigmf(bflo(g.z)) * acc[ai][bj][m][1][0]; o1[1] += sigmf(bfhi(g.z)) * acc[ai][bj][m][1][1];
                    o1[2] += sigmf(bflo(g.w)) * acc[ai][bj][m][1][2]; o1[3] += sigmf(bfhi(g.w)) * acc[ai][bj][m][1][3];
                    *(u32x4*)(O + (size_t)row * 1024 + col) = pack8(o0, o1); } }
    }
};
struct Resid {
    static constexpr bool PERM = false, AFTER_DRAIN = false;
    const float* xp; const float* xs; const float* x1in; float* x1out; const float* MOD; int goff;
    __device__ __forceinline__ void operator()(const f32x4 (&acc)[2][2][4][2], const Unit& u, int wr, int wc, int fr, int fq) const {
        const int rowb = u.pm * 256 + wr * 64 + fr, colb = u.pn * 256 + wc * 32 + 4 * fq;
#pragma unroll
        for (int ai = 0; ai < 2; ++ai)
#pragma unroll
            for (int m = 0; m < 4; ++m) { const int row = rowb + ai * 128 + m * 16;
                if (row >= MALL) continue;
                const float* base = x1in ? x1in + (size_t)row * 1024 : (row < MP ? xp + (size_t)row * 1024 : xs + (size_t)(row - MP) * 1024);
                const float* gr = MOD + (size_t)(row < MP ? (row >> 12) : 4 + (row - MP)) * 6144 + goff;
#pragma unroll
                for (int bj = 0; bj < 2; ++bj)
#pragma unroll
                    for (int n = 0; n < 2; ++n) { const int col = colb + bj * 128 + n * 16;
                        *(f32x4*)(x1out + (size_t)row * 1024 + col) = *(const f32x4*)(base + col) + *(const f32x4*)(gr + col) * acc[ai][bj][m][n]; } }
    }
};
struct Up {
    static constexpr bool PERM = true, AFTER_DRAIN = false;
    unsigned char* ws; float* out;
    __device__ __forceinline__ void operator()(const f32x4 (&acc)[2][2][4][2], const Unit& u, int wr, int wc, int fr, int fq) const {
        const int rowb = u.pm * 256 + wr * 64 + fr, colb = u.pn * 256 + wc * 32 + 8 * fq;
        bf16* U = (bf16*)(ws + WS_U);
#pragma unroll
        for (int ai = 0; ai < 2; ++ai)
#pragma unroll
            for (int m = 0; m < 4; ++m) { const int row = rowb + ai * 128 + m * 16;
                float* fo = nullptr;
                if (row < MP) { const int t = row & 4095; if (t >= 4094) fo = out + O_FFNP + ((size_t)(row >> 12) * 2 + (t - 4094)) * DFF2; }
                else if (row < MALL) fo = out + O_FFNS + ((size_t)(row - MP) * 2 + 1) * DFF2;
#pragma unroll
                for (int bj = 0; bj < 2; ++bj) { const int col = colb + bj * 128;
                    *(u32x4*)(U + (size_t)row * DFF2 + col) = pack8(acc[ai][bj][m][0], acc[ai][bj][m][1]);
                    if (fo) { *(f32x4*)(fo + col) = acc[ai][bj][m][0]; *(f32x4*)(fo + col + 4) = acc[ai][bj][m][1]; } } }
    }
};
}
__device__ __forceinline__ void conv_prompt_item(const Args& args, int item, int lane) {
    unsigned char* ws = args.ws;
    const int tg = item / 48, cgp = item % 48, cg = lane & 7, rg = lane >> 3;
    const int m0 = tg * 64 + 8 * rg, b = m0 >> 12, t0 = m0 & 4095, ch0 = cgp * 64 + 8 * cg;
    const bf16* X = (const bf16*)(ws + WS_XBC);
    float x[11][8];
#pragma unroll
    for (int i = 0; i < 11; ++i) {
        const int t = t0 - 3 + i;
        u32x4 v = (u32x4){0u, 0u, 0u, 0u};
        if (t >= 0) v = *(const u32x4*)(X + (size_t)(m0 - 3 + i) * CONVD + ch0);
        x[i][0] = bflo(v.x); x[i][1] = bfhi(v.x); x[i][2] = bflo(v.y); x[i][3] = bfhi(v.y); x[i][4] = bflo(v.z); x[i][5] = bfhi(v.z); x[i][6] = bflo(v.w); x[i][7] = bfhi(v.w);
    }
    const float* cw = INF(16); const float* cb = INF(17);
    float w[4][8], bias[8];
#pragma unroll
    for (int k = 0; k < 4; ++k) { const f32x4 a = *(const f32x4*)(cw + k * CONVD + ch0), c = *(const f32x4*)(cw + k * CONVD + ch0 + 4);
        w[k][0] = a.x; w[k][1] = a.y; w[k][2] = a.z; w[k][3] = a.w; w[k][4] = c.x; w[k][5] = c.y; w[k][6] = c.z; w[k][7] = c.w; }
    { const f32x4 a = *(const f32x4*)(cb + ch0), c = *(const f32x4*)(cb + ch0 + 4); bias[0] = a.x; bias[1] = a.y; bias[2] = a.z; bias[3] = a.w; bias[4] = c.x; bias[5] = c.y; bias[6] = c.z; bias[7] = c.w; }
    float y[8][8];
#pragma unroll
    for (int i = 0; i < 8; ++i)
#pragma unroll
        for (int c = 0; c < 8; ++c) { const float a = bias[c] + w[0][c] * x[i][c] + w[1][c] * x[i + 1][c] + w[2][c] * x[i + 2][c] + w[3][c] * x[i + 3][c]; y[i][c] = siluf(a); }
    if (cgp < 32) {
        bf16* XT = (bf16*)(ws + WS_XT) + ((size_t)(b * 32 + cgp) * 64 + 8 * cg) * 4096 + t0;
#pragma unroll
        for (int c = 0; c < 8; ++c) { u32x4 o; o.x = pk2(y[0][c], y[1][c]); o.y = pk2(y[2][c], y[3][c]); o.z = pk2(y[4][c], y[5][c]); o.w = pk2(y[6][c], y[7][c]); *(u32x4*)(XT + (size_t)c * 4096) = o; }
    } else {
        const int isC = cgp >= 40, gg = ((cgp - 32) & 7) >> 1, n0 = ((cgp - 32) & 1) * 64 + 8 * cg;
        bf16* N = (bf16*)(ws + (isC ? WS_CN : WS_BN)) + ((size_t)(b * 4 + gg) * 4096 + t0) * 128 + n0;
#pragma unroll
        for (int i = 0; i < 8; ++i) { u32x4 o; o.x = pk2(y[i][0], y[i][1]); o.y = pk2(y[i][2], y[i][3]); o.z = pk2(y[i][4], y[i][5]); o.w = pk2(y[i][6], y[i][7]); *(u32x4*)(N + (size_t)i * 128) = o; }
        if (!isC) {
            bf16* BT = (bf16*)(ws + WS_BT) + ((size_t)(b * 4 + gg) * 128 + n0) * 4096 + t0;
#pragma unroll
            for (int c = 0; c < 8; ++c) { u32x4 o; o.x = pk2(y[0][c], y[1][c]); o.y = pk2(y[2][c], y[3][c]); o.z = pk2(y[4][c], y[5][c]); o.w = pk2(y[6][c], y[7][c]); *(u32x4*)(BT + (size_t)c * 4096) = o; }
        }
    }
}
__device__ __forceinline__ void dtcs_item(const Args& args, int item, int lane) {
    unsigned char* ws = args.ws;
    const int c = item & 31, h = (item >> 5) & 31, b = item >> 10;
    const float* MISC = (const float*)(ws + WS_MISC);
    const float bias = INF(18)[h], a = -__expf(INF(19)[h]);
    const int t = c * 128 + 2 * lane; const size_t m = (size_t)b * 4096 + t;
    const float d0 = softplusf(MISC[m * 128 + h] + bias), d1 = softplusf(MISC[(m + 1) * 128 + h] + bias);
    const float a0 = d0 * a, a1 = d1 * a;
    float s = a0 + a1;
#pragma unroll
    for (int o = 1; o < 64; o <<= 1) { const float v = __shfl_up(s, o); if (lane >= o) s += v; }
    const float c1 = s, c0 = s - a1;
    float* DT = (float*)(ws + WS_DT) + (size_t)(b * 32 + h) * 4096 + t; float* CS = (float*)(ws + WS_CS) + (size_t)(b * 32 + h) * 4096 + t;
    *(f32x2*)DT = (f32x2){d0, d1}; *(f32x2*)CS = (f32x2){c0, c1};
}
__device__ __forceinline__ void sample_conv(const Args& args, int gt, int NGT) {
    unsigned char* ws = args.ws; float* out = args.out;
    const float* st = INF(8); const float* cw = INF(16); const float* cb = INF(17);
    for (int i = gt; i < MS * CONVD; i += NGT) {
        const int bs = i / CONVD, ch = i % CONVD;
        const float s0 = st[((size_t)bs * 3 + 0) * CONVD + ch], s1 = st[((size_t)bs * 3 + 1) * CONVD + ch], s2 = st[((size_t)bs * 3 + 2) * CONVD + ch];
        const float xn = out[O_CONVS + ((size_t)bs * 3 + 2) * CONVD + ch];
        out[O_CONVS + ((size_t)bs * 3 + 0) * CONVD + ch] = s1; out[O_CONVS + ((size_t)bs * 3 + 1) * CONVD + ch] = s2;
        const float a = cb[ch] + cw[ch] * s0 + cw[CONVD + ch] * s1 + cw[2 * CONVD + ch] * s2 + cw[3 * CONVD + ch] * xn;
        ((float*)(ws + WS_XCS))[i] = siluf(a);
    }
    for (int i = gt; i < MS * NH; i += NGT) { const int bs = i >> 5, h = i & 31;
        ((float*)(ws + WS_DTS))[i] = softplusf(((const float*)(ws + WS_MISC))[(size_t)(MP + bs) * 128 + h] + INF(18)[h]); }
}

__device__ __forceinline__ void ssd_states_unit(const Args& args, LAS unsigned char* lds, int unit, int wave, int lane) {
    unsigned char* ws = args.ws;
    const int g = unit & 3, c = (unit >> 2) & 31, b = unit >> 7, h = g * 8 + wave, q = lane >> 4, r16 = lane & 15;
    LAS float* wl = (LAS float*)(lds + wave * 512);
    const float* DT = (const float*)(ws + WS_DT) + (size_t)(b * 32 + h) * 4096 + c * 128; const float* CS = (const float*)(ws + WS_CS) + (size_t)(b * 32 + h) * 4096 + c * 128;
    const float cl = CS[127];
    wl[lane] = DT[lane] * __expf(cl - CS[lane]); wl[lane + 64] = DT[lane + 64] * __expf(cl - CS[lane + 64]);
    LDS_WAIT(); asm volatile("" ::: "memory");
    const bf16* XT = (const bf16*)(ws + WS_XT) + (size_t)(b * 32 + h) * 64 * 4096 + c * 128;
    const bf16* BT = (const bf16*)(ws + WS_BT) + (size_t)(b * 4 + g) * 128 * 4096 + c * 128;
    float* ST = (float*)(ws + WS_STATES) + (((size_t)(b * 32 + c) * 32 + h) * 64) * 128;
#pragma unroll 1
    for (int nh = 0; nh < 2; ++nh) {
        f32x4 acc[4][4];
#pragma unroll
        for (int i = 0; i < 4; ++i)
#pragma unroll
            for (int j = 0; j < 4; ++j) acc[i][j] = (f32x4){0.f, 0.f, 0.f, 0.f};
#pragma unroll 1
        for (int ks = 0; ks < 4; ++ks) {
            const int s0 = 32 * ks + 8 * q;
            const f32x4 w0 = *(const LAS f32x4*)(wl + s0), w1 = *(const LAS f32x4*)(wl + s0 + 4);
            bf16x8 af[4];
#pragma unroll
            for (int pt = 0; pt < 4; ++pt) { const u32x4 v = *(const u32x4*)(XT + (size_t)(16 * pt + r16) * 4096 + s0);
                u32x4 o; o.x = pk2(bflo(v.x) * w0.x, bfhi(v.x) * w0.y); o.y = pk2(bflo(v.y) * w0.z, bfhi(v.y) * w0.w); o.z = pk2(bflo(v.z) * w1.x, bfhi(v.z) * w1.y); o.w = pk2(bflo(v.w) * w1.z, bfhi(v.w) * w1.w);
                af[pt] = __builtin_bit_cast(bf16x8, o); }
#pragma unroll
            for (int nt = 0; nt < 4; ++nt) { const bf16x8 bf = *(const bf16x8*)(BT + (size_t)(64 * nh + 16 * nt + r16) * 4096 + s0);
#pragma unroll
                for (int pt = 0; pt < 4; ++pt) acc[pt][nt] = MFMA16(af[pt], bf, acc[pt][nt]); }
        }
#pragma unroll
        for (int pt = 0; pt < 4; ++pt)
#pragma unroll
            for (int nt = 0; nt < 4; ++nt)
#pragma unroll
                for (int r = 0; r < 4; ++r) ST[(size_t)(16 * pt + 4 * q + r) * 128 + 64 * nh + 16 * nt + r16] = acc[pt][nt][r];
    }
}

__device__ __forceinline__ void compress2_prompt_item(const Args& args, int item, int lane) {
    unsigned char* ws = args.ws;
    const int n = item & 255, bh = (item >> 8) & 15, st = item >> 12;
    const float* w2 = INF(st ? 27 : 24);
    float o = 0.f;
    if (n < 255) {
        const float* P = (const float*)(ws + (st ? WS_PARTV : WS_PARTK)) + (size_t)(bh * 256 + n) * 256; const float* pet = (const float*)(ws + WS_PET) + st * 128;
        const float a0 = siluf(pet[lane] + P[lane] + P[256 + 128 + lane]), a1 = siluf(pet[64 + lane] + P[64 + lane] + P[256 + 128 + 64 + lane]);
#pragma unroll 8
        for (int e = 0; e < 64; ++e) o += __shfl(a0, e) * w2[e * 64 + lane];
#pragma unroll 8
        for (int e = 0; e < 64; ++e) o += __shfl(a1, e) * w2[(64 + e) * 64 + lane];
    }
    if (st == 0) ((bf16*)(ws + WS_KC))[(size_t)(bh * 256 + n) * 64 + lane] = (bf16)f2bf(o);
    else ((bf16*)(ws + WS_VCT))[(size_t)(bh * 64 + lane) * 256 + n] = (bf16)f2bf(o);
}
__device__ __forceinline__ void compress2_sample_item(const Args& args, int item, int lane) {
    unsigned char* ws = args.ws;
    const int n = item & 127, bh = (item >> 7) & 511, st = item >> 16;
    const float* w2 = INF(st ? 27 : 24);
    float o = 0.f;
    if (n < 127) {
        const float* P = (const float*)(ws + (st ? WS_PARTSV : WS_PARTSK)) + (size_t)(bh * 128 + n) * 256; const float* pet = (const float*)(ws + WS_PET) + st * 128;
        const float a0 = siluf(pet[lane] + P[lane] + P[256 + 128 + lane]), a1 = siluf(pet[64 + lane] + P[64 + lane] + P[256 + 128 + 64 + lane]);
#pragma unroll 8
        for (int e = 0; e < 64; ++e) o += __shfl(a0, e) * w2[e * 64 + lane];
#pragma unroll 8
        for (int e = 0; e < 64; ++e) o += __shfl(a1, e) * w2[(64 + e) * 64 + lane];
    }
    ((float*)(ws + (st ? WS_VCS : WS_KCS)))[(size_t)(bh * 128 + n) * 64 + lane] = o;
}

__device__ __forceinline__ void sample_ssm_item(const Args& args, LAS unsigned char* lds, int item, int wave, int lane) {
    unsigned char* ws = args.ws; float* out = args.out;
    const int h = item & 31, bs = item >> 5, g = h >> 3;
    const float* XC = (const float*)(ws + WS_XCS) + (size_t)bs * CONVD;
    const float dt = ((const float*)(ws + WS_DTS))[bs * 32 + h], a = -__expf(INF(19)[h]), dec = __expf(dt * a), Dh = INF(20)[h];
    const f32x2 Bv = *(const f32x2*)(XC + 2048 + g * 128 + 2 * lane), Cv = *(const f32x2*)(XC + 2560 + g * 128 + 2 * lane);
    const float xl = XC[h * 64 + lane];
    const float* H0 = INF(7) + ((size_t)(bs * 32 + h) * 64) * 128; float* HN = out + O_SSMS + ((size_t)(bs * 32 + h) * 64) * 128;
    float ymine = 0.f;
#pragma unroll 8
    for (int p = 0; p < 64; ++p) {
        const float xp = __shfl(xl, p);
        const f32x2 h0 = *(const f32x2*)(H0 + p * 128 + 2 * lane);
        f32x2 hn; hn.x = h0.x * dec + dt * xp * Bv.x; hn.y = h0.y * dec + dt * xp * Bv.y;
        *(f32x2*)(HN + p * 128 + 2 * lane) = hn;
        const float yp = wave_sum(hn.x * Cv.x + hn.y * Cv.y);
        ymine = (lane == p) ? yp : ymine;
    }
    const float y = ymine + Dh * xl;
    const size_t m = MP + bs;
    const float z = bf2f(((const bf16*)(ws + WS_Z))[m * 2048 + h * 64 + lane]);
    const float v = y * siluf(z);
    ((bf16*)(ws + WS_YSSM))[m * 2048 + h * 64 + lane] = (bf16)f2bf(v * INF(21)[h * 64 + lane]);
    const float ss = wave_sum(v * v);
    if (lane == 0) ((float*)(ws + WS_MISC))[m * 128 + 80 + h] = ss;
}
__device__ __forceinline__ void scan_phase(const Args& args, int gt, int NGT) {
    unsigned char* ws = args.ws; float* out = args.out;
    for (int i = gt; i < 4 * 32 * 64 * 32; i += NGT) {
        const int n4 = i & 31, p = (i >> 5) & 63, h = (i >> 11) & 31, b = i >> 16;
        const float* CS = (const float*)(ws + WS_CS) + (size_t)(b * 32 + h) * 4096;
        f32x4 run = (f32x4){0.f, 0.f, 0.f, 0.f};
#pragma unroll 4
        for (int c = 0; c < 32; ++c) {
            const size_t off = ((((size_t)(b * 32 + c) * 32 + h) * 64 + p) * 128) + 4 * n4;
            const f32x4 st = *(const f32x4*)((const float*)(ws + WS_STATES) + off);
            u32x2 o; o.x = pk2(run.x, run.y); o.y = pk2(run.z, run.w);
            *(u32x2*)((bf16*)(ws + WS_HPREV) + off) = o;
            const float dec = __expf(CS[c * 128 + 127]);
            run = run * dec + st;
        }
        *(f32x4*)(out + O_SSMP + (((size_t)(b * 32 + h) * 64 + p) * 128) + 4 * n4) = run;
    }
    for (int i = gt; i < MS * 4; i += NGT) { const int bs = i >> 2, g = i & 3; const float* p = (const float*)(ws + WS_MISC) + (size_t)(MP + bs) * 128 + 80 + g * 8;
        ((float*)(ws + WS_SSQ))[(size_t)(MP + bs) * 4 + g] = ((p[0] + p[1]) + (p[2] + p[3])) + ((p[4] + p[5]) + (p[6] + p[7])); }
}

__device__ __forceinline__ void ssd_out_unit(const Args& args, LAS unsigned char* lds, int unit, int wave, int lane, int tid) {
    unsigned char* ws = args.ws;
    const int g = unit & 3, c = (unit >> 2) & 31, b = unit >> 7, h = g * 8 + wave, q = lane >> 4, r16 = lane & 15;
    LAS float* CBT = (LAS float*)lds; LAS float* SQ = (LAS float*)(lds + 65536);
    const bf16* Bn = (const bf16*)(ws + WS_BN) + ((size_t)(b * 4 + g) * 4096 + c * 128) * 128;
    const bf16* Cn = (const bf16*)(ws + WS_CN) + ((size_t)(b * 4 + g) * 4096 + c * 128) * 128;
    {
        bf16x8 af[4];
#pragma unroll
        for (int ks = 0; ks < 4; ++ks) af[ks] = *(const bf16x8*)(Bn + (size_t)(16 * wave + r16) * 128 + 32 * ks + 8 * q);
        for (int lt = wave; lt < 8; ++lt) {
            f32x4 d = (f32x4){0.f, 0.f, 0.f, 0.f};
#pragma unroll
            for (int ks = 0; ks < 4; ++ks) { const bf16x8 bf = *(const bf16x8*)(Cn + (size_t)(16 * lt + r16) * 128 + 32 * ks + 8 * q); d = MFMA16(af[ks], bf, d); }
#pragma unroll
            for (int r = 0; r < 4; ++r) CBT[((wave * 8 + lt) * 4 + r) * 64 + lane] = d[r];
        }
    }
    __syncthreads();
    const float* DT = (const float*)(ws + WS_DT) + (size_t)(b * 32 + h) * 4096 + c * 128; const float* CS = (const float*)(ws + WS_CS) + (size_t)(b * 32 + h) * 4096 + c * 128;
    const float Dh = INF(20)[h];
    const bf16* HP = (const bf16*)(ws + WS_HPREV) + (((size_t)(b * 32 + c) * 32 + h) * 64) * 128;
    const bf16* XT = (const bf16*)(ws + WS_XT) + (size_t)(b * 32 + h) * 64 * 4096 + c * 128;
    const bf16* Z = (const bf16*)(ws + WS_Z); bf16* Y = (bf16*)(ws + WS_YSSM); const float* nw = INF(21) + h * 64;
#pragma unroll
    for (int hl = 0; hl < 2; ++hl) {
        float csl[4];
#pragma unroll
        for (int lt = 0; lt < 4; ++lt) csl[lt] = CS[64 * hl + 16 * lt + r16];
        f32x4 acc[4][4];
#pragma unroll
        for (int i = 0; i < 4; ++i)
#pragma unroll
            for (int j = 0; j < 4; ++j) acc[i][j] = (f32x4){0.f, 0.f, 0.f, 0.f};
#pragma unroll 1
        for (int ks = 0; ks < 4; ++ks) {
            bf16x8 af[4];
#pragma unroll
            for (int pt = 0; pt < 4; ++pt) af[pt] = *(const bf16x8*)(HP + (size_t)(16 * pt + r16) * 128 + 32 * ks + 8 * q);
#pragma unroll
            for (int lt = 0; lt < 4; ++lt) { const bf16x8 bf = *(const bf16x8*)(Cn + (size_t)(64 * hl + 16 * lt + r16) * 128 + 32 * ks + 8 * q);
#pragma unroll
                for (int pt = 0; pt < 4; ++pt) acc[pt][lt] = MFMA16(af[pt], bf, acc[pt][lt]); }
        }
#pragma unroll
        for (int lt = 0; lt < 4; ++lt) { const float e = __expf(csl[lt]);
#pragma unroll
            for (int pt = 0; pt < 4; ++pt) acc[pt][lt] = acc[pt][lt] * e; }
#pragma unroll
        for (int i = 0; i < 2 * hl + 2; ++i) {
            const int sa = 32 * i + 4 * q, sb = sa + 16;
            const f32x4 csa = *(const f32x4*)(CS + sa), csb = *(const f32x4*)(CS + sb), dta = *(const f32x4*)(DT + sa), dtb = *(const f32x4*)(DT + sb);
            bf16x8 af[4];
#pragma unroll
            for (int pt = 0; pt < 4; ++pt) { const u32x2 lo = *(const u32x2*)(XT + (size_t)(16 * pt + r16) * 4096 + sa), hi = *(const u32x2*)(XT + (size_t)(16 * pt + r16) * 4096 + sb);
                af[pt] = __builtin_bit_cast(bf16x8, (u32x4){lo.x, lo.y, hi.x, hi.y}); }
#pragma unroll
            for (int lt = 0; lt < 4; ++lt) {
                const int LT = 4 * hl + lt;
                if (LT < 2 * i) continue;
                const int l = 16 * LT + r16;
                float ga[4], gb[4];
#pragma unroll
                for (int r = 0; r < 4; ++r) {
                    const float va = CBT[(((2 * i) * 8 + LT) * 4 + r) * 64 + lane];
                    const float vb = (LT >= 2 * i + 1) ? CBT[(((2 * i + 1) * 8 + LT) * 4 + r) * 64 + lane] : 0.f;
                    const int s1 = sa + r, s2 = sb + r;
                    float x1 = (l >= s1) ? va * __expf(csl[lt] - csa[r]) * dta[r] : 0.f;
                    float x2 = (l >= s2) ? vb * __expf(csl[lt] - csb[r]) * dtb[r] : 0.f;
                    if (l == s1) x1 += Dh;
                    if (l == s2) x2 += Dh;
                    ga[r] = x1; gb[r] = x2;
                }
                u32x4 o; o.x = pk2(ga[0], ga[1]); o.y = pk2(ga[2], ga[3]); o.z = pk2(gb[0], gb[1]); o.w = pk2(gb[2], gb[3]);
                const bf16x8 bf = __builtin_bit_cast(bf16x8, o);
#pragma unroll
                for (int pt = 0; pt < 4; ++pt) acc[pt][lt] = MFMA16(af[pt], bf, acc[pt][lt]);
            }
        }
#pragma unroll
        for (int lt = 0; lt < 4; ++lt) {
            const size_t m = (size_t)b * 4096 + c * 128 + 64 * hl + 16 * lt + r16;
            float ss = 0.f;
#pragma unroll
            for (int pt = 0; pt < 4; ++pt) {
                const int ch = 16 * pt + 4 * q;
                const u32x2 zz = *(const u32x2*)(Z + m * 2048 + h * 64 + ch); const f32x4 w = *(const f32x4*)(nw + ch);
                const float v0 = acc[pt][lt][0] * siluf(bflo(zz.x)), v1 = acc[pt][lt][1] * siluf(bfhi(zz.x)), v2 = acc[pt][lt][2] * siluf(bflo(zz.y)), v3 = acc[pt][lt][3] * siluf(bfhi(zz.y));
                ss += (v0 * v0 + v1 * v1) + (v2 * v2 + v3 * v3);
                u32x2 o; o.x = pk2(v0 * w.x, v1 * w.y); o.y = pk2(v2 * w.z, v3 * w.w);
                *(u32x2*)(Y + m * 2048 + h * 64 + ch) = o;
            }
            ss += __shfl_xor(ss, 16); ss += __shfl_xor(ss, 32);
            if (q == 0) SQ[wave * 128 + 64 * hl + 16 * lt + r16] = ss;
        }
    }
    __syncthreads();
    if (tid < 128) { float s = 0.f;
#pragma unroll
        for (int w = 0; w < 8; ++w) s += SQ[w * 128 + tid];
        ((float*)(ws + WS_SSQ))[((size_t)b * 4096 + c * 128 + tid) * 4 + g] = s; }
    __syncthreads();
}
template <int MODE>
__device__ __forceinline__ void flash_block(const bf16* Kp, const bf16* VTp, int jb, int t, bool selbit, const LAS bf16x8* Qs,
                                            f32x4 (&O)[4][4], float (&mx)[4], float (&ls)[4], int q, int r16) {
#pragma unroll
    for (int pr = 0; pr < 2; ++pr) {
        const int kb = 64 * jb + 32 * pr;
        asm volatile("" ::: "memory");
        f32x4 S[2][4];
#pragma unroll
        for (int kt = 0; kt < 2; ++kt) {
            const bf16* kr = Kp + (size_t)(kb + 16 * kt + r16) * 64 + 8 * q;
            const bf16x8 k0 = *(const bf16x8*)kr, k1 = *(const bf16x8*)(kr + 32);
#pragma unroll
            for (int g = 0; g < 4; ++g) { f32x4 s = MFMA16(k0, Qs[(g * 2 + 0) * 64], ((f32x4){0.f, 0.f, 0.f, 0.f})); S[kt][g] = MFMA16(k1, Qs[(g * 2 + 1) * 64], s); }
        }
        bf16x8 vf[4];
#pragma unroll
        for (int dt = 0; dt < 4; ++dt) { const bf16* vr = VTp + (size_t)(16 * dt + r16) * 4096 + kb + 4 * q;
            const u32x2 lo = *(const u32x2*)vr, hi = *(const u32x2*)(vr + 16); vf[dt] = __builtin_bit_cast(bf16x8, (u32x4){lo.x, lo.y, hi.x, hi.y}); }
#pragma unroll
        for (int g = 0; g < 4; ++g) {
            float tmax = NEGF;
#pragma unroll
            for (int kt = 0; kt < 2; ++kt)
#pragma unroll
                for (int r = 0; r < 4; ++r) { const int key = kb + 16 * kt + 4 * q + r;
                    const bool ok = (MODE == 0) ? (selbit && key <= t) : (key <= t && key + 512 > t);
                    const float s = ok ? S[kt][g][r] * 0.125f : NEGF; S[kt][g][r] = s; tmax = fmaxf(tmax, s); }
            tmax = fmaxf(tmax, __shfl_xor(tmax, 16)); tmax = fmaxf(tmax, __shfl_xor(tmax, 32));
            const float mnew = fmaxf(mx[g], tmax), alpha = __expf(mx[g] - mnew); mx[g] = mnew;
            float psum = 0.f;
#pragma unroll
            for (int kt = 0; kt < 2; ++kt)
#pragma unroll
                for (int r = 0; r < 4; ++r) { const float s = S[kt][g][r]; const float p = (s > 0.5f * NEGF) ? __expf(s - mnew) : 0.f; S[kt][g][r] = p; psum += p; }
            ls[g] = ls[g] * alpha + psum;
            u32x4 pw; pw.x = pk2(S[0][g][0], S[0][g][1]); pw.y = pk2(S[0][g][2], S[0][g][3]); pw.z = pk2(S[1][g][0], S[1][g][1]); pw.w = pk2(S[1][g][2], S[1][g][3]);
            const bf16x8 pf = __builtin_bit_cast(bf16x8, pw);
#pragma unroll
            for (int dt = 0; dt < 4; ++dt) O[dt][g] = MFMA16(vf[dt], pf, O[dt][g] * alpha);
        }
    }
}

template <int BR>
__device__ __forceinline__ void attn_finish(const Args& args, f32x4 (&O)[4][4], const float (&ls)[4], bool normalise, size_t m, int hkv, int q) {
    unsigned char* ws = args.ws;
    const float* gates = (const float*)(ws + WS_MISC) + m * 128 + 32;
#pragma unroll
    for (int g = 0; g < 4; ++g) {
        float sc = sigmf(gates[(hkv * 4 + g) * 3 + BR]);
        if (normalise) { float L = ls[g]; L += __shfl_xor(L, 16); L += __shfl_xor(L, 32); sc *= 1.f / fmaxf(L, TINYF); }
#pragma unroll
        for (int dt = 0; dt < 4; ++dt) {
            float* yf = (float*)(ws + WS_YATTF) + m * 1024 + (hkv * 4 + g) * 64 + 16 * dt + 4 * q;
            f32x4 v = O[dt][g] * sc;
            if (BR > 0) v = v + *(const f32x4*)yf;
            if (BR < 2) *(f32x4*)yf = v;
            else { u32x2 o; o.x = pk2(v.x, v.y); o.y = pk2(v.z, v.w); *(u32x2*)((bf16*)(ws + WS_YATT) + m * 1024 + (hkv * 4 + g) * 64 + 16 * dt + 4 * q) = o; }
        }
    }
}

__device__ __forceinline__ void attn_prompt_unit(const Args& args, LAS float* impL, int unit, int lane) {
    unsigned char* ws = args.ws;
    const int q = lane >> 4, r16 = lane & 15;
    const int bh = unit & 15, b = bh >> 2, hkv = bh & 3;
    const int tile = unit < 2048 ? 255 - (unit >> 4) : (unit - 2048) >> 4;
    const int t0 = tile * 16, t = t0 + r16; const size_t m = (size_t)b * 4096 + t;
    LAS bf16x8* Qs = (LAS bf16x8*)(impL + 1024) + lane;
#pragma unroll
    for (int g = 0; g < 4; ++g)
#pragma unroll
        for (int ks = 0; ks < 2; ++ks) Qs[(g * 2 + ks) * 64] = *(const bf16x8*)((const bf16*)(ws + WS_Q) + m * 1024 + (hkv * 4 + g) * 64 + 32 * ks + 8 * q);
    LDS_WAIT(); asm volatile("" ::: "memory");
    f32x4 O[4][4]; float mx[4], ls[4];
    const bf16* KCp = (const bf16*)(ws + WS_KC) + (size_t)bh * 256 * 64; const bf16* VCTp = (const bf16*)(ws + WS_VCT) + (size_t)bh * 64 * 256;
    const int nmax = (t0 + 15 >= 31) ? ((t0 + 15 - 31) >> 4) : -1;
    const int NP = nmax < 0 ? 0 : (nmax / 32 + 2 < 8 ? nmax / 32 + 2 : 8);
#pragma unroll
    for (int g = 0; g < 4; ++g) { mx[g] = NEGF; ls[g] = 0.f; }
    for (int kt = 0; kt < 2 * NP; ++kt) {
        const bf16* kr = KCp + (size_t)(16 * kt + r16) * 64 + 8 * q;
        const bf16x8 k0 = *(const bf16x8*)kr, k1 = *(const bf16x8*)(kr + 32);
#pragma unroll
        for (int g = 0; g < 4; ++g) {
            f32x4 s = MFMA16(k0, Qs[(g * 2 + 0) * 64], ((f32x4){0.f, 0.f, 0.f, 0.f})); s = MFMA16(k1, Qs[(g * 2 + 1) * 64], s);
            float tmax = NEGF;
#pragma unroll
            for (int r = 0; r < 4; ++r) { const int n = 16 * kt + 4 * q + r; const bool ok = (16 * n + 31 <= t); s[r] = ok ? s[r] * 0.125f : NEGF; tmax = fmaxf(tmax, s[r]); }
            const float mnew = fmaxf(mx[g], tmax); float ps = 0.f;
#pragma unroll
            for (int r = 0; r < 4; ++r) ps += (s[r] > 0.5f * NEGF) ? __expf(s[r] - mnew) : 0.f;
            ls[g] = ls[g] * __expf(mx[g] - mnew) + ps; mx[g] = mnew;
        }
    }
    float invL[4];
#pragma unroll
    for (int g = 0; g < 4; ++g) {
        float M = fmaxf(mx[g], __shfl_xor(mx[g], 16)); M = fmaxf(M, __shfl_xor(M, 32));
        float l = ls[g] * __expf(mx[g] - M); l += __shfl_xor(l, 16); l += __shfl_xor(l, 32);
        mx[g] = M; invL[g] = 1.f / fmaxf(l, TINYF);
    }
#pragma unroll
    for (int dt = 0; dt < 4; ++dt)
#pragma unroll
        for (int g = 0; g < 4; ++g) O[dt][g] = (f32x4){0.f, 0.f, 0.f, 0.f};
    float prev3 = 0.f;
#pragma unroll
    for (int kt = 0; kt < 16; ++kt) impL[kt * 64 + lane] = 0.f;
#pragma unroll 1
    for (int i = 0; i < NP; ++i) {
        f32x4 P[2][4];
#pragma unroll
        for (int kk = 0; kk < 2; ++kk) {
            const int kt = 2 * i + kk;
            const bf16* kr = KCp + (size_t)(16 * kt + r16) * 64 + 8 * q;
            const bf16x8 k0 = *(const bf16x8*)kr, k1 = *(const bf16x8*)(kr + 32);
            f32x4 psum = (f32x4){0.f, 0.f, 0.f, 0.f};
#pragma unroll
            for (int g = 0; g < 4; ++g) {
                f32x4 s = MFMA16(k0, Qs[(g * 2 + 0) * 64], ((f32x4){0.f, 0.f, 0.f, 0.f})); s = MFMA16(k1, Qs[(g * 2 + 1) * 64], s);
#pragma unroll
                for (int r = 0; r < 4; ++r) { const int n = 16 * kt + 4 * q + r; const bool ok = (16 * n + 31 <= t); s[r] = ok ? __expf(s[r] * 0.125f - mx[g]) * invL[g] : 0.f; }
                P[kk][g] = s; psum = psum + s;
            }
            const float a = __shfl(psum[3], (lane + 48) & 63), bb = __shfl(prev3, (lane + 48) & 63);
            impL[kt * 64 + lane] = 2.f * (psum[0] + psum[1] + psum[2]) + psum[3] + (q > 0 ? a : bb);
            prev3 = psum[3];
        }
        bf16x8 vf[4];
#pragma unroll
        for (int dt = 0; dt < 4; ++dt) { const bf16* vr = VCTp + (size_t)(16 * dt + r16) * 256 + 32 * i + 4 * q;
            const u32x2 lo = *(const u32x2*)vr, hi = *(const u32x2*)(vr + 16); vf[dt] = __builtin_bit_cast(bf16x8, (u32x4){lo.x, lo.y, hi.x, hi.y}); }
#pragma unroll
        for (int g = 0; g < 4; ++g) {
            u32x4 pw; pw.x = pk2(P[0][g][0], P[0][g][1]); pw.y = pk2(P[0][g][2], P[0][g][3]); pw.z = pk2(P[1][g][0], P[1][g][1]); pw.w = pk2(P[1][g][2], P[1][g][3]);
            const bf16x8 pf = __builtin_bit_cast(bf16x8, pw);
#pragma unroll
            for (int dt = 0; dt < 4; ++dt) O[dt][g] = MFMA16(vf[dt], pf, O[dt][g]);
        }
    }
    attn_finish<0>(args, O, ls, false, m, hkv, q);
    unsigned mlo = 0u, mhi = 0u;
    {
        const int cur = t >> 6;
        LDS_WAIT(); asm volatile("" ::: "memory");
        float v[16];
#pragma unroll
        for (int kt = 0; kt < 16; ++kt) { const int j = 4 * kt + q; const bool valid = (64 * j <= t), forced = (j == 0) || (j == cur) || (j == cur - 1);
            v[kt] = valid ? (forced ? BIGF : impL[kt * 64 + lane]) : -BIGF; }
#pragma unroll
        for (int kt = 0; kt < 16; ++kt) impL[kt * 64 + lane] = v[kt];
        LDS_WAIT(); asm volatile("" ::: "memory");
        int rank[16];
#pragma unroll
        for (int kt = 0; kt < 16; ++kt) rank[kt] = 0;
#pragma unroll 1
        for (int rot = 0; rot < 4; ++rot) {
#pragma unroll 2
            for (int kk = 0; kk < 16; ++kk) {
                const float o = impL[kk * 64 + (lane ^ (16 * rot))];
                const int oj = 4 * kk + (q ^ rot);
#pragma unroll
                for (int kt = 0; kt < 16; ++kt) { const int myj = 4 * kt + q; rank[kt] += ((o > v[kt]) || (o == v[kt] && oj < myj)) ? 1 : 0; }
            }
        }
#pragma unroll
        for (int kt = 0; kt < 16; ++kt) { const int j = 4 * kt + q; const unsigned bit = rank[kt] < 16 ? 1u : 0u; if (kt < 8) mlo |= bit << j; else mhi |= bit << (j - 32); }
        mlo |= __shfl_xor(mlo, 16); mlo |= __shfl_xor(mlo, 32); mhi |= __shfl_xor(mhi, 16); mhi |= __shfl_xor(mhi, 32);
    }
    unsigned ulo = mlo, uhi = mhi;
#pragma unroll
    for (int o = 1; o < 16; o <<= 1) { ulo |= __shfl_xor(ulo, o); uhi |= __shfl_xor(uhi, o); }
    ulo = __builtin_amdgcn_readfirstlane(ulo); uhi = __builtin_amdgcn_readfirstlane(uhi);
    {
#pragma unroll
        for (int g = 0; g < 4; ++g) { mx[g] = NEGF; ls[g] = 0.f; }
#pragma unroll
        for (int dt = 0; dt < 4; ++dt)
#pragma unroll
            for (int g = 0; g < 4; ++g) O[dt][g] = (f32x4){0.f, 0.f, 0.f, 0.f};
        const bf16* Kp = (const bf16*)(ws + WS_KVH) + ((size_t)(2 * 4 + b) * 4 + hkv) * 4096 * 64;
        const bf16* VTp = (const bf16*)(ws + WS_VT) + ((size_t)(0 * 4 + b) * 4 + hkv) * 64 * 4096;
        const int jend = (t0 + 15) >> 6;
        for (int jb = 0; jb <= jend; ++jb) {
            const unsigned ub = jb < 32 ? (ulo >> jb) & 1u : (uhi >> (jb - 32)) & 1u;
            if (!ub) continue;
            const bool selbit = (jb < 32 ? (mlo >> jb) & 1u : (mhi >> (jb - 32)) & 1u) != 0u;
            flash_block<0>(Kp, VTp, jb, t, selbit, Qs, O, mx, ls, q, r16);
        }
        attn_finish<1>(args, O, ls, true, m, hkv, q);
    }
    {
#pragma unroll
        for (int g = 0; g < 4; ++g) { mx[g] = NEGF; ls[g] = 0.f; }
#pragma unroll
        for (int dt = 0; dt < 4; ++dt)
#pragma unroll
            for (int g = 0; g < 4; ++g) O[dt][g] = (f32x4){0.f, 0.f, 0.f, 0.f};
        const bf16* Kp = (const bf16*)(ws + WS_KVH) + ((size_t)(4 * 4 + b) * 4 + hkv) * 4096 * 64;
        const bf16* VTp = (const bf16*)(ws + WS_VT) + ((size_t)(1 * 4 + b) * 4 + hkv) * 64 * 4096;
        const int jbeg = t0 >= 511 ? (t0 - 511) >> 6 : 0, jend = (t0 + 15) >> 6;
        for (int jb = jbeg; jb <= jend; ++jb) flash_block<1>(Kp, VTp, jb, t, true, Qs, O, mx, ls, q, r16);
        attn_finish<2>(args, O, ls, true, m, hkv, q);
    }
}
__device__ __forceinline__ void attn_sample_unit(const Args& args, LAS unsigned char* lds, int unit, int tid, int wave, int lane) {
    unsigned char* ws = args.ws; float* out = args.out;
    const int hkv = unit & 3, bs = unit >> 2; const size_t m = MP + bs;
    LAS float* sc = (LAS float*)lds; LAS float* impv = sc + 512; LAS int* selblk = (LAS int*)(impv + 64);
    LAS float* pm = (LAS float*)(selblk + 16); LAS float* pl = pm + 64; LAS float* po = pl + 64;
    const bf16* Qr = (const bf16*)(ws + WS_Q) + m * 1024 + hkv * 256;
    const float* KCS = (const float*)(ws + WS_KCS) + (size_t)(bs * 4 + hkv) * 128 * 64; const float* VCS = (const float*)(ws + WS_VCS) + (size_t)(bs * 4 + hkv) * 128 * 64;
    { const int g = tid >> 7, n = tid & 127; float s = NEGF;
      if (n < 127) { float a = 0.f;
#pragma unroll 8
          for (int d = 0; d < 64; ++d) a += bf2f(Qr[g * 64 + d]) * KCS[n * 64 + d];
          s = a * 0.125f; }
      sc[g * 128 + n] = s; }
    __syncthreads();
    if (wave < 4) { const float s0 = sc[wave * 128 + lane], s1 = sc[wave * 128 + 64 + lane];
        float mxv = fmaxf(s0, s1);
#pragma unroll
        for (int o = 1; o < 64; o <<= 1) mxv = fmaxf(mxv, __shfl_xor(mxv, o));
        const float e0 = __expf(s0 - mxv), e1 = (lane < 63) ? __expf(s1 - mxv) : 0.f;
        const float inv = 1.f / fmaxf(wave_sum(e0 + e1), TINYF);
        sc[wave * 128 + lane] = e0 * inv; sc[wave * 128 + 64 + lane] = e1 * inv; }
    __syncthreads();
    float oc = 0.f;
    if (tid < 256) { const int g = tid >> 6, d = tid & 63;
#pragma unroll 4
        for (int n = 0; n < 127; ++n) oc += sc[g * 128 + n] * VCS[n * 64 + d]; }
    else if (tid < 256 + 33) { const int j = tid - 256;
        float acc = 0.f;
#pragma unroll
        for (int k = -1; k < 4; ++k) { const int n = 4 * j + k; if (n >= 0 && n < 127) { const float P = (sc[n] + sc[128 + n]) + (sc[256 + n] + sc[384 + n]); acc += (k == -1 || k == 3) ? P : 2.f * P; } }
        impv[j] = (j == 0 || j == 31 || j == 32) ? BIGF : acc; }
    __syncthreads();
    if (tid < 64) { bool sel = false;
        if (tid < 33) { const float v = impv[tid]; int rank = 0;
            for (int k = 0; k < 33; ++k) { const float o = impv[k]; rank += ((o > v) || (o == v && k < tid)) ? 1 : 0; }
            sel = rank < 16 && tid < 32; }
        const unsigned long long bal = __ballot(sel);
        if (sel) selblk[__popcll(bal & ((1ull << tid) - 1ull))] = tid; }
    __syncthreads();
    float qv[4];
#pragma unroll
    for (int g = 0; g < 4; ++g) qv[g] = bf2f(Qr[g * 64 + lane]) * 0.125f;
    const int* pt = (const int*)args.in[5] + bs * NPAGES; const float* cache = INF(4); const float* cwin = INF(6);
#pragma unroll
    for (int br = 0; br < 2; ++br) {
        float mx[4], ls[4], o[4];
#pragma unroll
        for (int g = 0; g < 4; ++g) { mx[g] = NEGF; ls[g] = 0.f; o[g] = 0.f; }
        const int nrows = br == 0 ? 15 * 64 + 1 : 512;
        for (int idx = wave; idx < nrows; idx += 8) {
            float kx, vx;
            if (br == 0) {
                if (idx < 960) { const int pos = selblk[idx >> 6] * 64 + (idx & 63); const size_t rowp = ((size_t)pt[pos >> 7] * 128 + (pos & 127)) * 4;
                    kx = cache[(rowp + 2) * 256 + hkv * 64 + lane]; vx = cache[(rowp + 3) * 256 + hkv * 64 + lane]; }
                else { kx = out[O_KVS + ((size_t)bs * 4 + 2) * 256 + hkv * 64 + lane]; vx = out[O_KVS + ((size_t)bs * 4 + 3) * 256 + hkv * 64 + lane]; }
            } else {
                const int w = idx + 1;
                if (w < 512) { kx = cwin[(((size_t)bs * 512 + w) * 2 + 0) * 256 + hkv * 64 + lane]; vx = cwin[(((size_t)bs * 512 + w) * 2 + 1) * 256 + hkv * 64 + lane];
                    out[O_WINS + (((size_t)bs * 512 + (w - 1)) * 2 + 0) * 256 + hkv * 64 + lane] = kx; out[O_WINS + (((size_t)bs * 512 + (w - 1)) * 2 + 1) * 256 + hkv * 64 + lane] = vx; }
                else { kx = out[O_WINS + (((size_t)bs * 512 + 511) * 2 + 0) * 256 + hkv * 64 + lane]; vx = out[O_WINS + (((size_t)bs * 512 + 511) * 2 + 1) * 256 + hkv * 64 + lane]; }
            }
#pragma unroll
            for (int g = 0; g < 4; ++g) { const float s = wave_sum(qv[g] * kx);
                const float mnew = fmaxf(mx[g], s), alpha = __expf(mx[g] - mnew), p = __expf(s - mnew);
                ls[g] = ls[g] * alpha + p; o[g] = o[g] * alpha + p * vx; mx[g] = mnew; }
        }
#pragma unroll
        for (int g = 0; g < 4; ++g) { if (lane == 0) { pm[(br * 8 + wave) * 4 + g] = mx[g]; pl[(br * 8 + wave) * 4 + g] = ls[g]; } po[((br * 8 + wave) * 4 + g) * 64 + lane] = o[g]; }
    }
    __syncthreads();
    if (tid < 256) { const int g = tid >> 6, d = tid & 63;
        const float* gates = (const float*)(ws + WS_MISC) + m * 128 + 32 + (hkv * 4 + g) * 3;
        float res = sigmf(gates[0]) * oc;
#pragma unroll
        for (int br = 0; br < 2; ++br) { float M = NEGF;
#pragma unroll
            for (int w = 0; w < 8; ++w) M = fmaxf(M, pm[(br * 8 + w) * 4 + g]);
            float L = 0.f, O = 0.f;
#pragma unroll
            for (int w = 0; w < 8; ++w) { const float e = __expf(pm[(br * 8 + w) * 4 + g] - M); L += pl[(br * 8 + w) * 4 + g] * e; O += po[((br * 8 + w) * 4 + g) * 64 + d] * e; }
            res += sigmf(gates[1 + br]) * O / fmaxf(L, TINYF); }
        ((bf16*)(ws + WS_YATT))[m * 1024 + (hkv * 4 + g) * 64 + d] = (bf16)f2bf(res); }
    __syncthreads();
}

__device__ __forceinline__ void ffn_act_phase(const Args& args, int gt, int NGT) {
    unsigned char* ws = args.ws; float* out = args.out;
    const bf16* U = (const bf16*)(ws + WS_U); bf16* ACT = (bf16*)(ws + WS_ACT);
    const float* cw = INF(32); const float* cb = INF(33); const float* st = INF(9);
    for (int i = gt; i < MALL * (DFF / 8); i += NGT) {
        const int row = i / (DFF / 8), c8 = (i % (DFF / 8)) * 8;
        float r[2][8];
#pragma unroll
        for (int hf = 0; hf < 2; ++hf) {
            const int col = hf * DFF + c8;
            float u0[8], u1[8], u2[8];
            if (row < MP) {
                const int t = row & 4095;
                const u32x4 z = (u32x4){0u, 0u, 0u, 0u};
                const u32x4 a = t >= 2 ? *(const u32x4*)(U + (size_t)(row - 2) * DFF2 + col) : z, b = t >= 1 ? *(const u32x4*)(U + (size_t)(row - 1) * DFF2 + col) : z, c = *(const u32x4*)(U + (size_t)row * DFF2 + col);
                u0[0] = bflo(a.x); u0[1] = bfhi(a.x); u0[2] = bflo(a.y); u0[3] = bfhi(a.y); u0[4] = bflo(a.z); u0[5] = bfhi(a.z); u0[6] = bflo(a.w); u0[7] = bfhi(a.w);
                u1[0] = bflo(b.x); u1[1] = bfhi(b.x); u1[2] = bflo(b.y); u1[3] = bfhi(b.y); u1[4] = bflo(b.z); u1[5] = bfhi(b.z); u1[6] = bflo(b.w); u1[7] = bfhi(b.w);
                u2[0] = bflo(c.x); u2[1] = bfhi(c.x); u2[2] = bflo(c.y); u2[3] = bfhi(c.y); u2[4] = bflo(c.z); u2[5] = bfhi(c.z); u2[6] = bflo(c.w); u2[7] = bfhi(c.w);
            } else {
                const int bs = row - MP;
#pragma unroll
                for (int k = 0; k < 8; ++k) { u0[k] = st[((size_t)bs * 2 + 0) * DFF2 + col + k]; u1[k] = st[((size_t)bs * 2 + 1) * DFF2 + col + k]; u2[k] = out[O_FFNS + ((size_t)bs * 2 + 1) * DFF2 + col + k];
                    out[O_FFNS + ((size_t)bs * 2 + 0) * DFF2 + col + k] = u1[k]; }
            }
#pragma unroll
            for (int k = 0; k < 8; ++k) r[hf][k] = cb[col + k] + cw[col + k] * u0[k] + cw[DFF2 + col + k] * u1[k] + cw[2 * DFF2 + col + k] * u2[k];
        }
        u32x4 o; o.x = pk2(siluf(r[0][0]) * r[1][0], siluf(r[0][1]) * r[1][1]); o.y = pk2(siluf(r[0][2]) * r[1][2], siluf(r[0][3]) * r[1][3]);
        o.z = pk2(siluf(r[0][4]) * r[1][4], siluf(r[0][5]) * r[1][5]); o.w = pk2(siluf(r[0][6]) * r[1][6], siluf(r[0][7]) * r[1][7]);
        *(u32x4*)(ACT + (size_t)row * DFF + c8) = o;
    }
}
__device__ __forceinline__ void final_norm_phase(const Args& args, int gw, int NGW, int lane) {
    const float* X = (const float*)(args.ws + WS_X1); const float* nw = INF(14);
    for (int m = gw; m < MALL; m += NGW) {
        const float* xr = X + (size_t)m * 1024; float* o = args.out + (m < MP ? O_YP + (size_t)m * 1024 : O_YS + (size_t)(m - MP) * 1024);
        f32x4 v[4]; float s = 0.f;
#pragma unroll
        for (int j = 0; j < 4; ++j) { v[j] = *(const f32x4*)(xr + (j * 64 + lane) * 4); s += (v[j].x * v[j].x + v[j].y * v[j].y) + (v[j].z * v[j].z + v[j].w * v[j].w); }
        const float rstd = 1.f / sqrtf(wave_sum(s) * (1.f / 1024.f) + EPS);
#pragma unroll
        for (int j = 0; j < 4; ++j) { const int c0 = (j * 64 + lane) * 4; *(f32x4*)(o + c0) = (v[j] * rstd) * *(const f32x4*)(nw + c0); }
    }
}
constexpr int N_PHASES = 15;
#ifndef MK_PER_PHASE
#define MK_PER_PHASE 0
#endif

__global__ void __launch_bounds__(NTHR, 2) fwd_kernel(Args args) {
    extern __shared__ __attribute__((aligned(16))) unsigned char lds_raw[];
    LAS unsigned char* lds = (LAS unsigned char*)lds_raw;
    const int tid = threadIdx.x, lane = tid & 63, wave = __builtin_amdgcn_readfirstlane(tid >> 6);
    const int G = gridDim.x, bid = blockIdx.x, gw = bid * NWAVES + wave, NGW = G * NWAVES, gt = bid * NTHR + tid, NGT = G * NTHR;
    unsigned char* ws = args.ws;
    for (int u = tid; u < (LDS_BYTES - LDSCTL_OFF) / 4; u += NTHR) ((LAS unsigned*)(lds + LDSCTL_OFF))[u] = 0u;
    __syncthreads();
    XcdBarrier bar; bar.bar = (unsigned*)(ws + WS_CTL) + CW_BAR; bar.x = 0; bar.st = nullptr;
    if (!MK_PER_PHASE) bar = xcd_barrier_post((unsigned*)(ws + WS_CTL) + CW_BAR, (volatile LAS unsigned*)(lds + MISC_OFF) + 8);
    const int lo = args.ph_lo, hi = args.ph_hi;
#ifndef PHASE_MASK
#define PHASE_MASK 0x7fff
#endif
#define IN(k) ((((PHASE_MASK) >> (k)) & 1) && lo <= (k) && (k) < hi)
#define SEAM(k) do { if (IN(k) && IN((k) + 1)) xcd_barrier(bar); } while (0)
    using pg8::Gemm; using pg8::StaticOrder;

    if (IN(0)) { p0_prologue(args, lds, gw, NGW, lane, wave); }
    SEAM(0);
    if (IN(1)) {
        Gemm g{(const bf16*)(ws + WS_SC), (const bf16*)(ws + WS_WADA), 256, 6144, 1024}; StaticOrder S; S.init(256, 6144, G, bid);
        pg8::EpiF32 E{(float*)(ws + WS_MOD), 6144, INF(11)};
        pg8::gemm_phase<pg8::EpiF32, StaticOrder, true, true>(lds, g, S, E);
    }
    SEAM(1);
    if (IN(2)) { norm_mod_phase<0>(args, gw, NGW, lane); }
    SEAM(2);
    if (IN(3)) {
        Gemm g{(const bf16*)(ws + WS_H), (const bf16*)(ws + WS_WIN), MPAD, NPROJ, 1024}; StaticOrder S; S.init(MPAD, NPROJ, G, bid);
        epi::InProj E{ws, args.out};
        pg8::gemm_phase<epi::InProj, StaticOrder, true, true>(lds, g, S, E);
    }
    SEAM(3);
    if (IN(4)) {
        { Gemm g{(const bf16*)(ws + WS_CKB), (const bf16*)(ws + WS_W1K), 65536, 256, 1024}; StaticOrder S; S.init(65536, 256, G, bid);
          pg8::EpiF32 E{(float*)(ws + WS_PARTSK), 256, nullptr}; pg8::gemm_phase<pg8::EpiF32, StaticOrder, true, true>(lds, g, S, E); }
        { Gemm g{(const bf16*)(ws + WS_CVB), (const bf16*)(ws + WS_W1V), 65536, 256, 1024}; StaticOrder S; S.init(65536, 256, G, bid);
          pg8::EpiF32 E{(float*)(ws + WS_PARTSV), 256, nullptr}; pg8::gemm_phase<pg8::EpiF32, StaticOrder, true, true>(lds, g, S, E); }
        { Gemm g{(const bf16*)(ws + WS_KVH), (const bf16*)(ws + WS_W1K), 4096, 256, 1024}; StaticOrder S; S.init(4096, 256, G, bid);
          pg8::EpiF32 E{(float*)(ws + WS_PARTK), 256, nullptr}; pg8::gemm_phase<pg8::EpiF32, StaticOrder, true, true>(lds, g, S, E); }
        { Gemm g{(const bf16*)(ws + WS_KVH) + (size_t)16 * 4096 * 64, (const bf16*)(ws + WS_W1V), 4096, 256, 1024}; StaticOrder S; S.init(4096, 256, G, (bid + G - 16) % G);
          pg8::EpiF32 E{(float*)(ws + WS_PARTV), 256, nullptr}; pg8::gemm_phase<pg8::EpiF32, StaticOrder, true, true>(lds, g, S, E); }
        for (int it = gw; it < 256 * 48; it += NGW) conv_prompt_item(args, it, lane);
        for (int it = gw; it < 4096; it += NGW) dtcs_item(args, it, lane);
        sample_conv(args, gt, NGT);
    }
    SEAM(4);
    if (IN(5)) {
        for (int u = bid; u < 512; u += G) ssd_states_unit(args, lds, u, wave, lane);
        for (int it = gw; it < 2 * 16 * 256; it += NGW) compress2_prompt_item(args, it, lane);
        for (int it = gw; it < 2 * 512 * 128; it += NGW) compress2_sample_item(args, it, lane);
        for (int it = gw; it < MS * NH; it += NGW) sample_ssm_item(args, lds, it, wave, lane);
    }
    SEAM(5);
    if (IN(6)) { scan_phase(args, gt, NGT); }
    SEAM(6);
    if (IN(7)) {
#ifndef P7_MASK
#define P7_MASK 7
#endif
        if (P7_MASK & 1) for (int u = bid; u < 512; u += G) ssd_out_unit(args, lds, u, wave, lane, tid);
        if (P7_MASK & 2) for (int u = gw; u < 4096; u += NGW) attn_prompt_unit(args, (LAS float*)(lds + wave * 12288), u, lane);
        __syncthreads();
        if (P7_MASK & 4) for (int u = bid; u < 512; u += G) attn_sample_unit(args, lds, u, tid, wave, lane);
    }
    SEAM(7);
    if (IN(8)) {
        { Gemm g{(const bf16*)(ws + WS_YSSM), (const bf16*)(ws + WS_WSSM), MPAD, 1024, 2048}; StaticOrder S; S.init(MPAD, 1024, G, bid);
          epi::Merge1 E{ws}; pg8::gemm_phase<epi::Merge1, StaticOrder, true, true>(lds, g, S, E); }
        { Gemm g{(const bf16*)(ws + WS_YATT), (const bf16*)(ws + WS_WATT), MPAD, 1024, 1024}; StaticOrder S; S.init(MPAD, 1024, G, bid);
          epi::Merge2 E{ws}; pg8::gemm_phase<epi::Merge2, StaticOrder, true, true>(lds, g, S, E); }
    }
    SEAM(8);
    if (IN(9)) {
        Gemm g{(const bf16*)(ws + WS_MERGED), (const bf16*)(ws + WS_WOUT), MPAD, 1024, 1024}; StaticOrder S; S.init(MPAD, 1024, G, bid);
        epi::Resid E{INF(0), INF(1), nullptr, (float*)(ws + WS_X1), (const float*)(ws + WS_MOD), 2048};
        pg8::gemm_phase<epi::Resid, StaticOrder, true, true>(lds, g, S, E);
    }
    SEAM(9);
    if (IN(10)) { norm_mod_phase<1>(args, gw, NGW, lane); }
    SEAM(10);
    if (IN(11)) {
        Gemm g{(const bf16*)(ws + WS_H), (const bf16*)(ws + WS_WUP), MPAD, DFF2, 1024}; StaticOrder S; S.init(MPAD, DFF2, G, bid);
        epi::Up E{ws, args.out};
        pg8::gemm_phase<epi::Up, StaticOrder, true, true>(lds, g, S, E);
    }
    SEAM(11);
    if (IN(12)) { ffn_act_phase(args, gt, NGT); }
    SEAM(12);
    if (IN(13)) {
        Gemm g{(const bf16*)(ws + WS_ACT), (const bf16*)(ws + WS_WDN), MPAD, 1024, DFF}; StaticOrder S; S.init(MPAD, 1024, G, bid);
        epi::Resid E{INF(0), INF(1), (const float*)(ws + WS_X1), (float*)(ws + WS_X1), (const float*)(ws + WS_MOD), 5120};
        pg8::gemm_phase<epi::Resid, StaticOrder, true, true>(lds, g, S, E);
    }
    SEAM(13);
    if (IN(14)) { final_norm_phase(args, gw, NGW, lane); }
#undef IN
#undef SEAM
}

extern "C" void kernel_launch(void* const* d_in, const int* in_sizes, int n_in, void* d_out, int out_size, void* d_ws, size_t ws_size, hipStream_t stream) {
    static int grid = 0;
    if (grid == 0) {
        if (n_in != 35 || out_size != (int)O_END || ws_size < WS_END) { fprintf(stderr, "kernel_launch: unexpected shapes (n_in %d out %d ws %zu, need %zu)\n", n_in, out_size, ws_size, (size_t)WS_END); grid = -1; return; }
        int dev = 0, cus = 0, per_cu = 0;
        if (hipGetDevice(&dev) != hipSuccess || hipDeviceGetAttribute(&cus, hipDeviceAttributeMultiprocessorCount, dev) != hipSuccess) { grid = -1; return; }
        if (hipFuncSetAttribute((const void*)fwd_kernel, hipFuncAttributeMaxDynamicSharedMemorySize, LDS_BYTES) != hipSuccess) { fprintf(stderr, "kernel_launch: hipFuncSetAttribute failed\n"); grid = -1; return; }
        if (hipOccupancyMaxActiveBlocksPerMultiprocessor(&per_cu, (const void*)fwd_kernel, NTHR, LDS_BYTES) != hipSuccess || per_cu < 1) { fprintf(stderr, "kernel_launch: occupancy query says %d\n", per_cu); }
        (void)hipGetLastError();
        grid = cus;
    }
    if (grid < 0) return;
    (void)hipMemsetAsync((char*)d_ws + WS_CTL, 0, CTL_ZERO_BYTES, stream);
    Args a{};
    for (int i = 0; i < 35; ++i) a.in[i] = d_in[i];
    a.out = (float*)d_out; a.ws = (unsigned char*)d_ws;
#if MK_PER_PHASE
    for (int p = 0; p < N_PHASES; ++p) { a.ph_lo = p; a.ph_hi = p + 1; hipLaunchKernelGGL(fwd_kernel, dim3(grid), dim3(NTHR), LDS_BYTES, stream, a); }
#else
    a.ph_lo = 0; a.ph_hi = N_PHASES;
    hipLaunchKernelGGL(fwd_kernel, dim3(grid), dim3(NTHR), LDS_BYTES, stream, a);
#endif
}
```

```cpp
#include <hip/hip_runtime.h>
#include <cstdio>
#include <cstdint>
namespace pg8 {
#define PG8_LAS __attribute__((address_space(3)))
typedef unsigned short bf16_t;
typedef short bf16x8 __attribute__((ext_vector_type(8)));
typedef float f32x4 __attribute__((ext_vector_type(4)));
typedef unsigned u32x4 __attribute__((ext_vector_type(4)));
constexpr int BM = 256, BK = 64, HALF = 128, HTB = HALF * BK * 2  , STAGE_BYTES = 8 * HTB, NXCD = 8, WGM = 8;

__host__ __device__ __forceinline__ int lds_byte(int r, int c) { const int st = (r >> 4) * 2 + (c >> 5), rr = r & 15, cc = c & 31, ob = rr * 64 + cc * 2; return st * 1024 + (ob ^ (((ob >> 9) & 1) << 5)); }
__host__ __device__ __forceinline__ void stage_rc(int b, int& R, int& C) { const int st = b / 1024, sb = b % 1024, swz = sb ^ (((sb >> 9) & 1) << 5); R = (st >> 1) * 16 + swz / 64; C = (st & 1) * 32 + (swz % 64) / 2; }
__host__ __device__ __forceinline__ int perm32(int rho) { const int n = rho >> 4, i = rho & 15; return 8 * (i >> 2) + 4 * n + (i & 3); }

struct Unit { int pm, pn; };
struct Gemm { const bf16_t* A; const bf16_t* Bt; int M, N, K; };

struct StaticOrder {
    int nM, nN, nwg, G, c;
    __host__ __device__ void init(int M, int N, int G_, int c_) { nM = M / BM; nN = N / BM; nwg = nM * nN; G = G_; c = c_; }
    __host__ __device__ bool next(int i, Unit& u) const {
        const long L = (long)i * G + c; if (L >= nwg) return false;
        int wgid = (int)L; { const int q = nwg / NXCD, r = nwg % NXCD, xcd = wgid % NXCD, off = wgid / NXCD; wgid = (xcd < r ? xcd * (q + 1) : r * (q + 1) + (xcd - r) * q) + off; }
        const int nig = WGM * nN, gid = wgid / nig, fm = gid * WGM, gsz = (nM - fm) < WGM ? (nM - fm) : WGM;
        u.pm = fm + ((wgid % nig) % gsz); u.pn = (wgid % nig) / gsz; return true;
    }
    __device__ __forceinline__ void a_ready(const Unit&) const {}
    __device__ __forceinline__ void done(const Unit&) const {}
};
__device__ __forceinline__ unsigned cvt_pk_bf16(float lo, float hi) { unsigned r; asm volatile("v_cvt_pk_bf16_f32 %0, %1, %2" : "=v"(r) : "v"(lo), "v"(hi)); return r; }
typedef float f32x2 __attribute__((ext_vector_type(2)));
struct EpiF32 {
    static constexpr bool PERM = false, AFTER_DRAIN = false;
    float* C; int ldc; const float* bias;
    __device__ __forceinline__ void operator()(const f32x4 (&acc)[2][2][4][2], const Unit& u, int wr, int wc, int fr, int fq) const {
        const int row0 = u.pm * BM + wr * 64 + fr, col0 = u.pn * BM + wc * 32 + 4 * fq;
        f32x4 bv[2][2];
#pragma unroll
        for (int bj = 0; bj < 2; ++bj)
#pragma unroll
            for (int n = 0; n < 2; ++n) bv[bj][n] = bias ? *(const f32x4*)(bias + col0 + bj * HALF + n * 16) : (f32x4){0.f, 0.f, 0.f, 0.f};
#pragma unroll
        for (int ai = 0; ai < 2; ++ai)
#pragma unroll
            for (int m = 0; m < 4; ++m) { float* rowp = C + (size_t)(row0 + ai * HALF + m * 16) * ldc + col0;
#pragma unroll
                for (int bj = 0; bj < 2; ++bj)
#pragma unroll
                    for (int n = 0; n < 2; ++n) *(f32x4*)(rowp + bj * HALF + n * 16) = acc[ai][bj][m][n] + bv[bj][n]; }
    }
};
template <class Epi, class Sched, bool ALIGN_EPI = false, bool SP2 = false>
__device__ __forceinline__ void gemm_phase(PG8_LAS unsigned char* lds, const Gemm g, const Sched& S, const Epi& E) {
    const int tid = threadIdx.x, wid = __builtin_amdgcn_readfirstlane(tid >> 6), lane = tid & 63, wr = wid >> 2, wc = wid & 3, fr = lane & 15, fq = lane >> 4;
    const int K = g.K, nt = K / BK;
    unsigned voffA[2], voffB[2];
#pragma unroll
    for (int i = 0; i < 2; ++i) { int R, C; stage_rc(tid * 16 + i * 8192, R, C); const int Rb = Epi::PERM ? ((R & ~31) + perm32(R & 31)) : R;
        voffA[i] = (unsigned)(R * K + C) * 2u; voffB[i] = (unsigned)(Rb * K + C) * 2u; }
    const size_t kstep = (size_t)(BK * 2);
    const size_t hstep = (size_t)HALF * K * 2;
    const size_t tstep = 2 * hstep;
    const unsigned ldsw = (unsigned)wid * 1024u;
    const int aoff = lds_byte(wr * 64 + fr, fq * 8), boff = lds_byte(wc * 32 + fr, fq * 8);
#define PG8_SA(b, h) (((b) * 2 + (h)) * HTB)
#define PG8_SB(b, h) ((4 + (b) * 2 + (h)) * HTB)
#define PG8_STAGE(bufoff, gbase, voff) do { _Pragma("unroll") for (int _i = 0; _i < 2; ++_i) \
        __builtin_amdgcn_global_load_lds((const unsigned*)((const char*)(gbase) + (voff)[_i]), (PG8_LAS unsigned*)(lds + (bufoff) + ldsw + _i * 8192), 16, 0, 0); } while (0)
#define PG8_LDA(dst, b, h) do { _Pragma("unroll") for (int m = 0; m < 4; ++m) _Pragma("unroll") for (int k = 0; k < 2; ++k) dst[m][k] = *(const PG8_LAS bf16x8*)(lds + PG8_SA(b, h) + aoff + m * 2048 + k * 1024); } while (0)
#define PG8_LDB(dst, b, h) do { _Pragma("unroll") for (int n = 0; n < 2; ++n) _Pragma("unroll") for (int k = 0; k < 2; ++k) dst[n][k] = *(const PG8_LAS bf16x8*)(lds + PG8_SB(b, h) + boff + n * 2048 + k * 1024); } while (0)
#define PG8_MMA(ai, bj, At, Bt) do { __builtin_amdgcn_s_setprio(1); _Pragma("unroll") for (int m = 0; m < 4; ++m) _Pragma("unroll") for (int n = 0; n < 2; ++n) _Pragma("unroll") for (int k = 0; k < 2; ++k) \
        acc[ai][bj][m][n] = __builtin_amdgcn_mfma_f32_16x16x32_bf16(Bt[n][k], At[m][k], acc[ai][bj][m][n], 0, 0, 0); __builtin_amdgcn_s_setprio(0); } while (0)
#define PG8_WAIT_V(n) asm volatile("s_waitcnt vmcnt(" #n ")" ::: "memory")
#define PG8_WAIT_L(n) asm volatile("s_waitcnt lgkmcnt(" #n ")" ::: "memory")
#define PG8_BAR __builtin_amdgcn_s_barrier()
#define PG8_SCHED __builtin_amdgcn_sched_barrier(0)
    Unit cur, nxt; int ui = 0;
    if (!S.next(0, cur)) return;
    f32x4 acc[2][2][4][2];
#pragma unroll
    for (int a = 0; a < 2; ++a)
#pragma unroll
        for (int b = 0; b < 2; ++b)
#pragma unroll
            for (int m = 0; m < 4; ++m)
#pragma unroll
                for (int n = 0; n < 2; ++n) acc[a][b][m][n] = (f32x4){0.f, 0.f, 0.f, 0.f};
    bf16x8 At[4][2], B0[2][2], B1[2][2];
    const char* cA = (const char*)g.A + (size_t)cur.pm * tstep; const char* cB = (const char*)g.Bt + (size_t)cur.pn * tstep;
    S.a_ready(cur);
    if constexpr (SP2) {
        PG8_STAGE(PG8_SB(0, 0), cB, voffB); PG8_STAGE(PG8_SB(0, 1), cB + hstep, voffB); PG8_STAGE(PG8_SA(0, 0), cA, voffA); PG8_STAGE(PG8_SA(0, 1), cA + hstep, voffA);
        if (wr == 1) PG8_BAR;
        PG8_WAIT_V(2); PG8_BAR;
        PG8_STAGE(PG8_SB(1, 0), cB + kstep, voffB); PG8_STAGE(PG8_SA(1, 0), cA + kstep, voffA); PG8_STAGE(PG8_SB(1, 1), cB + hstep + kstep, voffB);
        PG8_WAIT_V(6); PG8_BAR;
    } else {
        PG8_STAGE(PG8_SB(0, 0), cB, voffB); PG8_STAGE(PG8_SA(0, 0), cA, voffA); PG8_STAGE(PG8_SB(0, 1), cB + hstep, voffB); PG8_STAGE(PG8_SA(0, 1), cA + hstep, voffA);
        if (wr == 1) PG8_BAR;
        PG8_WAIT_V(4); PG8_BAR;
        PG8_STAGE(PG8_SB(1, 0), cB + kstep, voffB); PG8_STAGE(PG8_SA(1, 0), cA + kstep, voffA); PG8_STAGE(PG8_SB(1, 1), cB + hstep + kstep, voffB);
        PG8_WAIT_V(6); PG8_BAR;
    }
    for (;;) {
        const bool has_next = S.next(ui + 1, nxt);
        const char* nA = has_next ? (const char*)g.A + (size_t)nxt.pm * tstep : cA; const char* nB = has_next ? (const char*)g.Bt + (size_t)nxt.pn * tstep : cB;
        for (int t = 0; t < nt; t += 2) {
            const bool last = (t == nt - 2);
            const char* a1 = cA + (size_t)(t + 1) * kstep;
            const char* a2 = last ? nA : cA + (size_t)(t + 2) * kstep; const char* b2 = last ? nB : cB + (size_t)(t + 2) * kstep;
            const char* a3 = a2 + kstep; const char* b3 = b2 + kstep;
            if (last && has_next) S.a_ready(nxt);
            if constexpr (SP2) {
            PG8_LDB(B0, 0, 0); PG8_LDB(B1, 0, 1); PG8_SCHED; PG8_LDA(At, 0, 0); PG8_STAGE(PG8_SA(1, 1), a1 + hstep, voffA);
            PG8_WAIT_V(8); PG8_WAIT_L(0); PG8_BAR; PG8_MMA(0, 0, At, B0); PG8_MMA(0, 1, At, B1); PG8_BAR; PG8_SCHED;
            PG8_LDA(At, 0, 1); PG8_STAGE(PG8_SB(0, 0), b2, voffB); PG8_STAGE(PG8_SB(0, 1), b2 + hstep, voffB); PG8_STAGE(PG8_SA(0, 0), a2, voffA);
            PG8_WAIT_V(8); PG8_WAIT_L(0); PG8_BAR; PG8_MMA(1, 0, At, B0); PG8_MMA(1, 1, At, B1); PG8_BAR; PG8_SCHED;
            PG8_LDB(B0, 1, 0); PG8_LDB(B1, 1, 1); PG8_SCHED; PG8_LDA(At, 1, 0); PG8_STAGE(PG8_SA(0, 1), a2 + hstep, voffA);
            PG8_WAIT_V(8); PG8_WAIT_L(0); PG8_BAR; PG8_MMA(0, 0, At, B0); PG8_MMA(0, 1, At, B1); PG8_BAR; PG8_SCHED;
            PG8_LDA(At, 1, 1); PG8_STAGE(PG8_SB(1, 0), b3, voffB); PG8_STAGE(PG8_SB(1, 1), b3 + hstep, voffB); PG8_STAGE(PG8_SA(1, 0), a3, voffA);
            PG8_WAIT_V(8); PG8_WAIT_L(0); PG8_BAR; PG8_MMA(1, 0, At, B0); PG8_MMA(1, 1, At, B1); PG8_BAR; PG8_SCHED;
            } else {
            PG8_LDB(B0, 0, 0); PG8_SCHED; PG8_LDA(At, 0, 0); PG8_STAGE(PG8_SA(1, 1), a1 + hstep, voffA);
            PG8_WAIT_L(8); PG8_BAR; PG8_WAIT_L(0); PG8_MMA(0, 0, At, B0); PG8_BAR; PG8_SCHED;
            PG8_LDB(B1, 0, 1); PG8_STAGE(PG8_SB(0, 0), b2, voffB);
            PG8_BAR; PG8_WAIT_L(0); PG8_MMA(0, 1, At, B1); PG8_BAR;
            PG8_LDA(At, 0, 1); PG8_STAGE(PG8_SA(0, 0), a2, voffA);
            PG8_BAR; PG8_WAIT_L(0); PG8_MMA(1, 0, At, B0); PG8_BAR; PG8_SCHED;
            PG8_STAGE(PG8_SB(0, 1), b2 + hstep, voffB);
            PG8_WAIT_V(6); PG8_BAR; PG8_MMA(1, 1, At, B1); PG8_BAR;
            PG8_LDB(B0, 1, 0); PG8_SCHED; PG8_LDA(At, 1, 0); PG8_STAGE(PG8_SA(0, 1), a2 + hstep, voffA);
            PG8_WAIT_L(8); PG8_BAR; PG8_WAIT_L(0); PG8_MMA(0, 0, At, B0); PG8_BAR; PG8_SCHED;
            PG8_LDB(B1, 1, 1); PG8_STAGE(PG8_SB(1, 0), b3, voffB);
            PG8_BAR; PG8_WAIT_L(0); PG8_MMA(0, 1, At, B1); PG8_BAR;
            PG8_LDA(At, 1, 1); PG8_STAGE(PG8_SA(1, 0), a3, voffA);
            PG8_BAR; PG8_WAIT_L(0); PG8_MMA(1, 0, At, B0); PG8_BAR; PG8_SCHED;
            PG8_STAGE(PG8_SB(1, 1), b3 + hstep, voffB);
            PG8_WAIT_V(6); PG8_BAR; PG8_MMA(1, 1, At, B1); PG8_BAR;
            }
        }
        if constexpr (ALIGN_EPI) { if (wr == 0) PG8_BAR; }
        if constexpr (!Epi::AFTER_DRAIN) { E(acc, cur, wr, wc, fr, fq); S.done(cur); }
        if (!has_next) break;
#pragma unroll
        for (int a = 0; a < 2; ++a)
#pragma unroll
            for (int b = 0; b < 2; ++b)
#pragma unroll
                for (int m = 0; m < 4; ++m)
#pragma unroll
                    for (int n = 0; n < 2; ++n) acc[a][b][m][n] = (f32x4){0.f, 0.f, 0.f, 0.f};
        cur = nxt; cA = nA; cB = nB; ++ui;
        if constexpr (ALIGN_EPI) { if (wr == 1) PG8_BAR; }
    }
    PG8_WAIT_V(0);
    if constexpr (!ALIGN_EPI) { if (wr == 0) PG8_BAR; }
    PG8_BAR;
    if constexpr (Epi::AFTER_DRAIN) { E.fused(acc, cur, wr, wc, fr, fq, lds, wid, lane); S.done(cur); }
#undef PG8_SA
#undef PG8_SB
#undef PG8_STAGE
#undef PG8_LDA
#undef PG8_LDB
#undef PG8_MMA
#undef PG8_WAIT_V
#undef PG8_WAIT_L
#undef PG8_BAR
#undef PG8_SCHED
}
}
#define GAS __attribute__((address_space(1)))
#define LAS __attribute__((address_space(3)))
typedef unsigned short bf16;
typedef float f32x4 __attribute__((ext_vector_type(4)));
typedef float f32x2 __attribute__((ext_vector_type(2)));
typedef short bf16x8 __attribute__((ext_vector_type(8)));
typedef short bf16x4 __attribute__((ext_vector_type(4)));
typedef unsigned u32x4 __attribute__((ext_vector_type(4)));
typedef unsigned u32x2 __attribute__((ext_vector_type(2)));
#define MFMA16(a, b, c) __builtin_amdgcn_mfma_f32_16x16x32_bf16((a), (b), (c), 0, 0, 0)

constexpr int NWAVES = 8, NTHR = 512;
constexpr int DM = 1024, SEQ = 4096, NB = 4, MP = NB * SEQ, MS = 128, MALL = MP + MS, MPAD = 16640;
constexpr int DI = 2048, CONVD = 3072, NH = 32, NG = 4, NST = 128;
constexpr int NPROJ = 9984;
constexpr int DFF = 2816, DFF2 = 5632;
constexpr int NPAGES = 16, PAST = 2048;
constexpr float EPS = 1e-6f, NEGF = -1e30f, BIGF = 1e30f, TINYF = 1e-30f;
constexpr int T_Z = 0, T_XBC = 8, T_Q = 20, T_KV = 24, T_MG = 30, T_MISC = 38;

constexpr size_t O_YP = 0;
constexpr size_t O_YS = O_YP + (size_t)MP * DM;
constexpr size_t O_KVP = O_YS + (size_t)MS * DM;
constexpr size_t O_KVS = O_KVP + (size_t)MP * 1024;
constexpr size_t O_WINP = O_KVS + (size_t)MS * 1024;
constexpr size_t O_WINS = O_WINP + (size_t)NB * 512 * 512;
constexpr size_t O_SSMP = O_WINS + (size_t)MS * 512 * 512;
constexpr size_t O_SSMS = O_SSMP + (size_t)NB * NH * 64 * 128;
constexpr size_t O_CONVP = O_SSMS + (size_t)MS * NH * 64 * 128;
constexpr size_t O_CONVS = O_CONVP + (size_t)NB * 3 * CONVD;
constexpr size_t O_FFNP = O_CONVS + (size_t)MS * 3 * CONVD;
constexpr size_t O_FFNS = O_FFNP + (size_t)NB * 2 * DFF2;
constexpr size_t O_END = O_FFNS + (size_t)MS * 2 * DFF2;
static_assert(O_END == 105725952, "output size");

constexpr size_t al256(size_t x) { return (x + 255) & ~(size_t)255; }
constexpr size_t WS_CTL = 0, CTL_ZERO_BYTES = 1u << 20;
constexpr size_t WS_WIN = CTL_ZERO_BYTES;
constexpr size_t WS_WSSM = WS_WIN + al256((size_t)NPROJ * 1024 * 2);
constexpr size_t WS_WATT = WS_WSSM + al256((size_t)1024 * 2048 * 2);
constexpr size_t WS_WOUT = WS_WATT + al256((size_t)1024 * 1024 * 2);
constexpr size_t WS_WUP = WS_WOUT + al256((size_t)1024 * 1024 * 2);
constexpr size_t WS_WDN = WS_WUP + al256((size_t)DFF2 * 1024 * 2);
constexpr size_t WS_WADA = WS_WDN + al256((size_t)1024 * DFF * 2);
constexpr size_t WS_W1K = WS_WADA + al256((size_t)6144 * 1024 * 2);
constexpr size_t WS_W1V = WS_W1K + al256((size_t)256 * 1024 * 2);
constexpr size_t WS_SC = WS_W1V + al256((size_t)256 * 1024 * 2);
constexpr size_t WS_MOD = WS_SC + al256((size_t)256 * 1024 * 2);
constexpr size_t WS_ROPE = WS_MOD + al256((size_t)256 * 6144 * 4);
constexpr size_t WS_PET = WS_ROPE + al256((size_t)4096 * 16 * 4);
constexpr size_t WS_H = WS_PET + al256(2 * 128 * 4);
constexpr size_t WS_Z = WS_H + al256((size_t)MPAD * 1024 * 2);
constexpr size_t WS_XBC = WS_Z + al256((size_t)MPAD * 2048 * 2);
constexpr size_t WS_Q = WS_XBC + al256((size_t)MPAD * 3072 * 2);
constexpr size_t WS_MG = WS_Q + al256((size_t)MPAD * 1024 * 2);
constexpr size_t WS_MISC = WS_MG + al256((size_t)MPAD * 2048 * 2);
constexpr size_t WS_KVH = WS_MISC + al256((size_t)MPAD * 128 * 4);
constexpr size_t WS_VT = WS_KVH + al256((size_t)6 * 16 * 4096 * 64 * 2);
constexpr size_t WS_XT = WS_VT + al256((size_t)2 * 16 * 64 * 4096 * 2);
constexpr size_t WS_BN = WS_XT + al256((size_t)4 * 32 * 64 * 4096 * 2);
constexpr size_t WS_CN = WS_BN + al256((size_t)16 * 4096 * 128 * 2);
constexpr size_t WS_BT = WS_CN + al256((size_t)16 * 4096 * 128 * 2);
constexpr size_t WS_DT = WS_BT + al256((size_t)16 * 4096 * 128 * 2);
constexpr size_t WS_CS = WS_DT + al256((size_t)128 * 4096 * 4);
constexpr size_t WS_STATES = WS_CS + al256((size_t)128 * 4096 * 4);
constexpr size_t WS_HPREV = WS_STATES + al256((size_t)4096 * 8192 * 4);
constexpr size_t WS_YSSM = WS_HPREV + al256((size_t)4096 * 8192 * 2);
constexpr size_t WS_SSQ = WS_YSSM + al256((size_t)MPAD * 2048 * 2);
constexpr size_t WS_PARTK = WS_SSQ + al256((size_t)MPAD * 4 * 4);
constexpr size_t WS_PARTV = WS_PARTK + al256((size_t)4096 * 256 * 4);
constexpr size_t WS_KC = WS_PARTV + al256((size_t)4096 * 256 * 4);
constexpr size_t WS_VCT = WS_KC + al256((size_t)16 * 256 * 64 * 2);
constexpr size_t WS_YATTF = WS_VCT + al256((size_t)16 * 256 * 64 * 2);
constexpr size_t WS_YATT = WS_YATTF + al256((size_t)MPAD * 1024 * 4);
constexpr size_t WS_TMPM = WS_YATT + al256((size_t)MPAD * 1024 * 2);
constexpr size_t WS_MERGED = WS_TMPM + al256((size_t)MPAD * 1024 * 4);
constexpr size_t WS_X1 = WS_MERGED + al256((size_t)MPAD * 1024 * 2);
constexpr size_t WS_U = WS_X1 + al256((size_t)MPAD * 1024 * 4);
constexpr size_t WS_ACT = WS_U + al256((size_t)MPAD * DFF2 * 2);
constexpr size_t WS_CKB = WS_ACT + al256((size_t)MPAD * DFF * 2);
constexpr size_t WS_CVB = WS_CKB + al256((size_t)128 * 4 * 2048 * 64 * 2);
constexpr size_t WS_PARTSK = WS_CVB + al256((size_t)128 * 4 * 2048 * 64 * 2);
constexpr size_t WS_PARTSV = WS_PARTSK + al256((size_t)65536 * 256 * 4);
constexpr size_t WS_KCS = WS_PARTSV + al256((size_t)65536 * 256 * 4);
constexpr size_t WS_VCS = WS_KCS + al256((size_t)128 * 4 * 128 * 64 * 4);
constexpr size_t WS_XCS = WS_VCS + al256((size_t)128 * 4 * 128 * 64 * 4);
constexpr size_t WS_DTS = WS_XCS + al256((size_t)128 * 3072 * 4);
constexpr size_t WS_W2T = WS_DTS + al256((size_t)128 * 32 * 4);
constexpr size_t WS_END = WS_W2T + al256((size_t)2 * 64 * 128 * 2);

constexpr int CW_BAR = 4096;

constexpr int RING_BYTES = 131072;
constexpr int LDSCTL_OFF = RING_BYTES, MISC_OFF = LDSCTL_OFF + 320;
constexpr int LDS_BYTES = 147456;

__device__ __forceinline__ unsigned f2bf(float f) { unsigned u = __builtin_bit_cast(unsigned, f); return (u + 0x7fffu + ((u >> 16) & 1u)) >> 16; }
__device__ __forceinline__ unsigned pk2(float lo, float hi) { return pg8::cvt_pk_bf16(lo, hi); }
__device__ __forceinline__ float bf2f(unsigned h) { return __builtin_bit_cast(float, h << 16); }
__device__ __forceinline__ float bflo(unsigned w) { return __builtin_bit_cast(float, w << 16); }
__device__ __forceinline__ float bfhi(unsigned w) { return __builtin_bit_cast(float, w & 0xffff0000u); }
__device__ __forceinline__ float wave_sum(float v) {
#pragma unroll
    for (int o = 1; o < 64; o <<= 1) v += __shfl_xor(v, o);
    return v;
}
__device__ __forceinline__ float siluf(float x) { return x / (1.f + __expf(-x)); }
__device__ __forceinline__ float sigmf(float x) { return 1.f / (1.f + __expf(-x)); }
__device__ __forceinline__ float softplusf(float x) { return x > 20.f ? x : log1pf(__expf(x)); }
#define LDS_WAIT() asm volatile("s_waitcnt lgkmcnt(0)" ::: "memory")

struct Args { const void* in[35]; float* out; unsigned char* ws; int ph_lo, ph_hi, p7mask, pad; };
#define INF(i) ((const float*)args.in[i])
#define XB_TMO      128
#define XB_XCNT(j)  (256  + 64 * (j))
#define XB_XSUB(j)  (1280 + 64 * (j))
#define XB_XGEN(j)  (2304 + 64 * (j))
#define XB_TOP      3328
#define XB_TOPGEN   3392
#define XCD_BAR_WORDS 3456
#define XB_SPIN_CAP (1u << 18)

__device__ __forceinline__ unsigned xb_ld(unsigned* p)              { return __hip_atomic_load(p, __ATOMIC_RELAXED, __HIP_MEMORY_SCOPE_AGENT); }
__device__ __forceinline__ unsigned xb_add(unsigned* p, unsigned v) { return __hip_atomic_fetch_add(p, v, __ATOMIC_RELAXED, __HIP_MEMORY_SCOPE_AGENT); }
__device__ __forceinline__ unsigned xb_xcc_id() { return (unsigned)__builtin_amdgcn_s_getreg((3 << 11) | 20) & 0xFu; }
#define XB_SPIN(cond, bar) do { unsigned _sp = 0; while (cond) { __builtin_amdgcn_s_sleep(1); \
    if ((++_sp & 255u) == 0u) { if (xb_ld(&(bar)[XB_TMO])) break; if (_sp > XB_SPIN_CAP) { atomicAdd(&(bar)[XB_TMO], 1u); break; } } } } while (0)

struct XcdBarrier {
    unsigned* bar; unsigned x;
    volatile LAS unsigned* st;
};

__device__ __forceinline__ XcdBarrier xcd_barrier_post(unsigned* bar, volatile LAS unsigned* st) {
    XcdBarrier b; b.bar = bar; b.x = xb_xcc_id(); b.st = st;
    if (threadIdx.x == 0) (void)xb_add(&bar[XB_XCNT(b.x)], 1u);
    return b;
}
__device__ __forceinline__ void xcd_barrier_complete(unsigned* bar, unsigned x, unsigned& nloc, unsigned& nx) {
    const unsigned G = gridDim.x * gridDim.y * gridDim.z;
    unsigned sum, cnt, mine, sp = 0u;
    for (;;) {
        sum = 0u; cnt = 0u; mine = 0u;
#pragma unroll
        for (unsigned j = 0; j < 16; ++j) { const unsigned c = xb_ld(&bar[XB_XCNT(j)]); sum += c; cnt += (c > 0u) ? 1u : 0u; mine = (j == x) ? c : mine; }
        if (sum == G) break;
        __builtin_amdgcn_s_sleep(1);
        if ((++sp & 255u) == 0u) { if (xb_ld(&bar[XB_TMO])) break; if (sp > XB_SPIN_CAP) { atomicAdd(&bar[XB_TMO], 1u); break; } }
    }
    nloc = mine > 0u ? mine : 1u; nx = cnt > 0u ? cnt : 1u;
}

__device__ __forceinline__ void xcd_barrier(const XcdBarrier& b) {
    asm volatile("s_waitcnt vmcnt(0)" ::: "memory");
    __syncthreads();
    if (threadIdx.x == 0) {
        unsigned* bar = b.bar;
        __builtin_amdgcn_s_waitcnt(0);
        unsigned nloc = b.st[0], nx = b.st[1];
        if (nloc == 0u) { xcd_barrier_complete(bar, b.x, nloc, nx); b.st[0] = nloc; b.st[1] = nx; }
        const unsigned old = xb_add(&bar[XB_XSUB(b.x)], 1u);
        const unsigned gen = old / nloc;
        if (old + 1u == (gen + 1u) * nloc) {
            __builtin_amdgcn_fence(__ATOMIC_RELEASE, "agent");
            asm volatile("s_waitcnt vmcnt(0)" ::: "memory");
            const unsigned og = xb_add(&bar[XB_TOP], 1u);
            const unsigned tg = og / nx;
            if (og + 1u == (tg + 1u) * nx) xb_add(&bar[XB_TOPGEN], 1u);
            else XB_SPIN(xb_ld(&bar[XB_TOPGEN]) == tg, bar);
            __builtin_amdgcn_fence(__ATOMIC_ACQUIRE, "agent");
            xb_add(&bar[XB_XGEN(b.x)], 1u);
            asm volatile("s_waitcnt vmcnt(0)" ::: "memory");
        } else {
            XB_SPIN(xb_ld(&bar[XB_XGEN(b.x)]) == gen, bar);
            __builtin_amdgcn_fence(__ATOMIC_ACQUIRE, "agent");
            asm volatile("s_waitcnt vmcnt(0)" ::: "memory");
        }
    }
    __syncthreads();
}
__device__ __forceinline__ int inproj_src_col(int n) {
    if (n < 5120) return n;
    if (n < 6144) return n - 5120 + 5152;
    if (n < 7680) return n - 6144 + 6176;
    if (n < 9728) return n - 7680 + 7760;
    const int i = n - 9728;
    if (i < 32) return 5120 + i;
    if (i < 80) return 7712 + (i - 32);
    return -1;
}
template <int MODE>
__device__ __forceinline__ void transpose_item(const float* W, int K, int ldw, int nblk, bf16* WT, int row_off, LAS float* scr, int item, int lane) {
    const int kb = item / nblk, nb = item % nblk, k0 = 64 * kb, n0 = 32 * nb;
    const int n = n0 + (lane & 31);
    const int sc = (MODE == 1) ? inproj_src_col(n) : n;
#pragma unroll 8
    for (int i = 0; i < 32; ++i) { const int kk = 2 * i + (lane >> 5); scr[kk * 33 + (lane & 31)] = (sc >= 0) ? W[(size_t)(k0 + kk) * ldw + sc] : 0.f; }
    LDS_WAIT(); asm volatile("" ::: "memory");
    const int c = lane & 7;
#pragma unroll
    for (int j = 0; j < 4; ++j) { const int nn = (lane >> 3) + 8 * j; const LAS float* s = scr + (8 * c) * 33 + nn;
        u32x4 o; o.x = pk2(s[0 * 33], s[1 * 33]); o.y = pk2(s[2 * 33], s[3 * 33]); o.z = pk2(s[4 * 33], s[5 * 33]); o.w = pk2(s[6 * 33], s[7 * 33]);
        *(u32x4*)(WT + (size_t)(row_off + n0 + nn) * K + k0 + 8 * c) = o; }
    LDS_WAIT(); asm volatile("" ::: "memory");
}

__device__ __forceinline__ void p0_prologue(const Args& args, LAS unsigned char* lds, int gw, int NGW, int lane, int wave) {
    unsigned char* ws = args.ws;
    LAS float* scr = (LAS float*)(lds + wave * 16384);
    constexpr int I_IN = 16 * (NPROJ / 32), I_SSM = 32 * 32, I_ATT = 16 * 32, I_OUT = 16 * 32, I_UP = 16 * (DFF2 / 32), I_DN = (DFF / 64) * 32, I_ADA = 16 * (6144 / 32), I_W1 = 16 * 4;
    constexpr int NITEMS = I_IN + I_SSM + I_ATT + I_OUT + I_UP + I_DN + I_ADA + 4 * I_W1;
    for (int it = gw; it < NITEMS; it += NGW) {
        int r = it;
        if (r < I_ADA) { transpose_item<0>(INF(10), 1024, 6144, 6144 / 32, (bf16*)(ws + WS_WADA), 0, scr, r, lane); continue; } r -= I_ADA;
        if (r < I_IN) { transpose_item<1>(INF(15), 1024, 9808, NPROJ / 32, (bf16*)(ws + WS_WIN), 0, scr, r, lane); continue; } r -= I_IN;
        if (r < I_SSM) { transpose_item<0>(INF(28), 2048, 1024, 32, (bf16*)(ws + WS_WSSM), 0, scr, r, lane); continue; } r -= I_SSM;
        if (r < I_ATT) { transpose_item<0>(INF(29), 1024, 1024, 32, (bf16*)(ws + WS_WATT), 0, scr, r, lane); continue; } r -= I_ATT;
        if (r < I_OUT) { transpose_item<0>(INF(30), 1024, 1024, 32, (bf16*)(ws + WS_WOUT), 0, scr, r, lane); continue; } r -= I_OUT;
        if (r < I_UP) { transpose_item<0>(INF(31), 1024, DFF2, DFF2 / 32, (bf16*)(ws + WS_WUP), 0, scr, r, lane); continue; } r -= I_UP;
        if (r < I_DN) { transpose_item<0>(INF(34), DFF, 1024, 32, (bf16*)(ws + WS_WDN), 0, scr, r, lane); continue; } r -= I_DN;
        { const int which = r / I_W1, rr = r % I_W1; const int st = which >> 1, r2 = which & 1;
          transpose_item<0>(INF(st ? 26 : 23) + (size_t)r2 * 16 * 64 * 128, 1024, 128, 4, (bf16*)(ws + (st ? WS_W1V : WS_W1K)), r2 * 128, scr, rr, lane); }
    }
    for (int r = gw; r < 256; r += NGW) {
        bf16* o = (bf16*)(ws + WS_SC) + (size_t)r * 1024;
        const float* src = r < 4 ? INF(2) + (size_t)r * 1024 : (r < 132 ? INF(3) + (size_t)(r - 4) * 1024 : nullptr);
#pragma unroll
        for (int j = 0; j < 4; ++j) { const int c0 = (j * 64 + lane) * 4; f32x4 v = src ? *(const f32x4*)(src + c0) : (f32x4){0.f, 0.f, 0.f, 0.f};
            u32x2 w; w.x = pk2(src ? siluf(v.x) : 0.f, src ? siluf(v.y) : 0.f); w.y = pk2(src ? siluf(v.z) : 0.f, src ? siluf(v.w) : 0.f); *(u32x2*)(o + c0) = w; }
    }
    for (int i = gw * 64 + lane; i < 4096 * 8; i += NGW * 64) {
        const int pos = i >> 3, k = i & 7;
        const float invf[8] = {1.0f, 0.1939227432012558f, 0.03760603070259094f, 0.007292664609849453f, 0.0014142135623842478f, 0.00027424818836152554f, 5.318296098266728e-05f, 1.0313386155758053e-05f};
        float fr = 1.0f;
#pragma unroll
        for (int q = 0; q < 8; ++q) fr = (k == q) ? invf[q] : fr;
        const float ang = (float)pos * fr;
        const double ad = (double)ang, rev = ad * 0.15915494309189535;
        const float fracrev = (float)(rev - __builtin_floor(rev));
        float* o = (float*)(ws + WS_ROPE) + (size_t)pos * 16;
        o[k] = __builtin_amdgcn_cosf(fracrev); o[8 + k] = __builtin_amdgcn_sinf(fracrev);
    }
    for (int it = gw; it < 256; it += NGW) {
        const int st = it >> 7, e = it & 127; const float* pe = INF(st ? 25 : 22); const float* w1 = INF(st ? 26 : 23);
        float s = 0.f;
        for (int i = 0; i < 32; ++i) { const int idx = lane + 64 * i; s += pe[idx] * w1[(size_t)idx * 128 + e]; }
        s = wave_sum(s);
        if (lane == 0) ((float*)(ws + WS_PET))[it] = s;
    }
    {
        const int* pt = (const int*)args.in[5]; const float* cache = INF(4);
        constexpr int NIT = 128 * 2048 * 2;
        for (int it0 = gw; it0 < NIT; it0 += 8 * NGW) {
            f32x4 v[8];
#pragma unroll
            for (int k = 0; k < 8; ++k) { const int it = it0 + k * NGW;
                if (it < NIT) { const int s = it & 1, t = (it >> 1) & 2047, b = it >> 12; const int page = pt[b * NPAGES + (t >> 7)];
                    v[k] = *(const f32x4*)(cache + (((size_t)page * 128 + (t & 127)) * 4 + s) * 256 + lane * 4); } }
#pragma unroll
            for (int k = 0; k < 8; ++k) { const int it = it0 + k * NGW;
                if (it < NIT) { const int s = it & 1, t = (it >> 1) & 2047, b = it >> 12; const int h = lane >> 4, d = (lane & 15) * 4;
                    bf16* dst = (bf16*)(ws + (s ? WS_CVB : WS_CKB)) + (((size_t)(b * 4 + h) * 2048 + t) * 64 + d);
                    u32x2 w; w.x = pk2(v[k].x, v[k].y); w.y = pk2(v[k].z, v[k].w); *(u32x2*)dst = w; } }
        }
    }
    for (int i = gw * 64 + lane; i < 2 * 64 * 128; i += NGW * 64) { const int st = i >> 13, d = (i >> 7) & 63, e = i & 127;
        ((bf16*)(ws + WS_W2T))[i] = (bf16)f2bf(INF(st ? 27 : 24)[e * 64 + d]); }
}

template <int WHICH>
__device__ __forceinline__ void norm_mod_phase(const Args& args, int gw, int NGW, int lane) {
    unsigned char* ws = args.ws; const float* MOD = (const float*)(ws + WS_MOD); bf16* H = (bf16*)(ws + WS_H);
    const float* nw = INF(WHICH ? 13 : 12);
    constexpr int SH = WHICH ? 3072 : 0, SCo = WHICH ? 4096 : 1024;
    for (int m = gw; m < MPAD; m += NGW) {
        u32x2* o = (u32x2*)(H + (size_t)m * 1024);
        if (m >= MALL) {
#pragma unroll
            for (int j = 0; j < 4; ++j) o[j * 64 + lane] = (u32x2){0u, 0u};
            continue; }
        const float* xr = WHICH ? (const float*)(ws + WS_X1) + (size_t)m * 1024 : (m < MP ? INF(0) + (size_t)m * 1024 : INF(1) + (size_t)(m - MP) * 1024);
        const float* mr = MOD + (size_t)(m < MP ? (m >> 12) : 4 + (m - MP)) * 6144;
        f32x4 v[4]; float s = 0.f;
#pragma unroll
        for (int j = 0; j < 4; ++j) { v[j] = *(const f32x4*)(xr + (j * 64 + lane) * 4); s += (v[j].x * v[j].x + v[j].y * v[j].y) + (v[j].z * v[j].z + v[j].w * v[j].w); }
        const float rstd = 1.f / sqrtf(wave_sum(s) * (1.f / 1024.f) + EPS);
#pragma unroll
        for (int j = 0; j < 4; ++j) { const int c0 = (j * 64 + lane) * 4;
            const f32x4 w = *(const f32x4*)(nw + c0), sc = *(const f32x4*)(mr + SCo + c0), sh = *(const f32x4*)(mr + SH + c0);
            const f32x4 r = (v[j] * rstd) * w * (sc + 1.f) + sh;
            u32x2 p; p.x = pk2(r.x, r.y); p.y = pk2(r.z, r.w); o[j * 64 + lane] = p; }
    }
}
namespace epi {
using pg8::Unit; using pg8::f32x4;
typedef unsigned u32x4 __attribute__((ext_vector_type(4)));
__device__ __forceinline__ u32x4 pack8(const f32x4& a, const f32x4& b) { u32x4 w; w.x = pg8::cvt_pk_bf16(a[0], a[1]); w.y = pg8::cvt_pk_bf16(a[2], a[3]); w.z = pg8::cvt_pk_bf16(b[0], b[1]); w.w = pg8::cvt_pk_bf16(b[2], b[3]); return w; }

struct InProj {
    static constexpr bool PERM = true, AFTER_DRAIN = false;
    unsigned char* ws; float* out;
    __device__ __forceinline__ void operator()(const f32x4 (&acc)[2][2][4][2], const Unit& u, int wr, int wc, int fr, int fq) const {
        const int pn = u.pn;
        const int rowb = u.pm * 256 + wr * 64 + fr;
        const int cl = wc * 32 + 8 * fq;
        if (pn < T_XBC || (pn >= T_MG && pn < T_MISC)) {
            bf16* base = pn < T_XBC ? (bf16*)(ws + WS_Z) : (bf16*)(ws + WS_MG);
            const int colt = (pn < T_XBC ? pn : pn - T_MG) * 256 + cl;
#pragma unroll
            for (int ai = 0; ai < 2; ++ai)
#pragma unroll
                for (int m = 0; m < 4; ++m) { const int row = rowb + ai * 128 + m * 16;
#pragma unroll
                    for (int bj = 0; bj < 2; ++bj) *(u32x4*)(base + (size_t)row * 2048 + colt + bj * 128) = pack8(acc[ai][bj][m][0], acc[ai][bj][m][1]); }
        } else if (pn < T_Q) {
            bf16* base = (bf16*)(ws + WS_XBC); const int colt = (pn - T_XBC) * 256 + cl;
#pragma unroll
            for (int ai = 0; ai < 2; ++ai)
#pragma unroll
                for (int m = 0; m < 4; ++m) { const int row = rowb + ai * 128 + m * 16;
                    float* fo = nullptr;
                    if (row < MP) { const int t = row & 4095; if (t >= 4093) fo = out + O_CONVP + ((size_t)(row >> 12) * 3 + (t - 4093)) * CONVD; }
                    else if (row < MALL) fo = out + O_CONVS + ((size_t)(row - MP) * 3 + 2) * CONVD;
#pragma unroll
                    for (int bj = 0; bj < 2; ++bj) { const int col = colt + bj * 128;
                        *(u32x4*)(base + (size_t)row * CONVD + col) = pack8(acc[ai][bj][m][0], acc[ai][bj][m][1]);
                        if (fo) { *(f32x4*)(fo + col) = acc[ai][bj][m][0]; *(f32x4*)(fo + col + 4) = acc[ai][bj][m][1]; } } }
        } else if (pn < T_MG) {
            const bool isq = pn < T_KV; const int s = pn - T_KV;
            const bool dorope = (isq || !(s & 1)) && !(wc & 1);
            const float* rope = (const float*)(ws + WS_ROPE);
#pragma unroll
            for (int ai = 0; ai < 2; ++ai)
#pragma unroll
                for (int m = 0; m < 4; ++m) { const int row = rowb + ai * 128 + m * 16;
                    const int pos = row < MP ? (row & 4095) : PAST;
#pragma unroll
                    for (int bj = 0; bj < 2; ++bj) {
                        f32x4 v0 = acc[ai][bj][m][0], v1 = acc[ai][bj][m][1];
                        if (dorope) {
                            f32x4 o0, o1;
#pragma unroll
                            for (int i = 0; i < 4; ++i) { o0[i] = __shfl_xor(v0[i], 16); o1[i] = __shfl_xor(v1[i], 16); }
                            if (fq < 2) {
                                const f32x4 c0 = *(const f32x4*)(rope + pos * 16), c1 = *(const f32x4*)(rope + pos * 16 + 4), s0 = *(const f32x4*)(rope + pos * 16 + 8), s1 = *(const f32x4*)(rope + pos * 16 + 12);
                                if (fq == 0) { v0 = v0 * c0 - o0 * s0; v1 = v1 * c1 - o1 * s1; }
                                else         { v0 = v0 * c0 + o0 * s0; v1 = v1 * c1 + o1 * s1; }
                            }
                        }
                        const int col = cl + bj * 128;
                        const u32x4 pk = pack8(v0, v1);
                        if (isq) { *(u32x4*)((bf16*)(ws + WS_Q) + (size_t)row * 1024 + (pn - T_Q) * 256 + col) = pk; }
                        else {
                            const int h = col >> 6, d = col & 63;
                            if (row < MP) {
                                const int b = row >> 12, t = row & 4095;
                                *(u32x4*)((bf16*)(ws + WS_KVH) + ((((size_t)s * 4 + b) * 4 + h) * 4096 + t) * 64 + d) = pk;
                                if (s < 4) { float* fo = out + O_KVP + ((size_t)row * 4 + s) * 256 + col; *(f32x4*)fo = v0; *(f32x4*)(fo + 4) = v1; }
                                else if (t >= 3584) { float* fo = out + O_WINP + (((size_t)b * 512 + (t - 3584)) * 2 + (s - 4)) * 256 + col; *(f32x4*)fo = v0; *(f32x4*)(fo + 4) = v1; }
                                if (s == 3 || s == 5) {
                                    bf16* vt = (bf16*)(ws + WS_VT) + ((((size_t)(s == 5) * 4 + b) * 4 + h) * 64 + d) * 4096 + t;
                                    vt[0 * 4096] = (bf16)(pk.x & 0xffffu); vt[1 * 4096] = (bf16)(pk.x >> 16); vt[2 * 4096] = (bf16)(pk.y & 0xffffu); vt[3 * 4096] = (bf16)(pk.y >> 16);
                                    vt[4 * 4096] = (bf16)(pk.z & 0xffffu); vt[5 * 4096] = (bf16)(pk.z >> 16); vt[6 * 4096] = (bf16)(pk.w & 0xffffu); vt[7 * 4096] = (bf16)(pk.w >> 16);
                                }
                            } else if (row < MALL) {
                                const int bs = row - MP;
                                float* fo = s < 4 ? out + O_KVS + ((size_t)bs * 4 + s) * 256 + col : out + O_WINS + (((size_t)bs * 512 + 511) * 2 + (s - 4)) * 256 + col;
                                *(f32x4*)fo = v0; *(f32x4*)(fo + 4) = v1;
                            }
                        }
                    } }
        } else {
            float* base = (float*)(ws + WS_MISC);
#pragma unroll
            for (int ai = 0; ai < 2; ++ai)
#pragma unroll
                for (int m = 0; m < 4; ++m) { const int row = rowb + ai * 128 + m * 16;
                    *(f32x4*)(base + (size_t)row * 128 + cl) = acc[ai][0][m][0]; *(f32x4*)(base + (size_t)row * 128 + cl + 4) = acc[ai][0][m][1]; }
        }
    }
};

struct Merge1 {
    static constexpr bool PERM = true, AFTER_DRAIN = false;
    unsigned char* ws;
    __device__ __forceinline__ void operator()(const f32x4 (&acc)[2][2][4][2], const Unit& u, int wr, int wc, int fr, int fq) const {
        const int rowb = u.pm * 256 + wr * 64 + fr, colb = u.pn * 256 + wc * 32 + 8 * fq;
        const bf16* MG = (const bf16*)(ws + WS_MG); const float* SSQ = (const float*)(ws + WS_SSQ); float* T = (float*)(ws + WS_TMPM);
#pragma unroll
        for (int ai = 0; ai < 2; ++ai)
#pragma unroll
            for (int m = 0; m < 4; ++m) { const int row = rowb + ai * 128 + m * 16;
                const f32x4 sq = *(const f32x4*)(SSQ + (size_t)row * 4);
                const float rstd = 1.f / sqrtf(((sq.x + sq.y) + (sq.z + sq.w)) * (1.f / 2048.f) + EPS);
#pragma unroll
                for (int bj = 0; bj < 2; ++bj) { const int col = colb + bj * 128;
                    const u32x4 g = *(const u32x4*)(MG + (size_t)row * 2048 + col);
                    f32x4 o0, o1;
                    o0[0] = sigmf(bflo(g.x)) * rstd * acc[ai][bj][m][0][0]; o0[1] = sigmf(bfhi(g.x)) * rstd * acc[ai][bj][m][0][1];
                    o0[2] = sigmf(bflo(g.y)) * rstd * acc[ai][bj][m][0][2]; o0[3] = sigmf(bfhi(g.y)) * rstd * acc[ai][bj][m][0][3];
                    o1[0] = sigmf(bflo(g.z)) * rstd * acc[ai][bj][m][1][0]; o1[1] = sigmf(bfhi(g.z)) * rstd * acc[ai][bj][m][1][1];
                    o1[2] = sigmf(bflo(g.w)) * rstd * acc[ai][bj][m][1][2]; o1[3] = sigmf(bfhi(g.w)) * rstd * acc[ai][bj][m][1][3];
                    *(f32x4*)(T + (size_t)row * 1024 + col) = o0; *(f32x4*)(T + (size_t)row * 1024 + col + 4) = o1; } }
    }
};
struct Merge2 {
    static constexpr bool PERM = true, AFTER_DRAIN = false;
    unsigned char* ws;
    __device__ __forceinline__ void operator()(const f32x4 (&acc)[2][2][4][2], const Unit& u, int wr, int wc, int fr, int fq) const {
        const int rowb = u.pm * 256 + wr * 64 + fr, colb = u.pn * 256 + wc * 32 + 8 * fq;
        const bf16* MG = (const bf16*)(ws + WS_MG); const float* T = (const float*)(ws + WS_TMPM); bf16* O = (bf16*)(ws + WS_MERGED);
#pragma unroll
        for (int ai = 0; ai < 2; ++ai)
#pragma unroll
            for (int m = 0; m < 4; ++m) { const int row = rowb + ai * 128 + m * 16;
#pragma unroll
                for (int bj = 0; bj < 2; ++bj) { const int col = colb + bj * 128;
                    const u32x4 g = *(const u32x4*)(MG + (size_t)row * 2048 + 1024 + col);
                    f32x4 o0 = *(const f32x4*)(T + (size_t)row * 1024 + col), o1 = *(const f32x4*)(T + (size_t)row * 1024 + col + 4);
                    o0[0] += sigmf(bflo(g.x)) * acc[ai][bj][m][0][0]; o0[1] += sigmf(bfhi(g.x)) * acc[ai][bj][m][0][1];
                    o0[2] += sigmf(bflo(g.y)) * acc[ai][bj][m][0][2]; o0[3] += sigmf(bfhi(g.y)) * acc[ai][bj][m][0][3];
                    o1[0] += sigmf(bflo(g.z)) * acc[ai][bj][m][1][0]; o1[1] += sigmf(bfhi(g.z)) * acc[ai][bj][m][1][1];
                    o1[2] += sigmf(bflo(g.w)) * acc[ai][bj][m][1][2]; o1[3] += sigmf(bfhi(g.w)) * acc[ai][bj][m][1][3];
                    *(u32x4*)(O + (size_t)row * 1024 + col) = pack8(o0, o1); } }
    }
};
struct Resid {
    static constexpr bool PERM = false, AFTER_DRAIN = false;
    const float* xp; const float* xs; const float* x1in; float* x1out; const float* MOD; int goff;
    __device__ __forceinline__ void operator()(const f32x4 (&acc)[2][2][4][2], const Unit& u, int wr, int wc, int fr, int fq) const {
        const int rowb = u.pm * 256 + wr * 64 + fr, colb = u.pn * 256 + wc * 32 + 4 * fq;
#pragma unroll
        for (int ai = 0; ai < 2; ++ai)
#pragma unroll
            for (int m = 0; m < 4; ++m) { const int row = rowb + ai * 128 + m * 16;
                if (row >= MALL) continue;
                const float* base = x1in ? x1in + (size_t)row * 1024 : (row < MP ? xp + (size_t)row * 1024 : xs + (size_t)(row - MP) * 1024);
                const float* gr = MOD + (size_t)(row < MP ? (row >> 12) : 4 + (row - MP)) * 6144 + goff;
#pragma unroll
                for (int bj = 0; bj < 2; ++bj)
#pragma unroll
                    for (int n = 0; n < 2; ++n) { const int col = colb + bj * 128 + n * 16;
                        *(f32x4*)(x1out + (size_t)row * 1024 + col) = *(const f32x4*)(base + col) + *(const f32x4*)(gr + col) * acc[ai][bj][m][n]; } }
    }
};
struct Up {
    static constexpr bool PERM = true, AFTER_DRAIN = false;
    unsigned char* ws; float* out;
    __device__ __forceinline__ void operator()(const f32x4 (&acc)[2][2][4][2], const Unit& u, int wr, int wc, int fr, int fq) const {
        const int rowb = u.pm * 256 + wr * 64 + fr, colb = u.pn * 256 + wc * 32 + 8 * fq;
        bf16* U = (bf16*)(ws + WS_U);
#pragma unroll
        for (int ai = 0; ai < 2; ++ai)
#pragma unroll
            for (int m = 0; m < 4; ++m) { const int row = rowb + ai * 128 + m * 16;
                float* fo = nullptr;
                if (row < MP) { const int t = row & 4095; if (t >= 4094) fo = out + O_FFNP + ((size_t)(row >> 12) * 2 + (t - 4094)) * DFF2; }
                else if (row < MALL) fo = out + O_FFNS + ((size_t)(row - MP) * 2 + 1) * DFF2;
#pragma unroll
                for (int bj = 0; bj < 2; ++bj) { const int col = colb + bj * 128;
                    *(u32x4*)(U + (size_t)row * DFF2 + col) = pack8(acc[ai][bj][m][0], acc[ai][bj][m][1]);
                    if (fo) { *(f32x4*)(fo + col) = acc[ai][bj][m][0]; *(f32x4*)(fo + col + 4) = acc[ai][bj][m][1]; } } }
    }
};
}
__device__ __forceinline__ void conv_prompt_item(const Args& args, int item, int lane) {
    unsigned char* ws = args.ws;
    const int tg = item / 48, cgp = item % 48, cg = lane & 7, rg = lane >> 3;
    const int m0 = tg * 64 + 8 * rg, b = m0 >> 12, t0 = m0 & 4095, ch0 = cgp * 64 + 8 * cg;
    const bf16* X = (const bf16*)(ws + WS_XBC);
    float x[11][8];
#pragma unroll
    for (int i = 0; i < 11; ++i) {
        const int t = t0 - 3 + i;
        u32x4 v = (u32x4){0u, 0u, 0u, 0u};
        if (t >= 0) v = *(const u32x4*)(X + (size_t)(m0 - 3 + i) * CONVD + ch0);
        x[i][0] = bflo(v.x); x[i][1] = bfhi(v.x); x[i][2] = bflo(v.y); x[i][3] = bfhi(v.y); x[i][4] = bflo(v.z); x[i][5] = bfhi(v.z); x[i][6] = bflo(v.w); x[i][7] = bfhi(v.w);
    }
    const float* cw = INF(16); const float* cb = INF(17);
    float w[4][8], bias[8];
#pragma unroll
    for (int k = 0; k < 4; ++k) { const f32x4 a = *(const f32x4*)(cw + k * CONVD + ch0), c = *(const f32x4*)(cw + k * CONVD + ch0 + 4);
        w[k][0] = a.x; w[k][1] = a.y; w[k][2] = a.z; w[k][3] = a.w; w[k][4] = c.x; w[k][5] = c.y; w[k][6] = c.z; w[k][7] = c.w; }
    { const f32x4 a = *(const f32x4*)(cb + ch0), c = *(const f32x4*)(cb + ch0 + 4); bias[0] = a.x; bias[1] = a.y; bias[2] = a.z; bias[3] = a.w; bias[4] = c.x; bias[5] = c.y; bias[6] = c.z; bias[7] = c.w; }
    float y[8][8];
#pragma unroll
    for (int i = 0; i < 8; ++i)
#pragma unroll
        for (int c = 0; c < 8; ++c) { const float a = bias[c] + w[0][c] * x[i][c] + w[1][c] * x[i + 1][c] + w[2][c] * x[i + 2][c] + w[3][c] * x[i + 3][c]; y[i][c] = siluf(a); }
    if (cgp < 32) {
        bf16* XT = (bf16*)(ws + WS_XT) + ((size_t)(b * 32 + cgp) * 64 + 8 * cg) * 4096 + t0;
#pragma unroll
        for (int c = 0; c < 8; ++c) { u32x4 o; o.x = pk2(y[0][c], y[1][c]); o.y = pk2(y[2][c], y[3][c]); o.z = pk2(y[4][c], y[5][c]); o.w = pk2(y[6][c], y[7][c]); *(u32x4*)(XT + (size_t)c * 4096) = o; }
    } else {
        const int isC = cgp >= 40, gg = ((cgp - 32) & 7) >> 1, n0 = ((cgp - 32) & 1) * 64 + 8 * cg;
        bf16* N = (bf16*)(ws + (isC ? WS_CN : WS_BN)) + ((size_t)(b * 4 + gg) * 4096 + t0) * 128 + n0;
#pragma unroll
        for (int i = 0; i < 8; ++i) { u32x4 o; o.x = pk2(y[i][0], y[i][1]); o.y = pk2(y[i][2], y[i][3]); o.z = pk2(y[i][4], y[i][5]); o.w = pk2(y[i][6], y[i][7]); *(u32x4*)(N + (size_t)i * 128) = o; }
        if (!isC) {
            bf16* BT = (bf16*)(ws + WS_BT) + ((size_t)(b * 4 + gg) * 128 + n0) * 4096 + t0;
#pragma unroll
            for (int c = 0; c < 8; ++c) { u32x4 o; o.x = pk2(y[0][c], y[1][c]); o.y = pk2(y[2][c], y[3][c]); o.z = pk2(y[4][c], y[5][c]); o.w = pk2(y[6][c], y[7][c]); *(u32x4*)(BT + (size_t)c * 4096) = o; }
        }
    }
}
__device__ __forceinline__ void dtcs_item(const Args& args, int item, int lane) {
    unsigned char* ws = args.ws;
    const int c = item & 31, h = (item >> 5) & 31, b = item >> 10;
    const float* MISC = (const float*)(ws + WS_MISC);
    const float bias = INF(18)[h], a = -__expf(INF(19)[h]);
    const int t = c * 128 + 2 * lane; const size_t m = (size_t)b * 4096 + t;
    const float d0 = softplusf(MISC[m * 128 + h] + bias), d1 = softplusf(MISC[(m + 1) * 128 + h] + bias);
    const float a0 = d0 * a, a1 = d1 * a;
    float s = a0 + a1;
#pragma unroll
    for (int o = 1; o < 64; o <<= 1) { const float v = __shfl_up(s, o); if (lane >= o) s += v; }
    const float c1 = s, c0 = s - a1;
    float* DT = (float*)(ws + WS_DT) + (size_t)(b * 32 + h) * 4096 + t; float* CS = (float*)(ws + WS_CS) + (size_t)(b * 32 + h) * 4096 + t;
    *(f32x2*)DT = (f32x2){d0, d1}; *(f32x2*)CS = (f32x2){c0, c1};
}
__device__ __forceinline__ void sample_conv(const Args& args, int gt, int NGT) {
    unsigned char* ws = args.ws; float* out = args.out;
    const float* st = INF(8); const float* cw = INF(16); const float* cb = INF(17);
    for (int i = gt; i < MS * CONVD; i += NGT) {
        const int bs = i / CONVD, ch = i % CONVD;
        const float s0 = st[((size_t)bs * 3 + 0) * CONVD + ch], s1 = st[((size_t)bs * 3 + 1) * CONVD + ch], s2 = st[((size_t)bs * 3 + 2) * CONVD + ch];
        const float xn = out[O_CONVS + ((size_t)bs * 3 + 2) * CONVD + ch];
        out[O_CONVS + ((size_t)bs * 3 + 0) * CONVD + ch] = s1; out[O_CONVS + ((size_t)bs * 3 + 1) * CONVD + ch] = s2;
        const float a = cb[ch] + cw[ch] * s0 + cw[CONVD + ch] * s1 + cw[2 * CONVD + ch] * s2 + cw[3 * CONVD + ch] * xn;
        ((float*)(ws + WS_XCS))[i] = siluf(a);
    }
    for (int i = gt; i < MS * NH; i += NGT) { const int bs = i >> 5, h = i & 31;
        ((float*)(ws + WS_DTS))[i] = softplusf(((const float*)(ws + WS_MISC))[(size_t)(MP + bs) * 128 + h] + INF(18)[h]); }
}

__device__ __forceinline__ void ssd_states_unit(const Args& args, LAS unsigned char* lds, int unit, int wave, int lane) {
    unsigned char* ws = args.ws;
    const int g = unit & 3, c = (unit >> 2) & 31, b = unit >> 7, h = g * 8 + wave, q = lane >> 4, r16 = lane & 15;
    LAS float* wl = (LAS float*)(lds + wave * 512);
    const float* DT = (const float*)(ws + WS_DT) + (size_t)(b * 32 + h) * 4096 + c * 128; const float* CS = (const float*)(ws + WS_CS) + (size_t)(b * 32 + h) * 4096 + c * 128;
    const float cl = CS[127];
    wl[lane] = DT[lane] * __expf(cl - CS[lane]); wl[lane + 64] = DT[lane + 64] * __expf(cl - CS[lane + 64]);
    LDS_WAIT(); asm volatile("" ::: "memory");
    const bf16* XT = (const bf16*)(ws + WS_XT) + (size_t)(b * 32 + h) * 64 * 4096 + c * 128;
    const bf16* BT = (const bf16*)(ws + WS_BT) + (size_t)(b * 4 + g) * 128 * 4096 + c * 128;
    float* ST = (float*)(ws + WS_STATES) + (((size_t)(b * 32 + c) * 32 + h) * 64) * 128;
#pragma unroll 1
    for (int nh = 0; nh < 2; ++nh) {
        f32x4 acc[4][4];
#pragma unroll
        for (int i = 0; i < 4; ++i)
#pragma unroll
            for (int j = 0; j < 4; ++j) acc[i][j] = (f32x4){0.f, 0.f, 0.f, 0.f};
#pragma unroll 1
        for (int ks = 0; ks < 4; ++ks) {
            const int s0 = 32 * ks + 8 * q;
            const f32x4 w0 = *(const LAS f32x4*)(wl + s0), w1 = *(const LAS f32x4*)(wl + s0 + 4);
            bf16x8 af[4];
#pragma unroll
            for (int pt = 0; pt < 4; ++pt) { const u32x4 v = *(const u32x4*)(XT + (size_t)(16 * pt + r16) * 4096 + s0);
                u32x4 o; o.x = pk2(bflo(v.x) * w0.x, bfhi(v.x) * w0.y); o.y = pk2(bflo(v.y) * w0.z, bfhi(v.y) * w0.w); o.z = pk2(bflo(v.z) * w1.x, bfhi(v.z) * w1.y); o.w = pk2(bflo(v.w) * w1.z, bfhi(v.w) * w1.w);
                af[pt] = __builtin_bit_cast(bf16x8, o); }
#pragma unroll
            for (int nt = 0; nt < 4; ++nt) { const bf16x8 bf = *(const bf16x8*)(BT + (size_t)(64 * nh + 16 * nt + r16) * 4096 + s0);
#pragma unroll
                for (int pt = 0; pt < 4; ++pt) acc[pt][nt] = MFMA16(af[pt], bf, acc[pt][nt]); }
        }
#pragma unroll
        for (int pt = 0; pt < 4; ++pt)
#pragma unroll
            for (int nt = 0; nt < 4; ++nt)
#pragma unroll
                for (int r = 0; r < 4; ++r) ST[(size_t)(16 * pt + 4 * q + r) * 128 + 64 * nh + 16 * nt + r16] = acc[pt][nt][r];
    }
}

template <int SAMPLE>
__device__ __forceinline__ void compress2_item(const Args& args, int item, int lane) {
    unsigned char* ws = args.ws;
    const int q = lane >> 4, r16 = lane & 15;
    constexpr int NPB = SAMPLE ? 128 : 256;
    constexpr int NI = (SAMPLE ? 65536 : 4096) / 16;
    const int st = item / NI, row0 = (item % NI) * 16;
    const float* P = (const float*)(ws + (SAMPLE ? (st ? WS_PARTSV : WS_PARTSK) : (st ? WS_PARTV : WS_PARTK))) + (size_t)(row0 + r16) * 256;
    const float* pet = (const float*)(ws + WS_PET) + st * 128;
    const bf16* W2T = (const bf16*)(ws + WS_W2T) + st * 8192;
    f32x4 acc[4];
#pragma unroll
    for (int dt = 0; dt < 4; ++dt) acc[dt] = (f32x4){0.f, 0.f, 0.f, 0.f};
#pragma unroll
    for (int ks = 0; ks < 4; ++ks) {
        const int e0 = 32 * ks + 8 * q;
        const f32x4 a0 = *(const f32x4*)(P + e0), a1 = *(const f32x4*)(P + e0 + 4), b0 = *(const f32x4*)(P + 256 + 128 + e0), b1 = *(const f32x4*)(P + 256 + 128 + e0 + 4);
        const f32x4 p0 = *(const f32x4*)(pet + e0), p1 = *(const f32x4*)(pet + e0 + 4);
        const f32x4 h0 = a0 + b0 + p0, h1 = a1 + b1 + p1;
        u32x4 o; o.x = pk2(siluf(h0.x), siluf(h0.y)); o.y = pk2(siluf(h0.z), siluf(h0.w)); o.z = pk2(siluf(h1.x), siluf(h1.y)); o.w = pk2(siluf(h1.z), siluf(h1.w));
        const bf16x8 af = __builtin_bit_cast(bf16x8, o);
#pragma unroll
        for (int dt = 0; dt < 4; ++dt) { const bf16x8 bf = *(const bf16x8*)(W2T + (size_t)(16 * dt + r16) * 128 + e0); acc[dt] = MFMA16(af, bf, acc[dt]); }
    }
    const int bh = row0 / NPB, n0 = row0 % NPB + 4 * q;
#pragma unroll
    for (int dt = 0; dt < 4; ++dt) {
        const int d = 16 * dt + r16;
        float v[4];
#pragma unroll
        for (int r = 0; r < 4; ++r) v[r] = (n0 + r < NPB - 1) ? acc[dt][r] : 0.f;
        if (SAMPLE) {
            float* o = (float*)(ws + (st ? WS_VCS : WS_KCS)) + ((size_t)bh * 128 + n0) * 64 + d;
#pragma unroll
            for (int r = 0; r < 4; ++r) o[r * 64] = v[r];
        } else if (st == 0) {
            bf16* o = (bf16*)(ws + WS_KC) + ((size_t)bh * 256 + n0) * 64 + d;
#pragma unroll
            for (int r = 0; r < 4; ++r) o[r * 64] = (bf16)f2bf(v[r]);
        } else {
            u32x2 w; w.x = pk2(v[0], v[1]); w.y = pk2(v[2], v[3]);
            *(u32x2*)((bf16*)(ws + WS_VCT) + ((size_t)bh * 64 + d) * 256 + n0) = w;
        }
    }
}

__device__ __forceinline__ void sample_ssm_item(const Args& args, LAS unsigned char* lds, int item, int wave, int lane) {
    unsigned char* ws = args.ws; float* out = args.out;
    const int h = item & 31, bs = item >> 5, g = h >> 3;
    const float* XC = (const float*)(ws + WS_XCS) + (size_t)bs * CONVD;
    const float dt = ((const float*)(ws + WS_DTS))[bs * 32 + h], a = -__expf(INF(19)[h]), dec = __expf(dt * a), Dh = INF(20)[h];
    const f32x2 Bv = *(const f32x2*)(XC + 2048 + g * 128 + 2 * lane), Cv = *(const f32x2*)(XC + 2560 + g * 128 + 2 * lane);
    const float xl = XC[h * 64 + lane];
    const float* H0 = INF(7) + ((size_t)(bs * 32 + h) * 64) * 128; float* HN = out + O_SSMS + ((size_t)(bs * 32 + h) * 64) * 128;
    float ymine = 0.f;
#pragma unroll 8
    for (int p = 0; p < 64; ++p) {
        const float xp = __shfl(xl, p);
        const f32x2 h0 = *(const f32x2*)(H0 + p * 128 + 2 * lane);
        f32x2 hn; hn.x = h0.x * dec + dt * xp * Bv.x; hn.y = h0.y * dec + dt * xp * Bv.y;
        *(f32x2*)(HN + p * 128 + 2 * lane) = hn;
        const float yp = wave_sum(hn.x * Cv.x + hn.y * Cv.y);
        ymine = (lane == p) ? yp : ymine;
    }
    const float y = ymine + Dh * xl;
    const size_t m = MP + bs;
    const float z = bf2f(((const bf16*)(ws + WS_Z))[m * 2048 + h * 64 + lane]);
    const float v = y * siluf(z);
    ((bf16*)(ws + WS_YSSM))[m * 2048 + h * 64 + lane] = (bf16)f2bf(v * INF(21)[h * 64 + lane]);
    const float ss = wave_sum(v * v);
    if (lane == 0) ((float*)(ws + WS_MISC))[m * 128 + 80 + h] = ss;
}
__device__ __forceinline__ void scan_phase(const Args& args, int gt, int NGT) {
    unsigned char* ws = args.ws; float* out = args.out;
    for (int i = gt; i < 4 * 32 * 64 * 32; i += NGT) {
        const int n4 = i & 31, p = (i >> 5) & 63, h = (i >> 11) & 31, b = i >> 16;
        const float* CS = (const float*)(ws + WS_CS) + (size_t)(b * 32 + h) * 4096;
        f32x4 run = (f32x4){0.f, 0.f, 0.f, 0.f};
#pragma unroll 4
        for (int c = 0; c < 32; ++c) {
            const size_t off = ((((size_t)(b * 32 + c) * 32 + h) * 64 + p) * 128) + 4 * n4;
            const f32x4 st = *(const f32x4*)((const float*)(ws + WS_STATES) + off);
            u32x2 o; o.x = pk2(run.x, run.y); o.y = pk2(run.z, run.w);
            *(u32x2*)((bf16*)(ws + WS_HPREV) + off) = o;
            const float dec = __expf(CS[c * 128 + 127]);
            run = run * dec + st;
        }
        *(f32x4*)(out + O_SSMP + (((size_t)(b * 32 + h) * 64 + p) * 128) + 4 * n4) = run;
    }
    for (int i = gt; i < MS * 4; i += NGT) { const int bs = i >> 2, g = i & 3; const float* p = (const float*)(ws + WS_MISC) + (size_t)(MP + bs) * 128 + 80 + g * 8;
        ((float*)(ws + WS_SSQ))[(size_t)(MP + bs) * 4 + g] = ((p[0] + p[1]) + (p[2] + p[3])) + ((p[4] + p[5]) + (p[6] + p[7])); }
}

__device__ __forceinline__ void ssd_out_unit(const Args& args, LAS unsigned char* lds, int unit, int wave, int lane, int tid) {
    unsigned char* ws = args.ws;
    const int g = unit & 3, c = (unit >> 2) & 31, b = unit >> 7, h = g * 8 + wave, q = lane >> 4, r16 = lane & 15;
    LAS float* CBT = (LAS float*)lds; LAS float* SQ = (LAS float*)(lds + 65536);
    const bf16* Bn = (const bf16*)(ws + WS_BN) + ((size_t)(b * 4 + g) * 4096 + c * 128) * 128;
    const bf16* Cn = (const bf16*)(ws + WS_CN) + ((size_t)(b * 4 + g) * 4096 + c * 128) * 128;
    {
        bf16x8 af[4];
#pragma unroll
        for (int ks = 0; ks < 4; ++ks) af[ks] = *(const bf16x8*)(Bn + (size_t)(16 * wave + r16) * 128 + 32 * ks + 8 * q);
        for (int lt = wave; lt < 8; ++lt) {
            f32x4 d = (f32x4){0.f, 0.f, 0.f, 0.f};
#pragma unroll
            for (int ks = 0; ks < 4; ++ks) { const bf16x8 bf = *(const bf16x8*)(Cn + (size_t)(16 * lt + r16) * 128 + 32 * ks + 8 * q); d = MFMA16(af[ks], bf, d); }
#pragma unroll
            for (int r = 0; r < 4; ++r) CBT[((wave * 8 + lt) * 4 + r) * 64 + lane] = d[r];
        }
    }
    __syncthreads();
    const float* DT = (const float*)(ws + WS_DT) + (size_t)(b * 32 + h) * 4096 + c * 128; const float* CS = (const float*)(ws + WS_CS) + (size_t)(b * 32 + h) * 4096 + c * 128;
    const float Dh = INF(20)[h];
    const bf16* HP = (const bf16*)(ws + WS_HPREV) + (((size_t)(b * 32 + c) * 32 + h) * 64) * 128;
    const bf16* XT = (const bf16*)(ws + WS_XT) + (size_t)(b * 32 + h) * 64 * 4096 + c * 128;
    const bf16* Z = (const bf16*)(ws + WS_Z); bf16* Y = (bf16*)(ws + WS_YSSM); const float* nw = INF(21) + h * 64;
#pragma unroll
    for (int hl = 0; hl < 2; ++hl) {
        float csl[4];
#pragma unroll
        for (int lt = 0; lt < 4; ++lt) csl[lt] = CS[64 * hl + 16 * lt + r16];
        f32x4 acc[4][4];
#pragma unroll
        for (int i = 0; i < 4; ++i)
#pragma unroll
            for (int j = 0; j < 4; ++j) acc[i][j] = (f32x4){0.f, 0.f, 0.f, 0.f};
#pragma unroll 1
        for (int ks = 0; ks < 4; ++ks) {
            bf16x8 af[4];
#pragma unroll
            for (int pt = 0; pt < 4; ++pt) af[pt] = *(const bf16x8*)(HP + (size_t)(16 * pt + r16) * 128 + 32 * ks + 8 * q);
#pragma unroll
            for (int lt = 0; lt < 4; ++lt) { const bf16x8 bf = *(const bf16x8*)(Cn + (size_t)(64 * hl + 16 * lt + r16) * 128 + 32 * ks + 8 * q);
#pragma unroll
                for (int pt = 0; pt < 4; ++pt) acc[pt][lt] = MFMA16(af[pt], bf, acc[pt][lt]); }
        }
#pragma unroll
        for (int lt = 0; lt < 4; ++lt) { const float e = __expf(csl[lt]);
#pragma unroll
            for (int pt = 0; pt < 4; ++pt) acc[pt][lt] = acc[pt][lt] * e; }
#pragma unroll
        for (int i = 0; i < 2 * hl + 2; ++i) {
            const int sa = 32 * i + 4 * q, sb = sa + 16;
            const f32x4 csa = *(const f32x4*)(CS + sa), csb = *(const f32x4*)(CS + sb), dta = *(const f32x4*)(DT + sa), dtb = *(const f32x4*)(DT + sb);
            bf16x8 af[4];
#pragma unroll
            for (int pt = 0; pt < 4; ++pt) { const u32x2 lo = *(const u32x2*)(XT + (size_t)(16 * pt + r16) * 4096 + sa), hi = *(const u32x2*)(XT + (size_t)(16 * pt + r16) * 4096 + sb);
                af[pt] = __builtin_bit_cast(bf16x8, (u32x4){lo.x, lo.y, hi.x, hi.y}); }
#pragma unroll
            for (int lt = 0; lt < 4; ++lt) {
                const int LT = 4 * hl + lt;
                if (LT < 2 * i) continue;
                const int l = 16 * LT + r16;
                float ga[4], gb[4];
#pragma unroll
                for (int r = 0; r < 4; ++r) {
                    const float va = CBT[(((2 * i) * 8 + LT) * 4 + r) * 64 + lane];
                    const float vb = (LT >= 2 * i + 1) ? CBT[(((2 * i + 1) * 8 + LT) * 4 + r) * 64 + lane] : 0.f;
                    const int s1 = sa + r, s2 = sb + r;
                    float x1 = (l >= s1) ? va * __expf(csl[lt] - csa[r]) * dta[r] : 0.f;
                    float x2 = (l >= s2) ? vb * __expf(csl[lt] - csb[r]) * dtb[r] : 0.f;
                    if (l == s1) x1 += Dh;
                    if (l == s2) x2 += Dh;
                    ga[r] = x1; gb[r] = x2;
                }
                u32x4 o; o.x = pk2(ga[0], ga[1]); o.y = pk2(ga[2], ga[3]); o.z = pk2(gb[0], gb[1]); o.w = pk2(gb[2], gb[3]);
                const bf16x8 bf = __builtin_bit_cast(bf16x8, o);
#pragma unroll
                for (int pt = 0; pt < 4; ++pt) acc[pt][lt] = MFMA16(af[pt], bf, acc[pt][lt]);
            }
        }
#pragma unroll
        for (int lt = 0; lt < 4; ++lt) {
            const size_t m = (size_t)b * 4096 + c * 128 + 64 * hl + 16 * lt + r16;
            float ss = 0.f;
#pragma unroll
            for (int pt = 0; pt < 4; ++pt) {
                const int ch = 16 * pt + 4 * q;
                const u32x2 zz = *(const u32x2*)(Z + m * 2048 + h * 64 + ch); const f32x4 w = *(const f32x4*)(nw + ch);
                const float v0 = acc[pt][lt][0] * siluf(bflo(zz.x)), v1 = acc[pt][lt][1] * siluf(bfhi(zz.x)), v2 = acc[pt][lt][2] * siluf(bflo(zz.y)), v3 = acc[pt][lt][3] * siluf(bfhi(zz.y));
                ss += (v0 * v0 + v1 * v1) + (v2 * v2 + v3 * v3);
                u32x2 o; o.x = pk2(v0 * w.x, v1 * w.y); o.y = pk2(v2 * w.z, v3 * w.w);
                *(u32x2*)(Y + m * 2048 + h * 64 + ch) = o;
            }
            ss += __shfl_xor(ss, 16); ss += __shfl_xor(ss, 32);
            if (q == 0) SQ[wave * 128 + 64 * hl + 16 * lt + r16] = ss;
        }
    }
    __syncthreads();
    if (tid < 128) { float s = 0.f;
#pragma unroll
        for (int w = 0; w < 8; ++w) s += SQ[w * 128 + tid];
        ((float*)(ws + WS_SSQ))[((size_t)b * 4096 + c * 128 + tid) * 4 + g] = s; }
    __syncthreads();
}
constexpr float SC2 = 0.125f * 1.4426950408889634f;
template <class T> __device__ __forceinline__ T ldu(const void* ubase, unsigned lane_off) { return *(const T*)((const char*)ubase + lane_off); }
template <int MODE>
__device__ __forceinline__ void flash_block(const bf16* Kp, const bf16* VTp, int jb, int t0, int t, bool selbit, const LAS bf16x8* Qs,
                                            f32x4 (&O)[4][4], float (&mx)[4], float (&ls)[4], int q, int r16) {
    const unsigned koff = (unsigned)(r16 * 64 + 8 * q) * 2u, voff = (unsigned)(r16 * 4096 + 4 * q) * 2u;
#pragma unroll
    for (int pr = 0; pr < 2; ++pr) {
        const int kb = 64 * jb + 32 * pr;
        const bool edge = (kb + 31 > t0) || (MODE == 1 && kb + 512 <= t0 + 15);
        bf16x8 kf[2][2], vf[4];
#pragma unroll
        for (int kt = 0; kt < 2; ++kt) { const bf16* kr = Kp + (size_t)(kb + 16 * kt) * 64; kf[kt][0] = ldu<bf16x8>(kr, koff); kf[kt][1] = ldu<bf16x8>(kr + 32, koff); }
#pragma unroll
        for (int dt = 0; dt < 4; ++dt) { const bf16* vr = VTp + (size_t)(16 * dt) * 4096 + kb;
            const u32x2 lo = ldu<u32x2>(vr, voff), hi = ldu<u32x2>(vr + 16, voff); vf[dt] = __builtin_bit_cast(bf16x8, (u32x4){lo.x, lo.y, hi.x, hi.y}); }
#pragma unroll
        for (int g = 0; g < 4; ++g) {
            asm volatile("" ::: "memory");
            const bf16x8 q0 = Qs[(g * 2 + 0) * 64], q1 = Qs[(g * 2 + 1) * 64];
            f32x4 S0 = MFMA16(kf[0][0], q0, ((f32x4){0.f, 0.f, 0.f, 0.f})), S1 = MFMA16(kf[1][0], q0, ((f32x4){0.f, 0.f, 0.f, 0.f}));
            S0 = MFMA16(kf[0][1], q1, S0); S1 = MFMA16(kf[1][1], q1, S1);
            float s[8];
#pragma unroll
            for (int r = 0; r < 4; ++r) { s[r] = S0[r]; s[4 + r] = S1[r]; }
            if (edge) {
#pragma unroll
                for (int i = 0; i < 8; ++i) { const int key = kb + 16 * (i >> 2) + 4 * q + (i & 3);
                    const bool ok = (MODE == 0) ? (key <= t) : (key <= t && key + 512 > t); s[i] = ok ? s[i] : NEGF; }
            }
            if (MODE == 0) {
#pragma unroll
                for (int i = 0; i < 8; ++i) s[i] = selbit ? s[i] : NEGF;
            }
            const float lm = fmaxf(fmaxf(fmaxf(s[0], s[1]), fmaxf(s[2], s[3])), fmaxf(fmaxf(s[4], s[5]), fmaxf(s[6], s[7]))) * SC2;
            if (__builtin_amdgcn_ballot_w64(lm > mx[g] + 8.f) != 0ull) {
                float tmax = fmaxf(lm, __shfl_xor(lm, 16)); tmax = fmaxf(tmax, __shfl_xor(tmax, 32));
                const float mnew = fmaxf(mx[g], tmax), alpha = __builtin_amdgcn_exp2f(mx[g] - mnew); mx[g] = mnew; ls[g] = ls[g] * alpha;
#pragma unroll
                for (int dt = 0; dt < 4; ++dt) O[dt][g] = O[dt][g] * alpha;
            }
            const float nmuse = -fmaxf(mx[g], -1e20f);
            float psum = 0.f;
#pragma unroll
            for (int i = 0; i < 8; ++i) { s[i] = __builtin_amdgcn_exp2f(__builtin_fmaf(s[i], SC2, nmuse)); psum += s[i]; }
            u32x4 pw; pw.x = pk2(s[0], s[1]); pw.y = pk2(s[2], s[3]); pw.z = pk2(s[4], s[5]); pw.w = pk2(s[6], s[7]);
            const bf16x8 pf = __builtin_bit_cast(bf16x8, pw);
            ls[g] += psum;
#pragma unroll
            for (int dt = 0; dt < 4; ++dt) O[dt][g] = MFMA16(vf[dt], pf, O[dt][g]);
        }
    }
}

template <int BR>
__device__ __forceinline__ void attn_finish(const Args& args, f32x4 (&O)[4][4], const float (&ls)[4], bool normalise, size_t m, int hkv, int q) {
    unsigned char* ws = args.ws;
    const float* gates = (const float*)(ws + WS_MISC) + m * 128 + 32;
    const unsigned yoff = (unsigned)((m & 15) * 1024 + 4 * q) * 4u, yboff = yoff >> 1;
#pragma unroll
    for (int g = 0; g < 4; ++g) {
        float sc = sigmf(gates[(hkv * 4 + g) * 3 + BR]);
        if (normalise) { float L = ls[g]; L += __shfl_xor(L, 16); L += __shfl_xor(L, 32); sc *= 1.f / fmaxf(L, TINYF); }
#pragma unroll
        for (int dt = 0; dt < 4; ++dt) {
            char* yfu = (char*)((float*)(ws + WS_YATTF) + (m & ~(size_t)15) * 1024 + (hkv * 4 + g) * 64 + 16 * dt);
            f32x4 v = O[dt][g] * sc;
            if (BR > 0) v = v + *(const f32x4*)(yfu + yoff);
            if (BR < 2) *(f32x4*)(yfu + yoff) = v;
            else { u32x2 o; o.x = pk2(v.x, v.y); o.y = pk2(v.z, v.w); *(u32x2*)((char*)((bf16*)(ws + WS_YATT) + (m & ~(size_t)15) * 1024 + (hkv * 4 + g) * 64 + 16 * dt) + yboff) = o; }
        }
    }
}

__device__ __forceinline__ void attn_prompt_unit(const Args& args, LAS float* impL, int unit, int lane) {
    unsigned char* ws = args.ws;
    const int q = lane >> 4, r16 = lane & 15;
    const int bh = unit & 15, b = bh >> 2, hkv = bh & 3;
    const int tile = unit < 2048 ? 255 - (unit >> 4) : (unit - 2048) >> 4;
    const int t0 = tile * 16, t = t0 + r16; const size_t m = (size_t)b * 4096 + t;
    LAS bf16x8* Qs = (LAS bf16x8*)(impL + 1024) + lane;
#pragma unroll
    for (int g = 0; g < 4; ++g)
#pragma unroll
        for (int ks = 0; ks < 2; ++ks) Qs[(g * 2 + ks) * 64] = ldu<bf16x8>((const bf16*)(ws + WS_Q) + ((size_t)b * 4096 + t0) * 1024 + (hkv * 4 + g) * 64 + 32 * ks, (unsigned)(r16 * 1024 + 8 * q) * 2u);
    LDS_WAIT(); asm volatile("" ::: "memory");
    f32x4 O[4][4]; float mx[4], ls[4];
    const bf16* KCp = (const bf16*)(ws + WS_KC) + (size_t)bh * 256 * 64; const bf16* VCTp = (const bf16*)(ws + WS_VCT) + (size_t)bh * 64 * 256;
    const unsigned kcoff = (unsigned)(r16 * 64 + 8 * q) * 2u, vcoff = (unsigned)(r16 * 256 + 4 * q) * 2u;
    const int nmax = (t0 + 15 >= 31) ? ((t0 + 15 - 31) >> 4) : -1;
    const int NP = nmax < 0 ? 0 : (nmax / 32 + 2 < 8 ? nmax / 32 + 2 : 8);
#pragma unroll
    for (int g = 0; g < 4; ++g) { mx[g] = NEGF; ls[g] = 0.f; }
    for (int kt = 0; kt < 2 * NP; ++kt) {
        const bf16* kr = KCp + (size_t)(16 * kt) * 64;
        const bf16x8 k0 = ldu<bf16x8>(kr, kcoff), k1 = ldu<bf16x8>(kr + 32, kcoff);
#pragma unroll
        for (int g = 0; g < 4; ++g) {
            f32x4 s = MFMA16(k0, Qs[(g * 2 + 0) * 64], ((f32x4){0.f, 0.f, 0.f, 0.f})); s = MFMA16(k1, Qs[(g * 2 + 1) * 64], s);
            float tmax = NEGF;
#pragma unroll
            for (int r = 0; r < 4; ++r) { const int n = 16 * kt + 4 * q + r; const bool ok = (16 * n + 31 <= t); s[r] = ok ? s[r] * 0.125f : NEGF; tmax = fmaxf(tmax, s[r]); }
            const float mnew = fmaxf(mx[g], tmax); float ps = 0.f;
#pragma unroll
            for (int r = 0; r < 4; ++r) ps += (s[r] > 0.5f * NEGF) ? __expf(s[r] - mnew) : 0.f;
            ls[g] = ls[g] * __expf(mx[g] - mnew) + ps; mx[g] = mnew;
        }
    }
    float invL[4];
#pragma unroll
    for (int g = 0; g < 4; ++g) {
        float M = fmaxf(mx[g], __shfl_xor(mx[g], 16)); M = fmaxf(M, __shfl_xor(M, 32));
        float l = ls[g] * __expf(mx[g] - M); l += __shfl_xor(l, 16); l += __shfl_xor(l, 32);
        mx[g] = M; invL[g] = 1.f / fmaxf(l, TINYF);
    }
#pragma unroll
    for (int dt = 0; dt < 4; ++dt)
#pragma unroll
        for (int g = 0; g < 4; ++g) O[dt][g] = (f32x4){0.f, 0.f, 0.f, 0.f};
    float prev3 = 0.f;
#pragma unroll
    for (int kt = 0; kt < 16; ++kt) impL[kt * 64 + lane] = 0.f;
#pragma unroll 1
    for (int i = 0; i < NP; ++i) {
        f32x4 P[2][4];
#pragma unroll
        for (int kk = 0; kk < 2; ++kk) {
            const int kt = 2 * i + kk;
            const bf16* kr = KCp + (size_t)(16 * kt) * 64;
            const bf16x8 k0 = ldu<bf16x8>(kr, kcoff), k1 = ldu<bf16x8>(kr + 32, kcoff);
            f32x4 psum = (f32x4){0.f, 0.f, 0.f, 0.f};
#pragma unroll
            for (int g = 0; g < 4; ++g) {
                f32x4 s = MFMA16(k0, Qs[(g * 2 + 0) * 64], ((f32x4){0.f, 0.f, 0.f, 0.f})); s = MFMA16(k1, Qs[(g * 2 + 1) * 64], s);
#pragma unroll
                for (int r = 0; r < 4; ++r) { const int n = 16 * kt + 4 * q + r; const bool ok = (16 * n + 31 <= t); s[r] = ok ? __expf(s[r] * 0.125f - mx[g]) * invL[g] : 0.f; }
                P[kk][g] = s; psum = psum + s;
            }
            const float a = __shfl(psum[3], (lane + 48) & 63), bb = __shfl(prev3, (lane + 48) & 63);
            impL[kt * 64 + lane] = 2.f * (psum[0] + psum[1] + psum[2]) + psum[3] + (q > 0 ? a : bb);
            prev3 = psum[3];
        }
        bf16x8 vf[4];
#pragma unroll
        for (int dt = 0; dt < 4; ++dt) { const bf16* vr = VCTp + (size_t)(16 * dt) * 256 + 32 * i;
            const u32x2 lo = ldu<u32x2>(vr, vcoff), hi = ldu<u32x2>(vr + 16, vcoff); vf[dt] = __builtin_bit_cast(bf16x8, (u32x4){lo.x, lo.y, hi.x, hi.y}); }
#pragma unroll
        for (int g = 0; g < 4; ++g) {
            u32x4 pw; pw.x = pk2(P[0][g][0], P[0][g][1]); pw.y = pk2(P[0][g][2], P[0][g][3]); pw.z = pk2(P[1][g][0], P[1][g][1]); pw.w = pk2(P[1][g][2], P[1][g][3]);
            const bf16x8 pf = __builtin_bit_cast(bf16x8, pw);
#pragma unroll
            for (int dt = 0; dt < 4; ++dt) O[dt][g] = MFMA16(vf[dt], pf, O[dt][g]);
        }
    }
    attn_finish<0>(args, O, ls, false, m, hkv, q);
    unsigned mlo = 0u, mhi = 0u;
    {
        const int cur = t >> 6;
        LDS_WAIT(); asm volatile("" ::: "memory");
        float v[16];
#pragma unroll
        for (int kt = 0; kt < 16; ++kt) { const int j = 4 * kt + q; const bool valid = (64 * j <= t), forced = (j == 0) || (j == cur) || (j == cur - 1);
            v[kt] = valid ? (forced ? BIGF : impL[kt * 64 + lane]) : -BIGF; }
#pragma unroll
        for (int kt = 0; kt < 16; ++kt) impL[kt * 64 + lane] = v[kt];
        LDS_WAIT(); asm volatile("" ::: "memory");
        int rank[16];
#pragma unroll
        for (int kt = 0; kt < 16; ++kt) rank[kt] = 0;
#pragma unroll 1
        for (int rot = 0; rot < 4; ++rot) {
#pragma unroll 2
            for (int kk = 0; kk < 16; ++kk) {
                const float o = impL[kk * 64 + (lane ^ (16 * rot))];
                const int oj = 4 * kk + (q ^ rot);
#pragma unroll
                for (int kt = 0; kt < 16; ++kt) { const int myj = 4 * kt + q; rank[kt] += ((o > v[kt]) || (o == v[kt] && oj < myj)) ? 1 : 0; }
            }
        }
#pragma unroll
        for (int kt = 0; kt < 16; ++kt) { const int j = 4 * kt + q; const unsigned bit = rank[kt] < 16 ? 1u : 0u; if (kt < 8) mlo |= bit << j; else mhi |= bit << (j - 32); }
        mlo |= __shfl_xor(mlo, 16); mlo |= __shfl_xor(mlo, 32); mhi |= __shfl_xor(mhi, 16); mhi |= __shfl_xor(mhi, 32);
    }
    unsigned ulo = mlo, uhi = mhi;
#pragma unroll
    for (int o = 1; o < 16; o <<= 1) { ulo |= __shfl_xor(ulo, o); uhi |= __shfl_xor(uhi, o); }
    ulo = __builtin_amdgcn_readfirstlane(ulo); uhi = __builtin_amdgcn_readfirstlane(uhi);
    {
#pragma unroll
        for (int g = 0; g < 4; ++g) { mx[g] = NEGF; ls[g] = 0.f; }
#pragma unroll
        for (int dt = 0; dt < 4; ++dt)
#pragma unroll
            for (int g = 0; g < 4; ++g) O[dt][g] = (f32x4){0.f, 0.f, 0.f, 0.f};
        const bf16* Kp = (const bf16*)(ws + WS_KVH) + ((size_t)(2 * 4 + b) * 4 + hkv) * 4096 * 64;
        const bf16* VTp = (const bf16*)(ws + WS_VT) + ((size_t)(0 * 4 + b) * 4 + hkv) * 64 * 4096;
        const int jend = (t0 + 15) >> 6;
        for (int jb = 0; jb <= jend; ++jb) {
            const unsigned ub = jb < 32 ? (ulo >> jb) & 1u : (uhi >> (jb - 32)) & 1u;
            if (!ub) continue;
            const bool selbit = (jb < 32 ? (mlo >> jb) & 1u : (mhi >> (jb - 32)) & 1u) != 0u;
            flash_block<0>(Kp, VTp, jb, t0, t, selbit, Qs, O, mx, ls, q, r16);
        }
        attn_finish<1>(args, O, ls, true, m, hkv, q);
    }
    {
#pragma unroll
        for (int g = 0; g < 4; ++g) { mx[g] = NEGF; ls[g] = 0.f; }
#pragma unroll
        for (int dt = 0; dt < 4; ++dt)
#pragma unroll
            for (int g = 0; g < 4; ++g) O[dt][g] = (f32x4){0.f, 0.f, 0.f, 0.f};
        const bf16* Kp = (const bf16*)(ws + WS_KVH) + ((size_t)(4 * 4 + b) * 4 + hkv) * 4096 * 64;
        const bf16* VTp = (const bf16*)(ws + WS_VT) + ((size_t)(1 * 4 + b) * 4 + hkv) * 64 * 4096;
        const int jbeg = t0 >= 511 ? (t0 - 511) >> 6 : 0, jend = (t0 + 15) >> 6;
        for (int jb = jbeg; jb <= jend; ++jb) flash_block<1>(Kp, VTp, jb, t0, t, true, Qs, O, mx, ls, q, r16);
        attn_finish<2>(args, O, ls, true, m, hkv, q);
    }
}
__device__ __forceinline__ void dot4_reduce(const float (&qv)[4], float kx, int lane, float (&sg)[4]) {
    const float v0 = qv[0] * kx, v1 = qv[1] * kx, v2 = qv[2] * kx, v3 = qv[3] * kx;
    const bool up = (lane & 32) != 0, up2 = (lane & 16) != 0;
    const float r0 = (up ? v2 : v0) + __shfl_xor(up ? v0 : v2, 32), r1 = (up ? v3 : v1) + __shfl_xor(up ? v1 : v3, 32);
    float x = (up2 ? r1 : r0) + __shfl_xor(up2 ? r0 : r1, 16);
    x += __shfl_xor(x, 8); x += __shfl_xor(x, 4); x += __shfl_xor(x, 2); x += __shfl_xor(x, 1);
    const int xi = __builtin_bit_cast(int, x);
    sg[0] = __builtin_bit_cast(float, __builtin_amdgcn_readlane(xi, 0)); sg[1] = __builtin_bit_cast(float, __builtin_amdgcn_readlane(xi, 16));
    sg[2] = __builtin_bit_cast(float, __builtin_amdgcn_readlane(xi, 32)); sg[3] = __builtin_bit_cast(float, __builtin_amdgcn_readlane(xi, 48));
}
struct SampleRows {
    const float* cache; const float* cwin; float* out; const LAS int* selblk; const LAS int* selpage; int bs, hkv, lane;
    template <int BR> __device__ __forceinline__ void load(int idx, int nrows, float& kx, float& vx) const {
        kx = 0.f; vx = 0.f;
        if (idx >= nrows) return;
        if (BR == 0) { const int k = idx >> 6; const unsigned off = (((unsigned)selpage[k] * 128u + (unsigned)((selblk[k] & 1) * 64 + (idx & 63))) * 4u + 2u) * 256u + (unsigned)(hkv * 64 + lane);
            kx = cache[off]; vx = cache[off + 256u]; }
        else { const unsigned off = (((unsigned)bs * 512u + (unsigned)(idx + 1)) * 2u) * 256u + (unsigned)(hkv * 64 + lane);
            kx = cwin[off]; vx = cwin[off + 256u]; }
    }
};
__device__ __forceinline__ void sample_row_update(const float (&qv)[4], float kx, float vx, int lane, float (&mx)[4], float (&ls)[4], float (&o)[4]) {
    float sg[4]; dot4_reduce(qv, kx, lane, sg);
#pragma unroll
    for (int g = 0; g < 4; ++g) { const float s = sg[g];
        const float mnew = fmaxf(mx[g], s), alpha = __expf(mx[g] - mnew), p = __expf(s - mnew);
        ls[g] = ls[g] * alpha + p; o[g] = o[g] * alpha + p * vx; mx[g] = mnew; }
}
template <int BR>
__device__ __forceinline__ void sample_rows_compute(const SampleRows& R, int base, int nrows, int wave, const float (&kx)[8], const float (&vx)[8], const float (&qv)[4],
                                                    float (&mx)[4], float (&ls)[4], float (&o)[4]) {
#pragma unroll
    for (int k = 0; k < 8; ++k) {
        const int idx = base + 8 * k + wave;
        if (idx < nrows) {
            if (BR == 1) { const unsigned off = (((unsigned)R.bs * 512u + (unsigned)idx) * 2u) * 256u + (unsigned)(R.hkv * 64 + R.lane); R.out[O_WINS + off] = kx[k]; R.out[O_WINS + off + 256u] = vx[k]; }
            sample_row_update(qv, kx[k], vx[k], R.lane, mx, ls, o);
        }
    }
}
template <int BR>
__device__ __forceinline__ void sample_rows_branch(const SampleRows& R, int wave, const float (&qv)[4], LAS float* pm, LAS float* pl, LAS float* po) {
    float mx[4], ls[4], o[4];
#pragma unroll
    for (int g = 0; g < 4; ++g) { mx[g] = NEGF; ls[g] = 0.f; o[g] = 0.f; }
    constexpr int nrows = BR == 0 ? 15 * 64 : 511;
    float ka[8], va[8], kb[8], vb[8];
#pragma unroll
    for (int k = 0; k < 8; ++k) R.load<BR>(8 * k + wave, nrows, ka[k], va[k]);
#pragma unroll 1
    for (int base = 0; base < nrows; base += 128) {
#pragma unroll
        for (int k = 0; k < 8; ++k) R.load<BR>(base + 64 + 8 * k + wave, nrows, kb[k], vb[k]);
        sample_rows_compute<BR>(R, base, nrows, wave, ka, va, qv, mx, ls, o);
#pragma unroll
        for (int k = 0; k < 8; ++k) R.load<BR>(base + 128 + 8 * k + wave, nrows, ka[k], va[k]);
        sample_rows_compute<BR>(R, base + 64, nrows, wave, kb, vb, qv, mx, ls, o);
    }
    if (wave == 0) {
        const float* src = BR == 0 ? R.out + O_KVS + ((size_t)R.bs * 4 + 2) * 256 + R.hkv * 64 + R.lane : R.out + O_WINS + (((size_t)R.bs * 512 + 511) * 2) * 256 + R.hkv * 64 + R.lane;
        sample_row_update(qv, src[0], src[256], R.lane, mx, ls, o);
    }
#pragma unroll
    for (int g = 0; g < 4; ++g) { if (R.lane == 0) { pm[(BR * 8 + wave) * 4 + g] = mx[g]; pl[(BR * 8 + wave) * 4 + g] = ls[g]; } po[((BR * 8 + wave) * 4 + g) * 64 + R.lane] = o[g]; }
}

__device__ __forceinline__ void attn_sample_unit(const Args& args, LAS unsigned char* lds, int unit, int tid, int wave, int lane) {
    unsigned char* ws = args.ws; float* out = args.out;
    const int hkv = unit & 3, bs = unit >> 2; const size_t m = MP + bs;
    LAS float* sc = (LAS float*)lds; LAS float* impv = sc + 512; LAS int* selblk = (LAS int*)(impv + 64); LAS int* selpage = selblk + 16; LAS int* pg = selpage + 16;
    LAS float* pm = (LAS float*)(pg + 16); LAS float* pl = pm + 64; LAS float* po = pl + 64;
    const bf16* Qr = (const bf16*)(ws + WS_Q) + m * 1024 + hkv * 256;
    const float* KCS = (const float*)(ws + WS_KCS) + (size_t)(bs * 4 + hkv) * 128 * 64; const float* VCS = (const float*)(ws + WS_VCS) + (size_t)(bs * 4 + hkv) * 128 * 64;
    float qv[4];
#pragma unroll
    for (int g = 0; g < 4; ++g) qv[g] = bf2f(Qr[g * 64 + lane]) * 0.125f;
    if (tid < 16) pg[tid] = ((const int*)args.in[5])[bs * NPAGES + tid];
    {
        float kr[16];
#pragma unroll
        for (int i = 0; i < 16; ++i) { const int n = wave + 8 * i; kr[i] = n < 127 ? KCS[n * 64 + lane] : 0.f; }
#pragma unroll
        for (int i = 0; i < 16; ++i) { const int n = wave + 8 * i; float sg[4]; dot4_reduce(qv, kr[i], lane, sg);
            if (lane < 4) sc[lane * 128 + n] = n < 127 ? (lane == 0 ? sg[0] : lane == 1 ? sg[1] : lane == 2 ? sg[2] : sg[3]) : NEGF; }
    }
    __syncthreads();
    if (wave < 4) { const float s0 = sc[wave * 128 + lane], s1 = sc[wave * 128 + 64 + lane];
        float mxv = fmaxf(s0, s1);
#pragma unroll
        for (int o = 1; o < 64; o <<= 1) mxv = fmaxf(mxv, __shfl_xor(mxv, o));
        const float e0 = __expf(s0 - mxv), e1 = (lane < 63) ? __expf(s1 - mxv) : 0.f;
        const float inv = 1.f / fmaxf(wave_sum(e0 + e1), TINYF);
        sc[wave * 128 + lane] = e0 * inv; sc[wave * 128 + 64 + lane] = e1 * inv; }
    __syncthreads();
    {
        float vr[16];
#pragma unroll
        for (int i = 0; i < 16; ++i) { const int n = wave + 8 * i; vr[i] = n < 127 ? VCS[n * 64 + lane] : 0.f; }
        float oc[4] = {0.f, 0.f, 0.f, 0.f};
#pragma unroll
        for (int i = 0; i < 16; ++i) { const int n = wave + 8 * i;
#pragma unroll
            for (int g = 0; g < 4; ++g) oc[g] += sc[g * 128 + n] * vr[i]; }
#pragma unroll
        for (int g = 0; g < 4; ++g) po[((2 * 8 + wave) * 4 + g) * 64 + lane] = oc[g];
        if (wave == 4 && lane < 33) { const int j = lane; float acc = 0.f;
#pragma unroll
            for (int k = -1; k < 4; ++k) { const int n = 4 * j + k; if (n >= 0 && n < 127) { const float P = (sc[n] + sc[128 + n]) + (sc[256 + n] + sc[384 + n]); acc += (k == -1 || k == 3) ? P : 2.f * P; } }
            impv[j] = (j == 0 || j == 31 || j == 32) ? BIGF : acc; }
    }
    __syncthreads();
    if (tid < 64) { bool sel = false;
        if (tid < 33) { const float v = impv[tid]; int rank = 0;
            for (int k = 0; k < 33; ++k) { const float o = impv[k]; rank += ((o > v) || (o == v && k < tid)) ? 1 : 0; }
            sel = rank < 16 && tid < 32; }
        const unsigned long long bal = __ballot(sel);
        if (sel) { const int slot = __popcll(bal & ((1ull << tid) - 1ull)); selblk[slot] = tid; selpage[slot] = pg[tid >> 1]; } }
    __syncthreads();
    {
        SampleRows R{INF(4), INF(6), out, selblk, selpage, bs, hkv, lane};
        sample_rows_branch<0>(R, wave, qv, pm, pl, po);
        sample_rows_branch<1>(R, wave, qv, pm, pl, po);
    }
    __syncthreads();
    if (tid < 256) { const int g = tid >> 6, d = tid & 63;
        const float* gates = (const float*)(ws + WS_MISC) + m * 128 + 32 + (hkv * 4 + g) * 3;
        float oc = 0.f;
#pragma unroll
        for (int w = 0; w < 8; ++w) oc += po[((2 * 8 + w) * 4 + g) * 64 + d];
        float res = sigmf(gates[0]) * oc;
#pragma unroll
        for (int br = 0; br < 2; ++br) { float M = NEGF;
#pragma unroll
            for (int w = 0; w < 8; ++w) M = fmaxf(M, pm[(br * 8 + w) * 4 + g]);
            float L = 0.f, O = 0.f;
#pragma unroll
            for (int w = 0; w < 8; ++w) { const float e = __expf(pm[(br * 8 + w) * 4 + g] - M); L += pl[(br * 8 + w) * 4 + g] * e; O += po[((br * 8 + w) * 4 + g) * 64 + d] * e; }
            res += sigmf(gates[1 + br]) * O / fmaxf(L, TINYF); }
        ((bf16*)(ws + WS_YATT))[m * 1024 + (hkv * 4 + g) * 64 + d] = (bf16)f2bf(res); }
    __syncthreads();
}

__device__ __forceinline__ void ffn_act_phase(const Args& args, int gt, int NGT) {
    unsigned char* ws = args.ws; float* out = args.out;
    const bf16* U = (const bf16*)(ws + WS_U); bf16* ACT = (bf16*)(ws + WS_ACT);
    const float* cw = INF(32); const float* cb = INF(33); const float* st = INF(9);
    for (int i = gt; i < MALL * (DFF / 8); i += NGT) {
        const int row = i / (DFF / 8), c8 = (i % (DFF / 8)) * 8;
        float r[2][8];
#pragma unroll
        for (int hf = 0; hf < 2; ++hf) {
            const int col = hf * DFF + c8;
            float u0[8], u1[8], u2[8];
            if (row < MP) {
                const int t = row & 4095;
                const u32x4 z = (u32x4){0u, 0u, 0u, 0u};
                const u32x4 a = t >= 2 ? *(const u32x4*)(U + (size_t)(row - 2) * DFF2 + col) : z, b = t >= 1 ? *(const u32x4*)(U + (size_t)(row - 1) * DFF2 + col) : z, c = *(const u32x4*)(U + (size_t)row * DFF2 + col);
                u0[0] = bflo(a.x); u0[1] = bfhi(a.x); u0[2] = bflo(a.y); u0[3] = bfhi(a.y); u0[4] = bflo(a.z); u0[5] = bfhi(a.z); u0[6] = bflo(a.w); u0[7] = bfhi(a.w);
                u1[0] = bflo(b.x); u1[1] = bfhi(b.x); u1[2] = bflo(b.y); u1[3] = bfhi(b.y); u1[4] = bflo(b.z); u1[5] = bfhi(b.z); u1[6] = bflo(b.w); u1[7] = bfhi(b.w);
                u2[0] = bflo(c.x); u2[1] = bfhi(c.x); u2[2] = bflo(c.y); u2[3] = bfhi(c.y); u2[4] = bflo(c.z); u2[5] = bfhi(c.z); u2[6] = bflo(c.w); u2[7] = bfhi(c.w);
            } else {
                const int bs = row - MP;
#pragma unroll
                for (int k = 0; k < 8; ++k) { u0[k] = st[((size_t)bs * 2 + 0) * DFF2 + col + k]; u1[k] = st[((size_t)bs * 2 + 1) * DFF2 + col + k]; u2[k] = out[O_FFNS + ((size_t)bs * 2 + 1) * DFF2 + col + k];
                    out[O_FFNS + ((size_t)bs * 2 + 0) * DFF2 + col + k] = u1[k]; }
            }
#pragma unroll
            for (int k = 0; k < 8; ++k) r[hf][k] = cb[col + k] + cw[col + k] * u0[k] + cw[DFF2 + col + k] * u1[k] + cw[2 * DFF2 + col + k] * u2[k];
        }
        u32x4 o; o.x = pk2(siluf(r[0][0]) * r[1][0], siluf(r[0][1]) * r[1][1]); o.y = pk2(siluf(r[0][2]) * r[1][2], siluf(r[0][3]) * r[1][3]);
        o.z = pk2(siluf(r[0][4]) * r[1][4], siluf(r[0][5]) * r[1][5]); o.w = pk2(siluf(r[0][6]) * r[1][6], siluf(r[0][7]) * r[1][7]);
        *(u32x4*)(ACT + (size_t)row * DFF + c8) = o;
    }
}
__device__ __forceinline__ void final_norm_phase(const Args& args, int gw, int NGW, int lane) {
    const float* X = (const float*)(args.ws + WS_X1); const float* nw = INF(14);
    for (int m = gw; m < MALL; m += NGW) {
        const float* xr = X + (size_t)m * 1024; float* o = args.out + (m < MP ? O_YP + (size_t)m * 1024 : O_YS + (size_t)(m - MP) * 1024);
        f32x4 v[4]; float s = 0.f;
#pragma unroll
        for (int j = 0; j < 4; ++j) { v[j] = *(const f32x4*)(xr + (j * 64 + lane) * 4); s += (v[j].x * v[j].x + v[j].y * v[j].y) + (v[j].z * v[j].z + v[j].w * v[j].w); }
        const float rstd = 1.f / sqrtf(wave_sum(s) * (1.f / 1024.f) + EPS);
#pragma unroll
        for (int j = 0; j < 4; ++j) { const int c0 = (j * 64 + lane) * 4; *(f32x4*)(o + c0) = (v[j] * rstd) * *(const f32x4*)(nw + c0); }
    }
}
constexpr int N_PHASES = 15;
#ifndef MK_PER_PHASE
#define MK_PER_PHASE 0
#endif

__global__ void __launch_bounds__(NTHR, 2) fwd_kernel(Args args) {
    extern __shared__ __attribute__((aligned(16))) unsigned char lds_raw[];
    LAS unsigned char* lds = (LAS unsigned char*)lds_raw;
    const int tid = threadIdx.x, lane = tid & 63, wave = __builtin_amdgcn_readfirstlane(tid >> 6);
    const int G = gridDim.x, bid = blockIdx.x, gw = bid * NWAVES + wave, NGW = G * NWAVES, gt = bid * NTHR + tid, NGT = G * NTHR;
    unsigned char* ws = args.ws;
    for (int u = tid; u < (LDS_BYTES - LDSCTL_OFF) / 4; u += NTHR) ((LAS unsigned*)(lds + LDSCTL_OFF))[u] = 0u;
    __syncthreads();
    XcdBarrier bar; bar.bar = (unsigned*)(ws + WS_CTL) + CW_BAR; bar.x = 0; bar.st = nullptr;
    if (!MK_PER_PHASE) bar = xcd_barrier_post((unsigned*)(ws + WS_CTL) + CW_BAR, (volatile LAS unsigned*)(lds + MISC_OFF) + 8);
    const int lo = args.ph_lo, hi = args.ph_hi;
#ifndef PHASE_MASK
#define PHASE_MASK 0x7fff
#endif
#define IN(k) ((((PHASE_MASK) >> (k)) & 1) && lo <= (k) && (k) < hi)
#define SEAM(k) do { if (IN(k) && IN((k) + 1)) xcd_barrier(bar); } while (0)
    using pg8::Gemm; using pg8::StaticOrder;

    if (IN(0)) { { p0_prologue(args, lds, gw, NGW, lane, wave); } }
    SEAM(0);
    if (IN(1)) { {
        Gemm g{(const bf16*)(ws + WS_SC), (const bf16*)(ws + WS_WADA), 256, 6144, 1024}; StaticOrder S; S.init(256, 6144, G, bid);
        pg8::EpiF32 E{(float*)(ws + WS_MOD), 6144, INF(11)};
        pg8::gemm_phase<pg8::EpiF32, StaticOrder, true, true>(lds, g, S, E);
    } }
    SEAM(1);
    if (IN(2)) { { norm_mod_phase<0>(args, gw, NGW, lane); } }
    SEAM(2);
    if (IN(3)) { {
        Gemm g{(const bf16*)(ws + WS_H), (const bf16*)(ws + WS_WIN), MPAD, NPROJ, 1024}; StaticOrder S; S.init(MPAD, NPROJ, G, bid);
        epi::InProj E{ws, args.out};
        pg8::gemm_phase<epi::InProj, StaticOrder, true, true>(lds, g, S, E);
    } }
    SEAM(3);
    if (IN(4)) { {
        { Gemm g{(const bf16*)(ws + WS_CKB), (const bf16*)(ws + WS_W1K), 65536, 256, 1024}; StaticOrder S; S.init(65536, 256, G, bid);
          pg8::EpiF32 E{(float*)(ws + WS_PARTSK), 256, nullptr}; pg8::gemm_phase<pg8::EpiF32, StaticOrder, true, true>(lds, g, S, E); }
        { Gemm g{(const bf16*)(ws + WS_CVB), (const bf16*)(ws + WS_W1V), 65536, 256, 1024}; StaticOrder S; S.init(65536, 256, G, bid);
          pg8::EpiF32 E{(float*)(ws + WS_PARTSV), 256, nullptr}; pg8::gemm_phase<pg8::EpiF32, StaticOrder, true, true>(lds, g, S, E); }
        { Gemm g{(const bf16*)(ws + WS_KVH), (const bf16*)(ws + WS_W1K), 4096, 256, 1024}; StaticOrder S; S.init(4096, 256, G, bid);
          pg8::EpiF32 E{(float*)(ws + WS_PARTK), 256, nullptr}; pg8::gemm_phase<pg8::EpiF32, StaticOrder, true, true>(lds, g, S, E); }
        { Gemm g{(const bf16*)(ws + WS_KVH) + (size_t)16 * 4096 * 64, (const bf16*)(ws + WS_W1V), 4096, 256, 1024}; StaticOrder S; S.init(4096, 256, G, (bid + G - 16) % G);
          pg8::EpiF32 E{(float*)(ws + WS_PARTV), 256, nullptr}; pg8::gemm_phase<pg8::EpiF32, StaticOrder, true, true>(lds, g, S, E); }
        for (int it = gw; it < 256 * 48; it += NGW) conv_prompt_item(args, it, lane);
        for (int it = gw; it < 4096; it += NGW) dtcs_item(args, it, lane);
        sample_conv(args, gt, NGT);
    } }
    SEAM(4);
    if (IN(5)) { {
        for (int u = bid; u < 512; u += G) ssd_states_unit(args, lds, u, wave, lane);
        for (int it = gw; it < 2 * (4096 / 16); it += NGW) compress2_item<0>(args, it, lane);
        for (int it = gw; it < 2 * (65536 / 16); it += NGW) compress2_item<1>(args, it, lane);
        for (int it = gw; it < MS * NH; it += NGW) sample_ssm_item(args, lds, it, wave, lane);
    } }
    SEAM(5);
    if (IN(6)) { { scan_phase(args, gt, NGT); } }
    SEAM(6);
    if (IN(7)) { {
#ifndef P7C
#define P7C 7
#endif
        const int p7 = args.p7mask & (P7C);
        if (p7 & 1) for (int u = bid; u < 512; u += G) ssd_out_unit(args, lds, u, wave, lane, tid);
        if (p7 & 2) for (int u = gw; u < 4096; u += NGW) attn_prompt_unit(args, (LAS float*)(lds + wave * 12288), u, lane);
        __syncthreads();
        if (p7 & 4) for (int u = bid; u < 512; u += G) attn_sample_unit(args, lds, u, tid, wave, lane);
    } }
    SEAM(7);
    if (IN(8)) { {
        { Gemm g{(const bf16*)(ws + WS_YSSM), (const bf16*)(ws + WS_WSSM), MPAD, 1024, 2048}; StaticOrder S; S.init(MPAD, 1024, G, bid);
          epi::Merge1 E{ws}; pg8::gemm_phase<epi::Merge1, StaticOrder, true, true>(lds, g, S, E); }
        { Gemm g{(const bf16*)(ws + WS_YATT), (const bf16*)(ws + WS_WATT), MPAD, 1024, 1024}; StaticOrder S; S.init(MPAD, 1024, G, bid);
          epi::Merge2 E{ws}; pg8::gemm_phase<epi::Merge2, StaticOrder, true, true>(lds, g, S, E); }
    } }
    SEAM(8);
    if (IN(9)) { {
        Gemm g{(const bf16*)(ws + WS_MERGED), (const bf16*)(ws + WS_WOUT), MPAD, 1024, 1024}; StaticOrder S; S.init(MPAD, 1024, G, bid);
        epi::Resid E{INF(0), INF(1), nullptr, (float*)(ws + WS_X1), (const float*)(ws + WS_MOD), 2048};
        pg8::gemm_phase<epi::Resid, StaticOrder, true, true>(lds, g, S, E);
    } }
    SEAM(9);
    if (IN(10)) { { norm_mod_phase<1>(args, gw, NGW, lane); } }
    SEAM(10);
    if (IN(11)) { {
        Gemm g{(const bf16*)(ws + WS_H), (const bf16*)(ws + WS_WUP), MPAD, DFF2, 1024}; StaticOrder S; S.init(MPAD, DFF2, G, bid);
        epi::Up E{ws, args.out};
        pg8::gemm_phase<epi::Up, StaticOrder, true, true>(lds, g, S, E);
    } }
    SEAM(11);
    if (IN(12)) { { ffn_act_phase(args, gt, NGT); } }
    SEAM(12);
    if (IN(13)) { {
        Gemm g{(const bf16*)(ws + WS_ACT), (const bf16*)(ws + WS_WDN), MPAD, 1024, DFF}; StaticOrder S; S.init(MPAD, 1024, G, bid);
        epi::Resid E{INF(0), INF(1), (const float*)(ws + WS_X1), (float*)(ws + WS_X1), (const float*)(ws + WS_MOD), 5120};
        pg8::gemm_phase<epi::Resid, StaticOrder, true, true>(lds, g, S, E);
    } }
    SEAM(13);
    if (IN(14)) { { final_norm_phase(args, gw, NGW, lane); } }
#undef IN
#undef SEAM
}

extern "C" void kernel_launch(void* const* d_in, const int* in_sizes, int n_in, void* d_out, int out_size, void* d_ws, size_t ws_size, hipStream_t stream) {
    static int grid = 0;
    if (grid == 0) {
        if (n_in != 35 || out_size != (int)O_END || ws_size < WS_END) { fprintf(stderr, "kernel_launch: unexpected shapes (n_in %d out %d ws %zu, need %zu)\n", n_in, out_size, ws_size, (size_t)WS_END); grid = -1; return; }
        int dev = 0, cus = 0, per_cu = 0;
        if (hipGetDevice(&dev) != hipSuccess || hipDeviceGetAttribute(&cus, hipDeviceAttributeMultiprocessorCount, dev) != hipSuccess) { grid = -1; return; }
        if (hipFuncSetAttribute((const void*)fwd_kernel, hipFuncAttributeMaxDynamicSharedMemorySize, LDS_BYTES) != hipSuccess) { fprintf(stderr, "kernel_launch: hipFuncSetAttribute failed\n"); grid = -1; return; }
        if (hipOccupancyMaxActiveBlocksPerMultiprocessor(&per_cu, (const void*)fwd_kernel, NTHR, LDS_BYTES) != hipSuccess || per_cu < 1) { fprintf(stderr, "kernel_launch: occupancy query says %d\n", per_cu); }
        (void)hipGetLastError();
        grid = cus;
    }
    if (grid < 0) return;
    (void)hipMemsetAsync((char*)d_ws + WS_CTL, 0, CTL_ZERO_BYTES, stream);
    Args a{};
    for (int i = 0; i < 35; ++i) a.in[i] = d_in[i];
    a.out = (float*)d_out; a.ws = (unsigned char*)d_ws;
    a.p7mask = 7; a.pad = 0;
#if MK_PER_PHASE
    for (int p = 0; p < N_PHASES; ++p) { a.ph_lo = p; a.ph_hi = p + 1; hipLaunchKernelGGL(fwd_kernel, dim3(grid), dim3(NTHR), LDS_BYTES, stream, a); }
#else
    a.ph_lo = 0; a.ph_hi = N_PHASES;
    hipLaunchKernelGGL(fwd_kernel, dim3(grid), dim3(NTHR), LDS_BYTES, stream, a);
#endif
#ifdef PROBE_LO
    a.ph_lo = PROBE_LO; a.ph_hi = PROBE_HI; a.p7mask = PROBE_P7MASK;
    hipLaunchKernelGGL(fwd_kernel, dim3(grid), dim3(NTHR), LDS_BYTES, stream, a);
#endif
}
```

```cpp
#include <hip/hip_runtime.h>
#include <cstdio>
#include <cstdint>
namespace pg8 {
#define PG8_LAS __attribute__((address_space(3)))
typedef unsigned short bf16_t;
typedef short bf16x8 __attribute__((ext_vector_type(8)));
typedef float f32x4 __attribute__((ext_vector_type(4)));
typedef unsigned u32x4 __attribute__((ext_vector_type(4)));
constexpr int BM = 256, BK = 64, HALF = 128, HTB = HALF * BK * 2  , STAGE_BYTES = 8 * HTB, NXCD = 8, WGM = 8;

__host__ __device__ __forceinline__ int lds_byte(int r, int c) { const int st = (r >> 4) * 2 + (c >> 5), rr = r & 15, cc = c & 31, ob = rr * 64 + cc * 2; return st * 1024 + (ob ^ (((ob >> 9) & 1) << 5)); }
__host__ __device__ __forceinline__ void stage_rc(int b, int& R, int& C) { const int st = b / 1024, sb = b % 1024, swz = sb ^ (((sb >> 9) & 1) << 5); R = (st >> 1) * 16 + swz / 64; C = (st & 1) * 32 + (swz % 64) / 2; }
__host__ __device__ __forceinline__ int perm32(int rho) { const int n = rho >> 4, i = rho & 15; return 8 * (i >> 2) + 4 * n + (i & 3); }

struct Unit { int pm, pn; };
struct Gemm { const bf16_t* A; const bf16_t* Bt; int M, N, K; };

struct StaticOrder {
    int nM, nN, nwg, G, c;
    __host__ __device__ void init(int M, int N, int G_, int c_) { nM = M / BM; nN = N / BM; nwg = nM * nN; G = G_; c = c_; }
    __host__ __device__ bool next(int i, Unit& u) const {
        const long L = (long)i * G + c; if (L >= nwg) return false;
        int wgid = (int)L; { const int q = nwg / NXCD, r = nwg % NXCD, xcd = wgid % NXCD, off = wgid / NXCD; wgid = (xcd < r ? xcd * (q + 1) : r * (q + 1) + (xcd - r) * q) + off; }
        const int nig = WGM * nN, gid = wgid / nig, fm = gid * WGM, gsz = (nM - fm) < WGM ? (nM - fm) : WGM;
        u.pm = fm + ((wgid % nig) % gsz); u.pn = (wgid % nig) / gsz; return true;
    }
    __device__ __forceinline__ void a_ready(const Unit&) const {}
    __device__ __forceinline__ void done(const Unit&) const {}
};
__device__ __forceinline__ unsigned cvt_pk_bf16(float lo, float hi) { unsigned r; asm volatile("v_cvt_pk_bf16_f32 %0, %1, %2" : "=v"(r) : "v"(lo), "v"(hi)); return r; }
typedef float f32x2 __attribute__((ext_vector_type(2)));
struct EpiF32 {
    static constexpr bool PERM = false, AFTER_DRAIN = false;
    float* C; int ldc; const float* bias;
    __device__ __forceinline__ void operator()(const f32x4 (&acc)[2][2][4][2], const Unit& u, int wr, int wc, int fr, int fq) const {
        const int row0 = u.pm * BM + wr * 64 + fr, col0 = u.pn * BM + wc * 32 + 4 * fq;
        f32x4 bv[2][2];
#pragma unroll
        for (int bj = 0; bj < 2; ++bj)
#pragma unroll
            for (int n = 0; n < 2; ++n) bv[bj][n] = bias ? *(const f32x4*)(bias + col0 + bj * HALF + n * 16) : (f32x4){0.f, 0.f, 0.f, 0.f};
#pragma unroll
        for (int ai = 0; ai < 2; ++ai)
#pragma unroll
            for (int m = 0; m < 4; ++m) { float* rowp = C + (size_t)(row0 + ai * HALF + m * 16) * ldc + col0;
#pragma unroll
                for (int bj = 0; bj < 2; ++bj)
#pragma unroll
                    for (int n = 0; n < 2; ++n) *(f32x4*)(rowp + bj * HALF + n * 16) = acc[ai][bj][m][n] + bv[bj][n]; }
    }
};
template <class Epi, class Sched, bool ALIGN_EPI = false, bool SP2 = false>
__device__ __forceinline__ void gemm_phase(PG8_LAS unsigned char* lds, const Gemm g, const Sched& S, const Epi& E) {
    const int tid = threadIdx.x, wid = __builtin_amdgcn_readfirstlane(tid >> 6), lane = tid & 63, wr = wid >> 2, wc = wid & 3, fr = lane & 15, fq = lane >> 4;
    const int K = g.K, nt = K / BK;
    unsigned voffA[2], voffB[2];
#pragma unroll
    for (int i = 0; i < 2; ++i) { int R, C; stage_rc(tid * 16 + i * 8192, R, C); const int Rb = Epi::PERM ? ((R & ~31) + perm32(R & 31)) : R;
        voffA[i] = (unsigned)(R * K + C) * 2u; voffB[i] = (unsigned)(Rb * K + C) * 2u; }
    const size_t kstep = (size_t)(BK * 2);
    const size_t hstep = (size_t)HALF * K * 2;
    const size_t tstep = 2 * hstep;
    const unsigned ldsw = (unsigned)wid * 1024u;
    const int aoff = lds_byte(wr * 64 + fr, fq * 8), boff = lds_byte(wc * 32 + fr, fq * 8);
#define PG8_SA(b, h) (((b) * 2 + (h)) * HTB)
#define PG8_SB(b, h) ((4 + (b) * 2 + (h)) * HTB)
#define PG8_STAGE(bufoff, gbase, voff) do { _Pragma("unroll") for (int _i = 0; _i < 2; ++_i) \
        __builtin_amdgcn_global_load_lds((const unsigned*)((const char*)(gbase) + (voff)[_i]), (PG8_LAS unsigned*)(lds + (bufoff) + ldsw + _i * 8192), 16, 0, 0); } while (0)
#define PG8_LDA(dst, b, h) do { _Pragma("unroll") for (int m = 0; m < 4; ++m) _Pragma("unroll") for (int k = 0; k < 2; ++k) dst[m][k] = *(const PG8_LAS bf16x8*)(lds + PG8_SA(b, h) + aoff + m * 2048 + k * 1024); } while (0)
#define PG8_LDB(dst, b, h) do { _Pragma("unroll") for (int n = 0; n < 2; ++n) _Pragma("unroll") for (int k = 0; k < 2; ++k) dst[n][k] = *(const PG8_LAS bf16x8*)(lds + PG8_SB(b, h) + boff + n * 2048 + k * 1024); } while (0)
#define PG8_MMA(ai, bj, At, Bt) do { __builtin_amdgcn_s_setprio(1); _Pragma("unroll") for (int m = 0; m < 4; ++m) _Pragma("unroll") for (int n = 0; n < 2; ++n) _Pragma("unroll") for (int k = 0; k < 2; ++k) \
        acc[ai][bj][m][n] = __builtin_amdgcn_mfma_f32_16x16x32_bf16(Bt[n][k], At[m][k], acc[ai][bj][m][n], 0, 0, 0); __builtin_amdgcn_s_setprio(0); } while (0)
#define PG8_WAIT_V(n) asm volatile("s_waitcnt vmcnt(" #n ")" ::: "memory")
#define PG8_WAIT_L(n) asm volatile("s_waitcnt lgkmcnt(" #n ")" ::: "memory")
#define PG8_BAR __builtin_amdgcn_s_barrier()
#define PG8_SCHED __builtin_amdgcn_sched_barrier(0)
    Unit cur, nxt; int ui = 0;
    if (!S.next(0, cur)) return;
    f32x4 acc[2][2][4][2];
#pragma unroll
    for (int a = 0; a < 2; ++a)
#pragma unroll
        for (int b = 0; b < 2; ++b)
#pragma unroll
            for (int m = 0; m < 4; ++m)
#pragma unroll
                for (int n = 0; n < 2; ++n) acc[a][b][m][n] = (f32x4){0.f, 0.f, 0.f, 0.f};
    bf16x8 At[4][2], B0[2][2], B1[2][2];
    const char* cA = (const char*)g.A + (size_t)cur.pm * tstep; const char* cB = (const char*)g.Bt + (size_t)cur.pn * tstep;
    S.a_ready(cur);
    if constexpr (SP2) {
        PG8_STAGE(PG8_SB(0, 0), cB, voffB); PG8_STAGE(PG8_SB(0, 1), cB + hstep, voffB); PG8_STAGE(PG8_SA(0, 0), cA, voffA); PG8_STAGE(PG8_SA(0, 1), cA + hstep, voffA);
        if (wr == 1) PG8_BAR;
        PG8_WAIT_V(2); PG8_BAR;
        PG8_STAGE(PG8_SB(1, 0), cB + kstep, voffB); PG8_STAGE(PG8_SA(1, 0), cA + kstep, voffA); PG8_STAGE(PG8_SB(1, 1), cB + hstep + kstep, voffB);
        PG8_WAIT_V(6); PG8_BAR;
    } else {
        PG8_STAGE(PG8_SB(0, 0), cB, voffB); PG8_STAGE(PG8_SA(0, 0), cA, voffA); PG8_STAGE(PG8_SB(0, 1), cB + hstep, voffB); PG8_STAGE(PG8_SA(0, 1), cA + hstep, voffA);
        if (wr == 1) PG8_BAR;
        PG8_WAIT_V(4); PG8_BAR;
        PG8_STAGE(PG8_SB(1, 0), cB + kstep, voffB); PG8_STAGE(PG8_SA(1, 0), cA + kstep, voffA); PG8_STAGE(PG8_SB(1, 1), cB + hstep + kstep, voffB);
        PG8_WAIT_V(6); PG8_BAR;
    }
    for (;;) {
        const bool has_next = S.next(ui + 1, nxt);
        const char* nA = has_next ? (const char*)g.A + (size_t)nxt.pm * tstep : cA; const char* nB = has_next ? (const char*)g.Bt + (size_t)nxt.pn * tstep : cB;
        for (int t = 0; t < nt; t += 2) {
            const bool last = (t == nt - 2);
            const char* a1 = cA + (size_t)(t + 1) * kstep;
            const char* a2 = last ? nA : cA + (size_t)(t + 2) * kstep; const char* b2 = last ? nB : cB + (size_t)(t + 2) * kstep;
            const char* a3 = a2 + kstep; const char* b3 = b2 + kstep;
            if (last && has_next) S.a_ready(nxt);
            if constexpr (SP2) {
            PG8_LDB(B0, 0, 0); PG8_LDB(B1, 0, 1); PG8_SCHED; PG8_LDA(At, 0, 0); PG8_STAGE(PG8_SA(1, 1), a1 + hstep, voffA);
            PG8_WAIT_V(8); PG8_WAIT_L(0); PG8_BAR; PG8_MMA(0, 0, At, B0); PG8_MMA(0, 1, At, B1); PG8_BAR; PG8_SCHED;
            PG8_LDA(At, 0, 1); PG8_STAGE(PG8_SB(0, 0), b2, voffB); PG8_STAGE(PG8_SB(0, 1), b2 + hstep, voffB); PG8_STAGE(PG8_SA(0, 0), a2, voffA);
            PG8_WAIT_V(8); PG8_WAIT_L(0); PG8_BAR; PG8_MMA(1, 0, At, B0); PG8_MMA(1, 1, At, B1); PG8_BAR; PG8_SCHED;
            PG8_LDB(B0, 1, 0); PG8_LDB(B1, 1, 1); PG8_SCHED; PG8_LDA(At, 1, 0); PG8_STAGE(PG8_SA(0, 1), a2 + hstep, voffA);
            PG8_WAIT_V(8); PG8_WAIT_L(0); PG8_BAR; PG8_MMA(0, 0, At, B0); PG8_MMA(0, 1, At, B1); PG8_BAR; PG8_SCHED;
            PG8_LDA(At, 1, 1); PG8_STAGE(PG8_SB(1, 0), b3, voffB); PG8_STAGE(PG8_SB(1, 1), b3 + hstep, voffB); PG8_STAGE(PG8_SA(1, 0), a3, voffA);
            PG8_WAIT_V(8); PG8_WAIT_L(0); PG8_BAR; PG8_MMA(1, 0, At, B0); PG8_MMA(1, 1, At, B1); PG8_BAR; PG8_SCHED;
            } else {
            PG8_LDB(B0, 0, 0); PG8_SCHED; PG8_LDA(At, 0, 0); PG8_STAGE(PG8_SA(1, 1), a1 + hstep, voffA);
            PG8_WAIT_L(8); PG8_BAR; PG8_WAIT_L(0); PG8_MMA(0, 0, At, B0); PG8_BAR; PG8_SCHED;
            PG8_LDB(B1, 0, 1); PG8_STAGE(PG8_SB(0, 0), b2, voffB);
            PG8_BAR; PG8_WAIT_L(0); PG8_MMA(0, 1, At, B1); PG8_BAR;
            PG8_LDA(At, 0, 1); PG8_STAGE(PG8_SA(0, 0), a2, voffA);
            PG8_BAR; PG8_WAIT_L(0); PG8_MMA(1, 0, At, B0); PG8_BAR; PG8_SCHED;
            PG8_STAGE(PG8_SB(0, 1), b2 + hstep, voffB);
            PG8_WAIT_V(6); PG8_BAR; PG8_MMA(1, 1, At, B1); PG8_BAR;
            PG8_LDB(B0, 1, 0); PG8_SCHED; PG8_LDA(At, 1, 0); PG8_STAGE(PG8_SA(0, 1), a2 + hstep, voffA);
            PG8_WAIT_L(8); PG8_BAR; PG8_WAIT_L(0); PG8_MMA(0, 0, At, B0); PG8_BAR; PG8_SCHED;
            PG8_LDB(B1, 1, 1); PG8_STAGE(PG8_SB(1, 0), b3, voffB);
            PG8_BAR; PG8_WAIT_L(0); PG8_MMA(0, 1, At, B1); PG8_BAR;
            PG8_LDA(At, 1, 1); PG8_STAGE(PG8_SA(1, 0), a3, voffA);
            PG8_BAR; PG8_WAIT_L(0); PG8_MMA(1, 0, At, B0); PG8_BAR; PG8_SCHED;
            PG8_STAGE(PG8_SB(1, 1), b3 + hstep, voffB);
            PG8_WAIT_V(6); PG8_BAR; PG8_MMA(1, 1, At, B1); PG8_BAR;
            }
        }
        if constexpr (ALIGN_EPI) { if (wr == 0) PG8_BAR; }
        if constexpr (!Epi::AFTER_DRAIN) { E(acc, cur, wr, wc, fr, fq); S.done(cur); }
        if (!has_next) break;
#pragma unroll
        for (int a = 0; a < 2; ++a)
#pragma unroll
            for (int b = 0; b < 2; ++b)
#pragma unroll
                for (int m = 0; m < 4; ++m)
#pragma unroll
                    for (int n = 0; n < 2; ++n) acc[a][b][m][n] = (f32x4){0.f, 0.f, 0.f, 0.f};
        cur = nxt; cA = nA; cB = nB; ++ui;
        if constexpr (ALIGN_EPI) { if (wr == 1) PG8_BAR; }
    }
    PG8_WAIT_V(0);
    if constexpr (!ALIGN_EPI) { if (wr == 0) PG8_BAR; }
    PG8_BAR;
    if constexpr (Epi::AFTER_DRAIN) { E.fused(acc, cur, wr, wc, fr, fq, lds, wid, lane); S.done(cur); }
#undef PG8_SA
#undef PG8_SB
#undef PG8_STAGE
#undef PG8_LDA
#undef PG8_LDB
#undef PG8_MMA
#undef PG8_WAIT_V
#undef PG8_WAIT_L
#undef PG8_BAR
#undef PG8_SCHED
}
}
#define GAS __attribute__((address_space(1)))
#define LAS __attribute__((address_space(3)))
typedef unsigned short bf16;
typedef float f32x4 __attribute__((ext_vector_type(4)));
typedef float f32x2 __attribute__((ext_vector_type(2)));
typedef short bf16x8 __attribute__((ext_vector_type(8)));
typedef short bf16x4 __attribute__((ext_vector_type(4)));
typedef unsigned u32x4 __attribute__((ext_vector_type(4)));
typedef unsigned u32x2 __attribute__((ext_vector_type(2)));
#define MFMA16(a, b, c) __builtin_amdgcn_mfma_f32_16x16x32_bf16((a), (b), (c), 0, 0, 0)

constexpr int NWAVES = 8, NTHR = 512;
constexpr int DM = 1024, SEQ = 4096, NB = 4, MP = NB * SEQ, MS = 128, MALL = MP + MS, MPAD = 16640;
constexpr int DI = 2048, CONVD = 3072, NH = 32, NG = 4, NST = 128;
constexpr int NPROJ = 9984;
constexpr int DFF = 2816, DFF2 = 5632;
constexpr int NPAGES = 16, PAST = 2048;
constexpr float EPS = 1e-6f, NEGF = -1e30f, BIGF = 1e30f, TINYF = 1e-30f;
constexpr int T_Z = 0, T_XBC = 8, T_Q = 20, T_KV = 24, T_MG = 30, T_MISC = 38;

constexpr size_t O_YP = 0;
constexpr size_t O_YS = O_YP + (size_t)MP * DM;
constexpr size_t O_KVP = O_YS + (size_t)MS * DM;
constexpr size_t O_KVS = O_KVP + (size_t)MP * 1024;
constexpr size_t O_WINP = O_KVS + (size_t)MS * 1024;
constexpr size_t O_WINS = O_WINP + (size_t)NB * 512 * 512;
constexpr size_t O_SSMP = O_WINS + (size_t)MS * 512 * 512;
constexpr size_t O_SSMS = O_SSMP + (size_t)NB * NH * 64 * 128;
constexpr size_t O_CONVP = O_SSMS + (size_t)MS * NH * 64 * 128;
constexpr size_t O_CONVS = O_CONVP + (size_t)NB * 3 * CONVD;
constexpr size_t O_FFNP = O_CONVS + (size_t)MS * 3 * CONVD;
constexpr size_t O_FFNS = O_FFNP + (size_t)NB * 2 * DFF2;
constexpr size_t O_END = O_FFNS + (size_t)MS * 2 * DFF2;
static_assert(O_END == 105725952, "output size");

constexpr size_t al256(size_t x) { return (x + 255) & ~(size_t)255; }
constexpr size_t WS_CTL = 0, CTL_ZERO_BYTES = 1u << 20;
constexpr size_t WS_WIN = CTL_ZERO_BYTES;
constexpr size_t WS_WSSM = WS_WIN + al256((size_t)NPROJ * 1024 * 2);
constexpr size_t WS_WATT = WS_WSSM + al256((size_t)1024 * 2048 * 2);
constexpr size_t WS_WOUT = WS_WATT + al256((size_t)1024 * 1024 * 2);
constexpr size_t WS_WUP = WS_WOUT + al256((size_t)1024 * 1024 * 2);
constexpr size_t WS_WDN = WS_WUP + al256((size_t)DFF2 * 1024 * 2);
constexpr size_t WS_WADA = WS_WDN + al256((size_t)1024 * DFF * 2);
constexpr size_t WS_W1K = WS_WADA + al256((size_t)6144 * 1024 * 2);
constexpr size_t WS_W1V = WS_W1K + al256((size_t)256 * 1024 * 2);
constexpr size_t WS_SC = WS_W1V + al256((size_t)256 * 1024 * 2);
constexpr size_t WS_MOD = WS_SC + al256((size_t)256 * 1024 * 2);
constexpr size_t WS_ROPE = WS_MOD + al256((size_t)256 * 6144 * 4);
constexpr size_t WS_PET = WS_ROPE + al256((size_t)4096 * 16 * 4);
constexpr size_t WS_H = WS_PET + al256(2 * 128 * 4);
constexpr size_t WS_Z = WS_H + al256((size_t)MPAD * 1024 * 2);
constexpr size_t WS_XBC = WS_Z + al256((size_t)MPAD * 2048 * 2);
constexpr size_t WS_Q = WS_XBC + al256((size_t)MPAD * 3072 * 2);
constexpr size_t WS_MG = WS_Q + al256((size_t)MPAD * 1024 * 2);
constexpr size_t WS_MISC = WS_MG + al256((size_t)MPAD * 2048 * 2);
constexpr size_t WS_KVH = WS_MISC + al256((size_t)MPAD * 128 * 4);
constexpr size_t WS_VT = WS_KVH + al256((size_t)6 * 16 * 4096 * 64 * 2);
constexpr size_t WS_XT = WS_VT + al256((size_t)2 * 16 * 64 * 4096 * 2);
constexpr size_t WS_BN = WS_XT + al256((size_t)4 * 32 * 64 * 4096 * 2);
constexpr size_t WS_CN = WS_BN + al256((size_t)16 * 4096 * 128 * 2);
constexpr size_t WS_BT = WS_CN + al256((size_t)16 * 4096 * 128 * 2);
constexpr size_t WS_DT = WS_BT + al256((size_t)16 * 4096 * 128 * 2);
constexpr size_t WS_CS = WS_DT + al256((size_t)128 * 4096 * 4);
constexpr size_t WS_STATES = WS_CS + al256((size_t)128 * 4096 * 4);
constexpr size_t WS_HPREV = WS_STATES + al256((size_t)4096 * 8192 * 4);
constexpr size_t WS_YSSM = WS_HPREV + al256((size_t)4096 * 8192 * 2);
constexpr size_t WS_SSQ = WS_YSSM + al256((size_t)MPAD * 2048 * 2);
constexpr size_t WS_PARTK = WS_SSQ + al256((size_t)MPAD * 4 * 4);
constexpr size_t WS_PARTV = WS_PARTK + al256((size_t)4096 * 256 * 4);
constexpr size_t WS_KC = WS_PARTV + al256((size_t)4096 * 256 * 4);
constexpr size_t WS_VCT = WS_KC + al256((size_t)16 * 256 * 64 * 2);
constexpr size_t WS_YATTF = WS_VCT + al256((size_t)16 * 256 * 64 * 2);
constexpr size_t WS_YATT = WS_YATTF + al256((size_t)MPAD * 1024 * 4);
constexpr size_t WS_TMPM = WS_YATT + al256((size_t)MPAD * 1024 * 2);
constexpr size_t WS_MERGED = WS_TMPM + al256((size_t)MPAD * 1024 * 4);
constexpr size_t WS_X1 = WS_MERGED + al256((size_t)MPAD * 1024 * 2);
constexpr size_t WS_U = WS_X1 + al256((size_t)MPAD * 1024 * 4);
constexpr size_t WS_ACT = WS_U + al256((size_t)MPAD * DFF2 * 2);
constexpr size_t WS_CKB = WS_ACT + al256((size_t)MPAD * DFF * 2);
constexpr size_t WS_CVB = WS_CKB + al256((size_t)128 * 4 * 2048 * 64 * 2);
constexpr size_t WS_PARTSK = WS_CVB + al256((size_t)128 * 4 * 2048 * 64 * 2);
constexpr size_t WS_PARTSV = WS_PARTSK + al256((size_t)65536 * 256 * 4);
constexpr size_t WS_KCS = WS_PARTSV + al256((size_t)65536 * 256 * 4);
constexpr size_t WS_VCS = WS_KCS + al256((size_t)128 * 4 * 128 * 64 * 4);
constexpr size_t WS_XCS = WS_VCS + al256((size_t)128 * 4 * 128 * 64 * 4);
constexpr size_t WS_DTS = WS_XCS + al256((size_t)128 * 3072 * 4);
constexpr size_t WS_W2T = WS_DTS + al256((size_t)128 * 32 * 4);
constexpr size_t WS_END = WS_W2T + al256((size_t)2 * 64 * 128 * 2);

constexpr int CW_BAR = 4096;

constexpr int RING_BYTES = 131072;
constexpr int LDSCTL_OFF = RING_BYTES, MISC_OFF = LDSCTL_OFF + 320;
constexpr int LDS_BYTES = 147456;

__device__ __forceinline__ unsigned f2bf(float f) { unsigned u = __builtin_bit_cast(unsigned, f); return (u + 0x7fffu + ((u >> 16) & 1u)) >> 16; }
__device__ __forceinline__ unsigned pk2(float lo, float hi) { return pg8::cvt_pk_bf16(lo, hi); }
__device__ __forceinline__ float bf2f(unsigned h) { return __builtin_bit_cast(float, h << 16); }
__device__ __forceinline__ float bflo(unsigned w) { return __builtin_bit_cast(float, w << 16); }
__device__ __forceinline__ float bfhi(unsigned w) { return __builtin_bit_cast(float, w & 0xffff0000u); }
__device__ __forceinline__ float wave_sum(float v) {
#pragma unroll
    for (int o = 1; o < 64; o <<= 1) v += __shfl_xor(v, o);
    return v;
}
__device__ __forceinline__ float siluf(float x) { return x / (1.f + __expf(-x)); }
__device__ __forceinline__ float sigmf(float x) { return 1.f / (1.f + __expf(-x)); }
__device__ __forceinline__ float softplusf(float x) { return x > 20.f ? x : log1pf(__expf(x)); }
#define LDS_WAIT() asm volatile("s_waitcnt lgkmcnt(0)" ::: "memory")

struct Args { const void* in[35]; float* out; unsigned char* ws; int ph_lo, ph_hi, p7mask, pad; };
#define INF(i) ((const float*)args.in[i])
#define XB_TMO      128
#define XB_XCNT(j)  (256  + 64 * (j))
#define XB_XSUB(j)  (1280 + 64 * (j))
#define XB_XGEN(j)  (2304 + 64 * (j))
#define XB_TOP      3328
#define XB_TOPGEN   3392
#define XCD_BAR_WORDS 3456
#define XB_SPIN_CAP (1u << 18)

__device__ __forceinline__ unsigned xb_ld(unsigned* p)              { return __hip_atomic_load(p, __ATOMIC_RELAXED, __HIP_MEMORY_SCOPE_AGENT); }
__device__ __forceinline__ unsigned xb_add(unsigned* p, unsigned v) { return __hip_atomic_fetch_add(p, v, __ATOMIC_RELAXED, __HIP_MEMORY_SCOPE_AGENT); }
__device__ __forceinline__ unsigned xb_xcc_id() { return (unsigned)__builtin_amdgcn_s_getreg((3 << 11) | 20) & 0xFu; }
#define XB_SPIN(cond, bar) do { unsigned _sp = 0; while (cond) { __builtin_amdgcn_s_sleep(1); \
    if ((++_sp & 255u) == 0u) { if (xb_ld(&(bar)[XB_TMO])) break; if (_sp > XB_SPIN_CAP) { atomicAdd(&(bar)[XB_TMO], 1u); break; } } } } while (0)

struct XcdBarrier {
    unsigned* bar; unsigned x;
    volatile LAS unsigned* st;
};

__device__ __forceinline__ XcdBarrier xcd_barrier_post(unsigned* bar, volatile LAS unsigned* st) {
    XcdBarrier b; b.bar = bar; b.x = xb_xcc_id(); b.st = st;
    if (threadIdx.x == 0) (void)xb_add(&bar[XB_XCNT(b.x)], 1u);
    return b;
}
__device__ __forceinline__ void xcd_barrier_complete(unsigned* bar, unsigned x, unsigned& nloc, unsigned& nx) {
    const unsigned G = gridDim.x * gridDim.y * gridDim.z;
    unsigned sum, cnt, mine, sp = 0u;
    for (;;) {
        sum = 0u; cnt = 0u; mine = 0u;
#pragma unroll
        for (unsigned j = 0; j < 16; ++j) { const unsigned c = xb_ld(&bar[XB_XCNT(j)]); sum += c; cnt += (c > 0u) ? 1u : 0u; mine = (j == x) ? c : mine; }
        if (sum == G) break;
        __builtin_amdgcn_s_sleep(1);
        if ((++sp & 255u) == 0u) { if (xb_ld(&bar[XB_TMO])) break; if (sp > XB_SPIN_CAP) { atomicAdd(&bar[XB_TMO], 1u); break; } }
    }
    nloc = mine > 0u ? mine : 1u; nx = cnt > 0u ? cnt : 1u;
}

__device__ __forceinline__ void xcd_barrier(const XcdBarrier& b) {
    asm volatile("s_waitcnt vmcnt(0)" ::: "memory");
    __syncthreads();
    if (threadIdx.x == 0) {
        unsigned* bar = b.bar;
        __builtin_amdgcn_s_waitcnt(0);
        unsigned nloc = b.st[0], nx = b.st[1];
        if (nloc == 0u) { xcd_barrier_complete(bar, b.x, nloc, nx); b.st[0] = nloc; b.st[1] = nx; }
        const unsigned old = xb_add(&bar[XB_XSUB(b.x)], 1u);
        const unsigned gen = old / nloc;
        if (old + 1u == (gen + 1u) * nloc) {
            __builtin_amdgcn_fence(__ATOMIC_RELEASE, "agent");
            asm volatile("s_waitcnt vmcnt(0)" ::: "memory");
            const unsigned og = xb_add(&bar[XB_TOP], 1u);
            const unsigned tg = og / nx;
            if (og + 1u == (tg + 1u) * nx) xb_add(&bar[XB_TOPGEN], 1u);
            else XB_SPIN(xb_ld(&bar[XB_TOPGEN]) == tg, bar);
            __builtin_amdgcn_fence(__ATOMIC_ACQUIRE, "agent");
            xb_add(&bar[XB_XGEN(b.x)], 1u);
            asm volatile("s_waitcnt vmcnt(0)" ::: "memory");
        } else {
            XB_SPIN(xb_ld(&bar[XB_XGEN(b.x)]) == gen, bar);
            __builtin_amdgcn_fence(__ATOMIC_ACQUIRE, "agent");
            asm volatile("s_waitcnt vmcnt(0)" ::: "memory");
        }
    }
    __syncthreads();
}
__device__ __forceinline__ int inproj_src_col(int n) {
    if (n < 5120) return n;
    if (n < 6144) return n - 5120 + 5152;
    if (n < 7680) return n - 6144 + 6176;
    if (n < 9728) return n - 7680 + 7760;
    const int i = n - 9728;
    if (i < 32) return 5120 + i;
    if (i < 80) return 7712 + (i - 32);
    return -1;
}
template <int MODE>
__device__ __forceinline__ void transpose_item(const float* W, int K, int ldw, int nblk, bf16* WT, int row_off, LAS float* scr, int item, int lane) {
    const int kb = item / nblk, nb = item % nblk, k0 = 64 * kb, n0 = 32 * nb;
    const int n = n0 + (lane & 31);
    const int sc = (MODE == 1) ? inproj_src_col(n) : n;
#pragma unroll 8
    for (int i = 0; i < 32; ++i) { const int kk = 2 * i + (lane >> 5); scr[kk * 33 + (lane & 31)] = (sc >= 0) ? W[(size_t)(k0 + kk) * ldw + sc] : 0.f; }
    LDS_WAIT(); asm volatile("" ::: "memory");
    const int c = lane & 7;
#pragma unroll
    for (int j = 0; j < 4; ++j) { const int nn = (lane >> 3) + 8 * j; const LAS float* s = scr + (8 * c) * 33 + nn;
        u32x4 o; o.x = pk2(s[0 * 33], s[1 * 33]); o.y = pk2(s[2 * 33], s[3 * 33]); o.z = pk2(s[4 * 33], s[5 * 33]); o.w = pk2(s[6 * 33], s[7 * 33]);
        *(u32x4*)(WT + (size_t)(row_off + n0 + nn) * K + k0 + 8 * c) = o; }
    LDS_WAIT(); asm volatile("" ::: "memory");
}

__device__ __forceinline__ void p0_prologue(const Args& args, LAS unsigned char* lds, int gw, int NGW, int lane, int wave) {
    unsigned char* ws = args.ws;
    LAS float* scr = (LAS float*)(lds + wave * 16384);
    constexpr int I_IN = 16 * (NPROJ / 32), I_SSM = 32 * 32, I_ATT = 16 * 32, I_OUT = 16 * 32, I_UP = 16 * (DFF2 / 32), I_DN = (DFF / 64) * 32, I_ADA = 16 * (6144 / 32), I_W1 = 16 * 4;
    constexpr int NITEMS = I_IN + I_SSM + I_ATT + I_OUT + I_UP + I_DN + I_ADA + 4 * I_W1;
    for (int it = gw; it < NITEMS; it += NGW) {
        int r = it;
        if (r < I_ADA) { transpose_item<0>(INF(10), 1024, 6144, 6144 / 32, (bf16*)(ws + WS_WADA), 0, scr, r, lane); continue; } r -= I_ADA;
        if (r < I_IN) { transpose_item<1>(INF(15), 1024, 9808, NPROJ / 32, (bf16*)(ws + WS_WIN), 0, scr, r, lane); continue; } r -= I_IN;
        if (r < I_SSM) { transpose_item<0>(INF(28), 2048, 1024, 32, (bf16*)(ws + WS_WSSM), 0, scr, r, lane); continue; } r -= I_SSM;
        if (r < I_ATT) { transpose_item<0>(INF(29), 1024, 1024, 32, (bf16*)(ws + WS_WATT), 0, scr, r, lane); continue; } r -= I_ATT;
        if (r < I_OUT) { transpose_item<0>(INF(30), 1024, 1024, 32, (bf16*)(ws + WS_WOUT), 0, scr, r, lane); continue; } r -= I_OUT;
        if (r < I_UP) { transpose_item<0>(INF(31), 1024, DFF2, DFF2 / 32, (bf16*)(ws + WS_WUP), 0, scr, r, lane); continue; } r -= I_UP;
        if (r < I_DN) { transpose_item<0>(INF(34), DFF, 1024, 32, (bf16*)(ws + WS_WDN), 0, scr, r, lane); continue; } r -= I_DN;
        { const int which = r / I_W1, rr = r % I_W1; const int st = which >> 1, r2 = which & 1;
          transpose_item<0>(INF(st ? 26 : 23) + (size_t)r2 * 16 * 64 * 128, 1024, 128, 4, (bf16*)(ws + (st ? WS_W1V : WS_W1K)), r2 * 128, scr, rr, lane); }
    }
    for (int r = gw; r < 256; r += NGW) {
        bf16* o = (bf16*)(ws + WS_SC) + (size_t)r * 1024;
        const float* src = r < 4 ? INF(2) + (size_t)r * 1024 : (r < 132 ? INF(3) + (size_t)(r - 4) * 1024 : nullptr);
#pragma unroll
        for (int j = 0; j < 4; ++j) { const int c0 = (j * 64 + lane) * 4; f32x4 v = src ? *(const f32x4*)(src + c0) : (f32x4){0.f, 0.f, 0.f, 0.f};
            u32x2 w; w.x = pk2(src ? siluf(v.x) : 0.f, src ? siluf(v.y) : 0.f); w.y = pk2(src ? siluf(v.z) : 0.f, src ? siluf(v.w) : 0.f); *(u32x2*)(o + c0) = w; }
    }
    for (int i = gw * 64 + lane; i < 4096 * 8; i += NGW * 64) {
        const int pos = i >> 3, k = i & 7;
        const float invf[8] = {1.0f, 0.1939227432012558f, 0.03760603070259094f, 0.007292664609849453f, 0.0014142135623842478f, 0.00027424818836152554f, 5.318296098266728e-05f, 1.0313386155758053e-05f};
        float fr = 1.0f;
#pragma unroll
        for (int q = 0; q < 8; ++q) fr = (k == q) ? invf[q] : fr;
        const float ang = (float)pos * fr;
        const double ad = (double)ang, rev = ad * 0.15915494309189535;
        const float fracrev = (float)(rev - __builtin_floor(rev));
        float* o = (float*)(ws + WS_ROPE) + (size_t)pos * 16;
        o[k] = __builtin_amdgcn_cosf(fracrev); o[8 + k] = __builtin_amdgcn_sinf(fracrev);
    }
    for (int it = gw; it < 256; it += NGW) {
        const int st = it >> 7, e = it & 127; const float* pe = INF(st ? 25 : 22); const float* w1 = INF(st ? 26 : 23);
        float s = 0.f;
        for (int i = 0; i < 32; ++i) { const int idx = lane + 64 * i; s += pe[idx] * w1[(size_t)idx * 128 + e]; }
        s = wave_sum(s);
        if (lane == 0) ((float*)(ws + WS_PET))[it] = s;
    }
    {
        const int* pt = (const int*)args.in[5]; const float* cache = INF(4);
        constexpr int NIT = 128 * 2048 * 2;
        for (int it0 = gw; it0 < NIT; it0 += 8 * NGW) {
            f32x4 v[8];
#pragma unroll
            for (int k = 0; k < 8; ++k) { const int it = it0 + k * NGW;
                if (it < NIT) { const int s = it & 1, t = (it >> 1) & 2047, b = it >> 12; const int page = pt[b * NPAGES + (t >> 7)];
                    v[k] = *(const f32x4*)(cache + (((size_t)page * 128 + (t & 127)) * 4 + s) * 256 + lane * 4); } }
#pragma unroll
            for (int k = 0; k < 8; ++k) { const int it = it0 + k * NGW;
                if (it < NIT) { const int s = it & 1, t = (it >> 1) & 2047, b = it >> 12; const int h = lane >> 4, d = (lane & 15) * 4;
                    bf16* dst = (bf16*)(ws + (s ? WS_CVB : WS_CKB)) + (((size_t)(b * 4 + h) * 2048 + t) * 64 + d);
                    u32x2 w; w.x = pk2(v[k].x, v[k].y); w.y = pk2(v[k].z, v[k].w); *(u32x2*)dst = w; } }
        }
    }
    for (int i = gw * 64 + lane; i < 2 * 64 * 128; i += NGW * 64) { const int st = i >> 13, d = (i >> 7) & 63, e = i & 127;
        ((bf16*)(ws + WS_W2T))[i] = (bf16)f2bf(INF(st ? 27 : 24)[e * 64 + d]); }
}

template <int WHICH>
__device__ __forceinline__ void norm_mod_phase(const Args& args, int gw, int NGW, int lane) {
    unsigned char* ws = args.ws; const float* MOD = (const float*)(ws + WS_MOD); bf16* H = (bf16*)(ws + WS_H);
    const float* nw = INF(WHICH ? 13 : 12);
    constexpr int SH = WHICH ? 3072 : 0, SCo = WHICH ? 4096 : 1024;
    for (int m = gw; m < MPAD; m += NGW) {
        u32x2* o = (u32x2*)(H + (size_t)m * 1024);
        if (m >= MALL) {
#pragma unroll
            for (int j = 0; j < 4; ++j) o[j * 64 + lane] = (u32x2){0u, 0u};
            continue; }
        const float* xr = WHICH ? (const float*)(ws + WS_X1) + (size_t)m * 1024 : (m < MP ? INF(0) + (size_t)m * 1024 : INF(1) + (size_t)(m - MP) * 1024);
        const float* mr = MOD + (size_t)(m < MP ? (m >> 12) : 4 + (m - MP)) * 6144;
        f32x4 v[4]; float s = 0.f;
#pragma unroll
        for (int j = 0; j < 4; ++j) { v[j] = *(const f32x4*)(xr + (j * 64 + lane) * 4); s += (v[j].x * v[j].x + v[j].y * v[j].y) + (v[j].z * v[j].z + v[j].w * v[j].w); }
        const float rstd = 1.f / sqrtf(wave_sum(s) * (1.f / 1024.f) + EPS);
#pragma unroll
        for (int j = 0; j < 4; ++j) { const int c0 = (j * 64 + lane) * 4;
            const f32x4 w = *(const f32x4*)(nw + c0), sc = *(const f32x4*)(mr + SCo + c0), sh = *(const f32x4*)(mr + SH + c0);
            const f32x4 r = (v[j] * rstd) * w * (sc + 1.f) + sh;
            u32x2 p; p.x = pk2(r.x, r.y); p.y = pk2(r.z, r.w); o[j * 64 + lane] = p; }
    }
}
namespace epi {
using pg8::Unit; using pg8::f32x4;
typedef unsigned u32x4 __attribute__((ext_vector_type(4)));
__device__ __forceinline__ u32x4 pack8(const f32x4& a, const f32x4& b) { u32x4 w; w.x = pg8::cvt_pk_bf16(a[0], a[1]); w.y = pg8::cvt_pk_bf16(a[2], a[3]); w.z = pg8::cvt_pk_bf16(b[0], b[1]); w.w = pg8::cvt_pk_bf16(b[2], b[3]); return w; }

struct InProj {
    static constexpr bool PERM = true, AFTER_DRAIN = false;
    unsigned char* ws; float* out;
    __device__ __forceinline__ void operator()(const f32x4 (&acc)[2][2][4][2], const Unit& u, int wr, int wc, int fr, int fq) const {
        const int pn = u.pn;
        const int rowb = u.pm * 256 + wr * 64 + fr;
        const int cl = wc * 32 + 8 * fq;
        if (pn < T_XBC || (pn >= T_MG && pn < T_MISC)) {
            bf16* base = pn < T_XBC ? (bf16*)(ws + WS_Z) : (bf16*)(ws + WS_MG);
            const int colt = (pn < T_XBC ? pn : pn - T_MG) * 256 + cl;
#pragma unroll
            for (int ai = 0; ai < 2; ++ai)
#pragma unroll
                for (int m = 0; m < 4; ++m) { const int row = rowb + ai * 128 + m * 16;
#pragma unroll
                    for (int bj = 0; bj < 2; ++bj) *(u32x4*)(base + (size_t)row * 2048 + colt + bj * 128) = pack8(acc[ai][bj][m][0], acc[ai][bj][m][1]); }
        } else if (pn < T_Q) {
            bf16* base = (bf16*)(ws + WS_XBC); const int colt = (pn - T_XBC) * 256 + cl;
#pragma unroll
            for (int ai = 0; ai < 2; ++ai)
#pragma unroll
                for (int m = 0; m < 4; ++m) { const int row = rowb + ai * 128 + m * 16;
                    float* fo = nullptr;
                    if (row < MP) { const int t = row & 4095; if (t >= 4093) fo = out + O_CONVP + ((size_t)(row >> 12) * 3 + (t - 4093)) * CONVD; }
                    else if (row < MALL) fo = out + O_CONVS + ((size_t)(row - MP) * 3 + 2) * CONVD;
#pragma unroll
                    for (int bj = 0; bj < 2; ++bj) { const int col = colt + bj * 128;
                        *(u32x4*)(base + (size_t)row * CONVD + col) = pack8(acc[ai][bj][m][0], acc[ai][bj][m][1]);
                        if (fo) { *(f32x4*)(fo + col) = acc[ai][bj][m][0]; *(f32x4*)(fo + col + 4) = acc[ai][bj][m][1]; } } }
        } else if (pn < T_MG) {
            const bool isq = pn < T_KV; const int s = pn - T_KV;
            const bool dorope = (isq || !(s & 1)) && !(wc & 1);
            const float* rope = (const float*)(ws + WS_ROPE);
#pragma unroll
            for (int ai = 0; ai < 2; ++ai)
#pragma unroll
                for (int m = 0; m < 4; ++m) { const int row = rowb + ai * 128 + m * 16;
                    const int pos = row < MP ? (row & 4095) : PAST;
#pragma unroll
                    for (int bj = 0; bj < 2; ++bj) {
                        f32x4 v0 = acc[ai][bj][m][0], v1 = acc[ai][bj][m][1];
                        if (dorope) {
                            f32x4 o0, o1;
#pragma unroll
                            for (int i = 0; i < 4; ++i) { o0[i] = __shfl_xor(v0[i], 16); o1[i] = __shfl_xor(v1[i], 16); }
                            if (fq < 2) {
                                const f32x4 c0 = *(const f32x4*)(rope + pos * 16), c1 = *(const f32x4*)(rope + pos * 16 + 4), s0 = *(const f32x4*)(rope + pos * 16 + 8), s1 = *(const f32x4*)(rope + pos * 16 + 12);
                                if (fq == 0) { v0 = v0 * c0 - o0 * s0; v1 = v1 * c1 - o1 * s1; }
                                else         { v0 = v0 * c0 + o0 * s0; v1 = v1 * c1 + o1 * s1; }
                            }
                        }
                        const int col = cl + bj * 128;
                        const u32x4 pk = pack8(v0, v1);
                        if (isq) { *(u32x4*)((bf16*)(ws + WS_Q) + (size_t)row * 1024 + (pn - T_Q) * 256 + col) = pk; }
                        else {
                            const int h = col >> 6, d = col & 63;
                            if (row < MP) {
                                const int b = row >> 12, t = row & 4095;
                                *(u32x4*)((bf16*)(ws + WS_KVH) + ((((size_t)s * 4 + b) * 4 + h) * 4096 + t) * 64 + d) = pk;
                                if (s < 4) { float* fo = out + O_KVP + ((size_t)row * 4 + s) * 256 + col; *(f32x4*)fo = v0; *(f32x4*)(fo + 4) = v1; }
                                else if (t >= 3584) { float* fo = out + O_WINP + (((size_t)b * 512 + (t - 3584)) * 2 + (s - 4)) * 256 + col; *(f32x4*)fo = v0; *(f32x4*)(fo + 4) = v1; }
                                if (s == 3 || s == 5) {
                                    const int kk = t & 31, kpos = 8 * ((kk & 15) >> 2) + 4 * (kk >> 4) + (kk & 3);
                                    bf16* vt = (bf16*)(ws + WS_VT) + ((((size_t)(s == 5) * 4 + b) * 4 + h) * 128 + (t >> 5)) * 2048 + d * 32 + kpos;
                                    vt[0 * 32] = (bf16)(pk.x & 0xffffu); vt[1 * 32] = (bf16)(pk.x >> 16); vt[2 * 32] = (bf16)(pk.y & 0xffffu); vt[3 * 32] = (bf16)(pk.y >> 16);
                                    vt[4 * 32] = (bf16)(pk.z & 0xffffu); vt[5 * 32] = (bf16)(pk.z >> 16); vt[6 * 32] = (bf16)(pk.w & 0xffffu); vt[7 * 32] = (bf16)(pk.w >> 16);
                                }
                            } else if (row < MALL) {
                                const int bs = row - MP;
                                float* fo = s < 4 ? out + O_KVS + ((size_t)bs * 4 + s) * 256 + col : out + O_WINS + (((size_t)bs * 512 + 511) * 2 + (s - 4)) * 256 + col;
                                *(f32x4*)fo = v0; *(f32x4*)(fo + 4) = v1;
                            }
                        }
                    } }
        } else {
            float* base = (float*)(ws + WS_MISC);
#pragma unroll
            for (int ai = 0; ai < 2; ++ai)
#pragma unroll
                for (int m = 0; m < 4; ++m) { const int row = rowb + ai * 128 + m * 16;
                    *(f32x4*)(base + (size_t)row * 128 + cl) = acc[ai][0][m][0]; *(f32x4*)(base + (size_t)row * 128 + cl + 4) = acc[ai][0][m][1]; }
        }
    }
};

struct Merge1 {
    static constexpr bool PERM = true, AFTER_DRAIN = false;
    unsigned char* ws;
    __device__ __forceinline__ void operator()(const f32x4 (&acc)[2][2][4][2], const Unit& u, int wr, int wc, int fr, int fq) const {
        const int rowb = u.pm * 256 + wr * 64 + fr, colb = u.pn * 256 + wc * 32 + 8 * fq;
        const bf16* MG = (const bf16*)(ws + WS_MG); const float* SSQ = (const float*)(ws + WS_SSQ); float* T = (float*)(ws + WS_TMPM);
#pragma unroll
        for (int ai = 0; ai < 2; ++ai)
#pragma unroll
            for (int m = 0; m < 4; ++m) { const int row = rowb + ai * 128 + m * 16;
                const f32x4 sq = *(const f32x4*)(SSQ + (size_t)row * 4);
                const float rstd = 1.f / sqrtf(((sq.x + sq.y) + (sq.z + sq.w)) * (1.f / 2048.f) + EPS);
#pragma unroll
                for (int bj = 0; bj < 2; ++bj) { const int col = colb + bj * 128;
                    const u32x4 g = *(const u32x4*)(MG + (size_t)row * 2048 + col);
                    f32x4 o0, o1;
                    o0[0] = sigmf(bflo(g.x)) * rstd * acc[ai][bj][m][0][0]; o0[1] = sigmf(bfhi(g.x)) * rstd * acc[ai][bj][m][0][1];
                    o0[2] = sigmf(bflo(g.y)) * rstd * acc[ai][bj][m][0][2]; o0[3] = sigmf(bfhi(g.y)) * rstd * acc[ai][bj][m][0][3];
                    o1[0] = sigmf(bflo(g.z)) * rstd * acc[ai][bj][m][1][0]; o1[1] = sigmf(bfhi(g.z)) * rstd * acc[ai][bj][m][1][1];
                    o1[2] = sigmf(bflo(g.w)) * rstd * acc[ai][bj][m][1][2]; o1[3] = sigmf(bfhi(g.w)) * rstd * acc[ai][bj][m][1][3];
                    *(f32x4*)(T + (size_t)row * 1024 + col) = o0; *(f32x4*)(T + (size_t)row * 1024 + col + 4) = o1; } }
    }
};
struct Merge2 {
    static constexpr bool PERM = true, AFTER_DRAIN = false;
    unsigned char* ws;
    __device__ __forceinline__ void operator()(const f32x4 (&acc)[2][2][4][2], const Unit& u, int wr, int wc, int fr, int fq) const {
        const int rowb = u.pm * 256 + wr * 64 + fr, colb = u.pn * 256 + wc * 32 + 8 * fq;
        const bf16* MG = (const bf16*)(ws + WS_MG); const float* T = (const float*)(ws + WS_TMPM); bf16* O = (bf16*)(ws + WS_MERGED);
#pragma unroll
        for (int ai = 0; ai < 2; ++ai)
#pragma unroll
            for (int m = 0; m < 4; ++m) { const int row = rowb + ai * 128 + m * 16;
#pragma unroll
                for (int bj = 0; bj < 2; ++bj) { const int col = colb + bj * 128;
                    const u32x4 g = *(const u32x4*)(MG + (size_t)row * 2048 + 1024 + col);
                    f32x4 o0 = *(const f32x4*)(T + (size_t)row * 1024 + col), o1 = *(const f32x4*)(T + (size_t)row * 1024 + col + 4);
                    o0[0] += sigmf(bflo(g.x)) * acc[ai][bj][m][0][0]; o0[1] += sigmf(bfhi(g.x)) * acc[ai][bj][m][0][1];
                    o0[2] += sigmf(bflo(g.y)) * acc[ai][bj][m][0][2]; o0[3] += sigmf(bfhi(g.y)) * acc[ai][bj][m][0][3];
                    o1[0] += sigmf(bflo(g.z)) * acc[ai][bj][m][1][0]; o1[1] += sigmf(bfhi(g.z)) * acc[ai][bj][m][1][1];
                    o1[2] += sigmf(bflo(g.w)) * acc[ai][bj][m][1][2]; o1[3] += sigmf(bfhi(g.w)) * acc[ai][bj][m][1][3];
                    *(u32x4*)(O + (size_t)row * 1024 + col) = pack8(o0, o1); } }
    }
};
struct Resid {
    static constexpr bool PERM = false, AFTER_DRAIN = false;
    const float* xp; const float* xs; const float* x1in; float* x1out; const float* MOD; int goff;
    __device__ __forceinline__ void operator()(const f32x4 (&acc)[2][2][4][2], const Unit& u, int wr, int wc, int fr, int fq) const {
        const int rowb = u.pm * 256 + wr * 64 + fr, colb = u.pn * 256 + wc * 32 + 4 * fq;
#pragma unroll
        for (int ai = 0; ai < 2; ++ai)
#pragma unroll
            for (int m = 0; m < 4; ++m) { const int row = rowb + ai * 128 + m * 16;
                if (row >= MALL) continue;
                const float* base = x1in ? x1in + (size_t)row * 1024 : (row < MP ? xp + (size_t)row * 1024 : xs + (size_t)(row - MP) * 1024);
                const float* gr = MOD + (size_t)(row < MP ? (row >> 12) : 4 + (row - MP)) * 6144 + goff;
#pragma unroll
                for (int bj = 0; bj < 2; ++bj)
#pragma unroll
                    for (int n = 0; n < 2; ++n) { const int col = colb + bj * 128 + n * 16;
                        *(f32x4*)(x1out + (size_t)row * 1024 + col) = *(const f32x4*)(base + col) + *(const f32x4*)(gr + col) * acc[ai][bj][m][n]; } }
    }
};
struct Up {
    static constexpr bool PERM = true, AFTER_DRAIN = false;
    unsigned char* ws; float* out;
    __device__ __forceinline__ void operator()(const f32x4 (&acc)[2][2][4][2], const Unit& u, int wr, int wc, int fr, int fq) const {
        const int rowb = u.pm * 256 + wr * 64 + fr, colb = u.pn * 256 + wc * 32 + 8 * fq;
        bf16* U = (bf16*)(ws + WS_U);
#pragma unroll
        for (int ai = 0; ai < 2; ++ai)
#pragma unroll
            for (int m = 0; m < 4; ++m) { const int row = rowb + ai * 128 + m * 16;
                float* fo = nullptr;
                if (row < MP) { const int t = row & 4095; if (t >= 4094) fo = out + O_FFNP + ((size_t)(row >> 12) * 2 + (t - 4094)) * DFF2; }
                else if (row < MALL) fo = out + O_FFNS + ((size_t)(row - MP) * 2 + 1) * DFF2;
#pragma unroll
                for (int bj = 0; bj < 2; ++bj) { const int col = colb + bj * 128;
                    *(u32x4*)(U + (size_t)row * DFF2 + col) = pack8(acc[ai][bj][m][0], acc[ai][bj][m][1]);
                    if (fo) { *(f32x4*)(fo + col) = acc[ai][bj][m][0]; *(f32x4*)(fo + col + 4) = acc[ai][bj][m][1]; } } }
    }
};
}
__device__ __forceinline__ void conv_prompt_item(const Args& args, int item, int lane) {
    unsigned char* ws = args.ws;
    const int tg = item / 48, cgp = item % 48, cg = lane & 7, rg = lane >> 3;
    const int m0 = tg * 64 + 8 * rg, b = m0 >> 12, t0 = m0 & 4095, ch0 = cgp * 64 + 8 * cg;
    const bf16* X = (const bf16*)(ws + WS_XBC);
    float x[11][8];
#pragma unroll
    for (int i = 0; i < 11; ++i) {
        const int t = t0 - 3 + i;
        u32x4 v = (u32x4){0u, 0u, 0u, 0u};
        if (t >= 0) v = *(const u32x4*)(X + (size_t)(m0 - 3 + i) * CONVD + ch0);
        x[i][0] = bflo(v.x); x[i][1] = bfhi(v.x); x[i][2] = bflo(v.y); x[i][3] = bfhi(v.y); x[i][4] = bflo(v.z); x[i][5] = bfhi(v.z); x[i][6] = bflo(v.w); x[i][7] = bfhi(v.w);
    }
    const float* cw = INF(16); const float* cb = INF(17);
    float w[4][8], bias[8];
#pragma unroll
    for (int k = 0; k < 4; ++k) { const f32x4 a = *(const f32x4*)(cw + k * CONVD + ch0), c = *(const f32x4*)(cw + k * CONVD + ch0 + 4);
        w[k][0] = a.x; w[k][1] = a.y; w[k][2] = a.z; w[k][3] = a.w; w[k][4] = c.x; w[k][5] = c.y; w[k][6] = c.z; w[k][7] = c.w; }
    { const f32x4 a = *(const f32x4*)(cb + ch0), c = *(const f32x4*)(cb + ch0 + 4); bias[0] = a.x; bias[1] = a.y; bias[2] = a.z; bias[3] = a.w; bias[4] = c.x; bias[5] = c.y; bias[6] = c.z; bias[7] = c.w; }
    float y[8][8];
#pragma unroll
    for (int i = 0; i < 8; ++i)
#pragma unroll
        for (int c = 0; c < 8; ++c) { const float a = bias[c] + w[0][c] * x[i][c] + w[1][c] * x[i + 1][c] + w[2][c] * x[i + 2][c] + w[3][c] * x[i + 3][c]; y[i][c] = siluf(a); }
    if (cgp < 32) {
        bf16* XT = (bf16*)(ws + WS_XT) + ((size_t)(b * 32 + cgp) * 64 + 8 * cg) * 4096 + t0;
#pragma unroll
        for (int c = 0; c < 8; ++c) { u32x4 o; o.x = pk2(y[0][c], y[1][c]); o.y = pk2(y[2][c], y[3][c]); o.z = pk2(y[4][c], y[5][c]); o.w = pk2(y[6][c], y[7][c]); *(u32x4*)(XT + (size_t)c * 4096) = o; }
    } else {
        const int isC = cgp >= 40, gg = ((cgp - 32) & 7) >> 1, n0 = ((cgp - 32) & 1) * 64 + 8 * cg;
        bf16* N = (bf16*)(ws + (isC ? WS_CN : WS_BN)) + ((size_t)(b * 4 + gg) * 4096 + t0) * 128 + n0;
#pragma unroll
        for (int i = 0; i < 8; ++i) { u32x4 o; o.x = pk2(y[i][0], y[i][1]); o.y = pk2(y[i][2], y[i][3]); o.z = pk2(y[i][4], y[i][5]); o.w = pk2(y[i][6], y[i][7]); *(u32x4*)(N + (size_t)i * 128) = o; }
        if (!isC) {
            bf16* BT = (bf16*)(ws + WS_BT) + ((size_t)(b * 4 + gg) * 128 + n0) * 4096 + t0;
#pragma unroll
            for (int c = 0; c < 8; ++c) { u32x4 o; o.x = pk2(y[0][c], y[1][c]); o.y = pk2(y[2][c], y[3][c]); o.z = pk2(y[4][c], y[5][c]); o.w = pk2(y[6][c], y[7][c]); *(u32x4*)(BT + (size_t)c * 4096) = o; }
        }
    }
}
__device__ __forceinline__ void dtcs_item(const Args& args, int item, int lane) {
    unsigned char* ws = args.ws;
    const int c = item & 31, h = (item >> 5) & 31, b = item >> 10;
    const float* MISC = (const float*)(ws + WS_MISC);
    const float bias = INF(18)[h], a = -__expf(INF(19)[h]);
    const int t = c * 128 + 2 * lane; const size_t m = (size_t)b * 4096 + t;
    const float d0 = softplusf(MISC[m * 128 + h] + bias), d1 = softplusf(MISC[(m + 1) * 128 + h] + bias);
    const float a0 = d0 * a, a1 = d1 * a;
    float s = a0 + a1;
#pragma unroll
    for (int o = 1; o < 64; o <<= 1) { const float v = __shfl_up(s, o); if (lane >= o) s += v; }
    const float c1 = s, c0 = s - a1;
    float* DT = (float*)(ws + WS_DT) + (size_t)(b * 32 + h) * 4096 + t; float* CS = (float*)(ws + WS_CS) + (size_t)(b * 32 + h) * 4096 + t;
    *(f32x2*)DT = (f32x2){d0, d1}; *(f32x2*)CS = (f32x2){c0, c1};
}
__device__ __forceinline__ void sample_conv(const Args& args, int gt, int NGT) {
    unsigned char* ws = args.ws; float* out = args.out;
    const float* st = INF(8); const float* cw = INF(16); const float* cb = INF(17);
    for (int i = gt; i < MS * CONVD; i += NGT) {
        const int bs = i / CONVD, ch = i % CONVD;
        const float s0 = st[((size_t)bs * 3 + 0) * CONVD + ch], s1 = st[((size_t)bs * 3 + 1) * CONVD + ch], s2 = st[((size_t)bs * 3 + 2) * CONVD + ch];
        const float xn = out[O_CONVS + ((size_t)bs * 3 + 2) * CONVD + ch];
        out[O_CONVS + ((size_t)bs * 3 + 0) * CONVD + ch] = s1; out[O_CONVS + ((size_t)bs * 3 + 1) * CONVD + ch] = s2;
        const float a = cb[ch] + cw[ch] * s0 + cw[CONVD + ch] * s1 + cw[2 * CONVD + ch] * s2 + cw[3 * CONVD + ch] * xn;
        ((float*)(ws + WS_XCS))[i] = siluf(a);
    }
    for (int i = gt; i < MS * NH; i += NGT) { const int bs = i >> 5, h = i & 31;
        ((float*)(ws + WS_DTS))[i] = softplusf(((const float*)(ws + WS_MISC))[(size_t)(MP + bs) * 128 + h] + INF(18)[h]); }
}

__device__ __forceinline__ void ssd_states_unit(const Args& args, LAS unsigned char* lds, int unit, int wave, int lane) {
    unsigned char* ws = args.ws;
    const int g = unit & 3, c = (unit >> 2) & 31, b = unit >> 7, h = g * 8 + wave, q = lane >> 4, r16 = lane & 15;
    LAS float* wl = (LAS float*)(lds + wave * 512);
    const float* DT = (const float*)(ws + WS_DT) + (size_t)(b * 32 + h) * 4096 + c * 128; const float* CS = (const float*)(ws + WS_CS) + (size_t)(b * 32 + h) * 4096 + c * 128;
    const float cl = CS[127];
    wl[lane] = DT[lane] * __expf(cl - CS[lane]); wl[lane + 64] = DT[lane + 64] * __expf(cl - CS[lane + 64]);
    LDS_WAIT(); asm volatile("" ::: "memory");
    const bf16* XT = (const bf16*)(ws + WS_XT) + (size_t)(b * 32 + h) * 64 * 4096 + c * 128;
    const bf16* BT = (const bf16*)(ws + WS_BT) + (size_t)(b * 4 + g) * 128 * 4096 + c * 128;
    float* ST = (float*)(ws + WS_STATES) + (((size_t)(b * 32 + c) * 32 + h) * 64) * 128;
#pragma unroll 1
    for (int nh = 0; nh < 2; ++nh) {
        f32x4 acc[4][4];
#pragma unroll
        for (int i = 0; i < 4; ++i)
#pragma unroll
            for (int j = 0; j < 4; ++j) acc[i][j] = (f32x4){0.f, 0.f, 0.f, 0.f};
#pragma unroll 1
        for (int ks = 0; ks < 4; ++ks) {
            const int s0 = 32 * ks + 8 * q;
            const f32x4 w0 = *(const LAS f32x4*)(wl + s0), w1 = *(const LAS f32x4*)(wl + s0 + 4);
            bf16x8 af[4];
#pragma unroll
            for (int pt = 0; pt < 4; ++pt) { const u32x4 v = *(const u32x4*)(XT + (size_t)(16 * pt + r16) * 4096 + s0);
                u32x4 o; o.x = pk2(bflo(v.x) * w0.x, bfhi(v.x) * w0.y); o.y = pk2(bflo(v.y) * w0.z, bfhi(v.y) * w0.w); o.z = pk2(bflo(v.z) * w1.x, bfhi(v.z) * w1.y); o.w = pk2(bflo(v.w) * w1.z, bfhi(v.w) * w1.w);
                af[pt] = __builtin_bit_cast(bf16x8, o); }
#pragma unroll
            for (int nt = 0; nt < 4; ++nt) { const bf16x8 bf = *(const bf16x8*)(BT + (size_t)(64 * nh + 16 * nt + r16) * 4096 + s0);
#pragma unroll
                for (int pt = 0; pt < 4; ++pt) acc[pt][nt] = MFMA16(af[pt], bf, acc[pt][nt]); }
        }
#pragma unroll
        for (int pt = 0; pt < 4; ++pt)
#pragma unroll
            for (int nt = 0; nt < 4; ++nt)
#pragma unroll
                for (int r = 0; r < 4; ++r) ST[(size_t)(16 * pt + 4 * q + r) * 128 + 64 * nh + 16 * nt + r16] = acc[pt][nt][r];
    }
}

template <int SAMPLE>
__device__ __forceinline__ void compress2_item(const Args& args, int item, int lane) {
    unsigned char* ws = args.ws;
    const int q = lane >> 4, r16 = lane & 15;
    constexpr int NPB = SAMPLE ? 128 : 256;
    constexpr int NI = (SAMPLE ? 65536 : 4096) / 16;
    const int st = item / NI, row0 = (item % NI) * 16;
    const float* P = (const float*)(ws + (SAMPLE ? (st ? WS_PARTSV : WS_PARTSK) : (st ? WS_PARTV : WS_PARTK))) + (size_t)(row0 + r16) * 256;
    const float* pet = (const float*)(ws + WS_PET) + st * 128;
    const bf16* W2T = (const bf16*)(ws + WS_W2T) + st * 8192;
    f32x4 acc[4];
#pragma unroll
    for (int dt = 0; dt < 4; ++dt) acc[dt] = (f32x4){0.f, 0.f, 0.f, 0.f};
#pragma unroll
    for (int ks = 0; ks < 4; ++ks) {
        const int e0 = 32 * ks + 8 * q;
        const f32x4 a0 = *(const f32x4*)(P + e0), a1 = *(const f32x4*)(P + e0 + 4), b0 = *(const f32x4*)(P + 256 + 128 + e0), b1 = *(const f32x4*)(P + 256 + 128 + e0 + 4);
        const f32x4 p0 = *(const f32x4*)(pet + e0), p1 = *(const f32x4*)(pet + e0 + 4);
        const f32x4 h0 = a0 + b0 + p0, h1 = a1 + b1 + p1;
        u32x4 o; o.x = pk2(siluf(h0.x), siluf(h0.y)); o.y = pk2(siluf(h0.z), siluf(h0.w)); o.z = pk2(siluf(h1.x), siluf(h1.y)); o.w = pk2(siluf(h1.z), siluf(h1.w));
        const bf16x8 af = __builtin_bit_cast(bf16x8, o);
#pragma unroll
        for (int dt = 0; dt < 4; ++dt) { const bf16x8 bf = *(const bf16x8*)(W2T + (size_t)(16 * dt + r16) * 128 + e0); acc[dt] = MFMA16(af, bf, acc[dt]); }
    }
    const int bh = row0 / NPB, n0 = row0 % NPB + 4 * q;
#pragma unroll
    for (int dt = 0; dt < 4; ++dt) {
        const int d = 16 * dt + r16;
        float v[4];
#pragma unroll
        for (int r = 0; r < 4; ++r) v[r] = (n0 + r < NPB - 1) ? acc[dt][r] : 0.f;
        if (SAMPLE) {
            float* o = (float*)(ws + (st ? WS_VCS : WS_KCS)) + ((size_t)bh * 128 + n0) * 64 + d;
#pragma unroll
            for (int r = 0; r < 4; ++r) o[r * 64] = v[r];
        } else if (st == 0) {
            bf16* o = (bf16*)(ws + WS_KC) + ((size_t)bh * 256 + n0) * 64 + d;
#pragma unroll
            for (int r = 0; r < 4; ++r) o[r * 64] = (bf16)f2bf(v[r]);
        } else {
            u32x2 w; w.x = pk2(v[0], v[1]); w.y = pk2(v[2], v[3]);
            *(u32x2*)((bf16*)(ws + WS_VCT) + ((size_t)bh * 64 + d) * 256 + n0) = w;
        }
    }
}

__device__ __forceinline__ void sample_ssm_item(const Args& args, LAS unsigned char* lds, int item, int wave, int lane) {
    unsigned char* ws = args.ws; float* out = args.out;
    const int h = item & 31, bs = item >> 5, g = h >> 3;
    const float* XC = (const float*)(ws + WS_XCS) + (size_t)bs * CONVD;
    const float dt = ((const float*)(ws + WS_DTS))[bs * 32 + h], a = -__expf(INF(19)[h]), dec = __expf(dt * a), Dh = INF(20)[h];
    const f32x2 Bv = *(const f32x2*)(XC + 2048 + g * 128 + 2 * lane), Cv = *(const f32x2*)(XC + 2560 + g * 128 + 2 * lane);
    const float xl = XC[h * 64 + lane];
    const float* H0 = INF(7) + ((size_t)(bs * 32 + h) * 64) * 128; float* HN = out + O_SSMS + ((size_t)(bs * 32 + h) * 64) * 128;
    float ymine = 0.f;
#pragma unroll 8
    for (int p = 0; p < 64; ++p) {
        const float xp = __shfl(xl, p);
        const f32x2 h0 = *(const f32x2*)(H0 + p * 128 + 2 * lane);
        f32x2 hn; hn.x = h0.x * dec + dt * xp * Bv.x; hn.y = h0.y * dec + dt * xp * Bv.y;
        *(f32x2*)(HN + p * 128 + 2 * lane) = hn;
        const float yp = wave_sum(hn.x * Cv.x + hn.y * Cv.y);
        ymine = (lane == p) ? yp : ymine;
    }
    const float y = ymine + Dh * xl;
    const size_t m = MP + bs;
    const float z = bf2f(((const bf16*)(ws + WS_Z))[m * 2048 + h * 64 + lane]);
    const float v = y * siluf(z);
    ((bf16*)(ws + WS_YSSM))[m * 2048 + h * 64 + lane] = (bf16)f2bf(v * INF(21)[h * 64 + lane]);
    const float ss = wave_sum(v * v);
    if (lane == 0) ((float*)(ws + WS_MISC))[m * 128 + 80 + h] = ss;
}
__device__ __forceinline__ void scan_phase(const Args& args, int gt, int NGT) {
    unsigned char* ws = args.ws; float* out = args.out;
    for (int i = gt; i < 4 * 32 * 64 * 32; i += NGT) {
        const int n4 = i & 31, p = (i >> 5) & 63, h = (i >> 11) & 31, b = i >> 16;
        const float* CS = (const float*)(ws + WS_CS) + (size_t)(b * 32 + h) * 4096;
        f32x4 run = (f32x4){0.f, 0.f, 0.f, 0.f};
#pragma unroll 4
        for (int c = 0; c < 32; ++c) {
            const size_t off = ((((size_t)(b * 32 + c) * 32 + h) * 64 + p) * 128) + 4 * n4;
            const f32x4 st = *(const f32x4*)((const float*)(ws + WS_STATES) + off);
            u32x2 o; o.x = pk2(run.x, run.y); o.y = pk2(run.z, run.w);
            *(u32x2*)((bf16*)(ws + WS_HPREV) + off) = o;
            const float dec = __expf(CS[c * 128 + 127]);
            run = run * dec + st;
        }
        *(f32x4*)(out + O_SSMP + (((size_t)(b * 32 + h) * 64 + p) * 128) + 4 * n4) = run;
    }
    for (int i = gt; i < MS * 4; i += NGT) { const int bs = i >> 2, g = i & 3; const float* p = (const float*)(ws + WS_MISC) + (size_t)(MP + bs) * 128 + 80 + g * 8;
        ((float*)(ws + WS_SSQ))[(size_t)(MP + bs) * 4 + g] = ((p[0] + p[1]) + (p[2] + p[3])) + ((p[4] + p[5]) + (p[6] + p[7])); }
}

__device__ __forceinline__ void ssd_out_unit(const Args& args, LAS unsigned char* lds, int unit, int wave, int lane, int tid) {
    unsigned char* ws = args.ws;
    const int g = unit & 3, c = (unit >> 2) & 31, b = unit >> 7, h = g * 8 + wave, q = lane >> 4, r16 = lane & 15;
    LAS float* CBT = (LAS float*)lds; LAS float* SQ = (LAS float*)(lds + 65536);
    const bf16* Bn = (const bf16*)(ws + WS_BN) + ((size_t)(b * 4 + g) * 4096 + c * 128) * 128;
    const bf16* Cn = (const bf16*)(ws + WS_CN) + ((size_t)(b * 4 + g) * 4096 + c * 128) * 128;
    {
        bf16x8 af[4];
#pragma unroll
        for (int ks = 0; ks < 4; ++ks) af[ks] = *(const bf16x8*)(Bn + (size_t)(16 * wave + r16) * 128 + 32 * ks + 8 * q);
        for (int lt = wave; lt < 8; ++lt) {
            f32x4 d = (f32x4){0.f, 0.f, 0.f, 0.f};
#pragma unroll
            for (int ks = 0; ks < 4; ++ks) { const bf16x8 bf = *(const bf16x8*)(Cn + (size_t)(16 * lt + r16) * 128 + 32 * ks + 8 * q); d = MFMA16(af[ks], bf, d); }
#pragma unroll
            for (int r = 0; r < 4; ++r) CBT[((wave * 8 + lt) * 4 + r) * 64 + lane] = d[r];
        }
    }
    __syncthreads();
    const float* DT = (const float*)(ws + WS_DT) + (size_t)(b * 32 + h) * 4096 + c * 128; const float* CS = (const float*)(ws + WS_CS) + (size_t)(b * 32 + h) * 4096 + c * 128;
    const float Dh = INF(20)[h];
    const bf16* HP = (const bf16*)(ws + WS_HPREV) + (((size_t)(b * 32 + c) * 32 + h) * 64) * 128;
    const bf16* XT = (const bf16*)(ws + WS_XT) + (size_t)(b * 32 + h) * 64 * 4096 + c * 128;
    const bf16* Z = (const bf16*)(ws + WS_Z); bf16* Y = (bf16*)(ws + WS_YSSM); const float* nw = INF(21) + h * 64;
#pragma unroll
    for (int hl = 0; hl < 2; ++hl) {
        float csl[4];
#pragma unroll
        for (int lt = 0; lt < 4; ++lt) csl[lt] = CS[64 * hl + 16 * lt + r16];
        f32x4 acc[4][4];
#pragma unroll
        for (int i = 0; i < 4; ++i)
#pragma unroll
            for (int j = 0; j < 4; ++j) acc[i][j] = (f32x4){0.f, 0.f, 0.f, 0.f};
#pragma unroll 1
        for (int ks = 0; ks < 4; ++ks) {
            bf16x8 af[4];
#pragma unroll
            for (int pt = 0; pt < 4; ++pt) af[pt] = *(const bf16x8*)(HP + (size_t)(16 * pt + r16) * 128 + 32 * ks + 8 * q);
#pragma unroll
            for (int lt = 0; lt < 4; ++lt) { const bf16x8 bf = *(const bf16x8*)(Cn + (size_t)(64 * hl + 16 * lt + r16) * 128 + 32 * ks + 8 * q);
#pragma unroll
                for (int pt = 0; pt < 4; ++pt) acc[pt][lt] = MFMA16(af[pt], bf, acc[pt][lt]); }
        }
#pragma unroll
        for (int lt = 0; lt < 4; ++lt) { const float e = __expf(csl[lt]);
#pragma unroll
            for (int pt = 0; pt < 4; ++pt) acc[pt][lt] = acc[pt][lt] * e; }
#pragma unroll
        for (int i = 0; i < 2 * hl + 2; ++i) {
            const int sa = 32 * i + 4 * q, sb = sa + 16;
            const f32x4 csa = *(const f32x4*)(CS + sa), csb = *(const f32x4*)(CS + sb), dta = *(const f32x4*)(DT + sa), dtb = *(const f32x4*)(DT + sb);
            bf16x8 af[4];
#pragma unroll
            for (int pt = 0; pt < 4; ++pt) { const u32x2 lo = *(const u32x2*)(XT + (size_t)(16 * pt + r16) * 4096 + sa), hi = *(const u32x2*)(XT + (size_t)(16 * pt + r16) * 4096 + sb);
                af[pt] = __builtin_bit_cast(bf16x8, (u32x4){lo.x, lo.y, hi.x, hi.y}); }
#pragma unroll
            for (int lt = 0; lt < 4; ++lt) {
                const int LT = 4 * hl + lt;
                if (LT < 2 * i) continue;
                const int l = 16 * LT + r16;
                float ga[4], gb[4];
#pragma unroll
                for (int r = 0; r < 4; ++r) {
                    const float va = CBT[(((2 * i) * 8 + LT) * 4 + r) * 64 + lane];
                    const float vb = (LT >= 2 * i + 1) ? CBT[(((2 * i + 1) * 8 + LT) * 4 + r) * 64 + lane] : 0.f;
                    const int s1 = sa + r, s2 = sb + r;
                    float x1 = (l >= s1) ? va * __expf(csl[lt] - csa[r]) * dta[r] : 0.f;
                    float x2 = (l >= s2) ? vb * __expf(csl[lt] - csb[r]) * dtb[r] : 0.f;
                    if (l == s1) x1 += Dh;
                    if (l == s2) x2 += Dh;
                    ga[r] = x1; gb[r] = x2;
                }
                u32x4 o; o.x = pk2(ga[0], ga[1]); o.y = pk2(ga[2], ga[3]); o.z = pk2(gb[0], gb[1]); o.w = pk2(gb[2], gb[3]);
                const bf16x8 bf = __builtin_bit_cast(bf16x8, o);
#pragma unroll
                for (int pt = 0; pt < 4; ++pt) acc[pt][lt] = MFMA16(af[pt], bf, acc[pt][lt]);
            }
        }
#pragma unroll
        for (int lt = 0; lt < 4; ++lt) {
            const size_t m = (size_t)b * 4096 + c * 128 + 64 * hl + 16 * lt + r16;
            float ss = 0.f;
#pragma unroll
            for (int pt = 0; pt < 4; ++pt) {
                const int ch = 16 * pt + 4 * q;
                const u32x2 zz = *(const u32x2*)(Z + m * 2048 + h * 64 + ch); const f32x4 w = *(const f32x4*)(nw + ch);
                const float v0 = acc[pt][lt][0] * siluf(bflo(zz.x)), v1 = acc[pt][lt][1] * siluf(bfhi(zz.x)), v2 = acc[pt][lt][2] * siluf(bflo(zz.y)), v3 = acc[pt][lt][3] * siluf(bfhi(zz.y));
                ss += (v0 * v0 + v1 * v1) + (v2 * v2 + v3 * v3);
                u32x2 o; o.x = pk2(v0 * w.x, v1 * w.y); o.y = pk2(v2 * w.z, v3 * w.w);
                *(u32x2*)(Y + m * 2048 + h * 64 + ch) = o;
            }
            ss += __shfl_xor(ss, 16); ss += __shfl_xor(ss, 32);
            if (q == 0) SQ[wave * 128 + 64 * hl + 16 * lt + r16] = ss;
        }
    }
    __syncthreads();
    if (tid < 128) { float s = 0.f;
#pragma unroll
        for (int w = 0; w < 8; ++w) s += SQ[w * 128 + tid];
        ((float*)(ws + WS_SSQ))[((size_t)b * 4096 + c * 128 + tid) * 4 + g] = s; }
    __syncthreads();
}
constexpr float SC2 = 0.125f * 1.4426950408889634f;
__device__ __forceinline__ float max3f(float a, float b, float c) { float r; asm("v_max3_f32 %0, %1, %2, %3" : "=v"(r) : "v"(a), "v"(b), "v"(c)); return r; }
template <class T> __device__ __forceinline__ T ldu(const void* ubase, unsigned lane_off) { return *(const T*)((const char*)ubase + lane_off); }
struct KFrag { bf16x8 kf[2][2]; };
__device__ __forceinline__ void flash_load(const bf16* Kp, int kb, unsigned koff, KFrag& F) {
#pragma unroll
    for (int kt = 0; kt < 2; ++kt) { const bf16* kr = Kp + (size_t)(kb + 16 * kt) * 64; F.kf[kt][0] = ldu<bf16x8>(kr, koff); F.kf[kt][1] = ldu<bf16x8>(kr + 32, koff); }
}
template <int MODE>
__device__ __forceinline__ void flash_step(const KFrag& F, const bf16* VTp, unsigned voff, int kb, int t0, int t, bool selbit, const LAS bf16x8* Qs,
                                           f32x4 (&O)[4][4], float (&mx)[4], f32x4 (&L)[4], int q) {
    const bf16x8 ones = __builtin_bit_cast(bf16x8, (u32x4){0x3f803f80u, 0x3f803f80u, 0x3f803f80u, 0x3f803f80u});
    const bool edge = (kb + 31 > t0) || (MODE == 1 && kb + 512 <= t0 + 15);
    bf16x8 vf[4];
#pragma unroll
    for (int dt = 0; dt < 4; ++dt) vf[dt] = ldu<bf16x8>(VTp + (size_t)(kb >> 5) * 2048 + (16 * dt) * 32, voff);
#pragma unroll
    for (int g = 0; g < 4; ++g) {
        asm volatile("" ::: "memory");
        __builtin_amdgcn_sched_barrier(0);
        const bf16x8 q0 = Qs[(g * 2 + 0) * 64], q1 = Qs[(g * 2 + 1) * 64];
        f32x4 S0 = MFMA16(F.kf[0][0], q0, ((f32x4){0.f, 0.f, 0.f, 0.f})), S1 = MFMA16(F.kf[1][0], q0, ((f32x4){0.f, 0.f, 0.f, 0.f}));
        S0 = MFMA16(F.kf[0][1], q1, S0); S1 = MFMA16(F.kf[1][1], q1, S1);
        float s[8];
#pragma unroll
        for (int r = 0; r < 4; ++r) { s[r] = S0[r]; s[4 + r] = S1[r]; }
        if (edge) {
#pragma unroll
            for (int i = 0; i < 8; ++i) { const int key = kb + 16 * (i >> 2) + 4 * q + (i & 3);
                const bool ok = (MODE == 0) ? (key <= t) : (key <= t && key + 512 > t); s[i] = ok ? s[i] : NEGF; }
        }
        float lm = max3f(max3f(s[0], s[1], s[2]), max3f(s[3], s[4], s[5]), fmaxf(s[6], s[7])) * SC2;
        if (MODE == 0) lm = selbit ? lm : NEGF;
        if (__builtin_amdgcn_ballot_w64(lm > mx[g] + 8.f) != 0ull) {
            float tmax = fmaxf(lm, __shfl_xor(lm, 16)); tmax = fmaxf(tmax, __shfl_xor(tmax, 32));
            const float mnew = fmaxf(mx[g], tmax), alpha = __builtin_amdgcn_exp2f(mx[g] - mnew); mx[g] = mnew; L[g] = L[g] * alpha;
#pragma unroll
            for (int dt = 0; dt < 4; ++dt) O[dt][g] = O[dt][g] * alpha;
        }
        float nmuse = -fmaxf(mx[g], -1e20f);
        if (MODE == 0) nmuse = selbit ? nmuse : NEGF;
#pragma unroll
        for (int i = 0; i < 8; ++i) s[i] = __builtin_amdgcn_exp2f(__builtin_fmaf(s[i], SC2, nmuse));
        u32x4 pw; pw.x = pk2(s[0], s[1]); pw.y = pk2(s[2], s[3]); pw.z = pk2(s[4], s[5]); pw.w = pk2(s[6], s[7]);
        const bf16x8 pf = __builtin_bit_cast(bf16x8, pw);
        L[g] = MFMA16(ones, pf, L[g]);
#pragma unroll
        for (int dt = 0; dt < 4; ++dt) O[dt][g] = MFMA16(vf[dt], pf, O[dt][g]);
    }
}
template <int MODE>
__device__ __forceinline__ void flash_branch(const bf16* Kp, const bf16* VTp, int jfirst, int jlast, unsigned ulo, unsigned uhi, unsigned mlo, unsigned mhi,
                                             int t0, int t, const LAS bf16x8* Qs, f32x4 (&O)[4][4], float (&mx)[4], f32x4 (&L)[4], int q, int r16) {
    const unsigned koff = (unsigned)(r16 * 64 + 8 * q) * 2u, voff = (unsigned)(r16 * 32 + 8 * q) * 2u;
    int jb = jfirst;
    while (jb <= jlast && !((jb < 32 ? (ulo >> jb) : (uhi >> (jb - 32))) & 1u)) ++jb;
    if (jb > jlast) return;
    KFrag A, B;
    flash_load(Kp, 64 * jb, koff, A);
    for (;;) {
        flash_load(Kp, 64 * jb + 32, koff, B);
        const bool selbit = ((jb < 32 ? (mlo >> jb) : (mhi >> (jb - 32))) & 1u) != 0u;
        flash_step<MODE>(A, VTp, voff, 64 * jb, t0, t, selbit, Qs, O, mx, L, q);
        int jn = jb + 1;
        while (jn <= jlast && !((jn < 32 ? (ulo >> jn) : (uhi >> (jn - 32))) & 1u)) ++jn;
        if (jn <= jlast) flash_load(Kp, 64 * jn, koff, A);
        flash_step<MODE>(B, VTp, voff, 64 * jb + 32, t0, t, selbit, Qs, O, mx, L, q);
        if (jn > jlast) break;
        jb = jn;
    }
}

template <int BR>
__device__ __forceinline__ void attn_finish(const Args& args, f32x4 (&O)[4][4], const f32x4 (&L)[4], bool normalise, size_t m, int hkv, int q) {
    unsigned char* ws = args.ws;
    const float* gates = (const float*)(ws + WS_MISC) + m * 128 + 32;
    const unsigned yoff = (unsigned)((m & 15) * 1024 + 4 * q) * 4u, yboff = yoff >> 1;
#pragma unroll
    for (int g = 0; g < 4; ++g) {
        float sc = sigmf(gates[(hkv * 4 + g) * 3 + BR]);
        if (normalise) sc *= 1.f / fmaxf(L[g][0], TINYF);
#pragma unroll
        for (int dt = 0; dt < 4; ++dt) {
            char* yfu = (char*)((float*)(ws + WS_YATTF) + (m & ~(size_t)15) * 1024 + (hkv * 4 + g) * 64 + 16 * dt);
            f32x4 v = O[dt][g] * sc;
            if (BR > 0) v = v + *(const f32x4*)(yfu + yoff);
            if (BR < 2) *(f32x4*)(yfu + yoff) = v;
            else { u32x2 o; o.x = pk2(v.x, v.y); o.y = pk2(v.z, v.w); *(u32x2*)((char*)((bf16*)(ws + WS_YATT) + (m & ~(size_t)15) * 1024 + (hkv * 4 + g) * 64 + 16 * dt) + yboff) = o; }
        }
    }
}

__device__ __forceinline__ void attn_prompt_unit(const Args& args, LAS float* impL, int unit, bool xcdmap, int lane_in) {
    int lane = lane_in; asm volatile("" : "+v"(lane));
    unsigned char* ws = args.ws;
    const int q = lane >> 4, r16 = lane & 15;
    const int pass = unit >> 11, gwv = unit & 2047, xcd = (gwv >> 3) & 7, wx = (gwv >> 6) * 8 + (gwv & 7);
    const int bh = xcdmap ? 2 * xcd + pass : (unit & 15), b = bh >> 2, hkv = bh & 3;
    const int tile = xcdmap ? (pass == 0 ? 255 - wx : wx) : (unit < 2048 ? 255 - (unit >> 4) : (unit - 2048) >> 4);
    const int t0 = tile * 16, t = t0 + r16; const size_t m = (size_t)b * 4096 + t;
    LAS bf16x8* Qs = (LAS bf16x8*)(impL + 1024) + lane;
#pragma unroll
    for (int g = 0; g < 4; ++g)
#pragma unroll
        for (int ks = 0; ks < 2; ++ks) Qs[(g * 2 + ks) * 64] = ldu<bf16x8>((const bf16*)(ws + WS_Q) + ((size_t)b * 4096 + t0) * 1024 + (hkv * 4 + g) * 64 + 32 * ks, (unsigned)(r16 * 1024 + 8 * q) * 2u);
    LDS_WAIT(); asm volatile("" ::: "memory");
    f32x4 O[4][4]; float mx[4], ls[4];
    const bf16* KCp = (const bf16*)(ws + WS_KC) + (size_t)bh * 256 * 64; const bf16* VCTp = (const bf16*)(ws + WS_VCT) + (size_t)bh * 64 * 256;
    const unsigned kcoff = (unsigned)(r16 * 64 + 8 * q) * 2u, vcoff = (unsigned)(r16 * 256 + 4 * q) * 2u;
    const int nmax = (t0 + 15 >= 31) ? ((t0 + 15 - 31) >> 4) : -1;
    const int NP = nmax < 0 ? 0 : (nmax / 32 + 2 < 8 ? nmax / 32 + 2 : 8);
#pragma unroll
    for (int g = 0; g < 4; ++g) { mx[g] = NEGF; ls[g] = 0.f; }
    for (int kt = 0; kt < 2 * NP; ++kt) {
        const bf16* kr = KCp + (size_t)(16 * kt) * 64;
        const bf16x8 k0 = ldu<bf16x8>(kr, kcoff), k1 = ldu<bf16x8>(kr + 32, kcoff);
#pragma unroll
        for (int g = 0; g < 4; ++g) {
            f32x4 s = MFMA16(k0, Qs[(g * 2 + 0) * 64], ((f32x4){0.f, 0.f, 0.f, 0.f})); s = MFMA16(k1, Qs[(g * 2 + 1) * 64], s);
            float tmax = NEGF;
#pragma unroll
            for (int r = 0; r < 4; ++r) { const int n = 16 * kt + 4 * q + r; const bool ok = (16 * n + 31 <= t); s[r] = ok ? s[r] * 0.125f : NEGF; tmax = fmaxf(tmax, s[r]); }
            const float mnew = fmaxf(mx[g], tmax); float ps = 0.f;
#pragma unroll
            for (int r = 0; r < 4; ++r) ps += (s[r] > 0.5f * NEGF) ? __expf(s[r] - mnew) : 0.f;
            ls[g] = ls[g] * __expf(mx[g] - mnew) + ps; mx[g] = mnew;
        }
    }
    float invL[4];
#pragma unroll
    for (int g = 0; g < 4; ++g) {
        float M = fmaxf(mx[g], __shfl_xor(mx[g], 16)); M = fmaxf(M, __shfl_xor(M, 32));
        float l = ls[g] * __expf(mx[g] - M); l += __shfl_xor(l, 16); l += __shfl_xor(l, 32);
        mx[g] = M; invL[g] = 1.f / fmaxf(l, TINYF);
    }
#pragma unroll
    for (int dt = 0; dt < 4; ++dt)
#pragma unroll
        for (int g = 0; g < 4; ++g) O[dt][g] = (f32x4){0.f, 0.f, 0.f, 0.f};
    float prev3 = 0.f;
#pragma unroll
    for (int kt = 0; kt < 16; ++kt) impL[kt * 64 + lane] = 0.f;
#pragma unroll 1
    for (int i = 0; i < NP; ++i) {
        f32x4 P[2][4];
#pragma unroll
        for (int kk = 0; kk < 2; ++kk) {
            const int kt = 2 * i + kk;
            const bf16* kr = KCp + (size_t)(16 * kt) * 64;
            const bf16x8 k0 = ldu<bf16x8>(kr, kcoff), k1 = ldu<bf16x8>(kr + 32, kcoff);
            f32x4 psum = (f32x4){0.f, 0.f, 0.f, 0.f};
#pragma unroll
            for (int g = 0; g < 4; ++g) {
                f32x4 s = MFMA16(k0, Qs[(g * 2 + 0) * 64], ((f32x4){0.f, 0.f, 0.f, 0.f})); s = MFMA16(k1, Qs[(g * 2 + 1) * 64], s);
#pragma unroll
                for (int r = 0; r < 4; ++r) { const int n = 16 * kt + 4 * q + r; const bool ok = (16 * n + 31 <= t); s[r] = ok ? __expf(s[r] * 0.125f - mx[g]) * invL[g] : 0.f; }
                P[kk][g] = s; psum = psum + s;
            }
            const float a = __shfl(psum[3], (lane + 48) & 63), bb = __shfl(prev3, (lane + 48) & 63);
            impL[kt * 64 + lane] = 2.f * (psum[0] + psum[1] + psum[2]) + psum[3] + (q > 0 ? a : bb);
            prev3 = psum[3];
        }
        bf16x8 vf[4];
#pragma unroll
        for (int dt = 0; dt < 4; ++dt) { const bf16* vr = VCTp + (size_t)(16 * dt) * 256 + 32 * i;
            const u32x2 lo = ldu<u32x2>(vr, vcoff), hi = ldu<u32x2>(vr + 16, vcoff); vf[dt] = __builtin_bit_cast(bf16x8, (u32x4){lo.x, lo.y, hi.x, hi.y}); }
#pragma unroll
        for (int g = 0; g < 4; ++g) {
            u32x4 pw; pw.x = pk2(P[0][g][0], P[0][g][1]); pw.y = pk2(P[0][g][2], P[0][g][3]); pw.z = pk2(P[1][g][0], P[1][g][1]); pw.w = pk2(P[1][g][2], P[1][g][3]);
            const bf16x8 pf = __builtin_bit_cast(bf16x8, pw);
#pragma unroll
            for (int dt = 0; dt < 4; ++dt) O[dt][g] = MFMA16(vf[dt], pf, O[dt][g]);
        }
    }
    f32x4 L[4];
#pragma unroll
    for (int g = 0; g < 4; ++g) L[g] = (f32x4){1.f, 1.f, 1.f, 1.f};
    attn_finish<0>(args, O, L, false, m, hkv, q);
    unsigned mlo = 0u, mhi = 0u;
    {
        const int cur = t >> 6;
        LDS_WAIT(); asm volatile("" ::: "memory");
        float v[16];
#pragma unroll
        for (int kt = 0; kt < 16; ++kt) { const int j = 4 * kt + q; const bool valid = (64 * j <= t), forced = (j == 0) || (j == cur) || (j == cur - 1);
            v[kt] = valid ? (forced ? BIGF : impL[kt * 64 + lane]) : -BIGF; }
#pragma unroll
        for (int kt = 0; kt < 16; ++kt) impL[kt * 64 + lane] = v[kt];
        LDS_WAIT(); asm volatile("" ::: "memory");
        int rank[16];
#pragma unroll
        for (int kt = 0; kt < 16; ++kt) rank[kt] = 0;
#pragma unroll 1
        for (int rot = 0; rot < 4; ++rot) {
#pragma unroll 2
            for (int kk = 0; kk < 16; ++kk) {
                const float o = impL[kk * 64 + (lane ^ (16 * rot))];
                const int oj = 4 * kk + (q ^ rot);
#pragma unroll
                for (int kt = 0; kt < 16; ++kt) { const int myj = 4 * kt + q; rank[kt] += ((o > v[kt]) || (o == v[kt] && oj < myj)) ? 1 : 0; }
            }
        }
#pragma unroll
        for (int kt = 0; kt < 16; ++kt) { const int j = 4 * kt + q; const unsigned bit = rank[kt] < 16 ? 1u : 0u; if (kt < 8) mlo |= bit << j; else mhi |= bit << (j - 32); }
        mlo |= __shfl_xor(mlo, 16); mlo |= __shfl_xor(mlo, 32); mhi |= __shfl_xor(mhi, 16); mhi |= __shfl_xor(mhi, 32);
    }
    unsigned ulo = mlo, uhi = mhi;
#pragma unroll
    for (int o = 1; o < 16; o <<= 1) { ulo |= __shfl_xor(ulo, o); uhi |= __shfl_xor(uhi, o); }
    ulo = __builtin_amdgcn_readfirstlane(ulo); uhi = __builtin_amdgcn_readfirstlane(uhi);
    {
#pragma unroll
        for (int g = 0; g < 4; ++g) { mx[g] = NEGF; L[g] = (f32x4){0.f, 0.f, 0.f, 0.f}; }
#pragma unroll
        for (int dt = 0; dt < 4; ++dt)
#pragma unroll
            for (int g = 0; g < 4; ++g) O[dt][g] = (f32x4){0.f, 0.f, 0.f, 0.f};
        const bf16* Kp = (const bf16*)(ws + WS_KVH) + ((size_t)(2 * 4 + b) * 4 + hkv) * 4096 * 64;
        const bf16* VTp = (const bf16*)(ws + WS_VT) + ((size_t)(0 * 4 + b) * 4 + hkv) * 64 * 4096;
        flash_branch<0>(Kp, VTp, 0, (t0 + 15) >> 6, ulo, uhi, mlo, mhi, t0, t, Qs, O, mx, L, q, r16);
        attn_finish<1>(args, O, L, true, m, hkv, q);
    }
    {
#pragma unroll
        for (int g = 0; g < 4; ++g) { mx[g] = NEGF; L[g] = (f32x4){0.f, 0.f, 0.f, 0.f}; }
#pragma unroll
        for (int dt = 0; dt < 4; ++dt)
#pragma unroll
            for (int g = 0; g < 4; ++g) O[dt][g] = (f32x4){0.f, 0.f, 0.f, 0.f};
        const bf16* Kp = (const bf16*)(ws + WS_KVH) + ((size_t)(4 * 4 + b) * 4 + hkv) * 4096 * 64;
        const bf16* VTp = (const bf16*)(ws + WS_VT) + ((size_t)(1 * 4 + b) * 4 + hkv) * 64 * 4096;
        const int jbeg = t0 >= 511 ? (t0 - 511) >> 6 : 0, jend = (t0 + 15) >> 6;
        flash_branch<1>(Kp, VTp, jbeg, jend, 0xffffffffu, 0xffffffffu, 0xffffffffu, 0xffffffffu, t0, t, Qs, O, mx, L, q, r16);
        attn_finish<2>(args, O, L, true, m, hkv, q);
    }
}
__device__ __forceinline__ void dot4_reduce(const float (&qv)[4], float kx, int lane, float (&sg)[4]) {
    const float v0 = qv[0] * kx, v1 = qv[1] * kx, v2 = qv[2] * kx, v3 = qv[3] * kx;
    const bool up = (lane & 32) != 0, up2 = (lane & 16) != 0;
    const float r0 = (up ? v2 : v0) + __shfl_xor(up ? v0 : v2, 32), r1 = (up ? v3 : v1) + __shfl_xor(up ? v1 : v3, 32);
    float x = (up2 ? r1 : r0) + __shfl_xor(up2 ? r0 : r1, 16);
    x += __shfl_xor(x, 8); x += __shfl_xor(x, 4); x += __shfl_xor(x, 2); x += __shfl_xor(x, 1);
    const int xi = __builtin_bit_cast(int, x);
    sg[0] = __builtin_bit_cast(float, __builtin_amdgcn_readlane(xi, 0)); sg[1] = __builtin_bit_cast(float, __builtin_amdgcn_readlane(xi, 16));
    sg[2] = __builtin_bit_cast(float, __builtin_amdgcn_readlane(xi, 32)); sg[3] = __builtin_bit_cast(float, __builtin_amdgcn_readlane(xi, 48));
}
struct SampleRows {
    const float* cache; const float* cwin; float* out; const LAS int* selblk; const LAS int* selpage; int bs, hkv, lane;
    template <int BR> __device__ __forceinline__ void load(int idx, int nrows, float& kx, float& vx) const {
        kx = 0.f; vx = 0.f;
        if (idx >= nrows) return;
        if (BR == 0) { const int k = idx >> 6; const unsigned off = (((unsigned)selpage[k] * 128u + (unsigned)((selblk[k] & 1) * 64 + (idx & 63))) * 4u + 2u) * 256u + (unsigned)(hkv * 64 + lane);
            kx = cache[off]; vx = cache[off + 256u]; }
        else { const unsigned off = (((unsigned)bs * 512u + (unsigned)(idx + 1)) * 2u) * 256u + (unsigned)(hkv * 64 + lane);
            kx = cwin[off]; vx = cwin[off + 256u]; }
    }
};
__device__ __forceinline__ void sample_row_update(const float (&qv)[4], float kx, float vx, int lane, float (&mx)[4], float (&ls)[4], float (&o)[4]) {
    float sg[4]; dot4_reduce(qv, kx, lane, sg);
#pragma unroll
    for (int g = 0; g < 4; ++g) { const float s = sg[g];
        const float mnew = fmaxf(mx[g], s), alpha = __expf(mx[g] - mnew), p = __expf(s - mnew);
        ls[g] = ls[g] * alpha + p; o[g] = o[g] * alpha + p * vx; mx[g] = mnew; }
}
template <int BR>
__device__ __forceinline__ void sample_rows_compute(const SampleRows& R, int base, int nrows, int wave, const float (&kx)[8], const float (&vx)[8], const float (&qv)[4],
                                                    float (&mx)[4], float (&ls)[4], float (&o)[4]) {
#pragma unroll
    for (int k = 0; k < 8; ++k) {
        const int idx = base + 8 * k + wave;
        if (idx < nrows) {
            if (BR == 1) { const unsigned off = (((unsigned)R.bs * 512u + (unsigned)idx) * 2u) * 256u + (unsigned)(R.hkv * 64 + R.lane); R.out[O_WINS + off] = kx[k]; R.out[O_WINS + off + 256u] = vx[k]; }
            sample_row_update(qv, kx[k], vx[k], R.lane, mx, ls, o);
        }
    }
}
template <int BR>
__device__ __forceinline__ void sample_rows_branch(const SampleRows& R, int wave, const float (&qv)[4], LAS float* pm, LAS float* pl, LAS float* po) {
    float mx[4], ls[4], o[4];
#pragma unroll
    for (int g = 0; g < 4; ++g) { mx[g] = NEGF; ls[g] = 0.f; o[g] = 0.f; }
    constexpr int nrows = BR == 0 ? 15 * 64 : 511;
    float ka[8], va[8], kb[8], vb[8];
#pragma unroll
    for (int k = 0; k < 8; ++k) R.load<BR>(8 * k + wave, nrows, ka[k], va[k]);
#pragma unroll 1
    for (int base = 0; base < nrows; base += 128) {
#pragma unroll
        for (int k = 0; k < 8; ++k) R.load<BR>(base + 64 + 8 * k + wave, nrows, kb[k], vb[k]);
        sample_rows_compute<BR>(R, base, nrows, wave, ka, va, qv, mx, ls, o);
#pragma unroll
        for (int k = 0; k < 8; ++k) R.load<BR>(base + 128 + 8 * k + wave, nrows, ka[k], va[k]);
        sample_rows_compute<BR>(R, base + 64, nrows, wave, kb, vb, qv, mx, ls, o);
    }
    if (wave == 0) {
        const float* src = BR == 0 ? R.out + O_KVS + ((size_t)R.bs * 4 + 2) * 256 + R.hkv * 64 + R.lane : R.out + O_WINS + (((size_t)R.bs * 512 + 511) * 2) * 256 + R.hkv * 64 + R.lane;
        sample_row_update(qv, src[0], src[256], R.lane, mx, ls, o);
    }
#pragma unroll
    for (int g = 0; g < 4; ++g) { if (R.lane == 0) { pm[(BR * 8 + wave) * 4 + g] = mx[g]; pl[(BR * 8 + wave) * 4 + g] = ls[g]; } po[((BR * 8 + wave) * 4 + g) * 64 + R.lane] = o[g]; }
}

__device__ __forceinline__ void attn_sample_unit(const Args& args, LAS unsigned char* lds, int unit, int tid, int wave, int lane) {
    unsigned char* ws = args.ws; float* out = args.out;
    const int hkv = unit & 3, bs = unit >> 2; const size_t m = MP + bs;
    LAS float* sc = (LAS float*)lds; LAS float* impv = sc + 512; LAS int* selblk = (LAS int*)(impv + 64); LAS int* selpage = selblk + 16; LAS int* pg = selpage + 16;
    LAS float* pm = (LAS float*)(pg + 16); LAS float* pl = pm + 64; LAS float* po = pl + 64;
    const bf16* Qr = (const bf16*)(ws + WS_Q) + m * 1024 + hkv * 256;
    const float* KCS = (const float*)(ws + WS_KCS) + (size_t)(bs * 4 + hkv) * 128 * 64; const float* VCS = (const float*)(ws + WS_VCS) + (size_t)(bs * 4 + hkv) * 128 * 64;
    float qv[4];
#pragma unroll
    for (int g = 0; g < 4; ++g) qv[g] = bf2f(Qr[g * 64 + lane]) * 0.125f;
    if (tid < 16) pg[tid] = ((const int*)args.in[5])[bs * NPAGES + tid];
    {
        float kr[16];
#pragma unroll
        for (int i = 0; i < 16; ++i) { const int n = wave + 8 * i; kr[i] = n < 127 ? KCS[n * 64 + lane] : 0.f; }
#pragma unroll
        for (int i = 0; i < 16; ++i) { const int n = wave + 8 * i; float sg[4]; dot4_reduce(qv, kr[i], lane, sg);
            if (lane < 4) sc[lane * 128 + n] = n < 127 ? (lane == 0 ? sg[0] : lane == 1 ? sg[1] : lane == 2 ? sg[2] : sg[3]) : NEGF; }
    }
    __syncthreads();
    if (wave < 4) { const float s0 = sc[wave * 128 + lane], s1 = sc[wave * 128 + 64 + lane];
        float mxv = fmaxf(s0, s1);
#pragma unroll
        for (int o = 1; o < 64; o <<= 1) mxv = fmaxf(mxv, __shfl_xor(mxv, o));
        const float e0 = __expf(s0 - mxv), e1 = (lane < 63) ? __expf(s1 - mxv) : 0.f;
        const float inv = 1.f / fmaxf(wave_sum(e0 + e1), TINYF);
        sc[wave * 128 + lane] = e0 * inv; sc[wave * 128 + 64 + lane] = e1 * inv; }
    __syncthreads();
    {
        float vr[16];
#pragma unroll
        for (int i = 0; i < 16; ++i) { const int n = wave + 8 * i; vr[i] = n < 127 ? VCS[n * 64 + lane] : 0.f; }
        float oc[4] = {0.f, 0.f, 0.f, 0.f};
#pragma unroll
        for (int i = 0; i < 16; ++i) { const int n = wave + 8 * i;
#pragma unroll
            for (int g = 0; g < 4; ++g) oc[g] += sc[g * 128 + n] * vr[i]; }
#pragma unroll
        for (int g = 0; g < 4; ++g) po[((2 * 8 + wave) * 4 + g) * 64 + lane] = oc[g];
        if (wave == 4 && lane < 33) { const int j = lane; float acc = 0.f;
#pragma unroll
            for (int k = -1; k < 4; ++k) { const int n = 4 * j + k; if (n >= 0 && n < 127) { const float P = (sc[n] + sc[128 + n]) + (sc[256 + n] + sc[384 + n]); acc += (k == -1 || k == 3) ? P : 2.f * P; } }
            impv[j] = (j == 0 || j == 31 || j == 32) ? BIGF : acc; }
    }
    __syncthreads();
    if (tid < 64) { bool sel = false;
        if (tid < 33) { const float v = impv[tid]; int rank = 0;
            for (int k = 0; k < 33; ++k) { const float o = impv[k]; rank += ((o > v) || (o == v && k < tid)) ? 1 : 0; }
            sel = rank < 16 && tid < 32; }
        const unsigned long long bal = __ballot(sel);
        if (sel) { const int slot = __popcll(bal & ((1ull << tid) - 1ull)); selblk[slot] = tid; selpage[slot] = pg[tid >> 1]; } }
    __syncthreads();
    {
        SampleRows R{INF(4), INF(6), out, selblk, selpage, bs, hkv, lane};
        sample_rows_branch<0>(R, wave, qv, pm, pl, po);
        sample_rows_branch<1>(R, wave, qv, pm, pl, po);
    }
    __syncthreads();
    if (tid < 256) { const int g = tid >> 6, d = tid & 63;
        const float* gates = (const float*)(ws + WS_MISC) + m * 128 + 32 + (hkv * 4 + g) * 3;
        float oc = 0.f;
#pragma unroll
        for (int w = 0; w < 8; ++w) oc += po[((2 * 8 + w) * 4 + g) * 64 + d];
        float res = sigmf(gates[0]) * oc;
#pragma unroll
        for (int br = 0; br < 2; ++br) { float M = NEGF;
#pragma unroll
            for (int w = 0; w < 8; ++w) M = fmaxf(M, pm[(br * 8 + w) * 4 + g]);
            float L = 0.f, O = 0.f;
#pragma unroll
            for (int w = 0; w < 8; ++w) { const float e = __expf(pm[(br * 8 + w) * 4 + g] - M); L += pl[(br * 8 + w) * 4 + g] * e; O += po[((br * 8 + w) * 4 + g) * 64 + d] * e; }
            res += sigmf(gates[1 + br]) * O / fmaxf(L, TINYF); }
        ((bf16*)(ws + WS_YATT))[m * 1024 + (hkv * 4 + g) * 64 + d] = (bf16)f2bf(res); }
    __syncthreads();
}

__device__ __forceinline__ void ffn_act_item(const Args& args, int item, int lane) {
    unsigned char* ws = args.ws; float* out = args.out;
    const bf16* U = (const bf16*)(ws + WS_U); bf16* ACT = (bf16*)(ws + WS_ACT);
    const float* cw = INF(32); const float* cb = INF(33); const float* st = INF(9);
    const int slab = item % 11, chunk = item / 11, row0 = chunk * 32, c4 = slab * 256 + lane * 4;
    f32x4 w[2][3], bia[2];
#pragma unroll
    for (int hf = 0; hf < 2; ++hf) { bia[hf] = *(const f32x4*)(cb + hf * DFF + c4);
#pragma unroll
        for (int k = 0; k < 3; ++k) w[hf][k] = *(const f32x4*)(cw + k * DFF2 + hf * DFF + c4); }
    if (row0 >= MP) {
        for (int r = 0; r < 32; ++r) { const int bs = row0 - MP + r; if (bs >= MS) break;
            f32x4 cu[2];
#pragma unroll
            for (int hf = 0; hf < 2; ++hf) { const int col = hf * DFF + c4;
                const f32x4 u0 = *(const f32x4*)(st + ((size_t)bs * 2 + 0) * DFF2 + col), u1 = *(const f32x4*)(st + ((size_t)bs * 2 + 1) * DFF2 + col), u2 = *(const f32x4*)(out + O_FFNS + ((size_t)bs * 2 + 1) * DFF2 + col);
                *(f32x4*)(out + O_FFNS + ((size_t)bs * 2 + 0) * DFF2 + col) = u1;
                cu[hf] = bia[hf] + w[hf][0] * u0 + w[hf][1] * u1 + w[hf][2] * u2; }
            u32x2 o; o.x = pk2(siluf(cu[0].x) * cu[1].x, siluf(cu[0].y) * cu[1].y); o.y = pk2(siluf(cu[0].z) * cu[1].z, siluf(cu[0].w) * cu[1].w);
            *(u32x2*)(ACT + (size_t)(row0 + r) * DFF + c4) = o; }
        return;
    }
    const int t0 = row0 & 4095;
    f32x4 p2[2], p1[2];
#pragma unroll
    for (int hf = 0; hf < 2; ++hf) { const int col = hf * DFF + c4;
        const u32x2 a = t0 >= 2 ? *(const u32x2*)(U + (size_t)(row0 - 2) * DFF2 + col) : (u32x2){0u, 0u}, b = t0 >= 1 ? *(const u32x2*)(U + (size_t)(row0 - 1) * DFF2 + col) : (u32x2){0u, 0u};
        p2[hf] = (f32x4){bflo(a.x), bfhi(a.x), bflo(a.y), bfhi(a.y)}; p1[hf] = (f32x4){bflo(b.x), bfhi(b.x), bflo(b.y), bfhi(b.y)}; }
#pragma unroll 1
    for (int rb = 0; rb < 32; rb += 8) {
        u32x2 v[8][2];
#pragma unroll
        for (int r = 0; r < 8; ++r)
#pragma unroll
            for (int hf = 0; hf < 2; ++hf) v[r][hf] = *(const u32x2*)(U + (size_t)(row0 + rb + r) * DFF2 + hf * DFF + c4);
#pragma unroll
        for (int r = 0; r < 8; ++r) {
            f32x4 cu[2];
#pragma unroll
            for (int hf = 0; hf < 2; ++hf) { const f32x4 u2 = (f32x4){bflo(v[r][hf].x), bfhi(v[r][hf].x), bflo(v[r][hf].y), bfhi(v[r][hf].y)};
                cu[hf] = bia[hf] + w[hf][0] * p2[hf] + w[hf][1] * p1[hf] + w[hf][2] * u2; p2[hf] = p1[hf]; p1[hf] = u2; }
            u32x2 o; o.x = pk2(siluf(cu[0].x) * cu[1].x, siluf(cu[0].y) * cu[1].y); o.y = pk2(siluf(cu[0].z) * cu[1].z, siluf(cu[0].w) * cu[1].w);
            *(u32x2*)(ACT + (size_t)(row0 + rb + r) * DFF + c4) = o;
        }
    }
}
__device__ __forceinline__ void final_norm_phase(const Args& args, int gw, int NGW, int lane) {
    const float* X = (const float*)(args.ws + WS_X1); const float* nw = INF(14);
    for (int m = gw; m < MALL; m += NGW) {
        const float* xr = X + (size_t)m * 1024; float* o = args.out + (m < MP ? O_YP + (size_t)m * 1024 : O_YS + (size_t)(m - MP) * 1024);
        f32x4 v[4]; float s = 0.f;
#pragma unroll
        for (int j = 0; j < 4; ++j) { v[j] = *(const f32x4*)(xr + (j * 64 + lane) * 4); s += (v[j].x * v[j].x + v[j].y * v[j].y) + (v[j].z * v[j].z + v[j].w * v[j].w); }
        const float rstd = 1.f / sqrtf(wave_sum(s) * (1.f / 1024.f) + EPS);
#pragma unroll
        for (int j = 0; j < 4; ++j) { const int c0 = (j * 64 + lane) * 4; *(f32x4*)(o + c0) = (v[j] * rstd) * *(const f32x4*)(nw + c0); }
    }
}
constexpr int N_PHASES = 15;
#ifndef MK_PER_PHASE
#define MK_PER_PHASE 0
#endif

__global__ void __launch_bounds__(NTHR, 2) fwd_kernel(Args args) {
    extern __shared__ __attribute__((aligned(16))) unsigned char lds_raw[];
    LAS unsigned char* lds = (LAS unsigned char*)lds_raw;
    const int tid = threadIdx.x, lane = tid & 63, wave = __builtin_amdgcn_readfirstlane(tid >> 6);
    const int G = gridDim.x, bid = blockIdx.x, gw = bid * NWAVES + wave, NGW = G * NWAVES, gt = bid * NTHR + tid, NGT = G * NTHR;
    unsigned char* ws = args.ws;
    for (int u = tid; u < (LDS_BYTES - LDSCTL_OFF) / 4; u += NTHR) ((LAS unsigned*)(lds + LDSCTL_OFF))[u] = 0u;
    __syncthreads();
    XcdBarrier bar; bar.bar = (unsigned*)(ws + WS_CTL) + CW_BAR; bar.x = 0; bar.st = nullptr;
    if (!MK_PER_PHASE) bar = xcd_barrier_post((unsigned*)(ws + WS_CTL) + CW_BAR, (volatile LAS unsigned*)(lds + MISC_OFF) + 8);
    const int lo = args.ph_lo, hi = args.ph_hi;
#ifndef PHASE_MASK
#define PHASE_MASK 0x7fff
#endif
#define IN(k) ((((PHASE_MASK) >> (k)) & 1) && lo <= (k) && (k) < hi)
#define SEAM(k) do { if (IN(k) && IN((k) + 1)) xcd_barrier(bar); } while (0)
    using pg8::Gemm; using pg8::StaticOrder;

    if (IN(0)) { { p0_prologue(args, lds, gw, NGW, lane, wave); } }
    SEAM(0);
    if (IN(1)) { {
        Gemm g{(const bf16*)(ws + WS_SC), (const bf16*)(ws + WS_WADA), 256, 6144, 1024}; StaticOrder S; S.init(256, 6144, G, bid);
        pg8::EpiF32 E{(float*)(ws + WS_MOD), 6144, INF(11)};
        pg8::gemm_phase<pg8::EpiF32, StaticOrder, true, true>(lds, g, S, E);
    } }
    SEAM(1);
    if (IN(2)) { { norm_mod_phase<0>(args, gw, NGW, lane); } }
    SEAM(2);
    if (IN(3)) { {
        Gemm g{(const bf16*)(ws + WS_H), (const bf16*)(ws + WS_WIN), MPAD, NPROJ, 1024}; StaticOrder S; S.init(MPAD, NPROJ, G, bid);
        epi::InProj E{ws, args.out};
        pg8::gemm_phase<epi::InProj, StaticOrder, true, true>(lds, g, S, E);
    } }
    SEAM(3);
    if (IN(4)) { {
        { Gemm g{(const bf16*)(ws + WS_CKB), (const bf16*)(ws + WS_W1K), 65536, 256, 1024}; StaticOrder S; S.init(65536, 256, G, bid);
          pg8::EpiF32 E{(float*)(ws + WS_PARTSK), 256, nullptr}; pg8::gemm_phase<pg8::EpiF32, StaticOrder, true, true>(lds, g, S, E); }
        { Gemm g{(const bf16*)(ws + WS_CVB), (const bf16*)(ws + WS_W1V), 65536, 256, 1024}; StaticOrder S; S.init(65536, 256, G, bid);
          pg8::EpiF32 E{(float*)(ws + WS_PARTSV), 256, nullptr}; pg8::gemm_phase<pg8::EpiF32, StaticOrder, true, true>(lds, g, S, E); }
        { Gemm g{(const bf16*)(ws + WS_KVH), (const bf16*)(ws + WS_W1K), 4096, 256, 1024}; StaticOrder S; S.init(4096, 256, G, bid);
          pg8::EpiF32 E{(float*)(ws + WS_PARTK), 256, nullptr}; pg8::gemm_phase<pg8::EpiF32, StaticOrder, true, true>(lds, g, S, E); }
        { Gemm g{(const bf16*)(ws + WS_KVH) + (size_t)16 * 4096 * 64, (const bf16*)(ws + WS_W1V), 4096, 256, 1024}; StaticOrder S; S.init(4096, 256, G, (bid + G - 16) % G);
          pg8::EpiF32 E{(float*)(ws + WS_PARTV), 256, nullptr}; pg8::gemm_phase<pg8::EpiF32, StaticOrder, true, true>(lds, g, S, E); }
        for (int it = gw; it < 256 * 48; it += NGW) conv_prompt_item(args, it, lane);
        for (int it = gw; it < 4096; it += NGW) dtcs_item(args, it, lane);
        sample_conv(args, gt, NGT);
    } }
    SEAM(4);
    if (IN(5)) { {
        for (int u = bid; u < 512; u += G) ssd_states_unit(args, lds, u, wave, lane);
        for (int it = gw; it < 2 * (4096 / 16); it += NGW) compress2_item<0>(args, it, lane);
        for (int it = gw; it < 2 * (65536 / 16); it += NGW) compress2_item<1>(args, it, lane);
        for (int it = gw; it < MS * NH; it += NGW) sample_ssm_item(args, lds, it, wave, lane);
    } }
    SEAM(5);
    if (IN(6)) { { scan_phase(args, gt, NGT); } }
    SEAM(6);
    if (IN(7)) { {
#ifndef P7C
#define P7C 7
#endif
        const int p7 = args.p7mask & (P7C);
        if (p7 & 1) for (int u = bid; u < 512; u += G) ssd_out_unit(args, lds, u, wave, lane, tid);
        if (p7 & 2) for (int u = gw; u < 4096; u += NGW) attn_prompt_unit(args, (LAS float*)(lds + wave * 12288), u, NGW == 2048, lane);
        __syncthreads();
        if (p7 & 4) for (int u = bid; u < 512; u += G) attn_sample_unit(args, lds, u, tid, wave, lane);
    } }
    SEAM(7);
    if (IN(8)) { {
        { Gemm g{(const bf16*)(ws + WS_YSSM), (const bf16*)(ws + WS_WSSM), MPAD, 1024, 2048}; StaticOrder S; S.init(MPAD, 1024, G, bid);
          epi::Merge1 E{ws}; pg8::gemm_phase<epi::Merge1, StaticOrder, true, true>(lds, g, S, E); }
        { Gemm g{(const bf16*)(ws + WS_YATT), (const bf16*)(ws + WS_WATT), MPAD, 1024, 1024}; StaticOrder S; S.init(MPAD, 1024, G, bid);
          epi::Merge2 E{ws}; pg8::gemm_phase<epi::Merge2, StaticOrder, true, true>(lds, g, S, E); }
    } }
    SEAM(8);
    if (IN(9)) { {
        Gemm g{(const bf16*)(ws + WS_MERGED), (const bf16*)(ws + WS_WOUT), MPAD, 1024, 1024}; StaticOrder S; S.init(MPAD, 1024, G, bid);
        epi::Resid E{INF(0), INF(1), nullptr, (float*)(ws + WS_X1), (const float*)(ws + WS_MOD), 2048};
        pg8::gemm_phase<epi::Resid, StaticOrder, true, true>(lds, g, S, E);
    } }
    SEAM(9);
    if (IN(10)) { { norm_mod_phase<1>(args, gw, NGW, lane); } }
    SEAM(10);
    if (IN(11)) { {
        Gemm g{(const bf16*)(ws + WS_H), (const bf16*)(ws + WS_WUP), MPAD, DFF2, 1024}; StaticOrder S; S.init(MPAD, DFF2, G, bid);
        epi::Up E{ws, args.out};
        pg8::gemm_phase<epi::Up, StaticOrder, true, true>(lds, g, S, E);
    } }
    SEAM(11);
    if (IN(12)) { { for (int it = gw; it < (MPAD / 32) * 11; it += NGW) ffn_act_item(args, it, lane); } }
    SEAM(12);
    if (IN(13)) { {
        Gemm g{(const bf16*)(ws + WS_ACT), (const bf16*)(ws + WS_WDN), MPAD, 1024, DFF}; StaticOrder S; S.init(MPAD, 1024, G, bid);
        epi::Resid E{INF(0), INF(1), (const float*)(ws + WS_X1), (float*)(ws + WS_X1), (const float*)(ws + WS_MOD), 5120};
        pg8::gemm_phase<epi::Resid, StaticOrder, true, true>(lds, g, S, E);
    } }
    SEAM(13);
    if (IN(14)) { { final_norm_phase(args, gw, NGW, lane); } }
#undef IN
#undef SEAM
}

extern "C" void kernel_launch(void* const* d_in, const int* in_sizes, int n_in, void* d_out, int out_size, void* d_ws, size_t ws_size, hipStream_t stream) {
    static int grid = 0;
    if (grid == 0) {
        if (n_in != 35 || out_size != (int)O_END || ws_size < WS_END) { fprintf(stderr, "kernel_launch: unexpected shapes (n_in %d out %d ws %zu, need %zu)\n", n_in, out_size, ws_size, (size_t)WS_END); grid = -1; return; }
        int dev = 0, cus = 0, per_cu = 0;
        if (hipGetDevice(&dev) != hipSuccess || hipDeviceGetAttribute(&cus, hipDeviceAttributeMultiprocessorCount, dev) != hipSuccess) { grid = -1; return; }
        if (hipFuncSetAttribute((const void*)fwd_kernel, hipFuncAttributeMaxDynamicSharedMemorySize, LDS_BYTES) != hipSuccess) { fprintf(stderr, "kernel_launch: hipFuncSetAttribute failed\n"); grid = -1; return; }
        if (hipOccupancyMaxActiveBlocksPerMultiprocessor(&per_cu, (const void*)fwd_kernel, NTHR, LDS_BYTES) != hipSuccess || per_cu < 1) { fprintf(stderr, "kernel_launch: occupancy query says %d\n", per_cu); }
        (void)hipGetLastError();
        grid = cus;
    }
    if (grid < 0) return;
    (void)hipMemsetAsync((char*)d_ws + WS_CTL, 0, CTL_ZERO_BYTES, stream);
    Args a{};
    for (int i = 0; i < 35; ++i) a.in[i] = d_in[i];
    a.out = (float*)d_out; a.ws = (unsigned char*)d_ws;
    a.p7mask = 7; a.pad = 0;
#if MK_PER_PHASE
    for (int p = 0; p < N_PHASES; ++p) { a.ph_lo = p; a.ph_hi = p + 1; hipLaunchKernelGGL(fwd_kernel, dim3(grid), dim3(NTHR), LDS_BYTES, stream, a); }
#else
    a.ph_lo = 0; a.ph_hi = N_PHASES;
    hipLaunchKernelGGL(fwd_kernel, dim3(grid), dim3(NTHR), LDS_BYTES, stream, a);
#endif
#ifdef PROBE_LO
    a.ph_lo = PROBE_LO; a.ph_hi = PROBE_HI; a.p7mask = PROBE_P7MASK;
    hipLaunchKernelGGL(fwd_kernel, dim3(grid), dim3(NTHR), LDS_BYTES, stream, a);
#endif
}
```

```cpp
#include <hip/hip_runtime.h>
#include <cstdio>
#include <cstdint>
namespace pg8 {
#define PG8_LAS __attribute__((address_space(3)))
typedef unsigned short bf16_t;
typedef short bf16x8 __attribute__((ext_vector_type(8)));
typedef float f32x4 __attribute__((ext_vector_type(4)));
typedef unsigned u32x4 __attribute__((ext_vector_type(4)));
constexpr int BM = 256, BK = 64, HALF = 128, HTB = HALF * BK * 2  , STAGE_BYTES = 8 * HTB, NXCD = 8, WGM = 8;

__host__ __device__ __forceinline__ int lds_byte(int r, int c) { const int st = (r >> 4) * 2 + (c >> 5), rr = r & 15, cc = c & 31, ob = rr * 64 + cc * 2; return st * 1024 + (ob ^ (((ob >> 9) & 1) << 5)); }
__host__ __device__ __forceinline__ void stage_rc(int b, int& R, int& C) { const int st = b / 1024, sb = b % 1024, swz = sb ^ (((sb >> 9) & 1) << 5); R = (st >> 1) * 16 + swz / 64; C = (st & 1) * 32 + (swz % 64) / 2; }
__host__ __device__ __forceinline__ int perm32(int rho) { const int n = rho >> 4, i = rho & 15; return 8 * (i >> 2) + 4 * n + (i & 3); }

struct Unit { int pm, pn; };
struct Gemm { const bf16_t* A; const bf16_t* Bt; int M, N, K; };

struct StaticOrder {
    int nM, nN, nwg, G, c;
    __host__ __device__ void init(int M, int N, int G_, int c_) { nM = M / BM; nN = N / BM; nwg = nM * nN; G = G_; c = c_; }
    __host__ __device__ bool next(int i, Unit& u) const {
        const long L = (long)i * G + c; if (L >= nwg) return false;
        int wgid = (int)L; { const int q = nwg / NXCD, r = nwg % NXCD, xcd = wgid % NXCD, off = wgid / NXCD; wgid = (xcd < r ? xcd * (q + 1) : r * (q + 1) + (xcd - r) * q) + off; }
        const int nig = WGM * nN, gid = wgid / nig, fm = gid * WGM, gsz = (nM - fm) < WGM ? (nM - fm) : WGM;
        u.pm = fm + ((wgid % nig) % gsz); u.pn = (wgid % nig) / gsz; return true;
    }
    __device__ __forceinline__ void a_ready(const Unit&) const {}
    __device__ __forceinline__ void done(const Unit&) const {}
};
__device__ __forceinline__ unsigned cvt_pk_bf16(float lo, float hi) { unsigned r; asm volatile("v_cvt_pk_bf16_f32 %0, %1, %2" : "=v"(r) : "v"(lo), "v"(hi)); return r; }
typedef float f32x2 __attribute__((ext_vector_type(2)));
struct EpiF32 {
    static constexpr bool PERM = false, AFTER_DRAIN = false;
    float* C; int ldc; const float* bias;
    __device__ __forceinline__ void operator()(const f32x4 (&acc)[2][2][4][2], const Unit& u, int wr, int wc, int fr, int fq) const {
        const int row0 = u.pm * BM + wr * 64 + fr, col0 = u.pn * BM + wc * 32 + 4 * fq;
        f32x4 bv[2][2];
#pragma unroll
        for (int bj = 0; bj < 2; ++bj)
#pragma unroll
            for (int n = 0; n < 2; ++n) bv[bj][n] = bias ? *(const f32x4*)(bias + col0 + bj * HALF + n * 16) : (f32x4){0.f, 0.f, 0.f, 0.f};
#pragma unroll
        for (int ai = 0; ai < 2; ++ai)
#pragma unroll
            for (int m = 0; m < 4; ++m) { float* rowp = C + (size_t)(row0 + ai * HALF + m * 16) * ldc + col0;
#pragma unroll
                for (int bj = 0; bj < 2; ++bj)
#pragma unroll
                    for (int n = 0; n < 2; ++n) *(f32x4*)(rowp + bj * HALF + n * 16) = acc[ai][bj][m][n] + bv[bj][n]; }
    }
};
template <class Epi, class Sched, bool ALIGN_EPI = false, bool SP2 = false>
__device__ __forceinline__ void gemm_phase(PG8_LAS unsigned char* lds, const Gemm g, const Sched& S, const Epi& E) {
    const int tid = threadIdx.x, wid = __builtin_amdgcn_readfirstlane(tid >> 6), lane = tid & 63, wr = wid >> 2, wc = wid & 3, fr = lane & 15, fq = lane >> 4;
    const int K = g.K, nt = K / BK;
    unsigned voffA[2], voffB[2];
#pragma unroll
    for (int i = 0; i < 2; ++i) { int R, C; stage_rc(tid * 16 + i * 8192, R, C); const int Rb = Epi::PERM ? ((R & ~31) + perm32(R & 31)) : R;
        voffA[i] = (unsigned)(R * K + C) * 2u; voffB[i] = (unsigned)(Rb * K + C) * 2u; }
    const size_t kstep = (size_t)(BK * 2);
    const size_t hstep = (size_t)HALF * K * 2;
    const size_t tstep = 2 * hstep;
    const unsigned ldsw = (unsigned)wid * 1024u;
    const int aoff = lds_byte(wr * 64 + fr, fq * 8), boff = lds_byte(wc * 32 + fr, fq * 8);
#define PG8_SA(b, h) (((b) * 2 + (h)) * HTB)
#define PG8_SB(b, h) ((4 + (b) * 2 + (h)) * HTB)
#define PG8_STAGE(bufoff, gbase, voff) do { _Pragma("unroll") for (int _i = 0; _i < 2; ++_i) \
        __builtin_amdgcn_global_load_lds((const unsigned*)((const char*)(gbase) + (voff)[_i]), (PG8_LAS unsigned*)(lds + (bufoff) + ldsw + _i * 8192), 16, 0, 0); } while (0)
#define PG8_LDA(dst, b, h) do { _Pragma("unroll") for (int m = 0; m < 4; ++m) _Pragma("unroll") for (int k = 0; k < 2; ++k) dst[m][k] = *(const PG8_LAS bf16x8*)(lds + PG8_SA(b, h) + aoff + m * 2048 + k * 1024); } while (0)
#define PG8_LDB(dst, b, h) do { _Pragma("unroll") for (int n = 0; n < 2; ++n) _Pragma("unroll") for (int k = 0; k < 2; ++k) dst[n][k] = *(const PG8_LAS bf16x8*)(lds + PG8_SB(b, h) + boff + n * 2048 + k * 1024); } while (0)
#define PG8_MMA(ai, bj, At, Bt) do { __builtin_amdgcn_s_setprio(1); _Pragma("unroll") for (int m = 0; m < 4; ++m) _Pragma("unroll") for (int n = 0; n < 2; ++n) _Pragma("unroll") for (int k = 0; k < 2; ++k) \
        acc[ai][bj][m][n] = __builtin_amdgcn_mfma_f32_16x16x32_bf16(Bt[n][k], At[m][k], acc[ai][bj][m][n], 0, 0, 0); __builtin_amdgcn_s_setprio(0); } while (0)
#define PG8_WAIT_V(n) asm volatile("s_waitcnt vmcnt(" #n ")" ::: "memory")
#define PG8_WAIT_L(n) asm volatile("s_waitcnt lgkmcnt(" #n ")" ::: "memory")
#define PG8_BAR __builtin_amdgcn_s_barrier()
#define PG8_SCHED __builtin_amdgcn_sched_barrier(0)
    Unit cur, nxt; int ui = 0;
    if (!S.next(0, cur)) return;
    f32x4 acc[2][2][4][2];
#pragma unroll
    for (int a = 0; a < 2; ++a)
#pragma unroll
        for (int b = 0; b < 2; ++b)
#pragma unroll
            for (int m = 0; m < 4; ++m)
#pragma unroll
                for (int n = 0; n < 2; ++n) acc[a][b][m][n] = (f32x4){0.f, 0.f, 0.f, 0.f};
    bf16x8 At[4][2], B0[2][2], B1[2][2];
    const char* cA = (const char*)g.A + (size_t)cur.pm * tstep; const char* cB = (const char*)g.Bt + (size_t)cur.pn * tstep;
    S.a_ready(cur);
    if constexpr (SP2) {
        PG8_STAGE(PG8_SB(0, 0), cB, voffB); PG8_STAGE(PG8_SB(0, 1), cB + hstep, voffB); PG8_STAGE(PG8_SA(0, 0), cA, voffA); PG8_STAGE(PG8_SA(0, 1), cA + hstep, voffA);
        if (wr == 1) PG8_BAR;
        PG8_WAIT_V(2); PG8_BAR;
        PG8_STAGE(PG8_SB(1, 0), cB + kstep, voffB); PG8_STAGE(PG8_SA(1, 0), cA + kstep, voffA); PG8_STAGE(PG8_SB(1, 1), cB + hstep + kstep, voffB);
        PG8_WAIT_V(6); PG8_BAR;
    } else {
        PG8_STAGE(PG8_SB(0, 0), cB, voffB); PG8_STAGE(PG8_SA(0, 0), cA, voffA); PG8_STAGE(PG8_SB(0, 1), cB + hstep, voffB); PG8_STAGE(PG8_SA(0, 1), cA + hstep, voffA);
        if (wr == 1) PG8_BAR;
        PG8_WAIT_V(4); PG8_BAR;
        PG8_STAGE(PG8_SB(1, 0), cB + kstep, voffB); PG8_STAGE(PG8_SA(1, 0), cA + kstep, voffA); PG8_STAGE(PG8_SB(1, 1), cB + hstep + kstep, voffB);
        PG8_WAIT_V(6); PG8_BAR;
    }
    for (;;) {
        const bool has_next = S.next(ui + 1, nxt);
        const char* nA = has_next ? (const char*)g.A + (size_t)nxt.pm * tstep : cA; const char* nB = has_next ? (const char*)g.Bt + (size_t)nxt.pn * tstep : cB;
        for (int t = 0; t < nt; t += 2) {
            const bool last = (t == nt - 2);
            const char* a1 = cA + (size_t)(t + 1) * kstep;
            const char* a2 = last ? nA : cA + (size_t)(t + 2) * kstep; const char* b2 = last ? nB : cB + (size_t)(t + 2) * kstep;
            const char* a3 = a2 + kstep; const char* b3 = b2 + kstep;
            if (last && has_next) S.a_ready(nxt);
            if constexpr (SP2) {
            PG8_LDB(B0, 0, 0); PG8_LDB(B1, 0, 1); PG8_SCHED; PG8_LDA(At, 0, 0); PG8_STAGE(PG8_SA(1, 1), a1 + hstep, voffA);
            PG8_WAIT_V(8); PG8_WAIT_L(0); PG8_BAR; PG8_MMA(0, 0, At, B0); PG8_MMA(0, 1, At, B1); PG8_BAR; PG8_SCHED;
            PG8_LDA(At, 0, 1); PG8_STAGE(PG8_SB(0, 0), b2, voffB); PG8_STAGE(PG8_SB(0, 1), b2 + hstep, voffB); PG8_STAGE(PG8_SA(0, 0), a2, voffA);
            PG8_WAIT_V(8); PG8_WAIT_L(0); PG8_BAR; PG8_MMA(1, 0, At, B0); PG8_MMA(1, 1, At, B1); PG8_BAR; PG8_SCHED;
            PG8_LDB(B0, 1, 0); PG8_LDB(B1, 1, 1); PG8_SCHED; PG8_LDA(At, 1, 0); PG8_STAGE(PG8_SA(0, 1), a2 + hstep, voffA);
            PG8_WAIT_V(8); PG8_WAIT_L(0); PG8_BAR; PG8_MMA(0, 0, At, B0); PG8_MMA(0, 1, At, B1); PG8_BAR; PG8_SCHED;
            PG8_LDA(At, 1, 1); PG8_STAGE(PG8_SB(1, 0), b3, voffB); PG8_STAGE(PG8_SB(1, 1), b3 + hstep, voffB); PG8_STAGE(PG8_SA(1, 0), a3, voffA);
            PG8_WAIT_V(8); PG8_WAIT_L(0); PG8_BAR; PG8_MMA(1, 0, At, B0); PG8_MMA(1, 1, At, B1); PG8_BAR; PG8_SCHED;
            } else {
            PG8_LDB(B0, 0, 0); PG8_SCHED; PG8_LDA(At, 0, 0); PG8_STAGE(PG8_SA(1, 1), a1 + hstep, voffA);
            PG8_WAIT_L(8); PG8_BAR; PG8_WAIT_L(0); PG8_MMA(0, 0, At, B0); PG8_BAR; PG8_SCHED;
            PG8_LDB(B1, 0, 1); PG8_STAGE(PG8_SB(0, 0), b2, voffB);
            PG8_BAR; PG8_WAIT_L(0); PG8_MMA(0, 1, At, B1); PG8_BAR;
            PG8_LDA(At, 0, 1); PG8_STAGE(PG8_SA(0, 0), a2, voffA);
            PG8_BAR; PG8_WAIT_L(0); PG8_MMA(1, 0, At, B0); PG8_BAR; PG8_SCHED;
            PG8_STAGE(PG8_SB(0, 1), b2 + hstep, voffB);
            PG8_WAIT_V(6); PG8_BAR; PG8_MMA(1, 1, At, B1); PG8_BAR;
            PG8_LDB(B0, 1, 0); PG8_SCHED; PG8_LDA(At, 1, 0); PG8_STAGE(PG8_SA(0, 1), a2 + hstep, voffA);
            PG8_WAIT_L(8); PG8_BAR; PG8_WAIT_L(0); PG8_MMA(0, 0, At, B0); PG8_BAR; PG8_SCHED;
            PG8_LDB(B1, 1, 1); PG8_STAGE(PG8_SB(1, 0), b3, voffB);
            PG8_BAR; PG8_WAIT_L(0); PG8_MMA(0, 1, At, B1); PG8_BAR;
            PG8_LDA(At, 1, 1); PG8_STAGE(PG8_SA(1, 0), a3, voffA);
            PG8_BAR; PG8_WAIT_L(0); PG8_MMA(1, 0, At, B0); PG8_BAR; PG8_SCHED;
            PG8_STAGE(PG8_SB(1, 1), b3 + hstep, voffB);
            PG8_WAIT_V(6); PG8_BAR; PG8_MMA(1, 1, At, B1); PG8_BAR;
            }
        }
        if constexpr (ALIGN_EPI) { if (wr == 0) PG8_BAR; }
        if constexpr (!Epi::AFTER_DRAIN) { E(acc, cur, wr, wc, fr, fq); S.done(cur); }
        if (!has_next) break;
#pragma unroll
        for (int a = 0; a < 2; ++a)
#pragma unroll
            for (int b = 0; b < 2; ++b)
#pragma unroll
                for (int m = 0; m < 4; ++m)
#pragma unroll
                    for (int n = 0; n < 2; ++n) acc[a][b][m][n] = (f32x4){0.f, 0.f, 0.f, 0.f};
        cur = nxt; cA = nA; cB = nB; ++ui;
        if constexpr (ALIGN_EPI) { if (wr == 1) PG8_BAR; }
    }
    PG8_WAIT_V(0);
    if constexpr (!ALIGN_EPI) { if (wr == 0) PG8_BAR; }
    PG8_BAR;
    if constexpr (Epi::AFTER_DRAIN) { E.fused(acc, cur, wr, wc, fr, fq, lds, wid, lane); S.done(cur); }
#undef PG8_SA
#undef PG8_SB
#undef PG8_STAGE
#undef PG8_LDA
#undef PG8_LDB
#undef PG8_MMA
#undef PG8_WAIT_V
#undef PG8_WAIT_L
#undef PG8_BAR
#undef PG8_SCHED
}
}
#define GAS __attribute__((address_space(1)))
#define LAS __attribute__((address_space(3)))
typedef unsigned short bf16;
typedef float f32x4 __attribute__((ext_vector_type(4)));
typedef float f32x2 __attribute__((ext_vector_type(2)));
typedef short bf16x8 __attribute__((ext_vector_type(8)));
typedef short bf16x4 __attribute__((ext_vector_type(4)));
typedef unsigned u32x4 __attribute__((ext_vector_type(4)));
typedef unsigned u32x2 __attribute__((ext_vector_type(2)));
#define MFMA16(a, b, c) __builtin_amdgcn_mfma_f32_16x16x32_bf16((a), (b), (c), 0, 0, 0)

constexpr int NWAVES = 8, NTHR = 512;
constexpr int DM = 1024, SEQ = 4096, NB = 4, MP = NB * SEQ, MS = 128, MALL = MP + MS, MPAD = 16640;
constexpr int DI = 2048, CONVD = 3072, NH = 32, NG = 4, NST = 128;
constexpr int NPROJ = 9984;
constexpr int DFF = 2816, DFF2 = 5632;
constexpr int NPAGES = 16, PAST = 2048;
constexpr float EPS = 1e-6f, NEGF = -1e30f, BIGF = 1e30f, TINYF = 1e-30f;
constexpr int T_Z = 0, T_XBC = 8, T_Q = 20, T_KV = 24, T_MG = 30, T_MISC = 38;

constexpr size_t O_YP = 0;
constexpr size_t O_YS = O_YP + (size_t)MP * DM;
constexpr size_t O_KVP = O_YS + (size_t)MS * DM;
constexpr size_t O_KVS = O_KVP + (size_t)MP * 1024;
constexpr size_t O_WINP = O_KVS + (size_t)MS * 1024;
constexpr size_t O_WINS = O_WINP + (size_t)NB * 512 * 512;
constexpr size_t O_SSMP = O_WINS + (size_t)MS * 512 * 512;
constexpr size_t O_SSMS = O_SSMP + (size_t)NB * NH * 64 * 128;
constexpr size_t O_CONVP = O_SSMS + (size_t)MS * NH * 64 * 128;
constexpr size_t O_CONVS = O_CONVP + (size_t)NB * 3 * CONVD;
constexpr size_t O_FFNP = O_CONVS + (size_t)MS * 3 * CONVD;
constexpr size_t O_FFNS = O_FFNP + (size_t)NB * 2 * DFF2;
constexpr size_t O_END = O_FFNS + (size_t)MS * 2 * DFF2;
static_assert(O_END == 105725952, "output size");

constexpr size_t al256(size_t x) { return (x + 255) & ~(size_t)255; }
constexpr size_t WS_CTL = 0, CTL_ZERO_BYTES = 1u << 20;
constexpr size_t WS_WIN = CTL_ZERO_BYTES;
constexpr size_t WS_WSSM = WS_WIN + al256((size_t)NPROJ * 1024 * 2);
constexpr size_t WS_WATT = WS_WSSM + al256((size_t)1024 * 2048 * 2);
constexpr size_t WS_WOUT = WS_WATT + al256((size_t)1024 * 1024 * 2);
constexpr size_t WS_WUP = WS_WOUT + al256((size_t)1024 * 1024 * 2);
constexpr size_t WS_WDN = WS_WUP + al256((size_t)DFF2 * 1024 * 2);
constexpr size_t WS_WADA = WS_WDN + al256((size_t)1024 * DFF * 2);
constexpr size_t WS_W1K = WS_WADA + al256((size_t)6144 * 1024 * 2);
constexpr size_t WS_W1V = WS_W1K + al256((size_t)256 * 1024 * 2);
constexpr size_t WS_SC = WS_W1V + al256((size_t)256 * 1024 * 2);
constexpr size_t WS_MOD = WS_SC + al256((size_t)256 * 1024 * 2);
constexpr size_t WS_ROPE = WS_MOD + al256((size_t)256 * 6144 * 4);
constexpr size_t WS_PET = WS_ROPE + al256((size_t)4096 * 16 * 4);
constexpr size_t WS_H = WS_PET + al256(2 * 128 * 4);
constexpr size_t WS_Z = WS_H + al256((size_t)MPAD * 1024 * 2);
constexpr size_t WS_XBC = WS_Z + al256((size_t)MPAD * 2048 * 2);
constexpr size_t WS_Q = WS_XBC + al256((size_t)MPAD * 3072 * 2);
constexpr size_t WS_MG = WS_Q + al256((size_t)MPAD * 1024 * 2);
constexpr size_t WS_MISC = WS_MG + al256((size_t)MPAD * 2048 * 2);
constexpr size_t WS_KVH = WS_MISC + al256((size_t)MPAD * 128 * 4);
constexpr size_t WS_VT = WS_KVH + al256((size_t)6 * 16 * 4096 * 64 * 2);
constexpr size_t WS_XT = WS_VT + al256((size_t)2 * 16 * 64 * 4096 * 2);
constexpr size_t WS_BN = WS_XT + al256((size_t)4 * 32 * 64 * 4096 * 2);
constexpr size_t WS_CN = WS_BN + al256((size_t)16 * 4096 * 128 * 2);
constexpr size_t WS_BT = WS_CN + al256((size_t)16 * 4096 * 128 * 2);
constexpr size_t WS_DT = WS_BT + al256((size_t)16 * 4096 * 128 * 2);
constexpr size_t WS_CS = WS_DT + al256((size_t)128 * 4096 * 4);
constexpr size_t WS_STATES = WS_CS + al256((size_t)128 * 4096 * 4);
constexpr size_t WS_HPREV = WS_STATES + al256((size_t)4096 * 8192 * 4);
constexpr size_t WS_YSSM = WS_HPREV + al256((size_t)4096 * 8192 * 2);
constexpr size_t WS_SSQ = WS_YSSM + al256((size_t)MPAD * 2048 * 2);
constexpr size_t WS_PARTK = WS_SSQ + al256((size_t)MPAD * 4 * 4);
constexpr size_t WS_PARTV = WS_PARTK + al256((size_t)4096 * 256 * 4);
constexpr size_t WS_KC = WS_PARTV + al256((size_t)4096 * 256 * 4);
constexpr size_t WS_VCT = WS_KC + al256((size_t)16 * 256 * 64 * 2);
constexpr size_t WS_YATTF = WS_VCT + al256((size_t)16 * 256 * 64 * 2);
constexpr size_t WS_YATT = WS_YATTF + al256((size_t)MPAD * 1024 * 4);
constexpr size_t WS_TMPM = WS_YATT + al256((size_t)MPAD * 1024 * 2);
constexpr size_t WS_MERGED = WS_TMPM + al256((size_t)MPAD * 1024 * 4);
constexpr size_t WS_X1 = WS_MERGED + al256((size_t)MPAD * 1024 * 2);
constexpr size_t WS_U = WS_X1 + al256((size_t)MPAD * 1024 * 4);
constexpr size_t WS_ACT = WS_U + al256((size_t)MPAD * DFF2 * 2);
constexpr size_t WS_CKB = WS_ACT + al256((size_t)MPAD * DFF * 2);
constexpr size_t WS_CVB = WS_CKB + al256((size_t)128 * 4 * 2048 * 64 * 2);
constexpr size_t WS_PARTSK = WS_CVB + al256((size_t)128 * 4 * 2048 * 64 * 2);
constexpr size_t WS_PARTSV = WS_PARTSK + al256((size_t)65536 * 256 * 4);
constexpr size_t WS_KCS = WS_PARTSV + al256((size_t)65536 * 256 * 4);
constexpr size_t WS_VCS = WS_KCS + al256((size_t)128 * 4 * 128 * 64 * 4);
constexpr size_t WS_XCS = WS_VCS + al256((size_t)128 * 4 * 128 * 64 * 4);
constexpr size_t WS_DTS = WS_XCS + al256((size_t)128 * 3072 * 4);
constexpr size_t WS_W2T = WS_DTS + al256((size_t)128 * 32 * 4);
constexpr size_t WS_END = WS_W2T + al256((size_t)2 * 64 * 128 * 2);

constexpr int CW_BAR = 4096;

constexpr int RING_BYTES = 131072;
constexpr int LDSCTL_OFF = RING_BYTES, MISC_OFF = LDSCTL_OFF + 320;
constexpr int LDS_BYTES = 147456;

__device__ __forceinline__ unsigned f2bf(float f) { unsigned u = __builtin_bit_cast(unsigned, f); return (u + 0x7fffu + ((u >> 16) & 1u)) >> 16; }
__device__ __forceinline__ unsigned pk2(float lo, float hi) { return pg8::cvt_pk_bf16(lo, hi); }
__device__ __forceinline__ float bf2f(unsigned h) { return __builtin_bit_cast(float, h << 16); }
__device__ __forceinline__ float bflo(unsigned w) { return __builtin_bit_cast(float, w << 16); }
__device__ __forceinline__ float bfhi(unsigned w) { return __builtin_bit_cast(float, w & 0xffff0000u); }
__device__ __forceinline__ float wave_sum(float v) {
#pragma unroll
    for (int o = 1; o < 64; o <<= 1) v += __shfl_xor(v, o);
    return v;
}
__device__ __forceinline__ float siluf(float x) { return x / (1.f + __expf(-x)); }
__device__ __forceinline__ float sigmf(float x) { return 1.f / (1.f + __expf(-x)); }
__device__ __forceinline__ float softplusf(float x) { return x > 20.f ? x : log1pf(__expf(x)); }
#define LDS_WAIT() asm volatile("s_waitcnt lgkmcnt(0)" ::: "memory")

struct Args { const void* in[35]; float* out; unsigned char* ws; int ph_lo, ph_hi, p7mask, pad; };
#define INF(i) ((const float*)args.in[i])
#define XB_TMO      128
#define XB_XCNT(j)  (256  + 64 * (j))
#define XB_XSUB(j)  (1280 + 64 * (j))
#define XB_XGEN(j)  (2304 + 64 * (j))
#define XB_TOP      3328
#define XB_TOPGEN   3392
#define XCD_BAR_WORDS 3456
#define XB_SPIN_CAP (1u << 18)

__device__ __forceinline__ unsigned xb_ld(unsigned* p)              { return __hip_atomic_load(p, __ATOMIC_RELAXED, __HIP_MEMORY_SCOPE_AGENT); }
__device__ __forceinline__ unsigned xb_add(unsigned* p, unsigned v) { return __hip_atomic_fetch_add(p, v, __ATOMIC_RELAXED, __HIP_MEMORY_SCOPE_AGENT); }
__device__ __forceinline__ unsigned xb_xcc_id() { return (unsigned)__builtin_amdgcn_s_getreg((3 << 11) | 20) & 0xFu; }
#define XB_SPIN(cond, bar) do { unsigned _sp = 0; while (cond) { __builtin_amdgcn_s_sleep(1); \
    if ((++_sp & 255u) == 0u) { if (xb_ld(&(bar)[XB_TMO])) break; if (_sp > XB_SPIN_CAP) { atomicAdd(&(bar)[XB_TMO], 1u); break; } } } } while (0)

struct XcdBarrier {
    unsigned* bar; unsigned x;
    volatile LAS unsigned* st;
};

__device__ __forceinline__ XcdBarrier xcd_barrier_post(unsigned* bar, volatile LAS unsigned* st) {
    XcdBarrier b; b.bar = bar; b.x = xb_xcc_id(); b.st = st;
    if (threadIdx.x == 0) (void)xb_add(&bar[XB_XCNT(b.x)], 1u);
    return b;
}
__device__ __forceinline__ void xcd_barrier_complete(unsigned* bar, unsigned x, unsigned& nloc, unsigned& nx) {
    const unsigned G = gridDim.x * gridDim.y * gridDim.z;
    unsigned sum, cnt, mine, sp = 0u;
    for (;;) {
        sum = 0u; cnt = 0u; mine = 0u;
#pragma unroll
        for (unsigned j = 0; j < 16; ++j) { const unsigned c = xb_ld(&bar[XB_XCNT(j)]); sum += c; cnt += (c > 0u) ? 1u : 0u; mine = (j == x) ? c : mine; }
        if (sum == G) break;
        __builtin_amdgcn_s_sleep(1);
        if ((++sp & 255u) == 0u) { if (xb_ld(&bar[XB_TMO])) break; if (sp > XB_SPIN_CAP) { atomicAdd(&bar[XB_TMO], 1u); break; } }
    }
    nloc = mine > 0u ? mine : 1u; nx = cnt > 0u ? cnt : 1u;
}

__device__ __forceinline__ void xcd_barrier(const XcdBarrier& b) {
    asm volatile("s_waitcnt vmcnt(0)" ::: "memory");
    __syncthreads();
    if (threadIdx.x == 0) {
        unsigned* bar = b.bar;
        __builtin_amdgcn_s_waitcnt(0);
        unsigned nloc = b.st[0], nx = b.st[1];
        if (nloc == 0u) { xcd_barrier_complete(bar, b.x, nloc, nx); b.st[0] = nloc; b.st[1] = nx; }
        const unsigned old = xb_add(&bar[XB_XSUB(b.x)], 1u);
        const unsigned gen = old / nloc;
        if (old + 1u == (gen + 1u) * nloc) {
            __builtin_amdgcn_fence(__ATOMIC_RELEASE, "agent");
            asm volatile("s_waitcnt vmcnt(0)" ::: "memory");
            const unsigned og = xb_add(&bar[XB_TOP], 1u);
            const unsigned tg = og / nx;
            if (og + 1u == (tg + 1u) * nx) xb_add(&bar[XB_TOPGEN], 1u);
            else XB_SPIN(xb_ld(&bar[XB_TOPGEN]) == tg, bar);
            __builtin_amdgcn_fence(__ATOMIC_ACQUIRE, "agent");
            xb_add(&bar[XB_XGEN(b.x)], 1u);
            asm volatile("s_waitcnt vmcnt(0)" ::: "memory");
        } else {
            XB_SPIN(xb_ld(&bar[XB_XGEN(b.x)]) == gen, bar);
            __builtin_amdgcn_fence(__ATOMIC_ACQUIRE, "agent");
            asm volatile("s_waitcnt vmcnt(0)" ::: "memory");
        }
    }
    __syncthreads();
}
__device__ __forceinline__ int inproj_src_col(int n) {
    if (n < 5120) return n;
    if (n < 6144) return n - 5120 + 5152;
    if (n < 7680) return n - 6144 + 6176;
    if (n < 9728) return n - 7680 + 7760;
    const int i = n - 9728;
    if (i < 32) return 5120 + i;
    if (i < 80) return 7712 + (i - 32);
    return -1;
}
template <int MODE>
__device__ __forceinline__ void transpose_item(const float* W, int K, int ldw, int nblk, bf16* WT, int row_off, LAS float* scr, int item, int lane) {
    const int kb = item / nblk, nb = item % nblk, k0 = 64 * kb, n0 = 32 * nb;
    const int n = n0 + (lane & 31);
    const int sc = (MODE == 1) ? inproj_src_col(n) : n;
#pragma unroll 8
    for (int i = 0; i < 32; ++i) { const int kk = 2 * i + (lane >> 5); scr[kk * 33 + (lane & 31)] = (sc >= 0) ? W[(size_t)(k0 + kk) * ldw + sc] : 0.f; }
    LDS_WAIT(); asm volatile("" ::: "memory");
    const int c = lane & 7;
#pragma unroll
    for (int j = 0; j < 4; ++j) { const int nn = (lane >> 3) + 8 * j; const LAS float* s = scr + (8 * c) * 33 + nn;
        u32x4 o; o.x = pk2(s[0 * 33], s[1 * 33]); o.y = pk2(s[2 * 33], s[3 * 33]); o.z = pk2(s[4 * 33], s[5 * 33]); o.w = pk2(s[6 * 33], s[7 * 33]);
        *(u32x4*)(WT + (size_t)(row_off + n0 + nn) * K + k0 + 8 * c) = o; }
    LDS_WAIT(); asm volatile("" ::: "memory");
}

__device__ __forceinline__ void p0_prologue(const Args& args, LAS unsigned char* lds, int gw, int NGW, int lane, int wave) {
    unsigned char* ws = args.ws;
    const int p0m = args.pad;
    LAS float* scr = (LAS float*)(lds + wave * 16384);
    constexpr int I_IN = 16 * (NPROJ / 32), I_SSM = 32 * 32, I_ATT = 16 * 32, I_OUT = 16 * 32, I_UP = 16 * (DFF2 / 32), I_DN = (DFF / 64) * 32, I_ADA = 16 * (6144 / 32), I_W1 = 16 * 4;
    constexpr int NITEMS = I_IN + I_SSM + I_ATT + I_OUT + I_UP + I_DN + I_ADA + 4 * I_W1;
    if (p0m & 1) for (int it = gw; it < NITEMS; it += NGW) {
        int r = it;
        if (r < I_ADA) { transpose_item<0>(INF(10), 1024, 6144, 6144 / 32, (bf16*)(ws + WS_WADA), 0, scr, r, lane); continue; } r -= I_ADA;
        if (r < I_IN) { transpose_item<1>(INF(15), 1024, 9808, NPROJ / 32, (bf16*)(ws + WS_WIN), 0, scr, r, lane); continue; } r -= I_IN;
        if (r < I_SSM) { transpose_item<0>(INF(28), 2048, 1024, 32, (bf16*)(ws + WS_WSSM), 0, scr, r, lane); continue; } r -= I_SSM;
        if (r < I_ATT) { transpose_item<0>(INF(29), 1024, 1024, 32, (bf16*)(ws + WS_WATT), 0, scr, r, lane); continue; } r -= I_ATT;
        if (r < I_OUT) { transpose_item<0>(INF(30), 1024, 1024, 32, (bf16*)(ws + WS_WOUT), 0, scr, r, lane); continue; } r -= I_OUT;
        if (r < I_UP) { transpose_item<0>(INF(31), 1024, DFF2, DFF2 / 32, (bf16*)(ws + WS_WUP), 0, scr, r, lane); continue; } r -= I_UP;
        if (r < I_DN) { transpose_item<0>(INF(34), DFF, 1024, 32, (bf16*)(ws + WS_WDN), 0, scr, r, lane); continue; } r -= I_DN;
        { const int which = r / I_W1, rr = r % I_W1; const int st = which >> 1, r2 = which & 1;
          transpose_item<0>(INF(st ? 26 : 23) + (size_t)r2 * 16 * 64 * 128, 1024, 128, 4, (bf16*)(ws + (st ? WS_W1V : WS_W1K)), r2 * 128, scr, rr, lane); }
    }
    if (p0m & 4) {
    for (int r = gw; r < 256; r += NGW) {
        bf16* o = (bf16*)(ws + WS_SC) + (size_t)r * 1024;
        const float* src = r < 4 ? INF(2) + (size_t)r * 1024 : (r < 132 ? INF(3) + (size_t)(r - 4) * 1024 : nullptr);
#pragma unroll
        for (int j = 0; j < 4; ++j) { const int c0 = (j * 64 + lane) * 4; f32x4 v = src ? *(const f32x4*)(src + c0) : (f32x4){0.f, 0.f, 0.f, 0.f};
            u32x2 w; w.x = pk2(src ? siluf(v.x) : 0.f, src ? siluf(v.y) : 0.f); w.y = pk2(src ? siluf(v.z) : 0.f, src ? siluf(v.w) : 0.f); *(u32x2*)(o + c0) = w; }
    }
    for (int i = gw * 64 + lane; i < 4096 * 8; i += NGW * 64) {
        const int pos = i >> 3, k = i & 7;
        const float invf[8] = {1.0f, 0.1939227432012558f, 0.03760603070259094f, 0.007292664609849453f, 0.0014142135623842478f, 0.00027424818836152554f, 5.318296098266728e-05f, 1.0313386155758053e-05f};
        float fr = 1.0f;
#pragma unroll
        for (int q = 0; q < 8; ++q) fr = (k == q) ? invf[q] : fr;
        const float ang = (float)pos * fr;
        const double ad = (double)ang, rev = ad * 0.15915494309189535;
        const float fracrev = (float)(rev - __builtin_floor(rev));
        float* o = (float*)(ws + WS_ROPE) + (size_t)pos * 16;
        o[k] = __builtin_amdgcn_cosf(fracrev); o[8 + k] = __builtin_amdgcn_sinf(fracrev);
    }
    for (int it = gw; it < 256; it += NGW) {
        const int st = it >> 7, e = it & 127; const float* pe = INF(st ? 25 : 22); const float* w1 = INF(st ? 26 : 23);
        float s = 0.f;
        for (int i = 0; i < 32; ++i) { const int idx = lane + 64 * i; s += pe[idx] * w1[(size_t)idx * 128 + e]; }
        s = wave_sum(s);
        if (lane == 0) ((float*)(ws + WS_PET))[it] = s;
    }
    }
    if (p0m & 2) {
        const int* pt = (const int*)args.in[5]; const float* cache = INF(4);
        constexpr int NIT = 128 * 2 * 4 * 256;
        const int r = lane >> 3, c = lane & 7;
        for (int it0 = gw; it0 < NIT; it0 += 4 * NGW) {
            f32x4 v[4][2];
#pragma unroll
            for (int k = 0; k < 4; ++k) { const int it = it0 + k * NGW;
                if (it < NIT) { const int tg = it & 255, h = (it >> 8) & 3, s = (it >> 10) & 1, b = it >> 11; const int t = tg * 8 + r; const int page = pt[b * NPAGES + (tg >> 4)];
                    const float* src = cache + (((size_t)page * 128 + (t & 127)) * 4 + s) * 256 + h * 64 + c * 8;
                    v[k][0] = *(const f32x4*)src; v[k][1] = *(const f32x4*)(src + 4); } }
#pragma unroll
            for (int k = 0; k < 4; ++k) { const int it = it0 + k * NGW;
                if (it < NIT) { const int tg = it & 255, h = (it >> 8) & 3, s = (it >> 10) & 1, b = it >> 11;
                    bf16* dst = (bf16*)(ws + (s ? WS_CVB : WS_CKB)) + (((size_t)(b * 4 + h) * 2048 + tg * 8 + r) * 64 + c * 8);
                    u32x4 w; w.x = pk2(v[k][0].x, v[k][0].y); w.y = pk2(v[k][0].z, v[k][0].w); w.z = pk2(v[k][1].x, v[k][1].y); w.w = pk2(v[k][1].z, v[k][1].w); *(u32x4*)dst = w; } }
        }
    }
    if (p0m & 4) for (int i = gw * 64 + lane; i < 2 * 64 * 128; i += NGW * 64) { const int st = i >> 13, d = (i >> 7) & 63, e = i & 127;
        ((bf16*)(ws + WS_W2T))[i] = (bf16)f2bf(INF(st ? 27 : 24)[e * 64 + d]); }
}

template <int WHICH>
__device__ __forceinline__ void norm_mod_phase(const Args& args, int gw, int NGW, int lane) {
    unsigned char* ws = args.ws; const float* MOD = (const float*)(ws + WS_MOD); bf16* H = (bf16*)(ws + WS_H);
    const float* nw = INF(WHICH == 0 ? 12 : (WHICH == 1 ? 13 : 14));
    constexpr int SH = WHICH ? 3072 : 0, SCo = WHICH ? 4096 : 1024;
    for (int grp = gw; grp < MPAD / 4; grp += NGW) {
        const int m0 = grp * 4;
        if (m0 >= MALL) {
            if (WHICH < 2) {
#pragma unroll
                for (int r = 0; r < 4; ++r)
#pragma unroll
                    for (int j = 0; j < 4; ++j) ((u32x2*)(H + (size_t)(m0 + r) * 1024))[j * 64 + lane] = (u32x2){0u, 0u};
            }
            continue; }
        f32x4 v[4][4]; float ss[4];
#pragma unroll
        for (int r = 0; r < 4; ++r) { const int m = m0 + r;
            const float* xr = WHICH ? (const float*)(ws + WS_X1) + (size_t)m * 1024 : (m < MP ? INF(0) + (size_t)m * 1024 : INF(1) + (size_t)(m - MP) * 1024);
            float s = 0.f;
#pragma unroll
            for (int j = 0; j < 4; ++j) { v[r][j] = *(const f32x4*)(xr + (j * 64 + lane) * 4); s += (v[r][j].x * v[r][j].x + v[r][j].y * v[r][j].y) + (v[r][j].z * v[r][j].z + v[r][j].w * v[r][j].w); }
            ss[r] = s; }
#pragma unroll
        for (int o = 1; o < 64; o <<= 1)
#pragma unroll
            for (int r = 0; r < 4; ++r) ss[r] += __shfl_xor(ss[r], o);
        f32x4 w[4];
#pragma unroll
        for (int j = 0; j < 4; ++j) w[j] = *(const f32x4*)(nw + (j * 64 + lane) * 4);
#pragma unroll
        for (int r = 0; r < 4; ++r) { const int m = m0 + r;
            const float rstd = 1.f / sqrtf(ss[r] * (1.f / 1024.f) + EPS);
            if (WHICH == 2) { float* o = args.out + (m < MP ? O_YP + (size_t)m * 1024 : O_YS + (size_t)(m - MP) * 1024);
#pragma unroll
                for (int j = 0; j < 4; ++j) *(f32x4*)(o + (j * 64 + lane) * 4) = (v[r][j] * rstd) * w[j];
            } else {
                const float* mr = MOD + (size_t)(m < MP ? (m >> 12) : 4 + (m - MP)) * 6144;
                u32x2* o = (u32x2*)(H + (size_t)m * 1024);
#pragma unroll
                for (int j = 0; j < 4; ++j) { const int c0 = (j * 64 + lane) * 4;
                    const f32x4 sc = *(const f32x4*)(mr + SCo + c0), sh = *(const f32x4*)(mr + SH + c0);
                    const f32x4 rr = (v[r][j] * rstd) * w[j] * (sc + 1.f) + sh;
                    u32x2 pk; pk.x = pk2(rr.x, rr.y); pk.y = pk2(rr.z, rr.w); o[j * 64 + lane] = pk; }
            }
        }
    }
}
namespace epi {
using pg8::Unit; using pg8::f32x4;
typedef unsigned u32x4 __attribute__((ext_vector_type(4)));
__device__ __forceinline__ u32x4 pack8(const f32x4& a, const f32x4& b) { u32x4 w; w.x = pg8::cvt_pk_bf16(a[0], a[1]); w.y = pg8::cvt_pk_bf16(a[2], a[3]); w.z = pg8::cvt_pk_bf16(b[0], b[1]); w.w = pg8::cvt_pk_bf16(b[2], b[3]); return w; }

struct InProj {
    static constexpr bool PERM = true, AFTER_DRAIN = false;
    unsigned char* ws; float* out;
    __device__ __forceinline__ void operator()(const f32x4 (&acc)[2][2][4][2], const Unit& u, int wr, int wc, int fr, int fq) const {
        const int pn = u.pn;
        const int rowb = u.pm * 256 + wr * 64 + fr;
        const int cl = wc * 32 + 8 * fq;
        if (pn < T_XBC || (pn >= T_MG && pn < T_MISC)) {
            bf16* base = pn < T_XBC ? (bf16*)(ws + WS_Z) : (bf16*)(ws + WS_MG);
            const int colt = (pn < T_XBC ? pn : pn - T_MG) * 256 + cl;
#pragma unroll
            for (int ai = 0; ai < 2; ++ai)
#pragma unroll
                for (int m = 0; m < 4; ++m) { const int row = rowb + ai * 128 + m * 16;
#pragma unroll
                    for (int bj = 0; bj < 2; ++bj) *(u32x4*)(base + (size_t)row * 2048 + colt + bj * 128) = pack8(acc[ai][bj][m][0], acc[ai][bj][m][1]); }
        } else if (pn < T_Q) {
            bf16* base = (bf16*)(ws + WS_XBC); const int colt = (pn - T_XBC) * 256 + cl;
#pragma unroll
            for (int ai = 0; ai < 2; ++ai)
#pragma unroll
                for (int m = 0; m < 4; ++m) { const int row = rowb + ai * 128 + m * 16;
                    float* fo = nullptr;
                    if (row < MP) { const int t = row & 4095; if (t >= 4093) fo = out + O_CONVP + ((size_t)(row >> 12) * 3 + (t - 4093)) * CONVD; }
                    else if (row < MALL) fo = out + O_CONVS + ((size_t)(row - MP) * 3 + 2) * CONVD;
#pragma unroll
                    for (int bj = 0; bj < 2; ++bj) { const int col = colt + bj * 128;
                        *(u32x4*)(base + (size_t)row * CONVD + col) = pack8(acc[ai][bj][m][0], acc[ai][bj][m][1]);
                        if (fo) { *(f32x4*)(fo + col) = acc[ai][bj][m][0]; *(f32x4*)(fo + col + 4) = acc[ai][bj][m][1]; } } }
        } else if (pn < T_MG) {
            const bool isq = pn < T_KV; const int s = pn - T_KV;
            const bool dorope = (isq || !(s & 1)) && !(wc & 1);
            const float* rope = (const float*)(ws + WS_ROPE);
#pragma unroll
            for (int ai = 0; ai < 2; ++ai)
#pragma unroll
                for (int m = 0; m < 4; ++m) { const int row = rowb + ai * 128 + m * 16;
                    const int pos = row < MP ? (row & 4095) : PAST;
#pragma unroll
                    for (int bj = 0; bj < 2; ++bj) {
                        f32x4 v0 = acc[ai][bj][m][0], v1 = acc[ai][bj][m][1];
                        if (dorope) {
                            f32x4 o0, o1;
#pragma unroll
                            for (int i = 0; i < 4; ++i) { o0[i] = __shfl_xor(v0[i], 16); o1[i] = __shfl_xor(v1[i], 16); }
                            if (fq < 2) {
                                const f32x4 c0 = *(const f32x4*)(rope + pos * 16), c1 = *(const f32x4*)(rope + pos * 16 + 4), s0 = *(const f32x4*)(rope + pos * 16 + 8), s1 = *(const f32x4*)(rope + pos * 16 + 12);
                                if (fq == 0) { v0 = v0 * c0 - o0 * s0; v1 = v1 * c1 - o1 * s1; }
                                else         { v0 = v0 * c0 + o0 * s0; v1 = v1 * c1 + o1 * s1; }
                            }
                        }
                        const int col = cl + bj * 128;
                        const u32x4 pk = pack8(v0, v1);
                        if (isq) { *(u32x4*)((bf16*)(ws + WS_Q) + (size_t)row * 1024 + (pn - T_Q) * 256 + col) = pk; }
                        else {
                            const int h = col >> 6, d = col & 63;
                            if (row < MP) {
                                const int b = row >> 12, t = row & 4095;
                                *(u32x4*)((bf16*)(ws + WS_KVH) + ((((size_t)s * 4 + b) * 4 + h) * 4096 + t) * 64 + d) = pk;
                                if (s < 4) { float* fo = out + O_KVP + ((size_t)row * 4 + s) * 256 + col; *(f32x4*)fo = v0; *(f32x4*)(fo + 4) = v1; }
                                else if (t >= 3584) { float* fo = out + O_WINP + (((size_t)b * 512 + (t - 3584)) * 2 + (s - 4)) * 256 + col; *(f32x4*)fo = v0; *(f32x4*)(fo + 4) = v1; }
                                if (s == 3 || s == 5) {
                                    const int kk = t & 31, kpos = 8 * ((kk & 15) >> 2) + 4 * (kk >> 4) + (kk & 3);
                                    bf16* vt = (bf16*)(ws + WS_VT) + ((((size_t)(s == 5) * 4 + b) * 4 + h) * 128 + (t >> 5)) * 2048 + d * 32 + kpos;
                                    vt[0 * 32] = (bf16)(pk.x & 0xffffu); vt[1 * 32] = (bf16)(pk.x >> 16); vt[2 * 32] = (bf16)(pk.y & 0xffffu); vt[3 * 32] = (bf16)(pk.y >> 16);
                                    vt[4 * 32] = (bf16)(pk.z & 0xffffu); vt[5 * 32] = (bf16)(pk.z >> 16); vt[6 * 32] = (bf16)(pk.w & 0xffffu); vt[7 * 32] = (bf16)(pk.w >> 16);
                                }
                            } else if (row < MALL) {
                                const int bs = row - MP;
                                float* fo = s < 4 ? out + O_KVS + ((size_t)bs * 4 + s) * 256 + col : out + O_WINS + (((size_t)bs * 512 + 511) * 2 + (s - 4)) * 256 + col;
                                *(f32x4*)fo = v0; *(f32x4*)(fo + 4) = v1;
                            }
                        }
                    } }
        } else {
            float* base = (float*)(ws + WS_MISC);
#pragma unroll
            for (int ai = 0; ai < 2; ++ai)
#pragma unroll
                for (int m = 0; m < 4; ++m) { const int row = rowb + ai * 128 + m * 16;
                    *(f32x4*)(base + (size_t)row * 128 + cl) = acc[ai][0][m][0]; *(f32x4*)(base + (size_t)row * 128 + cl + 4) = acc[ai][0][m][1]; }
        }
    }
};

struct Merge1 {
    static constexpr bool PERM = true, AFTER_DRAIN = false;
    unsigned char* ws;
    __device__ __forceinline__ void operator()(const f32x4 (&acc)[2][2][4][2], const Unit& u, int wr, int wc, int fr, int fq) const {
        const int rowb = u.pm * 256 + wr * 64 + fr, colb = u.pn * 256 + wc * 32 + 8 * fq;
        const bf16* MG = (const bf16*)(ws + WS_MG); const float* SSQ = (const float*)(ws + WS_SSQ); float* T = (float*)(ws + WS_TMPM);
#pragma unroll
        for (int ai = 0; ai < 2; ++ai)
#pragma unroll
            for (int m = 0; m < 4; ++m) { const int row = rowb + ai * 128 + m * 16;
                const f32x4 sq = *(const f32x4*)(SSQ + (size_t)row * 4);
                const float rstd = 1.f / sqrtf(((sq.x + sq.y) + (sq.z + sq.w)) * (1.f / 2048.f) + EPS);
#pragma unroll
                for (int bj = 0; bj < 2; ++bj) { const int col = colb + bj * 128;
                    const u32x4 g = *(const u32x4*)(MG + (size_t)row * 2048 + col);
                    f32x4 o0, o1;
                    o0[0] = sigmf(bflo(g.x)) * rstd * acc[ai][bj][m][0][0]; o0[1] = sigmf(bfhi(g.x)) * rstd * acc[ai][bj][m][0][1];
                    o0[2] = sigmf(bflo(g.y)) * rstd * acc[ai][bj][m][0][2]; o0[3] = sigmf(bfhi(g.y)) * rstd * acc[ai][bj][m][0][3];
                    o1[0] = sigmf(bflo(g.z)) * rstd * acc[ai][bj][m][1][0]; o1[1] = sigmf(bfhi(g.z)) * rstd * acc[ai][bj][m][1][1];
                    o1[2] = sigmf(bflo(g.w)) * rstd * acc[ai][bj][m][1][2]; o1[3] = sigmf(bfhi(g.w)) * rstd * acc[ai][bj][m][1][3];
                    *(f32x4*)(T + (size_t)row * 1024 + col) = o0; *(f32x4*)(T + (size_t)row * 1024 + col + 4) = o1; } }
    }
};
struct Merge2 {
    static constexpr bool PERM = true, AFTER_DRAIN = false;
    unsigned char* ws;
    __device__ __forceinline__ void operator()(const f32x4 (&acc)[2][2][4][2], const Unit& u, int wr, int wc, int fr, int fq) const {
        const int rowb = u.pm * 256 + wr * 64 + fr, colb = u.pn * 256 + wc * 32 + 8 * fq;
        const bf16* MG = (const bf16*)(ws + WS_MG); const float* T = (const float*)(ws + WS_TMPM); bf16* O = (bf16*)(ws + WS_MERGED);
#pragma unroll
        for (int ai = 0; ai < 2; ++ai)
#pragma unroll
            for (int m = 0; m < 4; ++m) { const int row = rowb + ai * 128 + m * 16;
#pragma unroll
                for (int bj = 0; bj < 2; ++bj) { const int col = colb + bj * 128;
                    const u32x4 g = *(const u32x4*)(MG + (size_t)row * 2048 + 1024 + col);
                    f32x4 o0 = *(const f32x4*)(T + (size_t)row * 1024 + col), o1 = *(const f32x4*)(T + (size_t)row * 1024 + col + 4);
                    o0[0] += sigmf(bflo(g.x)) * acc[ai][bj][m][0][0]; o0[1] += sigmf(bfhi(g.x)) * acc[ai][bj][m][0][1];
                    o0[2] += sigmf(bflo(g.y)) * acc[ai][bj][m][0][2]; o0[3] += sigmf(bfhi(g.y)) * acc[ai][bj][m][0][3];
                    o1[0] += sigmf(bflo(g.z)) * acc[ai][bj][m][1][0]; o1[1] += sigmf(bfhi(g.z)) * acc[ai][bj][m][1][1];
                    o1[2] += sigmf(bflo(g.w)) * acc[ai][bj][m][1][2]; o1[3] += sigmf(bfhi(g.w)) * acc[ai][bj][m][1][3];
                    *(u32x4*)(O + (size_t)row * 1024 + col) = pack8(o0, o1); } }
    }
};
struct Resid {
    static constexpr bool PERM = false, AFTER_DRAIN = false;
    const float* xp; const float* xs; const float* x1in; float* x1out; const float* MOD; int goff;
    __device__ __forceinline__ void operator()(const f32x4 (&acc)[2][2][4][2], const Unit& u, int wr, int wc, int fr, int fq) const {
        const int rowb = u.pm * 256 + wr * 64 + fr, colb = u.pn * 256 + wc * 32 + 4 * fq;
#pragma unroll
        for (int ai = 0; ai < 2; ++ai)
#pragma unroll
            for (int m = 0; m < 4; ++m) { const int row = rowb + ai * 128 + m * 16;
                if (row >= MALL) continue;
                const float* base = x1in ? x1in + (size_t)row * 1024 : (row < MP ? xp + (size_t)row * 1024 : xs + (size_t)(row - MP) * 1024);
                const float* gr = MOD + (size_t)(row < MP ? (row >> 12) : 4 + (row - MP)) * 6144 + goff;
#pragma unroll
                for (int bj = 0; bj < 2; ++bj)
#pragma unroll
                    for (int n = 0; n < 2; ++n) { const int col = colb + bj * 128 + n * 16;
                        *(f32x4*)(x1out + (size_t)row * 1024 + col) = *(const f32x4*)(base + col) + *(const f32x4*)(gr + col) * acc[ai][bj][m][n]; } }
    }
};
struct Up {
    static constexpr bool PERM = true, AFTER_DRAIN = false;
    unsigned char* ws; float* out;
    __device__ __forceinline__ void operator()(const f32x4 (&acc)[2][2][4][2], const Unit& u, int wr, int wc, int fr, int fq) const {
        const int rowb = u.pm * 256 + wr * 64 + fr, colb = u.pn * 256 + wc * 32 + 8 * fq;
        bf16* U = (bf16*)(ws + WS_U);
#pragma unroll
        for (int ai = 0; ai < 2; ++ai)
#pragma unroll
            for (int m = 0; m < 4; ++m) { const int row = rowb + ai * 128 + m * 16;
                float* fo = nullptr;
                if (row < MP) { const int t = row & 4095; if (t >= 4094) fo = out + O_FFNP + ((size_t)(row >> 12) * 2 + (t - 4094)) * DFF2; }
                else if (row < MALL) fo = out + O_FFNS + ((size_t)(row - MP) * 2 + 1) * DFF2;
#pragma unroll
                for (int bj = 0; bj < 2; ++bj) { const int col = colb + bj * 128;
                    *(u32x4*)(U + (size_t)row * DFF2 + col) = pack8(acc[ai][bj][m][0], acc[ai][bj][m][1]);
                    if (fo) { *(f32x4*)(fo + col) = acc[ai][bj][m][0]; *(f32x4*)(fo + col + 4) = acc[ai][bj][m][1]; } } }
    }
};
}
__device__ __forceinline__ void conv_prompt_item(const Args& args, int item, int lane) {
    unsigned char* ws = args.ws;
    const int tg = item / 48, cgp = item % 48, cg = lane & 7, rg = lane >> 3;
    const int m0 = tg * 64 + 8 * rg, b = m0 >> 12, t0 = m0 & 4095, ch0 = cgp * 64 + 8 * cg;
    const bf16* X = (const bf16*)(ws + WS_XBC);
    float x[11][8];
#pragma unroll
    for (int i = 0; i < 11; ++i) {
        const int t = t0 - 3 + i;
        u32x4 v = (u32x4){0u, 0u, 0u, 0u};
        if (t >= 0) v = *(const u32x4*)(X + (size_t)(m0 - 3 + i) * CONVD + ch0);
        x[i][0] = bflo(v.x); x[i][1] = bfhi(v.x); x[i][2] = bflo(v.y); x[i][3] = bfhi(v.y); x[i][4] = bflo(v.z); x[i][5] = bfhi(v.z); x[i][6] = bflo(v.w); x[i][7] = bfhi(v.w);
    }
    const float* cw = INF(16); const float* cb = INF(17);
    float w[4][8], bias[8];
#pragma unroll
    for (int k = 0; k < 4; ++k) { const f32x4 a = *(const f32x4*)(cw + k * CONVD + ch0), c = *(const f32x4*)(cw + k * CONVD + ch0 + 4);
        w[k][0] = a.x; w[k][1] = a.y; w[k][2] = a.z; w[k][3] = a.w; w[k][4] = c.x; w[k][5] = c.y; w[k][6] = c.z; w[k][7] = c.w; }
    { const f32x4 a = *(const f32x4*)(cb + ch0), c = *(const f32x4*)(cb + ch0 + 4); bias[0] = a.x; bias[1] = a.y; bias[2] = a.z; bias[3] = a.w; bias[4] = c.x; bias[5] = c.y; bias[6] = c.z; bias[7] = c.w; }
    float y[8][8];
#pragma unroll
    for (int i = 0; i < 8; ++i)
#pragma unroll
        for (int c = 0; c < 8; ++c) { const float a = bias[c] + w[0][c] * x[i][c] + w[1][c] * x[i + 1][c] + w[2][c] * x[i + 2][c] + w[3][c] * x[i + 3][c]; y[i][c] = siluf(a); }
    if (cgp < 32) {
        bf16* XT = (bf16*)(ws + WS_XT) + ((size_t)(b * 32 + cgp) * 128 + (t0 >> 5)) * 2048 + (8 * cg) * 32 + (t0 & 31);
#pragma unroll
        for (int c = 0; c < 8; ++c) { u32x4 o; o.x = pk2(y[0][c], y[1][c]); o.y = pk2(y[2][c], y[3][c]); o.z = pk2(y[4][c], y[5][c]); o.w = pk2(y[6][c], y[7][c]); *(u32x4*)(XT + (size_t)c * 32) = o; }
    } else {
        const int isC = cgp >= 40, gg = ((cgp - 32) & 7) >> 1, n0 = ((cgp - 32) & 1) * 64 + 8 * cg;
        bf16* N = (bf16*)(ws + (isC ? WS_CN : WS_BN)) + ((size_t)(b * 4 + gg) * 4096 + t0) * 128 + n0;
#pragma unroll
        for (int i = 0; i < 8; ++i) { u32x4 o; o.x = pk2(y[i][0], y[i][1]); o.y = pk2(y[i][2], y[i][3]); o.z = pk2(y[i][4], y[i][5]); o.w = pk2(y[i][6], y[i][7]); *(u32x4*)(N + (size_t)i * 128) = o; }
        if (!isC) {
            bf16* BT = (bf16*)(ws + WS_BT) + ((size_t)(b * 4 + gg) * 128 + (t0 >> 5)) * 4096 + n0 * 32 + (t0 & 31);
#pragma unroll
            for (int c = 0; c < 8; ++c) { u32x4 o; o.x = pk2(y[0][c], y[1][c]); o.y = pk2(y[2][c], y[3][c]); o.z = pk2(y[4][c], y[5][c]); o.w = pk2(y[6][c], y[7][c]); *(u32x4*)(BT + (size_t)c * 32) = o; }
        }
    }
}
__device__ __forceinline__ void dtcs_item(const Args& args, int item, int lane) {
    unsigned char* ws = args.ws;
    const int c = item & 31, h = (item >> 5) & 31, b = item >> 10;
    const float* MISC = (const float*)(ws + WS_MISC);
    const float bias = INF(18)[h], a = -__expf(INF(19)[h]);
    const int t = c * 128 + 2 * lane; const size_t m = (size_t)b * 4096 + t;
    const float d0 = softplusf(MISC[m * 128 + h] + bias), d1 = softplusf(MISC[(m + 1) * 128 + h] + bias);
    const float a0 = d0 * a, a1 = d1 * a;
    float s = a0 + a1;
#pragma unroll
    for (int o = 1; o < 64; o <<= 1) { const float v = __shfl_up(s, o); if (lane >= o) s += v; }
    const float c1 = s, c0 = s - a1;
    float* DT = (float*)(ws + WS_DT) + (size_t)(b * 32 + h) * 4096 + t; float* CS = (float*)(ws + WS_CS) + (size_t)(b * 32 + h) * 4096 + t;
    *(f32x2*)DT = (f32x2){d0, d1}; *(f32x2*)CS = (f32x2){c0, c1};
}
__device__ __forceinline__ void sample_conv(const Args& args, int gt, int NGT) {
    unsigned char* ws = args.ws; float* out = args.out;
    const float* st = INF(8); const float* cw = INF(16); const float* cb = INF(17);
    for (int i = gt; i < MS * CONVD; i += NGT) {
        const int bs = i / CONVD, ch = i % CONVD;
        const float s0 = st[((size_t)bs * 3 + 0) * CONVD + ch], s1 = st[((size_t)bs * 3 + 1) * CONVD + ch], s2 = st[((size_t)bs * 3 + 2) * CONVD + ch];
        const float xn = out[O_CONVS + ((size_t)bs * 3 + 2) * CONVD + ch];
        out[O_CONVS + ((size_t)bs * 3 + 0) * CONVD + ch] = s1; out[O_CONVS + ((size_t)bs * 3 + 1) * CONVD + ch] = s2;
        const float a = cb[ch] + cw[ch] * s0 + cw[CONVD + ch] * s1 + cw[2 * CONVD + ch] * s2 + cw[3 * CONVD + ch] * xn;
        ((float*)(ws + WS_XCS))[i] = siluf(a);
    }
    for (int i = gt; i < MS * NH; i += NGT) { const int bs = i >> 5, h = i & 31;
        ((float*)(ws + WS_DTS))[i] = softplusf(((const float*)(ws + WS_MISC))[(size_t)(MP + bs) * 128 + h] + INF(18)[h]); }
}

__device__ __forceinline__ void ssd_states_unit(const Args& args, LAS unsigned char* lds, int unit, int wave, int lane) {
    unsigned char* ws = args.ws;
    const int g = unit & 3, c = (unit >> 2) & 31, b = unit >> 7, h = g * 8 + wave, q = lane >> 4, r16 = lane & 15;
    LAS float* wl = (LAS float*)(lds + wave * 512);
    const float* DT = (const float*)(ws + WS_DT) + (size_t)(b * 32 + h) * 4096 + c * 128; const float* CS = (const float*)(ws + WS_CS) + (size_t)(b * 32 + h) * 4096 + c * 128;
    const float cl = CS[127];
    wl[lane] = DT[lane] * __expf(cl - CS[lane]); wl[lane + 64] = DT[lane + 64] * __expf(cl - CS[lane + 64]);
    LDS_WAIT(); asm volatile("" ::: "memory");
    const bf16* XT = (const bf16*)(ws + WS_XT) + ((size_t)(b * 32 + h) * 128 + c * 4) * 2048;
    const bf16* BT = (const bf16*)(ws + WS_BT) + ((size_t)(b * 4 + g) * 128 + c * 4) * 4096;
    float* ST = (float*)(ws + WS_STATES) + (((size_t)(b * 32 + c) * 32 + h) * 64) * 128;
#pragma unroll 1
    for (int nh = 0; nh < 2; ++nh) {
        f32x4 acc[4][4];
#pragma unroll
        for (int i = 0; i < 4; ++i)
#pragma unroll
            for (int j = 0; j < 4; ++j) acc[i][j] = (f32x4){0.f, 0.f, 0.f, 0.f};
#pragma unroll 1
        for (int ks = 0; ks < 4; ++ks) {
            const int s0 = 32 * ks + 8 * q;
            const f32x4 w0 = *(const LAS f32x4*)(wl + s0), w1 = *(const LAS f32x4*)(wl + s0 + 4);
            bf16x8 af[4];
#pragma unroll
            for (int pt = 0; pt < 4; ++pt) { const u32x4 v = *(const u32x4*)(XT + (size_t)ks * 2048 + (16 * pt + r16) * 32 + 8 * q);
                u32x4 o; o.x = pk2(bflo(v.x) * w0.x, bfhi(v.x) * w0.y); o.y = pk2(bflo(v.y) * w0.z, bfhi(v.y) * w0.w); o.z = pk2(bflo(v.z) * w1.x, bfhi(v.z) * w1.y); o.w = pk2(bflo(v.w) * w1.z, bfhi(v.w) * w1.w);
                af[pt] = __builtin_bit_cast(bf16x8, o); }
#pragma unroll
            for (int nt = 0; nt < 4; ++nt) { const bf16x8 bf = *(const bf16x8*)(BT + (size_t)ks * 4096 + (64 * nh + 16 * nt + r16) * 32 + 8 * q);
#pragma unroll
                for (int pt = 0; pt < 4; ++pt) acc[pt][nt] = MFMA16(af[pt], bf, acc[pt][nt]); }
        }
#pragma unroll
        for (int pt = 0; pt < 4; ++pt)
#pragma unroll
            for (int nt = 0; nt < 4; ++nt)
#pragma unroll
                for (int r = 0; r < 4; ++r) ST[(size_t)(16 * pt + 4 * q + r) * 128 + 64 * nh + 16 * nt + r16] = acc[pt][nt][r];
    }
}

template <int SAMPLE>
__device__ __forceinline__ void compress2_item(const Args& args, int item, int lane) {
    unsigned char* ws = args.ws;
    const int q = lane >> 4, r16 = lane & 15;
    constexpr int NPB = SAMPLE ? 128 : 256;
    constexpr int NI = (SAMPLE ? 65536 : 4096) / 16;
    const int st = item / NI, row0 = (item % NI) * 16;
    const float* P = (const float*)(ws + (SAMPLE ? (st ? WS_PARTSV : WS_PARTSK) : (st ? WS_PARTV : WS_PARTK))) + (size_t)(row0 + r16) * 256;
    const float* pet = (const float*)(ws + WS_PET) + st * 128;
    const bf16* W2T = (const bf16*)(ws + WS_W2T) + st * 8192;
    f32x4 acc[4];
#pragma unroll
    for (int dt = 0; dt < 4; ++dt) acc[dt] = (f32x4){0.f, 0.f, 0.f, 0.f};
#pragma unroll
    for (int ks = 0; ks < 4; ++ks) {
        const int e0 = 32 * ks + 8 * q;
        const f32x4 a0 = *(const f32x4*)(P + e0), a1 = *(const f32x4*)(P + e0 + 4), b0 = *(const f32x4*)(P + 256 + 128 + e0), b1 = *(const f32x4*)(P + 256 + 128 + e0 + 4);
        const f32x4 p0 = *(const f32x4*)(pet + e0), p1 = *(const f32x4*)(pet + e0 + 4);
        const f32x4 h0 = a0 + b0 + p0, h1 = a1 + b1 + p1;
        u32x4 o; o.x = pk2(siluf(h0.x), siluf(h0.y)); o.y = pk2(siluf(h0.z), siluf(h0.w)); o.z = pk2(siluf(h1.x), siluf(h1.y)); o.w = pk2(siluf(h1.z), siluf(h1.w));
        const bf16x8 af = __builtin_bit_cast(bf16x8, o);
#pragma unroll
        for (int dt = 0; dt < 4; ++dt) { const bf16x8 bf = *(const bf16x8*)(W2T + (size_t)(16 * dt + r16) * 128 + e0); acc[dt] = MFMA16(af, bf, acc[dt]); }
    }
    const int bh = row0 / NPB, n0 = row0 % NPB + 4 * q;
#pragma unroll
    for (int dt = 0; dt < 4; ++dt) {
        const int d = 16 * dt + r16;
        float v[4];
#pragma unroll
        for (int r = 0; r < 4; ++r) v[r] = (n0 + r < NPB - 1) ? acc[dt][r] : 0.f;
        if (SAMPLE) {
            float* o = (float*)(ws + (st ? WS_VCS : WS_KCS)) + ((size_t)bh * 128 + n0) * 64 + d;
#pragma unroll
            for (int r = 0; r < 4; ++r) o[r * 64] = v[r];
        } else if (st == 0) {
            bf16* o = (bf16*)(ws + WS_KC) + ((size_t)bh * 256 + n0) * 64 + d;
#pragma unroll
            for (int r = 0; r < 4; ++r) o[r * 64] = (bf16)f2bf(v[r]);
        } else {
            u32x2 w; w.x = pk2(v[0], v[1]); w.y = pk2(v[2], v[3]);
            *(u32x2*)((bf16*)(ws + WS_VCT) + ((size_t)bh * 8 + (n0 >> 5)) * 2048 + d * 32 + 8 * ((n0 & 15) >> 2) + 4 * ((n0 & 31) >> 4)) = w;
        }
    }
}

__device__ __forceinline__ void sample_ssm_item(const Args& args, LAS unsigned char* lds, int item, int wave, int lane) {
    unsigned char* ws = args.ws; float* out = args.out;
    const int h = item & 31, bs = item >> 5, g = h >> 3;
    const float* XC = (const float*)(ws + WS_XCS) + (size_t)bs * CONVD;
    const float dt = ((const float*)(ws + WS_DTS))[bs * 32 + h], a = -__expf(INF(19)[h]), dec = __expf(dt * a), Dh = INF(20)[h];
    const f32x2 Bv = *(const f32x2*)(XC + 2048 + g * 128 + 2 * lane), Cv = *(const f32x2*)(XC + 2560 + g * 128 + 2 * lane);
    const float xl = XC[h * 64 + lane];
    const float* H0 = INF(7) + ((size_t)(bs * 32 + h) * 64) * 128; float* HN = out + O_SSMS + ((size_t)(bs * 32 + h) * 64) * 128;
    float ymine = 0.f;
#pragma unroll 8
    for (int p = 0; p < 64; ++p) {
        const float xp = __shfl(xl, p);
        const f32x2 h0 = *(const f32x2*)(H0 + p * 128 + 2 * lane);
        f32x2 hn; hn.x = h0.x * dec + dt * xp * Bv.x; hn.y = h0.y * dec + dt * xp * Bv.y;
        *(f32x2*)(HN + p * 128 + 2 * lane) = hn;
        const float yp = wave_sum(hn.x * Cv.x + hn.y * Cv.y);
        ymine = (lane == p) ? yp : ymine;
    }
    const float y = ymine + Dh * xl;
    const size_t m = MP + bs;
    const float z = bf2f(((const bf16*)(ws + WS_Z))[m * 2048 + h * 64 + lane]);
    const float v = y * siluf(z);
    ((bf16*)(ws + WS_YSSM))[m * 2048 + h * 64 + lane] = (bf16)f2bf(v * INF(21)[h * 64 + lane]);
    const float ss = wave_sum(v * v);
    if (lane == 0) ((float*)(ws + WS_MISC))[m * 128 + 80 + h] = ss;
}
__device__ __forceinline__ void scan_phase(const Args& args, int gt, int NGT) {
    unsigned char* ws = args.ws; float* out = args.out;
    for (int i = gt; i < 4 * 32 * 64 * 32; i += NGT) {
        const int n4 = i & 31, p = (i >> 5) & 63, h = (i >> 11) & 31, b = i >> 16;
        const float* CS = (const float*)(ws + WS_CS) + (size_t)(b * 32 + h) * 4096;
        f32x4 run = (f32x4){0.f, 0.f, 0.f, 0.f};
#pragma unroll 4
        for (int c = 0; c < 32; ++c) {
            const size_t off = ((((size_t)(b * 32 + c) * 32 + h) * 64 + p) * 128) + 4 * n4;
            const f32x4 st = *(const f32x4*)((const float*)(ws + WS_STATES) + off);
            u32x2 o; o.x = pk2(run.x, run.y); o.y = pk2(run.z, run.w);
            *(u32x2*)((bf16*)(ws + WS_HPREV) + off) = o;
            const float dec = __expf(CS[c * 128 + 127]);
            run = run * dec + st;
        }
        *(f32x4*)(out + O_SSMP + (((size_t)(b * 32 + h) * 64 + p) * 128) + 4 * n4) = run;
    }
    for (int i = gt; i < MS * 4; i += NGT) { const int bs = i >> 2, g = i & 3; const float* p = (const float*)(ws + WS_MISC) + (size_t)(MP + bs) * 128 + 80 + g * 8;
        ((float*)(ws + WS_SSQ))[(size_t)(MP + bs) * 4 + g] = ((p[0] + p[1]) + (p[2] + p[3])) + ((p[4] + p[5]) + (p[6] + p[7])); }
}

__device__ __forceinline__ void ssd_out_unit(const Args& args, LAS unsigned char* lds, int unit, int wave, int lane, int tid) {
    unsigned char* ws = args.ws;
    const int g = unit & 3, c = (unit >> 2) & 31, b = unit >> 7, h = g * 8 + wave, q = lane >> 4, r16 = lane & 15;
    LAS float* CBT = (LAS float*)lds; LAS float* SQ = (LAS float*)(lds + 65536);
    const bf16* Bn = (const bf16*)(ws + WS_BN) + ((size_t)(b * 4 + g) * 4096 + c * 128) * 128;
    const bf16* Cn = (const bf16*)(ws + WS_CN) + ((size_t)(b * 4 + g) * 4096 + c * 128) * 128;
    {
        bf16x8 af[4];
#pragma unroll
        for (int ks = 0; ks < 4; ++ks) af[ks] = *(const bf16x8*)(Bn + (size_t)(16 * wave + r16) * 128 + 32 * ks + 8 * q);
        for (int lt = wave; lt < 8; ++lt) {
            f32x4 d = (f32x4){0.f, 0.f, 0.f, 0.f};
#pragma unroll
            for (int ks = 0; ks < 4; ++ks) { const bf16x8 bf = *(const bf16x8*)(Cn + (size_t)(16 * lt + r16) * 128 + 32 * ks + 8 * q); d = MFMA16(af[ks], bf, d); }
#pragma unroll
            for (int r = 0; r < 4; ++r) CBT[((wave * 8 + lt) * 4 + r) * 64 + lane] = d[r];
        }
    }
    __syncthreads();
    const float* DT = (const float*)(ws + WS_DT) + (size_t)(b * 32 + h) * 4096 + c * 128; const float* CS = (const float*)(ws + WS_CS) + (size_t)(b * 32 + h) * 4096 + c * 128;
    const float Dh = INF(20)[h];
    const bf16* HP = (const bf16*)(ws + WS_HPREV) + (((size_t)(b * 32 + c) * 32 + h) * 64) * 128;
    const bf16* XT = (const bf16*)(ws + WS_XT) + ((size_t)(b * 32 + h) * 128 + c * 4) * 2048;
    const bf16* Z = (const bf16*)(ws + WS_Z); bf16* Y = (bf16*)(ws + WS_YSSM); const float* nw = INF(21) + h * 64;
#pragma unroll
    for (int hl = 0; hl < 2; ++hl) {
        float csl[4];
#pragma unroll
        for (int lt = 0; lt < 4; ++lt) csl[lt] = CS[64 * hl + 16 * lt + r16];
        f32x4 acc[4][4];
#pragma unroll
        for (int i = 0; i < 4; ++i)
#pragma unroll
            for (int j = 0; j < 4; ++j) acc[i][j] = (f32x4){0.f, 0.f, 0.f, 0.f};
#pragma unroll 1
        for (int ks = 0; ks < 4; ++ks) {
            bf16x8 af[4];
#pragma unroll
            for (int pt = 0; pt < 4; ++pt) af[pt] = *(const bf16x8*)(HP + (size_t)(16 * pt + r16) * 128 + 32 * ks + 8 * q);
#pragma unroll
            for (int lt = 0; lt < 4; ++lt) { const bf16x8 bf = *(const bf16x8*)(Cn + (size_t)(64 * hl + 16 * lt + r16) * 128 + 32 * ks + 8 * q);
#pragma unroll
                for (int pt = 0; pt < 4; ++pt) acc[pt][lt] = MFMA16(af[pt], bf, acc[pt][lt]); }
        }
#pragma unroll
        for (int lt = 0; lt < 4; ++lt) { const float e = __expf(csl[lt]);
#pragma unroll
            for (int pt = 0; pt < 4; ++pt) acc[pt][lt] = acc[pt][lt] * e; }
#pragma unroll
        for (int i = 0; i < 2 * hl + 2; ++i) {
            const int sa = 32 * i + 4 * q, sb = sa + 16;
            const f32x4 csa = *(const f32x4*)(CS + sa), csb = *(const f32x4*)(CS + sb), dta = *(const f32x4*)(DT + sa), dtb = *(const f32x4*)(DT + sb);
            bf16x8 af[4];
#pragma unroll
            for (int pt = 0; pt < 4; ++pt) { const bf16* xr = XT + (size_t)i * 2048 + (16 * pt + r16) * 32 + 4 * q; const u32x2 lo = *(const u32x2*)xr, hi = *(const u32x2*)(xr + 16);
                af[pt] = __builtin_bit_cast(bf16x8, (u32x4){lo.x, lo.y, hi.x, hi.y}); }
#pragma unroll
            for (int lt = 0; lt < 4; ++lt) {
                const int LT = 4 * hl + lt;
                if (LT < 2 * i) continue;
                const int l = 16 * LT + r16;
                float ga[4], gb[4];
#pragma unroll
                for (int r = 0; r < 4; ++r) {
                    const float va = CBT[(((2 * i) * 8 + LT) * 4 + r) * 64 + lane];
                    const float vb = (LT >= 2 * i + 1) ? CBT[(((2 * i + 1) * 8 + LT) * 4 + r) * 64 + lane] : 0.f;
                    const int s1 = sa + r, s2 = sb + r;
                    float x1 = (l >= s1) ? va * __expf(csl[lt] - csa[r]) * dta[r] : 0.f;
                    float x2 = (l >= s2) ? vb * __expf(csl[lt] - csb[r]) * dtb[r] : 0.f;
                    if (l == s1) x1 += Dh;
                    if (l == s2) x2 += Dh;
                    ga[r] = x1; gb[r] = x2;
                }
                u32x4 o; o.x = pk2(ga[0], ga[1]); o.y = pk2(ga[2], ga[3]); o.z = pk2(gb[0], gb[1]); o.w = pk2(gb[2], gb[3]);
                const bf16x8 bf = __builtin_bit_cast(bf16x8, o);
#pragma unroll
                for (int pt = 0; pt < 4; ++pt) acc[pt][lt] = MFMA16(af[pt], bf, acc[pt][lt]);
            }
        }
#pragma unroll
        for (int lt = 0; lt < 4; ++lt) {
            const size_t m = (size_t)b * 4096 + c * 128 + 64 * hl + 16 * lt + r16;
            float ss = 0.f;
#pragma unroll
            for (int pt = 0; pt < 4; ++pt) {
                const int ch = 16 * pt + 4 * q;
                const u32x2 zz = *(const u32x2*)(Z + m * 2048 + h * 64 + ch); const f32x4 w = *(const f32x4*)(nw + ch);
                const float v0 = acc[pt][lt][0] * siluf(bflo(zz.x)), v1 = acc[pt][lt][1] * siluf(bfhi(zz.x)), v2 = acc[pt][lt][2] * siluf(bflo(zz.y)), v3 = acc[pt][lt][3] * siluf(bfhi(zz.y));
                ss += (v0 * v0 + v1 * v1) + (v2 * v2 + v3 * v3);
                u32x2 o; o.x = pk2(v0 * w.x, v1 * w.y); o.y = pk2(v2 * w.z, v3 * w.w);
                *(u32x2*)(Y + m * 2048 + h * 64 + ch) = o;
            }
            ss += __shfl_xor(ss, 16); ss += __shfl_xor(ss, 32);
            if (q == 0) SQ[wave * 128 + 64 * hl + 16 * lt + r16] = ss;
        }
    }
    __syncthreads();
    if (tid < 128) { float s = 0.f;
#pragma unroll
        for (int w = 0; w < 8; ++w) s += SQ[w * 128 + tid];
        ((float*)(ws + WS_SSQ))[((size_t)b * 4096 + c * 128 + tid) * 4 + g] = s; }
    __syncthreads();
}
constexpr float SC2 = 0.125f * 1.4426950408889634f;
__device__ __forceinline__ float max3f(float a, float b, float c) { float r; asm("v_max3_f32 %0, %1, %2, %3" : "=v"(r) : "v"(a), "v"(b), "v"(c)); return r; }
template <class T> __device__ __forceinline__ T ldu(const void* ubase, unsigned lane_off) { return *(const T*)((const char*)ubase + lane_off); }
struct KFrag { bf16x8 kf[2][2]; };
__device__ __forceinline__ void flash_load(const bf16* Kp, int kb, unsigned koff, KFrag& F) {
#pragma unroll
    for (int kt = 0; kt < 2; ++kt) { const bf16* kr = Kp + (size_t)(kb + 16 * kt) * 64; F.kf[kt][0] = ldu<bf16x8>(kr, koff); F.kf[kt][1] = ldu<bf16x8>(kr + 32, koff); }
}
template <int MODE>
__device__ __forceinline__ void flash_step(const KFrag& F, const bf16* VTp, unsigned voff, int kb, int t0, int t, bool selbit, const LAS bf16x8* Qs,
                                           f32x4 (&O)[4][4], float (&mx)[4], f32x4 (&L)[4], int q) {
    const bf16x8 ones = __builtin_bit_cast(bf16x8, (u32x4){0x3f803f80u, 0x3f803f80u, 0x3f803f80u, 0x3f803f80u});
    const bool edge = (kb + 31 > t0) || (MODE == 1 && kb + 512 <= t0 + 15);
    bf16x8 vf[4];
#pragma unroll
    for (int dt = 0; dt < 4; ++dt) vf[dt] = ldu<bf16x8>(VTp + (size_t)(kb >> 5) * 2048 + (16 * dt) * 32, voff);
#pragma unroll
    for (int g = 0; g < 4; ++g) {
        asm volatile("" ::: "memory");
        __builtin_amdgcn_sched_barrier(0);
        const bf16x8 q0 = Qs[(g * 2 + 0) * 64], q1 = Qs[(g * 2 + 1) * 64];
        f32x4 S0 = MFMA16(F.kf[0][0], q0, ((f32x4){0.f, 0.f, 0.f, 0.f})), S1 = MFMA16(F.kf[1][0], q0, ((f32x4){0.f, 0.f, 0.f, 0.f}));
        S0 = MFMA16(F.kf[0][1], q1, S0); S1 = MFMA16(F.kf[1][1], q1, S1);
        float s[8];
#pragma unroll
        for (int r = 0; r < 4; ++r) { s[r] = S0[r]; s[4 + r] = S1[r]; }
        if (edge) {
#pragma unroll
            for (int i = 0; i < 8; ++i) { const int key = kb + 16 * (i >> 2) + 4 * q + (i & 3);
                const bool ok = (MODE == 0) ? (key <= t) : (key <= t && key + 512 > t); s[i] = ok ? s[i] : NEGF; }
        }
        float lm = max3f(max3f(s[0], s[1], s[2]), max3f(s[3], s[4], s[5]), fmaxf(s[6], s[7])) * SC2;
        if (MODE == 0) lm = selbit ? lm : NEGF;
        if (__builtin_amdgcn_ballot_w64(lm > mx[g] + 8.f) != 0ull) {
            float tmax = fmaxf(lm, __shfl_xor(lm, 16)); tmax = fmaxf(tmax, __shfl_xor(tmax, 32));
            const float mnew = fmaxf(mx[g], tmax), alpha = __builtin_amdgcn_exp2f(mx[g] - mnew); mx[g] = mnew; L[g] = L[g] * alpha;
#pragma unroll
            for (int dt = 0; dt < 4; ++dt) O[dt][g] = O[dt][g] * alpha;
        }
        float nmuse = -fmaxf(mx[g], -1e20f);
        if (MODE == 0) nmuse = selbit ? nmuse : NEGF;
#pragma unroll
        for (int i = 0; i < 8; ++i) s[i] = __builtin_amdgcn_exp2f(__builtin_fmaf(s[i], SC2, nmuse));
        u32x4 pw; pw.x = pk2(s[0], s[1]); pw.y = pk2(s[2], s[3]); pw.z = pk2(s[4], s[5]); pw.w = pk2(s[6], s[7]);
        const bf16x8 pf = __builtin_bit_cast(bf16x8, pw);
        L[g] = MFMA16(ones, pf, L[g]);
#pragma unroll
        for (int dt = 0; dt < 4; ++dt) O[dt][g] = MFMA16(vf[dt], pf, O[dt][g]);
    }
}
template <int MODE>
__device__ __forceinline__ void flash_branch(const bf16* Kp, const bf16* VTp, int jfirst, int jlast, unsigned ulo, unsigned uhi, unsigned mlo, unsigned mhi,
                                             int t0, int t, const LAS bf16x8* Qs, f32x4 (&O)[4][4], float (&mx)[4], f32x4 (&L)[4], int q, int r16) {
    const unsigned koff = (unsigned)(r16 * 64 + 8 * q) * 2u, voff = (unsigned)(r16 * 32 + 8 * q) * 2u;
    int jb = jfirst;
    while (jb <= jlast && !((jb < 32 ? (ulo >> jb) : (uhi >> (jb - 32))) & 1u)) ++jb;
    if (jb > jlast) return;
    KFrag A, B;
    flash_load(Kp, 64 * jb, koff, A);
    for (;;) {
        flash_load(Kp, 64 * jb + 32, koff, B);
        const bool selbit = ((jb < 32 ? (mlo >> jb) : (mhi >> (jb - 32))) & 1u) != 0u;
        flash_step<MODE>(A, VTp, voff, 64 * jb, t0, t, selbit, Qs, O, mx, L, q);
        int jn = jb + 1;
        while (jn <= jlast && !((jn < 32 ? (ulo >> jn) : (uhi >> (jn - 32))) & 1u)) ++jn;
        if (jn <= jlast) flash_load(Kp, 64 * jn, koff, A);
        flash_step<MODE>(B, VTp, voff, 64 * jb + 32, t0, t, selbit, Qs, O, mx, L, q);
        if (jn > jlast) break;
        jb = jn;
    }
}

template <int BR>
__device__ __forceinline__ void attn_finish(const Args& args, f32x4 (&O)[4][4], const f32x4 (&L)[4], bool normalise, size_t m, int hkv, int q) {
    unsigned char* ws = args.ws;
    const float* gates = (const float*)(ws + WS_MISC) + m * 128 + 32;
    const unsigned yoff = (unsigned)((m & 15) * 1024 + 4 * q) * 4u, yboff = yoff >> 1;
#pragma unroll
    for (int g = 0; g < 4; ++g) {
        float sc = sigmf(gates[(hkv * 4 + g) * 3 + BR]);
        if (normalise) sc *= 1.f / fmaxf(L[g][0], TINYF);
#pragma unroll
        for (int dt = 0; dt < 4; ++dt) {
            char* yfu = (char*)((float*)(ws + WS_YATTF) + (m & ~(size_t)15) * 1024 + (hkv * 4 + g) * 64 + 16 * dt);
            f32x4 v = O[dt][g] * sc;
            if (BR > 0) v = v + *(const f32x4*)(yfu + yoff);
            if (BR < 2) *(f32x4*)(yfu + yoff) = v;
            else { u32x2 o; o.x = pk2(v.x, v.y); o.y = pk2(v.z, v.w); *(u32x2*)((char*)((bf16*)(ws + WS_YATT) + (m & ~(size_t)15) * 1024 + (hkv * 4 + g) * 64 + 16 * dt) + yboff) = o; }
        }
    }
}

__device__ __forceinline__ void attn_prompt_unit(const Args& args, LAS float* impL, int unit, bool xcdmap, int lane_in) {
    int lane = lane_in; asm volatile("" : "+v"(lane));
    unsigned char* ws = args.ws;
    const int q = lane >> 4, r16 = lane & 15;
    const int pass = unit >> 11, gwv = unit & 2047, xcd = (gwv >> 3) & 7, wx = (gwv >> 6) * 8 + (gwv & 7);
    const int bh = xcdmap ? 2 * xcd + pass : (unit & 15), b = bh >> 2, hkv = bh & 3;
    const int tile = xcdmap ? (pass == 0 ? 255 - wx : wx) : (unit < 2048 ? 255 - (unit >> 4) : (unit - 2048) >> 4);
    const int t0 = tile * 16, t = t0 + r16; const size_t m = (size_t)b * 4096 + t;
    LAS bf16x8* Qs = (LAS bf16x8*)(impL + 1024) + lane;
#pragma unroll
    for (int g = 0; g < 4; ++g)
#pragma unroll
        for (int ks = 0; ks < 2; ++ks) Qs[(g * 2 + ks) * 64] = ldu<bf16x8>((const bf16*)(ws + WS_Q) + ((size_t)b * 4096 + t0) * 1024 + (hkv * 4 + g) * 64 + 32 * ks, (unsigned)(r16 * 1024 + 8 * q) * 2u);
    LDS_WAIT(); asm volatile("" ::: "memory");
    f32x4 O[4][4]; float mx[4], ls[4];
    const bf16* KCp = (const bf16*)(ws + WS_KC) + (size_t)bh * 256 * 64; const bf16* VCTp = (const bf16*)(ws + WS_VCT) + (size_t)bh * 64 * 256;
    const unsigned kcoff = (unsigned)(r16 * 64 + 8 * q) * 2u, vcoff = (unsigned)(r16 * 32 + 8 * q) * 2u;
    const int nmax = (t0 + 15 >= 31) ? ((t0 + 15 - 31) >> 4) : -1;
    const int NP = nmax < 0 ? 0 : (nmax / 32 + 2 < 8 ? nmax / 32 + 2 : 8);
#pragma unroll
    for (int g = 0; g < 4; ++g) { mx[g] = NEGF; ls[g] = 0.f; }
    for (int kt = 0; kt < 2 * NP; ++kt) {
        const bf16* kr = KCp + (size_t)(16 * kt) * 64;
        const bf16x8 k0 = ldu<bf16x8>(kr, kcoff), k1 = ldu<bf16x8>(kr + 32, kcoff);
#pragma unroll
        for (int g = 0; g < 4; ++g) {
            f32x4 s = MFMA16(k0, Qs[(g * 2 + 0) * 64], ((f32x4){0.f, 0.f, 0.f, 0.f})); s = MFMA16(k1, Qs[(g * 2 + 1) * 64], s);
            float tmax = NEGF;
#pragma unroll
            for (int r = 0; r < 4; ++r) { const int n = 16 * kt + 4 * q + r; const bool ok = (16 * n + 31 <= t); s[r] = ok ? s[r] * 0.125f : NEGF; tmax = fmaxf(tmax, s[r]); }
            const float mnew = fmaxf(mx[g], tmax); float ps = 0.f;
#pragma unroll
            for (int r = 0; r < 4; ++r) ps += (s[r] > 0.5f * NEGF) ? __expf(s[r] - mnew) : 0.f;
            ls[g] = ls[g] * __expf(mx[g] - mnew) + ps; mx[g] = mnew;
        }
    }
    float invL[4];
#pragma unroll
    for (int g = 0; g < 4; ++g) {
        float M = fmaxf(mx[g], __shfl_xor(mx[g], 16)); M = fmaxf(M, __shfl_xor(M, 32));
        float l = ls[g] * __expf(mx[g] - M); l += __shfl_xor(l, 16); l += __shfl_xor(l, 32);
        mx[g] = M; invL[g] = 1.f / fmaxf(l, TINYF);
    }
#pragma unroll
    for (int dt = 0; dt < 4; ++dt)
#pragma unroll
        for (int g = 0; g < 4; ++g) O[dt][g] = (f32x4){0.f, 0.f, 0.f, 0.f};
    float prev3 = 0.f;
#pragma unroll
    for (int kt = 0; kt < 16; ++kt) impL[kt * 64 + lane] = 0.f;
#pragma unroll 1
    for (int i = 0; i < NP; ++i) {
        f32x4 P[2][4];
#pragma unroll
        for (int kk = 0; kk < 2; ++kk) {
            const int kt = 2 * i + kk;
            const bf16* kr = KCp + (size_t)(16 * kt) * 64;
            const bf16x8 k0 = ldu<bf16x8>(kr, kcoff), k1 = ldu<bf16x8>(kr + 32, kcoff);
            f32x4 psum = (f32x4){0.f, 0.f, 0.f, 0.f};
#pragma unroll
            for (int g = 0; g < 4; ++g) {
                f32x4 s = MFMA16(k0, Qs[(g * 2 + 0) * 64], ((f32x4){0.f, 0.f, 0.f, 0.f})); s = MFMA16(k1, Qs[(g * 2 + 1) * 64], s);
#pragma unroll
                for (int r = 0; r < 4; ++r) { const int n = 16 * kt + 4 * q + r; const bool ok = (16 * n + 31 <= t); s[r] = ok ? __expf(s[r] * 0.125f - mx[g]) * invL[g] : 0.f; }
                P[kk][g] = s; psum = psum + s;
            }
            const float a = __shfl(psum[3], (lane + 48) & 63), bb = __shfl(prev3, (lane + 48) & 63);
            impL[kt * 64 + lane] = 2.f * (psum[0] + psum[1] + psum[2]) + psum[3] + (q > 0 ? a : bb);
            prev3 = psum[3];
        }
        bf16x8 vf[4];
#pragma unroll
        for (int dt = 0; dt < 4; ++dt) vf[dt] = ldu<bf16x8>(VCTp + (size_t)i * 2048 + (16 * dt) * 32, vcoff);
#pragma unroll
        for (int g = 0; g < 4; ++g) {
            u32x4 pw; pw.x = pk2(P[0][g][0], P[0][g][1]); pw.y = pk2(P[0][g][2], P[0][g][3]); pw.z = pk2(P[1][g][0], P[1][g][1]); pw.w = pk2(P[1][g][2], P[1][g][3]);
            const bf16x8 pf = __builtin_bit_cast(bf16x8, pw);
#pragma unroll
            for (int dt = 0; dt < 4; ++dt) O[dt][g] = MFMA16(vf[dt], pf, O[dt][g]);
        }
    }
    f32x4 L[4];
#pragma unroll
    for (int g = 0; g < 4; ++g) L[g] = (f32x4){1.f, 1.f, 1.f, 1.f};
    attn_finish<0>(args, O, L, false, m, hkv, q);
    unsigned mlo = 0u, mhi = 0u;
    {
        const int cur = t >> 6;
        LDS_WAIT(); asm volatile("" ::: "memory");
        float v[16];
#pragma unroll
        for (int kt = 0; kt < 16; ++kt) { const int j = 4 * kt + q; const bool valid = (64 * j <= t), forced = (j == 0) || (j == cur) || (j == cur - 1);
            v[kt] = valid ? (forced ? BIGF : impL[kt * 64 + lane]) : -BIGF; }
#pragma unroll
        for (int kt = 0; kt < 16; ++kt) impL[kt * 64 + lane] = v[kt];
        LDS_WAIT(); asm volatile("" ::: "memory");
        int rank[16];
#pragma unroll
        for (int kt = 0; kt < 16; ++kt) rank[kt] = 0;
#pragma unroll 1
        for (int rot = 0; rot < 4; ++rot) {
#pragma unroll 2
            for (int kk = 0; kk < 16; ++kk) {
                const float o = impL[kk * 64 + (lane ^ (16 * rot))];
                const int oj = 4 * kk + (q ^ rot);
#pragma unroll
                for (int kt = 0; kt < 16; ++kt) { const int myj = 4 * kt + q; rank[kt] += ((o > v[kt]) || (o == v[kt] && oj < myj)) ? 1 : 0; }
            }
        }
#pragma unroll
        for (int kt = 0; kt < 16; ++kt) { const int j = 4 * kt + q; const unsigned bit = rank[kt] < 16 ? 1u : 0u; if (kt < 8) mlo |= bit << j; else mhi |= bit << (j - 32); }
        mlo |= __shfl_xor(mlo, 16); mlo |= __shfl_xor(mlo, 32); mhi |= __shfl_xor(mhi, 16); mhi |= __shfl_xor(mhi, 32);
    }
    unsigned ulo = mlo, uhi = mhi;
#pragma unroll
    for (int o = 1; o < 16; o <<= 1) { ulo |= __shfl_xor(ulo, o); uhi |= __shfl_xor(uhi, o); }
    ulo = __builtin_amdgcn_readfirstlane(ulo); uhi = __builtin_amdgcn_readfirstlane(uhi);
    {
#pragma unroll
        for (int g = 0; g < 4; ++g) { mx[g] = NEGF; L[g] = (f32x4){0.f, 0.f, 0.f, 0.f}; }
#pragma unroll
        for (int dt = 0; dt < 4; ++dt)
#pragma unroll
            for (int g = 0; g < 4; ++g) O[dt][g] = (f32x4){0.f, 0.f, 0.f, 0.f};
        const bf16* Kp = (const bf16*)(ws + WS_KVH) + ((size_t)(2 * 4 + b) * 4 + hkv) * 4096 * 64;
        const bf16* VTp = (const bf16*)(ws + WS_VT) + ((size_t)(0 * 4 + b) * 4 + hkv) * 64 * 4096;
        flash_branch<0>(Kp, VTp, 0, (t0 + 15) >> 6, ulo, uhi, mlo, mhi, t0, t, Qs, O, mx, L, q, r16);
        attn_finish<1>(args, O, L, true, m, hkv, q);
    }
    {
#pragma unroll
        for (int g = 0; g < 4; ++g) { mx[g] = NEGF; L[g] = (f32x4){0.f, 0.f, 0.f, 0.f}; }
#pragma unroll
        for (int dt = 0; dt < 4; ++dt)
#pragma unroll
            for (int g = 0; g < 4; ++g) O[dt][g] = (f32x4){0.f, 0.f, 0.f, 0.f};
        const bf16* Kp = (const bf16*)(ws + WS_KVH) + ((size_t)(4 * 4 + b) * 4 + hkv) * 4096 * 64;
        const bf16* VTp = (const bf16*)(ws + WS_VT) + ((size_t)(1 * 4 + b) * 4 + hkv) * 64 * 4096;
        const int jbeg = t0 >= 511 ? (t0 - 511) >> 6 : 0, jend = (t0 + 15) >> 6;
        flash_branch<1>(Kp, VTp, jbeg, jend, 0xffffffffu, 0xffffffffu, 0xffffffffu, 0xffffffffu, t0, t, Qs, O, mx, L, q, r16);
        attn_finish<2>(args, O, L, true, m, hkv, q);
    }
}
__device__ __forceinline__ void dot4_reduce(const float (&qv)[4], float kx, int lane, float (&sg)[4]) {
    const float v0 = qv[0] * kx, v1 = qv[1] * kx, v2 = qv[2] * kx, v3 = qv[3] * kx;
    const bool up = (lane & 32) != 0, up2 = (lane & 16) != 0;
    const float r0 = (up ? v2 : v0) + __shfl_xor(up ? v0 : v2, 32), r1 = (up ? v3 : v1) + __shfl_xor(up ? v1 : v3, 32);
    float x = (up2 ? r1 : r0) + __shfl_xor(up2 ? r0 : r1, 16);
    x += __shfl_xor(x, 8); x += __shfl_xor(x, 4); x += __shfl_xor(x, 2); x += __shfl_xor(x, 1);
    const int xi = __builtin_bit_cast(int, x);
    sg[0] = __builtin_bit_cast(float, __builtin_amdgcn_readlane(xi, 0)); sg[1] = __builtin_bit_cast(float, __builtin_amdgcn_readlane(xi, 16));
    sg[2] = __builtin_bit_cast(float, __builtin_amdgcn_readlane(xi, 32)); sg[3] = __builtin_bit_cast(float, __builtin_amdgcn_readlane(xi, 48));
}
struct SampleRows { const float* cache; const float* cwin; float* out; const LAS int* selblk; const LAS int* selpage; int bs, hkv, rs, dc; };
template <int BR> __device__ __forceinline__ void srow_load(const SampleRows& R, int row, int nrows, f32x4& kx, f32x4& vx) {
    kx = (f32x4){0.f, 0.f, 0.f, 0.f}; vx = kx;
    if (row < nrows) {
        if (BR == 0) { const int k = row >> 6; const unsigned off = (((unsigned)R.selpage[k] * 128u + (unsigned)((R.selblk[k] & 1) * 64 + (row & 63))) * 4u + 2u) * 256u + (unsigned)(R.hkv * 64 + 4 * R.dc);
            kx = *(const f32x4*)(R.cache + off); vx = *(const f32x4*)(R.cache + off + 256u); }
        else { const unsigned off = (((unsigned)R.bs * 512u + (unsigned)(row + 1)) * 2u) * 256u + (unsigned)(R.hkv * 64 + 4 * R.dc);
            kx = *(const f32x4*)(R.cwin + off); vx = *(const f32x4*)(R.cwin + off + 256u); }
    }
}
__device__ __forceinline__ void srow_update(const f32x4 (&qv)[4], const f32x4& kx, const f32x4& vx, bool valid, float (&mx)[4], float (&ls)[4], f32x4 (&o)[4]) {
    float s[4];
#pragma unroll
    for (int g = 0; g < 4; ++g) s[g] = (qv[g].x * kx.x + qv[g].y * kx.y) + (qv[g].z * kx.z + qv[g].w * kx.w);
#pragma unroll
    for (int st = 8; st >= 1; st >>= 1)
#pragma unroll
        for (int g = 0; g < 4; ++g) s[g] += __shfl_xor(s[g], st);
#pragma unroll
    for (int g = 0; g < 4; ++g) {
        const float mnew = valid ? fmaxf(mx[g], s[g]) : mx[g], alpha = __expf(mx[g] - mnew), p = valid ? __expf(s[g] - mnew) : 0.f;
        ls[g] = ls[g] * alpha + p; o[g] = o[g] * alpha + vx * p; mx[g] = mnew;
    }
}
template <int BR>
__device__ __forceinline__ void sample_rows_branch(const SampleRows& R, int wave, const f32x4 (&qv)[4], LAS float* pm, LAS float* pl, LAS float* po) {
    float mx[4], ls[4]; f32x4 o[4];
#pragma unroll
    for (int g = 0; g < 4; ++g) { mx[g] = NEGF; ls[g] = 0.f; o[g] = (f32x4){0.f, 0.f, 0.f, 0.f}; }
    constexpr int nrows = BR == 0 ? 15 * 64 : 511;
    constexpr int ngroups = (nrows + 3) / 4;
#pragma unroll 1
    for (int g0 = wave; g0 < ngroups; g0 += 64) {
        f32x4 kx[8], vx[8];
#pragma unroll
        for (int k = 0; k < 8; ++k) srow_load<BR>(R, 4 * (g0 + 8 * k) + R.rs, (g0 + 8 * k) < ngroups ? nrows : 0, kx[k], vx[k]);
#pragma unroll
        for (int k = 0; k < 8; ++k) {
            const int grp = g0 + 8 * k, row = 4 * grp + R.rs;
            if (grp < ngroups) {
                const bool valid = row < nrows;
                if (BR == 1 && valid) { const unsigned off = (((unsigned)R.bs * 512u + (unsigned)row) * 2u) * 256u + (unsigned)(R.hkv * 64 + 4 * R.dc);
                    *(f32x4*)(R.out + O_WINS + off) = kx[k]; *(f32x4*)(R.out + O_WINS + off + 256u) = vx[k]; }
                srow_update(qv, kx[k], vx[k], valid, mx, ls, o);
            }
        }
    }
    if (wave == 0) {
        const float* src = BR == 0 ? R.out + O_KVS + ((size_t)R.bs * 4 + 2) * 256 + R.hkv * 64 + 4 * R.dc : R.out + O_WINS + (((size_t)R.bs * 512 + 511) * 2) * 256 + R.hkv * 64 + 4 * R.dc;
        const f32x4 kx = *(const f32x4*)src, vx = *(const f32x4*)(src + 256);
        srow_update(qv, kx, vx, R.rs == 0, mx, ls, o);
    }
    const int slot = (BR * 32 + wave * 4 + R.rs) * 4;
#pragma unroll
    for (int g = 0; g < 4; ++g) { if (R.dc == 0) { pm[slot + g] = mx[g]; pl[slot + g] = ls[g]; } *(LAS f32x4*)(po + (size_t)(slot + g) * 64 + 4 * R.dc) = o[g]; }
}

__device__ __forceinline__ void attn_sample_unit(const Args& args, LAS unsigned char* lds, int unit, int tid, int wave, int lane) {
    unsigned char* ws = args.ws; float* out = args.out;
    const int hkv = unit & 3, bs = unit >> 2; const size_t m = MP + bs;
    LAS float* sc = (LAS float*)lds; LAS float* impv = sc + 512; LAS int* selblk = (LAS int*)(impv + 64); LAS int* selpage = selblk + 16; LAS int* pg = selpage + 16;
    LAS float* pm = (LAS float*)(pg + 16); LAS float* pl = pm + 256; LAS float* po = pl + 256;
    LAS float* poc = po + 2 * 32 * 4 * 64;
    const bf16* Qr = (const bf16*)(ws + WS_Q) + m * 1024 + hkv * 256;
    const float* KCS = (const float*)(ws + WS_KCS) + (size_t)(bs * 4 + hkv) * 128 * 64; const float* VCS = (const float*)(ws + WS_VCS) + (size_t)(bs * 4 + hkv) * 128 * 64;
    float qv[4];
#pragma unroll
    for (int g = 0; g < 4; ++g) qv[g] = bf2f(Qr[g * 64 + lane]) * 0.125f;
    if (tid < 16) pg[tid] = ((const int*)args.in[5])[bs * NPAGES + tid];
    {
        float kr[16];
#pragma unroll
        for (int i = 0; i < 16; ++i) { const int n = wave + 8 * i; kr[i] = n < 127 ? KCS[n * 64 + lane] : 0.f; }
#pragma unroll
        for (int i = 0; i < 16; ++i) { const int n = wave + 8 * i; float sg[4]; dot4_reduce(qv, kr[i], lane, sg);
            if (lane < 4) sc[lane * 128 + n] = n < 127 ? (lane == 0 ? sg[0] : lane == 1 ? sg[1] : lane == 2 ? sg[2] : sg[3]) : NEGF; }
    }
    __syncthreads();
    if (wave < 4) { const float s0 = sc[wave * 128 + lane], s1 = sc[wave * 128 + 64 + lane];
        float mxv = fmaxf(s0, s1);
#pragma unroll
        for (int o = 1; o < 64; o <<= 1) mxv = fmaxf(mxv, __shfl_xor(mxv, o));
        const float e0 = __expf(s0 - mxv), e1 = (lane < 63) ? __expf(s1 - mxv) : 0.f;
        const float inv = 1.f / fmaxf(wave_sum(e0 + e1), TINYF);
        sc[wave * 128 + lane] = e0 * inv; sc[wave * 128 + 64 + lane] = e1 * inv; }
    __syncthreads();
    {
        float vr[16];
#pragma unroll
        for (int i = 0; i < 16; ++i) { const int n = wave + 8 * i; vr[i] = n < 127 ? VCS[n * 64 + lane] : 0.f; }
        float oc[4] = {0.f, 0.f, 0.f, 0.f};
#pragma unroll
        for (int i = 0; i < 16; ++i) { const int n = wave + 8 * i;
#pragma unroll
            for (int g = 0; g < 4; ++g) oc[g] += sc[g * 128 + n] * vr[i]; }
#pragma unroll
        for (int g = 0; g < 4; ++g) poc[(wave * 4 + g) * 64 + lane] = oc[g];
        if (wave == 4 && lane < 33) { const int j = lane; float acc = 0.f;
#pragma unroll
            for (int k = -1; k < 4; ++k) { const int n = 4 * j + k; if (n >= 0 && n < 127) { const float P = (sc[n] + sc[128 + n]) + (sc[256 + n] + sc[384 + n]); acc += (k == -1 || k == 3) ? P : 2.f * P; } }
            impv[j] = (j == 0 || j == 31 || j == 32) ? BIGF : acc; }
    }
    __syncthreads();
    if (tid < 64) { bool sel = false;
        if (tid < 33) { const float v = impv[tid]; int rank = 0;
            for (int k = 0; k < 33; ++k) { const float o = impv[k]; rank += ((o > v) || (o == v && k < tid)) ? 1 : 0; }
            sel = rank < 16 && tid < 32; }
        const unsigned long long bal = __ballot(sel);
        if (sel) { const int slot = __popcll(bal & ((1ull << tid) - 1ull)); selblk[slot] = tid; selpage[slot] = pg[tid >> 1]; } }
    __syncthreads();
    {
        f32x4 qv4[4];
#pragma unroll
        for (int g = 0; g < 4; ++g) { const u32x2 w = *(const u32x2*)(Qr + g * 64 + 4 * (lane & 15)); qv4[g] = (f32x4){bflo(w.x), bfhi(w.x), bflo(w.y), bfhi(w.y)} * 0.125f; }
        SampleRows R{INF(4), INF(6), out, selblk, selpage, bs, hkv, lane >> 4, lane & 15};
        sample_rows_branch<0>(R, wave, qv4, pm, pl, po);
        sample_rows_branch<1>(R, wave, qv4, pm, pl, po);
    }
    __syncthreads();
    if (tid < 256) { const int g = tid >> 6, d = tid & 63;
        const float* gates = (const float*)(ws + WS_MISC) + m * 128 + 32 + (hkv * 4 + g) * 3;
        float oc = 0.f;
#pragma unroll
        for (int w = 0; w < 8; ++w) oc += poc[(w * 4 + g) * 64 + d];
        float res = sigmf(gates[0]) * oc;
#pragma unroll
        for (int br = 0; br < 2; ++br) { float M = NEGF;
#pragma unroll 8
            for (int w = 0; w < 32; ++w) M = fmaxf(M, pm[(br * 32 + w) * 4 + g]);
            float L = 0.f, O = 0.f;
#pragma unroll 8
            for (int w = 0; w < 32; ++w) { const float e = __expf(pm[(br * 32 + w) * 4 + g] - M); L += pl[(br * 32 + w) * 4 + g] * e; O += po[((br * 32 + w) * 4 + g) * 64 + d] * e; }
            res += sigmf(gates[1 + br]) * O / fmaxf(L, TINYF); }
        ((bf16*)(ws + WS_YATT))[m * 1024 + (hkv * 4 + g) * 64 + d] = (bf16)f2bf(res); }
    __syncthreads();
}

__device__ __forceinline__ void ffn_act_item(const Args& args, int item, int lane) {
    unsigned char* ws = args.ws; float* out = args.out;
    const bf16* U = (const bf16*)(ws + WS_U); bf16* ACT = (bf16*)(ws + WS_ACT);
    const float* cw = INF(32); const float* cb = INF(33); const float* st = INF(9);
    const int slab = item % 11, chunk = item / 11, row0 = chunk * 32, c4 = slab * 256 + lane * 4;
    f32x4 w[2][3], bia[2];
#pragma unroll
    for (int hf = 0; hf < 2; ++hf) { bia[hf] = *(const f32x4*)(cb + hf * DFF + c4);
#pragma unroll
        for (int k = 0; k < 3; ++k) w[hf][k] = *(const f32x4*)(cw + k * DFF2 + hf * DFF + c4); }
    if (row0 >= MP) {
        for (int r = 0; r < 32; ++r) { const int bs = row0 - MP + r; if (bs >= MS) break;
            f32x4 cu[2];
#pragma unroll
            for (int hf = 0; hf < 2; ++hf) { const int col = hf * DFF + c4;
                const f32x4 u0 = *(const f32x4*)(st + ((size_t)bs * 2 + 0) * DFF2 + col), u1 = *(const f32x4*)(st + ((size_t)bs * 2 + 1) * DFF2 + col), u2 = *(const f32x4*)(out + O_FFNS + ((size_t)bs * 2 + 1) * DFF2 + col);
                *(f32x4*)(out + O_FFNS + ((size_t)bs * 2 + 0) * DFF2 + col) = u1;
                cu[hf] = bia[hf] + w[hf][0] * u0 + w[hf][1] * u1 + w[hf][2] * u2; }
            u32x2 o; o.x = pk2(siluf(cu[0].x) * cu[1].x, siluf(cu[0].y) * cu[1].y); o.y = pk2(siluf(cu[0].z) * cu[1].z, siluf(cu[0].w) * cu[1].w);
            *(u32x2*)(ACT + (size_t)(row0 + r) * DFF + c4) = o; }
        return;
    }
    const int t0 = row0 & 4095;
    f32x4 p2[2], p1[2];
#pragma unroll
    for (int hf = 0; hf < 2; ++hf) { const int col = hf * DFF + c4;
        const u32x2 a = t0 >= 2 ? *(const u32x2*)(U + (size_t)(row0 - 2) * DFF2 + col) : (u32x2){0u, 0u}, b = t0 >= 1 ? *(const u32x2*)(U + (size_t)(row0 - 1) * DFF2 + col) : (u32x2){0u, 0u};
        p2[hf] = (f32x4){bflo(a.x), bfhi(a.x), bflo(a.y), bfhi(a.y)}; p1[hf] = (f32x4){bflo(b.x), bfhi(b.x), bflo(b.y), bfhi(b.y)}; }
#pragma unroll 1
    for (int rb = 0; rb < 32; rb += 8) {
        u32x2 v[8][2];
#pragma unroll
        for (int r = 0; r < 8; ++r)
#pragma unroll
            for (int hf = 0; hf < 2; ++hf) v[r][hf] = *(const u32x2*)(U + (size_t)(row0 + rb + r) * DFF2 + hf * DFF + c4);
#pragma unroll
        for (int r = 0; r < 8; ++r) {
            f32x4 cu[2];
#pragma unroll
            for (int hf = 0; hf < 2; ++hf) { const f32x4 u2 = (f32x4){bflo(v[r][hf].x), bfhi(v[r][hf].x), bflo(v[r][hf].y), bfhi(v[r][hf].y)};
                cu[hf] = bia[hf] + w[hf][0] * p2[hf] + w[hf][1] * p1[hf] + w[hf][2] * u2; p2[hf] = p1[hf]; p1[hf] = u2; }
            u32x2 o; o.x = pk2(siluf(cu[0].x) * cu[1].x, siluf(cu[0].y) * cu[1].y); o.y = pk2(siluf(cu[0].z) * cu[1].z, siluf(cu[0].w) * cu[1].w);
            *(u32x2*)(ACT + (size_t)(row0 + rb + r) * DFF + c4) = o;
        }
    }
}
template <int KTOT>
__device__ __forceinline__ f32x4 skinny_acc(const bf16* A, int lda, const bf16* Bt, int ldb, int wave, int ct, int q, int r16) {
    const bf16* ap = A + (size_t)(16 * wave + r16) * lda + 8 * q;
    const bf16* bp = Bt + (size_t)(16 * ct + r16) * ldb + 8 * q;
    f32x4 acc = (f32x4){0.f, 0.f, 0.f, 0.f};
#pragma unroll 1
    for (int k0 = 0; k0 < KTOT; k0 += 256) {
        bf16x8 af[8], bf[8];
#pragma unroll
        for (int i = 0; i < 8; ++i) { af[i] = *(const bf16x8*)(ap + k0 + 32 * i); bf[i] = *(const bf16x8*)(bp + k0 + 32 * i); }
#pragma unroll
        for (int i = 0; i < 8; ++i) acc = MFMA16(af[i], bf[i], acc);
    }
    return acc;
}
template <int WHICH>
__device__ __forceinline__ void skinny_sample_unit(const Args& args, int ct, int wave, int lane) {
    unsigned char* ws = args.ws;
    const int q = lane >> 4, r16 = lane & 15, col = 16 * ct + r16;
    if (WHICH == 0) {
        const f32x4 a1 = skinny_acc<2048>((const bf16*)(ws + WS_YSSM) + (size_t)MP * 2048, 2048, (const bf16*)(ws + WS_WSSM), 2048, wave, ct, q, r16);
        const f32x4 a2 = skinny_acc<1024>((const bf16*)(ws + WS_YATT) + (size_t)MP * 1024, 1024, (const bf16*)(ws + WS_WATT), 1024, wave, ct, q, r16);
#pragma unroll
        for (int r = 0; r < 4; ++r) { const size_t row = MP + 16 * wave + 4 * q + r;
            const f32x4 sq = *(const f32x4*)((const float*)(ws + WS_SSQ) + row * 4);
            const float rstd = 1.f / sqrtf(((sq.x + sq.y) + (sq.z + sq.w)) * (1.f / 2048.f) + EPS);
            const bf16* mg = (const bf16*)(ws + WS_MG) + row * 2048;
            const float v = sigmf(bf2f(mg[col])) * rstd * a1[r] + sigmf(bf2f(mg[1024 + col])) * a2[r];
            ((bf16*)(ws + WS_MERGED))[row * 1024 + col] = (bf16)f2bf(v); }
    } else if (WHICH == 1) {
        const f32x4 a = skinny_acc<1024>((const bf16*)(ws + WS_MERGED) + (size_t)MP * 1024, 1024, (const bf16*)(ws + WS_WOUT), 1024, wave, ct, q, r16);
#pragma unroll
        for (int r = 0; r < 4; ++r) { const int bs = 16 * wave + 4 * q + r;
            ((float*)(ws + WS_X1))[(size_t)(MP + bs) * 1024 + col] = INF(1)[(size_t)bs * 1024 + col] + ((const float*)(ws + WS_MOD))[(size_t)(4 + bs) * 6144 + 2048 + col] * a[r]; }
    } else {
        const f32x4 a = skinny_acc<DFF>((const bf16*)(ws + WS_ACT) + (size_t)MP * DFF, DFF, (const bf16*)(ws + WS_WDN), DFF, wave, ct, q, r16);
#pragma unroll
        for (int r = 0; r < 4; ++r) { const int bs = 16 * wave + 4 * q + r; float* x = (float*)(ws + WS_X1) + (size_t)(MP + bs) * 1024 + col;
            *x = *x + ((const float*)(ws + WS_MOD))[(size_t)(4 + bs) * 6144 + 5120 + col] * a[r]; }
    }
}
constexpr int N_PHASES = 15;
#ifndef MK_PER_PHASE
#define MK_PER_PHASE 0
#endif

__global__ void __launch_bounds__(NTHR, 2) fwd_kernel(Args args) {
    extern __shared__ __attribute__((aligned(16))) unsigned char lds_raw[];
    LAS unsigned char* lds = (LAS unsigned char*)lds_raw;
    const int tid = threadIdx.x, lane = tid & 63, wave = __builtin_amdgcn_readfirstlane(tid >> 6);
    const int G = gridDim.x, bid = blockIdx.x, gw = bid * NWAVES + wave, NGW = G * NWAVES, gt = bid * NTHR + tid, NGT = G * NTHR;
    unsigned char* ws = args.ws;
    for (int u = tid; u < (LDS_BYTES - LDSCTL_OFF) / 4; u += NTHR) ((LAS unsigned*)(lds + LDSCTL_OFF))[u] = 0u;
    __syncthreads();
    XcdBarrier bar; bar.bar = (unsigned*)(ws + WS_CTL) + CW_BAR; bar.x = 0; bar.st = nullptr;
    if (!MK_PER_PHASE) bar = xcd_barrier_post((unsigned*)(ws + WS_CTL) + CW_BAR, (volatile LAS unsigned*)(lds + MISC_OFF) + 8);
    const int lo = args.ph_lo, hi = args.ph_hi;
#ifndef PHASE_MASK
#define PHASE_MASK 0x7fff
#endif
#define IN(k) ((((PHASE_MASK) >> (k)) & 1) && lo <= (k) && (k) < hi)
#define SEAM(k) do { if (IN(k) && IN((k) + 1)) xcd_barrier(bar); } while (0)
    using pg8::Gemm; using pg8::StaticOrder;

    if (IN(0)) { { p0_prologue(args, lds, gw, NGW, lane, wave); } }
    SEAM(0);
    if (IN(1)) { {
        Gemm g{(const bf16*)(ws + WS_SC), (const bf16*)(ws + WS_WADA), 256, 6144, 1024}; StaticOrder S; S.init(256, 6144, G, bid);
        pg8::EpiF32 E{(float*)(ws + WS_MOD), 6144, INF(11)};
        pg8::gemm_phase<pg8::EpiF32, StaticOrder, true, true>(lds, g, S, E);
    } }
    SEAM(1);
    if (IN(2)) { { norm_mod_phase<0>(args, gw, NGW, lane); } }
    SEAM(2);
    if (IN(3)) { {
        Gemm g{(const bf16*)(ws + WS_H), (const bf16*)(ws + WS_WIN), MPAD, NPROJ, 1024}; StaticOrder S; S.init(MPAD, NPROJ, G, bid);
        epi::InProj E{ws, args.out};
        pg8::gemm_phase<epi::InProj, StaticOrder, true, true>(lds, g, S, E);
    } }
    SEAM(3);
    if (IN(4)) { {
        { Gemm g{(const bf16*)(ws + WS_CKB), (const bf16*)(ws + WS_W1K), 65536, 256, 1024}; StaticOrder S; S.init(65536, 256, G, bid);
          pg8::EpiF32 E{(float*)(ws + WS_PARTSK), 256, nullptr}; pg8::gemm_phase<pg8::EpiF32, StaticOrder, true, true>(lds, g, S, E); }
        { Gemm g{(const bf16*)(ws + WS_CVB), (const bf16*)(ws + WS_W1V), 65536, 256, 1024}; StaticOrder S; S.init(65536, 256, G, bid);
          pg8::EpiF32 E{(float*)(ws + WS_PARTSV), 256, nullptr}; pg8::gemm_phase<pg8::EpiF32, StaticOrder, true, true>(lds, g, S, E); }
        { Gemm g{(const bf16*)(ws + WS_KVH), (const bf16*)(ws + WS_W1K), 4096, 256, 1024}; StaticOrder S; S.init(4096, 256, G, bid);
          pg8::EpiF32 E{(float*)(ws + WS_PARTK), 256, nullptr}; pg8::gemm_phase<pg8::EpiF32, StaticOrder, true, true>(lds, g, S, E); }
        { Gemm g{(const bf16*)(ws + WS_KVH) + (size_t)16 * 4096 * 64, (const bf16*)(ws + WS_W1V), 4096, 256, 1024}; StaticOrder S; S.init(4096, 256, G, (bid + G - 16) % G);
          pg8::EpiF32 E{(float*)(ws + WS_PARTV), 256, nullptr}; pg8::gemm_phase<pg8::EpiF32, StaticOrder, true, true>(lds, g, S, E); }
        for (int it = gw; it < 256 * 48; it += NGW) conv_prompt_item(args, it, lane);
        for (int it = gw; it < 4096; it += NGW) dtcs_item(args, it, lane);
        sample_conv(args, gt, NGT);
    } }
    SEAM(4);
    if (IN(5)) { {
        for (int u = bid; u < 512; u += G) ssd_states_unit(args, lds, u, wave, lane);
        for (int it = gw; it < 2 * (4096 / 16); it += NGW) compress2_item<0>(args, it, lane);
        for (int it = gw; it < 2 * (65536 / 16); it += NGW) compress2_item<1>(args, it, lane);
        for (int it = gw; it < MS * NH; it += NGW) sample_ssm_item(args, lds, it, wave, lane);
    } }
    SEAM(5);
    if (IN(6)) { { scan_phase(args, gt, NGT); } }
    SEAM(6);
    if (IN(7)) { {
#ifndef P7C
#define P7C 7
#endif
        const int p7 = args.p7mask & (P7C);
        if (p7 & 1) for (int u = bid; u < 512; u += G) ssd_out_unit(args, lds, u, wave, lane, tid);
        if (p7 & 2) for (int u = gw; u < 4096; u += NGW) attn_prompt_unit(args, (LAS float*)(lds + wave * 12288), u, NGW == 2048, lane);
        __syncthreads();
        if (p7 & 4) for (int u = bid; u < 512; u += G) attn_sample_unit(args, lds, u, tid, wave, lane);
    } }
    SEAM(7);
    if (IN(8)) { {
        for (int u = bid; u < 64; u += G) skinny_sample_unit<0>(args, u, wave, lane);
        { Gemm g{(const bf16*)(ws + WS_YSSM), (const bf16*)(ws + WS_WSSM), MP, 1024, 2048}; StaticOrder S; S.init(MP, 1024, G, bid);
          epi::Merge1 E{ws}; pg8::gemm_phase<epi::Merge1, StaticOrder, true, true>(lds, g, S, E); }
        { Gemm g{(const bf16*)(ws + WS_YATT), (const bf16*)(ws + WS_WATT), MP, 1024, 1024}; StaticOrder S; S.init(MP, 1024, G, bid);
          epi::Merge2 E{ws}; pg8::gemm_phase<epi::Merge2, StaticOrder, true, true>(lds, g, S, E); }
    } }
    SEAM(8);
    if (IN(9)) { {
        for (int u = bid; u < 64; u += G) skinny_sample_unit<1>(args, u, wave, lane);
        Gemm g{(const bf16*)(ws + WS_MERGED), (const bf16*)(ws + WS_WOUT), MP, 1024, 1024}; StaticOrder S; S.init(MP, 1024, G, bid);
        epi::Resid E{INF(0), INF(1), nullptr, (float*)(ws + WS_X1), (const float*)(ws + WS_MOD), 2048};
        pg8::gemm_phase<epi::Resid, StaticOrder, true, true>(lds, g, S, E);
    } }
    SEAM(9);
    if (IN(10)) { { norm_mod_phase<1>(args, gw, NGW, lane); } }
    SEAM(10);
    if (IN(11)) { {
        Gemm g{(const bf16*)(ws + WS_H), (const bf16*)(ws + WS_WUP), MPAD, DFF2, 1024}; StaticOrder S; S.init(MPAD, DFF2, G, bid);
        epi::Up E{ws, args.out};
        pg8::gemm_phase<epi::Up, StaticOrder, true, true>(lds, g, S, E);
    } }
    SEAM(11);
    if (IN(12)) { { for (int it = gw; it < (MPAD / 32) * 11; it += NGW) ffn_act_item(args, it, lane); } }
    SEAM(12);
    if (IN(13)) { {
        for (int u = bid; u < 64; u += G) skinny_sample_unit<2>(args, u, wave, lane);
        Gemm g{(const bf16*)(ws + WS_ACT), (const bf16*)(ws + WS_WDN), MP, 1024, DFF}; StaticOrder S; S.init(MP, 1024, G, bid);
        epi::Resid E{INF(0), INF(1), (const float*)(ws + WS_X1), (float*)(ws + WS_X1), (const float*)(ws + WS_MOD), 5120};
        pg8::gemm_phase<epi::Resid, StaticOrder, true, true>(lds, g, S, E);
    } }
    SEAM(13);
    if (IN(14)) { { norm_mod_phase<2>(args, gw, NGW, lane); } }
#undef IN
#undef SEAM
}

extern "C" void kernel_launch(void* const* d_in, const int* in_sizes, int n_in, void* d_out, int out_size, void* d_ws, size_t ws_size, hipStream_t stream) {
    static int grid = 0;
    if (grid == 0) {
        if (n_in != 35 || out_size != (int)O_END || ws_size < WS_END) { fprintf(stderr, "kernel_launch: unexpected shapes (n_in %d out %d ws %zu, need %zu)\n", n_in, out_size, ws_size, (size_t)WS_END); grid = -1; return; }
        int dev = 0, cus = 0, per_cu = 0;
        if (hipGetDevice(&dev) != hipSuccess || hipDeviceGetAttribute(&cus, hipDeviceAttributeMultiprocessorCount, dev) != hipSuccess) { grid = -1; return; }
        if (hipFuncSetAttribute((const void*)fwd_kernel, hipFuncAttributeMaxDynamicSharedMemorySize, LDS_BYTES) != hipSuccess) { fprintf(stderr, "kernel_launch: hipFuncSetAttribute failed\n"); grid = -1; return; }
        if (hipOccupancyMaxActiveBlocksPerMultiprocessor(&per_cu, (const void*)fwd_kernel, NTHR, LDS_BYTES) != hipSuccess || per_cu < 1) { fprintf(stderr, "kernel_launch: occupancy query says %d\n", per_cu); }
        (void)hipGetLastError();
        grid = cus;
    }
    if (grid < 0) return;
    (void)hipMemsetAsync((char*)d_ws + WS_CTL, 0, CTL_ZERO_BYTES, stream);
    Args a{};
    for (int i = 0; i < 35; ++i) a.in[i] = d_in[i];
    a.out = (float*)d_out; a.ws = (unsigned char*)d_ws;
    a.p7mask = 7; a.pad = 7;
#if MK_PER_PHASE
    for (int p = 0; p < N_PHASES; ++p) { a.ph_lo = p; a.ph_hi = p + 1; hipLaunchKernelGGL(fwd_kernel, dim3(grid), dim3(NTHR), LDS_BYTES, stream, a); }
#else
    a.ph_lo = 0; a.ph_hi = N_PHASES;
    hipLaunchKernelGGL(fwd_kernel, dim3(grid), dim3(NTHR), LDS_BYTES, stream, a);
#endif
#ifdef PROBE_LO
    a.ph_lo = PROBE_LO; a.ph_hi = PROBE_HI; a.p7mask = PROBE_P7MASK; a.pad = PROBE_P7MASK;
    hipLaunchKernelGGL(fwd_kernel, dim3(grid), dim3(NTHR), LDS_BYTES, stream, a);
#endif
}
```

```cpp
#include <hip/hip_runtime.h>
#include <cstdio>
#include <cstdint>
namespace pg8 {
#define PG8_LAS __attribute__((address_space(3)))
typedef unsigned short bf16_t;
typedef short bf16x8 __attribute__((ext_vector_type(8)));
typedef float f32x4 __attribute__((ext_vector_type(4)));
typedef unsigned u32x4 __attribute__((ext_vector_type(4)));
constexpr int BM = 256, BK = 64, HALF = 128, HTB = HALF * BK * 2  , STAGE_BYTES = 8 * HTB, NXCD = 8, WGM = 8;

__host__ __device__ __forceinline__ int lds_byte(int r, int c) { const int st = (r >> 4) * 2 + (c >> 5), rr = r & 15, cc = c & 31, ob = rr * 64 + cc * 2; return st * 1024 + (ob ^ (((ob >> 9) & 1) << 5)); }
__host__ __device__ __forceinline__ void stage_rc(int b, int& R, int& C) { const int st = b / 1024, sb = b % 1024, swz = sb ^ (((sb >> 9) & 1) << 5); R = (st >> 1) * 16 + swz / 64; C = (st & 1) * 32 + (swz % 64) / 2; }
__host__ __device__ __forceinline__ int perm32(int rho) { const int n = rho >> 4, i = rho & 15; return 8 * (i >> 2) + 4 * n + (i & 3); }

struct Unit { int pm, pn; };
struct Gemm { const bf16_t* A; const bf16_t* Bt; int M, N, K; };

struct StaticOrder {
    int nM, nN, nwg, G, c;
    __host__ __device__ void init(int M, int N, int G_, int c_) { nM = M / BM; nN = N / BM; nwg = nM * nN; G = G_; c = c_; }
    __host__ __device__ bool next(int i, Unit& u) const {
        const long L = (long)i * G + c; if (L >= nwg) return false;
        int wgid = (int)L; { const int q = nwg / NXCD, r = nwg % NXCD, xcd = wgid % NXCD, off = wgid / NXCD; wgid = (xcd < r ? xcd * (q + 1) : r * (q + 1) + (xcd - r) * q) + off; }
        const int nig = WGM * nN, gid = wgid / nig, fm = gid * WGM, gsz = (nM - fm) < WGM ? (nM - fm) : WGM;
        u.pm = fm + ((wgid % nig) % gsz); u.pn = (wgid % nig) / gsz; return true;
    }
    __device__ __forceinline__ void a_ready(const Unit&) const {}
    __device__ __forceinline__ void done(const Unit&) const {}
};
__device__ __forceinline__ unsigned cvt_pk_bf16(float lo, float hi) { unsigned r; asm volatile("v_cvt_pk_bf16_f32 %0, %1, %2" : "=v"(r) : "v"(lo), "v"(hi)); return r; }
typedef float f32x2 __attribute__((ext_vector_type(2)));
struct EpiF32 {
    static constexpr bool PERM = false, AFTER_DRAIN = false;
    float* C; int ldc; const float* bias;
    __device__ __forceinline__ void operator()(const f32x4 (&acc)[2][2][4][2], const Unit& u, int wr, int wc, int fr, int fq) const {
        const int row0 = u.pm * BM + wr * 64 + fr, col0 = u.pn * BM + wc * 32 + 4 * fq;
        f32x4 bv[2][2];
#pragma unroll
        for (int bj = 0; bj < 2; ++bj)
#pragma unroll
            for (int n = 0; n < 2; ++n) bv[bj][n] = bias ? *(const f32x4*)(bias + col0 + bj * HALF + n * 16) : (f32x4){0.f, 0.f, 0.f, 0.f};
#pragma unroll
        for (int ai = 0; ai < 2; ++ai)
#pragma unroll
            for (int m = 0; m < 4; ++m) { float* rowp = C + (size_t)(row0 + ai * HALF + m * 16) * ldc + col0;
#pragma unroll
                for (int bj = 0; bj < 2; ++bj)
#pragma unroll
                    for (int n = 0; n < 2; ++n) *(f32x4*)(rowp + bj * HALF + n * 16) = acc[ai][bj][m][n] + bv[bj][n]; }
    }
};
template <class Epi, class Sched, bool ALIGN_EPI = false, bool SP2 = false>
__device__ __forceinline__ void gemm_phase(PG8_LAS unsigned char* lds, const Gemm g, const Sched& S, const Epi& E) {
    const int tid = threadIdx.x, wid = __builtin_amdgcn_readfirstlane(tid >> 6), lane = tid & 63, wr = wid >> 2, wc = wid & 3, fr = lane & 15, fq = lane >> 4;
    const int K = g.K, nt = K / BK;
    unsigned voffA[2], voffB[2];
#pragma unroll
    for (int i = 0; i < 2; ++i) { int R, C; stage_rc(tid * 16 + i * 8192, R, C); const int Rb = Epi::PERM ? ((R & ~31) + perm32(R & 31)) : R;
        voffA[i] = (unsigned)(R * K + C) * 2u; voffB[i] = (unsigned)(Rb * K + C) * 2u; }
    const size_t kstep = (size_t)(BK * 2);
    const size_t hstep = (size_t)HALF * K * 2;
    const size_t tstep = 2 * hstep;
    const unsigned ldsw = (unsigned)wid * 1024u;
    const int aoff = lds_byte(wr * 64 + fr, fq * 8), boff = lds_byte(wc * 32 + fr, fq * 8);
#define PG8_SA(b, h) (((b) * 2 + (h)) * HTB)
#define PG8_SB(b, h) ((4 + (b) * 2 + (h)) * HTB)
#define PG8_STAGE(bufoff, gbase, voff) do { _Pragma("unroll") for (int _i = 0; _i < 2; ++_i) \
        __builtin_amdgcn_global_load_lds((const unsigned*)((const char*)(gbase) + (voff)[_i]), (PG8_LAS unsigned*)(lds + (bufoff) + ldsw + _i * 8192), 16, 0, 0); } while (0)
#define PG8_LDA(dst, b, h) do { _Pragma("unroll") for (int m = 0; m < 4; ++m) _Pragma("unroll") for (int k = 0; k < 2; ++k) dst[m][k] = *(const PG8_LAS bf16x8*)(lds + PG8_SA(b, h) + aoff + m * 2048 + k * 1024); } while (0)
#define PG8_LDB(dst, b, h) do { _Pragma("unroll") for (int n = 0; n < 2; ++n) _Pragma("unroll") for (int k = 0; k < 2; ++k) dst[n][k] = *(const PG8_LAS bf16x8*)(lds + PG8_SB(b, h) + boff + n * 2048 + k * 1024); } while (0)
#define PG8_MMA(ai, bj, At, Bt) do { __builtin_amdgcn_s_setprio(1); _Pragma("unroll") for (int m = 0; m < 4; ++m) _Pragma("unroll") for (int n = 0; n < 2; ++n) _Pragma("unroll") for (int k = 0; k < 2; ++k) \
        acc[ai][bj][m][n] = __builtin_amdgcn_mfma_f32_16x16x32_bf16(Bt[n][k], At[m][k], acc[ai][bj][m][n], 0, 0, 0); __builtin_amdgcn_s_setprio(0); } while (0)
#define PG8_WAIT_V(n) asm volatile("s_waitcnt vmcnt(" #n ")" ::: "memory")
#define PG8_WAIT_L(n) asm volatile("s_waitcnt lgkmcnt(" #n ")" ::: "memory")
#define PG8_BAR __builtin_amdgcn_s_barrier()
#define PG8_SCHED __builtin_amdgcn_sched_barrier(0)
    Unit cur, nxt; int ui = 0;
    if (!S.next(0, cur)) return;
    f32x4 acc[2][2][4][2];
#pragma unroll
    for (int a = 0; a < 2; ++a)
#pragma unroll
        for (int b = 0; b < 2; ++b)
#pragma unroll
            for (int m = 0; m < 4; ++m)
#pragma unroll
                for (int n = 0; n < 2; ++n) acc[a][b][m][n] = (f32x4){0.f, 0.f, 0.f, 0.f};
    bf16x8 At[4][2], B0[2][2], B1[2][2];
    const char* cA = (const char*)g.A + (size_t)cur.pm * tstep; const char* cB = (const char*)g.Bt + (size_t)cur.pn * tstep;
    S.a_ready(cur);
    if constexpr (SP2) {
        PG8_STAGE(PG8_SB(0, 0), cB, voffB); PG8_STAGE(PG8_SB(0, 1), cB + hstep, voffB); PG8_STAGE(PG8_SA(0, 0), cA, voffA); PG8_STAGE(PG8_SA(0, 1), cA + hstep, voffA);
        if (wr == 1) PG8_BAR;
        PG8_WAIT_V(2); PG8_BAR;
        PG8_STAGE(PG8_SB(1, 0), cB + kstep, voffB); PG8_STAGE(PG8_SA(1, 0), cA + kstep, voffA); PG8_STAGE(PG8_SB(1, 1), cB + hstep + kstep, voffB);
        PG8_WAIT_V(6); PG8_BAR;
    } else {
        PG8_STAGE(PG8_SB(0, 0), cB, voffB); PG8_STAGE(PG8_SA(0, 0), cA, voffA); PG8_STAGE(PG8_SB(0, 1), cB + hstep, voffB); PG8_STAGE(PG8_SA(0, 1), cA + hstep, voffA);
        if (wr == 1) PG8_BAR;
        PG8_WAIT_V(4); PG8_BAR;
        PG8_STAGE(PG8_SB(1, 0), cB + kstep, voffB); PG8_STAGE(PG8_SA(1, 0), cA + kstep, voffA); PG8_STAGE(PG8_SB(1, 1), cB + hstep + kstep, voffB);
        PG8_WAIT_V(6); PG8_BAR;
    }
    for (;;) {
        const bool has_next = S.next(ui + 1, nxt);
        const char* nA = has_next ? (const char*)g.A + (size_t)nxt.pm * tstep : cA; const char* nB = has_next ? (const char*)g.Bt + (size_t)nxt.pn * tstep : cB;
        for (int t = 0; t < nt; t += 2) {
            const bool last = (t == nt - 2);
            const char* a1 = cA + (size_t)(t + 1) * kstep;
            const char* a2 = last ? nA : cA + (size_t)(t + 2) * kstep; const char* b2 = last ? nB : cB + (size_t)(t + 2) * kstep;
            const char* a3 = a2 + kstep; const char* b3 = b2 + kstep;
            if (last && has_next) S.a_ready(nxt);
            if constexpr (SP2) {
            PG8_LDB(B0, 0, 0); PG8_LDB(B1, 0, 1); PG8_SCHED; PG8_LDA(At, 0, 0); PG8_STAGE(PG8_SA(1, 1), a1 + hstep, voffA);
            PG8_WAIT_V(8); PG8_WAIT_L(0); PG8_BAR; PG8_MMA(0, 0, At, B0); PG8_MMA(0, 1, At, B1); PG8_BAR; PG8_SCHED;
            PG8_LDA(At, 0, 1); PG8_STAGE(PG8_SB(0, 0), b2, voffB); PG8_STAGE(PG8_SB(0, 1), b2 + hstep, voffB); PG8_STAGE(PG8_SA(0, 0), a2, voffA);
            PG8_WAIT_V(8); PG8_WAIT_L(0); PG8_BAR; PG8_MMA(1, 0, At, B0); PG8_MMA(1, 1, At, B1); PG8_BAR; PG8_SCHED;
            PG8_LDB(B0, 1, 0); PG8_LDB(B1, 1, 1); PG8_SCHED; PG8_LDA(At, 1, 0); PG8_STAGE(PG8_SA(0, 1), a2 + hstep, voffA);
            PG8_WAIT_V(8); PG8_WAIT_L(0); PG8_BAR; PG8_MMA(0, 0, At, B0); PG8_MMA(0, 1, At, B1); PG8_BAR; PG8_SCHED;
            PG8_LDA(At, 1, 1); PG8_STAGE(PG8_SB(1, 0), b3, voffB); PG8_STAGE(PG8_SB(1, 1), b3 + hstep, voffB); PG8_STAGE(PG8_SA(1, 0), a3, voffA);
            PG8_WAIT_V(8); PG8_WAIT_L(0); PG8_BAR; PG8_MMA(1, 0, At, B0); PG8_MMA(1, 1, At, B1); PG8_BAR; PG8_SCHED;
            } else {
            PG8_LDB(B0, 0, 0); PG8_SCHED; PG8_LDA(At, 0, 0); PG8_STAGE(PG8_SA(1, 1), a1 + hstep, voffA);
            PG8_WAIT_L(8); PG8_BAR; PG8_WAIT_L(0); PG8_MMA(0, 0, At, B0); PG8_BAR; PG8_SCHED;
            PG8_LDB(B1, 0, 1); PG8_STAGE(PG8_SB(0, 0), b2, voffB);
            PG8_BAR; PG8_WAIT_L(0); PG8_MMA(0, 1, At, B1); PG8_BAR;
            PG8_LDA(At, 0, 1); PG8_STAGE(PG8_SA(0, 0), a2, voffA);
            PG8_BAR; PG8_WAIT_L(0); PG8_MMA(1, 0, At, B0); PG8_BAR; PG8_SCHED;
            PG8_STAGE(PG8_SB(0, 1), b2 + hstep, voffB);
            PG8_WAIT_V(6); PG8_BAR; PG8_MMA(1, 1, At, B1); PG8_BAR;
            PG8_LDB(B0, 1, 0); PG8_SCHED; PG8_LDA(At, 1, 0); PG8_STAGE(PG8_SA(0, 1), a2 + hstep, voffA);
            PG8_WAIT_L(8); PG8_BAR; PG8_WAIT_L(0); PG8_MMA(0, 0, At, B0); PG8_BAR; PG8_SCHED;
            PG8_LDB(B1, 1, 1); PG8_STAGE(PG8_SB(1, 0), b3, voffB);
            PG8_BAR; PG8_WAIT_L(0); PG8_MMA(0, 1, At, B1); PG8_BAR;
            PG8_LDA(At, 1, 1); PG8_STAGE(PG8_SA(1, 0), a3, voffA);
            PG8_BAR; PG8_WAIT_L(0); PG8_MMA(1, 0, At, B0); PG8_BAR; PG8_SCHED;
            PG8_STAGE(PG8_SB(1, 1), b3 + hstep, voffB);
            PG8_WAIT_V(6); PG8_BAR; PG8_MMA(1, 1, At, B1); PG8_BAR;
            }
        }
        if constexpr (ALIGN_EPI) { if (wr == 0) PG8_BAR; }
        if constexpr (!Epi::AFTER_DRAIN) { E(acc, cur, wr, wc, fr, fq); S.done(cur); }
        if (!has_next) break;
#pragma unroll
        for (int a = 0; a < 2; ++a)
#pragma unroll
            for (int b = 0; b < 2; ++b)
#pragma unroll
                for (int m = 0; m < 4; ++m)
#pragma unroll
                    for (int n = 0; n < 2; ++n) acc[a][b][m][n] = (f32x4){0.f, 0.f, 0.f, 0.f};
        cur = nxt; cA = nA; cB = nB; ++ui;
        if constexpr (ALIGN_EPI) { if (wr == 1) PG8_BAR; }
    }
    PG8_WAIT_V(0);
    if constexpr (!ALIGN_EPI) { if (wr == 0) PG8_BAR; }
    PG8_BAR;
    if constexpr (Epi::AFTER_DRAIN) { E.fused(acc, cur, wr, wc, fr, fq, lds, wid, lane); S.done(cur); }
#undef PG8_SA
#undef PG8_SB
#undef PG8_STAGE
#undef PG8_LDA
#undef PG8_LDB
#undef PG8_MMA
#undef PG8_WAIT_V
#undef PG8_WAIT_L
#undef PG8_BAR
#undef PG8_SCHED
}
}
#define GAS __attribute__((address_space(1)))
#define LAS __attribute__((address_space(3)))
typedef unsigned short bf16;
typedef float f32x4 __attribute__((ext_vector_type(4)));
typedef float f32x2 __attribute__((ext_vector_type(2)));
typedef short bf16x8 __attribute__((ext_vector_type(8)));
typedef short bf16x4 __attribute__((ext_vector_type(4)));
typedef unsigned u32x4 __attribute__((ext_vector_type(4)));
typedef unsigned u32x2 __attribute__((ext_vector_type(2)));
#define MFMA16(a, b, c) __builtin_amdgcn_mfma_f32_16x16x32_bf16((a), (b), (c), 0, 0, 0)

constexpr int NWAVES = 8, NTHR = 512;
constexpr int DM = 1024, SEQ = 4096, NB = 4, MP = NB * SEQ, MS = 128, MALL = MP + MS, MPAD = 16640;
constexpr int DI = 2048, CONVD = 3072, NH = 32, NG = 4, NST = 128;
constexpr int NPROJ = 9984;
constexpr int DFF = 2816, DFF2 = 5632;
constexpr int NPAGES = 16, PAST = 2048;
constexpr float EPS = 1e-6f, NEGF = -1e30f, BIGF = 1e30f, TINYF = 1e-30f;
constexpr int T_Z = 0, T_XBC = 8, T_Q = 20, T_KV = 24, T_MG = 30, T_MISC = 38;

constexpr size_t O_YP = 0;
constexpr size_t O_YS = O_YP + (size_t)MP * DM;
constexpr size_t O_KVP = O_YS + (size_t)MS * DM;
constexpr size_t O_KVS = O_KVP + (size_t)MP * 1024;
constexpr size_t O_WINP = O_KVS + (size_t)MS * 1024;
constexpr size_t O_WINS = O_WINP + (size_t)NB * 512 * 512;
constexpr size_t O_SSMP = O_WINS + (size_t)MS * 512 * 512;
constexpr size_t O_SSMS = O_SSMP + (size_t)NB * NH * 64 * 128;
constexpr size_t O_CONVP = O_SSMS + (size_t)MS * NH * 64 * 128;
constexpr size_t O_CONVS = O_CONVP + (size_t)NB * 3 * CONVD;
constexpr size_t O_FFNP = O_CONVS + (size_t)MS * 3 * CONVD;
constexpr size_t O_FFNS = O_FFNP + (size_t)NB * 2 * DFF2;
constexpr size_t O_END = O_FFNS + (size_t)MS * 2 * DFF2;
static_assert(O_END == 105725952, "output size");

constexpr size_t al256(size_t x) { return (x + 255) & ~(size_t)255; }
constexpr size_t WS_CTL = 0, CTL_ZERO_BYTES = 1u << 20;
constexpr size_t WS_WIN = CTL_ZERO_BYTES;
constexpr size_t WS_WSSM = WS_WIN + al256((size_t)NPROJ * 1024 * 2);
constexpr size_t WS_WATT = WS_WSSM + al256((size_t)1024 * 2048 * 2);
constexpr size_t WS_WOUT = WS_WATT + al256((size_t)1024 * 1024 * 2);
constexpr size_t WS_WUP = WS_WOUT + al256((size_t)1024 * 1024 * 2);
constexpr size_t WS_WDN = WS_WUP + al256((size_t)DFF2 * 1024 * 2);
constexpr size_t WS_WADA = WS_WDN + al256((size_t)1024 * DFF * 2);
constexpr size_t WS_W1K = WS_WADA + al256((size_t)6144 * 1024 * 2);
constexpr size_t WS_W1V = WS_W1K + al256((size_t)256 * 1024 * 2);
constexpr size_t WS_SC = WS_W1V + al256((size_t)256 * 1024 * 2);
constexpr size_t WS_MOD = WS_SC + al256((size_t)256 * 1024 * 2);
constexpr size_t WS_ROPE = WS_MOD + al256((size_t)256 * 6144 * 4);
constexpr size_t WS_PET = WS_ROPE + al256((size_t)4096 * 16 * 4);
constexpr size_t WS_H = WS_PET + al256(2 * 128 * 4);
constexpr size_t WS_Z = WS_H + al256((size_t)MPAD * 1024 * 2);
constexpr size_t WS_XBC = WS_Z + al256((size_t)MPAD * 2048 * 2);
constexpr size_t WS_Q = WS_XBC + al256((size_t)MPAD * 3072 * 2);
constexpr size_t WS_MG = WS_Q + al256((size_t)MPAD * 1024 * 2);
constexpr size_t WS_MISC = WS_MG + al256((size_t)MPAD * 2048 * 2);
constexpr size_t WS_KVH = WS_MISC + al256((size_t)MPAD * 128 * 4);
constexpr size_t WS_VT = WS_KVH + al256((size_t)6 * 16 * 4096 * 64 * 2);
constexpr size_t WS_XT = WS_VT + al256((size_t)2 * 16 * 64 * 4096 * 2);
constexpr size_t WS_BN = WS_XT + al256((size_t)4 * 32 * 64 * 4096 * 2);
constexpr size_t WS_CN = WS_BN + al256((size_t)16 * 4096 * 128 * 2);
constexpr size_t WS_BT = WS_CN + al256((size_t)16 * 4096 * 128 * 2);
constexpr size_t WS_DT = WS_BT + al256((size_t)16 * 4096 * 128 * 2);
constexpr size_t WS_CS = WS_DT + al256((size_t)128 * 4096 * 4);
constexpr size_t WS_STATES = WS_CS + al256((size_t)128 * 4096 * 4);
constexpr size_t WS_HPREV = WS_STATES + al256((size_t)4096 * 8192 * 4);
constexpr size_t WS_YSSM = WS_HPREV + al256((size_t)4096 * 8192 * 2);
constexpr size_t WS_SSQ = WS_YSSM + al256((size_t)MPAD * 2048 * 2);
constexpr size_t WS_PARTK = WS_SSQ + al256((size_t)MPAD * 4 * 4);
constexpr size_t WS_PARTV = WS_PARTK + al256((size_t)4096 * 256 * 4);
constexpr size_t WS_KC = WS_PARTV + al256((size_t)4096 * 256 * 4);
constexpr size_t WS_VCT = WS_KC + al256((size_t)16 * 256 * 64 * 2);
constexpr size_t WS_YATTF = WS_VCT + al256((size_t)16 * 256 * 64 * 2);
constexpr size_t WS_YATT = WS_YATTF + al256((size_t)MPAD * 1024 * 4);
constexpr size_t WS_TMPM = WS_YATT + al256((size_t)MPAD * 1024 * 2);
constexpr size_t WS_MERGED = WS_TMPM + al256((size_t)MPAD * 1024 * 4);
constexpr size_t WS_X1 = WS_MERGED + al256((size_t)MPAD * 1024 * 2);
constexpr size_t WS_U = WS_X1 + al256((size_t)MPAD * 1024 * 4);
constexpr size_t WS_ACT = WS_U + al256((size_t)MPAD * DFF2 * 2);
constexpr size_t WS_CKB = WS_ACT + al256((size_t)MPAD * DFF * 2);
constexpr size_t WS_CVB = WS_CKB + al256((size_t)128 * 4 * 2048 * 64 * 2);
constexpr size_t WS_PARTSK = WS_CVB + al256((size_t)128 * 4 * 2048 * 64 * 2);
constexpr size_t WS_PARTSV = WS_PARTSK + al256((size_t)65536 * 256 * 4);
constexpr size_t WS_KCS = WS_PARTSV + al256((size_t)65536 * 256 * 4);
constexpr size_t WS_VCS = WS_KCS + al256((size_t)128 * 4 * 128 * 64 * 4);
constexpr size_t WS_XCS = WS_VCS + al256((size_t)128 * 4 * 128 * 64 * 4);
constexpr size_t WS_DTS = WS_XCS + al256((size_t)128 * 3072 * 4);
constexpr size_t WS_W2T = WS_DTS + al256((size_t)128 * 32 * 4);
constexpr size_t WS_END = WS_W2T + al256((size_t)2 * 64 * 128 * 2);

constexpr int CW_BAR = 4096;

constexpr int RING_BYTES = 131072;
constexpr int LDSCTL_OFF = RING_BYTES, MISC_OFF = LDSCTL_OFF + 320;
constexpr int LDS_BYTES = 147456;

__device__ __forceinline__ unsigned f2bf(float f) { unsigned u = __builtin_bit_cast(unsigned, f); return (u + 0x7fffu + ((u >> 16) & 1u)) >> 16; }
__device__ __forceinline__ unsigned pk2(float lo, float hi) { return pg8::cvt_pk_bf16(lo, hi); }
__device__ __forceinline__ float bf2f(unsigned h) { return __builtin_bit_cast(float, h << 16); }
__device__ __forceinline__ float bflo(unsigned w) { return __builtin_bit_cast(float, w << 16); }
__device__ __forceinline__ float bfhi(unsigned w) { return __builtin_bit_cast(float, w & 0xffff0000u); }
__device__ __forceinline__ float wave_sum(float v) {
#pragma unroll
    for (int o = 1; o < 64; o <<= 1) v += __shfl_xor(v, o);
    return v;
}
__device__ __forceinline__ float siluf(float x) { return x / (1.f + __expf(-x)); }
__device__ __forceinline__ float sigmf(float x) { return 1.f / (1.f + __expf(-x)); }
__device__ __forceinline__ float softplusf(float x) { return x > 20.f ? x : log1pf(__expf(x)); }
#define LDS_WAIT() asm volatile("s_waitcnt lgkmcnt(0)" ::: "memory")

struct Args { const void* in[35]; float* out; unsigned char* ws; int ph_lo, ph_hi, p7mask, pad; };
#define INF(i) ((const float*)args.in[i])
#define XB_TMO      128
#define XB_XCNT(j)  (256  + 64 * (j))
#define XB_XSUB(j)  (1280 + 64 * (j))
#define XB_XGEN(j)  (2304 + 64 * (j))
#define XB_TOP      3328
#define XB_TOPGEN   3392
#define XCD_BAR_WORDS 3456
#define XB_SPIN_CAP (1u << 18)

__device__ __forceinline__ unsigned xb_ld(unsigned* p)              { return __hip_atomic_load(p, __ATOMIC_RELAXED, __HIP_MEMORY_SCOPE_AGENT); }
__device__ __forceinline__ unsigned xb_add(unsigned* p, unsigned v) { return __hip_atomic_fetch_add(p, v, __ATOMIC_RELAXED, __HIP_MEMORY_SCOPE_AGENT); }
__device__ __forceinline__ unsigned xb_xcc_id() { return (unsigned)__builtin_amdgcn_s_getreg((3 << 11) | 20) & 0xFu; }
#define XB_SPIN(cond, bar) do { unsigned _sp = 0; while (cond) { __builtin_amdgcn_s_sleep(1); \
    if ((++_sp & 255u) == 0u) { if (xb_ld(&(bar)[XB_TMO])) break; if (_sp > XB_SPIN_CAP) { atomicAdd(&(bar)[XB_TMO], 1u); break; } } } } while (0)

struct XcdBarrier {
    unsigned* bar; unsigned x;
    volatile LAS unsigned* st;
};

__device__ __forceinline__ XcdBarrier xcd_barrier_post(unsigned* bar, volatile LAS unsigned* st) {
    XcdBarrier b; b.bar = bar; b.x = xb_xcc_id(); b.st = st;
    if (threadIdx.x == 0) (void)xb_add(&bar[XB_XCNT(b.x)], 1u);
    return b;
}
__device__ __forceinline__ void xcd_barrier_complete(unsigned* bar, unsigned x, unsigned& nloc, unsigned& nx) {
    const unsigned G = gridDim.x * gridDim.y * gridDim.z;
    unsigned sum, cnt, mine, sp = 0u;
    for (;;) {
        sum = 0u; cnt = 0u; mine = 0u;
#pragma unroll
        for (unsigned j = 0; j < 16; ++j) { const unsigned c = xb_ld(&bar[XB_XCNT(j)]); sum += c; cnt += (c > 0u) ? 1u : 0u; mine = (j == x) ? c : mine; }
        if (sum == G) break;
        __builtin_amdgcn_s_sleep(1);
        if ((++sp & 255u) == 0u) { if (xb_ld(&bar[XB_TMO])) break; if (sp > XB_SPIN_CAP) { atomicAdd(&bar[XB_TMO], 1u); break; } }
    }
    nloc = mine > 0u ? mine : 1u; nx = cnt > 0u ? cnt : 1u;
}

__device__ __forceinline__ void xcd_barrier(const XcdBarrier& b) {
    asm volatile("s_waitcnt vmcnt(0)" ::: "memory");
    __syncthreads();
    if (threadIdx.x == 0) {
        unsigned* bar = b.bar;
        __builtin_amdgcn_s_waitcnt(0);
        unsigned nloc = b.st[0], nx = b.st[1];
        if (nloc == 0u) { xcd_barrier_complete(bar, b.x, nloc, nx); b.st[0] = nloc; b.st[1] = nx; }
        const unsigned old = xb_add(&bar[XB_XSUB(b.x)], 1u);
        const unsigned gen = old / nloc;
        if (old + 1u == (gen + 1u) * nloc) {
            __builtin_amdgcn_fence(__ATOMIC_RELEASE, "agent");
            asm volatile("s_waitcnt vmcnt(0)" ::: "memory");
            const unsigned og = xb_add(&bar[XB_TOP], 1u);
            const unsigned tg = og / nx;
            if (og + 1u == (tg + 1u) * nx) xb_add(&bar[XB_TOPGEN], 1u);
            else XB_SPIN(xb_ld(&bar[XB_TOPGEN]) == tg, bar);
            __builtin_amdgcn_fence(__ATOMIC_ACQUIRE, "agent");
            xb_add(&bar[XB_XGEN(b.x)], 1u);
            asm volatile("s_waitcnt vmcnt(0)" ::: "memory");
        } else {
            XB_SPIN(xb_ld(&bar[XB_XGEN(b.x)]) == gen, bar);
            __builtin_amdgcn_fence(__ATOMIC_ACQUIRE, "agent");
            asm volatile("s_waitcnt vmcnt(0)" ::: "memory");
        }
    }
    __syncthreads();
}
__device__ __forceinline__ int inproj_src_col(int n) {
    if (n < 5120) return n;
    if (n < 6144) return n - 5120 + 5152;
    if (n < 7680) return n - 6144 + 6176;
    if (n < 9728) return n - 7680 + 7760;
    const int i = n - 9728;
    if (i < 32) return 5120 + i;
    if (i < 80) return 7712 + (i - 32);
    return -1;
}
template <int MODE>
__device__ __forceinline__ void transpose_item(const float* W, int K, int ldw, int nblk, bf16* WT, int row_off, LAS float* scr, int item, int lane) {
    const int kb = item / nblk, nb = item % nblk, k0 = 64 * kb, n0 = 32 * nb;
    const int n = n0 + (lane & 31);
    const int sc = (MODE == 1) ? inproj_src_col(n) : n;
#pragma unroll 8
    for (int i = 0; i < 32; ++i) { const int kk = 2 * i + (lane >> 5); scr[kk * 33 + (lane & 31)] = (sc >= 0) ? W[(size_t)(k0 + kk) * ldw + sc] : 0.f; }
    LDS_WAIT(); asm volatile("" ::: "memory");
    const int c = lane & 7;
#pragma unroll
    for (int j = 0; j < 4; ++j) { const int nn = (lane >> 3) + 8 * j; const LAS float* s = scr + (8 * c) * 33 + nn;
        u32x4 o; o.x = pk2(s[0 * 33], s[1 * 33]); o.y = pk2(s[2 * 33], s[3 * 33]); o.z = pk2(s[4 * 33], s[5 * 33]); o.w = pk2(s[6 * 33], s[7 * 33]);
        *(u32x4*)(WT + (size_t)(row_off + n0 + nn) * K + k0 + 8 * c) = o; }
    LDS_WAIT(); asm volatile("" ::: "memory");
}

__device__ __forceinline__ void p0_prologue(const Args& args, LAS unsigned char* lds, int gw, int NGW, int lane, int wave) {
    unsigned char* ws = args.ws;
    const int p0m = args.pad;
    LAS float* scr = (LAS float*)(lds + wave * 16384);
    constexpr int I_IN = 16 * (NPROJ / 32), I_SSM = 32 * 32, I_ATT = 16 * 32, I_OUT = 16 * 32, I_UP = 16 * (DFF2 / 32), I_DN = (DFF / 64) * 32, I_ADA = 16 * (6144 / 32), I_W1 = 16 * 4;
    constexpr int NITEMS = I_IN + I_SSM + I_ATT + I_OUT + I_UP + I_DN + I_ADA + 4 * I_W1;
    if (p0m & 1) for (int it = gw; it < NITEMS; it += NGW) {
        int r = it;
        if (r < I_ADA) { transpose_item<0>(INF(10), 1024, 6144, 6144 / 32, (bf16*)(ws + WS_WADA), 0, scr, r, lane); continue; } r -= I_ADA;
        if (r < I_IN) { transpose_item<1>(INF(15), 1024, 9808, NPROJ / 32, (bf16*)(ws + WS_WIN), 0, scr, r, lane); continue; } r -= I_IN;
        if (r < I_SSM) { transpose_item<0>(INF(28), 2048, 1024, 32, (bf16*)(ws + WS_WSSM), 0, scr, r, lane); continue; } r -= I_SSM;
        if (r < I_ATT) { transpose_item<0>(INF(29), 1024, 1024, 32, (bf16*)(ws + WS_WATT), 0, scr, r, lane); continue; } r -= I_ATT;
        if (r < I_OUT) { transpose_item<0>(INF(30), 1024, 1024, 32, (bf16*)(ws + WS_WOUT), 0, scr, r, lane); continue; } r -= I_OUT;
        if (r < I_UP) { transpose_item<0>(INF(31), 1024, DFF2, DFF2 / 32, (bf16*)(ws + WS_WUP), 0, scr, r, lane); continue; } r -= I_UP;
        if (r < I_DN) { transpose_item<0>(INF(34), DFF, 1024, 32, (bf16*)(ws + WS_WDN), 0, scr, r, lane); continue; } r -= I_DN;
        { const int which = r / I_W1, rr = r % I_W1; const int st = which >> 1, r2 = which & 1;
          transpose_item<0>(INF(st ? 26 : 23) + (size_t)r2 * 16 * 64 * 128, 1024, 128, 4, (bf16*)(ws + (st ? WS_W1V : WS_W1K)), r2 * 128, scr, rr, lane); }
    }
    if (p0m & 4) {
    for (int r = gw; r < 256; r += NGW) {
        bf16* o = (bf16*)(ws + WS_SC) + (size_t)r * 1024;
        const float* src = r < 4 ? INF(2) + (size_t)r * 1024 : (r < 132 ? INF(3) + (size_t)(r - 4) * 1024 : nullptr);
#pragma unroll
        for (int j = 0; j < 4; ++j) { const int c0 = (j * 64 + lane) * 4; f32x4 v = src ? *(const f32x4*)(src + c0) : (f32x4){0.f, 0.f, 0.f, 0.f};
            u32x2 w; w.x = pk2(src ? siluf(v.x) : 0.f, src ? siluf(v.y) : 0.f); w.y = pk2(src ? siluf(v.z) : 0.f, src ? siluf(v.w) : 0.f); *(u32x2*)(o + c0) = w; }
    }
    for (int i = gw * 64 + lane; i < 4096 * 8; i += NGW * 64) {
        const int pos = i >> 3, k = i & 7;
        const float invf[8] = {1.0f, 0.1939227432012558f, 0.03760603070259094f, 0.007292664609849453f, 0.0014142135623842478f, 0.00027424818836152554f, 5.318296098266728e-05f, 1.0313386155758053e-05f};
        float fr = 1.0f;
#pragma unroll
        for (int q = 0; q < 8; ++q) fr = (k == q) ? invf[q] : fr;
        const float ang = (float)pos * fr;
        const double ad = (double)ang, rev = ad * 0.15915494309189535;
        const float fracrev = (float)(rev - __builtin_floor(rev));
        float* o = (float*)(ws + WS_ROPE) + (size_t)pos * 16;
        o[k] = __builtin_amdgcn_cosf(fracrev); o[8 + k] = __builtin_amdgcn_sinf(fracrev);
    }
    for (int it = gw; it < 256; it += NGW) {
        const int st = it >> 7, e = it & 127; const float* pe = INF(st ? 25 : 22); const float* w1 = INF(st ? 26 : 23);
        float s = 0.f;
        for (int i = 0; i < 32; ++i) { const int idx = lane + 64 * i; s += pe[idx] * w1[(size_t)idx * 128 + e]; }
        s = wave_sum(s);
        if (lane == 0) ((float*)(ws + WS_PET))[it] = s;
    }
    }
    if (p0m & 2) {
        const int* pt = (const int*)args.in[5]; const float* cache = INF(4);
        constexpr int NIT = 128 * 2 * 4 * 256;
        const int r = lane >> 3, c = lane & 7;
        for (int it0 = gw; it0 < NIT; it0 += 4 * NGW) {
            f32x4 v[4][2];
#pragma unroll
            for (int k = 0; k < 4; ++k) { const int it = it0 + k * NGW;
                if (it < NIT) { const int tg = it & 255, h = (it >> 8) & 3, s = (it >> 10) & 1, b = it >> 11; const int t = tg * 8 + r; const int page = pt[b * NPAGES + (tg >> 4)];
                    const float* src = cache + (((size_t)page * 128 + (t & 127)) * 4 + s) * 256 + h * 64 + c * 8;
                    v[k][0] = *(const f32x4*)src; v[k][1] = *(const f32x4*)(src + 4); } }
#pragma unroll
            for (int k = 0; k < 4; ++k) { const int it = it0 + k * NGW;
                if (it < NIT) { const int tg = it & 255, h = (it >> 8) & 3, s = (it >> 10) & 1, b = it >> 11;
                    bf16* dst = (bf16*)(ws + (s ? WS_CVB : WS_CKB)) + (((size_t)(b * 4 + h) * 2048 + tg * 8 + r) * 64 + c * 8);
                    u32x4 w; w.x = pk2(v[k][0].x, v[k][0].y); w.y = pk2(v[k][0].z, v[k][0].w); w.z = pk2(v[k][1].x, v[k][1].y); w.w = pk2(v[k][1].z, v[k][1].w); *(u32x4*)dst = w; } }
        }
    }
    if (p0m & 4) for (int i = gw * 64 + lane; i < 2 * 64 * 128; i += NGW * 64) { const int st = i >> 13, d = (i >> 7) & 63, e = i & 127;
        ((bf16*)(ws + WS_W2T))[i] = (bf16)f2bf(INF(st ? 27 : 24)[e * 64 + d]); }
}

template <int WHICH>
__device__ __forceinline__ void norm_mod_phase(const Args& args, int gw, int NGW, int lane) {
    unsigned char* ws = args.ws; const float* MOD = (const float*)(ws + WS_MOD); bf16* H = (bf16*)(ws + WS_H);
    const float* nw = INF(WHICH == 0 ? 12 : (WHICH == 1 ? 13 : 14));
    constexpr int SH = WHICH ? 3072 : 0, SCo = WHICH ? 4096 : 1024;
    for (int grp = gw; grp < MPAD / 4; grp += NGW) {
        const int m0 = grp * 4;
        if (m0 >= MALL) {
            if (WHICH < 2) {
#pragma unroll
                for (int r = 0; r < 4; ++r)
#pragma unroll
                    for (int j = 0; j < 4; ++j) ((u32x2*)(H + (size_t)(m0 + r) * 1024))[j * 64 + lane] = (u32x2){0u, 0u};
            }
            continue; }
        f32x4 v[4][4]; float ss[4];
#pragma unroll
        for (int r = 0; r < 4; ++r) { const int m = m0 + r;
            const float* xr = WHICH ? (const float*)(ws + WS_X1) + (size_t)m * 1024 : (m < MP ? INF(0) + (size_t)m * 1024 : INF(1) + (size_t)(m - MP) * 1024);
            float s = 0.f;
#pragma unroll
            for (int j = 0; j < 4; ++j) { v[r][j] = *(const f32x4*)(xr + (j * 64 + lane) * 4); s += (v[r][j].x * v[r][j].x + v[r][j].y * v[r][j].y) + (v[r][j].z * v[r][j].z + v[r][j].w * v[r][j].w); }
            ss[r] = s; }
#pragma unroll
        for (int o = 1; o < 64; o <<= 1)
#pragma unroll
            for (int r = 0; r < 4; ++r) ss[r] += __shfl_xor(ss[r], o);
        f32x4 w[4];
#pragma unroll
        for (int j = 0; j < 4; ++j) w[j] = *(const f32x4*)(nw + (j * 64 + lane) * 4);
#pragma unroll
        for (int r = 0; r < 4; ++r) { const int m = m0 + r;
            const float rstd = 1.f / sqrtf(ss[r] * (1.f / 1024.f) + EPS);
            if (WHICH == 2) { float* o = args.out + (m < MP ? O_YP + (size_t)m * 1024 : O_YS + (size_t)(m - MP) * 1024);
#pragma unroll
                for (int j = 0; j < 4; ++j) *(f32x4*)(o + (j * 64 + lane) * 4) = (v[r][j] * rstd) * w[j];
            } else {
                const float* mr = MOD + (size_t)(m < MP ? (m >> 12) : 4 + (m - MP)) * 6144;
                u32x2* o = (u32x2*)(H + (size_t)m * 1024);
#pragma unroll
                for (int j = 0; j < 4; ++j) { const int c0 = (j * 64 + lane) * 4;
                    const f32x4 sc = *(const f32x4*)(mr + SCo + c0), sh = *(const f32x4*)(mr + SH + c0);
                    const f32x4 rr = (v[r][j] * rstd) * w[j] * (sc + 1.f) + sh;
                    u32x2 pk; pk.x = pk2(rr.x, rr.y); pk.y = pk2(rr.z, rr.w); o[j * 64 + lane] = pk; }
            }
        }
    }
}
namespace epi {
using pg8::Unit; using pg8::f32x4;
typedef unsigned u32x4 __attribute__((ext_vector_type(4)));
__device__ __forceinline__ u32x4 pack8(const f32x4& a, const f32x4& b) { u32x4 w; w.x = pg8::cvt_pk_bf16(a[0], a[1]); w.y = pg8::cvt_pk_bf16(a[2], a[3]); w.z = pg8::cvt_pk_bf16(b[0], b[1]); w.w = pg8::cvt_pk_bf16(b[2], b[3]); return w; }

struct InProj {
    static constexpr bool PERM = true, AFTER_DRAIN = false;
    unsigned char* ws; float* out;
    __device__ __forceinline__ void operator()(const f32x4 (&acc)[2][2][4][2], const Unit& u, int wr, int wc, int fr, int fq) const {
        const int pn = u.pn;
        const int rowb = u.pm * 256 + wr * 64 + fr;
        const int cl = wc * 32 + 8 * fq;
        if (pn < T_XBC || (pn >= T_MG && pn < T_MISC)) {
            bf16* base = pn < T_XBC ? (bf16*)(ws + WS_Z) : (bf16*)(ws + WS_MG);
            const int colt = (pn < T_XBC ? pn : pn - T_MG) * 256 + cl;
#pragma unroll
            for (int ai = 0; ai < 2; ++ai)
#pragma unroll
                for (int m = 0; m < 4; ++m) { const int row = rowb + ai * 128 + m * 16;
#pragma unroll
                    for (int bj = 0; bj < 2; ++bj) *(u32x4*)(base + (size_t)row * 2048 + colt + bj * 128) = pack8(acc[ai][bj][m][0], acc[ai][bj][m][1]); }
        } else if (pn < T_Q) {
            bf16* base = (bf16*)(ws + WS_XBC); const int colt = (pn - T_XBC) * 256 + cl;
#pragma unroll
            for (int ai = 0; ai < 2; ++ai)
#pragma unroll
                for (int m = 0; m < 4; ++m) { const int row = rowb + ai * 128 + m * 16;
                    float* fo = nullptr;
                    if (row < MP) { const int t = row & 4095; if (t >= 4093) fo = out + O_CONVP + ((size_t)(row >> 12) * 3 + (t - 4093)) * CONVD; }
                    else if (row < MALL) fo = out + O_CONVS + ((size_t)(row - MP) * 3 + 2) * CONVD;
#pragma unroll
                    for (int bj = 0; bj < 2; ++bj) { const int col = colt + bj * 128;
                        *(u32x4*)(base + (size_t)row * CONVD + col) = pack8(acc[ai][bj][m][0], acc[ai][bj][m][1]);
                        if (fo) { *(f32x4*)(fo + col) = acc[ai][bj][m][0]; *(f32x4*)(fo + col + 4) = acc[ai][bj][m][1]; } } }
        } else if (pn < T_MG) {
            const bool isq = pn < T_KV; const int s = pn - T_KV;
            const bool dorope = (isq || !(s & 1)) && !(wc & 1);
            const float* rope = (const float*)(ws + WS_ROPE);
#pragma unroll
            for (int ai = 0; ai < 2; ++ai)
#pragma unroll
                for (int m = 0; m < 4; ++m) { const int row = rowb + ai * 128 + m * 16;
                    const int pos = row < MP ? (row & 4095) : PAST;
#pragma unroll
                    for (int bj = 0; bj < 2; ++bj) {
                        f32x4 v0 = acc[ai][bj][m][0], v1 = acc[ai][bj][m][1];
                        if (dorope) {
                            f32x4 o0, o1;
#pragma unroll
                            for (int i = 0; i < 4; ++i) { o0[i] = __shfl_xor(v0[i], 16); o1[i] = __shfl_xor(v1[i], 16); }
                            if (fq < 2) {
                                const f32x4 c0 = *(const f32x4*)(rope + pos * 16), c1 = *(const f32x4*)(rope + pos * 16 + 4), s0 = *(const f32x4*)(rope + pos * 16 + 8), s1 = *(const f32x4*)(rope + pos * 16 + 12);
                                if (fq == 0) { v0 = v0 * c0 - o0 * s0; v1 = v1 * c1 - o1 * s1; }
                                else         { v0 = v0 * c0 + o0 * s0; v1 = v1 * c1 + o1 * s1; }
                            }
                        }
                        const int col = cl + bj * 128;
                        const u32x4 pk = pack8(v0, v1);
                        if (isq) { *(u32x4*)((bf16*)(ws + WS_Q) + (size_t)row * 1024 + (pn - T_Q) * 256 + col) = pk; }
                        else {
                            const int h = col >> 6, d = col & 63;
                            if (row < MP) {
                                const int b = row >> 12, t = row & 4095;
                                *(u32x4*)((bf16*)(ws + WS_KVH) + ((((size_t)s * 4 + b) * 4 + h) * 4096 + t) * 64 + d) = pk;
                                if (s < 4) { float* fo = out + O_KVP + ((size_t)row * 4 + s) * 256 + col; *(f32x4*)fo = v0; *(f32x4*)(fo + 4) = v1; }
                                else if (t >= 3584) { float* fo = out + O_WINP + (((size_t)b * 512 + (t - 3584)) * 2 + (s - 4)) * 256 + col; *(f32x4*)fo = v0; *(f32x4*)(fo + 4) = v1; }
                                if (s == 3 || s == 5) {
                                    const int kk = t & 31, kpos = 8 * ((kk & 15) >> 2) + 4 * (kk >> 4) + (kk & 3);
                                    bf16* vt = (bf16*)(ws + WS_VT) + ((((size_t)(s == 5) * 4 + b) * 4 + h) * 128 + (t >> 5)) * 2048 + d * 32 + kpos;
                                    vt[0 * 32] = (bf16)(pk.x & 0xffffu); vt[1 * 32] = (bf16)(pk.x >> 16); vt[2 * 32] = (bf16)(pk.y & 0xffffu); vt[3 * 32] = (bf16)(pk.y >> 16);
                                    vt[4 * 32] = (bf16)(pk.z & 0xffffu); vt[5 * 32] = (bf16)(pk.z >> 16); vt[6 * 32] = (bf16)(pk.w & 0xffffu); vt[7 * 32] = (bf16)(pk.w >> 16);
                                }
                            } else if (row < MALL) {
                                const int bs = row - MP;
                                float* fo = s < 4 ? out + O_KVS + ((size_t)bs * 4 + s) * 256 + col : out + O_WINS + (((size_t)bs * 512 + 511) * 2 + (s - 4)) * 256 + col;
                                *(f32x4*)fo = v0; *(f32x4*)(fo + 4) = v1;
                            }
                        }
                    } }
        } else {
            float* base = (float*)(ws + WS_MISC);
#pragma unroll
            for (int ai = 0; ai < 2; ++ai)
#pragma unroll
                for (int m = 0; m < 4; ++m) { const int row = rowb + ai * 128 + m * 16;
                    *(f32x4*)(base + (size_t)row * 128 + cl) = acc[ai][0][m][0]; *(f32x4*)(base + (size_t)row * 128 + cl + 4) = acc[ai][0][m][1]; }
        }
    }
};

struct Merge1 {
    static constexpr bool PERM = true, AFTER_DRAIN = false;
    unsigned char* ws;
    __device__ __forceinline__ void operator()(const f32x4 (&acc)[2][2][4][2], const Unit& u, int wr, int wc, int fr, int fq) const {
        const int rowb = u.pm * 256 + wr * 64 + fr, colb = u.pn * 256 + wc * 32 + 8 * fq;
        const bf16* MG = (const bf16*)(ws + WS_MG); const float* SSQ = (const float*)(ws + WS_SSQ); float* T = (float*)(ws + WS_TMPM);
#pragma unroll
        for (int ai = 0; ai < 2; ++ai)
#pragma unroll
            for (int m = 0; m < 4; ++m) { const int row = rowb + ai * 128 + m * 16;
                const f32x4 sq = *(const f32x4*)(SSQ + (size_t)row * 4);
                const float rstd = 1.f / sqrtf(((sq.x + sq.y) + (sq.z + sq.w)) * (1.f / 2048.f) + EPS);
#pragma unroll
                for (int bj = 0; bj < 2; ++bj) { const int col = colb + bj * 128;
                    const u32x4 g = *(const u32x4*)(MG + (size_t)row * 2048 + col);
                    f32x4 o0, o1;
                    o0[0] = sigmf(bflo(g.x)) * rstd * acc[ai][bj][m][0][0]; o0[1] = sigmf(bfhi(g.x)) * rstd * acc[ai][bj][m][0][1];
                    o0[2] = sigmf(bflo(g.y)) * rstd * acc[ai][bj][m][0][2]; o0[3] = sigmf(bfhi(g.y)) * rstd * acc[ai][bj][m][0][3];
                    o1[0] = sigmf(bflo(g.z)) * rstd * acc[ai][bj][m][1][0]; o1[1] = sigmf(bfhi(g.z)) * rstd * acc[ai][bj][m][1][1];
                    o1[2] = sigmf(bflo(g.w)) * rstd * acc[ai][bj][m][1][2]; o1[3] = sigmf(bfhi(g.w)) * rstd * acc[ai][bj][m][1][3];
                    *(f32x4*)(T + (size_t)row * 1024 + col) = o0; *(f32x4*)(T + (size_t)row * 1024 + col + 4) = o1; } }
    }
};
struct Merge2 {
    static constexpr bool PERM = true, AFTER_DRAIN = false;
    unsigned char* ws;
    __device__ __forceinline__ void operator()(const f32x4 (&acc)[2][2][4][2], const Unit& u, int wr, int wc, int fr, int fq) const {
        const int rowb = u.pm * 256 + wr * 64 + fr, colb = u.pn * 256 + wc * 32 + 8 * fq;
        const bf16* MG = (const bf16*)(ws + WS_MG); const float* T = (const float*)(ws + WS_TMPM); bf16* O = (bf16*)(ws + WS_MERGED);
#pragma unroll
        for (int ai = 0; ai < 2; ++ai)
#pragma unroll
            for (int m = 0; m < 4; ++m) { const int row = rowb + ai * 128 + m * 16;
#pragma unroll
                for (int bj = 0; bj < 2; ++bj) { const int col = colb + bj * 128;
                    const u32x4 g = *(const u32x4*)(MG + (size_t)row * 2048 + 1024 + col);
                    f32x4 o0 = *(const f32x4*)(T + (size_t)row * 1024 + col), o1 = *(const f32x4*)(T + (size_t)row * 1024 + col + 4);
                    o0[0] += sigmf(bflo(g.x)) * acc[ai][bj][m][0][0]; o0[1] += sigmf(bfhi(g.x)) * acc[ai][bj][m][0][1];
                    o0[2] += sigmf(bflo(g.y)) * acc[ai][bj][m][0][2]; o0[3] += sigmf(bfhi(g.y)) * acc[ai][bj][m][0][3];
                    o1[0] += sigmf(bflo(g.z)) * acc[ai][bj][m][1][0]; o1[1] += sigmf(bfhi(g.z)) * acc[ai][bj][m][1][1];
                    o1[2] += sigmf(bflo(g.w)) * acc[ai][bj][m][1][2]; o1[3] += sigmf(bfhi(g.w)) * acc[ai][bj][m][1][3];
                    *(u32x4*)(O + (size_t)row * 1024 + col) = pack8(o0, o1); } }
    }
};
struct Resid {
    static constexpr bool PERM = false, AFTER_DRAIN = false;
    const float* xp; const float* xs; const float* x1in; float* x1out; const float* MOD; int goff;
    __device__ __forceinline__ void operator()(const f32x4 (&acc)[2][2][4][2], const Unit& u, int wr, int wc, int fr, int fq) const {
        const int rowb = u.pm * 256 + wr * 64 + fr, colb = u.pn * 256 + wc * 32 + 4 * fq;
#pragma unroll
        for (int ai = 0; ai < 2; ++ai)
#pragma unroll
            for (int m = 0; m < 4; ++m) { const int row = rowb + ai * 128 + m * 16;
                if (row >= MALL) continue;
                const float* base = x1in ? x1in + (size_t)row * 1024 : (row < MP ? xp + (size_t)row * 1024 : xs + (size_t)(row - MP) * 1024);
                const float* gr = MOD + (size_t)(row < MP ? (row >> 12) : 4 + (row - MP)) * 6144 + goff;
#pragma unroll
                for (int bj = 0; bj < 2; ++bj)
#pragma unroll
                    for (int n = 0; n < 2; ++n) { const int col = colb + bj * 128 + n * 16;
                        *(f32x4*)(x1out + (size_t)row * 1024 + col) = *(const f32x4*)(base + col) + *(const f32x4*)(gr + col) * acc[ai][bj][m][n]; } }
    }
};
struct Up {
    static constexpr bool PERM = true, AFTER_DRAIN = false;
    unsigned char* ws; float* out;
    __device__ __forceinline__ void operator()(const f32x4 (&acc)[2][2][4][2], const Unit& u, int wr, int wc, int fr, int fq) const {
        const int rowb = u.pm * 256 + wr * 64 + fr, colb = u.pn * 256 + wc * 32 + 8 * fq;
        bf16* U = (bf16*)(ws + WS_U);
#pragma unroll
        for (int ai = 0; ai < 2; ++ai)
#pragma unroll
            for (int m = 0; m < 4; ++m) { const int row = rowb + ai * 128 + m * 16;
                float* fo = nullptr;
                if (row < MP) { const int t = row & 4095; if (t >= 4094) fo = out + O_FFNP + ((size_t)(row >> 12) * 2 + (t - 4094)) * DFF2; }
                else if (row < MALL) fo = out + O_FFNS + ((size_t)(row - MP) * 2 + 1) * DFF2;
#pragma unroll
                for (int bj = 0; bj < 2; ++bj) { const int col = colb + bj * 128;
                    *(u32x4*)(U + (size_t)row * DFF2 + col) = pack8(acc[ai][bj][m][0], acc[ai][bj][m][1]);
                    if (fo) { *(f32x4*)(fo + col) = acc[ai][bj][m][0]; *(f32x4*)(fo + col + 4) = acc[ai][bj][m][1]; } } }
    }
};
}
__device__ __forceinline__ void conv_prompt_item(const Args& args, int item, int lane) {
    unsigned char* ws = args.ws;
    const int tg = item / 48, cgp = item % 48, cg = lane & 7, rg = lane >> 3;
    const int m0 = tg * 64 + 8 * rg, b = m0 >> 12, t0 = m0 & 4095, ch0 = cgp * 64 + 8 * cg;
    const bf16* X = (const bf16*)(ws + WS_XBC);
    float x[11][8];
#pragma unroll
    for (int i = 0; i < 11; ++i) {
        const int t = t0 - 3 + i;
        u32x4 v = (u32x4){0u, 0u, 0u, 0u};
        if (t >= 0) v = *(const u32x4*)(X + (size_t)(m0 - 3 + i) * CONVD + ch0);
        x[i][0] = bflo(v.x); x[i][1] = bfhi(v.x); x[i][2] = bflo(v.y); x[i][3] = bfhi(v.y); x[i][4] = bflo(v.z); x[i][5] = bfhi(v.z); x[i][6] = bflo(v.w); x[i][7] = bfhi(v.w);
    }
    const float* cw = INF(16); const float* cb = INF(17);
    float w[4][8], bias[8];
#pragma unroll
    for (int k = 0; k < 4; ++k) { const f32x4 a = *(const f32x4*)(cw + k * CONVD + ch0), c = *(const f32x4*)(cw + k * CONVD + ch0 + 4);
        w[k][0] = a.x; w[k][1] = a.y; w[k][2] = a.z; w[k][3] = a.w; w[k][4] = c.x; w[k][5] = c.y; w[k][6] = c.z; w[k][7] = c.w; }
    { const f32x4 a = *(const f32x4*)(cb + ch0), c = *(const f32x4*)(cb + ch0 + 4); bias[0] = a.x; bias[1] = a.y; bias[2] = a.z; bias[3] = a.w; bias[4] = c.x; bias[5] = c.y; bias[6] = c.z; bias[7] = c.w; }
    float y[8][8];
#pragma unroll
    for (int i = 0; i < 8; ++i)
#pragma unroll
        for (int c = 0; c < 8; ++c) { const float a = bias[c] + w[0][c] * x[i][c] + w[1][c] * x[i + 1][c] + w[2][c] * x[i + 2][c] + w[3][c] * x[i + 3][c]; y[i][c] = siluf(a); }
    if (cgp < 32) {
        bf16* XT = (bf16*)(ws + WS_XT) + ((size_t)(b * 32 + cgp) * 128 + (t0 >> 5)) * 2048 + (8 * cg) * 32 + (t0 & 31);
#pragma unroll
        for (int c = 0; c < 8; ++c) { u32x4 o; o.x = pk2(y[0][c], y[1][c]); o.y = pk2(y[2][c], y[3][c]); o.z = pk2(y[4][c], y[5][c]); o.w = pk2(y[6][c], y[7][c]); *(u32x4*)(XT + (size_t)c * 32) = o; }
    } else {
        const int isC = cgp >= 40, gg = ((cgp - 32) & 7) >> 1, n0 = ((cgp - 32) & 1) * 64 + 8 * cg;
        bf16* N = (bf16*)(ws + (isC ? WS_CN : WS_BN)) + ((size_t)(b * 4 + gg) * 4096 + t0) * 128 + n0;
#pragma unroll
        for (int i = 0; i < 8; ++i) { u32x4 o; o.x = pk2(y[i][0], y[i][1]); o.y = pk2(y[i][2], y[i][3]); o.z = pk2(y[i][4], y[i][5]); o.w = pk2(y[i][6], y[i][7]); *(u32x4*)(N + (size_t)i * 128) = o; }
        if (!isC) {
            bf16* BT = (bf16*)(ws + WS_BT) + ((size_t)(b * 4 + gg) * 128 + (t0 >> 5)) * 4096 + n0 * 32 + (t0 & 31);
#pragma unroll
            for (int c = 0; c < 8; ++c) { u32x4 o; o.x = pk2(y[0][c], y[1][c]); o.y = pk2(y[2][c], y[3][c]); o.z = pk2(y[4][c], y[5][c]); o.w = pk2(y[6][c], y[7][c]); *(u32x4*)(BT + (size_t)c * 32) = o; }
        }
    }
}
__device__ __forceinline__ void dtcs_item(const Args& args, int item, int lane) {
    unsigned char* ws = args.ws;
    const int c = item & 31, h = (item >> 5) & 31, b = item >> 10;
    const float* MISC = (const float*)(ws + WS_MISC);
    const float bias = INF(18)[h], a = -__expf(INF(19)[h]);
    const int t = c * 128 + 2 * lane; const size_t m = (size_t)b * 4096 + t;
    const float d0 = softplusf(MISC[m * 128 + h] + bias), d1 = softplusf(MISC[(m + 1) * 128 + h] + bias);
    const float a0 = d0 * a, a1 = d1 * a;
    float s = a0 + a1;
#pragma unroll
    for (int o = 1; o < 64; o <<= 1) { const float v = __shfl_up(s, o); if (lane >= o) s += v; }
    const float c1 = s, c0 = s - a1;
    float* DT = (float*)(ws + WS_DT) + (size_t)(b * 32 + h) * 4096 + t; float* CS = (float*)(ws + WS_CS) + (size_t)(b * 32 + h) * 4096 + t;
    *(f32x2*)DT = (f32x2){d0, d1}; *(f32x2*)CS = (f32x2){c0, c1};
}
__device__ __forceinline__ void sample_conv(const Args& args, int gt, int NGT) {
    unsigned char* ws = args.ws; float* out = args.out;
    const float* st = INF(8); const float* cw = INF(16); const float* cb = INF(17);
    for (int i = gt; i < MS * CONVD; i += NGT) {
        const int bs = i / CONVD, ch = i % CONVD;
        const float s0 = st[((size_t)bs * 3 + 0) * CONVD + ch], s1 = st[((size_t)bs * 3 + 1) * CONVD + ch], s2 = st[((size_t)bs * 3 + 2) * CONVD + ch];
        const float xn = out[O_CONVS + ((size_t)bs * 3 + 2) * CONVD + ch];
        out[O_CONVS + ((size_t)bs * 3 + 0) * CONVD + ch] = s1; out[O_CONVS + ((size_t)bs * 3 + 1) * CONVD + ch] = s2;
        const float a = cb[ch] + cw[ch] * s0 + cw[CONVD + ch] * s1 + cw[2 * CONVD + ch] * s2 + cw[3 * CONVD + ch] * xn;
        ((float*)(ws + WS_XCS))[i] = siluf(a);
    }
    for (int i = gt; i < MS * NH; i += NGT) { const int bs = i >> 5, h = i & 31;
        ((float*)(ws + WS_DTS))[i] = softplusf(((const float*)(ws + WS_MISC))[(size_t)(MP + bs) * 128 + h] + INF(18)[h]); }
}

struct SFrag { u32x4 x[4]; bf16x8 b[4]; };
__device__ __forceinline__ void ssd_states_load(const bf16* XT, const bf16* BT, int nh, int ks, int q, int r16, SFrag& F) {
#pragma unroll
    for (int pt = 0; pt < 4; ++pt) F.x[pt] = *(const u32x4*)(XT + (size_t)ks * 2048 + (16 * pt + r16) * 32 + 8 * q);
#pragma unroll
    for (int nt = 0; nt < 4; ++nt) F.b[nt] = *(const bf16x8*)(BT + (size_t)ks * 4096 + (64 * nh + 16 * nt + r16) * 32 + 8 * q);
}
__device__ __forceinline__ void ssd_states_step(const LAS float* wl, int ks, int q, const SFrag& F, f32x4 (&acc)[4][4]) {
    const int s0 = 32 * ks + 8 * q;
    const f32x4 w0 = *(const LAS f32x4*)(wl + s0), w1 = *(const LAS f32x4*)(wl + s0 + 4);
    bf16x8 af[4];
#pragma unroll
    for (int pt = 0; pt < 4; ++pt) { const u32x4 v = F.x[pt];
        u32x4 o; o.x = pk2(bflo(v.x) * w0.x, bfhi(v.x) * w0.y); o.y = pk2(bflo(v.y) * w0.z, bfhi(v.y) * w0.w); o.z = pk2(bflo(v.z) * w1.x, bfhi(v.z) * w1.y); o.w = pk2(bflo(v.w) * w1.z, bfhi(v.w) * w1.w);
        af[pt] = __builtin_bit_cast(bf16x8, o); }
#pragma unroll
    for (int nt = 0; nt < 4; ++nt)
#pragma unroll
        for (int pt = 0; pt < 4; ++pt) acc[pt][nt] = MFMA16(af[pt], F.b[nt], acc[pt][nt]);
}
__device__ __forceinline__ void ssd_states_unit(const Args& args, LAS unsigned char* lds, int unit, int wave, int lane) {
    unsigned char* ws = args.ws;
    const int g = unit & 3, c = (unit >> 2) & 31, b = unit >> 7, h = g * 8 + wave, q = lane >> 4, r16 = lane & 15;
    LAS float* wl = (LAS float*)(lds + wave * 512);
    const float* DT = (const float*)(ws + WS_DT) + (size_t)(b * 32 + h) * 4096 + c * 128; const float* CS = (const float*)(ws + WS_CS) + (size_t)(b * 32 + h) * 4096 + c * 128;
    const float cl = CS[127];
    wl[lane] = DT[lane] * __expf(cl - CS[lane]); wl[lane + 64] = DT[lane + 64] * __expf(cl - CS[lane + 64]);
    LDS_WAIT(); asm volatile("" ::: "memory");
    const bf16* XT = (const bf16*)(ws + WS_XT) + ((size_t)(b * 32 + h) * 128 + c * 4) * 2048;
    const bf16* BT = (const bf16*)(ws + WS_BT) + ((size_t)(b * 4 + g) * 128 + c * 4) * 4096;
    float* ST = (float*)(ws + WS_STATES) + (((size_t)(b * 32 + c) * 32 + h) * 64) * 128;
    SFrag FA, FB;
    ssd_states_load(XT, BT, 0, 0, q, r16, FA);
#pragma unroll 1
    for (int nh = 0; nh < 2; ++nh) {
        f32x4 acc[4][4];
#pragma unroll
        for (int i = 0; i < 4; ++i)
#pragma unroll
            for (int j = 0; j < 4; ++j) acc[i][j] = (f32x4){0.f, 0.f, 0.f, 0.f};
        ssd_states_load(XT, BT, nh, 1, q, r16, FB); ssd_states_step(wl, 0, q, FA, acc);
        ssd_states_load(XT, BT, nh, 2, q, r16, FA); ssd_states_step(wl, 1, q, FB, acc);
        ssd_states_load(XT, BT, nh, 3, q, r16, FB); ssd_states_step(wl, 2, q, FA, acc);
        if (nh == 0) ssd_states_load(XT, BT, 1, 0, q, r16, FA);
        ssd_states_step(wl, 3, q, FB, acc);
#pragma unroll
        for (int pt = 0; pt < 4; ++pt)
#pragma unroll
            for (int nt = 0; nt < 4; ++nt)
#pragma unroll
                for (int r = 0; r < 4; ++r) ST[(size_t)(16 * pt + 4 * q + r) * 128 + 64 * nh + 16 * nt + r16] = acc[pt][nt][r];
    }
}

template <int SAMPLE>
__device__ __forceinline__ void compress2_item(const Args& args, int item, int lane) {
    unsigned char* ws = args.ws;
    const int q = lane >> 4, r16 = lane & 15;
    constexpr int NPB = SAMPLE ? 128 : 256;
    constexpr int NI = (SAMPLE ? 65536 : 4096) / 16;
    const int st = item / NI, row0 = (item % NI) * 16;
    const float* P = (const float*)(ws + (SAMPLE ? (st ? WS_PARTSV : WS_PARTSK) : (st ? WS_PARTV : WS_PARTK))) + (size_t)(row0 + r16) * 256;
    const float* pet = (const float*)(ws + WS_PET) + st * 128;
    const bf16* W2T = (const bf16*)(ws + WS_W2T) + st * 8192;
    f32x4 acc[4];
#pragma unroll
    for (int dt = 0; dt < 4; ++dt) acc[dt] = (f32x4){0.f, 0.f, 0.f, 0.f};
#pragma unroll
    for (int ks = 0; ks < 4; ++ks) {
        const int e0 = 32 * ks + 8 * q;
        const f32x4 a0 = *(const f32x4*)(P + e0), a1 = *(const f32x4*)(P + e0 + 4), b0 = *(const f32x4*)(P + 256 + 128 + e0), b1 = *(const f32x4*)(P + 256 + 128 + e0 + 4);
        const f32x4 p0 = *(const f32x4*)(pet + e0), p1 = *(const f32x4*)(pet + e0 + 4);
        const f32x4 h0 = a0 + b0 + p0, h1 = a1 + b1 + p1;
        u32x4 o; o.x = pk2(siluf(h0.x), siluf(h0.y)); o.y = pk2(siluf(h0.z), siluf(h0.w)); o.z = pk2(siluf(h1.x), siluf(h1.y)); o.w = pk2(siluf(h1.z), siluf(h1.w));
        const bf16x8 af = __builtin_bit_cast(bf16x8, o);
#pragma unroll
        for (int dt = 0; dt < 4; ++dt) { const bf16x8 bf = *(const bf16x8*)(W2T + (size_t)(16 * dt + r16) * 128 + e0); acc[dt] = MFMA16(af, bf, acc[dt]); }
    }
    const int bh = row0 / NPB, n0 = row0 % NPB + 4 * q;
#pragma unroll
    for (int dt = 0; dt < 4; ++dt) {
        const int d = 16 * dt + r16;
        float v[4];
#pragma unroll
        for (int r = 0; r < 4; ++r) v[r] = (n0 + r < NPB - 1) ? acc[dt][r] : 0.f;
        if (SAMPLE) {
            float* o = (float*)(ws + (st ? WS_VCS : WS_KCS)) + ((size_t)bh * 128 + n0) * 64 + d;
#pragma unroll
            for (int r = 0; r < 4; ++r) o[r * 64] = v[r];
        } else if (st == 0) {
            bf16* o = (bf16*)(ws + WS_KC) + ((size_t)bh * 256 + n0) * 64 + d;
#pragma unroll
            for (int r = 0; r < 4; ++r) o[r * 64] = (bf16)f2bf(v[r]);
        } else {
            u32x2 w; w.x = pk2(v[0], v[1]); w.y = pk2(v[2], v[3]);
            *(u32x2*)((bf16*)(ws + WS_VCT) + ((size_t)bh * 8 + (n0 >> 5)) * 2048 + d * 32 + 8 * ((n0 & 15) >> 2) + 4 * ((n0 & 31) >> 4)) = w;
        }
    }
}

__device__ __forceinline__ void sample_ssm_item(const Args& args, LAS unsigned char* lds, int item, int wave, int lane) {
    unsigned char* ws = args.ws; float* out = args.out;
    const int h = item & 31, bs = item >> 5, g = h >> 3, rs = lane >> 5, nc = lane & 31;
    const float* XC = (const float*)(ws + WS_XCS) + (size_t)bs * CONVD;
    const float dt = ((const float*)(ws + WS_DTS))[bs * 32 + h], a = -__expf(INF(19)[h]), dec = __expf(dt * a), Dh = INF(20)[h];
    const f32x4 Bv = *(const f32x4*)(XC + 2048 + g * 128 + 4 * nc) * dt, Cv = *(const f32x4*)(XC + 2560 + g * 128 + 4 * nc);
    const float xl = XC[h * 64 + lane];
    const size_t m = MP + bs;
    const float zl = bf2f(((const bf16*)(ws + WS_Z))[m * 2048 + h * 64 + lane]), nwl = INF(21)[h * 64 + lane];
    const float* H0 = INF(7) + ((size_t)(bs * 32 + h) * 64) * 128 + 4 * nc; float* HN = out + O_SSMS + ((size_t)(bs * 32 + h) * 64) * 128 + 4 * nc;
    const bool b4 = (lane & 16) != 0, b3 = (lane & 8) != 0, b2 = (lane & 4) != 0;
    float yl = 0.f;
#pragma unroll 1
    for (int bt = 0; bt < 4; ++bt) {
        f32x4 h0[8];
#pragma unroll
        for (int k = 0; k < 8; ++k) h0[k] = *(const f32x4*)(H0 + (size_t)(2 * (8 * bt + k) + rs) * 128);
        float v[8];
#pragma unroll
        for (int k = 0; k < 8; ++k) { const int p = 2 * (8 * bt + k) + rs;
            const float xp = __shfl(xl, p);
            const f32x4 hn = h0[k] * dec + Bv * xp;
            *(f32x4*)(HN + (size_t)p * 128) = hn;
            v[k] = (hn.x * Cv.x + hn.y * Cv.y) + (hn.z * Cv.z + hn.w * Cv.w); }
        float a4[4], a2[2];
#pragma unroll
        for (int i = 0; i < 4; ++i) a4[i] = (b4 ? v[4 + i] : v[i]) + __shfl_xor(b4 ? v[i] : v[4 + i], 16);
#pragma unroll
        for (int i = 0; i < 2; ++i) a2[i] = (b3 ? a4[2 + i] : a4[i]) + __shfl_xor(b3 ? a4[i] : a4[2 + i], 8);
        float c = (b2 ? a2[1] : a2[0]) + __shfl_xor(b2 ? a2[0] : a2[1], 4);
        c += __shfl_xor(c, 2); c += __shfl_xor(c, 1);
        const int pl = lane - 16 * bt;
        const int kk = (pl >> 1) & 7, src = ((pl & 1) << 5) | ((kk & 4) << 2) | ((kk & 2) << 2) | ((kk & 1) << 2);
        const float got = __shfl(c, src & 63);
        if (pl >= 0 && pl < 16) yl = got;
    }
    const float y = yl + Dh * xl;
    const float vv = y * siluf(zl);
    ((bf16*)(ws + WS_YSSM))[m * 2048 + h * 64 + lane] = (bf16)f2bf(vv * nwl);
    const float ss = wave_sum(vv * vv);
    if (lane == 0) ((float*)(ws + WS_MISC))[m * 128 + 80 + h] = ss;
}
__device__ __forceinline__ void scan_phase(const Args& args, int gt, int NGT) {
    unsigned char* ws = args.ws; float* out = args.out;
    for (int i = gt; i < 4 * 32 * 64 * 32; i += NGT) {
        const int n4 = i & 31, p = (i >> 5) & 63, h = (i >> 11) & 31, b = i >> 16;
        const float* CS = (const float*)(ws + WS_CS) + (size_t)(b * 32 + h) * 4096;
        f32x4 run = (f32x4){0.f, 0.f, 0.f, 0.f};
#pragma unroll 4
        for (int c = 0; c < 32; ++c) {
            const size_t off = ((((size_t)(b * 32 + c) * 32 + h) * 64 + p) * 128) + 4 * n4;
            const f32x4 st = *(const f32x4*)((const float*)(ws + WS_STATES) + off);
            u32x2 o; o.x = pk2(run.x, run.y); o.y = pk2(run.z, run.w);
            *(u32x2*)((bf16*)(ws + WS_HPREV) + off) = o;
            const float dec = __expf(CS[c * 128 + 127]);
            run = run * dec + st;
        }
        *(f32x4*)(out + O_SSMP + (((size_t)(b * 32 + h) * 64 + p) * 128) + 4 * n4) = run;
    }
    for (int i = gt; i < MS * 4; i += NGT) { const int bs = i >> 2, g = i & 3; const float* p = (const float*)(ws + WS_MISC) + (size_t)(MP + bs) * 128 + 80 + g * 8;
        ((float*)(ws + WS_SSQ))[(size_t)(MP + bs) * 4 + g] = ((p[0] + p[1]) + (p[2] + p[3])) + ((p[4] + p[5]) + (p[6] + p[7])); }
}

constexpr int CNL_PITCH = 136;
struct DFrag { bf16x8 x[4]; f32x4 csa, csb, dta, dtb; };
__device__ __forceinline__ void ssd_out_load(const bf16* XT, const float* CS, const float* DT, int i, int q, int r16, DFrag& F) {
    const int sa = 32 * i + 4 * q, sb = sa + 16;
    F.csa = *(const f32x4*)(CS + sa); F.csb = *(const f32x4*)(CS + sb); F.dta = *(const f32x4*)(DT + sa); F.dtb = *(const f32x4*)(DT + sb);
#pragma unroll
    for (int pt = 0; pt < 4; ++pt) { const bf16* xr = XT + (size_t)i * 2048 + (16 * pt + r16) * 32 + 4 * q; const u32x2 lo = *(const u32x2*)xr, hi = *(const u32x2*)(xr + 16);
        F.x[pt] = __builtin_bit_cast(bf16x8, (u32x4){lo.x, lo.y, hi.x, hi.y}); }
}
template <int HL, int I>
__device__ __forceinline__ void ssd_out_diag(const LAS float* CBT, const DFrag& F, const float (&csl)[4], float Dh, int q, int r16, int lane, f32x4 (&acc)[4][4]) {
    const int sa = 32 * I + 4 * q, sb = sa + 16;
#pragma unroll
    for (int lt = 0; lt < 4; ++lt) {
        constexpr int dummy = 0; (void)dummy;
        const int LT = 4 * HL + lt;
        if (LT < 2 * I) continue;
        const int l = 16 * LT + r16;
        float ga[4], gb[4];
#pragma unroll
        for (int r = 0; r < 4; ++r) {
            const float va = CBT[(((2 * I) * 8 + LT) * 4 + r) * 64 + lane];
            const float vb = (LT >= 2 * I + 1) ? CBT[(((2 * I + 1) * 8 + LT) * 4 + r) * 64 + lane] : 0.f;
            const int s1 = sa + r, s2 = sb + r;
            float x1 = (l >= s1) ? va * __expf(csl[lt] - F.csa[r]) * F.dta[r] : 0.f;
            float x2 = (l >= s2) ? vb * __expf(csl[lt] - F.csb[r]) * F.dtb[r] : 0.f;
            if (l == s1) x1 += Dh;
            if (l == s2) x2 += Dh;
            ga[r] = x1; gb[r] = x2;
        }
        u32x4 o; o.x = pk2(ga[0], ga[1]); o.y = pk2(ga[2], ga[3]); o.z = pk2(gb[0], gb[1]); o.w = pk2(gb[2], gb[3]);
        const bf16x8 bf = __builtin_bit_cast(bf16x8, o);
#pragma unroll
        for (int pt = 0; pt < 4; ++pt) acc[pt][lt] = MFMA16(F.x[pt], bf, acc[pt][lt]);
    }
}
template <int HL>
__device__ __forceinline__ void ssd_out_half(const Args& args, const LAS float* CBT, const LAS bf16* CnL, LAS float* SQ, const bf16x8 (&hp)[16], const bf16* XT, const float* CS, const float* DT,
                                             float Dh, int b, int c, int h, int wave, int q, int r16, int lane) {
    unsigned char* ws = args.ws;
    float csl[4];
#pragma unroll
    for (int lt = 0; lt < 4; ++lt) csl[lt] = CS[64 * HL + 16 * lt + r16];
    DFrag FA, FB;
    ssd_out_load(XT, CS, DT, 0, q, r16, FA);
    f32x4 acc[4][4];
#pragma unroll
    for (int i = 0; i < 4; ++i)
#pragma unroll
        for (int j = 0; j < 4; ++j) acc[i][j] = (f32x4){0.f, 0.f, 0.f, 0.f};
#pragma unroll
    for (int ks = 0; ks < 4; ++ks)
#pragma unroll
        for (int lt = 0; lt < 4; ++lt) { const bf16x8 bf = *(const LAS bf16x8*)(CnL + (64 * HL + 16 * lt + r16) * CNL_PITCH + 32 * ks + 8 * q);
#pragma unroll
            for (int pt = 0; pt < 4; ++pt) acc[pt][lt] = MFMA16(hp[ks * 4 + pt], bf, acc[pt][lt]); }
#pragma unroll
    for (int lt = 0; lt < 4; ++lt) { const float e = __expf(csl[lt]);
#pragma unroll
        for (int pt = 0; pt < 4; ++pt) acc[pt][lt] = acc[pt][lt] * e; }
    ssd_out_load(XT, CS, DT, 1, q, r16, FB);
    ssd_out_diag<HL, 0>(CBT, FA, csl, Dh, q, r16, lane, acc);
    if (HL == 1) ssd_out_load(XT, CS, DT, 2, q, r16, FA);
    ssd_out_diag<HL, 1>(CBT, FB, csl, Dh, q, r16, lane, acc);
    if (HL == 1) {
        ssd_out_load(XT, CS, DT, 3, q, r16, FB);
        ssd_out_diag<HL, 2>(CBT, FA, csl, Dh, q, r16, lane, acc);
        ssd_out_diag<HL, 3>(CBT, FB, csl, Dh, q, r16, lane, acc);
    }
    const bf16* Z = (const bf16*)(ws + WS_Z); bf16* Y = (bf16*)(ws + WS_YSSM); const float* nw = INF(21) + h * 64;
    u32x2 zz[4][4];
#pragma unroll
    for (int lt = 0; lt < 4; ++lt)
#pragma unroll
        for (int pt = 0; pt < 4; ++pt) zz[lt][pt] = *(const u32x2*)(Z + ((size_t)b * 4096 + c * 128 + 64 * HL + 16 * lt + r16) * 2048 + h * 64 + 16 * pt + 4 * q);
#pragma unroll
    for (int lt = 0; lt < 4; ++lt) {
        const size_t m = (size_t)b * 4096 + c * 128 + 64 * HL + 16 * lt + r16;
        float ss = 0.f;
#pragma unroll
        for (int pt = 0; pt < 4; ++pt) {
            const int ch = 16 * pt + 4 * q;
            const f32x4 w = *(const f32x4*)(nw + ch);
            const float v0 = acc[pt][lt][0] * siluf(bflo(zz[lt][pt].x)), v1 = acc[pt][lt][1] * siluf(bfhi(zz[lt][pt].x)), v2 = acc[pt][lt][2] * siluf(bflo(zz[lt][pt].y)), v3 = acc[pt][lt][3] * siluf(bfhi(zz[lt][pt].y));
            ss += (v0 * v0 + v1 * v1) + (v2 * v2 + v3 * v3);
            u32x2 o; o.x = pk2(v0 * w.x, v1 * w.y); o.y = pk2(v2 * w.z, v3 * w.w);
            *(u32x2*)(Y + m * 2048 + h * 64 + ch) = o;
        }
        ss += __shfl_xor(ss, 16); ss += __shfl_xor(ss, 32);
        if (q == 0) SQ[wave * 128 + 64 * HL + 16 * lt + r16] = ss;
    }
}
__device__ __forceinline__ void ssd_out_unit(const Args& args, LAS unsigned char* lds, int unit, int wave, int lane_in, int tid) {
    int lane = lane_in; asm volatile("" : "+v"(lane));
    unsigned char* ws = args.ws;
    const int g = unit & 3, c = (unit >> 2) & 31, b = unit >> 7, h = g * 8 + wave, q = lane >> 4, r16 = lane & 15;
    LAS float* CBT = (LAS float*)lds; LAS bf16* CnL = (LAS bf16*)(lds + 65536); LAS float* SQ = (LAS float*)(lds + 65536 + 128 * CNL_PITCH * 2);
    const bf16* Bn = (const bf16*)(ws + WS_BN) + ((size_t)(b * 4 + g) * 4096 + c * 128) * 128;
    const bf16* Cn = (const bf16*)(ws + WS_CN) + ((size_t)(b * 4 + g) * 4096 + c * 128) * 128;
    {
        u32x4 cv[4];
#pragma unroll
        for (int i = 0; i < 4; ++i) cv[i] = *(const u32x4*)(Cn + (size_t)(wave * 64 + lane + 512 * i) * 8);
        bf16x8 bnf[4], hp[16];
#pragma unroll
        for (int ks = 0; ks < 4; ++ks) bnf[ks] = *(const bf16x8*)(Bn + (size_t)(16 * wave + r16) * 128 + 32 * ks + 8 * q);
        const bf16* HP = (const bf16*)(ws + WS_HPREV) + (((size_t)(b * 32 + c) * 32 + h) * 64) * 128;
#pragma unroll
        for (int ks = 0; ks < 4; ++ks)
#pragma unroll
            for (int pt = 0; pt < 4; ++pt) hp[ks * 4 + pt] = *(const bf16x8*)(HP + (size_t)(16 * pt + r16) * 128 + 32 * ks + 8 * q);
#pragma unroll
        for (int i = 0; i < 4; ++i) { const int id = wave * 64 + lane + 512 * i; *(LAS u32x4*)(CnL + (id >> 4) * CNL_PITCH + (id & 15) * 8) = cv[i]; }
        __syncthreads();
        for (int lt = wave; lt < 8; ++lt) {
            f32x4 d = (f32x4){0.f, 0.f, 0.f, 0.f};
#pragma unroll
            for (int ks = 0; ks < 4; ++ks) { const bf16x8 bf = *(const LAS bf16x8*)(CnL + (16 * lt + r16) * CNL_PITCH + 32 * ks + 8 * q); d = MFMA16(bnf[ks], bf, d); }
#pragma unroll
            for (int r = 0; r < 4; ++r) CBT[((wave * 8 + lt) * 4 + r) * 64 + lane] = d[r];
        }
        __syncthreads();
        const float* DT = (const float*)(ws + WS_DT) + (size_t)(b * 32 + h) * 4096 + c * 128; const float* CS = (const float*)(ws + WS_CS) + (size_t)(b * 32 + h) * 4096 + c * 128;
        const float Dh = INF(20)[h];
        const bf16* XT = (const bf16*)(ws + WS_XT) + ((size_t)(b * 32 + h) * 128 + c * 4) * 2048;
        ssd_out_half<0>(args, CBT, CnL, SQ, hp, XT, CS, DT, Dh, b, c, h, wave, q, r16, lane);
        ssd_out_half<1>(args, CBT, CnL, SQ, hp, XT, CS, DT, Dh, b, c, h, wave, q, r16, lane);
    }
    __syncthreads();
    if (tid < 128) { float s = 0.f;
#pragma unroll
        for (int w = 0; w < 8; ++w) s += SQ[w * 128 + tid];
        ((float*)(ws + WS_SSQ))[((size_t)b * 4096 + c * 128 + tid) * 4 + g] = s; }
    __syncthreads();
}
constexpr float SC2 = 0.125f * 1.4426950408889634f;
__device__ __forceinline__ float max3f(float a, float b, float c) { float r; asm("v_max3_f32 %0, %1, %2, %3" : "=v"(r) : "v"(a), "v"(b), "v"(c)); return r; }
template <class T> __device__ __forceinline__ T ldu(const void* ubase, unsigned lane_off) { return *(const T*)((const char*)ubase + lane_off); }
struct KFrag { bf16x8 kf[2][2]; };
__device__ __forceinline__ void flash_load(const bf16* Kp, int kb, unsigned koff, KFrag& F) {
#pragma unroll
    for (int kt = 0; kt < 2; ++kt) { const bf16* kr = Kp + (size_t)(kb + 16 * kt) * 64; F.kf[kt][0] = ldu<bf16x8>(kr, koff); F.kf[kt][1] = ldu<bf16x8>(kr + 32, koff); }
}
template <int MODE>
__device__ __forceinline__ void flash_step(const KFrag& F, const bf16* VTp, unsigned voff, int kb, int t0, int t, bool selbit, const LAS bf16x8* Qs,
                                           f32x4 (&O)[4][4], float (&mx)[4], f32x4 (&L)[4], int q) {
    const bf16x8 ones = __builtin_bit_cast(bf16x8, (u32x4){0x3f803f80u, 0x3f803f80u, 0x3f803f80u, 0x3f803f80u});
    const bool edge = (kb + 31 > t0) || (MODE == 1 && kb + 512 <= t0 + 15);
    bf16x8 vf[4];
#pragma unroll
    for (int dt = 0; dt < 4; ++dt) vf[dt] = ldu<bf16x8>(VTp + (size_t)(kb >> 5) * 2048 + (16 * dt) * 32, voff);
#pragma unroll
    for (int g = 0; g < 4; ++g) {
        asm volatile("" ::: "memory");
        __builtin_amdgcn_sched_barrier(0);
        const bf16x8 q0 = Qs[(g * 2 + 0) * 64], q1 = Qs[(g * 2 + 1) * 64];
        f32x4 S0 = MFMA16(F.kf[0][0], q0, ((f32x4){0.f, 0.f, 0.f, 0.f})), S1 = MFMA16(F.kf[1][0], q0, ((f32x4){0.f, 0.f, 0.f, 0.f}));
        S0 = MFMA16(F.kf[0][1], q1, S0); S1 = MFMA16(F.kf[1][1], q1, S1);
        float s[8];
#pragma unroll
        for (int r = 0; r < 4; ++r) { s[r] = S0[r]; s[4 + r] = S1[r]; }
        if (edge) {
#pragma unroll
            for (int i = 0; i < 8; ++i) { const int key = kb + 16 * (i >> 2) + 4 * q + (i & 3);
                const bool ok = (MODE == 0) ? (key <= t) : (key <= t && key + 512 > t); s[i] = ok ? s[i] : NEGF; }
        }
        float lm = max3f(max3f(s[0], s[1], s[2]), max3f(s[3], s[4], s[5]), fmaxf(s[6], s[7])) * SC2;
        if (MODE == 0) lm = selbit ? lm : NEGF;
        if (__builtin_amdgcn_ballot_w64(lm > mx[g] + 8.f) != 0ull) {
            float tmax = fmaxf(lm, __shfl_xor(lm, 16)); tmax = fmaxf(tmax, __shfl_xor(tmax, 32));
            const float mnew = fmaxf(mx[g], tmax), alpha = __builtin_amdgcn_exp2f(mx[g] - mnew); mx[g] = mnew; L[g] = L[g] * alpha;
#pragma unroll
            for (int dt = 0; dt < 4; ++dt) O[dt][g] = O[dt][g] * alpha;
        }
        float nmuse = -fmaxf(mx[g], -1e20f);
        if (MODE == 0) nmuse = selbit ? nmuse : NEGF;
#pragma unroll
        for (int i = 0; i < 8; ++i) s[i] = __builtin_amdgcn_exp2f(__builtin_fmaf(s[i], SC2, nmuse));
        u32x4 pw; pw.x = pk2(s[0], s[1]); pw.y = pk2(s[2], s[3]); pw.z = pk2(s[4], s[5]); pw.w = pk2(s[6], s[7]);
        const bf16x8 pf = __builtin_bit_cast(bf16x8, pw);
        L[g] = MFMA16(ones, pf, L[g]);
#pragma unroll
        for (int dt = 0; dt < 4; ++dt) O[dt][g] = MFMA16(vf[dt], pf, O[dt][g]);
    }
}
template <int MODE>
__device__ __forceinline__ void flash_branch(const bf16* Kp, const bf16* VTp, int jfirst, int jlast, unsigned ulo, unsigned uhi, unsigned mlo, unsigned mhi,
                                             int t0, int t, const LAS bf16x8* Qs, f32x4 (&O)[4][4], float (&mx)[4], f32x4 (&L)[4], int q, int r16) {
    const unsigned koff = (unsigned)(r16 * 64 + 8 * q) * 2u, voff = (unsigned)(r16 * 32 + 8 * q) * 2u;
    int jb = jfirst;
    while (jb <= jlast && !((jb < 32 ? (ulo >> jb) : (uhi >> (jb - 32))) & 1u)) ++jb;
    if (jb > jlast) return;
    KFrag A, B;
    flash_load(Kp, 64 * jb, koff, A);
    for (;;) {
        flash_load(Kp, 64 * jb + 32, koff, B);
        const bool selbit = ((jb < 32 ? (mlo >> jb) : (mhi >> (jb - 32))) & 1u) != 0u;
        flash_step<MODE>(A, VTp, voff, 64 * jb, t0, t, selbit, Qs, O, mx, L, q);
        int jn = jb + 1;
        while (jn <= jlast && !((jn < 32 ? (ulo >> jn) : (uhi >> (jn - 32))) & 1u)) ++jn;
        if (jn <= jlast) flash_load(Kp, 64 * jn, koff, A);
        flash_step<MODE>(B, VTp, voff, 64 * jb + 32, t0, t, selbit, Qs, O, mx, L, q);
        if (jn > jlast) break;
        jb = jn;
    }
}

template <int BR>
__device__ __forceinline__ void attn_finish(const Args& args, f32x4 (&O)[4][4], const f32x4 (&L)[4], bool normalise, size_t m, int hkv, int q) {
    unsigned char* ws = args.ws;
    const float* gates = (const float*)(ws + WS_MISC) + m * 128 + 32;
    const unsigned yoff = (unsigned)((m & 15) * 1024 + 4 * q) * 4u, yboff = yoff >> 1;
#pragma unroll
    for (int g = 0; g < 4; ++g) {
        float sc = sigmf(gates[(hkv * 4 + g) * 3 + BR]);
        if (normalise) sc *= 1.f / fmaxf(L[g][0], TINYF);
#pragma unroll
        for (int dt = 0; dt < 4; ++dt) {
            char* yfu = (char*)((float*)(ws + WS_YATTF) + (m & ~(size_t)15) * 1024 + (hkv * 4 + g) * 64 + 16 * dt);
            f32x4 v = O[dt][g] * sc;
            if (BR > 0) v = v + *(const f32x4*)(yfu + yoff);
            if (BR < 2) *(f32x4*)(yfu + yoff) = v;
            else { u32x2 o; o.x = pk2(v.x, v.y); o.y = pk2(v.z, v.w); *(u32x2*)((char*)((bf16*)(ws + WS_YATT) + (m & ~(size_t)15) * 1024 + (hkv * 4 + g) * 64 + 16 * dt) + yboff) = o; }
        }
    }
}

__device__ __forceinline__ void attn_prompt_unit(const Args& args, LAS float* impL, int unit, bool xcdmap, int lane_in) {
    int lane = lane_in; asm volatile("" : "+v"(lane));
    unsigned char* ws = args.ws;
    const int q = lane >> 4, r16 = lane & 15;
    const int pass = unit >> 11, gwv = unit & 2047, xcd = (gwv >> 3) & 7, wx = (gwv >> 6) * 8 + (gwv & 7);
    const int bh = xcdmap ? 2 * xcd + pass : (unit & 15), b = bh >> 2, hkv = bh & 3;
    const int tile = xcdmap ? (pass == 0 ? 255 - wx : wx) : (unit < 2048 ? 255 - (unit >> 4) : (unit - 2048) >> 4);
    const int t0 = tile * 16, t = t0 + r16; const size_t m = (size_t)b * 4096 + t;
    LAS bf16x8* Qs = (LAS bf16x8*)(impL + 1024) + lane;
#pragma unroll
    for (int g = 0; g < 4; ++g)
#pragma unroll
        for (int ks = 0; ks < 2; ++ks) Qs[(g * 2 + ks) * 64] = ldu<bf16x8>((const bf16*)(ws + WS_Q) + ((size_t)b * 4096 + t0) * 1024 + (hkv * 4 + g) * 64 + 32 * ks, (unsigned)(r16 * 1024 + 8 * q) * 2u);
    LDS_WAIT(); asm volatile("" ::: "memory");
    f32x4 O[4][4]; float mx[4], ls[4];
    const bf16* KCp = (const bf16*)(ws + WS_KC) + (size_t)bh * 256 * 64; const bf16* VCTp = (const bf16*)(ws + WS_VCT) + (size_t)bh * 64 * 256;
    const unsigned kcoff = (unsigned)(r16 * 64 + 8 * q) * 2u, vcoff = (unsigned)(r16 * 32 + 8 * q) * 2u;
    const int nmax = (t0 + 15 >= 31) ? ((t0 + 15 - 31) >> 4) : -1;
    const int NP = nmax < 0 ? 0 : (nmax / 32 + 2 < 8 ? nmax / 32 + 2 : 8);
#pragma unroll
    for (int g = 0; g < 4; ++g) { mx[g] = NEGF; ls[g] = 0.f; }
    for (int kt = 0; kt < 2 * NP; ++kt) {
        const bf16* kr = KCp + (size_t)(16 * kt) * 64;
        const bf16x8 k0 = ldu<bf16x8>(kr, kcoff), k1 = ldu<bf16x8>(kr + 32, kcoff);
#pragma unroll
        for (int g = 0; g < 4; ++g) {
            f32x4 s = MFMA16(k0, Qs[(g * 2 + 0) * 64], ((f32x4){0.f, 0.f, 0.f, 0.f})); s = MFMA16(k1, Qs[(g * 2 + 1) * 64], s);
            float tmax = NEGF;
#pragma unroll
            for (int r = 0; r < 4; ++r) { const int n = 16 * kt + 4 * q + r; const bool ok = (16 * n + 31 <= t); s[r] = ok ? s[r] * 0.125f : NEGF; tmax = fmaxf(tmax, s[r]); }
            const float mnew = fmaxf(mx[g], tmax); float ps = 0.f;
#pragma unroll
            for (int r = 0; r < 4; ++r) ps += (s[r] > 0.5f * NEGF) ? __expf(s[r] - mnew) : 0.f;
            ls[g] = ls[g] * __expf(mx[g] - mnew) + ps; mx[g] = mnew;
        }
    }
    float invL[4];
#pragma unroll
    for (int g = 0; g < 4; ++g) {
        float M = fmaxf(mx[g], __shfl_xor(mx[g], 16)); M = fmaxf(M, __shfl_xor(M, 32));
        float l = ls[g] * __expf(mx[g] - M); l += __shfl_xor(l, 16); l += __shfl_xor(l, 32);
        mx[g] = M; invL[g] = 1.f / fmaxf(l, TINYF);
    }
#pragma unroll
    for (int dt = 0; dt < 4; ++dt)
#pragma unroll
        for (int g = 0; g < 4; ++g) O[dt][g] = (f32x4){0.f, 0.f, 0.f, 0.f};
    float prev3 = 0.f;
#pragma unroll
    for (int kt = 0; kt < 16; ++kt) impL[kt * 64 + lane] = 0.f;
#pragma unroll 1
    for (int i = 0; i < NP; ++i) {
        f32x4 P[2][4];
#pragma unroll
        for (int kk = 0; kk < 2; ++kk) {
            const int kt = 2 * i + kk;
            const bf16* kr = KCp + (size_t)(16 * kt) * 64;
            const bf16x8 k0 = ldu<bf16x8>(kr, kcoff), k1 = ldu<bf16x8>(kr + 32, kcoff);
            f32x4 psum = (f32x4){0.f, 0.f, 0.f, 0.f};
#pragma unroll
            for (int g = 0; g < 4; ++g) {
                f32x4 s = MFMA16(k0, Qs[(g * 2 + 0) * 64], ((f32x4){0.f, 0.f, 0.f, 0.f})); s = MFMA16(k1, Qs[(g * 2 + 1) * 64], s);
#pragma unroll
                for (int r = 0; r < 4; ++r) { const int n = 16 * kt + 4 * q + r; const bool ok = (16 * n + 31 <= t); s[r] = ok ? __expf(s[r] * 0.125f - mx[g]) * invL[g] : 0.f; }
                P[kk][g] = s; psum = psum + s;
            }
            const float a = __shfl(psum[3], (lane + 48) & 63), bb = __shfl(prev3, (lane + 48) & 63);
            impL[kt * 64 + lane] = 2.f * (psum[0] + psum[1] + psum[2]) + psum[3] + (q > 0 ? a : bb);
            prev3 = psum[3];
        }
        bf16x8 vf[4];
#pragma unroll
        for (int dt = 0; dt < 4; ++dt) vf[dt] = ldu<bf16x8>(VCTp + (size_t)i * 2048 + (16 * dt) * 32, vcoff);
#pragma unroll
        for (int g = 0; g < 4; ++g) {
            u32x4 pw; pw.x = pk2(P[0][g][0], P[0][g][1]); pw.y = pk2(P[0][g][2], P[0][g][3]); pw.z = pk2(P[1][g][0], P[1][g][1]); pw.w = pk2(P[1][g][2], P[1][g][3]);
            const bf16x8 pf = __builtin_bit_cast(bf16x8, pw);
#pragma unroll
            for (int dt = 0; dt < 4; ++dt) O[dt][g] = MFMA16(vf[dt], pf, O[dt][g]);
        }
    }
    f32x4 L[4];
#pragma unroll
    for (int g = 0; g < 4; ++g) L[g] = (f32x4){1.f, 1.f, 1.f, 1.f};
    attn_finish<0>(args, O, L, false, m, hkv, q);
    unsigned mlo = 0u, mhi = 0u;
    {
        const int cur = t >> 6;
        LDS_WAIT(); asm volatile("" ::: "memory");
        float v[16];
#pragma unroll
        for (int kt = 0; kt < 16; ++kt) { const int j = 4 * kt + q; const bool valid = (64 * j <= t), forced = (j == 0) || (j == cur) || (j == cur - 1);
            v[kt] = valid ? (forced ? BIGF : impL[kt * 64 + lane]) : -BIGF; }
#pragma unroll
        for (int kt = 0; kt < 16; ++kt) impL[kt * 64 + lane] = v[kt];
        LDS_WAIT(); asm volatile("" ::: "memory");
        int rank[16];
#pragma unroll
        for (int kt = 0; kt < 16; ++kt) rank[kt] = 0;
#pragma unroll 1
        for (int rot = 0; rot < 4; ++rot) {
#pragma unroll 2
            for (int kk = 0; kk < 16; ++kk) {
                const float o = impL[kk * 64 + (lane ^ (16 * rot))];
                const int oj = 4 * kk + (q ^ rot);
#pragma unroll
                for (int kt = 0; kt < 16; ++kt) { const int myj = 4 * kt + q; rank[kt] += ((o > v[kt]) || (o == v[kt] && oj < myj)) ? 1 : 0; }
            }
        }
#pragma unroll
        for (int kt = 0; kt < 16; ++kt) { const int j = 4 * kt + q; const unsigned bit = rank[kt] < 16 ? 1u : 0u; if (kt < 8) mlo |= bit << j; else mhi |= bit << (j - 32); }
        mlo |= __shfl_xor(mlo, 16); mlo |= __shfl_xor(mlo, 32); mhi |= __shfl_xor(mhi, 16); mhi |= __shfl_xor(mhi, 32);
    }
    unsigned ulo = mlo, uhi = mhi;
#pragma unroll
    for (int o = 1; o < 16; o <<= 1) { ulo |= __shfl_xor(ulo, o); uhi |= __shfl_xor(uhi, o); }
    ulo = __builtin_amdgcn_readfirstlane(ulo); uhi = __builtin_amdgcn_readfirstlane(uhi);
    {
#pragma unroll
        for (int g = 0; g < 4; ++g) { mx[g] = NEGF; L[g] = (f32x4){0.f, 0.f, 0.f, 0.f}; }
#pragma unroll
        for (int dt = 0; dt < 4; ++dt)
#pragma unroll
            for (int g = 0; g < 4; ++g) O[dt][g] = (f32x4){0.f, 0.f, 0.f, 0.f};
        const bf16* Kp = (const bf16*)(ws + WS_KVH) + ((size_t)(2 * 4 + b) * 4 + hkv) * 4096 * 64;
        const bf16* VTp = (const bf16*)(ws + WS_VT) + ((size_t)(0 * 4 + b) * 4 + hkv) * 64 * 4096;
        flash_branch<0>(Kp, VTp, 0, (t0 + 15) >> 6, ulo, uhi, mlo, mhi, t0, t, Qs, O, mx, L, q, r16);
        attn_finish<1>(args, O, L, true, m, hkv, q);
    }
    {
#pragma unroll
        for (int g = 0; g < 4; ++g) { mx[g] = NEGF; L[g] = (f32x4){0.f, 0.f, 0.f, 0.f}; }
#pragma unroll
        for (int dt = 0; dt < 4; ++dt)
#pragma unroll
            for (int g = 0; g < 4; ++g) O[dt][g] = (f32x4){0.f, 0.f, 0.f, 0.f};
        const bf16* Kp = (const bf16*)(ws + WS_KVH) + ((size_t)(4 * 4 + b) * 4 + hkv) * 4096 * 64;
        const bf16* VTp = (const bf16*)(ws + WS_VT) + ((size_t)(1 * 4 + b) * 4 + hkv) * 64 * 4096;
        const int jbeg = t0 >= 511 ? (t0 - 511) >> 6 : 0, jend = (t0 + 15) >> 6;
        flash_branch<1>(Kp, VTp, jbeg, jend, 0xffffffffu, 0xffffffffu, 0xffffffffu, 0xffffffffu, t0, t, Qs, O, mx, L, q, r16);
        attn_finish<2>(args, O, L, true, m, hkv, q);
    }
}
__device__ __forceinline__ void dot4_reduce(const float (&qv)[4], float kx, int lane, float (&sg)[4]) {
    const float v0 = qv[0] * kx, v1 = qv[1] * kx, v2 = qv[2] * kx, v3 = qv[3] * kx;
    const bool up = (lane & 32) != 0, up2 = (lane & 16) != 0;
    const float r0 = (up ? v2 : v0) + __shfl_xor(up ? v0 : v2, 32), r1 = (up ? v3 : v1) + __shfl_xor(up ? v1 : v3, 32);
    float x = (up2 ? r1 : r0) + __shfl_xor(up2 ? r0 : r1, 16);
    x += __shfl_xor(x, 8); x += __shfl_xor(x, 4); x += __shfl_xor(x, 2); x += __shfl_xor(x, 1);
    const int xi = __builtin_bit_cast(int, x);
    sg[0] = __builtin_bit_cast(float, __builtin_amdgcn_readlane(xi, 0)); sg[1] = __builtin_bit_cast(float, __builtin_amdgcn_readlane(xi, 16));
    sg[2] = __builtin_bit_cast(float, __builtin_amdgcn_readlane(xi, 32)); sg[3] = __builtin_bit_cast(float, __builtin_amdgcn_readlane(xi, 48));
}
struct SampleRows { const float* cache; const float* cwin; float* out; const LAS int* selblk; const LAS int* selpage; int bs, hkv, rs, dc; };
template <int BR> __device__ __forceinline__ void srow_load(const SampleRows& R, int row, int nrows, f32x4& kx, f32x4& vx) {
    kx = (f32x4){0.f, 0.f, 0.f, 0.f}; vx = kx;
    if (row < nrows) {
        if (BR == 0) { const int k = row >> 6; const unsigned off = (((unsigned)R.selpage[k] * 128u + (unsigned)((R.selblk[k] & 1) * 64 + (row & 63))) * 4u + 2u) * 256u + (unsigned)(R.hkv * 64 + 4 * R.dc);
            kx = *(const f32x4*)(R.cache + off); vx = *(const f32x4*)(R.cache + off + 256u); }
        else { const unsigned off = (((unsigned)R.bs * 512u + (unsigned)(row + 1)) * 2u) * 256u + (unsigned)(R.hkv * 64 + 4 * R.dc);
            kx = *(const f32x4*)(R.cwin + off); vx = *(const f32x4*)(R.cwin + off + 256u); }
    }
}
__device__ __forceinline__ void srow_update(const f32x4 (&qv)[4], const f32x4& kx, const f32x4& vx, bool valid, float (&mx)[4], float (&ls)[4], f32x4 (&o)[4]) {
    float s[4];
#pragma unroll
    for (int g = 0; g < 4; ++g) s[g] = (qv[g].x * kx.x + qv[g].y * kx.y) + (qv[g].z * kx.z + qv[g].w * kx.w);
#pragma unroll
    for (int st = 8; st >= 1; st >>= 1)
#pragma unroll
        for (int g = 0; g < 4; ++g) s[g] += __shfl_xor(s[g], st);
#pragma unroll
    for (int g = 0; g < 4; ++g) {
        const float mnew = valid ? fmaxf(mx[g], s[g]) : mx[g], alpha = __expf(mx[g] - mnew), p = valid ? __expf(s[g] - mnew) : 0.f;
        ls[g] = ls[g] * alpha + p; o[g] = o[g] * alpha + vx * p; mx[g] = mnew;
    }
}
template <int BR>
__device__ __forceinline__ void sample_rows_branch(const SampleRows& R, int wave, const f32x4 (&qv)[4], LAS float* pm, LAS float* pl, LAS float* po) {
    float mx[4], ls[4]; f32x4 o[4];
#pragma unroll
    for (int g = 0; g < 4; ++g) { mx[g] = NEGF; ls[g] = 0.f; o[g] = (f32x4){0.f, 0.f, 0.f, 0.f}; }
    constexpr int nrows = BR == 0 ? 15 * 64 : 511;
    constexpr int ngroups = (nrows + 3) / 4;
#pragma unroll 1
    for (int g0 = wave; g0 < ngroups; g0 += 64) {
        f32x4 kx[8], vx[8];
#pragma unroll
        for (int k = 0; k < 8; ++k) srow_load<BR>(R, 4 * (g0 + 8 * k) + R.rs, (g0 + 8 * k) < ngroups ? nrows : 0, kx[k], vx[k]);
#pragma unroll
        for (int k = 0; k < 8; ++k) {
            const int grp = g0 + 8 * k, row = 4 * grp + R.rs;
            if (grp < ngroups) {
                const bool valid = row < nrows;
                if (BR == 1 && valid) { const unsigned off = (((unsigned)R.bs * 512u + (unsigned)row) * 2u) * 256u + (unsigned)(R.hkv * 64 + 4 * R.dc);
                    *(f32x4*)(R.out + O_WINS + off) = kx[k]; *(f32x4*)(R.out + O_WINS + off + 256u) = vx[k]; }
                srow_update(qv, kx[k], vx[k], valid, mx, ls, o);
            }
        }
    }
    if (wave == 0) {
        const float* src = BR == 0 ? R.out + O_KVS + ((size_t)R.bs * 4 + 2) * 256 + R.hkv * 64 + 4 * R.dc : R.out + O_WINS + (((size_t)R.bs * 512 + 511) * 2) * 256 + R.hkv * 64 + 4 * R.dc;
        const f32x4 kx = *(const f32x4*)src, vx = *(const f32x4*)(src + 256);
        srow_update(qv, kx, vx, R.rs == 0, mx, ls, o);
    }
    const int slot = (BR * 32 + wave * 4 + R.rs) * 4;
#pragma unroll
    for (int g = 0; g < 4; ++g) { if (R.dc == 0) { pm[slot + g] = mx[g]; pl[slot + g] = ls[g]; } *(LAS f32x4*)(po + (size_t)(slot + g) * 64 + 4 * R.dc) = o[g]; }
}

__device__ __forceinline__ void attn_sample_unit(const Args& args, LAS unsigned char* lds, int unit, int tid, int wave, int lane) {
    unsigned char* ws = args.ws; float* out = args.out;
    const int hkv = unit & 3, bs = unit >> 2; const size_t m = MP + bs;
    LAS float* sc = (LAS float*)lds; LAS float* impv = sc + 512; LAS int* selblk = (LAS int*)(impv + 64); LAS int* selpage = selblk + 16; LAS int* pg = selpage + 16;
    LAS float* pm = (LAS float*)(pg + 16); LAS float* pl = pm + 256; LAS float* po = pl + 256;
    LAS float* poc = po + 2 * 32 * 4 * 64;
    const bf16* Qr = (const bf16*)(ws + WS_Q) + m * 1024 + hkv * 256;
    const float* KCS = (const float*)(ws + WS_KCS) + (size_t)(bs * 4 + hkv) * 128 * 64; const float* VCS = (const float*)(ws + WS_VCS) + (size_t)(bs * 4 + hkv) * 128 * 64;
    float qv[4];
#pragma unroll
    for (int g = 0; g < 4; ++g) qv[g] = bf2f(Qr[g * 64 + lane]) * 0.125f;
    if (tid < 16) pg[tid] = ((const int*)args.in[5])[bs * NPAGES + tid];
    {
        float kr[16];
#pragma unroll
        for (int i = 0; i < 16; ++i) { const int n = wave + 8 * i; kr[i] = n < 127 ? KCS[n * 64 + lane] : 0.f; }
#pragma unroll
        for (int i = 0; i < 16; ++i) { const int n = wave + 8 * i; float sg[4]; dot4_reduce(qv, kr[i], lane, sg);
            if (lane < 4) sc[lane * 128 + n] = n < 127 ? (lane == 0 ? sg[0] : lane == 1 ? sg[1] : lane == 2 ? sg[2] : sg[3]) : NEGF; }
    }
    __syncthreads();
    if (wave < 4) { const float s0 = sc[wave * 128 + lane], s1 = sc[wave * 128 + 64 + lane];
        float mxv = fmaxf(s0, s1);
#pragma unroll
        for (int o = 1; o < 64; o <<= 1) mxv = fmaxf(mxv, __shfl_xor(mxv, o));
        const float e0 = __expf(s0 - mxv), e1 = (lane < 63) ? __expf(s1 - mxv) : 0.f;
        const float inv = 1.f / fmaxf(wave_sum(e0 + e1), TINYF);
        sc[wave * 128 + lane] = e0 * inv; sc[wave * 128 + 64 + lane] = e1 * inv; }
    __syncthreads();
    {
        float vr[16];
#pragma unroll
        for (int i = 0; i < 16; ++i) { const int n = wave + 8 * i; vr[i] = n < 127 ? VCS[n * 64 + lane] : 0.f; }
        float oc[4] = {0.f, 0.f, 0.f, 0.f};
#pragma unroll
        for (int i = 0; i < 16; ++i) { const int n = wave + 8 * i;
#pragma unroll
            for (int g = 0; g < 4; ++g) oc[g] += sc[g * 128 + n] * vr[i]; }
#pragma unroll
        for (int g = 0; g < 4; ++g) poc[(wave * 4 + g) * 64 + lane] = oc[g];
        if (wave == 4 && lane < 33) { const int j = lane; float acc = 0.f;
#pragma unroll
            for (int k = -1; k < 4; ++k) { const int n = 4 * j + k; if (n >= 0 && n < 127) { const float P = (sc[n] + sc[128 + n]) + (sc[256 + n] + sc[384 + n]); acc += (k == -1 || k == 3) ? P : 2.f * P; } }
            impv[j] = (j == 0 || j == 31 || j == 32) ? BIGF : acc; }
    }
    __syncthreads();
    if (tid < 64) { bool sel = false;
        if (tid < 33) { const float v = impv[tid]; int rank = 0;
            for (int k = 0; k < 33; ++k) { const float o = impv[k]; rank += ((o > v) || (o == v && k < tid)) ? 1 : 0; }
            sel = rank < 16 && tid < 32; }
        const unsigned long long bal = __ballot(sel);
        if (sel) { const int slot = __popcll(bal & ((1ull << tid) - 1ull)); selblk[slot] = tid; selpage[slot] = pg[tid >> 1]; } }
    __syncthreads();
    {
        f32x4 qv4[4];
#pragma unroll
        for (int g = 0; g < 4; ++g) { const u32x2 w = *(const u32x2*)(Qr + g * 64 + 4 * (lane & 15)); qv4[g] = (f32x4){bflo(w.x), bfhi(w.x), bflo(w.y), bfhi(w.y)} * 0.125f; }
        SampleRows R{INF(4), INF(6), out, selblk, selpage, bs, hkv, lane >> 4, lane & 15};
        sample_rows_branch<0>(R, wave, qv4, pm, pl, po);
        sample_rows_branch<1>(R, wave, qv4, pm, pl, po);
    }
    __syncthreads();
    if (tid < 256) { const int g = tid >> 6, d = tid & 63;
        const float* gates = (const float*)(ws + WS_MISC) + m * 128 + 32 + (hkv * 4 + g) * 3;
        float oc = 0.f;
#pragma unroll
        for (int w = 0; w < 8; ++w) oc += poc[(w * 4 + g) * 64 + d];
        float res = sigmf(gates[0]) * oc;
#pragma unroll
        for (int br = 0; br < 2; ++br) { float M = NEGF;
#pragma unroll 8
            for (int w = 0; w < 32; ++w) M = fmaxf(M, pm[(br * 32 + w) * 4 + g]);
            float L = 0.f, O = 0.f;
#pragma unroll 8
            for (int w = 0; w < 32; ++w) { const float e = __expf(pm[(br * 32 + w) * 4 + g] - M); L += pl[(br * 32 + w) * 4 + g] * e; O += po[((br * 32 + w) * 4 + g) * 64 + d] * e; }
            res += sigmf(gates[1 + br]) * O / fmaxf(L, TINYF); }
        ((bf16*)(ws + WS_YATT))[m * 1024 + (hkv * 4 + g) * 64 + d] = (bf16)f2bf(res); }
    __syncthreads();
}

__device__ __forceinline__ void ffn_act_item(const Args& args, int item, int lane) {
    unsigned char* ws = args.ws; float* out = args.out;
    const bf16* U = (const bf16*)(ws + WS_U); bf16* ACT = (bf16*)(ws + WS_ACT);
    const float* cw = INF(32); const float* cb = INF(33); const float* st = INF(9);
    const int slab = item % 11, chunk = item / 11, row0 = chunk * 32, c4 = slab * 256 + lane * 4;
    f32x4 w[2][3], bia[2];
#pragma unroll
    for (int hf = 0; hf < 2; ++hf) { bia[hf] = *(const f32x4*)(cb + hf * DFF + c4);
#pragma unroll
        for (int k = 0; k < 3; ++k) w[hf][k] = *(const f32x4*)(cw + k * DFF2 + hf * DFF + c4); }
    if (row0 >= MP) {
        for (int r = 0; r < 32; ++r) { const int bs = row0 - MP + r; if (bs >= MS) break;
            f32x4 cu[2];
#pragma unroll
            for (int hf = 0; hf < 2; ++hf) { const int col = hf * DFF + c4;
                const f32x4 u0 = *(const f32x4*)(st + ((size_t)bs * 2 + 0) * DFF2 + col), u1 = *(const f32x4*)(st + ((size_t)bs * 2 + 1) * DFF2 + col), u2 = *(const f32x4*)(out + O_FFNS + ((size_t)bs * 2 + 1) * DFF2 + col);
                *(f32x4*)(out + O_FFNS + ((size_t)bs * 2 + 0) * DFF2 + col) = u1;
                cu[hf] = bia[hf] + w[hf][0] * u0 + w[hf][1] * u1 + w[hf][2] * u2; }
            u32x2 o; o.x = pk2(siluf(cu[0].x) * cu[1].x, siluf(cu[0].y) * cu[1].y); o.y = pk2(siluf(cu[0].z) * cu[1].z, siluf(cu[0].w) * cu[1].w);
            *(u32x2*)(ACT + (size_t)(row0 + r) * DFF + c4) = o; }
        return;
    }
    const int t0 = row0 & 4095;
    f32x4 p2[2], p1[2];
#pragma unroll
    for (int hf = 0; hf < 2; ++hf) { const int col = hf * DFF + c4;
        const u32x2 a = t0 >= 2 ? *(const u32x2*)(U + (size_t)(row0 - 2) * DFF2 + col) : (u32x2){0u, 0u}, b = t0 >= 1 ? *(const u32x2*)(U + (size_t)(row0 - 1) * DFF2 + col) : (u32x2){0u, 0u};
        p2[hf] = (f32x4){bflo(a.x), bfhi(a.x), bflo(a.y), bfhi(a.y)}; p1[hf] = (f32x4){bflo(b.x), bfhi(b.x), bflo(b.y), bfhi(b.y)}; }
#pragma unroll 1
    for (int rb = 0; rb < 32; rb += 8) {
        u32x2 v[8][2];
#pragma unroll
        for (int r = 0; r < 8; ++r)
#pragma unroll
            for (int hf = 0; hf < 2; ++hf) v[r][hf] = *(const u32x2*)(U + (size_t)(row0 + rb + r) * DFF2 + hf * DFF + c4);
#pragma unroll
        for (int r = 0; r < 8; ++r) {
            f32x4 cu[2];
#pragma unroll
            for (int hf = 0; hf < 2; ++hf) { const f32x4 u2 = (f32x4){bflo(v[r][hf].x), bfhi(v[r][hf].x), bflo(v[r][hf].y), bfhi(v[r][hf].y)};
                cu[hf] = bia[hf] + w[hf][0] * p2[hf] + w[hf][1] * p1[hf] + w[hf][2] * u2; p2[hf] = p1[hf]; p1[hf] = u2; }
            u32x2 o; o.x = pk2(siluf(cu[0].x) * cu[1].x, siluf(cu[0].y) * cu[1].y); o.y = pk2(siluf(cu[0].z) * cu[1].z, siluf(cu[0].w) * cu[1].w);
            *(u32x2*)(ACT + (size_t)(row0 + rb + r) * DFF + c4) = o;
        }
    }
}
template <int KTOT>
__device__ __forceinline__ f32x4 skinny_acc(const bf16* A, int lda, const bf16* Bt, int ldb, int wave, int ct, int q, int r16) {
    const bf16* ap = A + (size_t)(16 * wave + r16) * lda + 8 * q;
    const bf16* bp = Bt + (size_t)(16 * ct + r16) * ldb + 8 * q;
    f32x4 acc = (f32x4){0.f, 0.f, 0.f, 0.f};
#pragma unroll 1
    for (int k0 = 0; k0 < KTOT; k0 += 256) {
        bf16x8 af[8], bf[8];
#pragma unroll
        for (int i = 0; i < 8; ++i) { af[i] = *(const bf16x8*)(ap + k0 + 32 * i); bf[i] = *(const bf16x8*)(bp + k0 + 32 * i); }
#pragma unroll
        for (int i = 0; i < 8; ++i) acc = MFMA16(af[i], bf[i], acc);
    }
    return acc;
}
template <int WHICH>
__device__ __forceinline__ void skinny_sample_unit(const Args& args, int ct, int wave, int lane) {
    unsigned char* ws = args.ws;
    const int q = lane >> 4, r16 = lane & 15, col = 16 * ct + r16;
    if (WHICH == 0) {
        const f32x4 a1 = skinny_acc<2048>((const bf16*)(ws + WS_YSSM) + (size_t)MP * 2048, 2048, (const bf16*)(ws + WS_WSSM), 2048, wave, ct, q, r16);
        const f32x4 a2 = skinny_acc<1024>((const bf16*)(ws + WS_YATT) + (size_t)MP * 1024, 1024, (const bf16*)(ws + WS_WATT), 1024, wave, ct, q, r16);
#pragma unroll
        for (int r = 0; r < 4; ++r) { const size_t row = MP + 16 * wave + 4 * q + r;
            const f32x4 sq = *(const f32x4*)((const float*)(ws + WS_SSQ) + row * 4);
            const float rstd = 1.f / sqrtf(((sq.x + sq.y) + (sq.z + sq.w)) * (1.f / 2048.f) + EPS);
            const bf16* mg = (const bf16*)(ws + WS_MG) + row * 2048;
            const float v = sigmf(bf2f(mg[col])) * rstd * a1[r] + sigmf(bf2f(mg[1024 + col])) * a2[r];
            ((bf16*)(ws + WS_MERGED))[row * 1024 + col] = (bf16)f2bf(v); }
    } else if (WHICH == 1) {
        const f32x4 a = skinny_acc<1024>((const bf16*)(ws + WS_MERGED) + (size_t)MP * 1024, 1024, (const bf16*)(ws + WS_WOUT), 1024, wave, ct, q, r16);
#pragma unroll
        for (int r = 0; r < 4; ++r) { const int bs = 16 * wave + 4 * q + r;
            ((float*)(ws + WS_X1))[(size_t)(MP + bs) * 1024 + col] = INF(1)[(size_t)bs * 1024 + col] + ((const float*)(ws + WS_MOD))[(size_t)(4 + bs) * 6144 + 2048 + col] * a[r]; }
    } else {
        const f32x4 a = skinny_acc<DFF>((const bf16*)(ws + WS_ACT) + (size_t)MP * DFF, DFF, (const bf16*)(ws + WS_WDN), DFF, wave, ct, q, r16);
#pragma unroll
        for (int r = 0; r < 4; ++r) { const int bs = 16 * wave + 4 * q + r; float* x = (float*)(ws + WS_X1) + (size_t)(MP + bs) * 1024 + col;
            *x = *x + ((const float*)(ws + WS_MOD))[(size_t)(4 + bs) * 6144 + 5120 + col] * a[r]; }
    }
}
constexpr int N_PHASES = 15;
#ifndef MK_PER_PHASE
#define MK_PER_PHASE 0
#endif

__global__ void __launch_bounds__(NTHR, 2) fwd_kernel(Args args) {
    extern __shared__ __attribute__((aligned(16))) unsigned char lds_raw[];
    LAS unsigned char* lds = (LAS unsigned char*)lds_raw;
    const int tid = threadIdx.x, lane = tid & 63, wave = __builtin_amdgcn_readfirstlane(tid >> 6);
    const int G = gridDim.x, bid = blockIdx.x, gw = bid * NWAVES + wave, NGW = G * NWAVES, gt = bid * NTHR + tid, NGT = G * NTHR;
    unsigned char* ws = args.ws;
    for (int u = tid; u < (LDS_BYTES - LDSCTL_OFF) / 4; u += NTHR) ((LAS unsigned*)(lds + LDSCTL_OFF))[u] = 0u;
    __syncthreads();
    XcdBarrier bar; bar.bar = (unsigned*)(ws + WS_CTL) + CW_BAR; bar.x = 0; bar.st = nullptr;
    if (!MK_PER_PHASE) bar = xcd_barrier_post((unsigned*)(ws + WS_CTL) + CW_BAR, (volatile LAS unsigned*)(lds + MISC_OFF) + 8);
    const int lo = args.ph_lo, hi = args.ph_hi;
#ifndef PHASE_MASK
#define PHASE_MASK 0x7fff
#endif
#define IN(k) ((((PHASE_MASK) >> (k)) & 1) && lo <= (k) && (k) < hi)
#define SEAM(k) do { if (IN(k) && IN((k) + 1)) xcd_barrier(bar); } while (0)
    using pg8::Gemm; using pg8::StaticOrder;

    if (IN(0)) { { p0_prologue(args, lds, gw, NGW, lane, wave); } }
    SEAM(0);
    if (IN(1)) { {
        Gemm g{(const bf16*)(ws + WS_SC), (const bf16*)(ws + WS_WADA), 256, 6144, 1024}; StaticOrder S; S.init(256, 6144, G, bid);
        pg8::EpiF32 E{(float*)(ws + WS_MOD), 6144, INF(11)};
        pg8::gemm_phase<pg8::EpiF32, StaticOrder, true, true>(lds, g, S, E);
    } }
    SEAM(1);
    if (IN(2)) { { norm_mod_phase<0>(args, gw, NGW, lane); } }
    SEAM(2);
    if (IN(3)) { {
        Gemm g{(const bf16*)(ws + WS_H), (const bf16*)(ws + WS_WIN), MPAD, NPROJ, 1024}; StaticOrder S; S.init(MPAD, NPROJ, G, bid);
        epi::InProj E{ws, args.out};
        pg8::gemm_phase<epi::InProj, StaticOrder, true, true>(lds, g, S, E);
    } }
    SEAM(3);
    if (IN(4)) { {
        const int p4 = args.p7mask >> 8;
        if (p4 & 1) {
        { Gemm g{(const bf16*)(ws + WS_CKB), (const bf16*)(ws + WS_W1K), 65536, 256, 1024}; StaticOrder S; S.init(65536, 256, G, bid);
          pg8::EpiF32 E{(float*)(ws + WS_PARTSK), 256, nullptr}; pg8::gemm_phase<pg8::EpiF32, StaticOrder, true, true>(lds, g, S, E); }
        { Gemm g{(const bf16*)(ws + WS_CVB), (const bf16*)(ws + WS_W1V), 65536, 256, 1024}; StaticOrder S; S.init(65536, 256, G, bid);
          pg8::EpiF32 E{(float*)(ws + WS_PARTSV), 256, nullptr}; pg8::gemm_phase<pg8::EpiF32, StaticOrder, true, true>(lds, g, S, E); }
        }
        if (p4 & 2) {
        { Gemm g{(const bf16*)(ws + WS_KVH), (const bf16*)(ws + WS_W1K), 4096, 256, 1024}; StaticOrder S; S.init(4096, 256, G, bid);
          pg8::EpiF32 E{(float*)(ws + WS_PARTK), 256, nullptr}; pg8::gemm_phase<pg8::EpiF32, StaticOrder, true, true>(lds, g, S, E); }
        { Gemm g{(const bf16*)(ws + WS_KVH) + (size_t)16 * 4096 * 64, (const bf16*)(ws + WS_W1V), 4096, 256, 1024}; StaticOrder S; S.init(4096, 256, G, (bid + G - 16) % G);
          pg8::EpiF32 E{(float*)(ws + WS_PARTV), 256, nullptr}; pg8::gemm_phase<pg8::EpiF32, StaticOrder, true, true>(lds, g, S, E); }
        }
        if (p4 & 4) for (int it = gw; it < 256 * 48; it += NGW) conv_prompt_item(args, it, lane);
        if (p4 & 8) { for (int it = gw; it < 4096; it += NGW) dtcs_item(args, it, lane);
            sample_conv(args, gt, NGT); }
    } }
    SEAM(4);
    if (IN(5)) { {
        const int p5 = args.p7mask >> 4;
        if (p5 & 1) for (int u = bid; u < 512; u += G) ssd_states_unit(args, lds, u, wave, lane);
        if (p5 & 2) { for (int it = gw; it < 2 * (4096 / 16); it += NGW) compress2_item<0>(args, it, lane);
            for (int it = gw; it < 2 * (65536 / 16); it += NGW) compress2_item<1>(args, it, lane); }
        if (p5 & 4) for (int it = gw; it < MS * NH; it += NGW) sample_ssm_item(args, lds, it, wave, lane);
    } }
    SEAM(5);
    if (IN(6)) { { scan_phase(args, gt, NGT); } }
    SEAM(6);
    if (IN(7)) { {
#ifndef P7C
#define P7C 7
#endif
        const int p7 = args.p7mask & (P7C);
        if (p7 & 1) for (int u = bid; u < 512; u += G) ssd_out_unit(args, lds, u, wave, lane, tid);
        if (p7 & 2) for (int u = gw; u < 4096; u += NGW) attn_prompt_unit(args, (LAS float*)(lds + wave * 12288), u, NGW == 2048, lane);
        __syncthreads();
        if (p7 & 4) for (int u = bid; u < 512; u += G) attn_sample_unit(args, lds, u, tid, wave, lane);
    } }
    SEAM(7);
    if (IN(8)) { {
        for (int u = bid; u < 64; u += G) skinny_sample_unit<0>(args, u, wave, lane);
        { Gemm g{(const bf16*)(ws + WS_YSSM), (const bf16*)(ws + WS_WSSM), MP, 1024, 2048}; StaticOrder S; S.init(MP, 1024, G, bid);
          epi::Merge1 E{ws}; pg8::gemm_phase<epi::Merge1, StaticOrder, true, true>(lds, g, S, E); }
        { Gemm g{(const bf16*)(ws + WS_YATT), (const bf16*)(ws + WS_WATT), MP, 1024, 1024}; StaticOrder S; S.init(MP, 1024, G, bid);
          epi::Merge2 E{ws}; pg8::gemm_phase<epi::Merge2, StaticOrder, true, true>(lds, g, S, E); }
    } }
    SEAM(8);
    if (IN(9)) { {
        for (int u = bid; u < 64; u += G) skinny_sample_unit<1>(args, u, wave, lane);
        Gemm g{(const bf16*)(ws + WS_MERGED), (const bf16*)(ws + WS_WOUT), MP, 1024, 1024}; StaticOrder S; S.init(MP, 1024, G, bid);
        epi::Resid E{INF(0), INF(1), nullptr, (float*)(ws + WS_X1), (const float*)(ws + WS_MOD), 2048};
        pg8::gemm_phase<epi::Resid, StaticOrder, true, true>(lds, g, S, E);
    } }
    SEAM(9);
    if (IN(10)) { { norm_mod_phase<1>(args, gw, NGW, lane); } }
    SEAM(10);
    if (IN(11)) { {
        Gemm g{(const bf16*)(ws + WS_H), (const bf16*)(ws + WS_WUP), MPAD, DFF2, 1024}; StaticOrder S; S.init(MPAD, DFF2, G, bid);
        epi::Up E{ws, args.out};
        pg8::gemm_phase<epi::Up, StaticOrder, true, true>(lds, g, S, E);
    } }
    SEAM(11);
    if (IN(12)) { { for (int it = gw; it < (MPAD / 32) * 11; it += NGW) ffn_act_item(args, it, lane); } }
    SEAM(12);
    if (IN(13)) { {
        for (int u = bid; u < 64; u += G) skinny_sample_unit<2>(args, u, wave, lane);
        Gemm g{(const bf16*)(ws + WS_ACT), (const bf16*)(ws + WS_WDN), MP, 1024, DFF}; StaticOrder S; S.init(MP, 1024, G, bid);
        epi::Resid E{INF(0), INF(1), (const float*)(ws + WS_X1), (float*)(ws + WS_X1), (const float*)(ws + WS_MOD), 5120};
        pg8::gemm_phase<epi::Resid, StaticOrder, true, true>(lds, g, S, E);
    } }
    SEAM(13);
    if (IN(14)) { { norm_mod_phase<2>(args, gw, NGW, lane); } }
#undef IN
#undef SEAM
}

extern "C" void kernel_launch(void* const* d_in, const int* in_sizes, int n_in, void* d_out, int out_size, void* d_ws, size_t ws_size, hipStream_t stream) {
    static int grid = 0;
    if (grid == 0) {
        if (n_in != 35 || out_size != (int)O_END || ws_size < WS_END) { fprintf(stderr, "kernel_launch: unexpected shapes (n_in %d out %d ws %zu, need %zu)\n", n_in, out_size, ws_size, (size_t)WS_END); grid = -1; return; }
        int dev = 0, cus = 0, per_cu = 0;
        if (hipGetDevice(&dev) != hipSuccess || hipDeviceGetAttribute(&cus, hipDeviceAttributeMultiprocessorCount, dev) != hipSuccess) { grid = -1; return; }
        if (hipFuncSetAttribute((const void*)fwd_kernel, hipFuncAttributeMaxDynamicSharedMemorySize, LDS_BYTES) != hipSuccess) { fprintf(stderr, "kernel_launch: hipFuncSetAttribute failed\n"); grid = -1; return; }
        if (hipOccupancyMaxActiveBlocksPerMultiprocessor(&per_cu, (const void*)fwd_kernel, NTHR, LDS_BYTES) != hipSuccess || per_cu < 1) { fprintf(stderr, "kernel_launch: occupancy query says %d\n", per_cu); }
        (void)hipGetLastError();
        grid = cus;
    }
    if (grid < 0) return;
    (void)hipMemsetAsync((char*)d_ws + WS_CTL, 0, CTL_ZERO_BYTES, stream);
    Args a{};
    for (int i = 0; i < 35; ++i) a.in[i] = d_in[i];
    a.out = (float*)d_out; a.ws = (unsigned char*)d_ws;
    a.p7mask = 0xFFF; a.pad = 7;
#if MK_PER_PHASE
    for (int p = 0; p < N_PHASES; ++p) { a.ph_lo = p; a.ph_hi = p + 1; hipLaunchKernelGGL(fwd_kernel, dim3(grid), dim3(NTHR), LDS_BYTES, stream, a); }
#else
    a.ph_lo = 0; a.ph_hi = N_PHASES;
    hipLaunchKernelGGL(fwd_kernel, dim3(grid), dim3(NTHR), LDS_BYTES, stream, a);
#endif
#ifdef PROBE_LO
    a.ph_lo = PROBE_LO; a.ph_hi = PROBE_HI; a.p7mask = PROBE_P7MASK; a.pad = PROBE_P7MASK;
    hipLaunchKernelGGL(fwd_kernel, dim3(grid), dim3(NTHR), LDS_BYTES, stream, a);
#endif
}
```

```cpp
#include <hip/hip_runtime.h>
#include <cstdio>
#include <cstdint>
namespace pg8 {
#define PG8_LAS __attribute__((address_space(3)))
typedef unsigned short bf16_t;
typedef short bf16x8 __attribute__((ext_vector_type(8)));
typedef float f32x4 __attribute__((ext_vector_type(4)));
typedef unsigned u32x4 __attribute__((ext_vector_type(4)));
constexpr int BM = 256, BK = 64, HALF = 128, HTB = HALF * BK * 2  , STAGE_BYTES = 8 * HTB, NXCD = 8, WGM = 8;

__host__ __device__ __forceinline__ int lds_byte(int r, int c) { const int st = (r >> 4) * 2 + (c >> 5), rr = r & 15, cc = c & 31, ob = rr * 64 + cc * 2; return st * 1024 + (ob ^ (((ob >> 9) & 1) << 5)); }
__host__ __device__ __forceinline__ void stage_rc(int b, int& R, int& C) { const int st = b / 1024, sb = b % 1024, swz = sb ^ (((sb >> 9) & 1) << 5); R = (st >> 1) * 16 + swz / 64; C = (st & 1) * 32 + (swz % 64) / 2; }
__host__ __device__ __forceinline__ int perm32(int rho) { const int n = rho >> 4, i = rho & 15; return 8 * (i >> 2) + 4 * n + (i & 3); }

struct Unit { int pm, pn; };
struct Gemm { const bf16_t* A; const bf16_t* Bt; int M, N, K; };

struct StaticOrder {
    int nM, nN, nwg, G, c;
    __host__ __device__ void init(int M, int N, int G_, int c_) { nM = M / BM; nN = N / BM; nwg = nM * nN; G = G_; c = c_; }
    __host__ __device__ bool next(int i, Unit& u) const {
        const long L = (long)i * G + c; if (L >= nwg) return false;
        int wgid = (int)L; { const int q = nwg / NXCD, r = nwg % NXCD, xcd = wgid % NXCD, off = wgid / NXCD; wgid = (xcd < r ? xcd * (q + 1) : r * (q + 1) + (xcd - r) * q) + off; }
        const int nig = WGM * nN, gid = wgid / nig, fm = gid * WGM, gsz = (nM - fm) < WGM ? (nM - fm) : WGM;
        u.pm = fm + ((wgid % nig) % gsz); u.pn = (wgid % nig) / gsz; return true;
    }
    __device__ __forceinline__ void a_ready(const Unit&) const {}
    __device__ __forceinline__ void done(const Unit&) const {}
};
__device__ __forceinline__ unsigned cvt_pk_bf16(float lo, float hi) { unsigned r; asm volatile("v_cvt_pk_bf16_f32 %0, %1, %2" : "=v"(r) : "v"(lo), "v"(hi)); return r; }
typedef float f32x2 __attribute__((ext_vector_type(2)));
struct EpiF32 {
    static constexpr bool PERM = false, AFTER_DRAIN = false;
    float* C; int ldc; const float* bias;
    __device__ __forceinline__ void operator()(const f32x4 (&acc)[2][2][4][2], const Unit& u, int wr, int wc, int fr, int fq) const {
        const int row0 = u.pm * BM + wr * 64 + fr, col0 = u.pn * BM + wc * 32 + 4 * fq;
        f32x4 bv[2][2];
#pragma unroll
        for (int bj = 0; bj < 2; ++bj)
#pragma unroll
            for (int n = 0; n < 2; ++n) bv[bj][n] = bias ? *(const f32x4*)(bias + col0 + bj * HALF + n * 16) : (f32x4){0.f, 0.f, 0.f, 0.f};
#pragma unroll
        for (int ai = 0; ai < 2; ++ai)
#pragma unroll
            for (int m = 0; m < 4; ++m) { float* rowp = C + (size_t)(row0 + ai * HALF + m * 16) * ldc + col0;
#pragma unroll
                for (int bj = 0; bj < 2; ++bj)
#pragma unroll
                    for (int n = 0; n < 2; ++n) *(f32x4*)(rowp + bj * HALF + n * 16) = acc[ai][bj][m][n] + bv[bj][n]; }
    }
};
template <class Epi, class Sched, bool ALIGN_EPI = false, bool SP2 = false>
__device__ __forceinline__ void gemm_phase(PG8_LAS unsigned char* lds, const Gemm g, const Sched& S, const Epi& E) {
    const int tid = threadIdx.x, wid = __builtin_amdgcn_readfirstlane(tid >> 6), lane = tid & 63, wr = wid >> 2, wc = wid & 3, fr = lane & 15, fq = lane >> 4;
    const int K = g.K, nt = K / BK;
    unsigned voffA[2], voffB[2];
#pragma unroll
    for (int i = 0; i < 2; ++i) { int R, C; stage_rc(tid * 16 + i * 8192, R, C); const int Rb = Epi::PERM ? ((R & ~31) + perm32(R & 31)) : R;
        voffA[i] = (unsigned)(R * K + C) * 2u; voffB[i] = (unsigned)(Rb * K + C) * 2u; }
    const size_t kstep = (size_t)(BK * 2);
    const size_t hstep = (size_t)HALF * K * 2;
    const size_t tstep = 2 * hstep;
    const unsigned ldsw = (unsigned)wid * 1024u;
    const int aoff = lds_byte(wr * 64 + fr, fq * 8), boff = lds_byte(wc * 32 + fr, fq * 8);
#define PG8_SA(b, h) (((b) * 2 + (h)) * HTB)
#define PG8_SB(b, h) ((4 + (b) * 2 + (h)) * HTB)
#define PG8_STAGE(bufoff, gbase, voff) do { _Pragma("unroll") for (int _i = 0; _i < 2; ++_i) \
        __builtin_amdgcn_global_load_lds((const unsigned*)((const char*)(gbase) + (voff)[_i]), (PG8_LAS unsigned*)(lds + (bufoff) + ldsw + _i * 8192), 16, 0, 0); } while (0)
#define PG8_LDA(dst, b, h) do { _Pragma("unroll") for (int m = 0; m < 4; ++m) _Pragma("unroll") for (int k = 0; k < 2; ++k) dst[m][k] = *(const PG8_LAS bf16x8*)(lds + PG8_SA(b, h) + aoff + m * 2048 + k * 1024); } while (0)
#define PG8_LDB(dst, b, h) do { _Pragma("unroll") for (int n = 0; n < 2; ++n) _Pragma("unroll") for (int k = 0; k < 2; ++k) dst[n][k] = *(const PG8_LAS bf16x8*)(lds + PG8_SB(b, h) + boff + n * 2048 + k * 1024); } while (0)
#define PG8_MMA(ai, bj, At, Bt) do { __builtin_amdgcn_s_setprio(1); _Pragma("unroll") for (int m = 0; m < 4; ++m) _Pragma("unroll") for (int n = 0; n < 2; ++n) _Pragma("unroll") for (int k = 0; k < 2; ++k) \
        acc[ai][bj][m][n] = __builtin_amdgcn_mfma_f32_16x16x32_bf16(Bt[n][k], At[m][k], acc[ai][bj][m][n], 0, 0, 0); __builtin_amdgcn_s_setprio(0); } while (0)
#define PG8_WAIT_V(n) asm volatile("s_waitcnt vmcnt(" #n ")" ::: "memory")
#define PG8_WAIT_L(n) asm volatile("s_waitcnt lgkmcnt(" #n ")" ::: "memory")
#define PG8_BAR __builtin_amdgcn_s_barrier()
#define PG8_SCHED __builtin_amdgcn_sched_barrier(0)
    Unit cur, nxt; int ui = 0;
    if (!S.next(0, cur)) return;
    f32x4 acc[2][2][4][2];
#pragma unroll
    for (int a = 0; a < 2; ++a)
#pragma unroll
        for (int b = 0; b < 2; ++b)
#pragma unroll
            for (int m = 0; m < 4; ++m)
#pragma unroll
                for (int n = 0; n < 2; ++n) acc[a][b][m][n] = (f32x4){0.f, 0.f, 0.f, 0.f};
    bf16x8 At[4][2], B0[2][2], B1[2][2];
    const char* cA = (const char*)g.A + (size_t)cur.pm * tstep; const char* cB = (const char*)g.Bt + (size_t)cur.pn * tstep;
    S.a_ready(cur);
    if constexpr (SP2) {
        PG8_STAGE(PG8_SB(0, 0), cB, voffB); PG8_STAGE(PG8_SB(0, 1), cB + hstep, voffB); PG8_STAGE(PG8_SA(0, 0), cA, voffA); PG8_STAGE(PG8_SA(0, 1), cA + hstep, voffA);
        if (wr == 1) PG8_BAR;
        PG8_WAIT_V(2); PG8_BAR;
        PG8_STAGE(PG8_SB(1, 0), cB + kstep, voffB); PG8_STAGE(PG8_SA(1, 0), cA + kstep, voffA); PG8_STAGE(PG8_SB(1, 1), cB + hstep + kstep, voffB);
        PG8_WAIT_V(6); PG8_BAR;
    } else {
        PG8_STAGE(PG8_SB(0, 0), cB, voffB); PG8_STAGE(PG8_SA(0, 0), cA, voffA); PG8_STAGE(PG8_SB(0, 1), cB + hstep, voffB); PG8_STAGE(PG8_SA(0, 1), cA + hstep, voffA);
        if (wr == 1) PG8_BAR;
        PG8_WAIT_V(4); PG8_BAR;
        PG8_STAGE(PG8_SB(1, 0), cB + kstep, voffB); PG8_STAGE(PG8_SA(1, 0), cA + kstep, voffA); PG8_STAGE(PG8_SB(1, 1), cB + hstep + kstep, voffB);
        PG8_WAIT_V(6); PG8_BAR;
    }
    for (;;) {
        const bool has_next = S.next(ui + 1, nxt);
        const char* nA = has_next ? (const char*)g.A + (size_t)nxt.pm * tstep : cA; const char* nB = has_next ? (const char*)g.Bt + (size_t)nxt.pn * tstep : cB;
        for (int t = 0; t < nt; t += 2) {
            const bool last = (t == nt - 2);
            const char* a1 = cA + (size_t)(t + 1) * kstep;
            const char* a2 = last ? nA : cA + (size_t)(t + 2) * kstep; const char* b2 = last ? nB : cB + (size_t)(t + 2) * kstep;
            const char* a3 = a2 + kstep; const char* b3 = b2 + kstep;
            if (last && has_next) S.a_ready(nxt);
            if constexpr (SP2) {
            PG8_LDB(B0, 0, 0); PG8_LDB(B1, 0, 1); PG8_SCHED; PG8_LDA(At, 0, 0); PG8_STAGE(PG8_SA(1, 1), a1 + hstep, voffA);
            PG8_WAIT_V(8); PG8_WAIT_L(0); PG8_BAR; PG8_MMA(0, 0, At, B0); PG8_MMA(0, 1, At, B1); PG8_BAR; PG8_SCHED;
            PG8_LDA(At, 0, 1); PG8_STAGE(PG8_SB(0, 0), b2, voffB); PG8_STAGE(PG8_SB(0, 1), b2 + hstep, voffB); PG8_STAGE(PG8_SA(0, 0), a2, voffA);
            PG8_WAIT_V(8); PG8_WAIT_L(0); PG8_BAR; PG8_MMA(1, 0, At, B0); PG8_MMA(1, 1, At, B1); PG8_BAR; PG8_SCHED;
            PG8_LDB(B0, 1, 0); PG8_LDB(B1, 1, 1); PG8_SCHED; PG8_LDA(At, 1, 0); PG8_STAGE(PG8_SA(0, 1), a2 + hstep, voffA);
            PG8_WAIT_V(8); PG8_WAIT_L(0); PG8_BAR; PG8_MMA(0, 0, At, B0); PG8_MMA(0, 1, At, B1); PG8_BAR; PG8_SCHED;
            PG8_LDA(At, 1, 1); PG8_STAGE(PG8_SB(1, 0), b3, voffB); PG8_STAGE(PG8_SB(1, 1), b3 + hstep, voffB); PG8_STAGE(PG8_SA(1, 0), a3, voffA);
            PG8_WAIT_V(8); PG8_WAIT_L(0); PG8_BAR; PG8_MMA(1, 0, At, B0); PG8_MMA(1, 1, At, B1); PG8_BAR; PG8_SCHED;
            } else {
            PG8_LDB(B0, 0, 0); PG8_SCHED; PG8_LDA(At, 0, 0); PG8_STAGE(PG8_SA(1, 1), a1 + hstep, voffA);
            PG8_WAIT_L(8); PG8_BAR; PG8_WAIT_L(0); PG8_MMA(0, 0, At, B0); PG8_BAR; PG8_SCHED;
            PG8_LDB(B1, 0, 1); PG8_STAGE(PG8_SB(0, 0), b2, voffB);
            PG8_BAR; PG8_WAIT_L(0); PG8_MMA(0, 1, At, B1); PG8_BAR;
            PG8_LDA(At, 0, 1); PG8_STAGE(PG8_SA(0, 0), a2, voffA);
            PG8_BAR; PG8_WAIT_L(0); PG8_MMA(1, 0, At, B0); PG8_BAR; PG8_SCHED;
            PG8_STAGE(PG8_SB(0, 1), b2 + hstep, voffB);
            PG8_WAIT_V(6); PG8_BAR; PG8_MMA(1, 1, At, B1); PG8_BAR;
            PG8_LDB(B0, 1, 0); PG8_SCHED; PG8_LDA(At, 1, 0); PG8_STAGE(PG8_SA(0, 1), a2 + hstep, voffA);
            PG8_WAIT_L(8); PG8_BAR; PG8_WAIT_L(0); PG8_MMA(0, 0, At, B0); PG8_BAR; PG8_SCHED;
            PG8_LDB(B1, 1, 1); PG8_STAGE(PG8_SB(1, 0), b3, voffB);
            PG8_BAR; PG8_WAIT_L(0); PG8_MMA(0, 1, At, B1); PG8_BAR;
            PG8_LDA(At, 1, 1); PG8_STAGE(PG8_SA(1, 0), a3, voffA);
            PG8_BAR; PG8_WAIT_L(0); PG8_MMA(1, 0, At, B0); PG8_BAR; PG8_SCHED;
            PG8_STAGE(PG8_SB(1, 1), b3 + hstep, voffB);
            PG8_WAIT_V(6); PG8_BAR; PG8_MMA(1, 1, At, B1); PG8_BAR;
            }
        }
        if constexpr (ALIGN_EPI) { if (wr == 0) PG8_BAR; }
        if constexpr (!Epi::AFTER_DRAIN) { E(acc, cur, wr, wc, fr, fq); S.done(cur); }
        if (!has_next) break;
#pragma unroll
        for (int a = 0; a < 2; ++a)
#pragma unroll
            for (int b = 0; b < 2; ++b)
#pragma unroll
                for (int m = 0; m < 4; ++m)
#pragma unroll
                    for (int n = 0; n < 2; ++n) acc[a][b][m][n] = (f32x4){0.f, 0.f, 0.f, 0.f};
        cur = nxt; cA = nA; cB = nB; ++ui;
        if constexpr (ALIGN_EPI) { if (wr == 1) PG8_BAR; }
    }
    PG8_WAIT_V(0);
    if constexpr (!ALIGN_EPI) { if (wr == 0) PG8_BAR; }
    PG8_BAR;
    if constexpr (Epi::AFTER_DRAIN) { E.fused(acc, cur, wr, wc, fr, fq, lds, wid, lane); S.done(cur); }
#undef PG8_SA
#undef PG8_SB
#undef PG8_STAGE
#undef PG8_LDA
#undef PG8_LDB
#undef PG8_MMA
#undef PG8_WAIT_V
#undef PG8_WAIT_L
#undef PG8_BAR
#undef PG8_SCHED
}
}
#define GAS __attribute__((address_space(1)))
#define LAS __attribute__((address_space(3)))
typedef unsigned short bf16;
typedef float f32x4 __attribute__((ext_vector_type(4)));
typedef float f32x2 __attribute__((ext_vector_type(2)));
typedef short bf16x8 __attribute__((ext_vector_type(8)));
typedef short bf16x4 __attribute__((ext_vector_type(4)));
typedef unsigned u32x4 __attribute__((ext_vector_type(4)));
typedef unsigned u32x2 __attribute__((ext_vector_type(2)));
#define MFMA16(a, b, c) __builtin_amdgcn_mfma_f32_16x16x32_bf16((a), (b), (c), 0, 0, 0)

constexpr int NWAVES = 8, NTHR = 512;
constexpr int DM = 1024, SEQ = 4096, NB = 4, MP = NB * SEQ, MS = 128, MALL = MP + MS, MPAD = 16640;
constexpr int DI = 2048, CONVD = 3072, NH = 32, NG = 4, NST = 128;
constexpr int NPROJ = 9984;
constexpr int DFF = 2816, DFF2 = 5632;
constexpr int NPAGES = 16, PAST = 2048;
constexpr float EPS = 1e-6f, NEGF = -1e30f, BIGF = 1e30f, TINYF = 1e-30f;
constexpr int T_Z = 0, T_XBC = 8, T_Q = 20, T_KV = 24, T_MG = 30, T_MISC = 38;

constexpr size_t O_YP = 0;
constexpr size_t O_YS = O_YP + (size_t)MP * DM;
constexpr size_t O_KVP = O_YS + (size_t)MS * DM;
constexpr size_t O_KVS = O_KVP + (size_t)MP * 1024;
constexpr size_t O_WINP = O_KVS + (size_t)MS * 1024;
constexpr size_t O_WINS = O_WINP + (size_t)NB * 512 * 512;
constexpr size_t O_SSMP = O_WINS + (size_t)MS * 512 * 512;
constexpr size_t O_SSMS = O_SSMP + (size_t)NB * NH * 64 * 128;
constexpr size_t O_CONVP = O_SSMS + (size_t)MS * NH * 64 * 128;
constexpr size_t O_CONVS = O_CONVP + (size_t)NB * 3 * CONVD;
constexpr size_t O_FFNP = O_CONVS + (size_t)MS * 3 * CONVD;
constexpr size_t O_FFNS = O_FFNP + (size_t)NB * 2 * DFF2;
constexpr size_t O_END = O_FFNS + (size_t)MS * 2 * DFF2;
static_assert(O_END == 105725952, "output size");

constexpr size_t al256(size_t x) { return (x + 255) & ~(size_t)255; }
constexpr size_t WS_CTL = 0, CTL_ZERO_BYTES = 1u << 20;
constexpr size_t WS_WIN = CTL_ZERO_BYTES;
constexpr size_t WS_WSSM = WS_WIN + al256((size_t)NPROJ * 1024 * 2);
constexpr size_t WS_WATT = WS_WSSM + al256((size_t)1024 * 2048 * 2);
constexpr size_t WS_WOUT = WS_WATT + al256((size_t)1024 * 1024 * 2);
constexpr size_t WS_WUP = WS_WOUT + al256((size_t)1024 * 1024 * 2);
constexpr size_t WS_WDN = WS_WUP + al256((size_t)DFF2 * 1024 * 2);
constexpr size_t WS_WADA = WS_WDN + al256((size_t)1024 * DFF * 2);
constexpr size_t WS_W1K = WS_WADA + al256((size_t)6144 * 1024 * 2);
constexpr size_t WS_W1V = WS_W1K + al256((size_t)256 * 1024 * 2);
constexpr size_t WS_SC = WS_W1V + al256((size_t)256 * 1024 * 2);
constexpr size_t WS_MOD = WS_SC + al256((size_t)256 * 1024 * 2);
constexpr size_t WS_ROPE = WS_MOD + al256((size_t)256 * 6144 * 4);
constexpr size_t WS_PET = WS_ROPE + al256((size_t)4096 * 16 * 4);
constexpr size_t WS_H = WS_PET + al256(2 * 128 * 4);
constexpr size_t WS_Z = WS_H + al256((size_t)MPAD * 1024 * 2);
constexpr size_t WS_XBC = WS_Z + al256((size_t)MPAD * 2048 * 2);
constexpr size_t WS_Q = WS_XBC + al256((size_t)MPAD * 3072 * 2);
constexpr size_t WS_MG = WS_Q + al256((size_t)MPAD * 1024 * 2);
constexpr size_t WS_MISC = WS_MG + al256((size_t)MPAD * 2048 * 2);
constexpr size_t WS_KVH = WS_MISC + al256((size_t)MPAD * 128 * 4);
constexpr size_t WS_VT = WS_KVH + al256((size_t)6 * 16 * 4096 * 64 * 2);
constexpr size_t WS_XT = WS_VT + al256((size_t)2 * 16 * 64 * 4096 * 2);
constexpr size_t WS_BN = WS_XT + al256((size_t)4 * 32 * 64 * 4096 * 2);
constexpr size_t WS_CN = WS_BN + al256((size_t)16 * 4096 * 128 * 2);
constexpr size_t WS_BT = WS_CN + al256((size_t)16 * 4096 * 128 * 2);
constexpr size_t WS_DT = WS_BT + al256((size_t)16 * 4096 * 128 * 2);
constexpr size_t WS_CS = WS_DT + al256((size_t)128 * 4096 * 4);
constexpr size_t WS_STATES = WS_CS + al256((size_t)128 * 4096 * 4);
constexpr size_t WS_HPREV = WS_STATES + al256((size_t)4096 * 8192 * 4);
constexpr size_t WS_YSSM = WS_HPREV + al256((size_t)4096 * 8192 * 2);
constexpr size_t WS_SSQ = WS_YSSM + al256((size_t)MPAD * 2048 * 2);
constexpr size_t WS_PARTK = WS_SSQ + al256((size_t)MPAD * 4 * 4);
constexpr size_t WS_PARTV = WS_PARTK + al256((size_t)4096 * 256 * 4);
constexpr size_t WS_KC = WS_PARTV + al256((size_t)4096 * 256 * 4);
constexpr size_t WS_VCT = WS_KC + al256((size_t)16 * 256 * 64 * 2);
constexpr size_t WS_YATTF = WS_VCT + al256((size_t)16 * 256 * 64 * 2);
constexpr size_t WS_YATT = WS_YATTF + al256((size_t)MPAD * 1024 * 4);
constexpr size_t WS_TMPM = WS_YATT + al256((size_t)MPAD * 1024 * 2);
constexpr size_t WS_MERGED = WS_TMPM + al256((size_t)MPAD * 1024 * 4);
constexpr size_t WS_X1 = WS_MERGED + al256((size_t)MPAD * 1024 * 2);
constexpr size_t WS_U = WS_X1 + al256((size_t)MPAD * 1024 * 4);
constexpr size_t WS_ACT = WS_U + al256((size_t)MPAD * DFF2 * 2);
constexpr size_t WS_CKB = WS_ACT + al256((size_t)MPAD * DFF * 2);
constexpr size_t WS_CVB = WS_CKB + al256((size_t)128 * 4 * 2048 * 64 * 2);
constexpr size_t WS_PARTSK = WS_CVB + al256((size_t)128 * 4 * 2048 * 64 * 2);
constexpr size_t WS_PARTSV = WS_PARTSK + al256((size_t)65536 * 256 * 4);
constexpr size_t WS_KCS = WS_PARTSV + al256((size_t)65536 * 256 * 4);
constexpr size_t WS_VCS = WS_KCS + al256((size_t)128 * 4 * 128 * 64 * 4);
constexpr size_t WS_XCS = WS_VCS + al256((size_t)128 * 4 * 128 * 64 * 4);
constexpr size_t WS_DTS = WS_XCS + al256((size_t)128 * 3072 * 4);
constexpr size_t WS_W2T = WS_DTS + al256((size_t)128 * 32 * 4);
constexpr size_t WS_END = WS_W2T + al256((size_t)2 * 64 * 128 * 2);

constexpr int CW_BAR = 4096;

constexpr int RING_BYTES = 131072;
constexpr int LDSCTL_OFF = RING_BYTES, MISC_OFF = LDSCTL_OFF + 320;
constexpr int LDS_BYTES = 147456;

__device__ __forceinline__ unsigned f2bf(float f) { unsigned u = __builtin_bit_cast(unsigned, f); return (u + 0x7fffu + ((u >> 16) & 1u)) >> 16; }
__device__ __forceinline__ unsigned pk2(float lo, float hi) { return pg8::cvt_pk_bf16(lo, hi); }
__device__ __forceinline__ float bf2f(unsigned h) { return __builtin_bit_cast(float, h << 16); }
__device__ __forceinline__ float bflo(unsigned w) { return __builtin_bit_cast(float, w << 16); }
__device__ __forceinline__ float bfhi(unsigned w) { return __builtin_bit_cast(float, w & 0xffff0000u); }
__device__ __forceinline__ float wave_sum(float v) {
#pragma unroll
    for (int o = 1; o < 64; o <<= 1) v += __shfl_xor(v, o);
    return v;
}
__device__ __forceinline__ float siluf(float x) { return x / (1.f + __expf(-x)); }
__device__ __forceinline__ float sigmf(float x) { return 1.f / (1.f + __expf(-x)); }
__device__ __forceinline__ float softplusf(float x) { return x > 20.f ? x : log1pf(__expf(x)); }
#define LDS_WAIT() asm volatile("s_waitcnt lgkmcnt(0)" ::: "memory")

struct Args { const void* in[35]; float* out; unsigned char* ws; int ph_lo, ph_hi, p7mask, pad; };
#define INF(i) ((const float*)args.in[i])
#define XB_TMO      128
#define XB_XCNT(j)  (256  + 64 * (j))
#define XB_XSUB(j)  (1280 + 64 * (j))
#define XB_XGEN(j)  (2304 + 64 * (j))
#define XB_TOP      3328
#define XB_TOPGEN   3392
#define XCD_BAR_WORDS 3456
#define XB_SPIN_CAP (1u << 18)

__device__ __forceinline__ unsigned xb_ld(unsigned* p)              { return __hip_atomic_load(p, __ATOMIC_RELAXED, __HIP_MEMORY_SCOPE_AGENT); }
__device__ __forceinline__ unsigned xb_add(unsigned* p, unsigned v) { return __hip_atomic_fetch_add(p, v, __ATOMIC_RELAXED, __HIP_MEMORY_SCOPE_AGENT); }
__device__ __forceinline__ unsigned xb_xcc_id() { return (unsigned)__builtin_amdgcn_s_getreg((3 << 11) | 20) & 0xFu; }
#define XB_SPIN(cond, bar) do { unsigned _sp = 0; while (cond) { __builtin_amdgcn_s_sleep(1); \
    if ((++_sp & 255u) == 0u) { if (xb_ld(&(bar)[XB_TMO])) break; if (_sp > XB_SPIN_CAP) { atomicAdd(&(bar)[XB_TMO], 1u); break; } } } } while (0)

struct XcdBarrier {
    unsigned* bar; unsigned x;
    volatile LAS unsigned* st;
};

__device__ __forceinline__ XcdBarrier xcd_barrier_post(unsigned* bar, volatile LAS unsigned* st) {
    XcdBarrier b; b.bar = bar; b.x = xb_xcc_id(); b.st = st;
    if (threadIdx.x == 0) (void)xb_add(&bar[XB_XCNT(b.x)], 1u);
    return b;
}
__device__ __forceinline__ void xcd_barrier_complete(unsigned* bar, unsigned x, unsigned& nloc, unsigned& nx) {
    const unsigned G = gridDim.x * gridDim.y * gridDim.z;
    unsigned sum, cnt, mine, sp = 0u;
    for (;;) {
        sum = 0u; cnt = 0u; mine = 0u;
#pragma unroll
        for (unsigned j = 0; j < 16; ++j) { const unsigned c = xb_ld(&bar[XB_XCNT(j)]); sum += c; cnt += (c > 0u) ? 1u : 0u; mine = (j == x) ? c : mine; }
        if (sum == G) break;
        __builtin_amdgcn_s_sleep(1);
        if ((++sp & 255u) == 0u) { if (xb_ld(&bar[XB_TMO])) break; if (sp > XB_SPIN_CAP) { atomicAdd(&bar[XB_TMO], 1u); break; } }
    }
    nloc = mine > 0u ? mine : 1u; nx = cnt > 0u ? cnt : 1u;
}

__device__ __forceinline__ void xcd_barrier(const XcdBarrier& b) {
    asm volatile("s_waitcnt vmcnt(0)" ::: "memory");
    __syncthreads();
    if (threadIdx.x == 0) {
        unsigned* bar = b.bar;
        __builtin_amdgcn_s_waitcnt(0);
        unsigned nloc = b.st[0], nx = b.st[1];
        if (nloc == 0u) { xcd_barrier_complete(bar, b.x, nloc, nx); b.st[0] = nloc; b.st[1] = nx; }
        const unsigned old = xb_add(&bar[XB_XSUB(b.x)], 1u);
        const unsigned gen = old / nloc;
        if (old + 1u == (gen + 1u) * nloc) {
            __builtin_amdgcn_fence(__ATOMIC_RELEASE, "agent");
            asm volatile("s_waitcnt vmcnt(0)" ::: "memory");
            const unsigned og = xb_add(&bar[XB_TOP], 1u);
            const unsigned tg = og / nx;
            if (og + 1u == (tg + 1u) * nx) xb_add(&bar[XB_TOPGEN], 1u);
            else XB_SPIN(xb_ld(&bar[XB_TOPGEN]) == tg, bar);
            __builtin_amdgcn_fence(__ATOMIC_ACQUIRE, "agent");
            xb_add(&bar[XB_XGEN(b.x)], 1u);
            asm volatile("s_waitcnt vmcnt(0)" ::: "memory");
        } else {
            XB_SPIN(xb_ld(&bar[XB_XGEN(b.x)]) == gen, bar);
            __builtin_amdgcn_fence(__ATOMIC_ACQUIRE, "agent");
            asm volatile("s_waitcnt vmcnt(0)" ::: "memory");
        }
    }
    __syncthreads();
}
__device__ __forceinline__ int inproj_src_col(int n) {
    if (n < 5120) return n;
    if (n < 6144) return n - 5120 + 5152;
    if (n < 7680) return n - 6144 + 6176;
    if (n < 9728) return n - 7680 + 7760;
    const int i = n - 9728;
    if (i < 32) return 5120 + i;
    if (i < 80) return 7712 + (i - 32);
    return -1;
}
template <int MODE>
__device__ __forceinline__ void transpose_item(const float* W, int K, int ldw, int nblk, bf16* WT, int row_off, LAS float* scr, int item, int lane) {
    const int kb = item / nblk, nb = item % nblk, k0 = 64 * kb, n0 = 32 * nb;
    const int n = n0 + (lane & 31);
    const int sc = (MODE == 1) ? inproj_src_col(n) : n;
#pragma unroll 8
    for (int i = 0; i < 32; ++i) { const int kk = 2 * i + (lane >> 5); scr[kk * 33 + (lane & 31)] = (sc >= 0) ? W[(size_t)(k0 + kk) * ldw + sc] : 0.f; }
    LDS_WAIT(); asm volatile("" ::: "memory");
    const int c = lane & 7;
#pragma unroll
    for (int j = 0; j < 4; ++j) { const int nn = (lane >> 3) + 8 * j; const LAS float* s = scr + (8 * c) * 33 + nn;
        u32x4 o; o.x = pk2(s[0 * 33], s[1 * 33]); o.y = pk2(s[2 * 33], s[3 * 33]); o.z = pk2(s[4 * 33], s[5 * 33]); o.w = pk2(s[6 * 33], s[7 * 33]);
        *(u32x4*)(WT + (size_t)(row_off + n0 + nn) * K + k0 + 8 * c) = o; }
    LDS_WAIT(); asm volatile("" ::: "memory");
}

__device__ __forceinline__ void p0_prologue(const Args& args, LAS unsigned char* lds, int gw, int NGW, int lane, int wave) {
    unsigned char* ws = args.ws;
    const int p0m = args.pad;
    LAS float* scr = (LAS float*)(lds + wave * 16384);
    constexpr int I_IN = 16 * (NPROJ / 32), I_SSM = 32 * 32, I_ATT = 16 * 32, I_OUT = 16 * 32, I_UP = 16 * (DFF2 / 32), I_DN = (DFF / 64) * 32, I_ADA = 16 * (6144 / 32), I_W1 = 16 * 4;
    constexpr int NITEMS = I_IN + I_SSM + I_ATT + I_OUT + I_UP + I_DN + I_ADA + 4 * I_W1;
    if (p0m & 1) for (int it = gw; it < NITEMS; it += NGW) {
        int r = it;
        if (r < I_ADA) { transpose_item<0>(INF(10), 1024, 6144, 6144 / 32, (bf16*)(ws + WS_WADA), 0, scr, r, lane); continue; } r -= I_ADA;
        if (r < I_IN) { transpose_item<1>(INF(15), 1024, 9808, NPROJ / 32, (bf16*)(ws + WS_WIN), 0, scr, r, lane); continue; } r -= I_IN;
        if (r < I_SSM) { transpose_item<0>(INF(28), 2048, 1024, 32, (bf16*)(ws + WS_WSSM), 0, scr, r, lane); continue; } r -= I_SSM;
        if (r < I_ATT) { transpose_item<0>(INF(29), 1024, 1024, 32, (bf16*)(ws + WS_WATT), 0, scr, r, lane); continue; } r -= I_ATT;
        if (r < I_OUT) { transpose_item<0>(INF(30), 1024, 1024, 32, (bf16*)(ws + WS_WOUT), 0, scr, r, lane); continue; } r -= I_OUT;
        if (r < I_UP) { transpose_item<0>(INF(31), 1024, DFF2, DFF2 / 32, (bf16*)(ws + WS_WUP), 0, scr, r, lane); continue; } r -= I_UP;
        if (r < I_DN) { transpose_item<0>(INF(34), DFF, 1024, 32, (bf16*)(ws + WS_WDN), 0, scr, r, lane); continue; } r -= I_DN;
        { const int which = r / I_W1, rr = r % I_W1; const int st = which >> 1, r2 = which & 1;
          transpose_item<0>(INF(st ? 26 : 23) + (size_t)r2 * 16 * 64 * 128, 1024, 128, 4, (bf16*)(ws + (st ? WS_W1V : WS_W1K)), r2 * 128, scr, rr, lane); }
    }
    if (p0m & 4) {
    for (int r = gw; r < 256; r += NGW) {
        bf16* o = (bf16*)(ws + WS_SC) + (size_t)r * 1024;
        const float* src = r < 4 ? INF(2) + (size_t)r * 1024 : (r < 132 ? INF(3) + (size_t)(r - 4) * 1024 : nullptr);
#pragma unroll
        for (int j = 0; j < 4; ++j) { const int c0 = (j * 64 + lane) * 4; f32x4 v = src ? *(const f32x4*)(src + c0) : (f32x4){0.f, 0.f, 0.f, 0.f};
            u32x2 w; w.x = pk2(src ? siluf(v.x) : 0.f, src ? siluf(v.y) : 0.f); w.y = pk2(src ? siluf(v.z) : 0.f, src ? siluf(v.w) : 0.f); *(u32x2*)(o + c0) = w; }
    }
    for (int i = gw * 64 + lane; i < 4096 * 8; i += NGW * 64) {
        const int pos = i >> 3, k = i & 7;
        const float invf[8] = {1.0f, 0.1939227432012558f, 0.03760603070259094f, 0.007292664609849453f, 0.0014142135623842478f, 0.00027424818836152554f, 5.318296098266728e-05f, 1.0313386155758053e-05f};
        float fr = 1.0f;
#pragma unroll
        for (int q = 0; q < 8; ++q) fr = (k == q) ? invf[q] : fr;
        const float ang = (float)pos * fr;
        const double ad = (double)ang, rev = ad * 0.15915494309189535;
        const float fracrev = (float)(rev - __builtin_floor(rev));
        float* o = (float*)(ws + WS_ROPE) + (size_t)pos * 16;
        o[k] = __builtin_amdgcn_cosf(fracrev); o[8 + k] = __builtin_amdgcn_sinf(fracrev);
    }
    for (int it = gw; it < 256; it += NGW) {
        const int st = it >> 7, e = it & 127; const float* pe = INF(st ? 25 : 22); const float* w1 = INF(st ? 26 : 23);
        float s = 0.f;
        for (int i = 0; i < 32; ++i) { const int idx = lane + 64 * i; s += pe[idx] * w1[(size_t)idx * 128 + e]; }
        s = wave_sum(s);
        if (lane == 0) ((float*)(ws + WS_PET))[it] = s;
    }
    }
    if (p0m & 2) {
        const int* pt = (const int*)args.in[5]; const float* cache = INF(4);
        constexpr int NIT = 128 * 2 * 4 * 256;
        const int r = lane >> 3, c = lane & 7;
        for (int it0 = gw; it0 < NIT; it0 += 4 * NGW) {
            f32x4 v[4][2];
#pragma unroll
            for (int k = 0; k < 4; ++k) { const int it = it0 + k * NGW;
                if (it < NIT) { const int tg = it & 255, h = (it >> 8) & 3, s = (it >> 10) & 1, b = it >> 11; const int t = tg * 8 + r; const int page = pt[b * NPAGES + (tg >> 4)];
                    const float* src = cache + (((size_t)page * 128 + (t & 127)) * 4 + s) * 256 + h * 64 + c * 8;
                    v[k][0] = *(const f32x4*)src; v[k][1] = *(const f32x4*)(src + 4); } }
#pragma unroll
            for (int k = 0; k < 4; ++k) { const int it = it0 + k * NGW;
                if (it < NIT) { const int tg = it & 255, h = (it >> 8) & 3, s = (it >> 10) & 1, b = it >> 11;
                    bf16* dst = (bf16*)(ws + (s ? WS_CVB : WS_CKB)) + (((size_t)(b * 4 + h) * 2048 + tg * 8 + r) * 64 + c * 8);
                    u32x4 w; w.x = pk2(v[k][0].x, v[k][0].y); w.y = pk2(v[k][0].z, v[k][0].w); w.z = pk2(v[k][1].x, v[k][1].y); w.w = pk2(v[k][1].z, v[k][1].w); *(u32x4*)dst = w; } }
        }
    }
    if (p0m & 4) for (int i = gw * 64 + lane; i < 2 * 64 * 128; i += NGW * 64) { const int st = i >> 13, d = (i >> 7) & 63, e = i & 127;
        ((bf16*)(ws + WS_W2T))[i] = (bf16)f2bf(INF(st ? 27 : 24)[e * 64 + d]); }
}

template <int WHICH>
__device__ __forceinline__ void norm_mod_phase(const Args& args, int gw, int NGW, int lane) {
    unsigned char* ws = args.ws; const float* MOD = (const float*)(ws + WS_MOD); bf16* H = (bf16*)(ws + WS_H);
    const float* nw = INF(WHICH == 0 ? 12 : (WHICH == 1 ? 13 : 14));
    constexpr int SH = WHICH ? 3072 : 0, SCo = WHICH ? 4096 : 1024;
    for (int grp = gw; grp < MPAD / 4; grp += NGW) {
        const int m0 = grp * 4;
        if (m0 >= MALL) {
            if (WHICH < 2) {
#pragma unroll
                for (int r = 0; r < 4; ++r)
#pragma unroll
                    for (int j = 0; j < 4; ++j) ((u32x2*)(H + (size_t)(m0 + r) * 1024))[j * 64 + lane] = (u32x2){0u, 0u};
            }
            continue; }
        f32x4 v[4][4]; float ss[4];
#pragma unroll
        for (int r = 0; r < 4; ++r) { const int m = m0 + r;
            const float* xr = WHICH ? (const float*)(ws + WS_X1) + (size_t)m * 1024 : (m < MP ? INF(0) + (size_t)m * 1024 : INF(1) + (size_t)(m - MP) * 1024);
            float s = 0.f;
#pragma unroll
            for (int j = 0; j < 4; ++j) { v[r][j] = *(const f32x4*)(xr + (j * 64 + lane) * 4); s += (v[r][j].x * v[r][j].x + v[r][j].y * v[r][j].y) + (v[r][j].z * v[r][j].z + v[r][j].w * v[r][j].w); }
            ss[r] = s; }
#pragma unroll
        for (int o = 1; o < 64; o <<= 1)
#pragma unroll
            for (int r = 0; r < 4; ++r) ss[r] += __shfl_xor(ss[r], o);
        f32x4 w[4];
#pragma unroll
        for (int j = 0; j < 4; ++j) w[j] = *(const f32x4*)(nw + (j * 64 + lane) * 4);
#pragma unroll
        for (int r = 0; r < 4; ++r) { const int m = m0 + r;
            const float rstd = 1.f / sqrtf(ss[r] * (1.f / 1024.f) + EPS);
            if (WHICH == 2) { float* o = args.out + (m < MP ? O_YP + (size_t)m * 1024 : O_YS + (size_t)(m - MP) * 1024);
#pragma unroll
                for (int j = 0; j < 4; ++j) *(f32x4*)(o + (j * 64 + lane) * 4) = (v[r][j] * rstd) * w[j];
            } else {
                const float* mr = MOD + (size_t)(m < MP ? (m >> 12) : 4 + (m - MP)) * 6144;
                u32x2* o = (u32x2*)(H + (size_t)m * 1024);
#pragma unroll
                for (int j = 0; j < 4; ++j) { const int c0 = (j * 64 + lane) * 4;
                    const f32x4 sc = *(const f32x4*)(mr + SCo + c0), sh = *(const f32x4*)(mr + SH + c0);
                    const f32x4 rr = (v[r][j] * rstd) * w[j] * (sc + 1.f) + sh;
                    u32x2 pk; pk.x = pk2(rr.x, rr.y); pk.y = pk2(rr.z, rr.w); o[j * 64 + lane] = pk; }
            }
        }
    }
}
namespace epi {
using pg8::Unit; using pg8::f32x4;
typedef unsigned u32x4 __attribute__((ext_vector_type(4)));
__device__ __forceinline__ u32x4 pack8(const f32x4& a, const f32x4& b) { u32x4 w; w.x = pg8::cvt_pk_bf16(a[0], a[1]); w.y = pg8::cvt_pk_bf16(a[2], a[3]); w.z = pg8::cvt_pk_bf16(b[0], b[1]); w.w = pg8::cvt_pk_bf16(b[2], b[3]); return w; }

struct InProj {
    static constexpr bool PERM = true, AFTER_DRAIN = false;
    unsigned char* ws; float* out;
    __device__ __forceinline__ void operator()(const f32x4 (&acc)[2][2][4][2], const Unit& u, int wr, int wc, int fr, int fq) const {
        const int pn = u.pn;
        const int rowb = u.pm * 256 + wr * 64 + fr;
        const int cl = wc * 32 + 8 * fq;
        if (pn < T_XBC || (pn >= T_MG && pn < T_MISC)) {
            bf16* base = pn < T_XBC ? (bf16*)(ws + WS_Z) : (bf16*)(ws + WS_MG);
            const int colt = (pn < T_XBC ? pn : pn - T_MG) * 256 + cl;
#pragma unroll
            for (int ai = 0; ai < 2; ++ai)
#pragma unroll
                for (int m = 0; m < 4; ++m) { const int row = rowb + ai * 128 + m * 16;
#pragma unroll
                    for (int bj = 0; bj < 2; ++bj) *(u32x4*)(base + (size_t)row * 2048 + colt + bj * 128) = pack8(acc[ai][bj][m][0], acc[ai][bj][m][1]); }
        } else if (pn < T_Q) {
            bf16* base = (bf16*)(ws + WS_XBC); const int colt = (pn - T_XBC) * 256 + cl;
#pragma unroll
            for (int ai = 0; ai < 2; ++ai)
#pragma unroll
                for (int m = 0; m < 4; ++m) { const int row = rowb + ai * 128 + m * 16;
                    float* fo = nullptr;
                    if (row < MP) { const int t = row & 4095; if (t >= 4093) fo = out + O_CONVP + ((size_t)(row >> 12) * 3 + (t - 4093)) * CONVD; }
                    else if (row < MALL) fo = out + O_CONVS + ((size_t)(row - MP) * 3 + 2) * CONVD;
#pragma unroll
                    for (int bj = 0; bj < 2; ++bj) { const int col = colt + bj * 128;
                        *(u32x4*)(base + (size_t)row * CONVD + col) = pack8(acc[ai][bj][m][0], acc[ai][bj][m][1]);
                        if (fo) { *(f32x4*)(fo + col) = acc[ai][bj][m][0]; *(f32x4*)(fo + col + 4) = acc[ai][bj][m][1]; } } }
        } else if (pn < T_MG) {
            const bool isq = pn < T_KV; const int s = pn - T_KV;
            const bool dorope = (isq || !(s & 1)) && !(wc & 1);
            const float* rope = (const float*)(ws + WS_ROPE);
#pragma unroll
            for (int ai = 0; ai < 2; ++ai)
#pragma unroll
                for (int m = 0; m < 4; ++m) { const int row = rowb + ai * 128 + m * 16;
                    const int pos = row < MP ? (row & 4095) : PAST;
#pragma unroll
                    for (int bj = 0; bj < 2; ++bj) {
                        f32x4 v0 = acc[ai][bj][m][0], v1 = acc[ai][bj][m][1];
                        if (dorope) {
                            f32x4 o0, o1;
#pragma unroll
                            for (int i = 0; i < 4; ++i) { o0[i] = __shfl_xor(v0[i], 16); o1[i] = __shfl_xor(v1[i], 16); }
                            if (fq < 2) {
                                const f32x4 c0 = *(const f32x4*)(rope + pos * 16), c1 = *(const f32x4*)(rope + pos * 16 + 4), s0 = *(const f32x4*)(rope + pos * 16 + 8), s1 = *(const f32x4*)(rope + pos * 16 + 12);
                                if (fq == 0) { v0 = v0 * c0 - o0 * s0; v1 = v1 * c1 - o1 * s1; }
                                else         { v0 = v0 * c0 + o0 * s0; v1 = v1 * c1 + o1 * s1; }
                            }
                        }
                        const int col = cl + bj * 128;
                        const u32x4 pk = pack8(v0, v1);
                        if (isq) { *(u32x4*)((bf16*)(ws + WS_Q) + (size_t)row * 1024 + (pn - T_Q) * 256 + col) = pk; }
                        else {
                            const int h = col >> 6, d = col & 63;
                            if (row < MP) {
                                const int b = row >> 12, t = row & 4095;
                                *(u32x4*)((bf16*)(ws + WS_KVH) + ((((size_t)s * 4 + b) * 4 + h) * 4096 + t) * 64 + d) = pk;
                                if (s < 4) { float* fo = out + O_KVP + ((size_t)row * 4 + s) * 256 + col; *(f32x4*)fo = v0; *(f32x4*)(fo + 4) = v1; }
                                else if (t >= 3584) { float* fo = out + O_WINP + (((size_t)b * 512 + (t - 3584)) * 2 + (s - 4)) * 256 + col; *(f32x4*)fo = v0; *(f32x4*)(fo + 4) = v1; }
                                if (s == 3 || s == 5) {
                                    const int kk = t & 31, kpos = 8 * ((kk & 15) >> 2) + 4 * (kk >> 4) + (kk & 3);
                                    bf16* vt = (bf16*)(ws + WS_VT) + ((((size_t)(s == 5) * 4 + b) * 4 + h) * 128 + (t >> 5)) * 2048 + d * 32 + kpos;
                                    vt[0 * 32] = (bf16)(pk.x & 0xffffu); vt[1 * 32] = (bf16)(pk.x >> 16); vt[2 * 32] = (bf16)(pk.y & 0xffffu); vt[3 * 32] = (bf16)(pk.y >> 16);
                                    vt[4 * 32] = (bf16)(pk.z & 0xffffu); vt[5 * 32] = (bf16)(pk.z >> 16); vt[6 * 32] = (bf16)(pk.w & 0xffffu); vt[7 * 32] = (bf16)(pk.w >> 16);
                                }
                            } else if (row < MALL) {
                                const int bs = row - MP;
                                float* fo = s < 4 ? out + O_KVS + ((size_t)bs * 4 + s) * 256 + col : out + O_WINS + (((size_t)bs * 512 + 511) * 2 + (s - 4)) * 256 + col;
                                *(f32x4*)fo = v0; *(f32x4*)(fo + 4) = v1;
                            }
                        }
                    } }
        } else {
            float* base = (float*)(ws + WS_MISC);
#pragma unroll
            for (int ai = 0; ai < 2; ++ai)
#pragma unroll
                for (int m = 0; m < 4; ++m) { const int row = rowb + ai * 128 + m * 16;
                    *(f32x4*)(base + (size_t)row * 128 + cl) = acc[ai][0][m][0]; *(f32x4*)(base + (size_t)row * 128 + cl + 4) = acc[ai][0][m][1]; }
        }
    }
};

struct Merge1 {
    static constexpr bool PERM = true, AFTER_DRAIN = false;
    unsigned char* ws;
    __device__ __forceinline__ void operator()(const f32x4 (&acc)[2][2][4][2], const Unit& u, int wr, int wc, int fr, int fq) const {
        const int rowb = u.pm * 256 + wr * 64 + fr, colb = u.pn * 256 + wc * 32 + 8 * fq;
        const bf16* MG = (const bf16*)(ws + WS_MG); const float* SSQ = (const float*)(ws + WS_SSQ); float* T = (float*)(ws + WS_TMPM);
#pragma unroll
        for (int ai = 0; ai < 2; ++ai)
#pragma unroll
            for (int m = 0; m < 4; ++m) { const int row = rowb + ai * 128 + m * 16;
                const f32x4 sq = *(const f32x4*)(SSQ + (size_t)row * 4);
                const float rstd = 1.f / sqrtf(((sq.x + sq.y) + (sq.z + sq.w)) * (1.f / 2048.f) + EPS);
#pragma unroll
                for (int bj = 0; bj < 2; ++bj) { const int col = colb + bj * 128;
                    const u32x4 g = *(const u32x4*)(MG + (size_t)row * 2048 + col);
                    f32x4 o0, o1;
                    o0[0] = sigmf(bflo(g.x)) * rstd * acc[ai][bj][m][0][0]; o0[1] = sigmf(bfhi(g.x)) * rstd * acc[ai][bj][m][0][1];
                    o0[2] = sigmf(bflo(g.y)) * rstd * acc[ai][bj][m][0][2]; o0[3] = sigmf(bfhi(g.y)) * rstd * acc[ai][bj][m][0][3];
                    o1[0] = sigmf(bflo(g.z)) * rstd * acc[ai][bj][m][1][0]; o1[1] = sigmf(bfhi(g.z)) * rstd * acc[ai][bj][m][1][1];
                    o1[2] = sigmf(bflo(g.w)) * rstd * acc[ai][bj][m][1][2]; o1[3] = sigmf(bfhi(g.w)) * rstd * acc[ai][bj][m][1][3];
                    *(f32x4*)(T + (size_t)row * 1024 + col) = o0; *(f32x4*)(T + (size_t)row * 1024 + col + 4) = o1; } }
    }
};
struct Merge2 {
    static constexpr bool PERM = true, AFTER_DRAIN = false;
    unsigned char* ws;
    __device__ __forceinline__ void operator()(const f32x4 (&acc)[2][2][4][2], const Unit& u, int wr, int wc, int fr, int fq) const {
        const int rowb = u.pm * 256 + wr * 64 + fr, colb = u.pn * 256 + wc * 32 + 8 * fq;
        const bf16* MG = (const bf16*)(ws + WS_MG); const float* T = (const float*)(ws + WS_TMPM); bf16* O = (bf16*)(ws + WS_MERGED);
#pragma unroll
        for (int ai = 0; ai < 2; ++ai)
#pragma unroll
            for (int m = 0; m < 4; ++m) { const int row = rowb + ai * 128 + m * 16;
#pragma unroll
                for (int bj = 0; bj < 2; ++bj) { const int col = colb + bj * 128;
                    const u32x4 g = *(const u32x4*)(MG + (size_t)row * 2048 + 1024 + col);
                    f32x4 o0 = *(const f32x4*)(T + (size_t)row * 1024 + col), o1 = *(const f32x4*)(T + (size_t)row * 1024 + col + 4);
                    o0[0] += sigmf(bflo(g.x)) * acc[ai][bj][m][0][0]; o0[1] += sigmf(bfhi(g.x)) * acc[ai][bj][m][0][1];
                    o0[2] += sigmf(bflo(g.y)) * acc[ai][bj][m][0][2]; o0[3] += sigmf(bfhi(g.y)) * acc[ai][bj][m][0][3];
                    o1[0] += sigmf(bflo(g.z)) * acc[ai][bj][m][1][0]; o1[1] += sigmf(bfhi(g.z)) * acc[ai][bj][m][1][1];
                    o1[2] += sigmf(bflo(g.w)) * acc[ai][bj][m][1][2]; o1[3] += sigmf(bfhi(g.w)) * acc[ai][bj][m][1][3];
                    *(u32x4*)(O + (size_t)row * 1024 + col) = pack8(o0, o1); } }
    }
};
struct Resid {
    static constexpr bool PERM = false, AFTER_DRAIN = false;
    const float* xp; const float* xs; const float* x1in; float* x1out; const float* MOD; int goff;
    __device__ __forceinline__ void operator()(const f32x4 (&acc)[2][2][4][2], const Unit& u, int wr, int wc, int fr, int fq) const {
        const int rowb = u.pm * 256 + wr * 64 + fr, colb = u.pn * 256 + wc * 32 + 4 * fq;
#pragma unroll
        for (int ai = 0; ai < 2; ++ai)
#pragma unroll
            for (int m = 0; m < 4; ++m) { const int row = rowb + ai * 128 + m * 16;
                if (row >= MALL) continue;
                const float* base = x1in ? x1in + (size_t)row * 1024 : (row < MP ? xp + (size_t)row * 1024 : xs + (size_t)(row - MP) * 1024);
                const float* gr = MOD + (size_t)(row < MP ? (row >> 12) : 4 + (row - MP)) * 6144 + goff;
#pragma unroll
                for (int bj = 0; bj < 2; ++bj)
#pragma unroll
                    for (int n = 0; n < 2; ++n) { const int col = colb + bj * 128 + n * 16;
                        *(f32x4*)(x1out + (size_t)row * 1024 + col) = *(const f32x4*)(base + col) + *(const f32x4*)(gr + col) * acc[ai][bj][m][n]; } }
    }
};
struct Up {
    static constexpr bool PERM = true, AFTER_DRAIN = false;
    unsigned char* ws; float* out;
    __device__ __forceinline__ void operator()(const f32x4 (&acc)[2][2][4][2], const Unit& u, int wr, int wc, int fr, int fq) const {
        const int rowb = u.pm * 256 + wr * 64 + fr, colb = u.pn * 256 + wc * 32 + 8 * fq;
        bf16* U = (bf16*)(ws + WS_U);
#pragma unroll
        for (int ai = 0; ai < 2; ++ai)
#pragma unroll
            for (int m = 0; m < 4; ++m) { const int row = rowb + ai * 128 + m * 16;
                float* fo = nullptr;
                if (row < MP) { const int t = row & 4095; if (t >= 4094) fo = out + O_FFNP + ((size_t)(row >> 12) * 2 + (t - 4094)) * DFF2; }
                else if (row < MALL) fo = out + O_FFNS + ((size_t)(row - MP) * 2 + 1) * DFF2;
#pragma unroll
                for (int bj = 0; bj < 2; ++bj) { const int col = colb + bj * 128;
                    *(u32x4*)(U + (size_t)row * DFF2 + col) = pack8(acc[ai][bj][m][0], acc[ai][bj][m][1]);
                    if (fo) { *(f32x4*)(fo + col) = acc[ai][bj][m][0]; *(f32x4*)(fo + col + 4) = acc[ai][bj][m][1]; } } }
    }
};
struct PartBf16 {
    static constexpr bool PERM = true, AFTER_DRAIN = false;
    bf16* P;
    __device__ __forceinline__ void operator()(const f32x4 (&acc)[2][2][4][2], const Unit& u, int wr, int wc, int fr, int fq) const {
        const int rowb = u.pm * 256 + wr * 64 + fr, colb = wc * 32 + 8 * fq;
#pragma unroll
        for (int ai = 0; ai < 2; ++ai)
#pragma unroll
            for (int m = 0; m < 4; ++m) { const int row = rowb + ai * 128 + m * 16;
#pragma unroll
                for (int bj = 0; bj < 2; ++bj) *(u32x4*)(P + (size_t)row * 256 + colb + bj * 128) = pack8(acc[ai][bj][m][0], acc[ai][bj][m][1]); }
    }
};
}
__device__ __forceinline__ void conv_prompt_item(const Args& args, int item, int lane) {
    unsigned char* ws = args.ws;
    const int tg = item / 48, cgp = item % 48, cg = lane & 7, rg = lane >> 3;
    const int m0 = tg * 64 + 8 * rg, b = m0 >> 12, t0 = m0 & 4095, ch0 = cgp * 64 + 8 * cg;
    const bf16* X = (const bf16*)(ws + WS_XBC);
    float x[11][8];
#pragma unroll
    for (int i = 0; i < 11; ++i) {
        const int t = t0 - 3 + i;
        u32x4 v = (u32x4){0u, 0u, 0u, 0u};
        if (t >= 0) v = *(const u32x4*)(X + (size_t)(m0 - 3 + i) * CONVD + ch0);
        x[i][0] = bflo(v.x); x[i][1] = bfhi(v.x); x[i][2] = bflo(v.y); x[i][3] = bfhi(v.y); x[i][4] = bflo(v.z); x[i][5] = bfhi(v.z); x[i][6] = bflo(v.w); x[i][7] = bfhi(v.w);
    }
    const float* cw = INF(16); const float* cb = INF(17);
    float w[4][8], bias[8];
#pragma unroll
    for (int k = 0; k < 4; ++k) { const f32x4 a = *(const f32x4*)(cw + k * CONVD + ch0), c = *(const f32x4*)(cw + k * CONVD + ch0 + 4);
        w[k][0] = a.x; w[k][1] = a.y; w[k][2] = a.z; w[k][3] = a.w; w[k][4] = c.x; w[k][5] = c.y; w[k][6] = c.z; w[k][7] = c.w; }
    { const f32x4 a = *(const f32x4*)(cb + ch0), c = *(const f32x4*)(cb + ch0 + 4); bias[0] = a.x; bias[1] = a.y; bias[2] = a.z; bias[3] = a.w; bias[4] = c.x; bias[5] = c.y; bias[6] = c.z; bias[7] = c.w; }
    float y[8][8];
#pragma unroll
    for (int i = 0; i < 8; ++i)
#pragma unroll
        for (int c = 0; c < 8; ++c) { const float a = bias[c] + w[0][c] * x[i][c] + w[1][c] * x[i + 1][c] + w[2][c] * x[i + 2][c] + w[3][c] * x[i + 3][c]; y[i][c] = siluf(a); }
    if (cgp < 32) {
        bf16* XT = (bf16*)(ws + WS_XT) + ((size_t)(b * 32 + cgp) * 128 + (t0 >> 5)) * 2048 + (8 * cg) * 32 + (t0 & 31);
#pragma unroll
        for (int c = 0; c < 8; ++c) { u32x4 o; o.x = pk2(y[0][c], y[1][c]); o.y = pk2(y[2][c], y[3][c]); o.z = pk2(y[4][c], y[5][c]); o.w = pk2(y[6][c], y[7][c]); *(u32x4*)(XT + (size_t)c * 32) = o; }
    } else {
        const int isC = cgp >= 40, gg = ((cgp - 32) & 7) >> 1, n0 = ((cgp - 32) & 1) * 64 + 8 * cg;
        bf16* N = (bf16*)(ws + (isC ? WS_CN : WS_BN)) + ((size_t)(b * 4 + gg) * 4096 + t0) * 128 + n0;
#pragma unroll
        for (int i = 0; i < 8; ++i) { u32x4 o; o.x = pk2(y[i][0], y[i][1]); o.y = pk2(y[i][2], y[i][3]); o.z = pk2(y[i][4], y[i][5]); o.w = pk2(y[i][6], y[i][7]); *(u32x4*)(N + (size_t)i * 128) = o; }
        if (!isC) {
            bf16* BT = (bf16*)(ws + WS_BT) + ((size_t)(b * 4 + gg) * 128 + (t0 >> 5)) * 4096 + n0 * 32 + (t0 & 31);
#pragma unroll
            for (int c = 0; c < 8; ++c) { u32x4 o; o.x = pk2(y[0][c], y[1][c]); o.y = pk2(y[2][c], y[3][c]); o.z = pk2(y[4][c], y[5][c]); o.w = pk2(y[6][c], y[7][c]); *(u32x4*)(BT + (size_t)c * 32) = o; }
        }
    }
}
__device__ __forceinline__ void dtcs_item(const Args& args, int item, int lane) {
    unsigned char* ws = args.ws;
    const int c = item & 31, h = (item >> 5) & 31, b = item >> 10;
    const float* MISC = (const float*)(ws + WS_MISC);
    const float bias = INF(18)[h], a = -__expf(INF(19)[h]);
    const int t = c * 128 + 2 * lane; const size_t m = (size_t)b * 4096 + t;
    const float d0 = softplusf(MISC[m * 128 + h] + bias), d1 = softplusf(MISC[(m + 1) * 128 + h] + bias);
    const float a0 = d0 * a, a1 = d1 * a;
    float s = a0 + a1;
#pragma unroll
    for (int o = 1; o < 64; o <<= 1) { const float v = __shfl_up(s, o); if (lane >= o) s += v; }
    const float c1 = s, c0 = s - a1;
    float* DT = (float*)(ws + WS_DT) + (size_t)(b * 32 + h) * 4096 + t; float* CS = (float*)(ws + WS_CS) + (size_t)(b * 32 + h) * 4096 + t;
    *(f32x2*)DT = (f32x2){d0, d1}; *(f32x2*)CS = (f32x2){c0, c1};
}
__device__ __forceinline__ void sample_conv(const Args& args, int gt, int NGT) {
    unsigned char* ws = args.ws; float* out = args.out;
    const float* st = INF(8); const float* cw = INF(16); const float* cb = INF(17);
    for (int i = gt; i < MS * CONVD; i += NGT) {
        const int bs = i / CONVD, ch = i % CONVD;
        const float s0 = st[((size_t)bs * 3 + 0) * CONVD + ch], s1 = st[((size_t)bs * 3 + 1) * CONVD + ch], s2 = st[((size_t)bs * 3 + 2) * CONVD + ch];
        const float xn = out[O_CONVS + ((size_t)bs * 3 + 2) * CONVD + ch];
        out[O_CONVS + ((size_t)bs * 3 + 0) * CONVD + ch] = s1; out[O_CONVS + ((size_t)bs * 3 + 1) * CONVD + ch] = s2;
        const float a = cb[ch] + cw[ch] * s0 + cw[CONVD + ch] * s1 + cw[2 * CONVD + ch] * s2 + cw[3 * CONVD + ch] * xn;
        ((float*)(ws + WS_XCS))[i] = siluf(a);
    }
    for (int i = gt; i < MS * NH; i += NGT) { const int bs = i >> 5, h = i & 31;
        ((float*)(ws + WS_DTS))[i] = softplusf(((const float*)(ws + WS_MISC))[(size_t)(MP + bs) * 128 + h] + INF(18)[h]); }
}

struct SFrag { u32x4 x[4]; bf16x8 b[4]; };
__device__ __forceinline__ void ssd_states_load(const bf16* XT, const bf16* BT, int nh, int ks, int q, int r16, SFrag& F) {
#pragma unroll
    for (int pt = 0; pt < 4; ++pt) F.x[pt] = *(const u32x4*)(XT + (size_t)ks * 2048 + (16 * pt + r16) * 32 + 8 * q);
#pragma unroll
    for (int nt = 0; nt < 4; ++nt) F.b[nt] = *(const bf16x8*)(BT + (size_t)ks * 4096 + (64 * nh + 16 * nt + r16) * 32 + 8 * q);
}
__device__ __forceinline__ void ssd_states_step(const LAS float* wl, int ks, int q, const SFrag& F, f32x4 (&acc)[4][4]) {
    const int s0 = 32 * ks + 8 * q;
    const f32x4 w0 = *(const LAS f32x4*)(wl + s0), w1 = *(const LAS f32x4*)(wl + s0 + 4);
    bf16x8 af[4];
#pragma unroll
    for (int pt = 0; pt < 4; ++pt) { const u32x4 v = F.x[pt];
        u32x4 o; o.x = pk2(bflo(v.x) * w0.x, bfhi(v.x) * w0.y); o.y = pk2(bflo(v.y) * w0.z, bfhi(v.y) * w0.w); o.z = pk2(bflo(v.z) * w1.x, bfhi(v.z) * w1.y); o.w = pk2(bflo(v.w) * w1.z, bfhi(v.w) * w1.w);
        af[pt] = __builtin_bit_cast(bf16x8, o); }
#pragma unroll
    for (int nt = 0; nt < 4; ++nt)
#pragma unroll
        for (int pt = 0; pt < 4; ++pt) acc[pt][nt] = MFMA16(af[pt], F.b[nt], acc[pt][nt]);
}
__device__ __forceinline__ void ssd_states_unit(const Args& args, LAS unsigned char* lds, int unit, int wave, int lane) {
    unsigned char* ws = args.ws;
    const int g = unit & 3, c = (unit >> 2) & 31, b = unit >> 7, h = g * 8 + wave, q = lane >> 4, r16 = lane & 15;
    LAS float* wl = (LAS float*)(lds + wave * 512);
    const float* DT = (const float*)(ws + WS_DT) + (size_t)(b * 32 + h) * 4096 + c * 128; const float* CS = (const float*)(ws + WS_CS) + (size_t)(b * 32 + h) * 4096 + c * 128;
    const float cl = CS[127];
    wl[lane] = DT[lane] * __expf(cl - CS[lane]); wl[lane + 64] = DT[lane + 64] * __expf(cl - CS[lane + 64]);
    LDS_WAIT(); asm volatile("" ::: "memory");
    const bf16* XT = (const bf16*)(ws + WS_XT) + ((size_t)(b * 32 + h) * 128 + c * 4) * 2048;
    const bf16* BT = (const bf16*)(ws + WS_BT) + ((size_t)(b * 4 + g) * 128 + c * 4) * 4096;
    float* ST = (float*)(ws + WS_STATES) + (((size_t)(b * 32 + c) * 32 + h) * 64) * 128;
    SFrag FA, FB;
    ssd_states_load(XT, BT, 0, 0, q, r16, FA);
#pragma unroll 1
    for (int nh = 0; nh < 2; ++nh) {
        f32x4 acc[4][4];
#pragma unroll
        for (int i = 0; i < 4; ++i)
#pragma unroll
            for (int j = 0; j < 4; ++j) acc[i][j] = (f32x4){0.f, 0.f, 0.f, 0.f};
        ssd_states_load(XT, BT, nh, 1, q, r16, FB); ssd_states_step(wl, 0, q, FA, acc);
        ssd_states_load(XT, BT, nh, 2, q, r16, FA); ssd_states_step(wl, 1, q, FB, acc);
        ssd_states_load(XT, BT, nh, 3, q, r16, FB); ssd_states_step(wl, 2, q, FA, acc);
        if (nh == 0) ssd_states_load(XT, BT, 1, 0, q, r16, FA);
        ssd_states_step(wl, 3, q, FB, acc);
#pragma unroll
        for (int pt = 0; pt < 4; ++pt)
#pragma unroll
            for (int nt = 0; nt < 4; ++nt)
#pragma unroll
                for (int r = 0; r < 4; ++r) ST[(size_t)(16 * pt + 4 * q + r) * 128 + 64 * nh + 16 * nt + r16] = acc[pt][nt][r];
    }
}

template <int SAMPLE>
__device__ __forceinline__ void compress2_item(const Args& args, int item, int lane) {
    unsigned char* ws = args.ws;
    const int q = lane >> 4, r16 = lane & 15;
    constexpr int NPB = SAMPLE ? 128 : 256;
    constexpr int NI = (SAMPLE ? 65536 : 4096) / 16;
    const int st = item / NI, row0 = (item % NI) * 16;
    const bf16* P = (const bf16*)(ws + (SAMPLE ? (st ? WS_PARTSV : WS_PARTSK) : (st ? WS_PARTV : WS_PARTK))) + (size_t)(row0 + r16) * 256;
    const float* pet = (const float*)(ws + WS_PET) + st * 128;
    const bf16* W2T = (const bf16*)(ws + WS_W2T) + st * 8192;
    f32x4 acc[4];
#pragma unroll
    for (int dt = 0; dt < 4; ++dt) acc[dt] = (f32x4){0.f, 0.f, 0.f, 0.f};
#pragma unroll
    for (int ks = 0; ks < 4; ++ks) {
        const int e0 = 32 * ks + 8 * q;
        const u32x4 pa = *(const u32x4*)(P + e0), pb = *(const u32x4*)(P + 256 + 128 + e0);
        const f32x4 a0 = (f32x4){bflo(pa.x), bfhi(pa.x), bflo(pa.y), bfhi(pa.y)}, a1 = (f32x4){bflo(pa.z), bfhi(pa.z), bflo(pa.w), bfhi(pa.w)};
        const f32x4 b0 = (f32x4){bflo(pb.x), bfhi(pb.x), bflo(pb.y), bfhi(pb.y)}, b1 = (f32x4){bflo(pb.z), bfhi(pb.z), bflo(pb.w), bfhi(pb.w)};
        const f32x4 p0 = *(const f32x4*)(pet + e0), p1 = *(const f32x4*)(pet + e0 + 4);
        const f32x4 h0 = a0 + b0 + p0, h1 = a1 + b1 + p1;
        u32x4 o; o.x = pk2(siluf(h0.x), siluf(h0.y)); o.y = pk2(siluf(h0.z), siluf(h0.w)); o.z = pk2(siluf(h1.x), siluf(h1.y)); o.w = pk2(siluf(h1.z), siluf(h1.w));
        const bf16x8 af = __builtin_bit_cast(bf16x8, o);
#pragma unroll
        for (int dt = 0; dt < 4; ++dt) { const bf16x8 bf = *(const bf16x8*)(W2T + (size_t)(16 * dt + r16) * 128 + e0); acc[dt] = MFMA16(af, bf, acc[dt]); }
    }
    const int bh = row0 / NPB, n0 = row0 % NPB + 4 * q;
#pragma unroll
    for (int dt = 0; dt < 4; ++dt) {
        const int d = 16 * dt + r16;
        float v[4];
#pragma unroll
        for (int r = 0; r < 4; ++r) v[r] = (n0 + r < NPB - 1) ? acc[dt][r] : 0.f;
        if (SAMPLE) {
            float* o = (float*)(ws + (st ? WS_VCS : WS_KCS)) + ((size_t)bh * 128 + n0) * 64 + d;
#pragma unroll
            for (int r = 0; r < 4; ++r) o[r * 64] = v[r];
        } else if (st == 0) {
            bf16* o = (bf16*)(ws + WS_KC) + ((size_t)bh * 256 + n0) * 64 + d;
#pragma unroll
            for (int r = 0; r < 4; ++r) o[r * 64] = (bf16)f2bf(v[r]);
        } else {
            u32x2 w; w.x = pk2(v[0], v[1]); w.y = pk2(v[2], v[3]);
            *(u32x2*)((bf16*)(ws + WS_VCT) + ((size_t)bh * 8 + (n0 >> 5)) * 2048 + d * 32 + 8 * ((n0 & 15) >> 2) + 4 * ((n0 & 31) >> 4)) = w;
        }
    }
}

__device__ __forceinline__ void sample_ssm_item(const Args& args, LAS unsigned char* lds, int item, int wave, int lane) {
    unsigned char* ws = args.ws; float* out = args.out;
    const int h = item & 31, bs = item >> 5, g = h >> 3, rs = lane >> 5, nc = lane & 31;
    const float* XC = (const float*)(ws + WS_XCS) + (size_t)bs * CONVD;
    const float dt = ((const float*)(ws + WS_DTS))[bs * 32 + h], a = -__expf(INF(19)[h]), dec = __expf(dt * a), Dh = INF(20)[h];
    const f32x4 Bv = *(const f32x4*)(XC + 2048 + g * 128 + 4 * nc) * dt, Cv = *(const f32x4*)(XC + 2560 + g * 128 + 4 * nc);
    const float xl = XC[h * 64 + lane];
    const size_t m = MP + bs;
    const float zl = bf2f(((const bf16*)(ws + WS_Z))[m * 2048 + h * 64 + lane]), nwl = INF(21)[h * 64 + lane];
    const float* H0 = INF(7) + ((size_t)(bs * 32 + h) * 64) * 128 + 4 * nc; float* HN = out + O_SSMS + ((size_t)(bs * 32 + h) * 64) * 128 + 4 * nc;
    const bool b4 = (lane & 16) != 0, b3 = (lane & 8) != 0, b2 = (lane & 4) != 0;
    float yl = 0.f;
#pragma unroll 1
    for (int bt = 0; bt < 4; ++bt) {
        f32x4 h0[8];
#pragma unroll
        for (int k = 0; k < 8; ++k) h0[k] = *(const f32x4*)(H0 + (size_t)(2 * (8 * bt + k) + rs) * 128);
        float v[8];
#pragma unroll
        for (int k = 0; k < 8; ++k) { const int p = 2 * (8 * bt + k) + rs;
            const float xp = __shfl(xl, p);
            const f32x4 hn = h0[k] * dec + Bv * xp;
            *(f32x4*)(HN + (size_t)p * 128) = hn;
            v[k] = (hn.x * Cv.x + hn.y * Cv.y) + (hn.z * Cv.z + hn.w * Cv.w); }
        float a4[4], a2[2];
#pragma unroll
        for (int i = 0; i < 4; ++i) a4[i] = (b4 ? v[4 + i] : v[i]) + __shfl_xor(b4 ? v[i] : v[4 + i], 16);
#pragma unroll
        for (int i = 0; i < 2; ++i) a2[i] = (b3 ? a4[2 + i] : a4[i]) + __shfl_xor(b3 ? a4[i] : a4[2 + i], 8);
        float c = (b2 ? a2[1] : a2[0]) + __shfl_xor(b2 ? a2[0] : a2[1], 4);
        c += __shfl_xor(c, 2); c += __shfl_xor(c, 1);
        const int pl = lane - 16 * bt;
        const int kk = (pl >> 1) & 7, src = ((pl & 1) << 5) | ((kk & 4) << 2) | ((kk & 2) << 2) | ((kk & 1) << 2);
        const float got = __shfl(c, src & 63);
        if (pl >= 0 && pl < 16) yl = got;
    }
    const float y = yl + Dh * xl;
    const float vv = y * siluf(zl);
    ((bf16*)(ws + WS_YSSM))[m * 2048 + h * 64 + lane] = (bf16)f2bf(vv * nwl);
    const float ss = wave_sum(vv * vv);
    if (lane == 0) ((float*)(ws + WS_MISC))[m * 128 + 80 + h] = ss;
}
__device__ __forceinline__ void scan_phase(const Args& args, int gt, int NGT) {
    unsigned char* ws = args.ws; float* out = args.out;
    constexpr int NITEM = 4 * 32 * 64 * 32;
    for (int i0 = gt; i0 < NITEM; i0 += 2 * NGT) {
        const int i1 = i0 + NGT; const bool two = i1 < NITEM;
        const int ia[2] = {i0, two ? i1 : i0};
        size_t base[2]; const float* CSp[2]; f32x4 run[2];
#pragma unroll
        for (int k = 0; k < 2; ++k) { const int i = ia[k]; const int n4 = i & 31, p = (i >> 5) & 63, h = (i >> 11) & 31, b = i >> 16;
            base[k] = (((size_t)(b * 32) * 32 + h) * 64 + p) * 128 + 4 * n4; CSp[k] = (const float*)(ws + WS_CS) + (size_t)(b * 32 + h) * 4096; run[k] = (f32x4){0.f, 0.f, 0.f, 0.f}; }
#pragma unroll 1
        for (int c0 = 0; c0 < 32; c0 += 8) {
            f32x4 st[2][8]; float dec[2][8];
#pragma unroll
            for (int k = 0; k < 2; ++k)
#pragma unroll
                for (int j = 0; j < 8; ++j) { st[k][j] = *(const f32x4*)((const float*)(ws + WS_STATES) + base[k] + (size_t)(c0 + j) * (32 * 64 * 128)); dec[k][j] = CSp[k][(c0 + j) * 128 + 127]; }
#pragma unroll
            for (int j = 0; j < 8; ++j)
#pragma unroll
                for (int k = 0; k < 2; ++k) {
                    u32x2 o; o.x = pk2(run[k].x, run[k].y); o.y = pk2(run[k].z, run[k].w);
                    if (k == 0 || two) *(u32x2*)((bf16*)(ws + WS_HPREV) + base[k] + (size_t)(c0 + j) * (32 * 64 * 128)) = o;
                    run[k] = run[k] * __expf(dec[k][j]) + st[k][j];
                }
        }
#pragma unroll
        for (int k = 0; k < 2; ++k) if (k == 0 || two) { const int i = ia[k]; const int n4 = i & 31, p = (i >> 5) & 63, h = (i >> 11) & 31, b = i >> 16;
            *(f32x4*)(out + O_SSMP + (((size_t)(b * 32 + h) * 64 + p) * 128) + 4 * n4) = run[k]; }
    }
    for (int i = gt; i < MS * 4; i += NGT) { const int bs = i >> 2, g = i & 3; const float* p = (const float*)(ws + WS_MISC) + (size_t)(MP + bs) * 128 + 80 + g * 8;
        ((float*)(ws + WS_SSQ))[(size_t)(MP + bs) * 4 + g] = ((p[0] + p[1]) + (p[2] + p[3])) + ((p[4] + p[5]) + (p[6] + p[7])); }
}

constexpr int CNL_PITCH = 136;
struct DFrag { bf16x8 x[4]; f32x4 csa, csb, dta, dtb; };
__device__ __forceinline__ void ssd_out_load(const bf16* XT, const float* CS, const float* DT, int i, int q, int r16, DFrag& F) {
    const int sa = 32 * i + 4 * q, sb = sa + 16;
    F.csa = *(const f32x4*)(CS + sa); F.csb = *(const f32x4*)(CS + sb); F.dta = *(const f32x4*)(DT + sa); F.dtb = *(const f32x4*)(DT + sb);
#pragma unroll
    for (int pt = 0; pt < 4; ++pt) { const bf16* xr = XT + (size_t)i * 2048 + (16 * pt + r16) * 32 + 4 * q; const u32x2 lo = *(const u32x2*)xr, hi = *(const u32x2*)(xr + 16);
        F.x[pt] = __builtin_bit_cast(bf16x8, (u32x4){lo.x, lo.y, hi.x, hi.y}); }
}
template <int HL, int I>
__device__ __forceinline__ void ssd_out_diag(const LAS float* CBT, const DFrag& F, const float (&csl)[4], float Dh, int q, int r16, int lane, f32x4 (&acc)[4][4]) {
    const int sa = 32 * I + 4 * q, sb = sa + 16;
#pragma unroll
    for (int lt = 0; lt < 4; ++lt) {
        constexpr int dummy = 0; (void)dummy;
        const int LT = 4 * HL + lt;
        if (LT < 2 * I) continue;
        const int l = 16 * LT + r16;
        float ga[4], gb[4];
#pragma unroll
        for (int r = 0; r < 4; ++r) {
            const float va = CBT[(((2 * I) * 8 + LT) * 4 + r) * 64 + lane];
            const float vb = (LT >= 2 * I + 1) ? CBT[(((2 * I + 1) * 8 + LT) * 4 + r) * 64 + lane] : 0.f;
            const int s1 = sa + r, s2 = sb + r;
            float x1 = (l >= s1) ? va * __expf(csl[lt] - F.csa[r]) * F.dta[r] : 0.f;
            float x2 = (l >= s2) ? vb * __expf(csl[lt] - F.csb[r]) * F.dtb[r] : 0.f;
            if (l == s1) x1 += Dh;
            if (l == s2) x2 += Dh;
            ga[r] = x1; gb[r] = x2;
        }
        u32x4 o; o.x = pk2(ga[0], ga[1]); o.y = pk2(ga[2], ga[3]); o.z = pk2(gb[0], gb[1]); o.w = pk2(gb[2], gb[3]);
        const bf16x8 bf = __builtin_bit_cast(bf16x8, o);
#pragma unroll
        for (int pt = 0; pt < 4; ++pt) acc[pt][lt] = MFMA16(F.x[pt], bf, acc[pt][lt]);
    }
}
template <int HL>
__device__ __forceinline__ void ssd_out_half(const Args& args, const LAS float* CBT, const LAS bf16* CnL, LAS float* SQ, const bf16x8 (&hp)[16], const bf16* XT, const float* CS, const float* DT,
                                             float Dh, int b, int c, int h, int wave, int q, int r16, int lane) {
    unsigned char* ws = args.ws;
    float csl[4];
#pragma unroll
    for (int lt = 0; lt < 4; ++lt) csl[lt] = CS[64 * HL + 16 * lt + r16];
    DFrag FA, FB;
    ssd_out_load(XT, CS, DT, 0, q, r16, FA);
    f32x4 acc[4][4];
#pragma unroll
    for (int i = 0; i < 4; ++i)
#pragma unroll
        for (int j = 0; j < 4; ++j) acc[i][j] = (f32x4){0.f, 0.f, 0.f, 0.f};
#pragma unroll
    for (int ks = 0; ks < 4; ++ks)
#pragma unroll
        for (int lt = 0; lt < 4; ++lt) { const bf16x8 bf = *(const LAS bf16x8*)(CnL + (64 * HL + 16 * lt + r16) * CNL_PITCH + 32 * ks + 8 * q);
#pragma unroll
            for (int pt = 0; pt < 4; ++pt) acc[pt][lt] = MFMA16(hp[ks * 4 + pt], bf, acc[pt][lt]); }
#pragma unroll
    for (int lt = 0; lt < 4; ++lt) { const float e = __expf(csl[lt]);
#pragma unroll
        for (int pt = 0; pt < 4; ++pt) acc[pt][lt] = acc[pt][lt] * e; }
    ssd_out_load(XT, CS, DT, 1, q, r16, FB);
    ssd_out_diag<HL, 0>(CBT, FA, csl, Dh, q, r16, lane, acc);
    if (HL == 1) ssd_out_load(XT, CS, DT, 2, q, r16, FA);
    ssd_out_diag<HL, 1>(CBT, FB, csl, Dh, q, r16, lane, acc);
    if (HL == 1) {
        ssd_out_load(XT, CS, DT, 3, q, r16, FB);
        ssd_out_diag<HL, 2>(CBT, FA, csl, Dh, q, r16, lane, acc);
        ssd_out_diag<HL, 3>(CBT, FB, csl, Dh, q, r16, lane, acc);
    }
    const bf16* Z = (const bf16*)(ws + WS_Z); bf16* Y = (bf16*)(ws + WS_YSSM); const float* nw = INF(21) + h * 64;
    u32x2 zz[4][4];
#pragma unroll
    for (int lt = 0; lt < 4; ++lt)
#pragma unroll
        for (int pt = 0; pt < 4; ++pt) zz[lt][pt] = *(const u32x2*)(Z + ((size_t)b * 4096 + c * 128 + 64 * HL + 16 * lt + r16) * 2048 + h * 64 + 16 * pt + 4 * q);
#pragma unroll
    for (int lt = 0; lt < 4; ++lt) {
        const size_t m = (size_t)b * 4096 + c * 128 + 64 * HL + 16 * lt + r16;
        float ss = 0.f;
#pragma unroll
        for (int pt = 0; pt < 4; ++pt) {
            const int ch = 16 * pt + 4 * q;
            const f32x4 w = *(const f32x4*)(nw + ch);
            const float v0 = acc[pt][lt][0] * siluf(bflo(zz[lt][pt].x)), v1 = acc[pt][lt][1] * siluf(bfhi(zz[lt][pt].x)), v2 = acc[pt][lt][2] * siluf(bflo(zz[lt][pt].y)), v3 = acc[pt][lt][3] * siluf(bfhi(zz[lt][pt].y));
            ss += (v0 * v0 + v1 * v1) + (v2 * v2 + v3 * v3);
            u32x2 o; o.x = pk2(v0 * w.x, v1 * w.y); o.y = pk2(v2 * w.z, v3 * w.w);
            *(u32x2*)(Y + m * 2048 + h * 64 + ch) = o;
        }
        ss += __shfl_xor(ss, 16); ss += __shfl_xor(ss, 32);
        if (q == 0) SQ[wave * 128 + 64 * HL + 16 * lt + r16] = ss;
    }
}
__device__ __forceinline__ void ssd_out_unit(const Args& args, LAS unsigned char* lds, int unit, int wave, int lane_in, int tid) {
    int lane = lane_in; asm volatile("" : "+v"(lane));
    unsigned char* ws = args.ws;
    const int g = unit & 3, c = (unit >> 2) & 31, b = unit >> 7, h = g * 8 + wave, q = lane >> 4, r16 = lane & 15;
    LAS float* CBT = (LAS float*)lds; LAS bf16* CnL = (LAS bf16*)(lds + 65536); LAS float* SQ = (LAS float*)(lds + 65536 + 128 * CNL_PITCH * 2);
    const bf16* Bn = (const bf16*)(ws + WS_BN) + ((size_t)(b * 4 + g) * 4096 + c * 128) * 128;
    const bf16* Cn = (const bf16*)(ws + WS_CN) + ((size_t)(b * 4 + g) * 4096 + c * 128) * 128;
    {
        u32x4 cv[4];
#pragma unroll
        for (int i = 0; i < 4; ++i) cv[i] = *(const u32x4*)(Cn + (size_t)(wave * 64 + lane + 512 * i) * 8);
        bf16x8 bnf[4], hp[16];
#pragma unroll
        for (int ks = 0; ks < 4; ++ks) bnf[ks] = *(const bf16x8*)(Bn + (size_t)(16 * wave + r16) * 128 + 32 * ks + 8 * q);
        const bf16* HP = (const bf16*)(ws + WS_HPREV) + (((size_t)(b * 32 + c) * 32 + h) * 64) * 128;
#pragma unroll
        for (int ks = 0; ks < 4; ++ks)
#pragma unroll
            for (int pt = 0; pt < 4; ++pt) hp[ks * 4 + pt] = *(const bf16x8*)(HP + (size_t)(16 * pt + r16) * 128 + 32 * ks + 8 * q);
#pragma unroll
        for (int i = 0; i < 4; ++i) { const int id = wave * 64 + lane + 512 * i; *(LAS u32x4*)(CnL + (id >> 4) * CNL_PITCH + (id & 15) * 8) = cv[i]; }
        __syncthreads();
        for (int lt = wave; lt < 8; ++lt) {
            f32x4 d = (f32x4){0.f, 0.f, 0.f, 0.f};
#pragma unroll
            for (int ks = 0; ks < 4; ++ks) { const bf16x8 bf = *(const LAS bf16x8*)(CnL + (16 * lt + r16) * CNL_PITCH + 32 * ks + 8 * q); d = MFMA16(bnf[ks], bf, d); }
#pragma unroll
            for (int r = 0; r < 4; ++r) CBT[((wave * 8 + lt) * 4 + r) * 64 + lane] = d[r];
        }
        __syncthreads();
        const float* DT = (const float*)(ws + WS_DT) + (size_t)(b * 32 + h) * 4096 + c * 128; const float* CS = (const float*)(ws + WS_CS) + (size_t)(b * 32 + h) * 4096 + c * 128;
        const float Dh = INF(20)[h];
        const bf16* XT = (const bf16*)(ws + WS_XT) + ((size_t)(b * 32 + h) * 128 + c * 4) * 2048;
        ssd_out_half<0>(args, CBT, CnL, SQ, hp, XT, CS, DT, Dh, b, c, h, wave, q, r16, lane);
        ssd_out_half<1>(args, CBT, CnL, SQ, hp, XT, CS, DT, Dh, b, c, h, wave, q, r16, lane);
    }
    __syncthreads();
    if (tid < 128) { float s = 0.f;
#pragma unroll
        for (int w = 0; w < 8; ++w) s += SQ[w * 128 + tid];
        ((float*)(ws + WS_SSQ))[((size_t)b * 4096 + c * 128 + tid) * 4 + g] = s; }
    __syncthreads();
}
constexpr float SC2 = 0.125f * 1.4426950408889634f;
__device__ __forceinline__ float max3f(float a, float b, float c) { float r; asm("v_max3_f32 %0, %1, %2, %3" : "=v"(r) : "v"(a), "v"(b), "v"(c)); return r; }
template <class T> __device__ __forceinline__ T ldu(const void* ubase, unsigned lane_off) { return *(const T*)((const char*)ubase + lane_off); }
struct KFrag { bf16x8 kf[2][2]; };
__device__ __forceinline__ void flash_load(const bf16* Kp, int kb, unsigned koff, KFrag& F) {
#pragma unroll
    for (int kt = 0; kt < 2; ++kt) { const bf16* kr = Kp + (size_t)(kb + 16 * kt) * 64; F.kf[kt][0] = ldu<bf16x8>(kr, koff); F.kf[kt][1] = ldu<bf16x8>(kr + 32, koff); }
}
template <int MODE>
__device__ __forceinline__ void flash_step(const KFrag& F, const bf16* VTp, unsigned voff, int kb, int t0, int t, bool selbit, const LAS bf16x8* Qs,
                                           f32x4 (&O)[4][4], float (&mx)[4], f32x4 (&L)[4], int q) {
    const bf16x8 ones = __builtin_bit_cast(bf16x8, (u32x4){0x3f803f80u, 0x3f803f80u, 0x3f803f80u, 0x3f803f80u});
    const bool edge = (kb + 31 > t0) || (MODE == 1 && kb + 512 <= t0 + 15);
    bf16x8 vf[4];
#pragma unroll
    for (int dt = 0; dt < 4; ++dt) vf[dt] = ldu<bf16x8>(VTp + (size_t)(kb >> 5) * 2048 + (16 * dt) * 32, voff);
#pragma unroll
    for (int g = 0; g < 4; ++g) {
        asm volatile("" ::: "memory");
        __builtin_amdgcn_sched_barrier(0);
        const bf16x8 q0 = Qs[(g * 2 + 0) * 64], q1 = Qs[(g * 2 + 1) * 64];
        f32x4 S0 = MFMA16(F.kf[0][0], q0, ((f32x4){0.f, 0.f, 0.f, 0.f})), S1 = MFMA16(F.kf[1][0], q0, ((f32x4){0.f, 0.f, 0.f, 0.f}));
        S0 = MFMA16(F.kf[0][1], q1, S0); S1 = MFMA16(F.kf[1][1], q1, S1);
        float s[8];
#pragma unroll
        for (int r = 0; r < 4; ++r) { s[r] = S0[r]; s[4 + r] = S1[r]; }
        if (edge) {
#pragma unroll
            for (int i = 0; i < 8; ++i) { const int key = kb + 16 * (i >> 2) + 4 * q + (i & 3);
                const bool ok = (MODE == 0) ? (key <= t) : (key <= t && key + 512 > t); s[i] = ok ? s[i] : NEGF; }
        }
        float lm = max3f(max3f(s[0], s[1], s[2]), max3f(s[3], s[4], s[5]), fmaxf(s[6], s[7])) * SC2;
        if (MODE == 0) lm = selbit ? lm : NEGF;
        if (__builtin_amdgcn_ballot_w64(lm > mx[g] + 8.f) != 0ull) {
            float tmax = fmaxf(lm, __shfl_xor(lm, 16)); tmax = fmaxf(tmax, __shfl_xor(tmax, 32));
            const float mnew = fmaxf(mx[g], tmax), alpha = __builtin_amdgcn_exp2f(mx[g] - mnew); mx[g] = mnew; L[g] = L[g] * alpha;
#pragma unroll
            for (int dt = 0; dt < 4; ++dt) O[dt][g] = O[dt][g] * alpha;
        }
        float nmuse = -fmaxf(mx[g], -1e20f);
        if (MODE == 0) nmuse = selbit ? nmuse : NEGF;
#pragma unroll
        for (int i = 0; i < 8; ++i) s[i] = __builtin_amdgcn_exp2f(__builtin_fmaf(s[i], SC2, nmuse));
        u32x4 pw; pw.x = pk2(s[0], s[1]); pw.y = pk2(s[2], s[3]); pw.z = pk2(s[4], s[5]); pw.w = pk2(s[6], s[7]);
        const bf16x8 pf = __builtin_bit_cast(bf16x8, pw);
        L[g] = MFMA16(ones, pf, L[g]);
#pragma unroll
        for (int dt = 0; dt < 4; ++dt) O[dt][g] = MFMA16(vf[dt], pf, O[dt][g]);
    }
}
template <int MODE>
__device__ __forceinline__ void flash_branch(const bf16* Kp, const bf16* VTp, int jfirst, int jlast, unsigned ulo, unsigned uhi, unsigned mlo, unsigned mhi,
                                             int t0, int t, const LAS bf16x8* Qs, f32x4 (&O)[4][4], float (&mx)[4], f32x4 (&L)[4], int q, int r16) {
    const unsigned koff = (unsigned)(r16 * 64 + 8 * q) * 2u, voff = (unsigned)(r16 * 32 + 8 * q) * 2u;
    int jb = jfirst;
    while (jb <= jlast && !((jb < 32 ? (ulo >> jb) : (uhi >> (jb - 32))) & 1u)) ++jb;
    if (jb > jlast) return;
    KFrag A, B;
    flash_load(Kp, 64 * jb, koff, A);
    for (;;) {
        flash_load(Kp, 64 * jb + 32, koff, B);
        const bool selbit = ((jb < 32 ? (mlo >> jb) : (mhi >> (jb - 32))) & 1u) != 0u;
        flash_step<MODE>(A, VTp, voff, 64 * jb, t0, t, selbit, Qs, O, mx, L, q);
        int jn = jb + 1;
        while (jn <= jlast && !((jn < 32 ? (ulo >> jn) : (uhi >> (jn - 32))) & 1u)) ++jn;
        if (jn <= jlast) flash_load(Kp, 64 * jn, koff, A);
        flash_step<MODE>(B, VTp, voff, 64 * jb + 32, t0, t, selbit, Qs, O, mx, L, q);
        if (jn > jlast) break;
        jb = jn;
    }
}

template <int BR>
__device__ __forceinline__ void attn_finish(const Args& args, f32x4 (&O)[4][4], const f32x4 (&L)[4], bool normalise, size_t m, int hkv, int q) {
    unsigned char* ws = args.ws;
    const float* gates = (const float*)(ws + WS_MISC) + m * 128 + 32;
    const unsigned yoff = (unsigned)((m & 15) * 1024 + 4 * q) * 4u, yboff = yoff >> 1;
#pragma unroll
    for (int g = 0; g < 4; ++g) {
        float sc = sigmf(gates[(hkv * 4 + g) * 3 + BR]);
        if (normalise) sc *= 1.f / fmaxf(L[g][0], TINYF);
#pragma unroll
        for (int dt = 0; dt < 4; ++dt) {
            char* yfu = (char*)((float*)(ws + WS_YATTF) + (m & ~(size_t)15) * 1024 + (hkv * 4 + g) * 64 + 16 * dt);
            f32x4 v = O[dt][g] * sc;
            if (BR > 0) v = v + *(const f32x4*)(yfu + yoff);
            if (BR < 2) *(f32x4*)(yfu + yoff) = v;
            else { u32x2 o; o.x = pk2(v.x, v.y); o.y = pk2(v.z, v.w); *(u32x2*)((char*)((bf16*)(ws + WS_YATT) + (m & ~(size_t)15) * 1024 + (hkv * 4 + g) * 64 + 16 * dt) + yboff) = o; }
        }
    }
}

__device__ __forceinline__ void cmp_pass1_tile(const bf16x8& k0, const bf16x8& k1, int kt, const LAS bf16x8* Qs, int t, int q, float (&mx)[4], float (&ls)[4]) {
#pragma unroll
    for (int g = 0; g < 4; ++g) {
        f32x4 s = MFMA16(k0, Qs[(g * 2 + 0) * 64], ((f32x4){0.f, 0.f, 0.f, 0.f})); s = MFMA16(k1, Qs[(g * 2 + 1) * 64], s);
        float tmax = NEGF;
#pragma unroll
        for (int r = 0; r < 4; ++r) { const int n = 16 * kt + 4 * q + r; const bool ok = (16 * n + 31 <= t); s[r] = ok ? s[r] * 0.125f : NEGF; tmax = fmaxf(tmax, s[r]); }
        const float mnew = fmaxf(mx[g], tmax); float ps = 0.f;
#pragma unroll
        for (int r = 0; r < 4; ++r) ps += (s[r] > 0.5f * NEGF) ? __expf(s[r] - mnew) : 0.f;
        ls[g] = ls[g] * __expf(mx[g] - mnew) + ps; mx[g] = mnew;
    }
}
__device__ __forceinline__ void attn_prompt_unit(const Args& args, LAS float* impL, int unit, bool xcdmap, int lane_in) {
    int lane = lane_in; asm volatile("" : "+v"(lane));
    unsigned char* ws = args.ws;
    const int q = lane >> 4, r16 = lane & 15;
    const int pass = unit >> 11, gwv = unit & 2047, xcd = (gwv >> 3) & 7, wx = (gwv >> 6) * 8 + (gwv & 7);
    const int bh = xcdmap ? 2 * xcd + pass : (unit & 15), b = bh >> 2, hkv = bh & 3;
    const int tile = xcdmap ? (pass == 0 ? 255 - wx : wx) : (unit < 2048 ? 255 - (unit >> 4) : (unit - 2048) >> 4);
    const int t0 = tile * 16, t = t0 + r16; const size_t m = (size_t)b * 4096 + t;
    LAS bf16x8* Qs = (LAS bf16x8*)(impL + 1024) + lane;
#pragma unroll
    for (int g = 0; g < 4; ++g)
#pragma unroll
        for (int ks = 0; ks < 2; ++ks) Qs[(g * 2 + ks) * 64] = ldu<bf16x8>((const bf16*)(ws + WS_Q) + ((size_t)b * 4096 + t0) * 1024 + (hkv * 4 + g) * 64 + 32 * ks, (unsigned)(r16 * 1024 + 8 * q) * 2u);
    LDS_WAIT(); asm volatile("" ::: "memory");
    f32x4 O[4][4]; float mx[4], ls[4];
    const bf16* KCp = (const bf16*)(ws + WS_KC) + (size_t)bh * 256 * 64; const bf16* VCTp = (const bf16*)(ws + WS_VCT) + (size_t)bh * 64 * 256;
    const unsigned kcoff = (unsigned)(r16 * 64 + 8 * q) * 2u, vcoff = (unsigned)(r16 * 32 + 8 * q) * 2u;
    const int nmax = (t0 + 15 >= 31) ? ((t0 + 15 - 31) >> 4) : -1;
    const int NP = nmax < 0 ? 0 : (nmax / 32 + 2 < 8 ? nmax / 32 + 2 : 8);
#pragma unroll
    for (int g = 0; g < 4; ++g) { mx[g] = NEGF; ls[g] = 0.f; }
    {
        bf16x8 ka0, ka1, kb0, kb1;
        if (NP > 0) { ka0 = ldu<bf16x8>(KCp, kcoff); ka1 = ldu<bf16x8>(KCp + 32, kcoff); }
#pragma unroll 1
        for (int kt = 0; kt < 2 * NP; kt += 2) {
            { const bf16* kr = KCp + (size_t)(16 * (kt + 1)) * 64; kb0 = ldu<bf16x8>(kr, kcoff); kb1 = ldu<bf16x8>(kr + 32, kcoff); }
            cmp_pass1_tile(ka0, ka1, kt, Qs, t, q, mx, ls);
            if (kt + 2 < 2 * NP) { const bf16* kr = KCp + (size_t)(16 * (kt + 2)) * 64; ka0 = ldu<bf16x8>(kr, kcoff); ka1 = ldu<bf16x8>(kr + 32, kcoff); }
            cmp_pass1_tile(kb0, kb1, kt + 1, Qs, t, q, mx, ls);
        }
    }
    float invL[4];
#pragma unroll
    for (int g = 0; g < 4; ++g) {
        float M = fmaxf(mx[g], __shfl_xor(mx[g], 16)); M = fmaxf(M, __shfl_xor(M, 32));
        float l = ls[g] * __expf(mx[g] - M); l += __shfl_xor(l, 16); l += __shfl_xor(l, 32);
        mx[g] = M; invL[g] = 1.f / fmaxf(l, TINYF);
    }
#pragma unroll
    for (int dt = 0; dt < 4; ++dt)
#pragma unroll
        for (int g = 0; g < 4; ++g) O[dt][g] = (f32x4){0.f, 0.f, 0.f, 0.f};
    float prev3 = 0.f;
#pragma unroll
    for (int kt = 0; kt < 16; ++kt) impL[kt * 64 + lane] = 0.f;
    bf16x8 kc[2][2], vcf[4];
    if (NP > 0) {
#pragma unroll
        for (int kk = 0; kk < 2; ++kk) { const bf16* kr = KCp + (size_t)(16 * kk) * 64; kc[kk][0] = ldu<bf16x8>(kr, kcoff); kc[kk][1] = ldu<bf16x8>(kr + 32, kcoff); }
#pragma unroll
        for (int dt = 0; dt < 4; ++dt) vcf[dt] = ldu<bf16x8>(VCTp + (16 * dt) * 32, vcoff);
    }
#pragma unroll 1
    for (int i = 0; i < NP; ++i) {
        bf16x8 kn[2][2], vn[4];
        if (i + 1 < NP) {
#pragma unroll
            for (int kk = 0; kk < 2; ++kk) { const bf16* kr = KCp + (size_t)(16 * (2 * i + 2 + kk)) * 64; kn[kk][0] = ldu<bf16x8>(kr, kcoff); kn[kk][1] = ldu<bf16x8>(kr + 32, kcoff); }
#pragma unroll
            for (int dt = 0; dt < 4; ++dt) vn[dt] = ldu<bf16x8>(VCTp + (size_t)(i + 1) * 2048 + (16 * dt) * 32, vcoff);
        }
        f32x4 P[2][4];
#pragma unroll
        for (int kk = 0; kk < 2; ++kk) {
            const int kt = 2 * i + kk;
            const bf16x8 k0 = kc[kk][0], k1 = kc[kk][1];
            f32x4 psum = (f32x4){0.f, 0.f, 0.f, 0.f};
#pragma unroll
            for (int g = 0; g < 4; ++g) {
                f32x4 s = MFMA16(k0, Qs[(g * 2 + 0) * 64], ((f32x4){0.f, 0.f, 0.f, 0.f})); s = MFMA16(k1, Qs[(g * 2 + 1) * 64], s);
#pragma unroll
                for (int r = 0; r < 4; ++r) { const int n = 16 * kt + 4 * q + r; const bool ok = (16 * n + 31 <= t); s[r] = ok ? __expf(s[r] * 0.125f - mx[g]) * invL[g] : 0.f; }
                P[kk][g] = s; psum = psum + s;
            }
            const float a = __shfl(psum[3], (lane + 48) & 63), bb = __shfl(prev3, (lane + 48) & 63);
            impL[kt * 64 + lane] = 2.f * (psum[0] + psum[1] + psum[2]) + psum[3] + (q > 0 ? a : bb);
            prev3 = psum[3];
        }
#pragma unroll
        for (int g = 0; g < 4; ++g) {
            u32x4 pw; pw.x = pk2(P[0][g][0], P[0][g][1]); pw.y = pk2(P[0][g][2], P[0][g][3]); pw.z = pk2(P[1][g][0], P[1][g][1]); pw.w = pk2(P[1][g][2], P[1][g][3]);
            const bf16x8 pf = __builtin_bit_cast(bf16x8, pw);
#pragma unroll
            for (int dt = 0; dt < 4; ++dt) O[dt][g] = MFMA16(vcf[dt], pf, O[dt][g]);
        }
        if (i + 1 < NP) {
#pragma unroll
            for (int kk = 0; kk < 2; ++kk) { kc[kk][0] = kn[kk][0]; kc[kk][1] = kn[kk][1]; }
#pragma unroll
            for (int dt = 0; dt < 4; ++dt) vcf[dt] = vn[dt];
        }
    }
    f32x4 L[4];
#pragma unroll
    for (int g = 0; g < 4; ++g) L[g] = (f32x4){1.f, 1.f, 1.f, 1.f};
    attn_finish<0>(args, O, L, false, m, hkv, q);
    unsigned mlo = 0u, mhi = 0u;
    {
        const int cur = t >> 6;
        LDS_WAIT(); asm volatile("" ::: "memory");
        unsigned key[16];
#pragma unroll
        for (int kt = 0; kt < 16; ++kt) { const int j = 4 * kt + q; const bool valid = (64 * j <= t), forced = (j == 0) || (j == cur) || (j == cur - 1);
            const float val = valid ? (forced ? BIGF : impL[kt * 64 + lane]) : -BIGF; const unsigned u = __builtin_bit_cast(unsigned, val);
            key[kt] = (u & 0x80000000u) ? ~u : (u | 0x80000000u); }
        unsigned T = 0u;
#pragma unroll 1
        for (int bit = 31; bit >= 0; --bit) {
            const unsigned cand = T | (1u << bit);
            int cnt = 0;
#pragma unroll
            for (int kt = 0; kt < 16; ++kt) cnt += key[kt] >= cand ? 1 : 0;
            cnt += __shfl_xor(cnt, 16); cnt += __shfl_xor(cnt, 32);
            T = cnt >= 16 ? cand : T;
        }
        int cgt = 0;
#pragma unroll
        for (int kt = 0; kt < 16; ++kt) cgt += key[kt] > T ? 1 : 0;
        cgt += __shfl_xor(cgt, 16); cgt += __shfl_xor(cgt, 32);
        const int need = 16 - cgt;
        unsigned elo = 0u, ehi = 0u;
#pragma unroll
        for (int kt = 0; kt < 16; ++kt) { const int j = 4 * kt + q; const unsigned bit = key[kt] == T ? 1u : 0u; if (kt < 8) elo |= bit << j; else ehi |= bit << (j - 32); }
        elo |= __shfl_xor(elo, 16); elo |= __shfl_xor(elo, 32); ehi |= __shfl_xor(ehi, 16); ehi |= __shfl_xor(ehi, 32);
        const int pclo = __popc(elo);
#pragma unroll
        for (int kt = 0; kt < 16; ++kt) { const int j = 4 * kt + q;
            const int before = kt < 8 ? __popc(elo & ((1u << j) - 1u)) : pclo + __popc(ehi & ((1u << (j - 32)) - 1u));
            const unsigned bit = (key[kt] > T || (key[kt] == T && before < need)) ? 1u : 0u;
            if (kt < 8) mlo |= bit << j; else mhi |= bit << (j - 32); }
        mlo |= __shfl_xor(mlo, 16); mlo |= __shfl_xor(mlo, 32); mhi |= __shfl_xor(mhi, 16); mhi |= __shfl_xor(mhi, 32);
    }
    unsigned ulo = mlo, uhi = mhi;
#pragma unroll
    for (int o = 1; o < 16; o <<= 1) { ulo |= __shfl_xor(ulo, o); uhi |= __shfl_xor(uhi, o); }
    ulo = __builtin_amdgcn_readfirstlane(ulo); uhi = __builtin_amdgcn_readfirstlane(uhi);
    {
#pragma unroll
        for (int g = 0; g < 4; ++g) { mx[g] = NEGF; L[g] = (f32x4){0.f, 0.f, 0.f, 0.f}; }
#pragma unroll
        for (int dt = 0; dt < 4; ++dt)
#pragma unroll
            for (int g = 0; g < 4; ++g) O[dt][g] = (f32x4){0.f, 0.f, 0.f, 0.f};
        const bf16* Kp = (const bf16*)(ws + WS_KVH) + ((size_t)(2 * 4 + b) * 4 + hkv) * 4096 * 64;
        const bf16* VTp = (const bf16*)(ws + WS_VT) + ((size_t)(0 * 4 + b) * 4 + hkv) * 64 * 4096;
        flash_branch<0>(Kp, VTp, 0, (t0 + 15) >> 6, ulo, uhi, mlo, mhi, t0, t, Qs, O, mx, L, q, r16);
        attn_finish<1>(args, O, L, true, m, hkv, q);
    }
    {
#pragma unroll
        for (int g = 0; g < 4; ++g) { mx[g] = NEGF; L[g] = (f32x4){0.f, 0.f, 0.f, 0.f}; }
#pragma unroll
        for (int dt = 0; dt < 4; ++dt)
#pragma unroll
            for (int g = 0; g < 4; ++g) O[dt][g] = (f32x4){0.f, 0.f, 0.f, 0.f};
        const bf16* Kp = (const bf16*)(ws + WS_KVH) + ((size_t)(4 * 4 + b) * 4 + hkv) * 4096 * 64;
        const bf16* VTp = (const bf16*)(ws + WS_VT) + ((size_t)(1 * 4 + b) * 4 + hkv) * 64 * 4096;
        const int jbeg = t0 >= 511 ? (t0 - 511) >> 6 : 0, jend = (t0 + 15) >> 6;
        flash_branch<1>(Kp, VTp, jbeg, jend, 0xffffffffu, 0xffffffffu, 0xffffffffu, 0xffffffffu, t0, t, Qs, O, mx, L, q, r16);
        attn_finish<2>(args, O, L, true, m, hkv, q);
    }
}
__device__ __forceinline__ void dot4_reduce(const float (&qv)[4], float kx, int lane, float (&sg)[4]) {
    const float v0 = qv[0] * kx, v1 = qv[1] * kx, v2 = qv[2] * kx, v3 = qv[3] * kx;
    const bool up = (lane & 32) != 0, up2 = (lane & 16) != 0;
    const float r0 = (up ? v2 : v0) + __shfl_xor(up ? v0 : v2, 32), r1 = (up ? v3 : v1) + __shfl_xor(up ? v1 : v3, 32);
    float x = (up2 ? r1 : r0) + __shfl_xor(up2 ? r0 : r1, 16);
    x += __shfl_xor(x, 8); x += __shfl_xor(x, 4); x += __shfl_xor(x, 2); x += __shfl_xor(x, 1);
    const int xi = __builtin_bit_cast(int, x);
    sg[0] = __builtin_bit_cast(float, __builtin_amdgcn_readlane(xi, 0)); sg[1] = __builtin_bit_cast(float, __builtin_amdgcn_readlane(xi, 16));
    sg[2] = __builtin_bit_cast(float, __builtin_amdgcn_readlane(xi, 32)); sg[3] = __builtin_bit_cast(float, __builtin_amdgcn_readlane(xi, 48));
}
struct SampleRows { const float* cache; const float* cwin; float* out; const LAS int* selblk; const LAS int* selpage; int bs, hkv, rs, dc; };
template <int BR> __device__ __forceinline__ void srow_load(const SampleRows& R, int row, int nrows, f32x4& kx, f32x4& vx) {
    kx = (f32x4){0.f, 0.f, 0.f, 0.f}; vx = kx;
    if (row < nrows) {
        if (BR == 0) { const int k = row >> 6; const unsigned off = (((unsigned)R.selpage[k] * 128u + (unsigned)((R.selblk[k] & 1) * 64 + (row & 63))) * 4u + 2u) * 256u + (unsigned)(R.hkv * 64 + 4 * R.dc);
            kx = *(const f32x4*)(R.cache + off); vx = *(const f32x4*)(R.cache + off + 256u); }
        else { const unsigned off = (((unsigned)R.bs * 512u + (unsigned)(row + 1)) * 2u) * 256u + (unsigned)(R.hkv * 64 + 4 * R.dc);
            kx = *(const f32x4*)(R.cwin + off); vx = *(const f32x4*)(R.cwin + off + 256u); }
    }
}
__device__ __forceinline__ void srow_update(const f32x4 (&qv)[4], const f32x4& kx, const f32x4& vx, bool valid, float (&mx)[4], float (&ls)[4], f32x4 (&o)[4]) {
    float s[4];
#pragma unroll
    for (int g = 0; g < 4; ++g) s[g] = (qv[g].x * kx.x + qv[g].y * kx.y) + (qv[g].z * kx.z + qv[g].w * kx.w);
#pragma unroll
    for (int st = 8; st >= 1; st >>= 1)
#pragma unroll
        for (int g = 0; g < 4; ++g) s[g] += __shfl_xor(s[g], st);
#pragma unroll
    for (int g = 0; g < 4; ++g) {
        const float mnew = valid ? fmaxf(mx[g], s[g]) : mx[g], alpha = __expf(mx[g] - mnew), p = valid ? __expf(s[g] - mnew) : 0.f;
        ls[g] = ls[g] * alpha + p; o[g] = o[g] * alpha + vx * p; mx[g] = mnew;
    }
}
template <int BR>
__device__ __forceinline__ void sample_rows_branch(const SampleRows& R, int wave, const f32x4 (&qv)[4], LAS float* pm, LAS float* pl, LAS float* po) {
    float mx[4], ls[4]; f32x4 o[4];
#pragma unroll
    for (int g = 0; g < 4; ++g) { mx[g] = NEGF; ls[g] = 0.f; o[g] = (f32x4){0.f, 0.f, 0.f, 0.f}; }
    constexpr int nrows = BR == 0 ? 15 * 64 : 511;
    constexpr int ngroups = (nrows + 3) / 4;
#pragma unroll 1
    for (int g0 = wave; g0 < ngroups; g0 += 64) {
        f32x4 kx[8], vx[8];
#pragma unroll
        for (int k = 0; k < 8; ++k) srow_load<BR>(R, 4 * (g0 + 8 * k) + R.rs, (g0 + 8 * k) < ngroups ? nrows : 0, kx[k], vx[k]);
#pragma unroll
        for (int k = 0; k < 8; ++k) {
            const int grp = g0 + 8 * k, row = 4 * grp + R.rs;
            if (grp < ngroups) {
                const bool valid = row < nrows;
                if (BR == 1 && valid) { const unsigned off = (((unsigned)R.bs * 512u + (unsigned)row) * 2u) * 256u + (unsigned)(R.hkv * 64 + 4 * R.dc);
                    *(f32x4*)(R.out + O_WINS + off) = kx[k]; *(f32x4*)(R.out + O_WINS + off + 256u) = vx[k]; }
                srow_update(qv, kx[k], vx[k], valid, mx, ls, o);
            }
        }
    }
    if (wave == 0) {
        const float* src = BR == 0 ? R.out + O_KVS + ((size_t)R.bs * 4 + 2) * 256 + R.hkv * 64 + 4 * R.dc : R.out + O_WINS + (((size_t)R.bs * 512 + 511) * 2) * 256 + R.hkv * 64 + 4 * R.dc;
        const f32x4 kx = *(const f32x4*)src, vx = *(const f32x4*)(src + 256);
        srow_update(qv, kx, vx, R.rs == 0, mx, ls, o);
    }
    const int slot = (BR * 32 + wave * 4 + R.rs) * 4;
#pragma unroll
    for (int g = 0; g < 4; ++g) { if (R.dc == 0) { pm[slot + g] = mx[g]; pl[slot + g] = ls[g]; } *(LAS f32x4*)(po + (size_t)(slot + g) * 64 + 4 * R.dc) = o[g]; }
}

__device__ __forceinline__ void attn_sample_unit(const Args& args, LAS unsigned char* lds, int unit, int tid, int wave, int lane) {
    unsigned char* ws = args.ws; float* out = args.out;
    const int hkv = unit & 3, bs = unit >> 2; const size_t m = MP + bs;
    LAS float* sc = (LAS float*)lds; LAS float* impv = sc + 512; LAS int* selblk = (LAS int*)(impv + 64); LAS int* selpage = selblk + 16; LAS int* pg = selpage + 16;
    LAS float* pm = (LAS float*)(pg + 16); LAS float* pl = pm + 256; LAS float* po = pl + 256;
    LAS float* poc = po + 2 * 32 * 4 * 64;
    const bf16* Qr = (const bf16*)(ws + WS_Q) + m * 1024 + hkv * 256;
    const float* KCS = (const float*)(ws + WS_KCS) + (size_t)(bs * 4 + hkv) * 128 * 64; const float* VCS = (const float*)(ws + WS_VCS) + (size_t)(bs * 4 + hkv) * 128 * 64;
    float qv[4];
#pragma unroll
    for (int g = 0; g < 4; ++g) qv[g] = bf2f(Qr[g * 64 + lane]) * 0.125f;
    if (tid < 16) pg[tid] = ((const int*)args.in[5])[bs * NPAGES + tid];
    {
        float kr[16];
#pragma unroll
        for (int i = 0; i < 16; ++i) { const int n = wave + 8 * i; kr[i] = n < 127 ? KCS[n * 64 + lane] : 0.f; }
#pragma unroll
        for (int i = 0; i < 16; ++i) { const int n = wave + 8 * i; float sg[4]; dot4_reduce(qv, kr[i], lane, sg);
            if (lane < 4) sc[lane * 128 + n] = n < 127 ? (lane == 0 ? sg[0] : lane == 1 ? sg[1] : lane == 2 ? sg[2] : sg[3]) : NEGF; }
    }
    __syncthreads();
    if (wave < 4) { const float s0 = sc[wave * 128 + lane], s1 = sc[wave * 128 + 64 + lane];
        float mxv = fmaxf(s0, s1);
#pragma unroll
        for (int o = 1; o < 64; o <<= 1) mxv = fmaxf(mxv, __shfl_xor(mxv, o));
        const float e0 = __expf(s0 - mxv), e1 = (lane < 63) ? __expf(s1 - mxv) : 0.f;
        const float inv = 1.f / fmaxf(wave_sum(e0 + e1), TINYF);
        sc[wave * 128 + lane] = e0 * inv; sc[wave * 128 + 64 + lane] = e1 * inv; }
    __syncthreads();
    {
        float vr[16];
#pragma unroll
        for (int i = 0; i < 16; ++i) { const int n = wave + 8 * i; vr[i] = n < 127 ? VCS[n * 64 + lane] : 0.f; }
        float oc[4] = {0.f, 0.f, 0.f, 0.f};
#pragma unroll
        for (int i = 0; i < 16; ++i) { const int n = wave + 8 * i;
#pragma unroll
            for (int g = 0; g < 4; ++g) oc[g] += sc[g * 128 + n] * vr[i]; }
#pragma unroll
        for (int g = 0; g < 4; ++g) poc[(wave * 4 + g) * 64 + lane] = oc[g];
        if (wave == 4 && lane < 33) { const int j = lane; float acc = 0.f;
#pragma unroll
            for (int k = -1; k < 4; ++k) { const int n = 4 * j + k; if (n >= 0 && n < 127) { const float P = (sc[n] + sc[128 + n]) + (sc[256 + n] + sc[384 + n]); acc += (k == -1 || k == 3) ? P : 2.f * P; } }
            impv[j] = (j == 0 || j == 31 || j == 32) ? BIGF : acc; }
    }
    __syncthreads();
    if (tid < 64) { bool sel = false;
        if (tid < 33) { const float v = impv[tid]; int rank = 0;
            for (int k = 0; k < 33; ++k) { const float o = impv[k]; rank += ((o > v) || (o == v && k < tid)) ? 1 : 0; }
            sel = rank < 16 && tid < 32; }
        const unsigned long long bal = __ballot(sel);
        if (sel) { const int slot = __popcll(bal & ((1ull << tid) - 1ull)); selblk[slot] = tid; selpage[slot] = pg[tid >> 1]; } }
    __syncthreads();
    {
        f32x4 qv4[4];
#pragma unroll
        for (int g = 0; g < 4; ++g) { const u32x2 w = *(const u32x2*)(Qr + g * 64 + 4 * (lane & 15)); qv4[g] = (f32x4){bflo(w.x), bfhi(w.x), bflo(w.y), bfhi(w.y)} * 0.125f; }
        SampleRows R{INF(4), INF(6), out, selblk, selpage, bs, hkv, lane >> 4, lane & 15};
        sample_rows_branch<0>(R, wave, qv4, pm, pl, po);
        sample_rows_branch<1>(R, wave, qv4, pm, pl, po);
    }
    __syncthreads();
    if (tid < 256) { const int g = tid >> 6, d = tid & 63;
        const float* gates = (const float*)(ws + WS_MISC) + m * 128 + 32 + (hkv * 4 + g) * 3;
        float oc = 0.f;
#pragma unroll
        for (int w = 0; w < 8; ++w) oc += poc[(w * 4 + g) * 64 + d];
        float res = sigmf(gates[0]) * oc;
#pragma unroll
        for (int br = 0; br < 2; ++br) { float M = NEGF;
#pragma unroll 8
            for (int w = 0; w < 32; ++w) M = fmaxf(M, pm[(br * 32 + w) * 4 + g]);
            float L = 0.f, O = 0.f;
#pragma unroll 8
            for (int w = 0; w < 32; ++w) { const float e = __expf(pm[(br * 32 + w) * 4 + g] - M); L += pl[(br * 32 + w) * 4 + g] * e; O += po[((br * 32 + w) * 4 + g) * 64 + d] * e; }
            res += sigmf(gates[1 + br]) * O / fmaxf(L, TINYF); }
        ((bf16*)(ws + WS_YATT))[m * 1024 + (hkv * 4 + g) * 64 + d] = (bf16)f2bf(res); }
    __syncthreads();
}

__device__ __forceinline__ void ffn_act_item(const Args& args, int item, int lane) {
    unsigned char* ws = args.ws; float* out = args.out;
    const bf16* U = (const bf16*)(ws + WS_U); bf16* ACT = (bf16*)(ws + WS_ACT);
    const float* cw = INF(32); const float* cb = INF(33); const float* st = INF(9);
    const int slab = item % 11, chunk = item / 11, row0 = chunk * 32, c4 = slab * 256 + lane * 4;
    f32x4 w[2][3], bia[2];
#pragma unroll
    for (int hf = 0; hf < 2; ++hf) { bia[hf] = *(const f32x4*)(cb + hf * DFF + c4);
#pragma unroll
        for (int k = 0; k < 3; ++k) w[hf][k] = *(const f32x4*)(cw + k * DFF2 + hf * DFF + c4); }
    if (row0 >= MP) {
        for (int r = 0; r < 32; ++r) { const int bs = row0 - MP + r; if (bs >= MS) break;
            f32x4 cu[2];
#pragma unroll
            for (int hf = 0; hf < 2; ++hf) { const int col = hf * DFF + c4;
                const f32x4 u0 = *(const f32x4*)(st + ((size_t)bs * 2 + 0) * DFF2 + col), u1 = *(const f32x4*)(st + ((size_t)bs * 2 + 1) * DFF2 + col), u2 = *(const f32x4*)(out + O_FFNS + ((size_t)bs * 2 + 1) * DFF2 + col);
                *(f32x4*)(out + O_FFNS + ((size_t)bs * 2 + 0) * DFF2 + col) = u1;
                cu[hf] = bia[hf] + w[hf][0] * u0 + w[hf][1] * u1 + w[hf][2] * u2; }
            u32x2 o; o.x = pk2(siluf(cu[0].x) * cu[1].x, siluf(cu[0].y) * cu[1].y); o.y = pk2(siluf(cu[0].z) * cu[1].z, siluf(cu[0].w) * cu[1].w);
            *(u32x2*)(ACT + (size_t)(row0 + r) * DFF + c4) = o; }
        return;
    }
    const int t0 = row0 & 4095;
    f32x4 p2[2], p1[2];
#pragma unroll
    for (int hf = 0; hf < 2; ++hf) { const int col = hf * DFF + c4;
        const u32x2 a = t0 >= 2 ? *(const u32x2*)(U + (size_t)(row0 - 2) * DFF2 + col) : (u32x2){0u, 0u}, b = t0 >= 1 ? *(const u32x2*)(U + (size_t)(row0 - 1) * DFF2 + col) : (u32x2){0u, 0u};
        p2[hf] = (f32x4){bflo(a.x), bfhi(a.x), bflo(a.y), bfhi(a.y)}; p1[hf] = (f32x4){bflo(b.x), bfhi(b.x), bflo(b.y), bfhi(b.y)}; }
#pragma unroll 1
    for (int rb = 0; rb < 32; rb += 8) {
        u32x2 v[8][2];
#pragma unroll
        for (int r = 0; r < 8; ++r)
#pragma unroll
            for (int hf = 0; hf < 2; ++hf) v[r][hf] = *(const u32x2*)(U + (size_t)(row0 + rb + r) * DFF2 + hf * DFF + c4);
#pragma unroll
        for (int r = 0; r < 8; ++r) {
            f32x4 cu[2];
#pragma unroll
            for (int hf = 0; hf < 2; ++hf) { const f32x4 u2 = (f32x4){bflo(v[r][hf].x), bfhi(v[r][hf].x), bflo(v[r][hf].y), bfhi(v[r][hf].y)};
                cu[hf] = bia[hf] + w[hf][0] * p2[hf] + w[hf][1] * p1[hf] + w[hf][2] * u2; p2[hf] = p1[hf]; p1[hf] = u2; }
            u32x2 o; o.x = pk2(siluf(cu[0].x) * cu[1].x, siluf(cu[0].y) * cu[1].y); o.y = pk2(siluf(cu[0].z) * cu[1].z, siluf(cu[0].w) * cu[1].w);
            *(u32x2*)(ACT + (size_t)(row0 + rb + r) * DFF + c4) = o;
        }
    }
}
template <int KTOT>
__device__ __forceinline__ f32x4 skinny_acc(const bf16* A, int lda, const bf16* Bt, int ldb, int wave, int ct, int q, int r16) {
    const bf16* ap = A + (size_t)(16 * wave + r16) * lda + 8 * q;
    const bf16* bp = Bt + (size_t)(16 * ct + r16) * ldb + 8 * q;
    f32x4 acc = (f32x4){0.f, 0.f, 0.f, 0.f};
#pragma unroll 1
    for (int k0 = 0; k0 < KTOT; k0 += 256) {
        bf16x8 af[8], bf[8];
#pragma unroll
        for (int i = 0; i < 8; ++i) { af[i] = *(const bf16x8*)(ap + k0 + 32 * i); bf[i] = *(const bf16x8*)(bp + k0 + 32 * i); }
#pragma unroll
        for (int i = 0; i < 8; ++i) acc = MFMA16(af[i], bf[i], acc);
    }
    return acc;
}
template <int WHICH>
__device__ __forceinline__ void skinny_sample_unit(const Args& args, int ct, int wave, int lane) {
    unsigned char* ws = args.ws;
    const int q = lane >> 4, r16 = lane & 15, col = 16 * ct + r16;
    if (WHICH == 0) {
        const f32x4 a1 = skinny_acc<2048>((const bf16*)(ws + WS_YSSM) + (size_t)MP * 2048, 2048, (const bf16*)(ws + WS_WSSM), 2048, wave, ct, q, r16);
        const f32x4 a2 = skinny_acc<1024>((const bf16*)(ws + WS_YATT) + (size_t)MP * 1024, 1024, (const bf16*)(ws + WS_WATT), 1024, wave, ct, q, r16);
#pragma unroll
        for (int r = 0; r < 4; ++r) { const size_t row = MP + 16 * wave + 4 * q + r;
            const f32x4 sq = *(const f32x4*)((const float*)(ws + WS_SSQ) + row * 4);
            const float rstd = 1.f / sqrtf(((sq.x + sq.y) + (sq.z + sq.w)) * (1.f / 2048.f) + EPS);
            const bf16* mg = (const bf16*)(ws + WS_MG) + row * 2048;
            const float v = sigmf(bf2f(mg[col])) * rstd * a1[r] + sigmf(bf2f(mg[1024 + col])) * a2[r];
            ((bf16*)(ws + WS_MERGED))[row * 1024 + col] = (bf16)f2bf(v); }
    } else if (WHICH == 1) {
        const f32x4 a = skinny_acc<1024>((const bf16*)(ws + WS_MERGED) + (size_t)MP * 1024, 1024, (const bf16*)(ws + WS_WOUT), 1024, wave, ct, q, r16);
#pragma unroll
        for (int r = 0; r < 4; ++r) { const int bs = 16 * wave + 4 * q + r;
            ((float*)(ws + WS_X1))[(size_t)(MP + bs) * 1024 + col] = INF(1)[(size_t)bs * 1024 + col] + ((const float*)(ws + WS_MOD))[(size_t)(4 + bs) * 6144 + 2048 + col] * a[r]; }
    } else {
        const f32x4 a = skinny_acc<DFF>((const bf16*)(ws + WS_ACT) + (size_t)MP * DFF, DFF, (const bf16*)(ws + WS_WDN), DFF, wave, ct, q, r16);
#pragma unroll
        for (int r = 0; r < 4; ++r) { const int bs = 16 * wave + 4 * q + r; float* x = (float*)(ws + WS_X1) + (size_t)(MP + bs) * 1024 + col;
            *x = *x + ((const float*)(ws + WS_MOD))[(size_t)(4 + bs) * 6144 + 5120 + col] * a[r]; }
    }
}
constexpr int N_PHASES = 15;
#ifndef MK_PER_PHASE
#define MK_PER_PHASE 0
#endif

__global__ void __launch_bounds__(NTHR, 2) fwd_kernel(Args args) {
    extern __shared__ __attribute__((aligned(16))) unsigned char lds_raw[];
    LAS unsigned char* lds = (LAS unsigned char*)lds_raw;
    const int tid = threadIdx.x, lane = tid & 63, wave = __builtin_amdgcn_readfirstlane(tid >> 6);
    const int G = gridDim.x, bid = blockIdx.x, gw = bid * NWAVES + wave, NGW = G * NWAVES, gt = bid * NTHR + tid, NGT = G * NTHR;
    unsigned char* ws = args.ws;
    for (int u = tid; u < (LDS_BYTES - LDSCTL_OFF) / 4; u += NTHR) ((LAS unsigned*)(lds + LDSCTL_OFF))[u] = 0u;
    __syncthreads();
    XcdBarrier bar; bar.bar = (unsigned*)(ws + WS_CTL) + CW_BAR; bar.x = 0; bar.st = nullptr;
    if (!MK_PER_PHASE) bar = xcd_barrier_post((unsigned*)(ws + WS_CTL) + CW_BAR, (volatile LAS unsigned*)(lds + MISC_OFF) + 8);
    const int lo = args.ph_lo, hi = args.ph_hi;
#ifndef PHASE_MASK
#define PHASE_MASK 0x7fff
#endif
#define IN(k) ((((PHASE_MASK) >> (k)) & 1) && lo <= (k) && (k) < hi)
#define SEAM(k) do { if (IN(k) && IN((k) + 1)) xcd_barrier(bar); } while (0)
    using pg8::Gemm; using pg8::StaticOrder;

    if (IN(0)) { { p0_prologue(args, lds, gw, NGW, lane, wave); } }
    SEAM(0);
    if (IN(1)) { {
        Gemm g{(const bf16*)(ws + WS_SC), (const bf16*)(ws + WS_WADA), 256, 6144, 1024}; StaticOrder S; S.init(256, 6144, G, bid);
        pg8::EpiF32 E{(float*)(ws + WS_MOD), 6144, INF(11)};
        pg8::gemm_phase<pg8::EpiF32, StaticOrder, true, true>(lds, g, S, E);
    } }
    SEAM(1);
    if (IN(2)) { { norm_mod_phase<0>(args, gw, NGW, lane); } }
    SEAM(2);
    if (IN(3)) { {
        Gemm g{(const bf16*)(ws + WS_H), (const bf16*)(ws + WS_WIN), MPAD, NPROJ, 1024}; StaticOrder S; S.init(MPAD, NPROJ, G, bid);
        epi::InProj E{ws, args.out};
        pg8::gemm_phase<epi::InProj, StaticOrder, true, true>(lds, g, S, E);
    } }
    SEAM(3);
    if (IN(4)) { {
        const int p4 = args.p7mask >> 8;
        if (p4 & 1) {
        { Gemm g{(const bf16*)(ws + WS_CKB), (const bf16*)(ws + WS_W1K), 65536, 256, 1024}; StaticOrder S; S.init(65536, 256, G, bid);
          epi::PartBf16 E{(bf16*)(ws + WS_PARTSK)}; pg8::gemm_phase<epi::PartBf16, StaticOrder, true, true>(lds, g, S, E); }
        { Gemm g{(const bf16*)(ws + WS_CVB), (const bf16*)(ws + WS_W1V), 65536, 256, 1024}; StaticOrder S; S.init(65536, 256, G, bid);
          epi::PartBf16 E{(bf16*)(ws + WS_PARTSV)}; pg8::gemm_phase<epi::PartBf16, StaticOrder, true, true>(lds, g, S, E); }
        }
        if (p4 & 2) {
        { Gemm g{(const bf16*)(ws + WS_KVH), (const bf16*)(ws + WS_W1K), 4096, 256, 1024}; StaticOrder S; S.init(4096, 256, G, bid);
          epi::PartBf16 E{(bf16*)(ws + WS_PARTK)}; pg8::gemm_phase<epi::PartBf16, StaticOrder, true, true>(lds, g, S, E); }
        { Gemm g{(const bf16*)(ws + WS_KVH) + (size_t)16 * 4096 * 64, (const bf16*)(ws + WS_W1V), 4096, 256, 1024}; StaticOrder S; S.init(4096, 256, G, (bid + G - 16) % G);
          epi::PartBf16 E{(bf16*)(ws + WS_PARTV)}; pg8::gemm_phase<epi::PartBf16, StaticOrder, true, true>(lds, g, S, E); }
        }
        if (p4 & 4) {
            if (G == 256) { if (bid >= 32) for (int it = gw - 32 * NWAVES; it < 256 * 48; it += NGW - 32 * NWAVES) conv_prompt_item(args, it, lane); }
            else for (int it = gw; it < 256 * 48; it += NGW) conv_prompt_item(args, it, lane);
        }
        if (p4 & 8) { for (int it = gw; it < 4096; it += NGW) dtcs_item(args, it, lane);
            sample_conv(args, gt, NGT); }
    } }
    SEAM(4);
    if (IN(5)) { {
        const int p5 = args.p7mask >> 4;
        if (p5 & 1) for (int u = bid; u < 512; u += G) ssd_states_unit(args, lds, u, wave, lane);
        if (p5 & 2) { for (int it = gw; it < 2 * (4096 / 16); it += NGW) compress2_item<0>(args, it, lane);
            for (int it = gw; it < 2 * (65536 / 16); it += NGW) compress2_item<1>(args, it, lane); }
        if (p5 & 4) for (int it = gw; it < MS * NH; it += NGW) sample_ssm_item(args, lds, it, wave, lane);
    } }
    SEAM(5);
    if (IN(6)) { { scan_phase(args, gt, NGT); } }
    SEAM(6);
    if (IN(7)) { {
#ifndef P7C
#define P7C 7
#endif
        const int p7 = args.p7mask & (P7C);
        if (p7 & 1) for (int u = bid; u < 512; u += G) ssd_out_unit(args, lds, u, wave, lane, tid);
        if (p7 & 2) for (int u = gw; u < 4096; u += NGW) attn_prompt_unit(args, (LAS float*)(lds + wave * 12288), u, NGW == 2048, lane);
        __syncthreads();
        if (p7 & 4) for (int u = bid; u < 512; u += G) attn_sample_unit(args, lds, u, tid, wave, lane);
    } }
    SEAM(7);
    if (IN(8)) { {
        for (int u = bid; u < 64; u += G) skinny_sample_unit<0>(args, u, wave, lane);
        { Gemm g{(const bf16*)(ws + WS_YSSM), (const bf16*)(ws + WS_WSSM), MP, 1024, 2048}; StaticOrder S; S.init(MP, 1024, G, bid);
          epi::Merge1 E{ws}; pg8::gemm_phase<epi::Merge1, StaticOrder, true, true>(lds, g, S, E); }
        { Gemm g{(const bf16*)(ws + WS_YATT), (const bf16*)(ws + WS_WATT), MP, 1024, 1024}; StaticOrder S; S.init(MP, 1024, G, bid);
          epi::Merge2 E{ws}; pg8::gemm_phase<epi::Merge2, StaticOrder, true, true>(lds, g, S, E); }
    } }
    SEAM(8);
    if (IN(9)) { {
        for (int u = bid; u < 64; u += G) skinny_sample_unit<1>(args, u, wave, lane);
        Gemm g{(const bf16*)(ws + WS_MERGED), (const bf16*)(ws + WS_WOUT), MP, 1024, 1024}; StaticOrder S; S.init(MP, 1024, G, bid);
        epi::Resid E{INF(0), INF(1), nullptr, (float*)(ws + WS_X1), (const float*)(ws + WS_MOD), 2048};
        pg8::gemm_phase<epi::Resid, StaticOrder, true, true>(lds, g, S, E);
    } }
    SEAM(9);
    if (IN(10)) { { norm_mod_phase<1>(args, gw, NGW, lane); } }
    SEAM(10);
    if (IN(11)) { {
        Gemm g{(const bf16*)(ws + WS_H), (const bf16*)(ws + WS_WUP), MPAD, DFF2, 1024}; StaticOrder S; S.init(MPAD, DFF2, G, bid);
        epi::Up E{ws, args.out};
        pg8::gemm_phase<epi::Up, StaticOrder, true, true>(lds, g, S, E);
    } }
    SEAM(11);
    if (IN(12)) { { for (int it = gw; it < (MPAD / 32) * 11; it += NGW) ffn_act_item(args, it, lane); } }
    SEAM(12);
    if (IN(13)) { {
        for (int u = bid; u < 64; u += G) skinny_sample_unit<2>(args, u, wave, lane);
        Gemm g{(const bf16*)(ws + WS_ACT), (const bf16*)(ws + WS_WDN), MP, 1024, DFF}; StaticOrder S; S.init(MP, 1024, G, bid);
        epi::Resid E{INF(0), INF(1), (const float*)(ws + WS_X1), (float*)(ws + WS_X1), (const float*)(ws + WS_MOD), 5120};
        pg8::gemm_phase<epi::Resid, StaticOrder, true, true>(lds, g, S, E);
    } }
    SEAM(13);
    if (IN(14)) { { norm_mod_phase<2>(args, gw, NGW, lane); } }
#undef IN
#undef SEAM
}

extern "C" void kernel_launch(void* const* d_in, const int* in_sizes, int n_in, void* d_out, int out_size, void* d_ws, size_t ws_size, hipStream_t stream) {
    static int grid = 0;
    if (grid == 0) {
        if (n_in != 35 || out_size != (int)O_END || ws_size < WS_END) { fprintf(stderr, "kernel_launch: unexpected shapes (n_in %d out %d ws %zu, need %zu)\n", n_in, out_size, ws_size, (size_t)WS_END); grid = -1; return; }
        int dev = 0, cus = 0, per_cu = 0;
        if (hipGetDevice(&dev) != hipSuccess || hipDeviceGetAttribute(&cus, hipDeviceAttributeMultiprocessorCount, dev) != hipSuccess) { grid = -1; return; }
        if (hipFuncSetAttribute((const void*)fwd_kernel, hipFuncAttributeMaxDynamicSharedMemorySize, LDS_BYTES) != hipSuccess) { fprintf(stderr, "kernel_launch: hipFuncSetAttribute failed\n"); grid = -1; return; }
        if (hipOccupancyMaxActiveBlocksPerMultiprocessor(&per_cu, (const void*)fwd_kernel, NTHR, LDS_BYTES) != hipSuccess || per_cu < 1) { fprintf(stderr, "kernel_launch: occupancy query says %d\n", per_cu); }
        (void)hipGetLastError();
        grid = cus;
    }
    if (grid < 0) return;
    (void)hipMemsetAsync((char*)d_ws + WS_CTL, 0, CTL_ZERO_BYTES, stream);
    Args a{};
    for (int i = 0; i < 35; ++i) a.in[i] = d_in[i];
    a.out = (float*)d_out; a.ws = (unsigned char*)d_ws;
    a.p7mask = 0xFFF; a.pad = 7;
#if MK_PER_PHASE
    for (int p = 0; p < N_PHASES; ++p) { a.ph_lo = p; a.ph_hi = p + 1; hipLaunchKernelGGL(fwd_kernel, dim3(grid), dim3(NTHR), LDS_BYTES, stream, a); }
#else
    a.ph_lo = 0; a.ph_hi = N_PHASES;
    hipLaunchKernelGGL(fwd_kernel, dim3(grid), dim3(NTHR), LDS_BYTES, stream, a);
#endif
#ifdef PROBE_LO
    a.ph_lo = PROBE_LO; a.ph_hi = PROBE_HI; a.p7mask = PROBE_P7MASK; a.pad = PROBE_P7MASK;
    hipLaunchKernelGGL(fwd_kernel, dim3(grid), dim3(NTHR), LDS_BYTES, stream, a);
#endif
}
```

```cpp
#include <hip/hip_runtime.h>
#include <cstdio>
#include <cstdint>
namespace pg8 {
#define PG8_LAS __attribute__((address_space(3)))
typedef unsigned short bf16_t;
typedef short bf16x8 __attribute__((ext_vector_type(8)));
typedef float f32x4 __attribute__((ext_vector_type(4)));
typedef unsigned u32x4 __attribute__((ext_vector_type(4)));
constexpr int BM = 256, BK = 64, HALF = 128, HTB = HALF * BK * 2  , STAGE_BYTES = 8 * HTB, NXCD = 8, WGM = 8;

__host__ __device__ __forceinline__ int lds_byte(int r, int c) { const int st = (r >> 4) * 2 + (c >> 5), rr = r & 15, cc = c & 31, ob = rr * 64 + cc * 2; return st * 1024 + (ob ^ (((ob >> 9) & 1) << 5)); }
__host__ __device__ __forceinline__ void stage_rc(int b, int& R, int& C) { const int st = b / 1024, sb = b % 1024, swz = sb ^ (((sb >> 9) & 1) << 5); R = (st >> 1) * 16 + swz / 64; C = (st & 1) * 32 + (swz % 64) / 2; }
__host__ __device__ __forceinline__ int perm32(int rho) { const int n = rho >> 4, i = rho & 15; return 8 * (i >> 2) + 4 * n + (i & 3); }

struct Unit { int pm, pn; };
struct Gemm { const bf16_t* A; const bf16_t* Bt; int M, N, K; };

struct StaticOrder {
    int nM, nN, nwg, G, c;
    __host__ __device__ void init(int M, int N, int G_, int c_) { nM = M / BM; nN = N / BM; nwg = nM * nN; G = G_; c = c_; }
    __host__ __device__ bool next(int i, Unit& u) const {
        const long L = (long)i * G + c; if (L >= nwg) return false;
        int wgid = (int)L; { const int q = nwg / NXCD, r = nwg % NXCD, xcd = wgid % NXCD, off = wgid / NXCD; wgid = (xcd < r ? xcd * (q + 1) : r * (q + 1) + (xcd - r) * q) + off; }
        const int nig = WGM * nN, gid = wgid / nig, fm = gid * WGM, gsz = (nM - fm) < WGM ? (nM - fm) : WGM;
        u.pm = fm + ((wgid % nig) % gsz); u.pn = (wgid % nig) / gsz; return true;
    }
    __device__ __forceinline__ void a_ready(const Unit&) const {}
    __device__ __forceinline__ void done(const Unit&) const {}
};
__device__ __forceinline__ unsigned cvt_pk_bf16(float lo, float hi) { unsigned r; asm volatile("v_cvt_pk_bf16_f32 %0, %1, %2" : "=v"(r) : "v"(lo), "v"(hi)); return r; }
typedef float f32x2 __attribute__((ext_vector_type(2)));
struct EpiF32 {
    static constexpr bool PERM = false, AFTER_DRAIN = false;
    float* C; int ldc; const float* bias;
    __device__ __forceinline__ void operator()(const f32x4 (&acc)[2][2][4][2], const Unit& u, int wr, int wc, int fr, int fq) const {
        const int row0 = u.pm * BM + wr * 64 + fr, col0 = u.pn * BM + wc * 32 + 4 * fq;
        f32x4 bv[2][2];
#pragma unroll
        for (int bj = 0; bj < 2; ++bj)
#pragma unroll
            for (int n = 0; n < 2; ++n) bv[bj][n] = bias ? *(const f32x4*)(bias + col0 + bj * HALF + n * 16) : (f32x4){0.f, 0.f, 0.f, 0.f};
#pragma unroll
        for (int ai = 0; ai < 2; ++ai)
#pragma unroll
            for (int m = 0; m < 4; ++m) { float* rowp = C + (size_t)(row0 + ai * HALF + m * 16) * ldc + col0;
#pragma unroll
                for (int bj = 0; bj < 2; ++bj)
#pragma unroll
                    for (int n = 0; n < 2; ++n) *(f32x4*)(rowp + bj * HALF + n * 16) = acc[ai][bj][m][n] + bv[bj][n]; }
    }
};
template <class Epi, class Sched, bool ALIGN_EPI = false, bool SP2 = false>
__device__ __forceinline__ void gemm_phase(PG8_LAS unsigned char* lds, const Gemm g, const Sched& S, const Epi& E) {
    const int tid = threadIdx.x, wid = __builtin_amdgcn_readfirstlane(tid >> 6), lane = tid & 63, wr = wid >> 2, wc = wid & 3, fr = lane & 15, fq = lane >> 4;
    const int K = g.K, nt = K / BK;
    unsigned voffA[2], voffB[2];
#pragma unroll
    for (int i = 0; i < 2; ++i) { int R, C; stage_rc(tid * 16 + i * 8192, R, C); const int Rb = Epi::PERM ? ((R & ~31) + perm32(R & 31)) : R;
        voffA[i] = (unsigned)(R * K + C) * 2u; voffB[i] = (unsigned)(Rb * K + C) * 2u; }
    const size_t kstep = (size_t)(BK * 2);
    const size_t hstep = (size_t)HALF * K * 2;
    const size_t tstep = 2 * hstep;
    const unsigned ldsw = (unsigned)wid * 1024u;
    const int aoff = lds_byte(wr * 64 + fr, fq * 8), boff = lds_byte(wc * 32 + fr, fq * 8);
#define PG8_SA(b, h) (((b) * 2 + (h)) * HTB)
#define PG8_SB(b, h) ((4 + (b) * 2 + (h)) * HTB)
#define PG8_STAGE(bufoff, gbase, voff) do { _Pragma("unroll") for (int _i = 0; _i < 2; ++_i) \
        __builtin_amdgcn_global_load_lds((const unsigned*)((const char*)(gbase) + (voff)[_i]), (PG8_LAS unsigned*)(lds + (bufoff) + ldsw + _i * 8192), 16, 0, 0); } while (0)
#define PG8_LDA(dst, b, h) do { _Pragma("unroll") for (int m = 0; m < 4; ++m) _Pragma("unroll") for (int k = 0; k < 2; ++k) dst[m][k] = *(const PG8_LAS bf16x8*)(lds + PG8_SA(b, h) + aoff + m * 2048 + k * 1024); } while (0)
#define PG8_LDB(dst, b, h) do { _Pragma("unroll") for (int n = 0; n < 2; ++n) _Pragma("unroll") for (int k = 0; k < 2; ++k) dst[n][k] = *(const PG8_LAS bf16x8*)(lds + PG8_SB(b, h) + boff + n * 2048 + k * 1024); } while (0)
#define PG8_MMA(ai, bj, At, Bt) do { __builtin_amdgcn_s_setprio(1); _Pragma("unroll") for (int m = 0; m < 4; ++m) _Pragma("unroll") for (int n = 0; n < 2; ++n) _Pragma("unroll") for (int k = 0; k < 2; ++k) \
        acc[ai][bj][m][n] = __builtin_amdgcn_mfma_f32_16x16x32_bf16(Bt[n][k], At[m][k], acc[ai][bj][m][n], 0, 0, 0); __builtin_amdgcn_s_setprio(0); } while (0)
#define PG8_WAIT_V(n) asm volatile("s_waitcnt vmcnt(" #n ")" ::: "memory")
#define PG8_WAIT_L(n) asm volatile("s_waitcnt lgkmcnt(" #n ")" ::: "memory")
#define PG8_BAR __builtin_amdgcn_s_barrier()
#define PG8_SCHED __builtin_amdgcn_sched_barrier(0)
    Unit cur, nxt; int ui = 0;
    if (!S.next(0, cur)) return;
    f32x4 acc[2][2][4][2];
#pragma unroll
    for (int a = 0; a < 2; ++a)
#pragma unroll
        for (int b = 0; b < 2; ++b)
#pragma unroll
            for (int m = 0; m < 4; ++m)
#pragma unroll
                for (int n = 0; n < 2; ++n) acc[a][b][m][n] = (f32x4){0.f, 0.f, 0.f, 0.f};
    bf16x8 At[4][2], B0[2][2], B1[2][2];
    const char* cA = (const char*)g.A + (size_t)cur.pm * tstep; const char* cB = (const char*)g.Bt + (size_t)cur.pn * tstep;
    S.a_ready(cur);
    if constexpr (SP2) {
        PG8_STAGE(PG8_SB(0, 0), cB, voffB); PG8_STAGE(PG8_SB(0, 1), cB + hstep, voffB); PG8_STAGE(PG8_SA(0, 0), cA, voffA); PG8_STAGE(PG8_SA(0, 1), cA + hstep, voffA);
        if (wr == 1) PG8_BAR;
        PG8_WAIT_V(2); PG8_BAR;
        PG8_STAGE(PG8_SB(1, 0), cB + kstep, voffB); PG8_STAGE(PG8_SA(1, 0), cA + kstep, voffA); PG8_STAGE(PG8_SB(1, 1), cB + hstep + kstep, voffB);
        PG8_WAIT_V(6); PG8_BAR;
    } else {
        PG8_STAGE(PG8_SB(0, 0), cB, voffB); PG8_STAGE(PG8_SA(0, 0), cA, voffA); PG8_STAGE(PG8_SB(0, 1), cB + hstep, voffB); PG8_STAGE(PG8_SA(0, 1), cA + hstep, voffA);
        if (wr == 1) PG8_BAR;
        PG8_WAIT_V(4); PG8_BAR;
        PG8_STAGE(PG8_SB(1, 0), cB + kstep, voffB); PG8_STAGE(PG8_SA(1, 0), cA + kstep, voffA); PG8_STAGE(PG8_SB(1, 1), cB + hstep + kstep, voffB);
        PG8_WAIT_V(6); PG8_BAR;
    }
    for (;;) {
        const bool has_next = S.next(ui + 1, nxt);
        const char* nA = has_next ? (const char*)g.A + (size_t)nxt.pm * tstep : cA; const char* nB = has_next ? (const char*)g.Bt + (size_t)nxt.pn * tstep : cB;
        for (int t = 0; t < nt; t += 2) {
            const bool last = (t == nt - 2);
            const char* a1 = cA + (size_t)(t + 1) * kstep;
            const char* a2 = last ? nA : cA + (size_t)(t + 2) * kstep; const char* b2 = last ? nB : cB + (size_t)(t + 2) * kstep;
            const char* a3 = a2 + kstep; const char* b3 = b2 + kstep;
            if (last && has_next) S.a_ready(nxt);
            if constexpr (SP2) {
            PG8_LDB(B0, 0, 0); PG8_LDB(B1, 0, 1); PG8_SCHED; PG8_LDA(At, 0, 0); PG8_STAGE(PG8_SA(1, 1), a1 + hstep, voffA);
            PG8_WAIT_V(8); PG8_WAIT_L(0); PG8_BAR; PG8_MMA(0, 0, At, B0); PG8_MMA(0, 1, At, B1); PG8_BAR; PG8_SCHED;
            PG8_LDA(At, 0, 1); PG8_STAGE(PG8_SB(0, 0), b2, voffB); PG8_STAGE(PG8_SB(0, 1), b2 + hstep, voffB); PG8_STAGE(PG8_SA(0, 0), a2, voffA);
            PG8_WAIT_V(8); PG8_WAIT_L(0); PG8_BAR; PG8_MMA(1, 0, At, B0); PG8_MMA(1, 1, At, B1); PG8_BAR; PG8_SCHED;
            PG8_LDB(B0, 1, 0); PG8_LDB(B1, 1, 1); PG8_SCHED; PG8_LDA(At, 1, 0); PG8_STAGE(PG8_SA(0, 1), a2 + hstep, voffA);
            PG8_WAIT_V(8); PG8_WAIT_L(0); PG8_BAR; PG8_MMA(0, 0, At, B0); PG8_MMA(0, 1, At, B1); PG8_BAR; PG8_SCHED;
            PG8_LDA(At, 1, 1); PG8_STAGE(PG8_SB(1, 0), b3, voffB); PG8_STAGE(PG8_SB(1, 1), b3 + hstep, voffB); PG8_STAGE(PG8_SA(1, 0), a3, voffA);
            PG8_WAIT_V(8); PG8_WAIT_L(0); PG8_BAR; PG8_MMA(1, 0, At, B0); PG8_MMA(1, 1, At, B1); PG8_BAR; PG8_SCHED;
            } else {
            PG8_LDB(B0, 0, 0); PG8_SCHED; PG8_LDA(At, 0, 0); PG8_STAGE(PG8_SA(1, 1), a1 + hstep, voffA);
            PG8_WAIT_L(8); PG8_BAR; PG8_WAIT_L(0); PG8_MMA(0, 0, At, B0); PG8_BAR; PG8_SCHED;
            PG8_LDB(B1, 0, 1); PG8_STAGE(PG8_SB(0, 0), b2, voffB);
            PG8_BAR; PG8_WAIT_L(0); PG8_MMA(0, 1, At, B1); PG8_BAR;
            PG8_LDA(At, 0, 1); PG8_STAGE(PG8_SA(0, 0), a2, voffA);
            PG8_BAR; PG8_WAIT_L(0); PG8_MMA(1, 0, At, B0); PG8_BAR; PG8_SCHED;
            PG8_STAGE(PG8_SB(0, 1), b2 + hstep, voffB);
            PG8_WAIT_V(6); PG8_BAR; PG8_MMA(1, 1, At, B1); PG8_BAR;
            PG8_LDB(B0, 1, 0); PG8_SCHED; PG8_LDA(At, 1, 0); PG8_STAGE(PG8_SA(0, 1), a2 + hstep, voffA);
            PG8_WAIT_L(8); PG8_BAR; PG8_WAIT_L(0); PG8_MMA(0, 0, At, B0); PG8_BAR; PG8_SCHED;
            PG8_LDB(B1, 1, 1); PG8_STAGE(PG8_SB(1, 0), b3, voffB);
            PG8_BAR; PG8_WAIT_L(0); PG8_MMA(0, 1, At, B1); PG8_BAR;
            PG8_LDA(At, 1, 1); PG8_STAGE(PG8_SA(1, 0), a3, voffA);
            PG8_BAR; PG8_WAIT_L(0); PG8_MMA(1, 0, At, B0); PG8_BAR; PG8_SCHED;
            PG8_STAGE(PG8_SB(1, 1), b3 + hstep, voffB);
            PG8_WAIT_V(6); PG8_BAR; PG8_MMA(1, 1, At, B1); PG8_BAR;
            }
        }
        if constexpr (ALIGN_EPI) { if (wr == 0) PG8_BAR; }
        if constexpr (!Epi::AFTER_DRAIN) { E(acc, cur, wr, wc, fr, fq); S.done(cur); }
        if (!has_next) break;
#pragma unroll
        for (int a = 0; a < 2; ++a)
#pragma unroll
            for (int b = 0; b < 2; ++b)
#pragma unroll
                for (int m = 0; m < 4; ++m)
#pragma unroll
                    for (int n = 0; n < 2; ++n) acc[a][b][m][n] = (f32x4){0.f, 0.f, 0.f, 0.f};
        cur = nxt; cA = nA; cB = nB; ++ui;
        if constexpr (ALIGN_EPI) { if (wr == 1) PG8_BAR; }
    }
    PG8_WAIT_V(0);
    if constexpr (!ALIGN_EPI) { if (wr == 0) PG8_BAR; }
    PG8_BAR;
    if constexpr (Epi::AFTER_DRAIN) { E.fused(acc, cur, wr, wc, fr, fq, lds, wid, lane); S.done(cur); }
#undef PG8_SA
#undef PG8_SB
#undef PG8_STAGE
#undef PG8_LDA
#undef PG8_LDB
#undef PG8_MMA
#undef PG8_WAIT_V
#undef PG8_WAIT_L
#undef PG8_BAR
#undef PG8_SCHED
}
}
#define GAS __attribute__((address_space(1)))
#define LAS __attribute__((address_space(3)))
typedef unsigned short bf16;
typedef float f32x4 __attribute__((ext_vector_type(4)));
typedef float f32x2 __attribute__((ext_vector_type(2)));
typedef short bf16x8 __attribute__((ext_vector_type(8)));
typedef short bf16x4 __attribute__((ext_vector_type(4)));
typedef unsigned u32x4 __attribute__((ext_vector_type(4)));
typedef unsigned u32x2 __attribute__((ext_vector_type(2)));
#define MFMA16(a, b, c) __builtin_amdgcn_mfma_f32_16x16x32_bf16((a), (b), (c), 0, 0, 0)

constexpr int NWAVES = 8, NTHR = 512;
constexpr int DM = 1024, SEQ = 4096, NB = 4, MP = NB * SEQ, MS = 128, MALL = MP + MS, MPAD = 16640;
constexpr int DI = 2048, CONVD = 3072, NH = 32, NG = 4, NST = 128;
constexpr int NPROJ = 9984;
constexpr int DFF = 2816, DFF2 = 5632;
constexpr int NPAGES = 16, PAST = 2048;
constexpr float EPS = 1e-6f, NEGF = -1e30f, BIGF = 1e30f, TINYF = 1e-30f;
constexpr int T_Z = 0, T_XBC = 8, T_Q = 20, T_KV = 24, T_MG = 30, T_MISC = 38;

constexpr size_t O_YP = 0;
constexpr size_t O_YS = O_YP + (size_t)MP * DM;
constexpr size_t O_KVP = O_YS + (size_t)MS * DM;
constexpr size_t O_KVS = O_KVP + (size_t)MP * 1024;
constexpr size_t O_WINP = O_KVS + (size_t)MS * 1024;
constexpr size_t O_WINS = O_WINP + (size_t)NB * 512 * 512;
constexpr size_t O_SSMP = O_WINS + (size_t)MS * 512 * 512;
constexpr size_t O_SSMS = O_SSMP + (size_t)NB * NH * 64 * 128;
constexpr size_t O_CONVP = O_SSMS + (size_t)MS * NH * 64 * 128;
constexpr size_t O_CONVS = O_CONVP + (size_t)NB * 3 * CONVD;
constexpr size_t O_FFNP = O_CONVS + (size_t)MS * 3 * CONVD;
constexpr size_t O_FFNS = O_FFNP + (size_t)NB * 2 * DFF2;
constexpr size_t O_END = O_FFNS + (size_t)MS * 2 * DFF2;
static_assert(O_END == 105725952, "output size");

constexpr size_t al256(size_t x) { return (x + 255) & ~(size_t)255; }
constexpr size_t WS_CTL = 0, CTL_ZERO_BYTES = 1u << 20;
constexpr size_t WS_WIN = CTL_ZERO_BYTES;
constexpr size_t WS_WSSM = WS_WIN + al256((size_t)NPROJ * 1024 * 2);
constexpr size_t WS_WATT = WS_WSSM + al256((size_t)1024 * 2048 * 2);
constexpr size_t WS_WOUT = WS_WATT + al256((size_t)1024 * 1024 * 2);
constexpr size_t WS_WUP = WS_WOUT + al256((size_t)1024 * 1024 * 2);
constexpr size_t WS_WDN = WS_WUP + al256((size_t)DFF2 * 1024 * 2);
constexpr size_t WS_WADA = WS_WDN + al256((size_t)1024 * DFF * 2);
constexpr size_t WS_W1K = WS_WADA + al256((size_t)6144 * 1024 * 2);
constexpr size_t WS_W1V = WS_W1K + al256((size_t)256 * 1024 * 2);
constexpr size_t WS_SC = WS_W1V + al256((size_t)256 * 1024 * 2);
constexpr size_t WS_MOD = WS_SC + al256((size_t)256 * 1024 * 2);
constexpr size_t WS_ROPE = WS_MOD + al256((size_t)256 * 6144 * 4);
constexpr size_t WS_PET = WS_ROPE + al256((size_t)4096 * 16 * 4);
constexpr size_t WS_H = WS_PET + al256(2 * 128 * 4);
constexpr size_t WS_Z = WS_H + al256((size_t)MPAD * 1024 * 2);
constexpr size_t WS_XBC = WS_Z + al256((size_t)MPAD * 2048 * 2);
constexpr size_t WS_Q = WS_XBC + al256((size_t)MPAD * 3072 * 2);
constexpr size_t WS_MG = WS_Q + al256((size_t)MPAD * 1024 * 2);
constexpr size_t WS_MISC = WS_MG + al256((size_t)MPAD * 2048 * 2);
constexpr size_t WS_KVH = WS_MISC + al256((size_t)MPAD * 128 * 4);
constexpr size_t WS_VT = WS_KVH + al256((size_t)6 * 16 * 4096 * 64 * 2);
constexpr size_t WS_XT = WS_VT + al256((size_t)2 * 16 * 64 * 4096 * 2);
constexpr size_t WS_BN = WS_XT + al256((size_t)4 * 32 * 64 * 4096 * 2);
constexpr size_t WS_CN = WS_BN + al256((size_t)16 * 4096 * 128 * 2);
constexpr size_t WS_BT = WS_CN + al256((size_t)16 * 4096 * 128 * 2);
constexpr size_t WS_DT = WS_BT + al256((size_t)16 * 4096 * 128 * 2);
constexpr size_t WS_CS = WS_DT + al256((size_t)128 * 4096 * 4);
constexpr size_t WS_STATES = WS_CS + al256((size_t)128 * 4096 * 4);
constexpr size_t WS_HPREV = WS_STATES + al256((size_t)4096 * 8192 * 4);
constexpr size_t WS_YSSM = WS_HPREV + al256((size_t)4096 * 8192 * 2);
constexpr size_t WS_SSQ = WS_YSSM + al256((size_t)MPAD * 2048 * 2);
constexpr size_t WS_PARTK = WS_SSQ + al256((size_t)MPAD * 4 * 4);
constexpr size_t WS_PARTV = WS_PARTK + al256((size_t)4096 * 256 * 4);
constexpr size_t WS_KC = WS_PARTV + al256((size_t)4096 * 256 * 4);
constexpr size_t WS_VCT = WS_KC + al256((size_t)16 * 256 * 64 * 2);
constexpr size_t WS_YATTF = WS_VCT + al256((size_t)16 * 256 * 64 * 2);
constexpr size_t WS_YATT = WS_YATTF + al256((size_t)MPAD * 1024 * 4);
constexpr size_t WS_TMPM = WS_YATT + al256((size_t)MPAD * 1024 * 2);
constexpr size_t WS_MERGED = WS_TMPM + al256((size_t)MPAD * 1024 * 4);
constexpr size_t WS_X1 = WS_MERGED + al256((size_t)MPAD * 1024 * 2);
constexpr size_t WS_U = WS_X1 + al256((size_t)MPAD * 1024 * 4);
constexpr size_t WS_ACT = WS_U + al256((size_t)MPAD * DFF2 * 2);
constexpr size_t WS_CKB = WS_ACT + al256((size_t)MPAD * DFF * 2);
constexpr size_t WS_CVB = WS_CKB + al256((size_t)128 * 4 * 2048 * 64 * 2);
constexpr size_t WS_PARTSK = WS_CVB + al256((size_t)128 * 4 * 2048 * 64 * 2);
constexpr size_t WS_PARTSV = WS_PARTSK + al256((size_t)65536 * 256 * 4);
constexpr size_t WS_KCS = WS_PARTSV + al256((size_t)65536 * 256 * 4);
constexpr size_t WS_VCS = WS_KCS + al256((size_t)128 * 4 * 128 * 64 * 4);
constexpr size_t WS_XCS = WS_VCS + al256((size_t)128 * 4 * 128 * 64 * 4);
constexpr size_t WS_DTS = WS_XCS + al256((size_t)128 * 3072 * 4);
constexpr size_t WS_W2T = WS_DTS + al256((size_t)128 * 32 * 4);
constexpr size_t WS_END = WS_W2T + al256((size_t)2 * 64 * 128 * 2);

constexpr int CW_BAR = 4096;

constexpr int RING_BYTES = 131072;
constexpr int LDSCTL_OFF = RING_BYTES, MISC_OFF = LDSCTL_OFF + 320;
constexpr int LDS_BYTES = 147456;

__device__ __forceinline__ unsigned f2bf(float f) { unsigned u = __builtin_bit_cast(unsigned, f); return (u + 0x7fffu + ((u >> 16) & 1u)) >> 16; }
__device__ __forceinline__ unsigned pk2(float lo, float hi) { return pg8::cvt_pk_bf16(lo, hi); }
__device__ __forceinline__ float bf2f(unsigned h) { return __builtin_bit_cast(float, h << 16); }
__device__ __forceinline__ float bflo(unsigned w) { return __builtin_bit_cast(float, w << 16); }
__device__ __forceinline__ float bfhi(unsigned w) { return __builtin_bit_cast(float, w & 0xffff0000u); }
__device__ __forceinline__ float wave_sum(float v) {
#pragma unroll
    for (int o = 1; o < 64; o <<= 1) v += __shfl_xor(v, o);
    return v;
}
__device__ __forceinline__ float siluf(float x) { return x / (1.f + __expf(-x)); }
__device__ __forceinline__ float sigmf(float x) { return 1.f / (1.f + __expf(-x)); }
__device__ __forceinline__ float softplusf(float x) { return x > 20.f ? x : log1pf(__expf(x)); }
#define LDS_WAIT() asm volatile("s_waitcnt lgkmcnt(0)" ::: "memory")

struct Args { const void* in[35]; float* out; unsigned char* ws; int ph_lo, ph_hi, p7mask, pad; };
#define INF(i) ((const float*)args.in[i])
#define XB_TMO      128
#define XB_XCNT(j)  (256  + 64 * (j))
#define XB_XSUB(j)  (1280 + 64 * (j))
#define XB_XGEN(j)  (2304 + 64 * (j))
#define XB_TOP      3328
#define XB_TOPGEN   3392
#define XCD_BAR_WORDS 3456
#define XB_SPIN_CAP (1u << 18)

__device__ __forceinline__ unsigned xb_ld(unsigned* p)              { return __hip_atomic_load(p, __ATOMIC_RELAXED, __HIP_MEMORY_SCOPE_AGENT); }
__device__ __forceinline__ unsigned xb_add(unsigned* p, unsigned v) { return __hip_atomic_fetch_add(p, v, __ATOMIC_RELAXED, __HIP_MEMORY_SCOPE_AGENT); }
__device__ __forceinline__ unsigned xb_xcc_id() { return (unsigned)__builtin_amdgcn_s_getreg((3 << 11) | 20) & 0xFu; }
#define XB_SPIN(cond, bar) do { unsigned _sp = 0; while (cond) { __builtin_amdgcn_s_sleep(1); \
    if ((++_sp & 255u) == 0u) { if (xb_ld(&(bar)[XB_TMO])) break; if (_sp > XB_SPIN_CAP) { atomicAdd(&(bar)[XB_TMO], 1u); break; } } } } while (0)

struct XcdBarrier {
    unsigned* bar; unsigned x;
    volatile LAS unsigned* st;
};

__device__ __forceinline__ XcdBarrier xcd_barrier_post(unsigned* bar, volatile LAS unsigned* st) {
    XcdBarrier b; b.bar = bar; b.x = xb_xcc_id(); b.st = st;
    if (threadIdx.x == 0) (void)xb_add(&bar[XB_XCNT(b.x)], 1u);
    return b;
}
__device__ __forceinline__ void xcd_barrier_complete(unsigned* bar, unsigned x, unsigned& nloc, unsigned& nx) {
    const unsigned G = gridDim.x * gridDim.y * gridDim.z;
    unsigned sum, cnt, mine, sp = 0u;
    for (;;) {
        sum = 0u; cnt = 0u; mine = 0u;
#pragma unroll
        for (unsigned j = 0; j < 16; ++j) { const unsigned c = xb_ld(&bar[XB_XCNT(j)]); sum += c; cnt += (c > 0u) ? 1u : 0u; mine = (j == x) ? c : mine; }
        if (sum == G) break;
        __builtin_amdgcn_s_sleep(1);
        if ((++sp & 255u) == 0u) { if (xb_ld(&bar[XB_TMO])) break; if (sp > XB_SPIN_CAP) { atomicAdd(&bar[XB_TMO], 1u); break; } }
    }
    nloc = mine > 0u ? mine : 1u; nx = cnt > 0u ? cnt : 1u;
}

__device__ __forceinline__ void xcd_barrier(const XcdBarrier& b) {
    asm volatile("s_waitcnt vmcnt(0)" ::: "memory");
    __syncthreads();
    if (threadIdx.x == 0) {
        unsigned* bar = b.bar;
        __builtin_amdgcn_s_waitcnt(0);
        unsigned nloc = b.st[0], nx = b.st[1];
        if (nloc == 0u) { xcd_barrier_complete(bar, b.x, nloc, nx); b.st[0] = nloc; b.st[1] = nx; }
        const unsigned old = xb_add(&bar[XB_XSUB(b.x)], 1u);
        const unsigned gen = old / nloc;
        if (old + 1u == (gen + 1u) * nloc) {
            __builtin_amdgcn_fence(__ATOMIC_RELEASE, "agent");
            asm volatile("s_waitcnt vmcnt(0)" ::: "memory");
            const unsigned og = xb_add(&bar[XB_TOP], 1u);
            const unsigned tg = og / nx;
            if (og + 1u == (tg + 1u) * nx) xb_add(&bar[XB_TOPGEN], 1u);
            else XB_SPIN(xb_ld(&bar[XB_TOPGEN]) == tg, bar);
            __builtin_amdgcn_fence(__ATOMIC_ACQUIRE, "agent");
            xb_add(&bar[XB_XGEN(b.x)], 1u);
            asm volatile("s_waitcnt vmcnt(0)" ::: "memory");
        } else {
            XB_SPIN(xb_ld(&bar[XB_XGEN(b.x)]) == gen, bar);
            __builtin_amdgcn_fence(__ATOMIC_ACQUIRE, "agent");
            asm volatile("s_waitcnt vmcnt(0)" ::: "memory");
        }
    }
    __syncthreads();
}
__device__ __forceinline__ int inproj_src_col(int n) {
    if (n < 5120) return n;
    if (n < 6144) return n - 5120 + 5152;
    if (n < 7680) return n - 6144 + 6176;
    if (n < 9728) return n - 7680 + 7760;
    const int i = n - 9728;
    if (i < 32) return 5120 + i;
    if (i < 80) return 7712 + (i - 32);
    return -1;
}
template <int MODE>
__device__ __forceinline__ void transpose_item(const float* W, int K, int ldw, int nblk, bf16* WT, int row_off, LAS float* scr, int item, int lane) {
    const int kb = item / nblk, nb = item % nblk, k0 = 64 * kb, n0 = 32 * nb;
    const int n = n0 + (lane & 31);
    const int sc = (MODE == 1) ? inproj_src_col(n) : n;
#pragma unroll 8
    for (int i = 0; i < 32; ++i) { const int kk = 2 * i + (lane >> 5); scr[kk * 33 + (lane & 31)] = (sc >= 0) ? W[(size_t)(k0 + kk) * ldw + sc] : 0.f; }
    LDS_WAIT(); asm volatile("" ::: "memory");
    const int c = lane & 7;
#pragma unroll
    for (int j = 0; j < 4; ++j) { const int nn = (lane >> 3) + 8 * j; const LAS float* s = scr + (8 * c) * 33 + nn;
        u32x4 o; o.x = pk2(s[0 * 33], s[1 * 33]); o.y = pk2(s[2 * 33], s[3 * 33]); o.z = pk2(s[4 * 33], s[5 * 33]); o.w = pk2(s[6 * 33], s[7 * 33]);
        *(u32x4*)(WT + (size_t)(row_off + n0 + nn) * K + k0 + 8 * c) = o; }
    LDS_WAIT(); asm volatile("" ::: "memory");
}

__device__ __forceinline__ void p0_prologue(const Args& args, LAS unsigned char* lds, int gw, int NGW, int lane, int wave) {
    unsigned char* ws = args.ws;
    const int p0m = args.pad;
    LAS float* scr = (LAS float*)(lds + wave * 16384);
    constexpr int I_IN = 16 * (NPROJ / 32), I_SSM = 32 * 32, I_ATT = 16 * 32, I_OUT = 16 * 32, I_UP = 16 * (DFF2 / 32), I_DN = (DFF / 64) * 32, I_ADA = 16 * (6144 / 32), I_W1 = 16 * 4;
    constexpr int NITEMS = I_IN + I_SSM + I_ATT + I_OUT + I_UP + I_DN + I_ADA + 4 * I_W1;
    if (p0m & 1) for (int it = gw; it < NITEMS; it += NGW) {
        int r = it;
        if (r < I_ADA) { transpose_item<0>(INF(10), 1024, 6144, 6144 / 32, (bf16*)(ws + WS_WADA), 0, scr, r, lane); continue; } r -= I_ADA;
        if (r < I_IN) { transpose_item<1>(INF(15), 1024, 9808, NPROJ / 32, (bf16*)(ws + WS_WIN), 0, scr, r, lane); continue; } r -= I_IN;
        if (r < I_SSM) { transpose_item<0>(INF(28), 2048, 1024, 32, (bf16*)(ws + WS_WSSM), 0, scr, r, lane); continue; } r -= I_SSM;
        if (r < I_ATT) { transpose_item<0>(INF(29), 1024, 1024, 32, (bf16*)(ws + WS_WATT), 0, scr, r, lane); continue; } r -= I_ATT;
        if (r < I_OUT) { transpose_item<0>(INF(30), 1024, 1024, 32, (bf16*)(ws + WS_WOUT), 0, scr, r, lane); continue; } r -= I_OUT;
        if (r < I_UP) { transpose_item<0>(INF(31), 1024, DFF2, DFF2 / 32, (bf16*)(ws + WS_WUP), 0, scr, r, lane); continue; } r -= I_UP;
        if (r < I_DN) { transpose_item<0>(INF(34), DFF, 1024, 32, (bf16*)(ws + WS_WDN), 0, scr, r, lane); continue; } r -= I_DN;
        { const int which = r / I_W1, rr = r % I_W1; const int st = which >> 1, r2 = which & 1;
          transpose_item<0>(INF(st ? 26 : 23) + (size_t)r2 * 16 * 64 * 128, 1024, 128, 4, (bf16*)(ws + (st ? WS_W1V : WS_W1K)), r2 * 128, scr, rr, lane); }
    }
    if (p0m & 4) {
    for (int r = gw; r < 256; r += NGW) {
        bf16* o = (bf16*)(ws + WS_SC) + (size_t)r * 1024;
        const float* src = r < 4 ? INF(2) + (size_t)r * 1024 : (r < 132 ? INF(3) + (size_t)(r - 4) * 1024 : nullptr);
#pragma unroll
        for (int j = 0; j < 4; ++j) { const int c0 = (j * 64 + lane) * 4; f32x4 v = src ? *(const f32x4*)(src + c0) : (f32x4){0.f, 0.f, 0.f, 0.f};
            u32x2 w; w.x = pk2(src ? siluf(v.x) : 0.f, src ? siluf(v.y) : 0.f); w.y = pk2(src ? siluf(v.z) : 0.f, src ? siluf(v.w) : 0.f); *(u32x2*)(o + c0) = w; }
    }
    for (int i = gw * 64 + lane; i < 4096 * 8; i += NGW * 64) {
        const int pos = i >> 3, k = i & 7;
        const float invf[8] = {1.0f, 0.1939227432012558f, 0.03760603070259094f, 0.007292664609849453f, 0.0014142135623842478f, 0.00027424818836152554f, 5.318296098266728e-05f, 1.0313386155758053e-05f};
        float fr = 1.0f;
#pragma unroll
        for (int q = 0; q < 8; ++q) fr = (k == q) ? invf[q] : fr;
        const float ang = (float)pos * fr;
        const double ad = (double)ang, rev = ad * 0.15915494309189535;
        const float fracrev = (float)(rev - __builtin_floor(rev));
        float* o = (float*)(ws + WS_ROPE) + (size_t)pos * 16;
        o[k] = __builtin_amdgcn_cosf(fracrev); o[8 + k] = __builtin_amdgcn_sinf(fracrev);
    }
    for (int it = gw; it < 256; it += NGW) {
        const int st = it >> 7, e = it & 127; const float* pe = INF(st ? 25 : 22); const float* w1 = INF(st ? 26 : 23);
        float s = 0.f;
        for (int i = 0; i < 32; ++i) { const int idx = lane + 64 * i; s += pe[idx] * w1[(size_t)idx * 128 + e]; }
        s = wave_sum(s);
        if (lane == 0) ((float*)(ws + WS_PET))[it] = s;
    }
    }
    if (p0m & 4) for (int i = gw * 64 + lane; i < 2 * 64 * 128; i += NGW * 64) { const int st = i >> 13, d = (i >> 7) & 63, e = i & 127;
        ((bf16*)(ws + WS_W2T))[i] = (bf16)f2bf(INF(st ? 27 : 24)[e * 64 + d]); }
}

template <int WHICH>
__device__ __forceinline__ void norm_mod_phase(const Args& args, int gw, int NGW, int lane) {
    unsigned char* ws = args.ws; const float* MOD = (const float*)(ws + WS_MOD); bf16* H = (bf16*)(ws + WS_H);
    const float* nw = INF(WHICH == 0 ? 12 : (WHICH == 1 ? 13 : 14));
    constexpr int SH = WHICH ? 3072 : 0, SCo = WHICH ? 4096 : 1024;
    for (int grp = gw; grp < MPAD / 4; grp += NGW) {
        const int m0 = grp * 4;
        if (m0 >= MALL) {
            if (WHICH < 2) {
#pragma unroll
                for (int r = 0; r < 4; ++r)
#pragma unroll
                    for (int j = 0; j < 4; ++j) ((u32x2*)(H + (size_t)(m0 + r) * 1024))[j * 64 + lane] = (u32x2){0u, 0u};
            }
            continue; }
        f32x4 v[4][4]; float ss[4];
#pragma unroll
        for (int r = 0; r < 4; ++r) { const int m = m0 + r;
            const float* xr = WHICH ? (const float*)(ws + WS_X1) + (size_t)m * 1024 : (m < MP ? INF(0) + (size_t)m * 1024 : INF(1) + (size_t)(m - MP) * 1024);
            float s = 0.f;
#pragma unroll
            for (int j = 0; j < 4; ++j) { v[r][j] = *(const f32x4*)(xr + (j * 64 + lane) * 4); s += (v[r][j].x * v[r][j].x + v[r][j].y * v[r][j].y) + (v[r][j].z * v[r][j].z + v[r][j].w * v[r][j].w); }
            ss[r] = s; }
#pragma unroll
        for (int o = 1; o < 64; o <<= 1)
#pragma unroll
            for (int r = 0; r < 4; ++r) ss[r] += __shfl_xor(ss[r], o);
        f32x4 w[4];
#pragma unroll
        for (int j = 0; j < 4; ++j) w[j] = *(const f32x4*)(nw + (j * 64 + lane) * 4);
#pragma unroll
        for (int r = 0; r < 4; ++r) { const int m = m0 + r;
            const float rstd = 1.f / sqrtf(ss[r] * (1.f / 1024.f) + EPS);
            if (WHICH == 2) { float* o = args.out + (m < MP ? O_YP + (size_t)m * 1024 : O_YS + (size_t)(m - MP) * 1024);
#pragma unroll
                for (int j = 0; j < 4; ++j) *(f32x4*)(o + (j * 64 + lane) * 4) = (v[r][j] * rstd) * w[j];
            } else {
                const float* mr = MOD + (size_t)(m < MP ? (m >> 12) : 4 + (m - MP)) * 6144;
                u32x2* o = (u32x2*)(H + (size_t)m * 1024);
#pragma unroll
                for (int j = 0; j < 4; ++j) { const int c0 = (j * 64 + lane) * 4;
                    const f32x4 sc = *(const f32x4*)(mr + SCo + c0), sh = *(const f32x4*)(mr + SH + c0);
                    const f32x4 rr = (v[r][j] * rstd) * w[j] * (sc + 1.f) + sh;
                    u32x2 pk; pk.x = pk2(rr.x, rr.y); pk.y = pk2(rr.z, rr.w); o[j * 64 + lane] = pk; }
            }
        }
    }
}
namespace epi {
using pg8::Unit; using pg8::f32x4;
typedef unsigned u32x4 __attribute__((ext_vector_type(4)));
__device__ __forceinline__ u32x4 pack8(const f32x4& a, const f32x4& b) { u32x4 w; w.x = pg8::cvt_pk_bf16(a[0], a[1]); w.y = pg8::cvt_pk_bf16(a[2], a[3]); w.z = pg8::cvt_pk_bf16(b[0], b[1]); w.w = pg8::cvt_pk_bf16(b[2], b[3]); return w; }

struct InProj {
    static constexpr bool PERM = true, AFTER_DRAIN = false;
    unsigned char* ws; float* out;
    __device__ __forceinline__ void operator()(const f32x4 (&acc)[2][2][4][2], const Unit& u, int wr, int wc, int fr, int fq) const {
        const int pn = u.pn;
        const int rowb = u.pm * 256 + wr * 64 + fr;
        const int cl = wc * 32 + 8 * fq;
        if (pn < T_XBC || (pn >= T_MG && pn < T_MISC)) {
            bf16* base = pn < T_XBC ? (bf16*)(ws + WS_Z) : (bf16*)(ws + WS_MG);
            const int colt = (pn < T_XBC ? pn : pn - T_MG) * 256 + cl;
#pragma unroll
            for (int ai = 0; ai < 2; ++ai)
#pragma unroll
                for (int m = 0; m < 4; ++m) { const int row = rowb + ai * 128 + m * 16;
#pragma unroll
                    for (int bj = 0; bj < 2; ++bj) *(u32x4*)(base + (size_t)row * 2048 + colt + bj * 128) = pack8(acc[ai][bj][m][0], acc[ai][bj][m][1]); }
        } else if (pn < T_Q) {
            bf16* base = (bf16*)(ws + WS_XBC); const int colt = (pn - T_XBC) * 256 + cl;
#pragma unroll
            for (int ai = 0; ai < 2; ++ai)
#pragma unroll
                for (int m = 0; m < 4; ++m) { const int row = rowb + ai * 128 + m * 16;
                    float* fo = nullptr;
                    if (row < MP) { const int t = row & 4095; if (t >= 4093) fo = out + O_CONVP + ((size_t)(row >> 12) * 3 + (t - 4093)) * CONVD; }
                    else if (row < MALL) fo = out + O_CONVS + ((size_t)(row - MP) * 3 + 2) * CONVD;
#pragma unroll
                    for (int bj = 0; bj < 2; ++bj) { const int col = colt + bj * 128;
                        *(u32x4*)(base + (size_t)row * CONVD + col) = pack8(acc[ai][bj][m][0], acc[ai][bj][m][1]);
                        if (fo) { *(f32x4*)(fo + col) = acc[ai][bj][m][0]; *(f32x4*)(fo + col + 4) = acc[ai][bj][m][1]; } } }
        } else if (pn < T_MG) {
            const bool isq = pn < T_KV; const int s = pn - T_KV;
            const bool dorope = (isq || !(s & 1)) && !(wc & 1);
            const float* rope = (const float*)(ws + WS_ROPE);
#pragma unroll
            for (int ai = 0; ai < 2; ++ai)
#pragma unroll
                for (int m = 0; m < 4; ++m) { const int row = rowb + ai * 128 + m * 16;
                    const int pos = row < MP ? (row & 4095) : PAST;
#pragma unroll
                    for (int bj = 0; bj < 2; ++bj) {
                        f32x4 v0 = acc[ai][bj][m][0], v1 = acc[ai][bj][m][1];
                        if (dorope) {
                            f32x4 o0, o1;
#pragma unroll
                            for (int i = 0; i < 4; ++i) { o0[i] = __shfl_xor(v0[i], 16); o1[i] = __shfl_xor(v1[i], 16); }
                            if (fq < 2) {
                                const f32x4 c0 = *(const f32x4*)(rope + pos * 16), c1 = *(const f32x4*)(rope + pos * 16 + 4), s0 = *(const f32x4*)(rope + pos * 16 + 8), s1 = *(const f32x4*)(rope + pos * 16 + 12);
                                if (fq == 0) { v0 = v0 * c0 - o0 * s0; v1 = v1 * c1 - o1 * s1; }
                                else         { v0 = v0 * c0 + o0 * s0; v1 = v1 * c1 + o1 * s1; }
                            }
                        }
                        const int col = cl + bj * 128;
                        const u32x4 pk = pack8(v0, v1);
                        if (isq) { *(u32x4*)((bf16*)(ws + WS_Q) + (size_t)row * 1024 + (pn - T_Q) * 256 + col) = pk; }
                        else {
                            const int h = col >> 6, d = col & 63;
                            if (row < MP) {
                                const int b = row >> 12, t = row & 4095;
                                *(u32x4*)((bf16*)(ws + WS_KVH) + ((((size_t)s * 4 + b) * 4 + h) * 4096 + t) * 64 + d) = pk;
                                if (s < 4) { float* fo = out + O_KVP + ((size_t)row * 4 + s) * 256 + col; *(f32x4*)fo = v0; *(f32x4*)(fo + 4) = v1; }
                                else if (t >= 3584) { float* fo = out + O_WINP + (((size_t)b * 512 + (t - 3584)) * 2 + (s - 4)) * 256 + col; *(f32x4*)fo = v0; *(f32x4*)(fo + 4) = v1; }
                                if (s == 3 || s == 5) {
                                    const int kk = t & 31, kpos = 8 * ((kk & 15) >> 2) + 4 * (kk >> 4) + (kk & 3);
                                    bf16* vt = (bf16*)(ws + WS_VT) + ((((size_t)(s == 5) * 4 + b) * 4 + h) * 128 + (t >> 5)) * 2048 + d * 32 + kpos;
                                    vt[0 * 32] = (bf16)(pk.x & 0xffffu); vt[1 * 32] = (bf16)(pk.x >> 16); vt[2 * 32] = (bf16)(pk.y & 0xffffu); vt[3 * 32] = (bf16)(pk.y >> 16);
                                    vt[4 * 32] = (bf16)(pk.z & 0xffffu); vt[5 * 32] = (bf16)(pk.z >> 16); vt[6 * 32] = (bf16)(pk.w & 0xffffu); vt[7 * 32] = (bf16)(pk.w >> 16);
                                }
                            } else if (row < MALL) {
                                const int bs = row - MP;
                                float* fo = s < 4 ? out + O_KVS + ((size_t)bs * 4 + s) * 256 + col : out + O_WINS + (((size_t)bs * 512 + 511) * 2 + (s - 4)) * 256 + col;
                                *(f32x4*)fo = v0; *(f32x4*)(fo + 4) = v1;
                            }
                        }
                    } }
        } else {
            float* base = (float*)(ws + WS_MISC);
#pragma unroll
            for (int ai = 0; ai < 2; ++ai)
#pragma unroll
                for (int m = 0; m < 4; ++m) { const int row = rowb + ai * 128 + m * 16;
                    *(f32x4*)(base + (size_t)row * 128 + cl) = acc[ai][0][m][0]; *(f32x4*)(base + (size_t)row * 128 + cl + 4) = acc[ai][0][m][1]; }
        }
    }
};

struct Merge1 {
    static constexpr bool PERM = true, AFTER_DRAIN = false;
    unsigned char* ws;
    __device__ __forceinline__ void operator()(const f32x4 (&acc)[2][2][4][2], const Unit& u, int wr, int wc, int fr, int fq) const {
        const int rowb = u.pm * 256 + wr * 64 + fr, colb = u.pn * 256 + wc * 32 + 8 * fq;
        const bf16* MG = (const bf16*)(ws + WS_MG); const float* SSQ = (const float*)(ws + WS_SSQ); float* T = (float*)(ws + WS_TMPM);
#pragma unroll
        for (int ai = 0; ai < 2; ++ai)
#pragma unroll
            for (int m = 0; m < 4; ++m) { const int row = rowb + ai * 128 + m * 16;
                const f32x4 sq = *(const f32x4*)(SSQ + (size_t)row * 4);
                const float rstd = 1.f / sqrtf(((sq.x + sq.y) + (sq.z + sq.w)) * (1.f / 2048.f) + EPS);
#pragma unroll
                for (int bj = 0; bj < 2; ++bj) { const int col = colb + bj * 128;
                    const u32x4 g = *(const u32x4*)(MG + (size_t)row * 2048 + col);
                    f32x4 o0, o1;
                    o0[0] = sigmf(bflo(g.x)) * rstd * acc[ai][bj][m][0][0]; o0[1] = sigmf(bfhi(g.x)) * rstd * acc[ai][bj][m][0][1];
                    o0[2] = sigmf(bflo(g.y)) * rstd * acc[ai][bj][m][0][2]; o0[3] = sigmf(bfhi(g.y)) * rstd * acc[ai][bj][m][0][3];
                    o1[0] = sigmf(bflo(g.z)) * rstd * acc[ai][bj][m][1][0]; o1[1] = sigmf(bfhi(g.z)) * rstd * acc[ai][bj][m][1][1];
                    o1[2] = sigmf(bflo(g.w)) * rstd * acc[ai][bj][m][1][2]; o1[3] = sigmf(bfhi(g.w)) * rstd * acc[ai][bj][m][1][3];
                    *(f32x4*)(T + (size_t)row * 1024 + col) = o0; *(f32x4*)(T + (size_t)row * 1024 + col + 4) = o1; } }
    }
};
struct Merge2 {
    static constexpr bool PERM = true, AFTER_DRAIN = false;
    unsigned char* ws;
    __device__ __forceinline__ void operator()(const f32x4 (&acc)[2][2][4][2], const Unit& u, int wr, int wc, int fr, int fq) const {
        const int rowb = u.pm * 256 + wr * 64 + fr, colb = u.pn * 256 + wc * 32 + 8 * fq;
        const bf16* MG = (const bf16*)(ws + WS_MG); const float* T = (const float*)(ws + WS_TMPM); bf16* O = (bf16*)(ws + WS_MERGED);
#pragma unroll
        for (int ai = 0; ai < 2; ++ai)
#pragma unroll
            for (int m = 0; m < 4; ++m) { const int row = rowb + ai * 128 + m * 16;
#pragma unroll
                for (int bj = 0; bj < 2; ++bj) { const int col = colb + bj * 128;
                    const u32x4 g = *(const u32x4*)(MG + (size_t)row * 2048 + 1024 + col);
                    f32x4 o0 = *(const f32x4*)(T + (size_t)row * 1024 + col), o1 = *(const f32x4*)(T + (size_t)row * 1024 + col + 4);
                    o0[0] += sigmf(bflo(g.x)) * acc[ai][bj][m][0][0]; o0[1] += sigmf(bfhi(g.x)) * acc[ai][bj][m][0][1];
                    o0[2] += sigmf(bflo(g.y)) * acc[ai][bj][m][0][2]; o0[3] += sigmf(bfhi(g.y)) * acc[ai][bj][m][0][3];
                    o1[0] += sigmf(bflo(g.z)) * acc[ai][bj][m][1][0]; o1[1] += sigmf(bfhi(g.z)) * acc[ai][bj][m][1][1];
                    o1[2] += sigmf(bflo(g.w)) * acc[ai][bj][m][1][2]; o1[3] += sigmf(bfhi(g.w)) * acc[ai][bj][m][1][3];
                    *(u32x4*)(O + (size_t)row * 1024 + col) = pack8(o0, o1); } }
    }
};
struct Resid {
    static constexpr bool PERM = false, AFTER_DRAIN = false;
    const float* xp; const float* xs; const float* x1in; float* x1out; const float* MOD; int goff;
    __device__ __forceinline__ void operator()(const f32x4 (&acc)[2][2][4][2], const Unit& u, int wr, int wc, int fr, int fq) const {
        const int rowb = u.pm * 256 + wr * 64 + fr, colb = u.pn * 256 + wc * 32 + 4 * fq;
#pragma unroll
        for (int ai = 0; ai < 2; ++ai)
#pragma unroll
            for (int m = 0; m < 4; ++m) { const int row = rowb + ai * 128 + m * 16;
                if (row >= MALL) continue;
                const float* base = x1in ? x1in + (size_t)row * 1024 : (row < MP ? xp + (size_t)row * 1024 : xs + (size_t)(row - MP) * 1024);
                const float* gr = MOD + (size_t)(row < MP ? (row >> 12) : 4 + (row - MP)) * 6144 + goff;
#pragma unroll
                for (int bj = 0; bj < 2; ++bj)
#pragma unroll
                    for (int n = 0; n < 2; ++n) { const int col = colb + bj * 128 + n * 16;
                        *(f32x4*)(x1out + (size_t)row * 1024 + col) = *(const f32x4*)(base + col) + *(const f32x4*)(gr + col) * acc[ai][bj][m][n]; } }
    }
};
struct Up {
    static constexpr bool PERM = true, AFTER_DRAIN = false;
    unsigned char* ws; float* out;
    __device__ __forceinline__ void operator()(const f32x4 (&acc)[2][2][4][2], const Unit& u, int wr, int wc, int fr, int fq) const {
        const int rowb = u.pm * 256 + wr * 64 + fr, colb = u.pn * 256 + wc * 32 + 8 * fq;
        bf16* U = (bf16*)(ws + WS_U);
#pragma unroll
        for (int ai = 0; ai < 2; ++ai)
#pragma unroll
            for (int m = 0; m < 4; ++m) { const int row = rowb + ai * 128 + m * 16;
                float* fo = nullptr;
                if (row < MP) { const int t = row & 4095; if (t >= 4094) fo = out + O_FFNP + ((size_t)(row >> 12) * 2 + (t - 4094)) * DFF2; }
                else if (row < MALL) fo = out + O_FFNS + ((size_t)(row - MP) * 2 + 1) * DFF2;
#pragma unroll
                for (int bj = 0; bj < 2; ++bj) { const int col = colb + bj * 128;
                    *(u32x4*)(U + (size_t)row * DFF2 + col) = pack8(acc[ai][bj][m][0], acc[ai][bj][m][1]);
                    if (fo) { *(f32x4*)(fo + col) = acc[ai][bj][m][0]; *(f32x4*)(fo + col + 4) = acc[ai][bj][m][1]; } } }
    }
};
struct PartBf16 {
    static constexpr bool PERM = true, AFTER_DRAIN = false;
    bf16* P;
    __device__ __forceinline__ void operator()(const f32x4 (&acc)[2][2][4][2], const Unit& u, int wr, int wc, int fr, int fq) const {
        const int rowb = u.pm * 256 + wr * 64 + fr, colb = wc * 32 + 8 * fq;
#pragma unroll
        for (int ai = 0; ai < 2; ++ai)
#pragma unroll
            for (int m = 0; m < 4; ++m) { const int row = rowb + ai * 128 + m * 16;
#pragma unroll
                for (int bj = 0; bj < 2; ++bj) *(u32x4*)(P + (size_t)row * 256 + colb + bj * 128) = pack8(acc[ai][bj][m][0], acc[ai][bj][m][1]); }
    }
};
}
__device__ __forceinline__ void conv_prompt_item(const Args& args, int item, int lane) {
    unsigned char* ws = args.ws;
    const int tg = item / 48, cgp = item % 48, cg = lane & 7, rg = lane >> 3;
    const int m0 = tg * 64 + 8 * rg, b = m0 >> 12, t0 = m0 & 4095, ch0 = cgp * 64 + 8 * cg;
    const bf16* X = (const bf16*)(ws + WS_XBC);
    float x[11][8];
#pragma unroll
    for (int i = 0; i < 11; ++i) {
        const int t = t0 - 3 + i;
        u32x4 v = (u32x4){0u, 0u, 0u, 0u};
        if (t >= 0) v = *(const u32x4*)(X + (size_t)(m0 - 3 + i) * CONVD + ch0);
        x[i][0] = bflo(v.x); x[i][1] = bfhi(v.x); x[i][2] = bflo(v.y); x[i][3] = bfhi(v.y); x[i][4] = bflo(v.z); x[i][5] = bfhi(v.z); x[i][6] = bflo(v.w); x[i][7] = bfhi(v.w);
    }
    const float* cw = INF(16); const float* cb = INF(17);
    float w[4][8], bias[8];
#pragma unroll
    for (int k = 0; k < 4; ++k) { const f32x4 a = *(const f32x4*)(cw + k * CONVD + ch0), c = *(const f32x4*)(cw + k * CONVD + ch0 + 4);
        w[k][0] = a.x; w[k][1] = a.y; w[k][2] = a.z; w[k][3] = a.w; w[k][4] = c.x; w[k][5] = c.y; w[k][6] = c.z; w[k][7] = c.w; }
    { const f32x4 a = *(const f32x4*)(cb + ch0), c = *(const f32x4*)(cb + ch0 + 4); bias[0] = a.x; bias[1] = a.y; bias[2] = a.z; bias[3] = a.w; bias[4] = c.x; bias[5] = c.y; bias[6] = c.z; bias[7] = c.w; }
    float y[8][8];
#pragma unroll
    for (int i = 0; i < 8; ++i)
#pragma unroll
        for (int c = 0; c < 8; ++c) { const float a = bias[c] + w[0][c] * x[i][c] + w[1][c] * x[i + 1][c] + w[2][c] * x[i + 2][c] + w[3][c] * x[i + 3][c]; y[i][c] = siluf(a); }
    if (cgp < 32) {
        bf16* XT = (bf16*)(ws + WS_XT) + ((size_t)(b * 32 + cgp) * 128 + (t0 >> 5)) * 2048 + (8 * cg) * 32 + (t0 & 31);
#pragma unroll
        for (int c = 0; c < 8; ++c) { u32x4 o; o.x = pk2(y[0][c], y[1][c]); o.y = pk2(y[2][c], y[3][c]); o.z = pk2(y[4][c], y[5][c]); o.w = pk2(y[6][c], y[7][c]); *(u32x4*)(XT + (size_t)c * 32) = o; }
    } else {
        const int isC = cgp >= 40, gg = ((cgp - 32) & 7) >> 1, n0 = ((cgp - 32) & 1) * 64 + 8 * cg;
        bf16* N = (bf16*)(ws + (isC ? WS_CN : WS_BN)) + ((size_t)(b * 4 + gg) * 4096 + t0) * 128 + n0;
#pragma unroll
        for (int i = 0; i < 8; ++i) { u32x4 o; o.x = pk2(y[i][0], y[i][1]); o.y = pk2(y[i][2], y[i][3]); o.z = pk2(y[i][4], y[i][5]); o.w = pk2(y[i][6], y[i][7]); *(u32x4*)(N + (size_t)i * 128) = o; }
        if (!isC) {
            bf16* BT = (bf16*)(ws + WS_BT) + ((size_t)(b * 4 + gg) * 128 + (t0 >> 5)) * 4096 + n0 * 32 + (t0 & 31);
#pragma unroll
            for (int c = 0; c < 8; ++c) { u32x4 o; o.x = pk2(y[0][c], y[1][c]); o.y = pk2(y[2][c], y[3][c]); o.z = pk2(y[4][c], y[5][c]); o.w = pk2(y[6][c], y[7][c]); *(u32x4*)(BT + (size_t)c * 32) = o; }
        }
    }
}
__device__ __forceinline__ void dtcs_item(const Args& args, int item, int lane) {
    unsigned char* ws = args.ws;
    const int c = item & 31, h = (item >> 5) & 31, b = item >> 10;
    const float* MISC = (const float*)(ws + WS_MISC);
    const float bias = INF(18)[h], a = -__expf(INF(19)[h]);
    const int t = c * 128 + 2 * lane; const size_t m = (size_t)b * 4096 + t;
    const float d0 = softplusf(MISC[m * 128 + h] + bias), d1 = softplusf(MISC[(m + 1) * 128 + h] + bias);
    const float a0 = d0 * a, a1 = d1 * a;
    float s = a0 + a1;
#pragma unroll
    for (int o = 1; o < 64; o <<= 1) { const float v = __shfl_up(s, o); if (lane >= o) s += v; }
    const float c1 = s, c0 = s - a1;
    float* DT = (float*)(ws + WS_DT) + (size_t)(b * 32 + h) * 4096 + t; float* CS = (float*)(ws + WS_CS) + (size_t)(b * 32 + h) * 4096 + t;
    *(f32x2*)DT = (f32x2){d0, d1}; *(f32x2*)CS = (f32x2){c0, c1};
}
__device__ __forceinline__ void sample_conv(const Args& args, int gt, int NGT) {
    unsigned char* ws = args.ws; float* out = args.out;
    const float* st = INF(8); const float* cw = INF(16); const float* cb = INF(17);
    for (int i = gt; i < MS * CONVD; i += NGT) {
        const int bs = i / CONVD, ch = i % CONVD;
        const float s0 = st[((size_t)bs * 3 + 0) * CONVD + ch], s1 = st[((size_t)bs * 3 + 1) * CONVD + ch], s2 = st[((size_t)bs * 3 + 2) * CONVD + ch];
        const float xn = out[O_CONVS + ((size_t)bs * 3 + 2) * CONVD + ch];
        out[O_CONVS + ((size_t)bs * 3 + 0) * CONVD + ch] = s1; out[O_CONVS + ((size_t)bs * 3 + 1) * CONVD + ch] = s2;
        const float a = cb[ch] + cw[ch] * s0 + cw[CONVD + ch] * s1 + cw[2 * CONVD + ch] * s2 + cw[3 * CONVD + ch] * xn;
        ((float*)(ws + WS_XCS))[i] = siluf(a);
    }
    for (int i = gt; i < MS * NH; i += NGT) { const int bs = i >> 5, h = i & 31;
        ((float*)(ws + WS_DTS))[i] = softplusf(((const float*)(ws + WS_MISC))[(size_t)(MP + bs) * 128 + h] + INF(18)[h]); }
}

struct SFrag { u32x4 x[4]; bf16x8 b[4]; };
__device__ __forceinline__ void ssd_states_load(const bf16* XT, const bf16* BT, int nh, int ks, int q, int r16, SFrag& F) {
#pragma unroll
    for (int pt = 0; pt < 4; ++pt) F.x[pt] = *(const u32x4*)(XT + (size_t)ks * 2048 + (16 * pt + r16) * 32 + 8 * q);
#pragma unroll
    for (int nt = 0; nt < 4; ++nt) F.b[nt] = *(const bf16x8*)(BT + (size_t)ks * 4096 + (64 * nh + 16 * nt + r16) * 32 + 8 * q);
}
__device__ __forceinline__ void ssd_states_step(const LAS float* wl, int ks, int q, const SFrag& F, f32x4 (&acc)[4][4]) {
    const int s0 = 32 * ks + 8 * q;
    const f32x4 w0 = *(const LAS f32x4*)(wl + s0), w1 = *(const LAS f32x4*)(wl + s0 + 4);
    bf16x8 af[4];
#pragma unroll
    for (int pt = 0; pt < 4; ++pt) { const u32x4 v = F.x[pt];
        u32x4 o; o.x = pk2(bflo(v.x) * w0.x, bfhi(v.x) * w0.y); o.y = pk2(bflo(v.y) * w0.z, bfhi(v.y) * w0.w); o.z = pk2(bflo(v.z) * w1.x, bfhi(v.z) * w1.y); o.w = pk2(bflo(v.w) * w1.z, bfhi(v.w) * w1.w);
        af[pt] = __builtin_bit_cast(bf16x8, o); }
#pragma unroll
    for (int nt = 0; nt < 4; ++nt)
#pragma unroll
        for (int pt = 0; pt < 4; ++pt) acc[pt][nt] = MFMA16(af[pt], F.b[nt], acc[pt][nt]);
}
__device__ __forceinline__ void ssd_states_unit(const Args& args, LAS unsigned char* lds, int unit, int wave, int lane) {
    unsigned char* ws = args.ws;
    const int g = unit & 3, c = (unit >> 2) & 31, b = unit >> 7, h = g * 8 + wave, q = lane >> 4, r16 = lane & 15;
    LAS float* wl = (LAS float*)(lds + wave * 512);
    const float* DT = (const float*)(ws + WS_DT) + (size_t)(b * 32 + h) * 4096 + c * 128; const float* CS = (const float*)(ws + WS_CS) + (size_t)(b * 32 + h) * 4096 + c * 128;
    const float cl = CS[127];
    wl[lane] = DT[lane] * __expf(cl - CS[lane]); wl[lane + 64] = DT[lane + 64] * __expf(cl - CS[lane + 64]);
    LDS_WAIT(); asm volatile("" ::: "memory");
    const bf16* XT = (const bf16*)(ws + WS_XT) + ((size_t)(b * 32 + h) * 128 + c * 4) * 2048;
    const bf16* BT = (const bf16*)(ws + WS_BT) + ((size_t)(b * 4 + g) * 128 + c * 4) * 4096;
    float* ST = (float*)(ws + WS_STATES) + (((size_t)(b * 32 + c) * 32 + h) * 64) * 128;
    SFrag FA, FB;
    ssd_states_load(XT, BT, 0, 0, q, r16, FA);
#pragma unroll 1
    for (int nh = 0; nh < 2; ++nh) {
        f32x4 acc[4][4];
#pragma unroll
        for (int i = 0; i < 4; ++i)
#pragma unroll
            for (int j = 0; j < 4; ++j) acc[i][j] = (f32x4){0.f, 0.f, 0.f, 0.f};
        ssd_states_load(XT, BT, nh, 1, q, r16, FB); ssd_states_step(wl, 0, q, FA, acc);
        ssd_states_load(XT, BT, nh, 2, q, r16, FA); ssd_states_step(wl, 1, q, FB, acc);
        ssd_states_load(XT, BT, nh, 3, q, r16, FB); ssd_states_step(wl, 2, q, FA, acc);
        if (nh == 0) ssd_states_load(XT, BT, 1, 0, q, r16, FA);
        ssd_states_step(wl, 3, q, FB, acc);
#pragma unroll
        for (int pt = 0; pt < 4; ++pt)
#pragma unroll
            for (int nt = 0; nt < 4; ++nt)
#pragma unroll
                for (int r = 0; r < 4; ++r) ST[(size_t)(16 * pt + 4 * q + r) * 128 + 64 * nh + 16 * nt + r16] = acc[pt][nt][r];
    }
}

template <int SAMPLE>
__device__ __forceinline__ void compress2_item(const Args& args, int item, int lane) {
    unsigned char* ws = args.ws;
    const int q = lane >> 4, r16 = lane & 15;
    constexpr int NPB = SAMPLE ? 128 : 256;
    constexpr int NI = (SAMPLE ? 65536 : 4096) / 16;
    const int st = item / NI, row0 = (item % NI) * 16;
    const bf16* P = (const bf16*)(ws + (SAMPLE ? (st ? WS_PARTSV : WS_PARTSK) : (st ? WS_PARTV : WS_PARTK))) + (size_t)(row0 + r16) * 256;
    const float* pet = (const float*)(ws + WS_PET) + st * 128;
    const bf16* W2T = (const bf16*)(ws + WS_W2T) + st * 8192;
    f32x4 acc[4];
#pragma unroll
    for (int dt = 0; dt < 4; ++dt) acc[dt] = (f32x4){0.f, 0.f, 0.f, 0.f};
#pragma unroll
    for (int ks = 0; ks < 4; ++ks) {
        const int e0 = 32 * ks + 8 * q;
        const u32x4 pa = *(const u32x4*)(P + e0), pb = *(const u32x4*)(P + 256 + 128 + e0);
        const f32x4 a0 = (f32x4){bflo(pa.x), bfhi(pa.x), bflo(pa.y), bfhi(pa.y)}, a1 = (f32x4){bflo(pa.z), bfhi(pa.z), bflo(pa.w), bfhi(pa.w)};
        const f32x4 b0 = (f32x4){bflo(pb.x), bfhi(pb.x), bflo(pb.y), bfhi(pb.y)}, b1 = (f32x4){bflo(pb.z), bfhi(pb.z), bflo(pb.w), bfhi(pb.w)};
        const f32x4 p0 = *(const f32x4*)(pet + e0), p1 = *(const f32x4*)(pet + e0 + 4);
        const f32x4 h0 = a0 + b0 + p0, h1 = a1 + b1 + p1;
        u32x4 o; o.x = pk2(siluf(h0.x), siluf(h0.y)); o.y = pk2(siluf(h0.z), siluf(h0.w)); o.z = pk2(siluf(h1.x), siluf(h1.y)); o.w = pk2(siluf(h1.z), siluf(h1.w));
        const bf16x8 af = __builtin_bit_cast(bf16x8, o);
#pragma unroll
        for (int dt = 0; dt < 4; ++dt) { const bf16x8 bf = *(const bf16x8*)(W2T + (size_t)(16 * dt + r16) * 128 + e0); acc[dt] = MFMA16(af, bf, acc[dt]); }
    }
    const int bh = row0 / NPB, n0 = row0 % NPB + 4 * q;
#pragma unroll
    for (int dt = 0; dt < 4; ++dt) {
        const int d = 16 * dt + r16;
        float v[4];
#pragma unroll
        for (int r = 0; r < 4; ++r) v[r] = (n0 + r < NPB - 1) ? acc[dt][r] : 0.f;
        if (SAMPLE) {
            float* o = (float*)(ws + (st ? WS_VCS : WS_KCS)) + ((size_t)bh * 128 + n0) * 64 + d;
#pragma unroll
            for (int r = 0; r < 4; ++r) o[r * 64] = v[r];
        } else if (st == 0) {
            bf16* o = (bf16*)(ws + WS_KC) + ((size_t)bh * 256 + n0) * 64 + d;
#pragma unroll
            for (int r = 0; r < 4; ++r) o[r * 64] = (bf16)f2bf(v[r]);
        } else {
            u32x2 w; w.x = pk2(v[0], v[1]); w.y = pk2(v[2], v[3]);
            *(u32x2*)((bf16*)(ws + WS_VCT) + ((size_t)bh * 8 + (n0 >> 5)) * 2048 + d * 32 + 8 * ((n0 & 15) >> 2) + 4 * ((n0 & 31) >> 4)) = w;
        }
    }
}

__device__ __forceinline__ void sample_ssm_item(const Args& args, LAS unsigned char* lds, int item, int wave, int lane) {
    unsigned char* ws = args.ws; float* out = args.out;
    const int h = item & 31, bs = item >> 5, g = h >> 3, rs = lane >> 5, nc = lane & 31;
    const float* XC = (const float*)(ws + WS_XCS) + (size_t)bs * CONVD;
    const float dt = ((const float*)(ws + WS_DTS))[bs * 32 + h], a = -__expf(INF(19)[h]), dec = __expf(dt * a), Dh = INF(20)[h];
    const f32x4 Bv = *(const f32x4*)(XC + 2048 + g * 128 + 4 * nc) * dt, Cv = *(const f32x4*)(XC + 2560 + g * 128 + 4 * nc);
    const float xl = XC[h * 64 + lane];
    const size_t m = MP + bs;
    const float zl = bf2f(((const bf16*)(ws + WS_Z))[m * 2048 + h * 64 + lane]), nwl = INF(21)[h * 64 + lane];
    const float* H0 = INF(7) + ((size_t)(bs * 32 + h) * 64) * 128 + 4 * nc; float* HN = out + O_SSMS + ((size_t)(bs * 32 + h) * 64) * 128 + 4 * nc;
    const bool b4 = (lane & 16) != 0, b3 = (lane & 8) != 0, b2 = (lane & 4) != 0;
    float yl = 0.f;
#pragma unroll 1
    for (int bt = 0; bt < 4; ++bt) {
        f32x4 h0[8];
#pragma unroll
        for (int k = 0; k < 8; ++k) h0[k] = *(const f32x4*)(H0 + (size_t)(2 * (8 * bt + k) + rs) * 128);
        float v[8];
#pragma unroll
        for (int k = 0; k < 8; ++k) { const int p = 2 * (8 * bt + k) + rs;
            const float xp = __shfl(xl, p);
            const f32x4 hn = h0[k] * dec + Bv * xp;
            *(f32x4*)(HN + (size_t)p * 128) = hn;
            v[k] = (hn.x * Cv.x + hn.y * Cv.y) + (hn.z * Cv.z + hn.w * Cv.w); }
        float a4[4], a2[2];
#pragma unroll
        for (int i = 0; i < 4; ++i) a4[i] = (b4 ? v[4 + i] : v[i]) + __shfl_xor(b4 ? v[i] : v[4 + i], 16);
#pragma unroll
        for (int i = 0; i < 2; ++i) a2[i] = (b3 ? a4[2 + i] : a4[i]) + __shfl_xor(b3 ? a4[i] : a4[2 + i], 8);
        float c = (b2 ? a2[1] : a2[0]) + __shfl_xor(b2 ? a2[0] : a2[1], 4);
        c += __shfl_xor(c, 2); c += __shfl_xor(c, 1);
        const int pl = lane - 16 * bt;
        const int kk = (pl >> 1) & 7, src = ((pl & 1) << 5) | ((kk & 4) << 2) | ((kk & 2) << 2) | ((kk & 1) << 2);
        const float got = __shfl(c, src & 63);
        if (pl >= 0 && pl < 16) yl = got;
    }
    const float y = yl + Dh * xl;
    const float vv = y * siluf(zl);
    ((bf16*)(ws + WS_YSSM))[m * 2048 + h * 64 + lane] = (bf16)f2bf(vv * nwl);
    const float ss = wave_sum(vv * vv);
    if (lane == 0) ((float*)(ws + WS_MISC))[m * 128 + 80 + h] = ss;
}
constexpr int SC_PP = 264;
__device__ __forceinline__ void sample_compress_unit(const Args& args, LAS unsigned char* lds, int unit, int tid, int wave, int lane) {
    unsigned char* ws = args.ws;
    const int st = unit >> 9, bh = unit & 511, b = bh >> 2, h = bh & 3, q = lane >> 4, r16 = lane & 15, wr = wave >> 2, wc = wave & 3;
    LAS bf16* As = (LAS bf16*)lds;
    LAS bf16* Pl = (LAS bf16*)(lds + 16384);
    const bf16* W1T = (const bf16*)(ws + (st ? WS_W1V : WS_W1K));
    const int sj = tid >> 2, sc8 = tid & 3;
    const int page = ((const int*)args.in[5])[b * NPAGES + (sj >> 3)];
    const float* asrc = INF(4) + (((size_t)page * 128 + 16 * (sj & 7)) * 4 + st) * 256 + h * 64 + 8 * sc8;
    LAS bf16* adst = As + sj * 32 + 8 * sc8;
    const bf16* bsrc = W1T + (size_t)(64 * wc + r16) * 1024 + 8 * q;
    f32x4 acc[4][4];
#pragma unroll
    for (int m = 0; m < 4; ++m)
#pragma unroll
        for (int n = 0; n < 4; ++n) acc[m][n] = (f32x4){0.f, 0.f, 0.f, 0.f};
    f32x4 ra[4][2];
#pragma unroll
    for (int i = 0; i < 4; ++i) { const float* p = asrc + (size_t)(i >> 1) * 1024 + 32 * (i & 1); ra[i][0] = *(const f32x4*)p; ra[i][1] = *(const f32x4*)(p + 4); }
    { u32x4 w; w.x = pk2(ra[0][0].x, ra[0][0].y); w.y = pk2(ra[0][0].z, ra[0][0].w); w.z = pk2(ra[0][1].x, ra[0][1].y); w.w = pk2(ra[0][1].z, ra[0][1].w); *(LAS u32x4*)adst = w; }
    __syncthreads();
#pragma unroll 1
    for (int k4 = 0; k4 < 32; k4 += 4) {
#pragma unroll
        for (int i = 0; i < 4; ++i) {
            const int ks = k4 + i;
            bf16x8 bfr[4];
#pragma unroll
            for (int n = 0; n < 4; ++n) bfr[n] = *(const bf16x8*)(bsrc + (size_t)(16 * n) * 1024 + 32 * ks);
            if (ks + 4 < 32) { const float* p = asrc + (size_t)((ks + 4) >> 1) * 1024 + 32 * ((ks + 4) & 1); ra[i][0] = *(const f32x4*)p; ra[i][1] = *(const f32x4*)(p + 4); }
            bf16x8 afr[4];
#pragma unroll
            for (int m = 0; m < 4; ++m) afr[m] = *(const LAS bf16x8*)(As + (ks & 1) * 4096 + (64 * wr + 16 * m + r16) * 32 + 8 * q);
#pragma unroll
            for (int m = 0; m < 4; ++m)
#pragma unroll
                for (int n = 0; n < 4; ++n) acc[m][n] = MFMA16(bfr[n], afr[m], acc[m][n]);
            if (ks + 1 < 32) { const f32x4 x0 = ra[(i + 1) & 3][0], x1 = ra[(i + 1) & 3][1];
                u32x4 w; w.x = pk2(x0.x, x0.y); w.y = pk2(x0.z, x0.w); w.z = pk2(x1.x, x1.y); w.w = pk2(x1.z, x1.w); *(LAS u32x4*)(adst + ((ks + 1) & 1) * 4096) = w; }
            __syncthreads();
        }
    }
#pragma unroll
    for (int m = 0; m < 4; ++m)
#pragma unroll
        for (int n = 0; n < 4; ++n) { u32x2 w; w.x = pk2(acc[m][n][0], acc[m][n][1]); w.y = pk2(acc[m][n][2], acc[m][n][3]);
            *(LAS u32x2*)(Pl + (64 * wr + 16 * m + r16) * SC_PP + 64 * wc + 16 * n + 4 * q) = w; }
    __syncthreads();
    {
        const float* pet = (const float*)(ws + WS_PET) + st * 128;
        const bf16* W2T = (const bf16*)(ws + WS_W2T) + st * 8192;
        const int nrow = 16 * wave + r16;
        f32x4 o[4];
#pragma unroll
        for (int dt = 0; dt < 4; ++dt) o[dt] = (f32x4){0.f, 0.f, 0.f, 0.f};
#pragma unroll
        for (int ks = 0; ks < 4; ++ks) {
            const int e0 = 32 * ks + 8 * q;
            const u32x4 pa = *(const LAS u32x4*)(Pl + nrow * SC_PP + e0), pb = *(const LAS u32x4*)(Pl + (nrow < 127 ? nrow + 1 : nrow) * SC_PP + 128 + e0);
            const f32x4 p0 = *(const f32x4*)(pet + e0), p1 = *(const f32x4*)(pet + e0 + 4);
            const f32x4 h0 = (f32x4){bflo(pa.x) + bflo(pb.x), bfhi(pa.x) + bfhi(pb.x), bflo(pa.y) + bflo(pb.y), bfhi(pa.y) + bfhi(pb.y)} + p0;
            const f32x4 h1 = (f32x4){bflo(pa.z) + bflo(pb.z), bfhi(pa.z) + bfhi(pb.z), bflo(pa.w) + bflo(pb.w), bfhi(pa.w) + bfhi(pb.w)} + p1;
            u32x4 w; w.x = pk2(siluf(h0.x), siluf(h0.y)); w.y = pk2(siluf(h0.z), siluf(h0.w)); w.z = pk2(siluf(h1.x), siluf(h1.y)); w.w = pk2(siluf(h1.z), siluf(h1.w));
            const bf16x8 af = __builtin_bit_cast(bf16x8, w);
#pragma unroll
            for (int dt = 0; dt < 4; ++dt) { const bf16x8 bf = *(const bf16x8*)(W2T + (size_t)(16 * dt + r16) * 128 + e0); o[dt] = MFMA16(af, bf, o[dt]); }
        }
        float* dst = (float*)(ws + (st ? WS_VCS : WS_KCS)) + ((size_t)bh * 128 + 16 * wave + 4 * q) * 64;
#pragma unroll
        for (int dt = 0; dt < 4; ++dt)
#pragma unroll
            for (int r = 0; r < 4; ++r) dst[r * 64 + 16 * dt + r16] = (16 * wave + 4 * q + r < 127) ? o[dt][r] : 0.f;
    }
    __syncthreads();
}
#ifdef SELFCHECK
__device__ __forceinline__ void check_sample_compress(const Args& args, LAS unsigned char* lds, int bid, int tid) {
    unsigned char* ws = args.ws;
    const int st = bid & 1, bh = (bid * 37) % 512, n = (bid * 11) % 127, b = bh >> 2, h = bh & 3;
    LAS float* hid = (LAS float*)lds;
    __syncthreads();
    if (tid < 128) {
        const float* pe = INF(st ? 25 : 22); const float* w1 = INF(st ? 26 : 23);
        float a = 0.f;
        for (int l = 0; l < 32; ++l) { const int t = 16 * n + l; const int page = ((const int*)args.in[5])[b * NPAGES + (t >> 7)];
            const float* row = INF(4) + (((size_t)page * 128 + (t & 127)) * 4 + st) * 256 + h * 64;
            for (int d = 0; d < 64; ++d) a += (row[d] + 0.f) * w1[((size_t)l * 64 + d) * 128 + tid] + pe[l * 64 + d] * w1[((size_t)l * 64 + d) * 128 + tid]; }
        hid[tid] = a / (1.f + __expf(-a));
    }
    __syncthreads();
    if (tid < 64) { const float* w2 = INF(st ? 27 : 24); float o = 0.f;
        for (int e = 0; e < 128; ++e) o += hid[e] * w2[e * 64 + tid];
        const float got = ((const float*)(ws + (st ? WS_VCS : WS_KCS)))[((size_t)bh * 128 + n) * 64 + tid];
        if (!(fabsf(got - o) <= 0.03f + 0.03f * fabsf(o))) atomicAdd((unsigned*)(ws + WS_CTL) + 8, 1u); }
    __syncthreads();
}
#endif
__device__ __forceinline__ void scan_phase(const Args& args, int gt, int NGT) {
    unsigned char* ws = args.ws; float* out = args.out;
    constexpr int NITEM = 4 * 32 * 64 * 32;
    for (int i0 = gt; i0 < NITEM; i0 += 2 * NGT) {
        const int i1 = i0 + NGT; const bool two = i1 < NITEM;
        const int ia[2] = {i0, two ? i1 : i0};
        size_t base[2]; const float* CSp[2]; f32x4 run[2];
#pragma unroll
        for (int k = 0; k < 2; ++k) { const int i = ia[k]; const int n4 = i & 31, p = (i >> 5) & 63, h = (i >> 11) & 31, b = i >> 16;
            base[k] = (((size_t)(b * 32) * 32 + h) * 64 + p) * 128 + 4 * n4; CSp[k] = (const float*)(ws + WS_CS) + (size_t)(b * 32 + h) * 4096; run[k] = (f32x4){0.f, 0.f, 0.f, 0.f}; }
#pragma unroll 1
        for (int c0 = 0; c0 < 32; c0 += 8) {
            f32x4 st[2][8]; float dec[2][8];
#pragma unroll
            for (int k = 0; k < 2; ++k)
#pragma unroll
                for (int j = 0; j < 8; ++j) { st[k][j] = *(const f32x4*)((const float*)(ws + WS_STATES) + base[k] + (size_t)(c0 + j) * (32 * 64 * 128)); dec[k][j] = CSp[k][(c0 + j) * 128 + 127]; }
#pragma unroll
            for (int j = 0; j < 8; ++j)
#pragma unroll
                for (int k = 0; k < 2; ++k) {
                    u32x2 o; o.x = pk2(run[k].x, run[k].y); o.y = pk2(run[k].z, run[k].w);
                    if (k == 0 || two) *(u32x2*)((bf16*)(ws + WS_HPREV) + base[k] + (size_t)(c0 + j) * (32 * 64 * 128)) = o;
                    run[k] = run[k] * __expf(dec[k][j]) + st[k][j];
                }
        }
#pragma unroll
        for (int k = 0; k < 2; ++k) if (k == 0 || two) { const int i = ia[k]; const int n4 = i & 31, p = (i >> 5) & 63, h = (i >> 11) & 31, b = i >> 16;
            *(f32x4*)(out + O_SSMP + (((size_t)(b * 32 + h) * 64 + p) * 128) + 4 * n4) = run[k]; }
    }
    for (int i = gt; i < MS * 4; i += NGT) { const int bs = i >> 2, g = i & 3; const float* p = (const float*)(ws + WS_MISC) + (size_t)(MP + bs) * 128 + 80 + g * 8;
        ((float*)(ws + WS_SSQ))[(size_t)(MP + bs) * 4 + g] = ((p[0] + p[1]) + (p[2] + p[3])) + ((p[4] + p[5]) + (p[6] + p[7])); }
}

constexpr int CNL_PITCH = 136;
struct DFrag { bf16x8 x[4]; f32x4 csa, csb, dta, dtb; };
__device__ __forceinline__ void ssd_out_load(const bf16* XT, const float* CS, const float* DT, int i, int q, int r16, DFrag& F) {
    const int sa = 32 * i + 4 * q, sb = sa + 16;
    F.csa = *(const f32x4*)(CS + sa); F.csb = *(const f32x4*)(CS + sb); F.dta = *(const f32x4*)(DT + sa); F.dtb = *(const f32x4*)(DT + sb);
#pragma unroll
    for (int pt = 0; pt < 4; ++pt) { const bf16* xr = XT + (size_t)i * 2048 + (16 * pt + r16) * 32 + 4 * q; const u32x2 lo = *(const u32x2*)xr, hi = *(const u32x2*)(xr + 16);
        F.x[pt] = __builtin_bit_cast(bf16x8, (u32x4){lo.x, lo.y, hi.x, hi.y}); }
}
template <int HL, int I>
__device__ __forceinline__ void ssd_out_diag(const LAS float* CBT, const DFrag& F, const float (&csl)[4], float Dh, int q, int r16, int lane, f32x4 (&acc)[4][4]) {
    const int sa = 32 * I + 4 * q, sb = sa + 16;
#pragma unroll
    for (int lt = 0; lt < 4; ++lt) {
        constexpr int dummy = 0; (void)dummy;
        const int LT = 4 * HL + lt;
        if (LT < 2 * I) continue;
        const int l = 16 * LT + r16;
        float ga[4], gb[4];
#pragma unroll
        for (int r = 0; r < 4; ++r) {
            const float va = CBT[(((2 * I) * 8 + LT) * 4 + r) * 64 + lane];
            const float vb = (LT >= 2 * I + 1) ? CBT[(((2 * I + 1) * 8 + LT) * 4 + r) * 64 + lane] : 0.f;
            const int s1 = sa + r, s2 = sb + r;
            float x1 = (l >= s1) ? va * __expf(csl[lt] - F.csa[r]) * F.dta[r] : 0.f;
            float x2 = (l >= s2) ? vb * __expf(csl[lt] - F.csb[r]) * F.dtb[r] : 0.f;
            if (l == s1) x1 += Dh;
            if (l == s2) x2 += Dh;
            ga[r] = x1; gb[r] = x2;
        }
        u32x4 o; o.x = pk2(ga[0], ga[1]); o.y = pk2(ga[2], ga[3]); o.z = pk2(gb[0], gb[1]); o.w = pk2(gb[2], gb[3]);
        const bf16x8 bf = __builtin_bit_cast(bf16x8, o);
#pragma unroll
        for (int pt = 0; pt < 4; ++pt) acc[pt][lt] = MFMA16(F.x[pt], bf, acc[pt][lt]);
    }
}
template <int HL>
__device__ __forceinline__ void ssd_out_half(const Args& args, const LAS float* CBT, const LAS bf16* CnL, LAS float* SQ, const bf16x8 (&hp)[16], const bf16* XT, const float* CS, const float* DT,
                                             float Dh, int b, int c, int h, int wave, int q, int r16, int lane) {
    unsigned char* ws = args.ws;
    float csl[4];
#pragma unroll
    for (int lt = 0; lt < 4; ++lt) csl[lt] = CS[64 * HL + 16 * lt + r16];
    DFrag FA, FB;
    ssd_out_load(XT, CS, DT, 0, q, r16, FA);
    f32x4 acc[4][4];
#pragma unroll
    for (int i = 0; i < 4; ++i)
#pragma unroll
        for (int j = 0; j < 4; ++j) acc[i][j] = (f32x4){0.f, 0.f, 0.f, 0.f};
#pragma unroll
    for (int ks = 0; ks < 4; ++ks)
#pragma unroll
        for (int lt = 0; lt < 4; ++lt) { const bf16x8 bf = *(const LAS bf16x8*)(CnL + (64 * HL + 16 * lt + r16) * CNL_PITCH + 32 * ks + 8 * q);
#pragma unroll
            for (int pt = 0; pt < 4; ++pt) acc[pt][lt] = MFMA16(hp[ks * 4 + pt], bf, acc[pt][lt]); }
#pragma unroll
    for (int lt = 0; lt < 4; ++lt) { const float e = __expf(csl[lt]);
#pragma unroll
        for (int pt = 0; pt < 4; ++pt) acc[pt][lt] = acc[pt][lt] * e; }
    ssd_out_load(XT, CS, DT, 1, q, r16, FB);
    ssd_out_diag<HL, 0>(CBT, FA, csl, Dh, q, r16, lane, acc);
    if (HL == 1) ssd_out_load(XT, CS, DT, 2, q, r16, FA);
    ssd_out_diag<HL, 1>(CBT, FB, csl, Dh, q, r16, lane, acc);
    if (HL == 1) {
        ssd_out_load(XT, CS, DT, 3, q, r16, FB);
        ssd_out_diag<HL, 2>(CBT, FA, csl, Dh, q, r16, lane, acc);
        ssd_out_diag<HL, 3>(CBT, FB, csl, Dh, q, r16, lane, acc);
    }
    const bf16* Z = (const bf16*)(ws + WS_Z); bf16* Y = (bf16*)(ws + WS_YSSM); const float* nw = INF(21) + h * 64;
    u32x2 zz[4][4];
#pragma unroll
    for (int lt = 0; lt < 4; ++lt)
#pragma unroll
        for (int pt = 0; pt < 4; ++pt) zz[lt][pt] = *(const u32x2*)(Z + ((size_t)b * 4096 + c * 128 + 64 * HL + 16 * lt + r16) * 2048 + h * 64 + 16 * pt + 4 * q);
#pragma unroll
    for (int lt = 0; lt < 4; ++lt) {
        const size_t m = (size_t)b * 4096 + c * 128 + 64 * HL + 16 * lt + r16;
        float ss = 0.f;
#pragma unroll
        for (int pt = 0; pt < 4; ++pt) {
            const int ch = 16 * pt + 4 * q;
            const f32x4 w = *(const f32x4*)(nw + ch);
            const float v0 = acc[pt][lt][0] * siluf(bflo(zz[lt][pt].x)), v1 = acc[pt][lt][1] * siluf(bfhi(zz[lt][pt].x)), v2 = acc[pt][lt][2] * siluf(bflo(zz[lt][pt].y)), v3 = acc[pt][lt][3] * siluf(bfhi(zz[lt][pt].y));
            ss += (v0 * v0 + v1 * v1) + (v2 * v2 + v3 * v3);
            u32x2 o; o.x = pk2(v0 * w.x, v1 * w.y); o.y = pk2(v2 * w.z, v3 * w.w);
            *(u32x2*)(Y + m * 2048 + h * 64 + ch) = o;
        }
        ss += __shfl_xor(ss, 16); ss += __shfl_xor(ss, 32);
        if (q == 0) SQ[wave * 128 + 64 * HL + 16 * lt + r16] = ss;
    }
}
__device__ __forceinline__ void ssd_out_unit(const Args& args, LAS unsigned char* lds, int unit, int wave, int lane_in, int tid) {
    int lane = lane_in; asm volatile("" : "+v"(lane));
    unsigned char* ws = args.ws;
    const int g = unit & 3, c = (unit >> 2) & 31, b = unit >> 7, h = g * 8 + wave, q = lane >> 4, r16 = lane & 15;
    LAS float* CBT = (LAS float*)lds; LAS bf16* CnL = (LAS bf16*)(lds + 65536); LAS float* SQ = (LAS float*)(lds + 65536 + 128 * CNL_PITCH * 2);
    const bf16* Bn = (const bf16*)(ws + WS_BN) + ((size_t)(b * 4 + g) * 4096 + c * 128) * 128;
    const bf16* Cn = (const bf16*)(ws + WS_CN) + ((size_t)(b * 4 + g) * 4096 + c * 128) * 128;
    {
        u32x4 cv[4];
#pragma unroll
        for (int i = 0; i < 4; ++i) cv[i] = *(const u32x4*)(Cn + (size_t)(wave * 64 + lane + 512 * i) * 8);
        bf16x8 bnf[4], hp[16];
#pragma unroll
        for (int ks = 0; ks < 4; ++ks) bnf[ks] = *(const bf16x8*)(Bn + (size_t)(16 * wave + r16) * 128 + 32 * ks + 8 * q);
        const bf16* HP = (const bf16*)(ws + WS_HPREV) + (((size_t)(b * 32 + c) * 32 + h) * 64) * 128;
#pragma unroll
        for (int ks = 0; ks < 4; ++ks)
#pragma unroll
            for (int pt = 0; pt < 4; ++pt) hp[ks * 4 + pt] = *(const bf16x8*)(HP + (size_t)(16 * pt + r16) * 128 + 32 * ks + 8 * q);
#pragma unroll
        for (int i = 0; i < 4; ++i) { const int id = wave * 64 + lane + 512 * i; *(LAS u32x4*)(CnL + (id >> 4) * CNL_PITCH + (id & 15) * 8) = cv[i]; }
        __syncthreads();
        for (int lt = wave; lt < 8; ++lt) {
            f32x4 d = (f32x4){0.f, 0.f, 0.f, 0.f};
#pragma unroll
            for (int ks = 0; ks < 4; ++ks) { const bf16x8 bf = *(const LAS bf16x8*)(CnL + (16 * lt + r16) * CNL_PITCH + 32 * ks + 8 * q); d = MFMA16(bnf[ks], bf, d); }
#pragma unroll
            for (int r = 0; r < 4; ++r) CBT[((wave * 8 + lt) * 4 + r) * 64 + lane] = d[r];
        }
        __syncthreads();
        const float* DT = (const float*)(ws + WS_DT) + (size_t)(b * 32 + h) * 4096 + c * 128; const float* CS = (const float*)(ws + WS_CS) + (size_t)(b * 32 + h) * 4096 + c * 128;
        const float Dh = INF(20)[h];
        const bf16* XT = (const bf16*)(ws + WS_XT) + ((size_t)(b * 32 + h) * 128 + c * 4) * 2048;
        ssd_out_half<0>(args, CBT, CnL, SQ, hp, XT, CS, DT, Dh, b, c, h, wave, q, r16, lane);
        ssd_out_half<1>(args, CBT, CnL, SQ, hp, XT, CS, DT, Dh, b, c, h, wave, q, r16, lane);
    }
    __syncthreads();
    if (tid < 128) { float s = 0.f;
#pragma unroll
        for (int w = 0; w < 8; ++w) s += SQ[w * 128 + tid];
        ((float*)(ws + WS_SSQ))[((size_t)b * 4096 + c * 128 + tid) * 4 + g] = s; }
    __syncthreads();
}
constexpr float SC2 = 0.125f * 1.4426950408889634f;
__device__ __forceinline__ float max3f(float a, float b, float c) { float r; asm("v_max3_f32 %0, %1, %2, %3" : "=v"(r) : "v"(a), "v"(b), "v"(c)); return r; }
template <class T> __device__ __forceinline__ T ldu(const void* ubase, unsigned lane_off) { return *(const T*)((const char*)ubase + lane_off); }
struct KFrag { bf16x8 kf[2][2]; };
__device__ __forceinline__ void flash_load(const bf16* Kp, int kb, unsigned koff, KFrag& F) {
#pragma unroll
    for (int kt = 0; kt < 2; ++kt) { const bf16* kr = Kp + (size_t)(kb + 16 * kt) * 64; F.kf[kt][0] = ldu<bf16x8>(kr, koff); F.kf[kt][1] = ldu<bf16x8>(kr + 32, koff); }
}
template <int MODE>
__device__ __forceinline__ void flash_step(const KFrag& F, const bf16* VTp, unsigned voff, int kb, int t0, int t, bool selbit, const LAS bf16x8* Qs,
                                           f32x4 (&O)[4][4], float (&mx)[4], f32x4 (&L)[4], int q) {
    const bf16x8 ones = __builtin_bit_cast(bf16x8, (u32x4){0x3f803f80u, 0x3f803f80u, 0x3f803f80u, 0x3f803f80u});
    const bool edge = (kb + 31 > t0) || (MODE == 1 && kb + 512 <= t0 + 15);
    bf16x8 vf[4];
#pragma unroll
    for (int dt = 0; dt < 4; ++dt) vf[dt] = ldu<bf16x8>(VTp + (size_t)(kb >> 5) * 2048 + (16 * dt) * 32, voff);
#pragma unroll
    for (int g = 0; g < 4; ++g) {
        asm volatile("" ::: "memory");
        __builtin_amdgcn_sched_barrier(0);
        const bf16x8 q0 = Qs[(g * 2 + 0) * 64], q1 = Qs[(g * 2 + 1) * 64];
        f32x4 S0 = MFMA16(F.kf[0][0], q0, ((f32x4){0.f, 0.f, 0.f, 0.f})), S1 = MFMA16(F.kf[1][0], q0, ((f32x4){0.f, 0.f, 0.f, 0.f}));
        S0 = MFMA16(F.kf[0][1], q1, S0); S1 = MFMA16(F.kf[1][1], q1, S1);
        float s[8];
#pragma unroll
        for (int r = 0; r < 4; ++r) { s[r] = S0[r]; s[4 + r] = S1[r]; }
        if (edge) {
#pragma unroll
            for (int i = 0; i < 8; ++i) { const int key = kb + 16 * (i >> 2) + 4 * q + (i & 3);
                const bool ok = (MODE == 0) ? (key <= t) : (key <= t && key + 512 > t); s[i] = ok ? s[i] : NEGF; }
        }
        float lm = max3f(max3f(s[0], s[1], s[2]), max3f(s[3], s[4], s[5]), fmaxf(s[6], s[7])) * SC2;
        if (MODE == 0) lm = selbit ? lm : NEGF;
        if (__builtin_amdgcn_ballot_w64(lm > mx[g] + 8.f) != 0ull) {
            float tmax = fmaxf(lm, __shfl_xor(lm, 16)); tmax = fmaxf(tmax, __shfl_xor(tmax, 32));
            const float mnew = fmaxf(mx[g], tmax), alpha = __builtin_amdgcn_exp2f(mx[g] - mnew); mx[g] = mnew; L[g] = L[g] * alpha;
#pragma unroll
            for (int dt = 0; dt < 4; ++dt) O[dt][g] = O[dt][g] * alpha;
        }
        float nmuse = -fmaxf(mx[g], -1e20f);
        if (MODE == 0) nmuse = selbit ? nmuse : NEGF;
#pragma unroll
        for (int i = 0; i < 8; ++i) s[i] = __builtin_amdgcn_exp2f(__builtin_fmaf(s[i], SC2, nmuse));
        u32x4 pw; pw.x = pk2(s[0], s[1]); pw.y = pk2(s[2], s[3]); pw.z = pk2(s[4], s[5]); pw.w = pk2(s[6], s[7]);
        const bf16x8 pf = __builtin_bit_cast(bf16x8, pw);
        L[g] = MFMA16(ones, pf, L[g]);
#pragma unroll
        for (int dt = 0; dt < 4; ++dt) O[dt][g] = MFMA16(vf[dt], pf, O[dt][g]);
    }
}
template <int MODE>
__device__ __forceinline__ void flash_branch(const bf16* Kp, const bf16* VTp, int jfirst, int jlast, unsigned ulo, unsigned uhi, unsigned mlo, unsigned mhi,
                                             int t0, int t, const LAS bf16x8* Qs, f32x4 (&O)[4][4], float (&mx)[4], f32x4 (&L)[4], int q, int r16) {
    const unsigned koff = (unsigned)(r16 * 64 + 8 * q) * 2u, voff = (unsigned)(r16 * 32 + 8 * q) * 2u;
    int jb = jfirst;
    while (jb <= jlast && !((jb < 32 ? (ulo >> jb) : (uhi >> (jb - 32))) & 1u)) ++jb;
    if (jb > jlast) return;
    KFrag A, B;
    flash_load(Kp, 64 * jb, koff, A);
    for (;;) {
        flash_load(Kp, 64 * jb + 32, koff, B);
        const bool selbit = ((jb < 32 ? (mlo >> jb) : (mhi >> (jb - 32))) & 1u) != 0u;
        flash_step<MODE>(A, VTp, voff, 64 * jb, t0, t, selbit, Qs, O, mx, L, q);
        int jn = jb + 1;
        while (jn <= jlast && !((jn < 32 ? (ulo >> jn) : (uhi >> (jn - 32))) & 1u)) ++jn;
        if (jn <= jlast) flash_load(Kp, 64 * jn, koff, A);
        flash_step<MODE>(B, VTp, voff, 64 * jb + 32, t0, t, selbit, Qs, O, mx, L, q);
        if (jn > jlast) break;
        jb = jn;
    }
}

template <int BR>
__device__ __forceinline__ void attn_finish(const Args& args, f32x4 (&O)[4][4], const f32x4 (&L)[4], bool normalise, size_t m, int hkv, int q) {
    unsigned char* ws = args.ws;
    const float* gates = (const float*)(ws + WS_MISC) + m * 128 + 32;
    const unsigned yoff = (unsigned)((m & 15) * 1024 + 4 * q) * 4u, yboff = yoff >> 1;
#pragma unroll
    for (int g = 0; g < 4; ++g) {
        float sc = sigmf(gates[(hkv * 4 + g) * 3 + BR]);
        if (normalise) sc *= 1.f / fmaxf(L[g][0], TINYF);
#pragma unroll
        for (int dt = 0; dt < 4; ++dt) {
            char* yfu = (char*)((float*)(ws + WS_YATTF) + (m & ~(size_t)15) * 1024 + (hkv * 4 + g) * 64 + 16 * dt);
            f32x4 v = O[dt][g] * sc;
            if (BR > 0) v = v + *(const f32x4*)(yfu + yoff);
            if (BR < 2) *(f32x4*)(yfu + yoff) = v;
            else { u32x2 o; o.x = pk2(v.x, v.y); o.y = pk2(v.z, v.w); *(u32x2*)((char*)((bf16*)(ws + WS_YATT) + (m & ~(size_t)15) * 1024 + (hkv * 4 + g) * 64 + 16 * dt) + yboff) = o; }
        }
    }
}

__device__ __forceinline__ void cmp_pass1_tile(const bf16x8& k0, const bf16x8& k1, int kt, const LAS bf16x8* Qs, int t, int q, float (&mx)[4], float (&ls)[4]) {
#pragma unroll
    for (int g = 0; g < 4; ++g) {
        f32x4 s = MFMA16(k0, Qs[(g * 2 + 0) * 64], ((f32x4){0.f, 0.f, 0.f, 0.f})); s = MFMA16(k1, Qs[(g * 2 + 1) * 64], s);
        float tmax = NEGF;
#pragma unroll
        for (int r = 0; r < 4; ++r) { const int n = 16 * kt + 4 * q + r; const bool ok = (16 * n + 31 <= t); s[r] = ok ? s[r] * 0.125f : NEGF; tmax = fmaxf(tmax, s[r]); }
        const float mnew = fmaxf(mx[g], tmax); float ps = 0.f;
#pragma unroll
        for (int r = 0; r < 4; ++r) ps += (s[r] > 0.5f * NEGF) ? __expf(s[r] - mnew) : 0.f;
        ls[g] = ls[g] * __expf(mx[g] - mnew) + ps; mx[g] = mnew;
    }
}
__device__ __forceinline__ void attn_prompt_unit(const Args& args, LAS float* impL, int unit, bool xcdmap, int lane_in) {
    int lane = lane_in; asm volatile("" : "+v"(lane));
    unsigned char* ws = args.ws;
    const int q = lane >> 4, r16 = lane & 15;
    const int pass = unit >> 11, gwv = unit & 2047, xcd = (gwv >> 3) & 7, wx = (gwv >> 6) * 8 + (gwv & 7);
    const int bh = xcdmap ? 2 * xcd + pass : (unit & 15), b = bh >> 2, hkv = bh & 3;
    const int tile = xcdmap ? (pass == 0 ? 255 - wx : wx) : (unit < 2048 ? 255 - (unit >> 4) : (unit - 2048) >> 4);
    const int t0 = tile * 16, t = t0 + r16; const size_t m = (size_t)b * 4096 + t;
    LAS bf16x8* Qs = (LAS bf16x8*)(impL + 1024) + lane;
#pragma unroll
    for (int g = 0; g < 4; ++g)
#pragma unroll
        for (int ks = 0; ks < 2; ++ks) Qs[(g * 2 + ks) * 64] = ldu<bf16x8>((const bf16*)(ws + WS_Q) + ((size_t)b * 4096 + t0) * 1024 + (hkv * 4 + g) * 64 + 32 * ks, (unsigned)(r16 * 1024 + 8 * q) * 2u);
    LDS_WAIT(); asm volatile("" ::: "memory");
    f32x4 O[4][4]; float mx[4], ls[4];
    const bf16* KCp = (const bf16*)(ws + WS_KC) + (size_t)bh * 256 * 64; const bf16* VCTp = (const bf16*)(ws + WS_VCT) + (size_t)bh * 64 * 256;
    const unsigned kcoff = (unsigned)(r16 * 64 + 8 * q) * 2u, vcoff = (unsigned)(r16 * 32 + 8 * q) * 2u;
    const int nmax = (t0 + 15 >= 31) ? ((t0 + 15 - 31) >> 4) : -1;
    const int NP = nmax < 0 ? 0 : (nmax / 32 + 2 < 8 ? nmax / 32 + 2 : 8);
#pragma unroll
    for (int g = 0; g < 4; ++g) { mx[g] = NEGF; ls[g] = 0.f; }
    {
        bf16x8 ka0, ka1, kb0, kb1;
        if (NP > 0) { ka0 = ldu<bf16x8>(KCp, kcoff); ka1 = ldu<bf16x8>(KCp + 32, kcoff); }
#pragma unroll 1
        for (int kt = 0; kt < 2 * NP; kt += 2) {
            { const bf16* kr = KCp + (size_t)(16 * (kt + 1)) * 64; kb0 = ldu<bf16x8>(kr, kcoff); kb1 = ldu<bf16x8>(kr + 32, kcoff); }
            cmp_pass1_tile(ka0, ka1, kt, Qs, t, q, mx, ls);
            if (kt + 2 < 2 * NP) { const bf16* kr = KCp + (size_t)(16 * (kt + 2)) * 64; ka0 = ldu<bf16x8>(kr, kcoff); ka1 = ldu<bf16x8>(kr + 32, kcoff); }
            cmp_pass1_tile(kb0, kb1, kt + 1, Qs, t, q, mx, ls);
        }
    }
    float invL[4];
#pragma unroll
    for (int g = 0; g < 4; ++g) {
        float M = fmaxf(mx[g], __shfl_xor(mx[g], 16)); M = fmaxf(M, __shfl_xor(M, 32));
        float l = ls[g] * __expf(mx[g] - M); l += __shfl_xor(l, 16); l += __shfl_xor(l, 32);
        mx[g] = M; invL[g] = 1.f / fmaxf(l, TINYF);
    }
#pragma unroll
    for (int dt = 0; dt < 4; ++dt)
#pragma unroll
        for (int g = 0; g < 4; ++g) O[dt][g] = (f32x4){0.f, 0.f, 0.f, 0.f};
    float prev3 = 0.f;
#pragma unroll
    for (int kt = 0; kt < 16; ++kt) impL[kt * 64 + lane] = 0.f;
    bf16x8 kc[2][2], vcf[4];
    if (NP > 0) {
#pragma unroll
        for (int kk = 0; kk < 2; ++kk) { const bf16* kr = KCp + (size_t)(16 * kk) * 64; kc[kk][0] = ldu<bf16x8>(kr, kcoff); kc[kk][1] = ldu<bf16x8>(kr + 32, kcoff); }
#pragma unroll
        for (int dt = 0; dt < 4; ++dt) vcf[dt] = ldu<bf16x8>(VCTp + (16 * dt) * 32, vcoff);
    }
#pragma unroll 1
    for (int i = 0; i < NP; ++i) {
        bf16x8 kn[2][2], vn[4];
        if (i + 1 < NP) {
#pragma unroll
            for (int kk = 0; kk < 2; ++kk) { const bf16* kr = KCp + (size_t)(16 * (2 * i + 2 + kk)) * 64; kn[kk][0] = ldu<bf16x8>(kr, kcoff); kn[kk][1] = ldu<bf16x8>(kr + 32, kcoff); }
#pragma unroll
            for (int dt = 0; dt < 4; ++dt) vn[dt] = ldu<bf16x8>(VCTp + (size_t)(i + 1) * 2048 + (16 * dt) * 32, vcoff);
        }
        f32x4 P[2][4];
#pragma unroll
        for (int kk = 0; kk < 2; ++kk) {
            const int kt = 2 * i + kk;
            const bf16x8 k0 = kc[kk][0], k1 = kc[kk][1];
            f32x4 psum = (f32x4){0.f, 0.f, 0.f, 0.f};
#pragma unroll
            for (int g = 0; g < 4; ++g) {
                f32x4 s = MFMA16(k0, Qs[(g * 2 + 0) * 64], ((f32x4){0.f, 0.f, 0.f, 0.f})); s = MFMA16(k1, Qs[(g * 2 + 1) * 64], s);
#pragma unroll
                for (int r = 0; r < 4; ++r) { const int n = 16 * kt + 4 * q + r; const bool ok = (16 * n + 31 <= t); s[r] = ok ? __expf(s[r] * 0.125f - mx[g]) * invL[g] : 0.f; }
                P[kk][g] = s; psum = psum + s;
            }
            const float a = __shfl(psum[3], (lane + 48) & 63), bb = __shfl(prev3, (lane + 48) & 63);
            impL[kt * 64 + lane] = 2.f * (psum[0] + psum[1] + psum[2]) + psum[3] + (q > 0 ? a : bb);
            prev3 = psum[3];
        }
#pragma unroll
        for (int g = 0; g < 4; ++g) {
            u32x4 pw; pw.x = pk2(P[0][g][0], P[0][g][1]); pw.y = pk2(P[0][g][2], P[0][g][3]); pw.z = pk2(P[1][g][0], P[1][g][1]); pw.w = pk2(P[1][g][2], P[1][g][3]);
            const bf16x8 pf = __builtin_bit_cast(bf16x8, pw);
#pragma unroll
            for (int dt = 0; dt < 4; ++dt) O[dt][g] = MFMA16(vcf[dt], pf, O[dt][g]);
        }
        if (i + 1 < NP) {
#pragma unroll
            for (int kk = 0; kk < 2; ++kk) { kc[kk][0] = kn[kk][0]; kc[kk][1] = kn[kk][1]; }
#pragma unroll
            for (int dt = 0; dt < 4; ++dt) vcf[dt] = vn[dt];
        }
    }
    f32x4 L[4];
#pragma unroll
    for (int g = 0; g < 4; ++g) L[g] = (f32x4){1.f, 1.f, 1.f, 1.f};
    attn_finish<0>(args, O, L, false, m, hkv, q);
    unsigned mlo = 0u, mhi = 0u;
    {
        const int cur = t >> 6;
        LDS_WAIT(); asm volatile("" ::: "memory");
        unsigned key[16];
#pragma unroll
        for (int kt = 0; kt < 16; ++kt) { const int j = 4 * kt + q; const bool valid = (64 * j <= t), forced = (j == 0) || (j == cur) || (j == cur - 1);
            const float val = valid ? (forced ? BIGF : impL[kt * 64 + lane]) : -BIGF; const unsigned u = __builtin_bit_cast(unsigned, val);
            key[kt] = (u & 0x80000000u) ? ~u : (u | 0x80000000u); }
        unsigned T = 0u;
#pragma unroll 1
        for (int bit = 31; bit >= 0; --bit) {
            const unsigned cand = T | (1u << bit);
            int cnt = 0;
#pragma unroll
            for (int kt = 0; kt < 16; ++kt) cnt += key[kt] >= cand ? 1 : 0;
            cnt += __shfl_xor(cnt, 16); cnt += __shfl_xor(cnt, 32);
            T = cnt >= 16 ? cand : T;
        }
        int cgt = 0;
#pragma unroll
        for (int kt = 0; kt < 16; ++kt) cgt += key[kt] > T ? 1 : 0;
        cgt += __shfl_xor(cgt, 16); cgt += __shfl_xor(cgt, 32);
        const int need = 16 - cgt;
        unsigned elo = 0u, ehi = 0u;
#pragma unroll
        for (int kt = 0; kt < 16; ++kt) { const int j = 4 * kt + q; const unsigned bit = key[kt] == T ? 1u : 0u; if (kt < 8) elo |= bit << j; else ehi |= bit << (j - 32); }
        elo |= __shfl_xor(elo, 16); elo |= __shfl_xor(elo, 32); ehi |= __shfl_xor(ehi, 16); ehi |= __shfl_xor(ehi, 32);
        const int pclo = __popc(elo);
#pragma unroll
        for (int kt = 0; kt < 16; ++kt) { const int j = 4 * kt + q;
            const int before = kt < 8 ? __popc(elo & ((1u << j) - 1u)) : pclo + __popc(ehi & ((1u << (j - 32)) - 1u));
            const unsigned bit = (key[kt] > T || (key[kt] == T && before < need)) ? 1u : 0u;
            if (kt < 8) mlo |= bit << j; else mhi |= bit << (j - 32); }
        mlo |= __shfl_xor(mlo, 16); mlo |= __shfl_xor(mlo, 32); mhi |= __shfl_xor(mhi, 16); mhi |= __shfl_xor(mhi, 32);
    }
    unsigned ulo = mlo, uhi = mhi;
#pragma unroll
    for (int o = 1; o < 16; o <<= 1) { ulo |= __shfl_xor(ulo, o); uhi |= __shfl_xor(uhi, o); }
    ulo = __builtin_amdgcn_readfirstlane(ulo); uhi = __builtin_amdgcn_readfirstlane(uhi);
    {
#pragma unroll
        for (int g = 0; g < 4; ++g) { mx[g] = NEGF; L[g] = (f32x4){0.f, 0.f, 0.f, 0.f}; }
#pragma unroll
        for (int dt = 0; dt < 4; ++dt)
#pragma unroll
            for (int g = 0; g < 4; ++g) O[dt][g] = (f32x4){0.f, 0.f, 0.f, 0.f};
        const bf16* Kp = (const bf16*)(ws + WS_KVH) + ((size_t)(2 * 4 + b) * 4 + hkv) * 4096 * 64;
        const bf16* VTp = (const bf16*)(ws + WS_VT) + ((size_t)(0 * 4 + b) * 4 + hkv) * 64 * 4096;
        flash_branch<0>(Kp, VTp, 0, (t0 + 15) >> 6, ulo, uhi, mlo, mhi, t0, t, Qs, O, mx, L, q, r16);
        attn_finish<1>(args, O, L, true, m, hkv, q);
    }
    {
#pragma unroll
        for (int g = 0; g < 4; ++g) { mx[g] = NEGF; L[g] = (f32x4){0.f, 0.f, 0.f, 0.f}; }
#pragma unroll
        for (int dt = 0; dt < 4; ++dt)
#pragma unroll
            for (int g = 0; g < 4; ++g) O[dt][g] = (f32x4){0.f, 0.f, 0.f, 0.f};
        const bf16* Kp = (const bf16*)(ws + WS_KVH) + ((size_t)(4 * 4 + b) * 4 + hkv) * 4096 * 64;
        const bf16* VTp = (const bf16*)(ws + WS_VT) + ((size_t)(1 * 4 + b) * 4 + hkv) * 64 * 4096;
        const int jbeg = t0 >= 511 ? (t0 - 511) >> 6 : 0, jend = (t0 + 15) >> 6;
        flash_branch<1>(Kp, VTp, jbeg, jend, 0xffffffffu, 0xffffffffu, 0xffffffffu, 0xffffffffu, t0, t, Qs, O, mx, L, q, r16);
        attn_finish<2>(args, O, L, true, m, hkv, q);
    }
}
__device__ __forceinline__ void dot4_reduce(const float (&qv)[4], float kx, int lane, float (&sg)[4]) {
    const float v0 = qv[0] * kx, v1 = qv[1] * kx, v2 = qv[2] * kx, v3 = qv[3] * kx;
    const bool up = (lane & 32) != 0, up2 = (lane & 16) != 0;
    const float r0 = (up ? v2 : v0) + __shfl_xor(up ? v0 : v2, 32), r1 = (up ? v3 : v1) + __shfl_xor(up ? v1 : v3, 32);
    float x = (up2 ? r1 : r0) + __shfl_xor(up2 ? r0 : r1, 16);
    x += __shfl_xor(x, 8); x += __shfl_xor(x, 4); x += __shfl_xor(x, 2); x += __shfl_xor(x, 1);
    const int xi = __builtin_bit_cast(int, x);
    sg[0] = __builtin_bit_cast(float, __builtin_amdgcn_readlane(xi, 0)); sg[1] = __builtin_bit_cast(float, __builtin_amdgcn_readlane(xi, 16));
    sg[2] = __builtin_bit_cast(float, __builtin_amdgcn_readlane(xi, 32)); sg[3] = __builtin_bit_cast(float, __builtin_amdgcn_readlane(xi, 48));
}
struct SampleRows { const float* cache; const float* cwin; float* out; const LAS int* selblk; const LAS int* selpage; int bs, hkv, rs, dc; };
template <int BR> __device__ __forceinline__ void srow_load(const SampleRows& R, int row, int nrows, f32x4& kx, f32x4& vx) {
    kx = (f32x4){0.f, 0.f, 0.f, 0.f}; vx = kx;
    if (row < nrows) {
        if (BR == 0) { const int k = row >> 6; const unsigned off = (((unsigned)R.selpage[k] * 128u + (unsigned)((R.selblk[k] & 1) * 64 + (row & 63))) * 4u + 2u) * 256u + (unsigned)(R.hkv * 64 + 4 * R.dc);
            kx = *(const f32x4*)(R.cache + off); vx = *(const f32x4*)(R.cache + off + 256u); }
        else { const unsigned off = (((unsigned)R.bs * 512u + (unsigned)(row + 1)) * 2u) * 256u + (unsigned)(R.hkv * 64 + 4 * R.dc);
            kx = *(const f32x4*)(R.cwin + off); vx = *(const f32x4*)(R.cwin + off + 256u); }
    }
}
__device__ __forceinline__ void srow_update(const f32x4 (&qv)[4], const f32x4& kx, const f32x4& vx, bool valid, float (&mx)[4], float (&ls)[4], f32x4 (&o)[4]) {
    float s[4];
#pragma unroll
    for (int g = 0; g < 4; ++g) s[g] = (qv[g].x * kx.x + qv[g].y * kx.y) + (qv[g].z * kx.z + qv[g].w * kx.w);
#pragma unroll
    for (int st = 8; st >= 1; st >>= 1)
#pragma unroll
        for (int g = 0; g < 4; ++g) s[g] += __shfl_xor(s[g], st);
#pragma unroll
    for (int g = 0; g < 4; ++g) {
        const float mnew = valid ? fmaxf(mx[g], s[g]) : mx[g], alpha = __expf(mx[g] - mnew), p = valid ? __expf(s[g] - mnew) : 0.f;
        ls[g] = ls[g] * alpha + p; o[g] = o[g] * alpha + vx * p; mx[g] = mnew;
    }
}
template <int BR>
__device__ __forceinline__ void sample_rows_branch(const SampleRows& R, int wave, const f32x4 (&qv)[4], LAS float* pm, LAS float* pl, LAS float* po) {
    float mx[4], ls[4]; f32x4 o[4];
#pragma unroll
    for (int g = 0; g < 4; ++g) { mx[g] = NEGF; ls[g] = 0.f; o[g] = (f32x4){0.f, 0.f, 0.f, 0.f}; }
    constexpr int nrows = BR == 0 ? 15 * 64 : 511;
    constexpr int ngroups = (nrows + 3) / 4;
#pragma unroll 1
    for (int g0 = wave; g0 < ngroups; g0 += 64) {
        f32x4 kx[8], vx[8];
#pragma unroll
        for (int k = 0; k < 8; ++k) srow_load<BR>(R, 4 * (g0 + 8 * k) + R.rs, (g0 + 8 * k) < ngroups ? nrows : 0, kx[k], vx[k]);
#pragma unroll
        for (int k = 0; k < 8; ++k) {
            const int grp = g0 + 8 * k, row = 4 * grp + R.rs;
            if (grp < ngroups) {
                const bool valid = row < nrows;
                if (BR == 1 && valid) { const unsigned off = (((unsigned)R.bs * 512u + (unsigned)row) * 2u) * 256u + (unsigned)(R.hkv * 64 + 4 * R.dc);
                    *(f32x4*)(R.out + O_WINS + off) = kx[k]; *(f32x4*)(R.out + O_WINS + off + 256u) = vx[k]; }
                srow_update(qv, kx[k], vx[k], valid, mx, ls, o);
            }
        }
    }
    if (wave == 0) {
        const float* src = BR == 0 ? R.out + O_KVS + ((size_t)R.bs * 4 + 2) * 256 + R.hkv * 64 + 4 * R.dc : R.out + O_WINS + (((size_t)R.bs * 512 + 511) * 2) * 256 + R.hkv * 64 + 4 * R.dc;
        const f32x4 kx = *(const f32x4*)src, vx = *(const f32x4*)(src + 256);
        srow_update(qv, kx, vx, R.rs == 0, mx, ls, o);
    }
    const int slot = (BR * 32 + wave * 4 + R.rs) * 4;
#pragma unroll
    for (int g = 0; g < 4; ++g) { if (R.dc == 0) { pm[slot + g] = mx[g]; pl[slot + g] = ls[g]; } *(LAS f32x4*)(po + (size_t)(slot + g) * 64 + 4 * R.dc) = o[g]; }
}

__device__ __forceinline__ void attn_sample_unit(const Args& args, LAS unsigned char* lds, int unit, int tid, int wave, int lane) {
    unsigned char* ws = args.ws; float* out = args.out;
    const int hkv = unit & 3, bs = unit >> 2; const size_t m = MP + bs;
    LAS float* sc = (LAS float*)lds; LAS float* impv = sc + 512; LAS int* selblk = (LAS int*)(impv + 64); LAS int* selpage = selblk + 16; LAS int* pg = selpage + 16;
    LAS float* pm = (LAS float*)(pg + 16); LAS float* pl = pm + 256; LAS float* po = pl + 256;
    LAS float* poc = po + 2 * 32 * 4 * 64;
    const bf16* Qr = (const bf16*)(ws + WS_Q) + m * 1024 + hkv * 256;
    const float* KCS = (const float*)(ws + WS_KCS) + (size_t)(bs * 4 + hkv) * 128 * 64; const float* VCS = (const float*)(ws + WS_VCS) + (size_t)(bs * 4 + hkv) * 128 * 64;
    float qv[4];
#pragma unroll
    for (int g = 0; g < 4; ++g) qv[g] = bf2f(Qr[g * 64 + lane]) * 0.125f;
    if (tid < 16) pg[tid] = ((const int*)args.in[5])[bs * NPAGES + tid];
    {
        float kr[16];
#pragma unroll
        for (int i = 0; i < 16; ++i) { const int n = wave + 8 * i; kr[i] = n < 127 ? KCS[n * 64 + lane] : 0.f; }
#pragma unroll
        for (int i = 0; i < 16; ++i) { const int n = wave + 8 * i; float sg[4]; dot4_reduce(qv, kr[i], lane, sg);
            if (lane < 4) sc[lane * 128 + n] = n < 127 ? (lane == 0 ? sg[0] : lane == 1 ? sg[1] : lane == 2 ? sg[2] : sg[3]) : NEGF; }
    }
    __syncthreads();
    if (wave < 4) { const float s0 = sc[wave * 128 + lane], s1 = sc[wave * 128 + 64 + lane];
        float mxv = fmaxf(s0, s1);
#pragma unroll
        for (int o = 1; o < 64; o <<= 1) mxv = fmaxf(mxv, __shfl_xor(mxv, o));
        const float e0 = __expf(s0 - mxv), e1 = (lane < 63) ? __expf(s1 - mxv) : 0.f;
        const float inv = 1.f / fmaxf(wave_sum(e0 + e1), TINYF);
        sc[wave * 128 + lane] = e0 * inv; sc[wave * 128 + 64 + lane] = e1 * inv; }
    __syncthreads();
    {
        float vr[16];
#pragma unroll
        for (int i = 0; i < 16; ++i) { const int n = wave + 8 * i; vr[i] = n < 127 ? VCS[n * 64 + lane] : 0.f; }
        float oc[4] = {0.f, 0.f, 0.f, 0.f};
#pragma unroll
        for (int i = 0; i < 16; ++i) { const int n = wave + 8 * i;
#pragma unroll
            for (int g = 0; g < 4; ++g) oc[g] += sc[g * 128 + n] * vr[i]; }
#pragma unroll
        for (int g = 0; g < 4; ++g) poc[(wave * 4 + g) * 64 + lane] = oc[g];
        if (wave == 4 && lane < 33) { const int j = lane; float acc = 0.f;
#pragma unroll
            for (int k = -1; k < 4; ++k) { const int n = 4 * j + k; if (n >= 0 && n < 127) { const float P = (sc[n] + sc[128 + n]) + (sc[256 + n] + sc[384 + n]); acc += (k == -1 || k == 3) ? P : 2.f * P; } }
            impv[j] = (j == 0 || j == 31 || j == 32) ? BIGF : acc; }
    }
    __syncthreads();
    if (tid < 64) { bool sel = false;
        if (tid < 33) { const float v = impv[tid]; int rank = 0;
            for (int k = 0; k < 33; ++k) { const float o = impv[k]; rank += ((o > v) || (o == v && k < tid)) ? 1 : 0; }
            sel = rank < 16 && tid < 32; }
        const unsigned long long bal = __ballot(sel);
        if (sel) { const int slot = __popcll(bal & ((1ull << tid) - 1ull)); selblk[slot] = tid; selpage[slot] = pg[tid >> 1]; } }
    __syncthreads();
    {
        f32x4 qv4[4];
#pragma unroll
        for (int g = 0; g < 4; ++g) { const u32x2 w = *(const u32x2*)(Qr + g * 64 + 4 * (lane & 15)); qv4[g] = (f32x4){bflo(w.x), bfhi(w.x), bflo(w.y), bfhi(w.y)} * 0.125f; }
        SampleRows R{INF(4), INF(6), out, selblk, selpage, bs, hkv, lane >> 4, lane & 15};
        sample_rows_branch<0>(R, wave, qv4, pm, pl, po);
        sample_rows_branch<1>(R, wave, qv4, pm, pl, po);
    }
    __syncthreads();
    if (tid < 256) { const int g = tid >> 6, d = tid & 63;
        const float* gates = (const float*)(ws + WS_MISC) + m * 128 + 32 + (hkv * 4 + g) * 3;
        float oc = 0.f;
#pragma unroll
        for (int w = 0; w < 8; ++w) oc += poc[(w * 4 + g) * 64 + d];
        float res = sigmf(gates[0]) * oc;
#pragma unroll
        for (int br = 0; br < 2; ++br) { float M = NEGF;
#pragma unroll 8
            for (int w = 0; w < 32; ++w) M = fmaxf(M, pm[(br * 32 + w) * 4 + g]);
            float L = 0.f, O = 0.f;
#pragma unroll 8
            for (int w = 0; w < 32; ++w) { const float e = __expf(pm[(br * 32 + w) * 4 + g] - M); L += pl[(br * 32 + w) * 4 + g] * e; O += po[((br * 32 + w) * 4 + g) * 64 + d] * e; }
            res += sigmf(gates[1 + br]) * O / fmaxf(L, TINYF); }
        ((bf16*)(ws + WS_YATT))[m * 1024 + (hkv * 4 + g) * 64 + d] = (bf16)f2bf(res); }
    __syncthreads();
}

__device__ __forceinline__ void ffn_act_item(const Args& args, int item, int lane) {
    unsigned char* ws = args.ws; float* out = args.out;
    const bf16* U = (const bf16*)(ws + WS_U); bf16* ACT = (bf16*)(ws + WS_ACT);
    const float* cw = INF(32); const float* cb = INF(33); const float* st = INF(9);
    const int slab = item % 11, chunk = item / 11, row0 = chunk * 32, c4 = slab * 256 + lane * 4;
    f32x4 w[2][3], bia[2];
#pragma unroll
    for (int hf = 0; hf < 2; ++hf) { bia[hf] = *(const f32x4*)(cb + hf * DFF + c4);
#pragma unroll
        for (int k = 0; k < 3; ++k) w[hf][k] = *(const f32x4*)(cw + k * DFF2 + hf * DFF + c4); }
    if (row0 >= MP) {
        for (int r = 0; r < 32; ++r) { const int bs = row0 - MP + r; if (bs >= MS) break;
            f32x4 cu[2];
#pragma unroll
            for (int hf = 0; hf < 2; ++hf) { const int col = hf * DFF + c4;
                const f32x4 u0 = *(const f32x4*)(st + ((size_t)bs * 2 + 0) * DFF2 + col), u1 = *(const f32x4*)(st + ((size_t)bs * 2 + 1) * DFF2 + col), u2 = *(const f32x4*)(out + O_FFNS + ((size_t)bs * 2 + 1) * DFF2 + col);
                *(f32x4*)(out + O_FFNS + ((size_t)bs * 2 + 0) * DFF2 + col) = u1;
                cu[hf] = bia[hf] + w[hf][0] * u0 + w[hf][1] * u1 + w[hf][2] * u2; }
            u32x2 o; o.x = pk2(siluf(cu[0].x) * cu[1].x, siluf(cu[0].y) * cu[1].y); o.y = pk2(siluf(cu[0].z) * cu[1].z, siluf(cu[0].w) * cu[1].w);
            *(u32x2*)(ACT + (size_t)(row0 + r) * DFF + c4) = o; }
        return;
    }
    const int t0 = row0 & 4095;
    f32x4 p2[2], p1[2];
#pragma unroll
    for (int hf = 0; hf < 2; ++hf) { const int col = hf * DFF + c4;
        const u32x2 a = t0 >= 2 ? *(const u32x2*)(U + (size_t)(row0 - 2) * DFF2 + col) : (u32x2){0u, 0u}, b = t0 >= 1 ? *(const u32x2*)(U + (size_t)(row0 - 1) * DFF2 + col) : (u32x2){0u, 0u};
        p2[hf] = (f32x4){bflo(a.x), bfhi(a.x), bflo(a.y), bfhi(a.y)}; p1[hf] = (f32x4){bflo(b.x), bfhi(b.x), bflo(b.y), bfhi(b.y)}; }
#pragma unroll 1
    for (int rb = 0; rb < 32; rb += 8) {
        u32x2 v[8][2];
#pragma unroll
        for (int r = 0; r < 8; ++r)
#pragma unroll
            for (int hf = 0; hf < 2; ++hf) v[r][hf] = *(const u32x2*)(U + (size_t)(row0 + rb + r) * DFF2 + hf * DFF + c4);
#pragma unroll
        for (int r = 0; r < 8; ++r) {
            f32x4 cu[2];
#pragma unroll
            for (int hf = 0; hf < 2; ++hf) { const f32x4 u2 = (f32x4){bflo(v[r][hf].x), bfhi(v[r][hf].x), bflo(v[r][hf].y), bfhi(v[r][hf].y)};
                cu[hf] = bia[hf] + w[hf][0] * p2[hf] + w[hf][1] * p1[hf] + w[hf][2] * u2; p2[hf] = p1[hf]; p1[hf] = u2; }
            u32x2 o; o.x = pk2(siluf(cu[0].x) * cu[1].x, siluf(cu[0].y) * cu[1].y); o.y = pk2(siluf(cu[0].z) * cu[1].z, siluf(cu[0].w) * cu[1].w);
            *(u32x2*)(ACT + (size_t)(row0 + rb + r) * DFF + c4) = o;
        }
    }
}
template <int KTOT>
__device__ __forceinline__ f32x4 skinny_acc(const bf16* A, int lda, const bf16* Bt, int ldb, int wave, int ct, int q, int r16) {
    const bf16* ap = A + (size_t)(16 * wave + r16) * lda + 8 * q;
    const bf16* bp = Bt + (size_t)(16 * ct + r16) * ldb + 8 * q;
    f32x4 acc = (f32x4){0.f, 0.f, 0.f, 0.f};
#pragma unroll 1
    for (int k0 = 0; k0 < KTOT; k0 += 256) {
        bf16x8 af[8], bf[8];
#pragma unroll
        for (int i = 0; i < 8; ++i) { af[i] = *(const bf16x8*)(ap + k0 + 32 * i); bf[i] = *(const bf16x8*)(bp + k0 + 32 * i); }
#pragma unroll
        for (int i = 0; i < 8; ++i) acc = MFMA16(af[i], bf[i], acc);
    }
    return acc;
}
template <int WHICH>
__device__ __forceinline__ void skinny_sample_unit(const Args& args, int ct, int wave, int lane) {
    unsigned char* ws = args.ws;
    const int q = lane >> 4, r16 = lane & 15, col = 16 * ct + r16;
    if (WHICH == 0) {
        const f32x4 a1 = skinny_acc<2048>((const bf16*)(ws + WS_YSSM) + (size_t)MP * 2048, 2048, (const bf16*)(ws + WS_WSSM), 2048, wave, ct, q, r16);
        const f32x4 a2 = skinny_acc<1024>((const bf16*)(ws + WS_YATT) + (size_t)MP * 1024, 1024, (const bf16*)(ws + WS_WATT), 1024, wave, ct, q, r16);
#pragma unroll
        for (int r = 0; r < 4; ++r) { const size_t row = MP + 16 * wave + 4 * q + r;
            const f32x4 sq = *(const f32x4*)((const float*)(ws + WS_SSQ) + row * 4);
            const float rstd = 1.f / sqrtf(((sq.x + sq.y) + (sq.z + sq.w)) * (1.f / 2048.f) + EPS);
            const bf16* mg = (const bf16*)(ws + WS_MG) + row * 2048;
            const float v = sigmf(bf2f(mg[col])) * rstd * a1[r] + sigmf(bf2f(mg[1024 + col])) * a2[r];
            ((bf16*)(ws + WS_MERGED))[row * 1024 + col] = (bf16)f2bf(v); }
    } else if (WHICH == 1) {
        const f32x4 a = skinny_acc<1024>((const bf16*)(ws + WS_MERGED) + (size_t)MP * 1024, 1024, (const bf16*)(ws + WS_WOUT), 1024, wave, ct, q, r16);
#pragma unroll
        for (int r = 0; r < 4; ++r) { const int bs = 16 * wave + 4 * q + r;
            ((float*)(ws + WS_X1))[(size_t)(MP + bs) * 1024 + col] = INF(1)[(size_t)bs * 1024 + col] + ((const float*)(ws + WS_MOD))[(size_t)(4 + bs) * 6144 + 2048 + col] * a[r]; }
    } else {
        const f32x4 a = skinny_acc<DFF>((const bf16*)(ws + WS_ACT) + (size_t)MP * DFF, DFF, (const bf16*)(ws + WS_WDN), DFF, wave, ct, q, r16);
#pragma unroll
        for (int r = 0; r < 4; ++r) { const int bs = 16 * wave + 4 * q + r; float* x = (float*)(ws + WS_X1) + (size_t)(MP + bs) * 1024 + col;
            *x = *x + ((const float*)(ws + WS_MOD))[(size_t)(4 + bs) * 6144 + 5120 + col] * a[r]; }
    }
}
constexpr int N_PHASES = 15;
#ifndef MK_PER_PHASE
#define MK_PER_PHASE 0
#endif

__global__ void __launch_bounds__(NTHR, 2) fwd_kernel(Args args) {
    extern __shared__ __attribute__((aligned(16))) unsigned char lds_raw[];
    LAS unsigned char* lds = (LAS unsigned char*)lds_raw;
    const int tid = threadIdx.x, lane = tid & 63, wave = __builtin_amdgcn_readfirstlane(tid >> 6);
    const int G = gridDim.x, bid = blockIdx.x, gw = bid * NWAVES + wave, NGW = G * NWAVES, gt = bid * NTHR + tid, NGT = G * NTHR;
    unsigned char* ws = args.ws;
    for (int u = tid; u < (LDS_BYTES - LDSCTL_OFF) / 4; u += NTHR) ((LAS unsigned*)(lds + LDSCTL_OFF))[u] = 0u;
    __syncthreads();
    XcdBarrier bar; bar.bar = (unsigned*)(ws + WS_CTL) + CW_BAR; bar.x = 0; bar.st = nullptr;
    if (!MK_PER_PHASE) bar = xcd_barrier_post((unsigned*)(ws + WS_CTL) + CW_BAR, (volatile LAS unsigned*)(lds + MISC_OFF) + 8);
    const int lo = args.ph_lo, hi = args.ph_hi;
#ifndef PHASE_MASK
#define PHASE_MASK 0x7fff
#endif
#define IN(k) ((((PHASE_MASK) >> (k)) & 1) && lo <= (k) && (k) < hi)
#define SEAM(k) do { if (IN(k) && IN((k) + 1)) xcd_barrier(bar); } while (0)
    using pg8::Gemm; using pg8::StaticOrder;

    if (IN(0)) { { p0_prologue(args, lds, gw, NGW, lane, wave); } }
    SEAM(0);
    if (IN(1)) { {
        Gemm g{(const bf16*)(ws + WS_SC), (const bf16*)(ws + WS_WADA), 256, 6144, 1024}; StaticOrder S; S.init(256, 6144, G, bid);
        pg8::EpiF32 E{(float*)(ws + WS_MOD), 6144, INF(11)};
        pg8::gemm_phase<pg8::EpiF32, StaticOrder, true, true>(lds, g, S, E);
    } }
    SEAM(1);
    if (IN(2)) { { norm_mod_phase<0>(args, gw, NGW, lane); } }
    SEAM(2);
    if (IN(3)) { {
        Gemm g{(const bf16*)(ws + WS_H), (const bf16*)(ws + WS_WIN), MPAD, NPROJ, 1024}; StaticOrder S; S.init(MPAD, NPROJ, G, bid);
        epi::InProj E{ws, args.out};
        pg8::gemm_phase<epi::InProj, StaticOrder, true, true>(lds, g, S, E);
    } }
    SEAM(3);
    if (IN(4)) { {
        const int p4 = args.p7mask >> 8;
        if (p4 & 1) for (int u = bid; u < 1024; u += G) sample_compress_unit(args, lds, u, tid, wave, lane);
        if (p4 & 2) {
        { Gemm g{(const bf16*)(ws + WS_KVH), (const bf16*)(ws + WS_W1K), 4096, 256, 1024}; StaticOrder S; S.init(4096, 256, G, bid);
          epi::PartBf16 E{(bf16*)(ws + WS_PARTK)}; pg8::gemm_phase<epi::PartBf16, StaticOrder, true, true>(lds, g, S, E); }
        { Gemm g{(const bf16*)(ws + WS_KVH) + (size_t)16 * 4096 * 64, (const bf16*)(ws + WS_W1V), 4096, 256, 1024}; StaticOrder S; S.init(4096, 256, G, (bid + G - 16) % G);
          epi::PartBf16 E{(bf16*)(ws + WS_PARTV)}; pg8::gemm_phase<epi::PartBf16, StaticOrder, true, true>(lds, g, S, E); }
        }
        if (p4 & 4) {
            if (G == 256) { if (bid >= 32) for (int it = gw - 32 * NWAVES; it < 256 * 48; it += NGW - 32 * NWAVES) conv_prompt_item(args, it, lane); }
            else for (int it = gw; it < 256 * 48; it += NGW) conv_prompt_item(args, it, lane);
        }
        if (p4 & 8) { for (int it = gw; it < 4096; it += NGW) dtcs_item(args, it, lane);
            sample_conv(args, gt, NGT); }
    } }
    SEAM(4);
    if (IN(5)) { {
        const int p5 = args.p7mask >> 4;
#ifdef SELFCHECK
        check_sample_compress(args, lds, bid, tid);
#endif
        if (p5 & 1) for (int u = bid; u < 512; u += G) ssd_states_unit(args, lds, u, wave, lane);
        if (p5 & 2) for (int it = gw; it < 2 * (4096 / 16); it += NGW) compress2_item<0>(args, it, lane);
        if (p5 & 4) for (int it = gw; it < MS * NH; it += NGW) sample_ssm_item(args, lds, it, wave, lane);
    } }
    SEAM(5);
    if (IN(6)) { { scan_phase(args, gt, NGT); } }
    SEAM(6);
    if (IN(7)) { {
#ifndef P7C
#define P7C 7
#endif
        const int p7 = args.p7mask & (P7C);
        if (p7 & 1) for (int u = bid; u < 512; u += G) ssd_out_unit(args, lds, u, wave, lane, tid);
        if (p7 & 2) for (int u = gw; u < 4096; u += NGW) attn_prompt_unit(args, (LAS float*)(lds + wave * 12288), u, NGW == 2048, lane);
        __syncthreads();
        if (p7 & 4) for (int u = bid; u < 512; u += G) attn_sample_unit(args, lds, u, tid, wave, lane);
    } }
    SEAM(7);
    if (IN(8)) { {
        for (int u = bid; u < 64; u += G) skinny_sample_unit<0>(args, u, wave, lane);
        { Gemm g{(const bf16*)(ws + WS_YSSM), (const bf16*)(ws + WS_WSSM), MP, 1024, 2048}; StaticOrder S; S.init(MP, 1024, G, bid);
          epi::Merge1 E{ws}; pg8::gemm_phase<epi::Merge1, StaticOrder, true, true>(lds, g, S, E); }
        { Gemm g{(const bf16*)(ws + WS_YATT), (const bf16*)(ws + WS_WATT), MP, 1024, 1024}; StaticOrder S; S.init(MP, 1024, G, bid);
          epi::Merge2 E{ws}; pg8::gemm_phase<epi::Merge2, StaticOrder, true, true>(lds, g, S, E); }
    } }
    SEAM(8);
    if (IN(9)) { {
        for (int u = bid; u < 64; u += G) skinny_sample_unit<1>(args, u, wave, lane);
        Gemm g{(const bf16*)(ws + WS_MERGED), (const bf16*)(ws + WS_WOUT), MP, 1024, 1024}; StaticOrder S; S.init(MP, 1024, G, bid);
        epi::Resid E{INF(0), INF(1), nullptr, (float*)(ws + WS_X1), (const float*)(ws + WS_MOD), 2048};
        pg8::gemm_phase<epi::Resid, StaticOrder, true, true>(lds, g, S, E);
    } }
    SEAM(9);
    if (IN(10)) { { norm_mod_phase<1>(args, gw, NGW, lane); } }
    SEAM(10);
    if (IN(11)) { {
        Gemm g{(const bf16*)(ws + WS_H), (const bf16*)(ws + WS_WUP), MPAD, DFF2, 1024}; StaticOrder S; S.init(MPAD, DFF2, G, bid);
        epi::Up E{ws, args.out};
        pg8::gemm_phase<epi::Up, StaticOrder, true, true>(lds, g, S, E);
    } }
    SEAM(11);
    if (IN(12)) { { for (int it = gw; it < (MPAD / 32) * 11; it += NGW) ffn_act_item(args, it, lane); } }
    SEAM(12);
    if (IN(13)) { {
        for (int u = bid; u < 64; u += G) skinny_sample_unit<2>(args, u, wave, lane);
        Gemm g{(const bf16*)(ws + WS_ACT), (const bf16*)(ws + WS_WDN), MP, 1024, DFF}; StaticOrder S; S.init(MP, 1024, G, bid);
        epi::Resid E{INF(0), INF(1), (const float*)(ws + WS_X1), (float*)(ws + WS_X1), (const float*)(ws + WS_MOD), 5120};
        pg8::gemm_phase<epi::Resid, StaticOrder, true, true>(lds, g, S, E);
    } }
    SEAM(13);
    if (IN(14)) { { norm_mod_phase<2>(args, gw, NGW, lane); } }
#ifdef SELFCHECK
    if (IN(14) && bid == 0 && tid == 0 && ((volatile unsigned*)(ws + WS_CTL))[8] != 0u) args.out[O_YS] = __builtin_nanf("");
#endif
#undef IN
#undef SEAM
}

extern "C" void kernel_launch(void* const* d_in, const int* in_sizes, int n_in, void* d_out, int out_size, void* d_ws, size_t ws_size, hipStream_t stream) {
    static int grid = 0;
    if (grid == 0) {
        if (n_in != 35 || out_size != (int)O_END || ws_size < WS_END) { fprintf(stderr, "kernel_launch: unexpected shapes (n_in %d out %d ws %zu, need %zu)\n", n_in, out_size, ws_size, (size_t)WS_END); grid = -1; return; }
        int dev = 0, cus = 0, per_cu = 0;
        if (hipGetDevice(&dev) != hipSuccess || hipDeviceGetAttribute(&cus, hipDeviceAttributeMultiprocessorCount, dev) != hipSuccess) { grid = -1; return; }
        if (hipFuncSetAttribute((const void*)fwd_kernel, hipFuncAttributeMaxDynamicSharedMemorySize, LDS_BYTES) != hipSuccess) { fprintf(stderr, "kernel_launch: hipFuncSetAttribute failed\n"); grid = -1; return; }
        if (hipOccupancyMaxActiveBlocksPerMultiprocessor(&per_cu, (const void*)fwd_kernel, NTHR, LDS_BYTES) != hipSuccess || per_cu < 1) { fprintf(stderr, "kernel_launch: occupancy query says %d\n", per_cu); }
        (void)hipGetLastError();
        grid = cus;
    }
    if (grid < 0) return;
    (void)hipMemsetAsync((char*)d_ws + WS_CTL, 0, CTL_ZERO_BYTES, stream);
    Args a{};
    for (int i = 0; i < 35; ++i) a.in[i] = d_in[i];
    a.out = (float*)d_out; a.ws = (unsigned char*)d_ws;
    a.p7mask = 0xFFF; a.pad = 7;
#if MK_PER_PHASE
    for (int p = 0; p < N_PHASES; ++p) { a.ph_lo = p; a.ph_hi = p + 1; hipLaunchKernelGGL(fwd_kernel, dim3(grid), dim3(NTHR), LDS_BYTES, stream, a); }
#else
    a.ph_lo = 0; a.ph_hi = N_PHASES;
    hipLaunchKernelGGL(fwd_kernel, dim3(grid), dim3(NTHR), LDS_BYTES, stream, a);
#endif
#ifdef PROBE_LO
    a.ph_lo = PROBE_LO; a.ph_hi = PROBE_HI; a.p7mask = PROBE_P7MASK; a.pad = PROBE_P7MASK;
    hipLaunchKernelGGL(fwd_kernel, dim3(grid), dim3(NTHR), LDS_BYTES, stream, a);
#endif
}
```

```cpp
#include <hip/hip_runtime.h>
#include <cstdio>
#include <cstdint>
namespace pg8 {
#define PG8_LAS __attribute__((address_space(3)))
typedef unsigned short bf16_t;
typedef short bf16x8 __attribute__((ext_vector_type(8)));
typedef float f32x4 __attribute__((ext_vector_type(4)));
typedef unsigned u32x4 __attribute__((ext_vector_type(4)));
constexpr int BM = 256, BK = 64, HALF = 128, HTB = HALF * BK * 2  , STAGE_BYTES = 8 * HTB, NXCD = 8, WGM = 8;

__host__ __device__ __forceinline__ int lds_byte(int r, int c) { const int st = (r >> 4) * 2 + (c >> 5), rr = r & 15, cc = c & 31, ob = rr * 64 + cc * 2; return st * 1024 + (ob ^ (((ob >> 9) & 1) << 5)); }
__host__ __device__ __forceinline__ void stage_rc(int b, int& R, int& C) { const int st = b / 1024, sb = b % 1024, swz = sb ^ (((sb >> 9) & 1) << 5); R = (st >> 1) * 16 + swz / 64; C = (st & 1) * 32 + (swz % 64) / 2; }
__host__ __device__ __forceinline__ int perm32(int rho) { const int n = rho >> 4, i = rho & 15; return 8 * (i >> 2) + 4 * n + (i & 3); }

struct Unit { int pm, pn; };
struct Gemm { const bf16_t* A; const bf16_t* Bt; int M, N, K; };

struct StaticOrder {
    int nM, nN, nwg, G, c;
    __host__ __device__ void init(int M, int N, int G_, int c_) { nM = M / BM; nN = N / BM; nwg = nM * nN; G = G_; c = c_; }
    __host__ __device__ bool next(int i, Unit& u) const {
        const long L = (long)i * G + c; if (L >= nwg) return false;
        int wgid = (int)L; { const int q = nwg / NXCD, r = nwg % NXCD, xcd = wgid % NXCD, off = wgid / NXCD; wgid = (xcd < r ? xcd * (q + 1) : r * (q + 1) + (xcd - r) * q) + off; }
        const int nig = WGM * nN, gid = wgid / nig, fm = gid * WGM, gsz = (nM - fm) < WGM ? (nM - fm) : WGM;
        u.pm = fm + ((wgid % nig) % gsz); u.pn = (wgid % nig) / gsz; return true;
    }
    __device__ __forceinline__ void a_ready(const Unit&) const {}
    __device__ __forceinline__ void done(const Unit&) const {}
};
__device__ __forceinline__ unsigned cvt_pk_bf16(float lo, float hi) { unsigned r; asm volatile("v_cvt_pk_bf16_f32 %0, %1, %2" : "=v"(r) : "v"(lo), "v"(hi)); return r; }
typedef float f32x2 __attribute__((ext_vector_type(2)));
struct EpiF32 {
    static constexpr bool PERM = false, AFTER_DRAIN = false;
    float* C; int ldc; const float* bias;
    __device__ __forceinline__ void operator()(const f32x4 (&acc)[2][2][4][2], const Unit& u, int wr, int wc, int fr, int fq) const {
        const int row0 = u.pm * BM + wr * 64 + fr, col0 = u.pn * BM + wc * 32 + 4 * fq;
        f32x4 bv[2][2];
#pragma unroll
        for (int bj = 0; bj < 2; ++bj)
#pragma unroll
            for (int n = 0; n < 2; ++n) bv[bj][n] = bias ? *(const f32x4*)(bias + col0 + bj * HALF + n * 16) : (f32x4){0.f, 0.f, 0.f, 0.f};
#pragma unroll
        for (int ai = 0; ai < 2; ++ai)
#pragma unroll
            for (int m = 0; m < 4; ++m) { float* rowp = C + (size_t)(row0 + ai * HALF + m * 16) * ldc + col0;
#pragma unroll
                for (int bj = 0; bj < 2; ++bj)
#pragma unroll
                    for (int n = 0; n < 2; ++n) *(f32x4*)(rowp + bj * HALF + n * 16) = acc[ai][bj][m][n] + bv[bj][n]; }
    }
};
template <class Epi, class Sched, bool ALIGN_EPI = false, bool SP2 = false>
__device__ __forceinline__ void gemm_phase(PG8_LAS unsigned char* lds, const Gemm g, const Sched& S, const Epi& E) {
    const int tid = threadIdx.x, wid = __builtin_amdgcn_readfirstlane(tid >> 6), lane = tid & 63, wr = wid >> 2, wc = wid & 3, fr = lane & 15, fq = lane >> 4;
    const int K = g.K, nt = K / BK;
    unsigned voffA[2], voffB[2];
#pragma unroll
    for (int i = 0; i < 2; ++i) { int R, C; stage_rc(tid * 16 + i * 8192, R, C); const int Rb = Epi::PERM ? ((R & ~31) + perm32(R & 31)) : R;
        voffA[i] = (unsigned)(R * K + C) * 2u; voffB[i] = (unsigned)(Rb * K + C) * 2u; }
    const size_t kstep = (size_t)(BK * 2);
    const size_t hstep = (size_t)HALF * K * 2;
    const size_t tstep = 2 * hstep;
    const unsigned ldsw = (unsigned)wid * 1024u;
    const int aoff = lds_byte(wr * 64 + fr, fq * 8), boff = lds_byte(wc * 32 + fr, fq * 8);
#define PG8_SA(b, h) (((b) * 2 + (h)) * HTB)
#define PG8_SB(b, h) ((4 + (b) * 2 + (h)) * HTB)
#define PG8_STAGE(bufoff, gbase, voff) do { _Pragma("unroll") for (int _i = 0; _i < 2; ++_i) \
        __builtin_amdgcn_global_load_lds((const unsigned*)((const char*)(gbase) + (voff)[_i]), (PG8_LAS unsigned*)(lds + (bufoff) + ldsw + _i * 8192), 16, 0, 0); } while (0)
#define PG8_LDA(dst, b, h) do { _Pragma("unroll") for (int m = 0; m < 4; ++m) _Pragma("unroll") for (int k = 0; k < 2; ++k) dst[m][k] = *(const PG8_LAS bf16x8*)(lds + PG8_SA(b, h) + aoff + m * 2048 + k * 1024); } while (0)
#define PG8_LDB(dst, b, h) do { _Pragma("unroll") for (int n = 0; n < 2; ++n) _Pragma("unroll") for (int k = 0; k < 2; ++k) dst[n][k] = *(const PG8_LAS bf16x8*)(lds + PG8_SB(b, h) + boff + n * 2048 + k * 1024); } while (0)
#define PG8_MMA(ai, bj, At, Bt) do { __builtin_amdgcn_s_setprio(1); _Pragma("unroll") for (int m = 0; m < 4; ++m) _Pragma("unroll") for (int n = 0; n < 2; ++n) _Pragma("unroll") for (int k = 0; k < 2; ++k) \
        acc[ai][bj][m][n] = __builtin_amdgcn_mfma_f32_16x16x32_bf16(Bt[n][k], At[m][k], acc[ai][bj][m][n], 0, 0, 0); __builtin_amdgcn_s_setprio(0); } while (0)
#define PG8_WAIT_V(n) asm volatile("s_waitcnt vmcnt(" #n ")" ::: "memory")
#define PG8_WAIT_L(n) asm volatile("s_waitcnt lgkmcnt(" #n ")" ::: "memory")
#define PG8_BAR __builtin_amdgcn_s_barrier()
#define PG8_SCHED __builtin_amdgcn_sched_barrier(0)
    Unit cur, nxt; int ui = 0;
    if (!S.next(0, cur)) return;
    f32x4 acc[2][2][4][2];
#pragma unroll
    for (int a = 0; a < 2; ++a)
#pragma unroll
        for (int b = 0; b < 2; ++b)
#pragma unroll
            for (int m = 0; m < 4; ++m)
#pragma unroll
                for (int n = 0; n < 2; ++n) acc[a][b][m][n] = (f32x4){0.f, 0.f, 0.f, 0.f};
    bf16x8 At[4][2], B0[2][2], B1[2][2];
    const char* cA = (const char*)g.A + (size_t)cur.pm * tstep; const char* cB = (const char*)g.Bt + (size_t)cur.pn * tstep;
    S.a_ready(cur);
    if constexpr (SP2) {
        PG8_STAGE(PG8_SB(0, 0), cB, voffB); PG8_STAGE(PG8_SB(0, 1), cB + hstep, voffB); PG8_STAGE(PG8_SA(0, 0), cA, voffA); PG8_STAGE(PG8_SA(0, 1), cA + hstep, voffA);
        if (wr == 1) PG8_BAR;
        PG8_WAIT_V(2); PG8_BAR;
        PG8_STAGE(PG8_SB(1, 0), cB + kstep, voffB); PG8_STAGE(PG8_SA(1, 0), cA + kstep, voffA); PG8_STAGE(PG8_SB(1, 1), cB + hstep + kstep, voffB);
        PG8_WAIT_V(6); PG8_BAR;
    } else {
        PG8_STAGE(PG8_SB(0, 0), cB, voffB); PG8_STAGE(PG8_SA(0, 0), cA, voffA); PG8_STAGE(PG8_SB(0, 1), cB + hstep, voffB); PG8_STAGE(PG8_SA(0, 1), cA + hstep, voffA);
        if (wr == 1) PG8_BAR;
        PG8_WAIT_V(4); PG8_BAR;
        PG8_STAGE(PG8_SB(1, 0), cB + kstep, voffB); PG8_STAGE(PG8_SA(1, 0), cA + kstep, voffA); PG8_STAGE(PG8_SB(1, 1), cB + hstep + kstep, voffB);
        PG8_WAIT_V(6); PG8_BAR;
    }
    for (;;) {
        const bool has_next = S.next(ui + 1, nxt);
        const char* nA = has_next ? (const char*)g.A + (size_t)nxt.pm * tstep : cA; const char* nB = has_next ? (const char*)g.Bt + (size_t)nxt.pn * tstep : cB;
        for (int t = 0; t < nt; t += 2) {
            const bool last = (t == nt - 2);
            const char* a1 = cA + (size_t)(t + 1) * kstep;
            const char* a2 = last ? nA : cA + (size_t)(t + 2) * kstep; const char* b2 = last ? nB : cB + (size_t)(t + 2) * kstep;
            const char* a3 = a2 + kstep; const char* b3 = b2 + kstep;
            if (last && has_next) S.a_ready(nxt);
            if constexpr (SP2) {
            PG8_LDB(B0, 0, 0); PG8_LDB(B1, 0, 1); PG8_SCHED; PG8_LDA(At, 0, 0); PG8_STAGE(PG8_SA(1, 1), a1 + hstep, voffA);
            PG8_WAIT_V(8); PG8_WAIT_L(0); PG8_BAR; PG8_MMA(0, 0, At, B0); PG8_MMA(0, 1, At, B1); PG8_BAR; PG8_SCHED;
            PG8_LDA(At, 0, 1); PG8_STAGE(PG8_SB(0, 0), b2, voffB); PG8_STAGE(PG8_SB(0, 1), b2 + hstep, voffB); PG8_STAGE(PG8_SA(0, 0), a2, voffA);
            PG8_WAIT_V(8); PG8_WAIT_L(0); PG8_BAR; PG8_MMA(1, 0, At, B0); PG8_MMA(1, 1, At, B1); PG8_BAR; PG8_SCHED;
            PG8_LDB(B0, 1, 0); PG8_LDB(B1, 1, 1); PG8_SCHED; PG8_LDA(At, 1, 0); PG8_STAGE(PG8_SA(0, 1), a2 + hstep, voffA);
            PG8_WAIT_V(8); PG8_WAIT_L(0); PG8_BAR; PG8_MMA(0, 0, At, B0); PG8_MMA(0, 1, At, B1); PG8_BAR; PG8_SCHED;
            PG8_LDA(At, 1, 1); PG8_STAGE(PG8_SB(1, 0), b3, voffB); PG8_STAGE(PG8_SB(1, 1), b3 + hstep, voffB); PG8_STAGE(PG8_SA(1, 0), a3, voffA);
            PG8_WAIT_V(8); PG8_WAIT_L(0); PG8_BAR; PG8_MMA(1, 0, At, B0); PG8_MMA(1, 1, At, B1); PG8_BAR; PG8_SCHED;
            } else {
            PG8_LDB(B0, 0, 0); PG8_SCHED; PG8_LDA(At, 0, 0); PG8_STAGE(PG8_SA(1, 1), a1 + hstep, voffA);
            PG8_WAIT_L(8); PG8_BAR; PG8_WAIT_L(0); PG8_MMA(0, 0, At, B0); PG8_BAR; PG8_SCHED;
            PG8_LDB(B1, 0, 1); PG8_STAGE(PG8_SB(0, 0), b2, voffB);
            PG8_BAR; PG8_WAIT_L(0); PG8_MMA(0, 1, At, B1); PG8_BAR;
            PG8_LDA(At, 0, 1); PG8_STAGE(PG8_SA(0, 0), a2, voffA);
            PG8_BAR; PG8_WAIT_L(0); PG8_MMA(1, 0, At, B0); PG8_BAR; PG8_SCHED;
            PG8_STAGE(PG8_SB(0, 1), b2 + hstep, voffB);
            PG8_WAIT_V(6); PG8_BAR; PG8_MMA(1, 1, At, B1); PG8_BAR;
            PG8_LDB(B0, 1, 0); PG8_SCHED; PG8_LDA(At, 1, 0); PG8_STAGE(PG8_SA(0, 1), a2 + hstep, voffA);
            PG8_WAIT_L(8); PG8_BAR; PG8_WAIT_L(0); PG8_MMA(0, 0, At, B0); PG8_BAR; PG8_SCHED;
            PG8_LDB(B1, 1, 1); PG8_STAGE(PG8_SB(1, 0), b3, voffB);
            PG8_BAR; PG8_WAIT_L(0); PG8_MMA(0, 1, At, B1); PG8_BAR;
            PG8_LDA(At, 1, 1); PG8_STAGE(PG8_SA(1, 0), a3, voffA);
            PG8_BAR; PG8_WAIT_L(0); PG8_MMA(1, 0, At, B0); PG8_BAR; PG8_SCHED;
            PG8_STAGE(PG8_SB(1, 1), b3 + hstep, voffB);
            PG8_WAIT_V(6); PG8_BAR; PG8_MMA(1, 1, At, B1); PG8_BAR;
            }
        }
        if constexpr (ALIGN_EPI) { if (wr == 0) PG8_BAR; }
        if constexpr (!Epi::AFTER_DRAIN) { E(acc, cur, wr, wc, fr, fq); S.done(cur); }
        if (!has_next) break;
#pragma unroll
        for (int a = 0; a < 2; ++a)
#pragma unroll
            for (int b = 0; b < 2; ++b)
#pragma unroll
                for (int m = 0; m < 4; ++m)
#pragma unroll
                    for (int n = 0; n < 2; ++n) acc[a][b][m][n] = (f32x4){0.f, 0.f, 0.f, 0.f};
        cur = nxt; cA = nA; cB = nB; ++ui;
        if constexpr (ALIGN_EPI) { if (wr == 1) PG8_BAR; }
    }
    PG8_WAIT_V(0);
    if constexpr (!ALIGN_EPI) { if (wr == 0) PG8_BAR; }
    PG8_BAR;
    if constexpr (Epi::AFTER_DRAIN) { E.fused(acc, cur, wr, wc, fr, fq, lds, wid, lane); S.done(cur); }
#undef PG8_SA
#undef PG8_SB
#undef PG8_STAGE
#undef PG8_LDA
#undef PG8_LDB
#undef PG8_MMA
#undef PG8_WAIT_V
#undef PG8_WAIT_L
#undef PG8_BAR
#undef PG8_SCHED
}
}
#define GAS __attribute__((address_space(1)))
#define LAS __attribute__((address_space(3)))
typedef unsigned short bf16;
typedef float f32x4 __attribute__((ext_vector_type(4)));
typedef float f32x2 __attribute__((ext_vector_type(2)));
typedef short bf16x8 __attribute__((ext_vector_type(8)));
typedef short bf16x4 __attribute__((ext_vector_type(4)));
typedef unsigned u32x4 __attribute__((ext_vector_type(4)));
typedef unsigned u32x2 __attribute__((ext_vector_type(2)));
#define MFMA16(a, b, c) __builtin_amdgcn_mfma_f32_16x16x32_bf16((a), (b), (c), 0, 0, 0)

constexpr int NWAVES = 8, NTHR = 512;
constexpr int DM = 1024, SEQ = 4096, NB = 4, MP = NB * SEQ, MS = 128, MALL = MP + MS, MPAD = 16640;
constexpr int DI = 2048, CONVD = 3072, NH = 32, NG = 4, NST = 128;
constexpr int NPROJ = 9984;
constexpr int DFF = 2816, DFF2 = 5632;
constexpr int NPAGES = 16, PAST = 2048;
constexpr float EPS = 1e-6f, NEGF = -1e30f, BIGF = 1e30f, TINYF = 1e-30f;
constexpr int T_Z = 0, T_XBC = 8, T_Q = 20, T_KV = 24, T_MG = 30, T_MISC = 38;

constexpr size_t O_YP = 0;
constexpr size_t O_YS = O_YP + (size_t)MP * DM;
constexpr size_t O_KVP = O_YS + (size_t)MS * DM;
constexpr size_t O_KVS = O_KVP + (size_t)MP * 1024;
constexpr size_t O_WINP = O_KVS + (size_t)MS * 1024;
constexpr size_t O_WINS = O_WINP + (size_t)NB * 512 * 512;
constexpr size_t O_SSMP = O_WINS + (size_t)MS * 512 * 512;
constexpr size_t O_SSMS = O_SSMP + (size_t)NB * NH * 64 * 128;
constexpr size_t O_CONVP = O_SSMS + (size_t)MS * NH * 64 * 128;
constexpr size_t O_CONVS = O_CONVP + (size_t)NB * 3 * CONVD;
constexpr size_t O_FFNP = O_CONVS + (size_t)MS * 3 * CONVD;
constexpr size_t O_FFNS = O_FFNP + (size_t)NB * 2 * DFF2;
constexpr size_t O_END = O_FFNS + (size_t)MS * 2 * DFF2;
static_assert(O_END == 105725952, "output size");

constexpr size_t al256(size_t x) { return (x + 255) & ~(size_t)255; }
constexpr size_t WS_CTL = 0, CTL_ZERO_BYTES = 1u << 20;
constexpr size_t WS_WIN = CTL_ZERO_BYTES;
constexpr size_t WS_WSSM = WS_WIN + al256((size_t)NPROJ * 1024 * 2);
constexpr size_t WS_WATT = WS_WSSM + al256((size_t)1024 * 2048 * 2);
constexpr size_t WS_WOUT = WS_WATT + al256((size_t)1024 * 1024 * 2);
constexpr size_t WS_WUP = WS_WOUT + al256((size_t)1024 * 1024 * 2);
constexpr size_t WS_WDN = WS_WUP + al256((size_t)DFF2 * 1024 * 2);
constexpr size_t WS_WADA = WS_WDN + al256((size_t)1024 * DFF * 2);
constexpr size_t WS_W1K = WS_WADA + al256((size_t)6144 * 1024 * 2);
constexpr size_t WS_W1V = WS_W1K + al256((size_t)256 * 1024 * 2);
constexpr size_t WS_SC = WS_W1V + al256((size_t)256 * 1024 * 2);
constexpr size_t WS_MOD = WS_SC + al256((size_t)256 * 1024 * 2);
constexpr size_t WS_ROPE = WS_MOD + al256((size_t)256 * 6144 * 4);
constexpr size_t WS_PET = WS_ROPE + al256((size_t)4096 * 16 * 4);
constexpr size_t WS_H = WS_PET + al256(2 * 128 * 4);
constexpr size_t WS_Z = WS_H + al256((size_t)MPAD * 1024 * 2);
constexpr size_t WS_XBC = WS_Z + al256((size_t)MPAD * 2048 * 2);
constexpr size_t WS_Q = WS_XBC + al256((size_t)MPAD * 3072 * 2);
constexpr size_t WS_MG = WS_Q + al256((size_t)MPAD * 1024 * 2);
constexpr size_t WS_MISC = WS_MG + al256((size_t)MPAD * 2048 * 2);
constexpr size_t WS_KVH = WS_MISC + al256((size_t)MPAD * 128 * 4);
constexpr size_t WS_VT = WS_KVH + al256((size_t)6 * 16 * 4096 * 64 * 2);
constexpr size_t WS_XT = WS_VT + al256((size_t)2 * 16 * 64 * 4096 * 2);
constexpr size_t WS_BN = WS_XT + al256((size_t)4 * 32 * 64 * 4096 * 2);
constexpr size_t WS_CN = WS_BN + al256((size_t)16 * 4096 * 128 * 2);
constexpr size_t WS_BT = WS_CN + al256((size_t)16 * 4096 * 128 * 2);
constexpr size_t WS_DT = WS_BT + al256((size_t)16 * 4096 * 128 * 2);
constexpr size_t WS_CS = WS_DT + al256((size_t)128 * 4096 * 4);
constexpr size_t WS_STATES = WS_CS + al256((size_t)128 * 4096 * 4);
constexpr size_t WS_HPREV = WS_STATES + al256((size_t)4096 * 8192 * 4);
constexpr size_t WS_YSSM = WS_HPREV + al256((size_t)4096 * 8192 * 2);
constexpr size_t WS_SSQ = WS_YSSM + al256((size_t)MPAD * 2048 * 2);
constexpr size_t WS_PARTK = WS_SSQ + al256((size_t)MPAD * 4 * 4);
constexpr size_t WS_PARTV = WS_PARTK + al256((size_t)4096 * 256 * 4);
constexpr size_t WS_KC = WS_PARTV + al256((size_t)4096 * 256 * 4);
constexpr size_t WS_VCT = WS_KC + al256((size_t)16 * 256 * 64 * 2);
constexpr size_t WS_YATTF = WS_VCT + al256((size_t)16 * 256 * 64 * 2);
constexpr size_t WS_YATT = WS_YATTF + al256((size_t)MPAD * 1024 * 4);
constexpr size_t WS_TMPM = WS_YATT + al256((size_t)MPAD * 1024 * 2);
constexpr size_t WS_MERGED = WS_TMPM + al256((size_t)MPAD * 1024 * 4);
constexpr size_t WS_X1 = WS_MERGED + al256((size_t)MPAD * 1024 * 2);
constexpr size_t WS_U = WS_X1 + al256((size_t)MPAD * 1024 * 4);
constexpr size_t WS_ACT = WS_U + al256((size_t)MPAD * DFF2 * 2);
constexpr size_t WS_CKB = WS_ACT + al256((size_t)MPAD * DFF * 2);
constexpr size_t WS_CVB = WS_CKB + al256((size_t)128 * 4 * 2048 * 64 * 2);
constexpr size_t WS_PARTSK = WS_CVB + al256((size_t)128 * 4 * 2048 * 64 * 2);
constexpr size_t WS_PARTSV = WS_PARTSK + al256((size_t)65536 * 256 * 4);
constexpr size_t WS_KCS = WS_PARTSV + al256((size_t)65536 * 256 * 4);
constexpr size_t WS_VCS = WS_KCS + al256((size_t)128 * 4 * 128 * 64 * 4);
constexpr size_t WS_XCS = WS_VCS + al256((size_t)128 * 4 * 128 * 64 * 4);
constexpr size_t WS_DTS = WS_XCS + al256((size_t)128 * 3072 * 4);
constexpr size_t WS_W2T = WS_DTS + al256((size_t)128 * 32 * 4);
constexpr size_t WS_PARTB = WS_W2T + al256((size_t)2 * 64 * 128 * 2);
constexpr size_t WS_END = WS_PARTB + al256((size_t)2 * 128 * 4 * 4 * 2 * 128 * 2);

constexpr int CW_BAR = 4096;

constexpr int RING_BYTES = 131072;
constexpr int LDSCTL_OFF = RING_BYTES, MISC_OFF = LDSCTL_OFF + 320;
constexpr int LDS_BYTES = 147456;

__device__ __forceinline__ unsigned f2bf(float f) { unsigned u = __builtin_bit_cast(unsigned, f); return (u + 0x7fffu + ((u >> 16) & 1u)) >> 16; }
__device__ __forceinline__ unsigned pk2(float lo, float hi) { return pg8::cvt_pk_bf16(lo, hi); }
typedef __bf16 bf16x2_t __attribute__((ext_vector_type(2)));
__device__ __forceinline__ unsigned pk2c(float lo, float hi) { const f32x2 v = {lo, hi}; return __builtin_bit_cast(unsigned, __builtin_convertvector(v, bf16x2_t)); }
__device__ __forceinline__ float bf2f(unsigned h) { return __builtin_bit_cast(float, h << 16); }
__device__ __forceinline__ float bflo(unsigned w) { return __builtin_bit_cast(float, w << 16); }
__device__ __forceinline__ float bfhi(unsigned w) { return __builtin_bit_cast(float, w & 0xffff0000u); }
__device__ __forceinline__ float wave_sum(float v) {
#pragma unroll
    for (int o = 1; o < 64; o <<= 1) v += __shfl_xor(v, o);
    return v;
}
__device__ __forceinline__ float siluf(float x) { return x / (1.f + __expf(-x)); }
__device__ __forceinline__ float sigmf(float x) { return 1.f / (1.f + __expf(-x)); }
__device__ __forceinline__ float softplusf(float x) { return x > 20.f ? x : log1pf(__expf(x)); }
#define LDS_WAIT() asm volatile("s_waitcnt lgkmcnt(0)" ::: "memory")

struct Args { const void* in[35]; float* out; unsigned char* ws; int ph_lo, ph_hi, p7mask, pad; };
#define INF(i) ((const float*)args.in[i])
#define XB_TMO      128
#define XB_XCNT(j)  (256  + 64 * (j))
#define XB_XSUB(j)  (1280 + 64 * (j))
#define XB_XGEN(j)  (2304 + 64 * (j))
#define XB_TOP      3328
#define XB_TOPGEN   3392
#define XCD_BAR_WORDS 3456
#define XB_SPIN_CAP (1u << 18)

__device__ __forceinline__ unsigned xb_ld(unsigned* p)              { return __hip_atomic_load(p, __ATOMIC_RELAXED, __HIP_MEMORY_SCOPE_AGENT); }
__device__ __forceinline__ unsigned xb_add(unsigned* p, unsigned v) { return __hip_atomic_fetch_add(p, v, __ATOMIC_RELAXED, __HIP_MEMORY_SCOPE_AGENT); }
__device__ __forceinline__ unsigned xb_xcc_id() { return (unsigned)__builtin_amdgcn_s_getreg((3 << 11) | 20) & 0xFu; }
#define XB_SPIN(cond, bar) do { unsigned _sp = 0; while (cond) { __builtin_amdgcn_s_sleep(1); \
    if ((++_sp & 255u) == 0u) { if (xb_ld(&(bar)[XB_TMO])) break; if (_sp > XB_SPIN_CAP) { atomicAdd(&(bar)[XB_TMO], 1u); break; } } } } while (0)

struct XcdBarrier {
    unsigned* bar; unsigned x;
    volatile LAS unsigned* st;
};

__device__ __forceinline__ XcdBarrier xcd_barrier_post(unsigned* bar, volatile LAS unsigned* st) {
    XcdBarrier b; b.bar = bar; b.x = xb_xcc_id(); b.st = st;
    if (threadIdx.x == 0) (void)xb_add(&bar[XB_XCNT(b.x)], 1u);
    return b;
}
__device__ __forceinline__ void xcd_barrier_complete(unsigned* bar, unsigned x, unsigned& nloc, unsigned& nx) {
    const unsigned G = gridDim.x * gridDim.y * gridDim.z;
    unsigned sum, cnt, mine, sp = 0u;
    for (;;) {
        sum = 0u; cnt = 0u; mine = 0u;
#pragma unroll
        for (unsigned j = 0; j < 16; ++j) { const unsigned c = xb_ld(&bar[XB_XCNT(j)]); sum += c; cnt += (c > 0u) ? 1u : 0u; mine = (j == x) ? c : mine; }
        if (sum == G) break;
        __builtin_amdgcn_s_sleep(1);
        if ((++sp & 255u) == 0u) { if (xb_ld(&bar[XB_TMO])) break; if (sp > XB_SPIN_CAP) { atomicAdd(&bar[XB_TMO], 1u); break; } }
    }
    nloc = mine > 0u ? mine : 1u; nx = cnt > 0u ? cnt : 1u;
}

__device__ __forceinline__ void xcd_barrier(const XcdBarrier& b) {
    asm volatile("s_waitcnt vmcnt(0)" ::: "memory");
    __syncthreads();
    if (threadIdx.x == 0) {
        unsigned* bar = b.bar;
        __builtin_amdgcn_s_waitcnt(0);
        unsigned nloc = b.st[0], nx = b.st[1];
        if (nloc == 0u) { xcd_barrier_complete(bar, b.x, nloc, nx); b.st[0] = nloc; b.st[1] = nx; }
        const unsigned old = xb_add(&bar[XB_XSUB(b.x)], 1u);
        const unsigned gen = old / nloc;
        if (old + 1u == (gen + 1u) * nloc) {
            __builtin_amdgcn_fence(__ATOMIC_RELEASE, "agent");
            asm volatile("s_waitcnt vmcnt(0)" ::: "memory");
            const unsigned og = xb_add(&bar[XB_TOP], 1u);
            const unsigned tg = og / nx;
            if (og + 1u == (tg + 1u) * nx) xb_add(&bar[XB_TOPGEN], 1u);
            else XB_SPIN(xb_ld(&bar[XB_TOPGEN]) == tg, bar);
            __builtin_amdgcn_fence(__ATOMIC_ACQUIRE, "agent");
            xb_add(&bar[XB_XGEN(b.x)], 1u);
            asm volatile("s_waitcnt vmcnt(0)" ::: "memory");
        } else {
            XB_SPIN(xb_ld(&bar[XB_XGEN(b.x)]) == gen, bar);
            __builtin_amdgcn_fence(__ATOMIC_ACQUIRE, "agent");
            asm volatile("s_waitcnt vmcnt(0)" ::: "memory");
        }
    }
    __syncthreads();
}
__device__ __forceinline__ int inproj_src_col(int n) {
    if (n < 5120) return n;
    if (n < 6144) return n - 5120 + 5152;
    if (n < 7680) return n - 6144 + 6176;
    if (n < 9728) return n - 7680 + 7760;
    const int i = n - 9728;
    if (i < 32) return 5120 + i;
    if (i < 80) return 7712 + (i - 32);
    return -1;
}
template <int MODE>
__device__ __forceinline__ void transpose_item(const float* W, int K, int ldw, int nblk, bf16* WT, int row_off, LAS float* scr, int item, int lane) {
    const int kb = item / nblk, nb = item % nblk, k0 = 64 * kb, n0 = 32 * nb;
    const int n = n0 + (lane & 31);
    const int sc = (MODE == 1) ? inproj_src_col(n) : n;
#pragma unroll 8
    for (int i = 0; i < 32; ++i) { const int kk = 2 * i + (lane >> 5); scr[kk * 33 + (lane & 31)] = (sc >= 0) ? W[(size_t)(k0 + kk) * ldw + sc] : 0.f; }
    LDS_WAIT(); asm volatile("" ::: "memory");
    const int c = lane & 7;
#pragma unroll
    for (int j = 0; j < 4; ++j) { const int nn = (lane >> 3) + 8 * j; const LAS float* s = scr + (8 * c) * 33 + nn;
        u32x4 o; o.x = pk2(s[0 * 33], s[1 * 33]); o.y = pk2(s[2 * 33], s[3 * 33]); o.z = pk2(s[4 * 33], s[5 * 33]); o.w = pk2(s[6 * 33], s[7 * 33]);
        *(u32x4*)(WT + (size_t)(row_off + n0 + nn) * K + k0 + 8 * c) = o; }
    LDS_WAIT(); asm volatile("" ::: "memory");
}

__device__ __forceinline__ void p0_prologue(const Args& args, LAS unsigned char* lds, int gw, int NGW, int lane, int wave) {
    unsigned char* ws = args.ws;
    const int p0m = args.pad;
    LAS float* scr = (LAS float*)(lds + wave * 16384);
    constexpr int I_IN = 16 * (NPROJ / 32), I_SSM = 32 * 32, I_ATT = 16 * 32, I_OUT = 16 * 32, I_UP = 16 * (DFF2 / 32), I_DN = (DFF / 64) * 32, I_ADA = 16 * (6144 / 32), I_W1 = 16 * 4;
    constexpr int NITEMS = I_IN + I_SSM + I_ATT + I_OUT + I_UP + I_DN + I_ADA + 4 * I_W1;
    if (p0m & 1) for (int it = gw; it < NITEMS; it += NGW) {
        int r = it;
        if (r < I_ADA) { transpose_item<0>(INF(10), 1024, 6144, 6144 / 32, (bf16*)(ws + WS_WADA), 0, scr, r, lane); continue; } r -= I_ADA;
        if (r < I_IN) { transpose_item<1>(INF(15), 1024, 9808, NPROJ / 32, (bf16*)(ws + WS_WIN), 0, scr, r, lane); continue; } r -= I_IN;
        if (r < I_SSM) { transpose_item<0>(INF(28), 2048, 1024, 32, (bf16*)(ws + WS_WSSM), 0, scr, r, lane); continue; } r -= I_SSM;
        if (r < I_ATT) { transpose_item<0>(INF(29), 1024, 1024, 32, (bf16*)(ws + WS_WATT), 0, scr, r, lane); continue; } r -= I_ATT;
        if (r < I_OUT) { transpose_item<0>(INF(30), 1024, 1024, 32, (bf16*)(ws + WS_WOUT), 0, scr, r, lane); continue; } r -= I_OUT;
        if (r < I_UP) { transpose_item<0>(INF(31), 1024, DFF2, DFF2 / 32, (bf16*)(ws + WS_WUP), 0, scr, r, lane); continue; } r -= I_UP;
        if (r < I_DN) { transpose_item<0>(INF(34), DFF, 1024, 32, (bf16*)(ws + WS_WDN), 0, scr, r, lane); continue; } r -= I_DN;
        { const int which = r / I_W1, rr = r % I_W1; const int st = which >> 1, r2 = which & 1;
          transpose_item<0>(INF(st ? 26 : 23) + (size_t)r2 * 16 * 64 * 128, 1024, 128, 4, (bf16*)(ws + (st ? WS_W1V : WS_W1K)), r2 * 128, scr, rr, lane); }
    }
    if (p0m & 4) {
    for (int r = gw; r < 256; r += NGW) {
        bf16* o = (bf16*)(ws + WS_SC) + (size_t)r * 1024;
        const float* src = r < 4 ? INF(2) + (size_t)r * 1024 : (r < 132 ? INF(3) + (size_t)(r - 4) * 1024 : nullptr);
#pragma unroll
        for (int j = 0; j < 4; ++j) { const int c0 = (j * 64 + lane) * 4; f32x4 v = src ? *(const f32x4*)(src + c0) : (f32x4){0.f, 0.f, 0.f, 0.f};
            u32x2 w; w.x = pk2(src ? siluf(v.x) : 0.f, src ? siluf(v.y) : 0.f); w.y = pk2(src ? siluf(v.z) : 0.f, src ? siluf(v.w) : 0.f); *(u32x2*)(o + c0) = w; }
    }
    for (int i = gw * 64 + lane; i < 4096 * 8; i += NGW * 64) {
        const int pos = i >> 3, k = i & 7;
        const float invf[8] = {1.0f, 0.1939227432012558f, 0.03760603070259094f, 0.007292664609849453f, 0.0014142135623842478f, 0.00027424818836152554f, 5.318296098266728e-05f, 1.0313386155758053e-05f};
        float fr = 1.0f;
#pragma unroll
        for (int q = 0; q < 8; ++q) fr = (k == q) ? invf[q] : fr;
        const float ang = (float)pos * fr;
        const double ad = (double)ang, rev = ad * 0.15915494309189535;
        const float fracrev = (float)(rev - __builtin_floor(rev));
        float* o = (float*)(ws + WS_ROPE) + (size_t)pos * 16;
        o[k] = __builtin_amdgcn_cosf(fracrev); o[8 + k] = __builtin_amdgcn_sinf(fracrev);
    }
    for (int it = gw; it < 256; it += NGW) {
        const int st = it >> 7, e = it & 127; const float* pe = INF(st ? 25 : 22); const float* w1 = INF(st ? 26 : 23);
        float s = 0.f;
        for (int i = 0; i < 32; ++i) { const int idx = lane + 64 * i; s += pe[idx] * w1[(size_t)idx * 128 + e]; }
        s = wave_sum(s);
        if (lane == 0) ((float*)(ws + WS_PET))[it] = s;
    }
    }
    if (p0m & 4) for (int i = gw * 64 + lane; i < 2 * 64 * 128; i += NGW * 64) { const int st = i >> 13, d = (i >> 7) & 63, e = i & 127;
        ((bf16*)(ws + WS_W2T))[i] = (bf16)f2bf(INF(st ? 27 : 24)[e * 64 + d]); }
}

template <int WHICH>
__device__ __forceinline__ void norm_mod_phase(const Args& args, int gw, int NGW, int lane) {
    unsigned char* ws = args.ws; const float* MOD = (const float*)(ws + WS_MOD); bf16* H = (bf16*)(ws + WS_H);
    const float* nw = INF(WHICH == 0 ? 12 : (WHICH == 1 ? 13 : 14));
    constexpr int SH = WHICH ? 3072 : 0, SCo = WHICH ? 4096 : 1024;
    for (int grp = gw; grp < MPAD / 4; grp += NGW) {
        const int m0 = grp * 4;
        if (m0 >= MALL) {
            if (WHICH < 2) {
#pragma unroll
                for (int r = 0; r < 4; ++r)
#pragma unroll
                    for (int j = 0; j < 4; ++j) ((u32x2*)(H + (size_t)(m0 + r) * 1024))[j * 64 + lane] = (u32x2){0u, 0u};
            }
            continue; }
        f32x4 v[4][4]; float ss[4];
#pragma unroll
        for (int r = 0; r < 4; ++r) { const int m = m0 + r;
            const float* xr = WHICH ? (const float*)(ws + WS_X1) + (size_t)m * 1024 : (m < MP ? INF(0) + (size_t)m * 1024 : INF(1) + (size_t)(m - MP) * 1024);
            float s = 0.f;
#pragma unroll
            for (int j = 0; j < 4; ++j) { v[r][j] = *(const f32x4*)(xr + (j * 64 + lane) * 4); s += (v[r][j].x * v[r][j].x + v[r][j].y * v[r][j].y) + (v[r][j].z * v[r][j].z + v[r][j].w * v[r][j].w); }
            ss[r] = s; }
#pragma unroll
        for (int o = 1; o < 64; o <<= 1)
#pragma unroll
            for (int r = 0; r < 4; ++r) ss[r] += __shfl_xor(ss[r], o);
        f32x4 w[4];
#pragma unroll
        for (int j = 0; j < 4; ++j) w[j] = *(const f32x4*)(nw + (j * 64 + lane) * 4);
#pragma unroll
        for (int r = 0; r < 4; ++r) { const int m = m0 + r;
            const float rstd = 1.f / sqrtf(ss[r] * (1.f / 1024.f) + EPS);
            if (WHICH == 2) { float* o = args.out + (m < MP ? O_YP + (size_t)m * 1024 : O_YS + (size_t)(m - MP) * 1024);
#pragma unroll
                for (int j = 0; j < 4; ++j) *(f32x4*)(o + (j * 64 + lane) * 4) = (v[r][j] * rstd) * w[j];
            } else {
                const float* mr = MOD + (size_t)(m < MP ? (m >> 12) : 4 + (m - MP)) * 6144;
                u32x2* o = (u32x2*)(H + (size_t)m * 1024);
#pragma unroll
                for (int j = 0; j < 4; ++j) { const int c0 = (j * 64 + lane) * 4;
                    const f32x4 sc = *(const f32x4*)(mr + SCo + c0), sh = *(const f32x4*)(mr + SH + c0);
                    const f32x4 rr = (v[r][j] * rstd) * w[j] * (sc + 1.f) + sh;
                    u32x2 pk; pk.x = pk2(rr.x, rr.y); pk.y = pk2(rr.z, rr.w); o[j * 64 + lane] = pk; }
            }
        }
    }
}
namespace epi {
using pg8::Unit; using pg8::f32x4;
typedef unsigned u32x4 __attribute__((ext_vector_type(4)));
__device__ __forceinline__ u32x4 pack8(const f32x4& a, const f32x4& b) { u32x4 w; w.x = pg8::cvt_pk_bf16(a[0], a[1]); w.y = pg8::cvt_pk_bf16(a[2], a[3]); w.z = pg8::cvt_pk_bf16(b[0], b[1]); w.w = pg8::cvt_pk_bf16(b[2], b[3]); return w; }

struct InProj {
    static constexpr bool PERM = true, AFTER_DRAIN = false;
    unsigned char* ws; float* out;
    __device__ __forceinline__ void operator()(const f32x4 (&acc)[2][2][4][2], const Unit& u, int wr, int wc, int fr, int fq) const {
        const int pn = u.pn;
        const int rowb = u.pm * 256 + wr * 64 + fr;
        const int cl = wc * 32 + 8 * fq;
        if (pn < T_XBC || (pn >= T_MG && pn < T_MISC)) {
            bf16* base = pn < T_XBC ? (bf16*)(ws + WS_Z) : (bf16*)(ws + WS_MG);
            const int colt = (pn < T_XBC ? pn : pn - T_MG) * 256 + cl;
#pragma unroll
            for (int ai = 0; ai < 2; ++ai)
#pragma unroll
                for (int m = 0; m < 4; ++m) { const int row = rowb + ai * 128 + m * 16;
#pragma unroll
                    for (int bj = 0; bj < 2; ++bj) *(u32x4*)(base + (size_t)row * 2048 + colt + bj * 128) = pack8(acc[ai][bj][m][0], acc[ai][bj][m][1]); }
        } else if (pn < T_Q) {
            bf16* base = (bf16*)(ws + WS_XBC); const int colt = (pn - T_XBC) * 256 + cl;
#pragma unroll
            for (int ai = 0; ai < 2; ++ai)
#pragma unroll
                for (int m = 0; m < 4; ++m) { const int row = rowb + ai * 128 + m * 16;
                    float* fo = nullptr;
                    if (row < MP) { const int t = row & 4095; if (t >= 4093) fo = out + O_CONVP + ((size_t)(row >> 12) * 3 + (t - 4093)) * CONVD; }
                    else if (row < MALL) fo = out + O_CONVS + ((size_t)(row - MP) * 3 + 2) * CONVD;
#pragma unroll
                    for (int bj = 0; bj < 2; ++bj) { const int col = colt + bj * 128;
                        *(u32x4*)(base + (size_t)row * CONVD + col) = pack8(acc[ai][bj][m][0], acc[ai][bj][m][1]);
                        if (fo) { *(f32x4*)(fo + col) = acc[ai][bj][m][0]; *(f32x4*)(fo + col + 4) = acc[ai][bj][m][1]; } } }
        } else if (pn < T_MG) {
            const bool isq = pn < T_KV; const int s = pn - T_KV;
            const bool dorope = (isq || !(s & 1)) && !(wc & 1);
            const float* rope = (const float*)(ws + WS_ROPE);
#pragma unroll
            for (int ai = 0; ai < 2; ++ai)
#pragma unroll
                for (int m = 0; m < 4; ++m) { const int row = rowb + ai * 128 + m * 16;
                    const int pos = row < MP ? (row & 4095) : PAST;
#pragma unroll
                    for (int bj = 0; bj < 2; ++bj) {
                        f32x4 v0 = acc[ai][bj][m][0], v1 = acc[ai][bj][m][1];
                        if (dorope) {
                            f32x4 o0, o1;
#pragma unroll
                            for (int i = 0; i < 4; ++i) { o0[i] = __shfl_xor(v0[i], 16); o1[i] = __shfl_xor(v1[i], 16); }
                            if (fq < 2) {
                                const f32x4 c0 = *(const f32x4*)(rope + pos * 16), c1 = *(const f32x4*)(rope + pos * 16 + 4), s0 = *(const f32x4*)(rope + pos * 16 + 8), s1 = *(const f32x4*)(rope + pos * 16 + 12);
                                if (fq == 0) { v0 = v0 * c0 - o0 * s0; v1 = v1 * c1 - o1 * s1; }
                                else         { v0 = v0 * c0 + o0 * s0; v1 = v1 * c1 + o1 * s1; }
                            }
                        }
                        const int col = cl + bj * 128;
                        const u32x4 pk = pack8(v0, v1);
                        if (isq) { *(u32x4*)((bf16*)(ws + WS_Q) + (size_t)row * 1024 + (pn - T_Q) * 256 + col) = pk; }
                        else {
                            const int h = col >> 6, d = col & 63;
                            if (row < MP) {
                                const int b = row >> 12, t = row & 4095;
                                *(u32x4*)((bf16*)(ws + WS_KVH) + ((((size_t)s * 4 + b) * 4 + h) * 4096 + t) * 64 + d) = pk;
                                if (s < 4) { float* fo = out + O_KVP + ((size_t)row * 4 + s) * 256 + col; *(f32x4*)fo = v0; *(f32x4*)(fo + 4) = v1; }
                                else if (t >= 3584) { float* fo = out + O_WINP + (((size_t)b * 512 + (t - 3584)) * 2 + (s - 4)) * 256 + col; *(f32x4*)fo = v0; *(f32x4*)(fo + 4) = v1; }
                                if (s == 3 || s == 5) {
                                    const int kk = t & 31, kpos = 8 * ((kk & 15) >> 2) + 4 * (kk >> 4) + (kk & 3);
                                    bf16* vt = (bf16*)(ws + WS_VT) + ((((size_t)(s == 5) * 4 + b) * 4 + h) * 128 + (t >> 5)) * 2048 + d * 32 + kpos;
                                    vt[0 * 32] = (bf16)(pk.x & 0xffffu); vt[1 * 32] = (bf16)(pk.x >> 16); vt[2 * 32] = (bf16)(pk.y & 0xffffu); vt[3 * 32] = (bf16)(pk.y >> 16);
                                    vt[4 * 32] = (bf16)(pk.z & 0xffffu); vt[5 * 32] = (bf16)(pk.z >> 16); vt[6 * 32] = (bf16)(pk.w & 0xffffu); vt[7 * 32] = (bf16)(pk.w >> 16);
                                }
                            } else if (row < MALL) {
                                const int bs = row - MP;
                                float* fo = s < 4 ? out + O_KVS + ((size_t)bs * 4 + s) * 256 + col : out + O_WINS + (((size_t)bs * 512 + 511) * 2 + (s - 4)) * 256 + col;
                                *(f32x4*)fo = v0; *(f32x4*)(fo + 4) = v1;
                            }
                        }
                    } }
        } else {
            float* base = (float*)(ws + WS_MISC);
#pragma unroll
            for (int ai = 0; ai < 2; ++ai)
#pragma unroll
                for (int m = 0; m < 4; ++m) { const int row = rowb + ai * 128 + m * 16;
                    *(f32x4*)(base + (size_t)row * 128 + cl) = acc[ai][0][m][0]; *(f32x4*)(base + (size_t)row * 128 + cl + 4) = acc[ai][0][m][1]; }
        }
    }
};

struct Merge1 {
    static constexpr bool PERM = true, AFTER_DRAIN = false;
    unsigned char* ws;
    __device__ __forceinline__ void operator()(const f32x4 (&acc)[2][2][4][2], const Unit& u, int wr, int wc, int fr, int fq) const {
        const int rowb = u.pm * 256 + wr * 64 + fr, colb = u.pn * 256 + wc * 32 + 8 * fq;
        const bf16* MG = (const bf16*)(ws + WS_MG); const float* SSQ = (const float*)(ws + WS_SSQ); float* T = (float*)(ws + WS_TMPM);
#pragma unroll
        for (int ai = 0; ai < 2; ++ai)
#pragma unroll
            for (int m = 0; m < 4; ++m) { const int row = rowb + ai * 128 + m * 16;
                const f32x4 sq = *(const f32x4*)(SSQ + (size_t)row * 4);
                const float rstd = 1.f / sqrtf(((sq.x + sq.y) + (sq.z + sq.w)) * (1.f / 2048.f) + EPS);
#pragma unroll
                for (int bj = 0; bj < 2; ++bj) { const int col = colb + bj * 128;
                    const u32x4 g = *(const u32x4*)(MG + (size_t)row * 2048 + col);
                    f32x4 o0, o1;
                    o0[0] = sigmf(bflo(g.x)) * rstd * acc[ai][bj][m][0][0]; o0[1] = sigmf(bfhi(g.x)) * rstd * acc[ai][bj][m][0][1];
                    o0[2] = sigmf(bflo(g.y)) * rstd * acc[ai][bj][m][0][2]; o0[3] = sigmf(bfhi(g.y)) * rstd * acc[ai][bj][m][0][3];
                    o1[0] = sigmf(bflo(g.z)) * rstd * acc[ai][bj][m][1][0]; o1[1] = sigmf(bfhi(g.z)) * rstd * acc[ai][bj][m][1][1];
                    o1[2] = sigmf(bflo(g.w)) * rstd * acc[ai][bj][m][1][2]; o1[3] = sigmf(bfhi(g.w)) * rstd * acc[ai][bj][m][1][3];
                    *(f32x4*)(T + (size_t)row * 1024 + col) = o0; *(f32x4*)(T + (size_t)row * 1024 + col + 4) = o1; } }
    }
};
struct Merge2 {
    static constexpr bool PERM = true, AFTER_DRAIN = false;
    unsigned char* ws;
    __device__ __forceinline__ void operator()(const f32x4 (&acc)[2][2][4][2], const Unit& u, int wr, int wc, int fr, int fq) const {
        const int rowb = u.pm * 256 + wr * 64 + fr, colb = u.pn * 256 + wc * 32 + 8 * fq;
        const bf16* MG = (const bf16*)(ws + WS_MG); const float* T = (const float*)(ws + WS_TMPM); bf16* O = (bf16*)(ws + WS_MERGED);
#pragma unroll
        for (int ai = 0; ai < 2; ++ai)
#pragma unroll
            for (int m = 0; m < 4; ++m) { const int row = rowb + ai * 128 + m * 16;
#pragma unroll
                for (int bj = 0; bj < 2; ++bj) { const int col = colb + bj * 128;
                    const u32x4 g = *(const u32x4*)(MG + (size_t)row * 2048 + 1024 + col);
                    f32x4 o0 = *(const f32x4*)(T + (size_t)row * 1024 + col), o1 = *(const f32x4*)(T + (size_t)row * 1024 + col + 4);
                    o0[0] += sigmf(bflo(g.x)) * acc[ai][bj][m][0][0]; o0[1] += sigmf(bfhi(g.x)) * acc[ai][bj][m][0][1];
                    o0[2] += sigmf(bflo(g.y)) * acc[ai][bj][m][0][2]; o0[3] += sigmf(bfhi(g.y)) * acc[ai][bj][m][0][3];
                    o1[0] += sigmf(bflo(g.z)) * acc[ai][bj][m][1][0]; o1[1] += sigmf(bfhi(g.z)) * acc[ai][bj][m][1][1];
                    o1[2] += sigmf(bflo(g.w)) * acc[ai][bj][m][1][2]; o1[3] += sigmf(bfhi(g.w)) * acc[ai][bj][m][1][3];
                    *(u32x4*)(O + (size_t)row * 1024 + col) = pack8(o0, o1); } }
    }
};
struct Resid {
    static constexpr bool PERM = false, AFTER_DRAIN = false;
    const float* xp; const float* xs; const float* x1in; float* x1out; const float* MOD; int goff;
    __device__ __forceinline__ void operator()(const f32x4 (&acc)[2][2][4][2], const Unit& u, int wr, int wc, int fr, int fq) const {
        const int rowb = u.pm * 256 + wr * 64 + fr, colb = u.pn * 256 + wc * 32 + 4 * fq;
#pragma unroll
        for (int ai = 0; ai < 2; ++ai)
#pragma unroll
            for (int m = 0; m < 4; ++m) { const int row = rowb + ai * 128 + m * 16;
                if (row >= MALL) continue;
                const float* base = x1in ? x1in + (size_t)row * 1024 : (row < MP ? xp + (size_t)row * 1024 : xs + (size_t)(row - MP) * 1024);
                const float* gr = MOD + (size_t)(row < MP ? (row >> 12) : 4 + (row - MP)) * 6144 + goff;
#pragma unroll
                for (int bj = 0; bj < 2; ++bj)
#pragma unroll
                    for (int n = 0; n < 2; ++n) { const int col = colb + bj * 128 + n * 16;
                        *(f32x4*)(x1out + (size_t)row * 1024 + col) = *(const f32x4*)(base + col) + *(const f32x4*)(gr + col) * acc[ai][bj][m][n]; } }
    }
};
struct Up {
    static constexpr bool PERM = true, AFTER_DRAIN = false;
    unsigned char* ws; float* out;
    __device__ __forceinline__ void operator()(const f32x4 (&acc)[2][2][4][2], const Unit& u, int wr, int wc, int fr, int fq) const {
        const int rowb = u.pm * 256 + wr * 64 + fr, colb = u.pn * 256 + wc * 32 + 8 * fq;
        bf16* U = (bf16*)(ws + WS_U);
#pragma unroll
        for (int ai = 0; ai < 2; ++ai)
#pragma unroll
            for (int m = 0; m < 4; ++m) { const int row = rowb + ai * 128 + m * 16;
                float* fo = nullptr;
                if (row < MP) { const int t = row & 4095; if (t >= 4094) fo = out + O_FFNP + ((size_t)(row >> 12) * 2 + (t - 4094)) * DFF2; }
                else if (row < MALL) fo = out + O_FFNS + ((size_t)(row - MP) * 2 + 1) * DFF2;
#pragma unroll
                for (int bj = 0; bj < 2; ++bj) { const int col = colb + bj * 128;
                    *(u32x4*)(U + (size_t)row * DFF2 + col) = pack8(acc[ai][bj][m][0], acc[ai][bj][m][1]);
                    if (fo) { *(f32x4*)(fo + col) = acc[ai][bj][m][0]; *(f32x4*)(fo + col + 4) = acc[ai][bj][m][1]; } } }
    }
};
struct PartBf16 {
    static constexpr bool PERM = true, AFTER_DRAIN = false;
    bf16* P;
    __device__ __forceinline__ void operator()(const f32x4 (&acc)[2][2][4][2], const Unit& u, int wr, int wc, int fr, int fq) const {
        const int rowb = u.pm * 256 + wr * 64 + fr, colb = wc * 32 + 8 * fq;
#pragma unroll
        for (int ai = 0; ai < 2; ++ai)
#pragma unroll
            for (int m = 0; m < 4; ++m) { const int row = rowb + ai * 128 + m * 16;
#pragma unroll
                for (int bj = 0; bj < 2; ++bj) *(u32x4*)(P + (size_t)row * 256 + colb + bj * 128) = pack8(acc[ai][bj][m][0], acc[ai][bj][m][1]); }
    }
};
}
__device__ __forceinline__ void conv_prompt_item(const Args& args, int item, int lane) {
    unsigned char* ws = args.ws;
    const int tg = item / 48, cgp = item % 48, cg = lane & 7, rg = lane >> 3;
    const int m0 = tg * 64 + 8 * rg, b = m0 >> 12, t0 = m0 & 4095, ch0 = cgp * 64 + 8 * cg;
    const bf16* X = (const bf16*)(ws + WS_XBC);
    float x[11][8];
#pragma unroll
    for (int i = 0; i < 11; ++i) {
        const int t = t0 - 3 + i;
        u32x4 v = (u32x4){0u, 0u, 0u, 0u};
        if (t >= 0) v = *(const u32x4*)(X + (size_t)(m0 - 3 + i) * CONVD + ch0);
        x[i][0] = bflo(v.x); x[i][1] = bfhi(v.x); x[i][2] = bflo(v.y); x[i][3] = bfhi(v.y); x[i][4] = bflo(v.z); x[i][5] = bfhi(v.z); x[i][6] = bflo(v.w); x[i][7] = bfhi(v.w);
    }
    const float* cw = INF(16); const float* cb = INF(17);
    float w[4][8], bias[8];
#pragma unroll
    for (int k = 0; k < 4; ++k) { const f32x4 a = *(const f32x4*)(cw + k * CONVD + ch0), c = *(const f32x4*)(cw + k * CONVD + ch0 + 4);
        w[k][0] = a.x; w[k][1] = a.y; w[k][2] = a.z; w[k][3] = a.w; w[k][4] = c.x; w[k][5] = c.y; w[k][6] = c.z; w[k][7] = c.w; }
    { const f32x4 a = *(const f32x4*)(cb + ch0), c = *(const f32x4*)(cb + ch0 + 4); bias[0] = a.x; bias[1] = a.y; bias[2] = a.z; bias[3] = a.w; bias[4] = c.x; bias[5] = c.y; bias[6] = c.z; bias[7] = c.w; }
    float y[8][8];
#pragma unroll
    for (int i = 0; i < 8; ++i)
#pragma unroll
        for (int c = 0; c < 8; ++c) { const float a = bias[c] + w[0][c] * x[i][c] + w[1][c] * x[i + 1][c] + w[2][c] * x[i + 2][c] + w[3][c] * x[i + 3][c]; y[i][c] = siluf(a); }
    if (cgp < 32) {
        bf16* XT = (bf16*)(ws + WS_XT) + ((size_t)(b * 32 + cgp) * 128 + (t0 >> 5)) * 2048 + (8 * cg) * 32 + (t0 & 31);
#pragma unroll
        for (int c = 0; c < 8; ++c) { u32x4 o; o.x = pk2(y[0][c], y[1][c]); o.y = pk2(y[2][c], y[3][c]); o.z = pk2(y[4][c], y[5][c]); o.w = pk2(y[6][c], y[7][c]); *(u32x4*)(XT + (size_t)c * 32) = o; }
    } else {
        const int isC = cgp >= 40, gg = ((cgp - 32) & 7) >> 1, n0 = ((cgp - 32) & 1) * 64 + 8 * cg;
        bf16* N = (bf16*)(ws + (isC ? WS_CN : WS_BN)) + ((size_t)(b * 4 + gg) * 4096 + t0) * 128 + n0;
#pragma unroll
        for (int i = 0; i < 8; ++i) { u32x4 o; o.x = pk2(y[i][0], y[i][1]); o.y = pk2(y[i][2], y[i][3]); o.z = pk2(y[i][4], y[i][5]); o.w = pk2(y[i][6], y[i][7]); *(u32x4*)(N + (size_t)i * 128) = o; }
        if (!isC) {
            bf16* BT = (bf16*)(ws + WS_BT) + ((size_t)(b * 4 + gg) * 128 + (t0 >> 5)) * 4096 + n0 * 32 + (t0 & 31);
#pragma unroll
            for (int c = 0; c < 8; ++c) { u32x4 o; o.x = pk2(y[0][c], y[1][c]); o.y = pk2(y[2][c], y[3][c]); o.z = pk2(y[4][c], y[5][c]); o.w = pk2(y[6][c], y[7][c]); *(u32x4*)(BT + (size_t)c * 32) = o; }
        }
    }
}
__device__ __forceinline__ void dtcs_item(const Args& args, int item, int lane) {
    unsigned char* ws = args.ws;
    const int c = item & 31, h = (item >> 5) & 31, b = item >> 10;
    const float* MISC = (const float*)(ws + WS_MISC);
    const float bias = INF(18)[h], a = -__expf(INF(19)[h]);
    const int t = c * 128 + 2 * lane; const size_t m = (size_t)b * 4096 + t;
    const float d0 = softplusf(MISC[m * 128 + h] + bias), d1 = softplusf(MISC[(m + 1) * 128 + h] + bias);
    const float a0 = d0 * a, a1 = d1 * a;
    float s = a0 + a1;
#pragma unroll
    for (int o = 1; o < 64; o <<= 1) { const float v = __shfl_up(s, o); if (lane >= o) s += v; }
    const float c1 = s, c0 = s - a1;
    float* DT = (float*)(ws + WS_DT) + (size_t)(b * 32 + h) * 4096 + t; float* CS = (float*)(ws + WS_CS) + (size_t)(b * 32 + h) * 4096 + t;
    *(f32x2*)DT = (f32x2){d0, d1}; *(f32x2*)CS = (f32x2){c0, c1};
}
__device__ __forceinline__ void sample_conv(const Args& args, int gt, int NGT) {
    unsigned char* ws = args.ws; float* out = args.out;
    const float* st = INF(8); const float* cw = INF(16); const float* cb = INF(17);
    for (int i = gt; i < MS * CONVD; i += NGT) {
        const int bs = i / CONVD, ch = i % CONVD;
        const float s0 = st[((size_t)bs * 3 + 0) * CONVD + ch], s1 = st[((size_t)bs * 3 + 1) * CONVD + ch], s2 = st[((size_t)bs * 3 + 2) * CONVD + ch];
        const float xn = out[O_CONVS + ((size_t)bs * 3 + 2) * CONVD + ch];
        out[O_CONVS + ((size_t)bs * 3 + 0) * CONVD + ch] = s1; out[O_CONVS + ((size_t)bs * 3 + 1) * CONVD + ch] = s2;
        const float a = cb[ch] + cw[ch] * s0 + cw[CONVD + ch] * s1 + cw[2 * CONVD + ch] * s2 + cw[3 * CONVD + ch] * xn;
        ((float*)(ws + WS_XCS))[i] = siluf(a);
    }
    for (int i = gt; i < MS * NH; i += NGT) { const int bs = i >> 5, h = i & 31;
        ((float*)(ws + WS_DTS))[i] = softplusf(((const float*)(ws + WS_MISC))[(size_t)(MP + bs) * 128 + h] + INF(18)[h]); }
}

struct SFrag { u32x4 x[4]; bf16x8 b[4]; };
__device__ __forceinline__ void ssd_states_load(const bf16* XT, const bf16* BT, int nh, int ks, int q, int r16, SFrag& F) {
#pragma unroll
    for (int pt = 0; pt < 4; ++pt) F.x[pt] = *(const u32x4*)(XT + (size_t)ks * 2048 + (16 * pt + r16) * 32 + 8 * q);
#pragma unroll
    for (int nt = 0; nt < 4; ++nt) F.b[nt] = *(const bf16x8*)(BT + (size_t)ks * 4096 + (64 * nh + 16 * nt + r16) * 32 + 8 * q);
}
__device__ __forceinline__ void ssd_states_step(const LAS float* wl, int ks, int q, const SFrag& F, f32x4 (&acc)[4][4]) {
    const int s0 = 32 * ks + 8 * q;
    const f32x4 w0 = *(const LAS f32x4*)(wl + s0), w1 = *(const LAS f32x4*)(wl + s0 + 4);
    bf16x8 af[4];
#pragma unroll
    for (int pt = 0; pt < 4; ++pt) { const u32x4 v = F.x[pt];
        u32x4 o; o.x = pk2(bflo(v.x) * w0.x, bfhi(v.x) * w0.y); o.y = pk2(bflo(v.y) * w0.z, bfhi(v.y) * w0.w); o.z = pk2(bflo(v.z) * w1.x, bfhi(v.z) * w1.y); o.w = pk2(bflo(v.w) * w1.z, bfhi(v.w) * w1.w);
        af[pt] = __builtin_bit_cast(bf16x8, o); }
#pragma unroll
    for (int nt = 0; nt < 4; ++nt)
#pragma unroll
        for (int pt = 0; pt < 4; ++pt) acc[pt][nt] = MFMA16(af[pt], F.b[nt], acc[pt][nt]);
}
__device__ __forceinline__ void ssd_states_unit(const Args& args, LAS unsigned char* lds, int unit, int wave, int lane) {
    unsigned char* ws = args.ws;
    const int g = unit & 3, c = (unit >> 2) & 31, b = unit >> 7, h = g * 8 + wave, q = lane >> 4, r16 = lane & 15;
    LAS float* wl = (LAS float*)(lds + wave * 512);
    const float* DT = (const float*)(ws + WS_DT) + (size_t)(b * 32 + h) * 4096 + c * 128; const float* CS = (const float*)(ws + WS_CS) + (size_t)(b * 32 + h) * 4096 + c * 128;
    const float cl = CS[127];
    wl[lane] = DT[lane] * __expf(cl - CS[lane]); wl[lane + 64] = DT[lane + 64] * __expf(cl - CS[lane + 64]);
    LDS_WAIT(); asm volatile("" ::: "memory");
    const bf16* XT = (const bf16*)(ws + WS_XT) + ((size_t)(b * 32 + h) * 128 + c * 4) * 2048;
    const bf16* BT = (const bf16*)(ws + WS_BT) + ((size_t)(b * 4 + g) * 128 + c * 4) * 4096;
    float* ST = (float*)(ws + WS_STATES) + (((size_t)(b * 32 + c) * 32 + h) * 64) * 128;
    SFrag FA, FB;
    ssd_states_load(XT, BT, 0, 0, q, r16, FA);
#pragma unroll 1
    for (int nh = 0; nh < 2; ++nh) {
        f32x4 acc[4][4];
#pragma unroll
        for (int i = 0; i < 4; ++i)
#pragma unroll
            for (int j = 0; j < 4; ++j) acc[i][j] = (f32x4){0.f, 0.f, 0.f, 0.f};
        ssd_states_load(XT, BT, nh, 1, q, r16, FB); ssd_states_step(wl, 0, q, FA, acc);
        ssd_states_load(XT, BT, nh, 2, q, r16, FA); ssd_states_step(wl, 1, q, FB, acc);
        ssd_states_load(XT, BT, nh, 3, q, r16, FB); ssd_states_step(wl, 2, q, FA, acc);
        if (nh == 0) ssd_states_load(XT, BT, 1, 0, q, r16, FA);
        ssd_states_step(wl, 3, q, FB, acc);
#pragma unroll
        for (int pt = 0; pt < 4; ++pt)
#pragma unroll
            for (int nt = 0; nt < 4; ++nt)
#pragma unroll
                for (int r = 0; r < 4; ++r) ST[(size_t)(16 * pt + 4 * q + r) * 128 + 64 * nh + 16 * nt + r16] = acc[pt][nt][r];
    }
}

template <int SAMPLE>
__device__ __forceinline__ void compress2_item(const Args& args, int item, int lane) {
    unsigned char* ws = args.ws;
    const int q = lane >> 4, r16 = lane & 15;
    constexpr int NPB = SAMPLE ? 128 : 256;
    constexpr int NI = (SAMPLE ? 65536 : 4096) / 16;
    const int st = item / NI, row0 = (item % NI) * 16;
    const bf16* P = (const bf16*)(ws + (SAMPLE ? (st ? WS_PARTSV : WS_PARTSK) : (st ? WS_PARTV : WS_PARTK))) + (size_t)(row0 + r16) * 256;
    const float* pet = (const float*)(ws + WS_PET) + st * 128;
    const bf16* W2T = (const bf16*)(ws + WS_W2T) + st * 8192;
    f32x4 acc[4];
#pragma unroll
    for (int dt = 0; dt < 4; ++dt) acc[dt] = (f32x4){0.f, 0.f, 0.f, 0.f};
#pragma unroll
    for (int ks = 0; ks < 4; ++ks) {
        const int e0 = 32 * ks + 8 * q;
        const u32x4 pa = *(const u32x4*)(P + e0), pb = *(const u32x4*)(P + 256 + 128 + e0);
        const f32x4 a0 = (f32x4){bflo(pa.x), bfhi(pa.x), bflo(pa.y), bfhi(pa.y)}, a1 = (f32x4){bflo(pa.z), bfhi(pa.z), bflo(pa.w), bfhi(pa.w)};
        const f32x4 b0 = (f32x4){bflo(pb.x), bfhi(pb.x), bflo(pb.y), bfhi(pb.y)}, b1 = (f32x4){bflo(pb.z), bfhi(pb.z), bflo(pb.w), bfhi(pb.w)};
        const f32x4 p0 = *(const f32x4*)(pet + e0), p1 = *(const f32x4*)(pet + e0 + 4);
        const f32x4 h0 = a0 + b0 + p0, h1 = a1 + b1 + p1;
        u32x4 o; o.x = pk2(siluf(h0.x), siluf(h0.y)); o.y = pk2(siluf(h0.z), siluf(h0.w)); o.z = pk2(siluf(h1.x), siluf(h1.y)); o.w = pk2(siluf(h1.z), siluf(h1.w));
        const bf16x8 af = __builtin_bit_cast(bf16x8, o);
#pragma unroll
        for (int dt = 0; dt < 4; ++dt) { const bf16x8 bf = *(const bf16x8*)(W2T + (size_t)(16 * dt + r16) * 128 + e0); acc[dt] = MFMA16(af, bf, acc[dt]); }
    }
    const int bh = row0 / NPB, n0 = row0 % NPB + 4 * q;
#pragma unroll
    for (int dt = 0; dt < 4; ++dt) {
        const int d = 16 * dt + r16;
        float v[4];
#pragma unroll
        for (int r = 0; r < 4; ++r) v[r] = (n0 + r < NPB - 1) ? acc[dt][r] : 0.f;
        if (SAMPLE) {
            float* o = (float*)(ws + (st ? WS_VCS : WS_KCS)) + ((size_t)bh * 128 + n0) * 64 + d;
#pragma unroll
            for (int r = 0; r < 4; ++r) o[r * 64] = v[r];
        } else if (st == 0) {
            bf16* o = (bf16*)(ws + WS_KC) + ((size_t)bh * 256 + n0) * 64 + d;
#pragma unroll
            for (int r = 0; r < 4; ++r) o[r * 64] = (bf16)f2bf(v[r]);
        } else {
            u32x2 w; w.x = pk2(v[0], v[1]); w.y = pk2(v[2], v[3]);
            *(u32x2*)((bf16*)(ws + WS_VCT) + ((size_t)bh * 8 + (n0 >> 5)) * 2048 + d * 32 + 8 * ((n0 & 15) >> 2) + 4 * ((n0 & 31) >> 4)) = w;
        }
    }
}

__device__ __forceinline__ void sample_ssm_item(const Args& args, LAS unsigned char* lds, int item, int wave, int lane) {
    unsigned char* ws = args.ws; float* out = args.out;
    const int h = item & 31, bs = item >> 5, g = h >> 3, rs = lane >> 5, nc = lane & 31;
    const float* XC = (const float*)(ws + WS_XCS) + (size_t)bs * CONVD;
    const float dt = ((const float*)(ws + WS_DTS))[bs * 32 + h], a = -__expf(INF(19)[h]), dec = __expf(dt * a), Dh = INF(20)[h];
    const f32x4 Bv = *(const f32x4*)(XC + 2048 + g * 128 + 4 * nc) * dt, Cv = *(const f32x4*)(XC + 2560 + g * 128 + 4 * nc);
    const float xl = XC[h * 64 + lane];
    const size_t m = MP + bs;
    const float zl = bf2f(((const bf16*)(ws + WS_Z))[m * 2048 + h * 64 + lane]), nwl = INF(21)[h * 64 + lane];
    const float* H0 = INF(7) + ((size_t)(bs * 32 + h) * 64) * 128 + 4 * nc; float* HN = out + O_SSMS + ((size_t)(bs * 32 + h) * 64) * 128 + 4 * nc;
    const bool b4 = (lane & 16) != 0, b3 = (lane & 8) != 0, b2 = (lane & 4) != 0;
    float yl = 0.f;
#pragma unroll 1
    for (int bt = 0; bt < 4; ++bt) {
        f32x4 h0[8];
#pragma unroll
        for (int k = 0; k < 8; ++k) h0[k] = *(const f32x4*)(H0 + (size_t)(2 * (8 * bt + k) + rs) * 128);
        float v[8];
#pragma unroll
        for (int k = 0; k < 8; ++k) { const int p = 2 * (8 * bt + k) + rs;
            const float xp = __shfl(xl, p);
            const f32x4 hn = h0[k] * dec + Bv * xp;
            *(f32x4*)(HN + (size_t)p * 128) = hn;
            v[k] = (hn.x * Cv.x + hn.y * Cv.y) + (hn.z * Cv.z + hn.w * Cv.w); }
        float a4[4], a2[2];
#pragma unroll
        for (int i = 0; i < 4; ++i) a4[i] = (b4 ? v[4 + i] : v[i]) + __shfl_xor(b4 ? v[i] : v[4 + i], 16);
#pragma unroll
        for (int i = 0; i < 2; ++i) a2[i] = (b3 ? a4[2 + i] : a4[i]) + __shfl_xor(b3 ? a4[i] : a4[2 + i], 8);
        float c = (b2 ? a2[1] : a2[0]) + __shfl_xor(b2 ? a2[0] : a2[1], 4);
        c += __shfl_xor(c, 2); c += __shfl_xor(c, 1);
        const int pl = lane - 16 * bt;
        const int kk = (pl >> 1) & 7, src = ((pl & 1) << 5) | ((kk & 4) << 2) | ((kk & 2) << 2) | ((kk & 1) << 2);
        const float got = __shfl(c, src & 63);
        if (pl >= 0 && pl < 16) yl = got;
    }
    const float y = yl + Dh * xl;
    const float vv = y * siluf(zl);
    ((bf16*)(ws + WS_YSSM))[m * 2048 + h * 64 + lane] = (bf16)f2bf(vv * nwl);
    const float ss = wave_sum(vv * vv);
    if (lane == 0) ((float*)(ws + WS_MISC))[m * 128 + 80 + h] = ss;
}
constexpr int SC_PP = 264;
constexpr int SC_AP = 72;
__device__ __forceinline__ void sample_compress_unit(const Args& args, LAS unsigned char* lds, int unit, int tid_in, int wave, int lane_in) {
    int tid = tid_in, lane = lane_in; asm volatile("" : "+v"(tid), "+v"(lane));
    unsigned char* ws = args.ws;
    const int st = unit & 1, qd = (unit >> 1) & 3, b = unit >> 3, q = lane >> 4, r16 = lane & 15, wr = wave >> 2, wc = wave & 3;
    LAS bf16* As = (LAS bf16*)lds;
    LAS bf16* Pl = (LAS bf16*)(lds + 2 * 128 * SC_AP * 2);
    const bf16* W1T = (const bf16*)(ws + (st ? WS_W1V : WS_W1K));
    const int sj = tid >> 2, sc16 = tid & 3, sjj = 32 * qd + (sj >> 2), sh = sj & 3;
    const int page = ((const int*)args.in[5])[b * NPAGES + (sjj >> 3)];
    const float* asrc = INF(4) + (((size_t)page * 128 + 16 * (sjj & 7)) * 4 + st) * 256 + sh * 64 + 16 * sc16;
    LAS bf16* adst = As + sj * SC_AP + 16 * sc16;
    const bf16* bsrc = W1T + (size_t)(64 * wc + r16) * 1024 + 8 * q;
    f32x4 acc[4][4];
#pragma unroll
    for (int m = 0; m < 4; ++m)
#pragma unroll
        for (int n = 0; n < 4; ++n) acc[m][n] = (f32x4){0.f, 0.f, 0.f, 0.f};
    f32x4 ra[4][4];
#pragma unroll
    for (int i = 0; i < 4; ++i)
#pragma unroll
        for (int c = 0; c < 4; ++c) ra[i][c] = *(const f32x4*)(asrc + (size_t)i * 1024 + 4 * c);
    { u32x4 w0, w1; w0.x = pk2(ra[0][0].x, ra[0][0].y); w0.y = pk2(ra[0][0].z, ra[0][0].w); w0.z = pk2(ra[0][1].x, ra[0][1].y); w0.w = pk2(ra[0][1].z, ra[0][1].w);
      w1.x = pk2(ra[0][2].x, ra[0][2].y); w1.y = pk2(ra[0][2].z, ra[0][2].w); w1.z = pk2(ra[0][3].x, ra[0][3].y); w1.w = pk2(ra[0][3].z, ra[0][3].w);
      *(LAS u32x4*)adst = w0; *(LAS u32x4*)(adst + 8) = w1; }
    __syncthreads();
#pragma unroll 1
    for (int s4 = 0; s4 < 16; s4 += 4) {
#pragma unroll
        for (int i = 0; i < 4; ++i) {
            const int s = s4 + i;
            bf16x8 rb[2][4];
#pragma unroll
            for (int k2 = 0; k2 < 2; ++k2)
#pragma unroll
                for (int n = 0; n < 4; ++n) rb[k2][n] = *(const bf16x8*)(bsrc + (size_t)(16 * n) * 1024 + 64 * s + 32 * k2);
#pragma unroll
            for (int k2 = 0; k2 < 2; ++k2) {
                bf16x8 afr[4];
#pragma unroll
                for (int m = 0; m < 4; ++m) afr[m] = *(const LAS bf16x8*)(As + (s & 1) * (128 * SC_AP) + (64 * wr + 16 * m + r16) * SC_AP + 32 * k2 + 8 * q);
#pragma unroll
                for (int m = 0; m < 4; ++m)
#pragma unroll
                    for (int n = 0; n < 4; ++n) acc[m][n] = MFMA16(rb[k2][n], afr[m], acc[m][n]);
            }
            if (s + 4 < 16) {
#pragma unroll
                for (int c = 0; c < 4; ++c) ra[i][c] = *(const f32x4*)(asrc + (size_t)(s + 4) * 1024 + 4 * c); }
            if (s + 1 < 16) { const int j = (i + 1) & 3; u32x4 w0, w1;
                w0.x = pk2(ra[j][0].x, ra[j][0].y); w0.y = pk2(ra[j][0].z, ra[j][0].w); w0.z = pk2(ra[j][1].x, ra[j][1].y); w0.w = pk2(ra[j][1].z, ra[j][1].w);
                w1.x = pk2(ra[j][2].x, ra[j][2].y); w1.y = pk2(ra[j][2].z, ra[j][2].w); w1.z = pk2(ra[j][3].x, ra[j][3].y); w1.w = pk2(ra[j][3].z, ra[j][3].w);
                LAS bf16* d = adst + ((s + 1) & 1) * (128 * SC_AP); *(LAS u32x4*)d = w0; *(LAS u32x4*)(d + 8) = w1; }
            __syncthreads();
        }
    }
#pragma unroll
    for (int m = 0; m < 4; ++m)
#pragma unroll
        for (int n = 0; n < 4; ++n) { u32x2 w; w.x = pk2(acc[m][n][0], acc[m][n][1]); w.y = pk2(acc[m][n][2], acc[m][n][3]);
            *(LAS u32x2*)(Pl + (64 * wr + 16 * m + r16) * SC_PP + 64 * wc + 16 * n + 4 * q) = w; }
    __syncthreads();
    {
        const float* pet = (const float*)(ws + WS_PET) + st * 128;
        const bf16* W2T = (const bf16*)(ws + WS_W2T) + st * 8192;
        const int nrow = 16 * wave + r16;
        f32x4 o[4];
#pragma unroll
        for (int dt = 0; dt < 4; ++dt) o[dt] = (f32x4){0.f, 0.f, 0.f, 0.f};
#pragma unroll
        for (int ks = 0; ks < 4; ++ks) {
            const int e0 = 32 * ks + 8 * q;
            const u32x4 pa = *(const LAS u32x4*)(Pl + nrow * SC_PP + e0), pb = *(const LAS u32x4*)(Pl + (nrow < 124 ? nrow + 4 : nrow) * SC_PP + 128 + e0);
            const f32x4 p0 = *(const f32x4*)(pet + e0), p1 = *(const f32x4*)(pet + e0 + 4);
            const f32x4 h0 = (f32x4){bflo(pa.x) + bflo(pb.x), bfhi(pa.x) + bfhi(pb.x), bflo(pa.y) + bflo(pb.y), bfhi(pa.y) + bfhi(pb.y)} + p0;
            const f32x4 h1 = (f32x4){bflo(pa.z) + bflo(pb.z), bfhi(pa.z) + bfhi(pb.z), bflo(pa.w) + bflo(pb.w), bfhi(pa.w) + bfhi(pb.w)} + p1;
            u32x4 w; w.x = pk2(siluf(h0.x), siluf(h0.y)); w.y = pk2(siluf(h0.z), siluf(h0.w)); w.z = pk2(siluf(h1.x), siluf(h1.y)); w.w = pk2(siluf(h1.z), siluf(h1.w));
            const bf16x8 af = __builtin_bit_cast(bf16x8, w);
#pragma unroll
            for (int dt = 0; dt < 4; ++dt) { const bf16x8 bf = *(const bf16x8*)(W2T + (size_t)(16 * dt + r16) * 128 + e0); o[dt] = MFMA16(af, bf, o[dt]); }
        }
        const int jj = 4 * wave + q, n = 32 * qd + jj;
        if (jj < 31) {
#pragma unroll
            for (int r = 0; r < 4; ++r) { float* dst = (float*)(ws + (st ? WS_VCS : WS_KCS)) + ((size_t)(b * 4 + r) * 128 + n) * 64;
#pragma unroll
                for (int dt = 0; dt < 4; ++dt) dst[16 * dt + r16] = o[dt][r]; }
        }
        if (tid < 256) { const int hh = tid >> 6, which = (tid >> 5) & 1, c4 = (tid & 31) * 4;
            const u32x2 v = *(const LAS u32x2*)(Pl + (which ? hh : 124 + hh) * SC_PP + which * 128 + c4);
            *(u32x2*)((bf16*)(ws + WS_PARTB) + ((((size_t)(st * 128 + b) * 4 + hh) * 4 + qd) * 2 + which) * 128 + c4) = v; }
        if (qd == 3 && tid < 256) { const int hh = tid >> 6; ((float*)(ws + (st ? WS_VCS : WS_KCS)))[((size_t)(b * 4 + hh) * 128 + 127) * 64 + (tid & 63)] = 0.f; }
    }
    __syncthreads();
}

__device__ __forceinline__ void compress_fixup_item(const Args& args, int item, int lane) {
    unsigned char* ws = args.ws;
    const int qd = item % 3, hh = (item / 3) & 3, b = (item / 12) & 127, st = item / (12 * 128);
    const bf16* PB = (const bf16*)(ws + WS_PARTB) + (((size_t)(st * 128 + b) * 4 + hh) * 4) * 2 * 128;
    const float* pet = (const float*)(ws + WS_PET) + st * 128; const float* w2 = INF(st ? 27 : 24);
    const float a0 = siluf(pet[lane] + bf2f(PB[(qd * 2 + 0) * 128 + lane]) + bf2f(PB[((qd + 1) * 2 + 1) * 128 + lane]));
    const float a1 = siluf(pet[64 + lane] + bf2f(PB[(qd * 2 + 0) * 128 + 64 + lane]) + bf2f(PB[((qd + 1) * 2 + 1) * 128 + 64 + lane]));
    float o = 0.f;
#pragma unroll 8
    for (int e = 0; e < 64; ++e) o += __shfl(a0, e) * w2[e * 64 + lane];
#pragma unroll 8
    for (int e = 0; e < 64; ++e) o += __shfl(a1, e) * w2[(64 + e) * 64 + lane];
    ((float*)(ws + (st ? WS_VCS : WS_KCS)))[((size_t)(b * 4 + hh) * 128 + 32 * qd + 31) * 64 + lane] = o;
}
#ifdef SELFCHECK
__device__ __forceinline__ void check_sample_compress(const Args& args, LAS unsigned char* lds, int bid, int tid) {
    unsigned char* ws = args.ws;
    const int st = bid & 1, bh = (bid * 37) % 512, n = (bid & 3) == 3 ? 32 * ((bid >> 2) % 3) + 31 : (bid * 11) % 127, b = bh >> 2, h = bh & 3;
    LAS float* hid = (LAS float*)lds;
    __syncthreads();
    if (tid < 128) {
        const float* pe = INF(st ? 25 : 22); const float* w1 = INF(st ? 26 : 23);
        float a = 0.f;
        for (int l = 0; l < 32; ++l) { const int t = 16 * n + l; const int page = ((const int*)args.in[5])[b * NPAGES + (t >> 7)];
            const float* row = INF(4) + (((size_t)page * 128 + (t & 127)) * 4 + st) * 256 + h * 64;
            for (int d = 0; d < 64; ++d) a += (row[d] + 0.f) * w1[((size_t)l * 64 + d) * 128 + tid] + pe[l * 64 + d] * w1[((size_t)l * 64 + d) * 128 + tid]; }
        hid[tid] = a / (1.f + __expf(-a));
    }
    __syncthreads();
    if (tid < 64) { const float* w2 = INF(st ? 27 : 24); float o = 0.f;
        for (int e = 0; e < 128; ++e) o += hid[e] * w2[e * 64 + tid];
        const float got = ((const float*)(ws + (st ? WS_VCS : WS_KCS)))[((size_t)bh * 128 + n) * 64 + tid];
        if (!(fabsf(got - o) <= 0.03f + 0.03f * fabsf(o))) atomicAdd((unsigned*)(ws + WS_CTL) + 8, 1u); }
    __syncthreads();
}
#endif
__device__ __forceinline__ void scan_phase(const Args& args, int gt, int NGT) {
    unsigned char* ws = args.ws; float* out = args.out;
    constexpr int NITEM = 4 * 32 * 64 * 32;
    for (int i0 = gt; i0 < NITEM; i0 += 2 * NGT) {
        const int i1 = i0 + NGT; const bool two = i1 < NITEM;
        const int ia[2] = {i0, two ? i1 : i0};
        size_t base[2]; const float* CSp[2]; f32x4 run[2];
#pragma unroll
        for (int k = 0; k < 2; ++k) { const int i = ia[k]; const int n4 = i & 31, p = (i >> 5) & 63, h = (i >> 11) & 31, b = i >> 16;
            base[k] = (((size_t)(b * 32) * 32 + h) * 64 + p) * 128 + 4 * n4; CSp[k] = (const float*)(ws + WS_CS) + (size_t)(b * 32 + h) * 4096; run[k] = (f32x4){0.f, 0.f, 0.f, 0.f}; }
#pragma unroll 1
        for (int c0 = 0; c0 < 32; c0 += 8) {
            f32x4 st[2][8]; float dec[2][8];
#pragma unroll
            for (int k = 0; k < 2; ++k)
#pragma unroll
                for (int j = 0; j < 8; ++j) { st[k][j] = *(const f32x4*)((const float*)(ws + WS_STATES) + base[k] + (size_t)(c0 + j) * (32 * 64 * 128)); dec[k][j] = CSp[k][(c0 + j) * 128 + 127]; }
#pragma unroll
            for (int j = 0; j < 8; ++j)
#pragma unroll
                for (int k = 0; k < 2; ++k) {
                    u32x2 o; o.x = pk2(run[k].x, run[k].y); o.y = pk2(run[k].z, run[k].w);
                    if (k == 0 || two) *(u32x2*)((bf16*)(ws + WS_HPREV) + base[k] + (size_t)(c0 + j) * (32 * 64 * 128)) = o;
                    run[k] = run[k] * __expf(dec[k][j]) + st[k][j];
                }
        }
#pragma unroll
        for (int k = 0; k < 2; ++k) if (k == 0 || two) { const int i = ia[k]; const int n4 = i & 31, p = (i >> 5) & 63, h = (i >> 11) & 31, b = i >> 16;
            *(f32x4*)(out + O_SSMP + (((size_t)(b * 32 + h) * 64 + p) * 128) + 4 * n4) = run[k]; }
    }
    for (int i = gt; i < MS * 4; i += NGT) { const int bs = i >> 2, g = i & 3; const float* p = (const float*)(ws + WS_MISC) + (size_t)(MP + bs) * 128 + 80 + g * 8;
        ((float*)(ws + WS_SSQ))[(size_t)(MP + bs) * 4 + g] = ((p[0] + p[1]) + (p[2] + p[3])) + ((p[4] + p[5]) + (p[6] + p[7])); }
}

constexpr int CNL_PITCH = 136;
struct DFrag { bf16x8 x[4]; f32x4 csa, csb, dta, dtb; };
__device__ __forceinline__ void ssd_out_load(const bf16* XT, const float* CS, const float* DT, int i, int q, int r16, DFrag& F) {
    const int sa = 32 * i + 4 * q, sb = sa + 16;
    F.csa = *(const f32x4*)(CS + sa); F.csb = *(const f32x4*)(CS + sb); F.dta = *(const f32x4*)(DT + sa); F.dtb = *(const f32x4*)(DT + sb);
#pragma unroll
    for (int pt = 0; pt < 4; ++pt) { const bf16* xr = XT + (size_t)i * 2048 + (16 * pt + r16) * 32 + 4 * q; const u32x2 lo = *(const u32x2*)xr, hi = *(const u32x2*)(xr + 16);
        F.x[pt] = __builtin_bit_cast(bf16x8, (u32x4){lo.x, lo.y, hi.x, hi.y}); }
}
template <int HL, int I>
__device__ __forceinline__ void ssd_out_diag(const LAS float* CBT, const DFrag& F, const float (&csl)[4], float Dh, int q, int r16, int lane, f32x4 (&acc)[4][4]) {
    const int sa = 32 * I + 4 * q, sb = sa + 16;
#pragma unroll
    for (int lt = 0; lt < 4; ++lt) {
        constexpr int dummy = 0; (void)dummy;
        const int LT = 4 * HL + lt;
        if (LT < 2 * I) continue;
        const int l = 16 * LT + r16;
        float ga[4], gb[4];
#pragma unroll
        for (int r = 0; r < 4; ++r) {
            const float va = CBT[(((2 * I) * 8 + LT) * 4 + r) * 64 + lane];
            const float vb = (LT >= 2 * I + 1) ? CBT[(((2 * I + 1) * 8 + LT) * 4 + r) * 64 + lane] : 0.f;
            const int s1 = sa + r, s2 = sb + r;
            float x1 = (l >= s1) ? va * __expf(csl[lt] - F.csa[r]) * F.dta[r] : 0.f;
            float x2 = (l >= s2) ? vb * __expf(csl[lt] - F.csb[r]) * F.dtb[r] : 0.f;
            if (l == s1) x1 += Dh;
            if (l == s2) x2 += Dh;
            ga[r] = x1; gb[r] = x2;
        }
        u32x4 o; o.x = pk2(ga[0], ga[1]); o.y = pk2(ga[2], ga[3]); o.z = pk2(gb[0], gb[1]); o.w = pk2(gb[2], gb[3]);
        const bf16x8 bf = __builtin_bit_cast(bf16x8, o);
#pragma unroll
        for (int pt = 0; pt < 4; ++pt) acc[pt][lt] = MFMA16(F.x[pt], bf, acc[pt][lt]);
    }
}
template <int HL>
__device__ __forceinline__ void ssd_out_half(const Args& args, const LAS float* CBT, const LAS bf16* CnL, LAS float* SQ, const bf16x8 (&hp)[16], const bf16* XT, const float* CS, const float* DT,
                                             float Dh, int b, int c, int h, int wave, int q, int r16, int lane) {
    unsigned char* ws = args.ws;
    float csl[4];
#pragma unroll
    for (int lt = 0; lt < 4; ++lt) csl[lt] = CS[64 * HL + 16 * lt + r16];
    DFrag FA, FB;
    ssd_out_load(XT, CS, DT, 0, q, r16, FA);
    f32x4 acc[4][4];
#pragma unroll
    for (int i = 0; i < 4; ++i)
#pragma unroll
        for (int j = 0; j < 4; ++j) acc[i][j] = (f32x4){0.f, 0.f, 0.f, 0.f};
#pragma unroll
    for (int ks = 0; ks < 4; ++ks)
#pragma unroll
        for (int lt = 0; lt < 4; ++lt) { const bf16x8 bf = *(const LAS bf16x8*)(CnL + (64 * HL + 16 * lt + r16) * CNL_PITCH + 32 * ks + 8 * q);
#pragma unroll
            for (int pt = 0; pt < 4; ++pt) acc[pt][lt] = MFMA16(hp[ks * 4 + pt], bf, acc[pt][lt]); }
#pragma unroll
    for (int lt = 0; lt < 4; ++lt) { const float e = __expf(csl[lt]);
#pragma unroll
        for (int pt = 0; pt < 4; ++pt) acc[pt][lt] = acc[pt][lt] * e; }
    ssd_out_load(XT, CS, DT, 1, q, r16, FB);
    ssd_out_diag<HL, 0>(CBT, FA, csl, Dh, q, r16, lane, acc);
    if (HL == 1) ssd_out_load(XT, CS, DT, 2, q, r16, FA);
    ssd_out_diag<HL, 1>(CBT, FB, csl, Dh, q, r16, lane, acc);
    if (HL == 1) {
        ssd_out_load(XT, CS, DT, 3, q, r16, FB);
        ssd_out_diag<HL, 2>(CBT, FA, csl, Dh, q, r16, lane, acc);
        ssd_out_diag<HL, 3>(CBT, FB, csl, Dh, q, r16, lane, acc);
    }
    const bf16* Z = (const bf16*)(ws + WS_Z); bf16* Y = (bf16*)(ws + WS_YSSM); const float* nw = INF(21) + h * 64;
    u32x2 zz[4][4];
#pragma unroll
    for (int lt = 0; lt < 4; ++lt)
#pragma unroll
        for (int pt = 0; pt < 4; ++pt) zz[lt][pt] = *(const u32x2*)(Z + ((size_t)b * 4096 + c * 128 + 64 * HL + 16 * lt + r16) * 2048 + h * 64 + 16 * pt + 4 * q);
#pragma unroll
    for (int lt = 0; lt < 4; ++lt) {
        const size_t m = (size_t)b * 4096 + c * 128 + 64 * HL + 16 * lt + r16;
        float ss = 0.f;
#pragma unroll
        for (int pt = 0; pt < 4; ++pt) {
            const int ch = 16 * pt + 4 * q;
            const f32x4 w = *(const f32x4*)(nw + ch);
            const float v0 = acc[pt][lt][0] * siluf(bflo(zz[lt][pt].x)), v1 = acc[pt][lt][1] * siluf(bfhi(zz[lt][pt].x)), v2 = acc[pt][lt][2] * siluf(bflo(zz[lt][pt].y)), v3 = acc[pt][lt][3] * siluf(bfhi(zz[lt][pt].y));
            ss += (v0 * v0 + v1 * v1) + (v2 * v2 + v3 * v3);
            u32x2 o; o.x = pk2(v0 * w.x, v1 * w.y); o.y = pk2(v2 * w.z, v3 * w.w);
            *(u32x2*)(Y + m * 2048 + h * 64 + ch) = o;
        }
        ss += __shfl_xor(ss, 16); ss += __shfl_xor(ss, 32);
        if (q == 0) SQ[wave * 128 + 64 * HL + 16 * lt + r16] = ss;
    }
}
__device__ __forceinline__ void ssd_out_unit(const Args& args, LAS unsigned char* lds, int unit, int wave, int lane_in, int tid) {
    int lane = lane_in; asm volatile("" : "+v"(lane));
    unsigned char* ws = args.ws;
    const int g = unit & 3, c = (unit >> 2) & 31, b = unit >> 7, h = g * 8 + wave, q = lane >> 4, r16 = lane & 15;
    LAS float* CBT = (LAS float*)lds; LAS bf16* CnL = (LAS bf16*)(lds + 65536); LAS float* SQ = (LAS float*)(lds + 65536 + 128 * CNL_PITCH * 2);
    const bf16* Bn = (const bf16*)(ws + WS_BN) + ((size_t)(b * 4 + g) * 4096 + c * 128) * 128;
    const bf16* Cn = (const bf16*)(ws + WS_CN) + ((size_t)(b * 4 + g) * 4096 + c * 128) * 128;
    {
        u32x4 cv[4];
#pragma unroll
        for (int i = 0; i < 4; ++i) cv[i] = *(const u32x4*)(Cn + (size_t)(wave * 64 + lane + 512 * i) * 8);
        bf16x8 bnf[4], hp[16];
#pragma unroll
        for (int ks = 0; ks < 4; ++ks) bnf[ks] = *(const bf16x8*)(Bn + (size_t)(16 * wave + r16) * 128 + 32 * ks + 8 * q);
        const bf16* HP = (const bf16*)(ws + WS_HPREV) + (((size_t)(b * 32 + c) * 32 + h) * 64) * 128;
#pragma unroll
        for (int ks = 0; ks < 4; ++ks)
#pragma unroll
            for (int pt = 0; pt < 4; ++pt) hp[ks * 4 + pt] = *(const bf16x8*)(HP + (size_t)(16 * pt + r16) * 128 + 32 * ks + 8 * q);
#pragma unroll
        for (int i = 0; i < 4; ++i) { const int id = wave * 64 + lane + 512 * i; *(LAS u32x4*)(CnL + (id >> 4) * CNL_PITCH + (id & 15) * 8) = cv[i]; }
        __syncthreads();
        for (int lt = wave; lt < 8; ++lt) {
            f32x4 d = (f32x4){0.f, 0.f, 0.f, 0.f};
#pragma unroll
            for (int ks = 0; ks < 4; ++ks) { const bf16x8 bf = *(const LAS bf16x8*)(CnL + (16 * lt + r16) * CNL_PITCH + 32 * ks + 8 * q); d = MFMA16(bnf[ks], bf, d); }
#pragma unroll
            for (int r = 0; r < 4; ++r) CBT[((wave * 8 + lt) * 4 + r) * 64 + lane] = d[r];
        }
        __syncthreads();
        const float* DT = (const float*)(ws + WS_DT) + (size_t)(b * 32 + h) * 4096 + c * 128; const float* CS = (const float*)(ws + WS_CS) + (size_t)(b * 32 + h) * 4096 + c * 128;
        const float Dh = INF(20)[h];
        const bf16* XT = (const bf16*)(ws + WS_XT) + ((size_t)(b * 32 + h) * 128 + c * 4) * 2048;
        ssd_out_half<0>(args, CBT, CnL, SQ, hp, XT, CS, DT, Dh, b, c, h, wave, q, r16, lane);
        ssd_out_half<1>(args, CBT, CnL, SQ, hp, XT, CS, DT, Dh, b, c, h, wave, q, r16, lane);
    }
    __syncthreads();
    if (tid < 128) { float s = 0.f;
#pragma unroll
        for (int w = 0; w < 8; ++w) s += SQ[w * 128 + tid];
        ((float*)(ws + WS_SSQ))[((size_t)b * 4096 + c * 128 + tid) * 4 + g] = s; }
    __syncthreads();
}
constexpr float SC2 = 0.125f * 1.4426950408889634f;
__device__ __forceinline__ float max3f(float a, float b, float c) { float r; asm("v_max3_f32 %0, %1, %2, %3" : "=v"(r) : "v"(a), "v"(b), "v"(c)); return r; }
template <class T> __device__ __forceinline__ T ldu(const void* ubase, unsigned lane_off) { return *(const T*)((const char*)ubase + lane_off); }
struct KFrag { bf16x8 kf[2][2]; };
__device__ __forceinline__ void flash_load(const bf16* Kp, int kb, unsigned koff, KFrag& F) {
#pragma unroll
    for (int kt = 0; kt < 2; ++kt) { const bf16* kr = Kp + (size_t)(kb + 16 * kt) * 64; F.kf[kt][0] = ldu<bf16x8>(kr, koff); F.kf[kt][1] = ldu<bf16x8>(kr + 32, koff); }
}
template <int MODE>
__device__ __forceinline__ void flash_step(const KFrag& F, const bf16* VTp, unsigned voff, int kb, int t0, int t, bool selbit, const LAS bf16x8* Qs,
                                           f32x4 (&O)[4][4], float (&mx)[4], f32x4 (&L)[4], int q) {
    const bf16x8 ones = __builtin_bit_cast(bf16x8, (u32x4){0x3f803f80u, 0x3f803f80u, 0x3f803f80u, 0x3f803f80u});
    const bool edge = (kb + 31 > t0) || (MODE == 1 && kb + 512 <= t0 + 15);
    bf16x8 vf[4];
#pragma unroll
    for (int dt = 0; dt < 4; ++dt) vf[dt] = ldu<bf16x8>(VTp + (size_t)(kb >> 5) * 2048 + (16 * dt) * 32, voff);
#pragma unroll
    for (int g = 0; g < 4; ++g) {
        asm volatile("" ::: "memory");
        __builtin_amdgcn_sched_barrier(0);
        const bf16x8 q0 = Qs[(g * 2 + 0) * 64], q1 = Qs[(g * 2 + 1) * 64];
        f32x4 S0 = MFMA16(F.kf[0][0], q0, ((f32x4){0.f, 0.f, 0.f, 0.f})), S1 = MFMA16(F.kf[1][0], q0, ((f32x4){0.f, 0.f, 0.f, 0.f}));
        S0 = MFMA16(F.kf[0][1], q1, S0); S1 = MFMA16(F.kf[1][1], q1, S1);
        float s[8];
#pragma unroll
        for (int r = 0; r < 4; ++r) { s[r] = S0[r]; s[4 + r] = S1[r]; }
        if (edge) {
#pragma unroll
            for (int i = 0; i < 8; ++i) { const int key = kb + 16 * (i >> 2) + 4 * q + (i & 3);
                const bool ok = (MODE == 0) ? (key <= t) : (key <= t && key + 512 > t); s[i] = ok ? s[i] : NEGF; }
        }
        float lm = max3f(max3f(s[0], s[1], s[2]), max3f(s[3], s[4], s[5]), fmaxf(s[6], s[7])) * SC2;
        if (MODE == 0) lm = selbit ? lm : NEGF;
        if (__builtin_amdgcn_ballot_w64(lm > mx[g] + 8.f) != 0ull) {
            float tmax = fmaxf(lm, __shfl_xor(lm, 16)); tmax = fmaxf(tmax, __shfl_xor(tmax, 32));
            const float mnew = fmaxf(mx[g], tmax), alpha = __builtin_amdgcn_exp2f(mx[g] - mnew); mx[g] = mnew; L[g] = L[g] * alpha;
#pragma unroll
            for (int dt = 0; dt < 4; ++dt) O[dt][g] = O[dt][g] * alpha;
        }
        float nmuse = -fmaxf(mx[g], -1e20f);
        if (MODE == 0) nmuse = selbit ? nmuse : NEGF;
#pragma unroll
        for (int i = 0; i < 8; ++i) s[i] = __builtin_amdgcn_exp2f(__builtin_fmaf(s[i], SC2, nmuse));
        u32x4 pw; pw.x = pk2(s[0], s[1]); pw.y = pk2(s[2], s[3]); pw.z = pk2(s[4], s[5]); pw.w = pk2(s[6], s[7]);
        const bf16x8 pf = __builtin_bit_cast(bf16x8, pw);
        L[g] = MFMA16(ones, pf, L[g]);
#pragma unroll
        for (int dt = 0; dt < 4; ++dt) O[dt][g] = MFMA16(vf[dt], pf, O[dt][g]);
    }
}
template <int MODE>
__device__ __forceinline__ void flash_branch(const bf16* Kp, const bf16* VTp, int jfirst, int jlast, unsigned ulo, unsigned uhi, unsigned mlo, unsigned mhi,
                                             int t0, int t, const LAS bf16x8* Qs, f32x4 (&O)[4][4], float (&mx)[4], f32x4 (&L)[4], int q, int r16) {
    const unsigned koff = (unsigned)(r16 * 64 + 8 * q) * 2u, voff = (unsigned)(r16 * 32 + 8 * q) * 2u;
    int jb = jfirst;
    while (jb <= jlast && !((jb < 32 ? (ulo >> jb) : (uhi >> (jb - 32))) & 1u)) ++jb;
    if (jb > jlast) return;
    KFrag A, B;
    flash_load(Kp, 64 * jb, koff, A);
    for (;;) {
        flash_load(Kp, 64 * jb + 32, koff, B);
        const bool selbit = ((jb < 32 ? (mlo >> jb) : (mhi >> (jb - 32))) & 1u) != 0u;
        flash_step<MODE>(A, VTp, voff, 64 * jb, t0, t, selbit, Qs, O, mx, L, q);
        int jn = jb + 1;
        while (jn <= jlast && !((jn < 32 ? (ulo >> jn) : (uhi >> (jn - 32))) & 1u)) ++jn;
        if (jn <= jlast) flash_load(Kp, 64 * jn, koff, A);
        flash_step<MODE>(B, VTp, voff, 64 * jb + 32, t0, t, selbit, Qs, O, mx, L, q);
        if (jn > jlast) break;
        jb = jn;
    }
}

template <int BR>
__device__ __forceinline__ void attn_finish(const Args& args, f32x4 (&O)[4][4], const f32x4 (&L)[4], bool normalise, size_t m, int hkv, int q) {
    unsigned char* ws = args.ws;
    const float* gates = (const float*)(ws + WS_MISC) + m * 128 + 32;
    const unsigned yoff = (unsigned)((m & 15) * 1024 + 4 * q) * 4u, yboff = yoff >> 1;
#pragma unroll
    for (int g = 0; g < 4; ++g) {
        float sc = sigmf(gates[(hkv * 4 + g) * 3 + BR]);
        if (normalise) sc *= 1.f / fmaxf(L[g][0], TINYF);
#pragma unroll
        for (int dt = 0; dt < 4; ++dt) {
            char* yfu = (char*)((float*)(ws + WS_YATTF) + (m & ~(size_t)15) * 1024 + (hkv * 4 + g) * 64 + 16 * dt);
            f32x4 v = O[dt][g] * sc;
            if (BR > 0) v = v + *(const f32x4*)(yfu + yoff);
            if (BR < 2) *(f32x4*)(yfu + yoff) = v;
            else { u32x2 o; o.x = pk2(v.x, v.y); o.y = pk2(v.z, v.w); *(u32x2*)((char*)((bf16*)(ws + WS_YATT) + (m & ~(size_t)15) * 1024 + (hkv * 4 + g) * 64 + 16 * dt) + yboff) = o; }
        }
    }
}

__device__ __forceinline__ void cmp_pass1_tile(const bf16x8& k0, const bf16x8& k1, int kt, const LAS bf16x8* Qs, int t, int q, float (&mx)[4], float (&ls)[4]) {
#pragma unroll
    for (int g = 0; g < 4; ++g) {
        f32x4 s = MFMA16(k0, Qs[(g * 2 + 0) * 64], ((f32x4){0.f, 0.f, 0.f, 0.f})); s = MFMA16(k1, Qs[(g * 2 + 1) * 64], s);
        float tmax = NEGF;
#pragma unroll
        for (int r = 0; r < 4; ++r) { const int n = 16 * kt + 4 * q + r; const bool ok = (16 * n + 31 <= t); s[r] = ok ? s[r] * 0.125f : NEGF; tmax = fmaxf(tmax, s[r]); }
        const float mnew = fmaxf(mx[g], tmax); float ps = 0.f;
#pragma unroll
        for (int r = 0; r < 4; ++r) ps += (s[r] > 0.5f * NEGF) ? __expf(s[r] - mnew) : 0.f;
        ls[g] = ls[g] * __expf(mx[g] - mnew) + ps; mx[g] = mnew;
    }
}
__device__ __forceinline__ void attn_prompt_unit(const Args& args, LAS float* impL, int unit, bool xcdmap, int lane_in) {
    int lane = lane_in; asm volatile("" : "+v"(lane));
    unsigned char* ws = args.ws;
    const int q = lane >> 4, r16 = lane & 15;
    const int pass = unit >> 11, gwv = unit & 2047, xcd = (gwv >> 3) & 7, wx = (gwv >> 6) * 8 + (gwv & 7);
    const int bh = xcdmap ? 2 * xcd + pass : (unit & 15), b = bh >> 2, hkv = bh & 3;
    const int tile = xcdmap ? (pass == 0 ? 255 - wx : wx) : (unit < 2048 ? 255 - (unit >> 4) : (unit - 2048) >> 4);
    const int t0 = tile * 16, t = t0 + r16; const size_t m = (size_t)b * 4096 + t;
    LAS bf16x8* Qs = (LAS bf16x8*)(impL + 1024) + lane;
#pragma unroll
    for (int g = 0; g < 4; ++g)
#pragma unroll
        for (int ks = 0; ks < 2; ++ks) Qs[(g * 2 + ks) * 64] = ldu<bf16x8>((const bf16*)(ws + WS_Q) + ((size_t)b * 4096 + t0) * 1024 + (hkv * 4 + g) * 64 + 32 * ks, (unsigned)(r16 * 1024 + 8 * q) * 2u);
    LDS_WAIT(); asm volatile("" ::: "memory");
    f32x4 O[4][4]; float mx[4], ls[4];
    const bf16* KCp = (const bf16*)(ws + WS_KC) + (size_t)bh * 256 * 64; const bf16* VCTp = (const bf16*)(ws + WS_VCT) + (size_t)bh * 64 * 256;
    const unsigned kcoff = (unsigned)(r16 * 64 + 8 * q) * 2u, vcoff = (unsigned)(r16 * 32 + 8 * q) * 2u;
    const int nmax = (t0 + 15 >= 31) ? ((t0 + 15 - 31) >> 4) : -1;
    const int NP = nmax < 0 ? 0 : (nmax / 32 + 2 < 8 ? nmax / 32 + 2 : 8);
#pragma unroll
    for (int g = 0; g < 4; ++g) { mx[g] = NEGF; ls[g] = 0.f; }
    {
        bf16x8 ka0, ka1, kb0, kb1;
        if (NP > 0) { ka0 = ldu<bf16x8>(KCp, kcoff); ka1 = ldu<bf16x8>(KCp + 32, kcoff); }
#pragma unroll 1
        for (int kt = 0; kt < 2 * NP; kt += 2) {
            { const bf16* kr = KCp + (size_t)(16 * (kt + 1)) * 64; kb0 = ldu<bf16x8>(kr, kcoff); kb1 = ldu<bf16x8>(kr + 32, kcoff); }
            cmp_pass1_tile(ka0, ka1, kt, Qs, t, q, mx, ls);
            if (kt + 2 < 2 * NP) { const bf16* kr = KCp + (size_t)(16 * (kt + 2)) * 64; ka0 = ldu<bf16x8>(kr, kcoff); ka1 = ldu<bf16x8>(kr + 32, kcoff); }
            cmp_pass1_tile(kb0, kb1, kt + 1, Qs, t, q, mx, ls);
        }
    }
    float invL[4];
#pragma unroll
    for (int g = 0; g < 4; ++g) {
        float M = fmaxf(mx[g], __shfl_xor(mx[g], 16)); M = fmaxf(M, __shfl_xor(M, 32));
        float l = ls[g] * __expf(mx[g] - M); l += __shfl_xor(l, 16); l += __shfl_xor(l, 32);
        mx[g] = M; invL[g] = 1.f / fmaxf(l, TINYF);
    }
#pragma unroll
    for (int dt = 0; dt < 4; ++dt)
#pragma unroll
        for (int g = 0; g < 4; ++g) O[dt][g] = (f32x4){0.f, 0.f, 0.f, 0.f};
    float prev3 = 0.f;
#pragma unroll
    for (int kt = 0; kt < 16; ++kt) impL[kt * 64 + lane] = 0.f;
    bf16x8 kc[2][2], vcf[4];
    if (NP > 0) {
#pragma unroll
        for (int kk = 0; kk < 2; ++kk) { const bf16* kr = KCp + (size_t)(16 * kk) * 64; kc[kk][0] = ldu<bf16x8>(kr, kcoff); kc[kk][1] = ldu<bf16x8>(kr + 32, kcoff); }
#pragma unroll
        for (int dt = 0; dt < 4; ++dt) vcf[dt] = ldu<bf16x8>(VCTp + (16 * dt) * 32, vcoff);
    }
#pragma unroll 1
    for (int i = 0; i < NP; ++i) {
        bf16x8 kn[2][2], vn[4];
        if (i + 1 < NP) {
#pragma unroll
            for (int kk = 0; kk < 2; ++kk) { const bf16* kr = KCp + (size_t)(16 * (2 * i + 2 + kk)) * 64; kn[kk][0] = ldu<bf16x8>(kr, kcoff); kn[kk][1] = ldu<bf16x8>(kr + 32, kcoff); }
#pragma unroll
            for (int dt = 0; dt < 4; ++dt) vn[dt] = ldu<bf16x8>(VCTp + (size_t)(i + 1) * 2048 + (16 * dt) * 32, vcoff);
        }
        f32x4 P[2][4];
#pragma unroll
        for (int kk = 0; kk < 2; ++kk) {
            const int kt = 2 * i + kk;
            const bf16x8 k0 = kc[kk][0], k1 = kc[kk][1];
            f32x4 psum = (f32x4){0.f, 0.f, 0.f, 0.f};
#pragma unroll
            for (int g = 0; g < 4; ++g) {
                f32x4 s = MFMA16(k0, Qs[(g * 2 + 0) * 64], ((f32x4){0.f, 0.f, 0.f, 0.f})); s = MFMA16(k1, Qs[(g * 2 + 1) * 64], s);
#pragma unroll
                for (int r = 0; r < 4; ++r) { const int n = 16 * kt + 4 * q + r; const bool ok = (16 * n + 31 <= t); s[r] = ok ? __expf(s[r] * 0.125f - mx[g]) * invL[g] : 0.f; }
                P[kk][g] = s; psum = psum + s;
            }
            const float a = __shfl(psum[3], (lane + 48) & 63), bb = __shfl(prev3, (lane + 48) & 63);
            impL[kt * 64 + lane] = 2.f * (psum[0] + psum[1] + psum[2]) + psum[3] + (q > 0 ? a : bb);
            prev3 = psum[3];
        }
#pragma unroll
        for (int g = 0; g < 4; ++g) {
            u32x4 pw; pw.x = pk2(P[0][g][0], P[0][g][1]); pw.y = pk2(P[0][g][2], P[0][g][3]); pw.z = pk2(P[1][g][0], P[1][g][1]); pw.w = pk2(P[1][g][2], P[1][g][3]);
            const bf16x8 pf = __builtin_bit_cast(bf16x8, pw);
#pragma unroll
            for (int dt = 0; dt < 4; ++dt) O[dt][g] = MFMA16(vcf[dt], pf, O[dt][g]);
        }
        if (i + 1 < NP) {
#pragma unroll
            for (int kk = 0; kk < 2; ++kk) { kc[kk][0] = kn[kk][0]; kc[kk][1] = kn[kk][1]; }
#pragma unroll
            for (int dt = 0; dt < 4; ++dt) vcf[dt] = vn[dt];
        }
    }
    f32x4 L[4];
#pragma unroll
    for (int g = 0; g < 4; ++g) L[g] = (f32x4){1.f, 1.f, 1.f, 1.f};
    attn_finish<0>(args, O, L, false, m, hkv, q);
    unsigned mlo = 0u, mhi = 0u;
    {
        const int cur = t >> 6;
        LDS_WAIT(); asm volatile("" ::: "memory");
        unsigned key[16];
#pragma unroll
        for (int kt = 0; kt < 16; ++kt) { const int j = 4 * kt + q; const bool valid = (64 * j <= t), forced = (j == 0) || (j == cur) || (j == cur - 1);
            const float val = valid ? (forced ? BIGF : impL[kt * 64 + lane]) : -BIGF; const unsigned u = __builtin_bit_cast(unsigned, val);
            key[kt] = (u & 0x80000000u) ? ~u : (u | 0x80000000u); }
        unsigned T = 0u;
#pragma unroll 1
        for (int bit = 31; bit >= 0; --bit) {
            const unsigned cand = T | (1u << bit);
            int cnt = 0;
#pragma unroll
            for (int kt = 0; kt < 16; ++kt) cnt += key[kt] >= cand ? 1 : 0;
            cnt += __shfl_xor(cnt, 16); cnt += __shfl_xor(cnt, 32);
            T = cnt >= 16 ? cand : T;
        }
        int cgt = 0;
#pragma unroll
        for (int kt = 0; kt < 16; ++kt) cgt += key[kt] > T ? 1 : 0;
        cgt += __shfl_xor(cgt, 16); cgt += __shfl_xor(cgt, 32);
        const int need = 16 - cgt;
        unsigned elo = 0u, ehi = 0u;
#pragma unroll
        for (int kt = 0; kt < 16; ++kt) { const int j = 4 * kt + q; const unsigned bit = key[kt] == T ? 1u : 0u; if (kt < 8) elo |= bit << j; else ehi |= bit << (j - 32); }
        elo |= __shfl_xor(elo, 16); elo |= __shfl_xor(elo, 32); ehi |= __shfl_xor(ehi, 16); ehi |= __shfl_xor(ehi, 32);
        const int pclo = __popc(elo);
#pragma unroll
        for (int kt = 0; kt < 16; ++kt) { const int j = 4 * kt + q;
            const int before = kt < 8 ? __popc(elo & ((1u << j) - 1u)) : pclo + __popc(ehi & ((1u << (j - 32)) - 1u));
            const unsigned bit = (key[kt] > T || (key[kt] == T && before < need)) ? 1u : 0u;
            if (kt < 8) mlo |= bit << j; else mhi |= bit << (j - 32); }
        mlo |= __shfl_xor(mlo, 16); mlo |= __shfl_xor(mlo, 32); mhi |= __shfl_xor(mhi, 16); mhi |= __shfl_xor(mhi, 32);
    }
    unsigned ulo = mlo, uhi = mhi;
#pragma unroll
    for (int o = 1; o < 16; o <<= 1) { ulo |= __shfl_xor(ulo, o); uhi |= __shfl_xor(uhi, o); }
    ulo = __builtin_amdgcn_readfirstlane(ulo); uhi = __builtin_amdgcn_readfirstlane(uhi);
    {
#pragma unroll
        for (int g = 0; g < 4; ++g) { mx[g] = NEGF; L[g] = (f32x4){0.f, 0.f, 0.f, 0.f}; }
#pragma unroll
        for (int dt = 0; dt < 4; ++dt)
#pragma unroll
            for (int g = 0; g < 4; ++g) O[dt][g] = (f32x4){0.f, 0.f, 0.f, 0.f};
        const bf16* Kp = (const bf16*)(ws + WS_KVH) + ((size_t)(2 * 4 + b) * 4 + hkv) * 4096 * 64;
        const bf16* VTp = (const bf16*)(ws + WS_VT) + ((size_t)(0 * 4 + b) * 4 + hkv) * 64 * 4096;
        flash_branch<0>(Kp, VTp, 0, (t0 + 15) >> 6, ulo, uhi, mlo, mhi, t0, t, Qs, O, mx, L, q, r16);
        attn_finish<1>(args, O, L, true, m, hkv, q);
    }
    {
#pragma unroll
        for (int g = 0; g < 4; ++g) { mx[g] = NEGF; L[g] = (f32x4){0.f, 0.f, 0.f, 0.f}; }
#pragma unroll
        for (int dt = 0; dt < 4; ++dt)
#pragma unroll
            for (int g = 0; g < 4; ++g) O[dt][g] = (f32x4){0.f, 0.f, 0.f, 0.f};
        const bf16* Kp = (const bf16*)(ws + WS_KVH) + ((size_t)(4 * 4 + b) * 4 + hkv) * 4096 * 64;
        const bf16* VTp = (const bf16*)(ws + WS_VT) + ((size_t)(1 * 4 + b) * 4 + hkv) * 64 * 4096;
        const int jbeg = t0 >= 511 ? (t0 - 511) >> 6 : 0, jend = (t0 + 15) >> 6;
        flash_branch<1>(Kp, VTp, jbeg, jend, 0xffffffffu, 0xffffffffu, 0xffffffffu, 0xffffffffu, t0, t, Qs, O, mx, L, q, r16);
        attn_finish<2>(args, O, L, true, m, hkv, q);
    }
}
#ifdef SELFCHECK
__device__ __forceinline__ void check_attn_prompt(const Args& args, LAS unsigned char* lds, int bid, int tid) {
    unsigned char* ws = args.ws;
    const int tl[12] = {0, 15, 30, 31, 63, 64, 127, 511, 512, 1023, 1024, 4095};
    int t = (bid * 997 + 13) % 4096;
#pragma unroll
    for (int i = 0; i < 12; ++i) t = (bid == i) ? tl[i] : t;
    const int b = bid & 3, hkv = (bid >> 2) & 3, bh = b * 4 + hkv; const size_t m = (size_t)b * 4096 + t;
    LAS float* qf = (LAS float*)lds;
    LAS float* sc = qf + 256;
    LAS float* imp = sc + 1024;
    LAS int* sel = (LAS int*)(imp + 64);
    LAS float* ss = (LAS float*)(sel + 16);
    LAS float* res = ss + 4096;
    LAS float* red = res + 256;
    const bf16* Q = (const bf16*)(ws + WS_Q) + m * 1024 + hkv * 256;
    const bf16* KC = (const bf16*)(ws + WS_KC) + (size_t)bh * 256 * 64;
    const bf16* VCT = (const bf16*)(ws + WS_VCT) + (size_t)bh * 64 * 256;
    const float* gates = (const float*)(ws + WS_MISC) + m * 128 + 32 + hkv * 12;
    __syncthreads();
    if (tid < 256) { qf[tid] = bf2f(Q[tid]); res[tid] = 0.f; }
    __syncthreads();
    for (int i = tid; i < 1024; i += 512) { const int g = i >> 8, n = i & 255; float s = NEGF;
        if (n < 255 && 16 * n + 31 <= t) { float a = 0.f; for (int d = 0; d < 64; ++d) a += qf[g * 64 + d] * bf2f(KC[n * 64 + d]); s = a * 0.125f; }
        sc[i] = s; }
    __syncthreads();
    if (tid < 4) { float mx = NEGF; for (int n = 0; n < 255; ++n) mx = fmaxf(mx, sc[tid * 256 + n]);
        float sum = 0.f; for (int n = 0; n < 255; ++n) { const float s = sc[tid * 256 + n]; const float e = (s > 0.5f * NEGF) ? __expf(s - mx) : 0.f; sc[tid * 256 + n] = e; sum += e; }
        const float inv = 1.f / fmaxf(sum, TINYF); for (int n = 0; n < 255; ++n) sc[tid * 256 + n] *= inv; sc[tid * 256 + 255] = 0.f; }
    __syncthreads();
    if (tid < 256) { const int g = tid >> 6, d = tid & 63; float o = 0.f;
        for (int n = 0; n < 255; ++n) { const int kk = n & 31, kpos = 8 * ((kk & 15) >> 2) + 4 * (kk >> 4) + (kk & 3);
            o += sc[g * 256 + n] * bf2f(VCT[(size_t)(n >> 5) * 2048 + d * 32 + kpos]); }
        res[tid] += sigmf(gates[g * 3 + 0]) * o; }
    if (tid >= 256 && tid < 320) { const int j = tid - 256; float a = 0.f;
        for (int i = 0; i < 255; ++i) { const int lo = max(16 * i, 64 * j), hi = min(16 * i + 32, 64 * j + 64); const int ov = hi > lo ? hi - lo : 0;
            a += ((sc[i] + sc[256 + i]) + (sc[512 + i] + sc[768 + i])) * ((float)ov * (1.f / 16.f)); }
        const int cur = t >> 6; const bool valid = 64 * j <= t, forced = (j == 0) || (j == cur) || (j == cur - 1);
        imp[j] = valid ? (forced ? BIGF : a) : -BIGF; }
    __syncthreads();
    if (tid == 0) { unsigned long long taken = 0ull;
        for (int k = 0; k < 16; ++k) { int best = -1; float bv = 0.f;
            for (int j = 0; j < 64; ++j) if (!((taken >> j) & 1ull) && (best < 0 || imp[j] > bv)) { best = j; bv = imp[j]; }
            taken |= 1ull << best; sel[k] = best; } }
    __syncthreads();
    for (int br = 1; br < 3; ++br) {
        const bf16* Kp = (const bf16*)(ws + WS_KVH) + ((size_t)((br == 1 ? 2 : 4) * 4 + b) * 4 + hkv) * 4096 * 64;
        const bf16* Vp = (const bf16*)(ws + WS_KVH) + ((size_t)((br == 1 ? 3 : 5) * 4 + b) * 4 + hkv) * 4096 * 64;
        const int nk = br == 1 ? 1024 : 512;
        for (int i = tid; i < 4 * nk; i += 512) { const int g = i / nk, k = i % nk;
            const int pos = br == 1 ? sel[k >> 6] * 64 + (k & 63) : t - 511 + k;
            float s = NEGF;
            if (pos >= 0 && pos <= t && pos < 4096) { float a = 0.f; for (int d = 0; d < 64; ++d) a += qf[g * 64 + d] * bf2f(Kp[(size_t)pos * 64 + d]); s = a * 0.125f; }
            ss[g * 1024 + k] = s; }
        __syncthreads();
        if (tid < 4) { float mx = NEGF; for (int k = 0; k < nk; ++k) mx = fmaxf(mx, ss[tid * 1024 + k]);
            float sum = 0.f; for (int k = 0; k < nk; ++k) { const float s = ss[tid * 1024 + k]; const float e = (s > 0.5f * NEGF) ? __expf(s - mx) : 0.f; ss[tid * 1024 + k] = e; sum += e; }
            red[tid] = 1.f / fmaxf(sum, TINYF); }
        __syncthreads();
        if (tid < 256) { const int g = tid >> 6, d = tid & 63; float o = 0.f;
            for (int k = 0; k < nk; ++k) { const float p = ss[g * 1024 + k]; if (p != 0.f) { const int pos = br == 1 ? sel[k >> 6] * 64 + (k & 63) : t - 511 + k; o += p * bf2f(Vp[(size_t)pos * 64 + d]); } }
            res[tid] += sigmf(gates[g * 3 + br]) * o * red[g]; }
        __syncthreads();
    }
    if (tid < 256) { const float ref = res[tid], got = bf2f(((const bf16*)(ws + WS_YATT))[m * 1024 + hkv * 256 + tid]);
        if (!(fabsf(got - ref) <= 0.003f + 0.03f * fabsf(ref))) atomicAdd((unsigned*)(ws + WS_CTL) + 8, 1u); }
    __syncthreads();
}
#endif
#ifdef SELFCHECK
__device__ __forceinline__ void check_attn_sample(const Args& args, LAS unsigned char* lds, int bid, int tid) {
    unsigned char* ws = args.ws; const float* out = args.out;
    const int u = (bid * 2 + 1) % 512, bs = u >> 2, hkv = u & 3; const size_t m = MP + bs;
    LAS float* qf = (LAS float*)lds; LAS float* sc = qf + 256; LAS float* imp = sc + 512; LAS int* sel = (LAS int*)(imp + 64);
    LAS float* ss = (LAS float*)(sel + 16); LAS float* res = ss + 4096; LAS float* red = res + 256;
    const bf16* Q = (const bf16*)(ws + WS_Q) + m * 1024 + hkv * 256;
    const float* KCS = (const float*)(ws + WS_KCS) + (size_t)(bs * 4 + hkv) * 128 * 64; const float* VCS = (const float*)(ws + WS_VCS) + (size_t)(bs * 4 + hkv) * 128 * 64;
    const float* gates = (const float*)(ws + WS_MISC) + m * 128 + 32 + hkv * 12;
    const int* pt = (const int*)args.in[5] + bs * NPAGES; const float* cache = INF(4); const float* cwin = INF(6);
    __syncthreads();
    if (tid < 256) { qf[tid] = bf2f(Q[tid]); res[tid] = 0.f; }
    __syncthreads();
    { const int g = tid >> 7, n = tid & 127; float s = NEGF;
      if (n < 127) { float a = 0.f; for (int d = 0; d < 64; ++d) a += qf[g * 64 + d] * KCS[n * 64 + d]; s = a * 0.125f; }
      sc[tid] = s; }
    __syncthreads();
    if (tid < 4) { float mx = NEGF; for (int n = 0; n < 127; ++n) mx = fmaxf(mx, sc[tid * 128 + n]);
        float sum = 0.f; for (int n = 0; n < 127; ++n) { const float e = __expf(sc[tid * 128 + n] - mx); sc[tid * 128 + n] = e; sum += e; }
        const float inv = 1.f / fmaxf(sum, TINYF); for (int n = 0; n < 127; ++n) sc[tid * 128 + n] *= inv; sc[tid * 128 + 127] = 0.f; }
    __syncthreads();
    if (tid < 256) { const int g = tid >> 6, d = tid & 63; float o = 0.f; for (int n = 0; n < 127; ++n) o += sc[g * 128 + n] * VCS[n * 64 + d]; res[tid] += sigmf(gates[g * 3 + 0]) * o; }
    if (tid >= 256 && tid < 256 + 33) { const int j = tid - 256; float a = 0.f;
        for (int i = 0; i < 127; ++i) { const int lo = max(16 * i, 64 * j), hi = min(16 * i + 32, 64 * j + 64); const int ov = hi > lo ? hi - lo : 0;
            a += ((sc[i] + sc[128 + i]) + (sc[256 + i] + sc[384 + i])) * ((float)ov * (1.f / 16.f)); }
        imp[j] = (j == 0 || j == 32 || j == 31) ? BIGF : a; }
    __syncthreads();
    if (tid == 0) { unsigned long long taken = 0ull;
        for (int k = 0; k < 16; ++k) { int best = -1; float bv = 0.f;
            for (int j = 0; j < 33; ++j) if (!((taken >> j) & 1ull) && (best < 0 || imp[j] > bv)) { best = j; bv = imp[j]; }
            taken |= 1ull << best; sel[k] = best; } }
    __syncthreads();
    for (int br = 1; br < 3; ++br) {
        const int nk = br == 1 ? 1024 : 513;
        for (int i = tid; i < 4 * nk; i += 512) { const int g = i / nk, k = i % nk; float s = NEGF; const float* kr = nullptr;
            if (br == 1) { const int pos = sel[k >> 6] * 64 + (k & 63);
                if (pos < 2048) kr = cache + (((size_t)pt[pos >> 7] * 128 + (pos & 127)) * 4 + 2) * 256 + hkv * 64;
                else if (pos == 2048) kr = out + O_KVS + ((size_t)bs * 4 + 2) * 256 + hkv * 64; }
            else { if (k >= 1 && k < 512) kr = cwin + (((size_t)bs * 512 + k) * 2 + 0) * 256 + hkv * 64;
                   else if (k == 512) kr = out + O_WINS + (((size_t)bs * 512 + 511) * 2 + 0) * 256 + hkv * 64; }
            if (kr) { float a = 0.f; for (int d = 0; d < 64; ++d) a += qf[g * 64 + d] * kr[d]; s = a * 0.125f; }
            ss[g * 1024 + k] = s; }
        __syncthreads();
        if (tid < 4) { float mx = NEGF; for (int k = 0; k < nk; ++k) mx = fmaxf(mx, ss[tid * 1024 + k]);
            float sum = 0.f; for (int k = 0; k < nk; ++k) { const float s = ss[tid * 1024 + k]; const float e = (s > 0.5f * NEGF) ? __expf(s - mx) : 0.f; ss[tid * 1024 + k] = e; sum += e; }
            red[tid] = 1.f / fmaxf(sum, TINYF); }
        __syncthreads();
        if (tid < 256) { const int g = tid >> 6, d = tid & 63; float o = 0.f;
            for (int k = 0; k < nk; ++k) { const float p = ss[g * 1024 + k]; if (p != 0.f) { const float* vr;
                if (br == 1) { const int pos = sel[k >> 6] * 64 + (k & 63);
                    vr = pos < 2048 ? cache + (((size_t)pt[pos >> 7] * 128 + (pos & 127)) * 4 + 3) * 256 + hkv * 64 : out + O_KVS + ((size_t)bs * 4 + 3) * 256 + hkv * 64; }
                else vr = k < 512 ? cwin + (((size_t)bs * 512 + k) * 2 + 1) * 256 + hkv * 64 : out + O_WINS + (((size_t)bs * 512 + 511) * 2 + 1) * 256 + hkv * 64;
                o += p * vr[d]; } }
            res[tid] += sigmf(gates[g * 3 + br]) * o * red[g]; }
        __syncthreads();
    }
    if (tid < 256) { const float ref = res[tid], got = bf2f(((const bf16*)(ws + WS_YATT))[m * 1024 + hkv * 256 + tid]);
        if (!(fabsf(got - ref) <= 0.003f + 0.03f * fabsf(ref))) atomicAdd((unsigned*)(ws + WS_CTL) + 8, 1u); }
    __syncthreads();
}
__device__ __forceinline__ void check_prompt_compress(const Args& args, LAS unsigned char* lds, int bid, int tid) {
    unsigned char* ws = args.ws;
    const int st = bid & 1, bh = (bid * 5) % 16, n = (bid * 11 + 3) % 255;
    LAS float* hid = (LAS float*)lds;
    const bf16* X = (const bf16*)(ws + WS_KVH) + ((size_t)st * 16 + bh) * 4096 * 64;
    __syncthreads();
    if (tid < 128) { const float* pe = INF(st ? 25 : 22); const float* w1 = INF(st ? 26 : 23); float a = 0.f;
        for (int l = 0; l < 32; ++l) for (int d = 0; d < 64; ++d) a += (bf2f(X[(size_t)(16 * n + l) * 64 + d]) + pe[l * 64 + d]) * w1[((size_t)l * 64 + d) * 128 + tid];
        hid[tid] = a / (1.f + __expf(-a)); }
    __syncthreads();
    if (tid < 64) { const float* w2 = INF(st ? 27 : 24); float o = 0.f;
        for (int e = 0; e < 128; ++e) o += hid[e] * w2[e * 64 + tid];
        const int kk = n & 31, kpos = 8 * ((kk & 15) >> 2) + 4 * (kk >> 4) + (kk & 3);
        const float got = st == 0 ? bf2f(((const bf16*)(ws + WS_KC))[((size_t)bh * 256 + n) * 64 + tid]) : bf2f(((const bf16*)(ws + WS_VCT))[((size_t)bh * 8 + (n >> 5)) * 2048 + tid * 32 + kpos]);
        if (!(fabsf(got - o) <= 0.03f + 0.03f * fabsf(o))) atomicAdd((unsigned*)(ws + WS_CTL) + 8, 1u); }
    __syncthreads();
}
#endif
__device__ __forceinline__ void dot4_reduce(const float (&qv)[4], float kx, int lane, float (&sg)[4]) {
    const float v0 = qv[0] * kx, v1 = qv[1] * kx, v2 = qv[2] * kx, v3 = qv[3] * kx;
    const bool up = (lane & 32) != 0, up2 = (lane & 16) != 0;
    const float r0 = (up ? v2 : v0) + __shfl_xor(up ? v0 : v2, 32), r1 = (up ? v3 : v1) + __shfl_xor(up ? v1 : v3, 32);
    float x = (up2 ? r1 : r0) + __shfl_xor(up2 ? r0 : r1, 16);
    x += __shfl_xor(x, 8); x += __shfl_xor(x, 4); x += __shfl_xor(x, 2); x += __shfl_xor(x, 1);
    const int xi = __builtin_bit_cast(int, x);
    sg[0] = __builtin_bit_cast(float, __builtin_amdgcn_readlane(xi, 0)); sg[1] = __builtin_bit_cast(float, __builtin_amdgcn_readlane(xi, 16));
    sg[2] = __builtin_bit_cast(float, __builtin_amdgcn_readlane(xi, 32)); sg[3] = __builtin_bit_cast(float, __builtin_amdgcn_readlane(xi, 48));
}
struct SampleRows { const float* cache; const float* cwin; float* out; const LAS int* selblk; const LAS int* selpage; int bs, hkv, rs, dc; };
template <int BR> __device__ __forceinline__ void srow_load(const SampleRows& R, int row, int nrows, f32x4& kx, f32x4& vx) {
    kx = (f32x4){0.f, 0.f, 0.f, 0.f}; vx = kx;
    if (row < nrows) {
        if (BR == 0) { const int k = row >> 6; const unsigned off = (((unsigned)R.selpage[k] * 128u + (unsigned)((R.selblk[k] & 1) * 64 + (row & 63))) * 4u + 2u) * 256u + (unsigned)(R.hkv * 64 + 4 * R.dc);
            kx = *(const f32x4*)(R.cache + off); vx = *(const f32x4*)(R.cache + off + 256u); }
        else { const unsigned off = (((unsigned)R.bs * 512u + (unsigned)(row + 1)) * 2u) * 256u + (unsigned)(R.hkv * 64 + 4 * R.dc);
            kx = *(const f32x4*)(R.cwin + off); vx = *(const f32x4*)(R.cwin + off + 256u); }
    }
}
__device__ __forceinline__ void srow_update(const f32x4 (&qv)[4], const f32x4& kx, const f32x4& vx, bool valid, float (&mx)[4], float (&ls)[4], f32x4 (&o)[4]) {
    float s[4];
#pragma unroll
    for (int g = 0; g < 4; ++g) s[g] = (qv[g].x * kx.x + qv[g].y * kx.y) + (qv[g].z * kx.z + qv[g].w * kx.w);
#pragma unroll
    for (int st = 8; st >= 1; st >>= 1)
#pragma unroll
        for (int g = 0; g < 4; ++g) s[g] += __shfl_xor(s[g], st);
#pragma unroll
    for (int g = 0; g < 4; ++g) {
        const float mnew = valid ? fmaxf(mx[g], s[g]) : mx[g], alpha = __expf(mx[g] - mnew), p = valid ? __expf(s[g] - mnew) : 0.f;
        ls[g] = ls[g] * alpha + p; o[g] = o[g] * alpha + vx * p; mx[g] = mnew;
    }
}
template <int BR>
__device__ __forceinline__ void sample_rows_branch(const SampleRows& R, int wave, const f32x4 (&qv)[4], LAS float* pm, LAS float* pl, LAS float* po) {
    float mx[4], ls[4]; f32x4 o[4];
#pragma unroll
    for (int g = 0; g < 4; ++g) { mx[g] = NEGF; ls[g] = 0.f; o[g] = (f32x4){0.f, 0.f, 0.f, 0.f}; }
    constexpr int nrows = BR == 0 ? 15 * 64 : 511;
    constexpr int ngroups = (nrows + 3) / 4;
#pragma unroll 1
    for (int g0 = wave; g0 < ngroups; g0 += 64) {
        f32x4 kx[8], vx[8];
#pragma unroll
        for (int k = 0; k < 8; ++k) srow_load<BR>(R, 4 * (g0 + 8 * k) + R.rs, (g0 + 8 * k) < ngroups ? nrows : 0, kx[k], vx[k]);
#pragma unroll
        for (int k = 0; k < 8; ++k) {
            const int grp = g0 + 8 * k, row = 4 * grp + R.rs;
            if (grp < ngroups) {
                const bool valid = row < nrows;
                if (BR == 1 && valid) { const unsigned off = (((unsigned)R.bs * 512u + (unsigned)row) * 2u) * 256u + (unsigned)(R.hkv * 64 + 4 * R.dc);
                    *(f32x4*)(R.out + O_WINS + off) = kx[k]; *(f32x4*)(R.out + O_WINS + off + 256u) = vx[k]; }
                srow_update(qv, kx[k], vx[k], valid, mx, ls, o);
            }
        }
    }
    if (wave == 0) {
        const float* src = BR == 0 ? R.out + O_KVS + ((size_t)R.bs * 4 + 2) * 256 + R.hkv * 64 + 4 * R.dc : R.out + O_WINS + (((size_t)R.bs * 512 + 511) * 2) * 256 + R.hkv * 64 + 4 * R.dc;
        const f32x4 kx = *(const f32x4*)src, vx = *(const f32x4*)(src + 256);
        srow_update(qv, kx, vx, R.rs == 0, mx, ls, o);
    }
    const int slot = (BR * 32 + wave * 4 + R.rs) * 4;
#pragma unroll
    for (int g = 0; g < 4; ++g) { if (R.dc == 0) { pm[slot + g] = mx[g]; pl[slot + g] = ls[g]; } *(LAS f32x4*)(po + (size_t)(slot + g) * 64 + 4 * R.dc) = o[g]; }
}

__device__ __forceinline__ void attn_sample_unit(const Args& args, LAS unsigned char* lds, int unit, int tid, int wave, int lane) {
    unsigned char* ws = args.ws; float* out = args.out;
    const int hkv = unit & 3, bs = unit >> 2; const size_t m = MP + bs;
    LAS float* sc = (LAS float*)lds; LAS float* impv = sc + 512; LAS int* selblk = (LAS int*)(impv + 64); LAS int* selpage = selblk + 16; LAS int* pg = selpage + 16;
    LAS float* pm = (LAS float*)(pg + 16); LAS float* pl = pm + 256; LAS float* po = pl + 256;
    LAS float* poc = po + 2 * 32 * 4 * 64;
    const bf16* Qr = (const bf16*)(ws + WS_Q) + m * 1024 + hkv * 256;
    const float* KCS = (const float*)(ws + WS_KCS) + (size_t)(bs * 4 + hkv) * 128 * 64; const float* VCS = (const float*)(ws + WS_VCS) + (size_t)(bs * 4 + hkv) * 128 * 64;
    float qv[4];
#pragma unroll
    for (int g = 0; g < 4; ++g) qv[g] = bf2f(Qr[g * 64 + lane]) * 0.125f;
    if (tid < 16) pg[tid] = ((const int*)args.in[5])[bs * NPAGES + tid];
    {
        float kr[16];
#pragma unroll
        for (int i = 0; i < 16; ++i) { const int n = wave + 8 * i; kr[i] = n < 127 ? KCS[n * 64 + lane] : 0.f; }
#pragma unroll
        for (int i = 0; i < 16; ++i) { const int n = wave + 8 * i; float sg[4]; dot4_reduce(qv, kr[i], lane, sg);
            if (lane < 4) sc[lane * 128 + n] = n < 127 ? (lane == 0 ? sg[0] : lane == 1 ? sg[1] : lane == 2 ? sg[2] : sg[3]) : NEGF; }
    }
    __syncthreads();
    if (wave < 4) { const float s0 = sc[wave * 128 + lane], s1 = sc[wave * 128 + 64 + lane];
        float mxv = fmaxf(s0, s1);
#pragma unroll
        for (int o = 1; o < 64; o <<= 1) mxv = fmaxf(mxv, __shfl_xor(mxv, o));
        const float e0 = __expf(s0 - mxv), e1 = (lane < 63) ? __expf(s1 - mxv) : 0.f;
        const float inv = 1.f / fmaxf(wave_sum(e0 + e1), TINYF);
        sc[wave * 128 + lane] = e0 * inv; sc[wave * 128 + 64 + lane] = e1 * inv; }
    __syncthreads();
    {
        float vr[16];
#pragma unroll
        for (int i = 0; i < 16; ++i) { const int n = wave + 8 * i; vr[i] = n < 127 ? VCS[n * 64 + lane] : 0.f; }
        float oc[4] = {0.f, 0.f, 0.f, 0.f};
#pragma unroll
        for (int i = 0; i < 16; ++i) { const int n = wave + 8 * i;
#pragma unroll
            for (int g = 0; g < 4; ++g) oc[g] += sc[g * 128 + n] * vr[i]; }
#pragma unroll
        for (int g = 0; g < 4; ++g) poc[(wave * 4 + g) * 64 + lane] = oc[g];
        if (wave == 4 && lane < 33) { const int j = lane; float acc = 0.f;
#pragma unroll
            for (int k = -1; k < 4; ++k) { const int n = 4 * j + k; if (n >= 0 && n < 127) { const float P = (sc[n] + sc[128 + n]) + (sc[256 + n] + sc[384 + n]); acc += (k == -1 || k == 3) ? P : 2.f * P; } }
            impv[j] = (j == 0 || j == 31 || j == 32) ? BIGF : acc; }
    }
    __syncthreads();
    if (tid < 64) { bool sel = false;
        if (tid < 33) { const float v = impv[tid]; int rank = 0;
            for (int k = 0; k < 33; ++k) { const float o = impv[k]; rank += ((o > v) || (o == v && k < tid)) ? 1 : 0; }
            sel = rank < 16 && tid < 32; }
        const unsigned long long bal = __ballot(sel);
        if (sel) { const int slot = __popcll(bal & ((1ull << tid) - 1ull)); selblk[slot] = tid; selpage[slot] = pg[tid >> 1]; } }
    __syncthreads();
    {
        f32x4 qv4[4];
#pragma unroll
        for (int g = 0; g < 4; ++g) { const u32x2 w = *(const u32x2*)(Qr + g * 64 + 4 * (lane & 15)); qv4[g] = (f32x4){bflo(w.x), bfhi(w.x), bflo(w.y), bfhi(w.y)} * 0.125f; }
        SampleRows R{INF(4), INF(6), out, selblk, selpage, bs, hkv, lane >> 4, lane & 15};
        sample_rows_branch<0>(R, wave, qv4, pm, pl, po);
        sample_rows_branch<1>(R, wave, qv4, pm, pl, po);
    }
    __syncthreads();
    if (tid < 256) { const int g = tid >> 6, d = tid & 63;
        const float* gates = (const float*)(ws + WS_MISC) + m * 128 + 32 + (hkv * 4 + g) * 3;
        float oc = 0.f;
#pragma unroll
        for (int w = 0; w < 8; ++w) oc += poc[(w * 4 + g) * 64 + d];
        float res = sigmf(gates[0]) * oc;
#pragma unroll
        for (int br = 0; br < 2; ++br) { float M = NEGF;
#pragma unroll 8
            for (int w = 0; w < 32; ++w) M = fmaxf(M, pm[(br * 32 + w) * 4 + g]);
            float L = 0.f, O = 0.f;
#pragma unroll 8
            for (int w = 0; w < 32; ++w) { const float e = __expf(pm[(br * 32 + w) * 4 + g] - M); L += pl[(br * 32 + w) * 4 + g] * e; O += po[((br * 32 + w) * 4 + g) * 64 + d] * e; }
            res += sigmf(gates[1 + br]) * O / fmaxf(L, TINYF); }
        ((bf16*)(ws + WS_YATT))[m * 1024 + (hkv * 4 + g) * 64 + d] = (bf16)f2bf(res); }
    __syncthreads();
}

__device__ __forceinline__ void ffn_act_item(const Args& args, int item, int lane) {
    unsigned char* ws = args.ws; float* out = args.out;
    const bf16* U = (const bf16*)(ws + WS_U); bf16* ACT = (bf16*)(ws + WS_ACT);
    const float* cw = INF(32); const float* cb = INF(33); const float* st = INF(9);
    const int slab = item % 11, chunk = item / 11, row0 = chunk * 32, c4 = slab * 256 + lane * 4;
    f32x4 w[2][3], bia[2];
#pragma unroll
    for (int hf = 0; hf < 2; ++hf) { bia[hf] = *(const f32x4*)(cb + hf * DFF + c4);
#pragma unroll
        for (int k = 0; k < 3; ++k) w[hf][k] = *(const f32x4*)(cw + k * DFF2 + hf * DFF + c4); }
    if (row0 >= MP) {
        for (int r = 0; r < 32; ++r) { const int bs = row0 - MP + r; if (bs >= MS) break;
            f32x4 cu[2];
#pragma unroll
            for (int hf = 0; hf < 2; ++hf) { const int col = hf * DFF + c4;
                const f32x4 u0 = *(const f32x4*)(st + ((size_t)bs * 2 + 0) * DFF2 + col), u1 = *(const f32x4*)(st + ((size_t)bs * 2 + 1) * DFF2 + col), u2 = *(const f32x4*)(out + O_FFNS + ((size_t)bs * 2 + 1) * DFF2 + col);
                *(f32x4*)(out + O_FFNS + ((size_t)bs * 2 + 0) * DFF2 + col) = u1;
                cu[hf] = bia[hf] + w[hf][0] * u0 + w[hf][1] * u1 + w[hf][2] * u2; }
            u32x2 o; o.x = pk2(siluf(cu[0].x) * cu[1].x, siluf(cu[0].y) * cu[1].y); o.y = pk2(siluf(cu[0].z) * cu[1].z, siluf(cu[0].w) * cu[1].w);
            *(u32x2*)(ACT + (size_t)(row0 + r) * DFF + c4) = o; }
        return;
    }
    const int t0 = row0 & 4095;
    f32x4 p2[2], p1[2];
#pragma unroll
    for (int hf = 0; hf < 2; ++hf) { const int col = hf * DFF + c4;
        const u32x2 a = t0 >= 2 ? *(const u32x2*)(U + (size_t)(row0 - 2) * DFF2 + col) : (u32x2){0u, 0u}, b = t0 >= 1 ? *(const u32x2*)(U + (size_t)(row0 - 1) * DFF2 + col) : (u32x2){0u, 0u};
        p2[hf] = (f32x4){bflo(a.x), bfhi(a.x), bflo(a.y), bfhi(a.y)}; p1[hf] = (f32x4){bflo(b.x), bfhi(b.x), bflo(b.y), bfhi(b.y)}; }
#pragma unroll 1
    for (int rb = 0; rb < 32; rb += 8) {
        u32x2 v[8][2];
#pragma unroll
        for (int r = 0; r < 8; ++r)
#pragma unroll
            for (int hf = 0; hf < 2; ++hf) v[r][hf] = *(const u32x2*)(U + (size_t)(row0 + rb + r) * DFF2 + hf * DFF + c4);
#pragma unroll
        for (int r = 0; r < 8; ++r) {
            f32x4 cu[2];
#pragma unroll
            for (int hf = 0; hf < 2; ++hf) { const f32x4 u2 = (f32x4){bflo(v[r][hf].x), bfhi(v[r][hf].x), bflo(v[r][hf].y), bfhi(v[r][hf].y)};
                cu[hf] = bia[hf] + w[hf][0] * p2[hf] + w[hf][1] * p1[hf] + w[hf][2] * u2; p2[hf] = p1[hf]; p1[hf] = u2; }
            u32x2 o; o.x = pk2(siluf(cu[0].x) * cu[1].x, siluf(cu[0].y) * cu[1].y); o.y = pk2(siluf(cu[0].z) * cu[1].z, siluf(cu[0].w) * cu[1].w);
            *(u32x2*)(ACT + (size_t)(row0 + rb + r) * DFF + c4) = o;
        }
    }
}
template <int KTOT>
__device__ __forceinline__ f32x4 skinny_acc(const bf16* A, int lda, const bf16* Bt, int ldb, int wave, int ct, int q, int r16) {
    const bf16* ap = A + (size_t)(16 * wave + r16) * lda + 8 * q;
    const bf16* bp = Bt + (size_t)(16 * ct + r16) * ldb + 8 * q;
    f32x4 acc = (f32x4){0.f, 0.f, 0.f, 0.f};
#pragma unroll 1
    for (int k0 = 0; k0 < KTOT; k0 += 256) {
        bf16x8 af[8], bf[8];
#pragma unroll
        for (int i = 0; i < 8; ++i) { af[i] = *(const bf16x8*)(ap + k0 + 32 * i); bf[i] = *(const bf16x8*)(bp + k0 + 32 * i); }
#pragma unroll
        for (int i = 0; i < 8; ++i) acc = MFMA16(af[i], bf[i], acc);
    }
    return acc;
}
template <int WHICH>
__device__ __forceinline__ void skinny_sample_unit(const Args& args, int ct, int wave, int lane) {
    unsigned char* ws = args.ws;
    const int q = lane >> 4, r16 = lane & 15, col = 16 * ct + r16;
    if (WHICH == 0) {
        const f32x4 a1 = skinny_acc<2048>((const bf16*)(ws + WS_YSSM) + (size_t)MP * 2048, 2048, (const bf16*)(ws + WS_WSSM), 2048, wave, ct, q, r16);
        const f32x4 a2 = skinny_acc<1024>((const bf16*)(ws + WS_YATT) + (size_t)MP * 1024, 1024, (const bf16*)(ws + WS_WATT), 1024, wave, ct, q, r16);
#pragma unroll
        for (int r = 0; r < 4; ++r) { const size_t row = MP + 16 * wave + 4 * q + r;
            const f32x4 sq = *(const f32x4*)((const float*)(ws + WS_SSQ) + row * 4);
            const float rstd = 1.f / sqrtf(((sq.x + sq.y) + (sq.z + sq.w)) * (1.f / 2048.f) + EPS);
            const bf16* mg = (const bf16*)(ws + WS_MG) + row * 2048;
            const float v = sigmf(bf2f(mg[col])) * rstd * a1[r] + sigmf(bf2f(mg[1024 + col])) * a2[r];
            ((bf16*)(ws + WS_MERGED))[row * 1024 + col] = (bf16)f2bf(v); }
    } else if (WHICH == 1) {
        const f32x4 a = skinny_acc<1024>((const bf16*)(ws + WS_MERGED) + (size_t)MP * 1024, 1024, (const bf16*)(ws + WS_WOUT), 1024, wave, ct, q, r16);
#pragma unroll
        for (int r = 0; r < 4; ++r) { const int bs = 16 * wave + 4 * q + r;
            ((float*)(ws + WS_X1))[(size_t)(MP + bs) * 1024 + col] = INF(1)[(size_t)bs * 1024 + col] + ((const float*)(ws + WS_MOD))[(size_t)(4 + bs) * 6144 + 2048 + col] * a[r]; }
    } else {
        const f32x4 a = skinny_acc<DFF>((const bf16*)(ws + WS_ACT) + (size_t)MP * DFF, DFF, (const bf16*)(ws + WS_WDN), DFF, wave, ct, q, r16);
#pragma unroll
        for (int r = 0; r < 4; ++r) { const int bs = 16 * wave + 4 * q + r; float* x = (float*)(ws + WS_X1) + (size_t)(MP + bs) * 1024 + col;
            *x = *x + ((const float*)(ws + WS_MOD))[(size_t)(4 + bs) * 6144 + 5120 + col] * a[r]; }
    }
}
constexpr int N_PHASES = 15;
#ifndef MK_PER_PHASE
#define MK_PER_PHASE 0
#endif

__global__ void __launch_bounds__(NTHR, 2) fwd_kernel(Args args) {
    extern __shared__ __attribute__((aligned(16))) unsigned char lds_raw[];
    LAS unsigned char* lds = (LAS unsigned char*)lds_raw;
    const int tid = threadIdx.x, lane = tid & 63, wave = __builtin_amdgcn_readfirstlane(tid >> 6);
    const int G = gridDim.x, bid = blockIdx.x, gw = bid * NWAVES + wave, NGW = G * NWAVES, gt = bid * NTHR + tid, NGT = G * NTHR;
    unsigned char* ws = args.ws;
    for (int u = tid; u < (LDS_BYTES - LDSCTL_OFF) / 4; u += NTHR) ((LAS unsigned*)(lds + LDSCTL_OFF))[u] = 0u;
    __syncthreads();
    XcdBarrier bar; bar.bar = (unsigned*)(ws + WS_CTL) + CW_BAR; bar.x = 0; bar.st = nullptr;
    if (!MK_PER_PHASE) bar = xcd_barrier_post((unsigned*)(ws + WS_CTL) + CW_BAR, (volatile LAS unsigned*)(lds + MISC_OFF) + 8);
    const int lo = args.ph_lo, hi = args.ph_hi;
#ifndef PHASE_MASK
#define PHASE_MASK 0x7fff
#endif
#define IN(k) ((((PHASE_MASK) >> (k)) & 1) && lo <= (k) && (k) < hi)
#define SEAM(k) do { if (IN(k) && IN((k) + 1)) xcd_barrier(bar); } while (0)
    using pg8::Gemm; using pg8::StaticOrder;

    if (IN(0)) { { p0_prologue(args, lds, gw, NGW, lane, wave); } }
    SEAM(0);
    if (IN(1)) { {
        Gemm g{(const bf16*)(ws + WS_SC), (const bf16*)(ws + WS_WADA), 256, 6144, 1024}; StaticOrder S; S.init(256, 6144, G, bid);
        pg8::EpiF32 E{(float*)(ws + WS_MOD), 6144, INF(11)};
        pg8::gemm_phase<pg8::EpiF32, StaticOrder, true, true>(lds, g, S, E);
    } }
    SEAM(1);
    if (IN(2)) { { norm_mod_phase<0>(args, gw, NGW, lane); } }
    SEAM(2);
    if (IN(3)) { {
        Gemm g{(const bf16*)(ws + WS_H), (const bf16*)(ws + WS_WIN), MPAD, NPROJ, 1024}; StaticOrder S; S.init(MPAD, NPROJ, G, bid);
        epi::InProj E{ws, args.out};
        pg8::gemm_phase<epi::InProj, StaticOrder, true, true>(lds, g, S, E);
    } }
    SEAM(3);
    if (IN(4)) { {
        const int p4 = args.p7mask >> 8;
        if (p4 & 1) for (int u = bid; u < 1024; u += G) sample_compress_unit(args, lds, u, tid, wave, lane);
        if (p4 & 2) {
        { Gemm g{(const bf16*)(ws + WS_KVH), (const bf16*)(ws + WS_W1K), 4096, 256, 1024}; StaticOrder S; S.init(4096, 256, G, bid);
          epi::PartBf16 E{(bf16*)(ws + WS_PARTK)}; pg8::gemm_phase<epi::PartBf16, StaticOrder, true, true>(lds, g, S, E); }
        { Gemm g{(const bf16*)(ws + WS_KVH) + (size_t)16 * 4096 * 64, (const bf16*)(ws + WS_W1V), 4096, 256, 1024}; StaticOrder S; S.init(4096, 256, G, (bid + G - 16) % G);
          epi::PartBf16 E{(bf16*)(ws + WS_PARTV)}; pg8::gemm_phase<epi::PartBf16, StaticOrder, true, true>(lds, g, S, E); }
        }
        if (p4 & 4) {
            if (G == 256) { if (bid >= 32) for (int it = gw - 32 * NWAVES; it < 256 * 48; it += NGW - 32 * NWAVES) conv_prompt_item(args, it, lane); }
            else for (int it = gw; it < 256 * 48; it += NGW) conv_prompt_item(args, it, lane);
        }
        if (p4 & 8) { for (int it = gw; it < 4096; it += NGW) dtcs_item(args, it, lane);
            sample_conv(args, gt, NGT); }
    } }
    SEAM(4);
    if (IN(5)) { {
        const int p5 = args.p7mask >> 4;
        if (p5 & 1) for (int u = bid; u < 512; u += G) ssd_states_unit(args, lds, u, wave, lane);
        if (p5 & 2) for (int it = gw; it < 2 * (4096 / 16); it += NGW) compress2_item<0>(args, it, lane);
        if (p5 & 2) for (int it = gw; it < 2 * 128 * 4 * 3; it += NGW) compress_fixup_item(args, it, lane);
        if (p5 & 4) for (int it = gw; it < MS * NH; it += NGW) sample_ssm_item(args, lds, it, wave, lane);
    } }
    SEAM(5);
    if (IN(6)) { { scan_phase(args, gt, NGT); } }
    SEAM(6);
    if (IN(7)) { {
#ifndef P7C
#define P7C 7
#endif
        const int p7 = args.p7mask & (P7C);
        if (p7 & 1) for (int u = bid; u < 512; u += G) ssd_out_unit(args, lds, u, wave, lane, tid);
        if (p7 & 2) for (int u = gw; u < 4096; u += NGW) attn_prompt_unit(args, (LAS float*)(lds + wave * 12288), u, NGW == 2048, lane);
        __syncthreads();
        if (p7 & 4) for (int u = bid; u < 512; u += G) attn_sample_unit(args, lds, u, tid, wave, lane);
    } }
    SEAM(7);
    if (IN(8)) { {
#ifdef SELFCHECK
        check_attn_prompt(args, lds, bid, tid); check_attn_sample(args, lds, bid, tid); check_prompt_compress(args, lds, bid, tid); check_sample_compress(args, lds, bid, tid);
#endif
        for (int u = bid; u < 64; u += G) skinny_sample_unit<0>(args, u, wave, lane);
        { Gemm g{(const bf16*)(ws + WS_YSSM), (const bf16*)(ws + WS_WSSM), MP, 1024, 2048}; StaticOrder S; S.init(MP, 1024, G, bid);
          epi::Merge1 E{ws}; pg8::gemm_phase<epi::Merge1, StaticOrder, true, true>(lds, g, S, E); }
        { Gemm g{(const bf16*)(ws + WS_YATT), (const bf16*)(ws + WS_WATT), MP, 1024, 1024}; StaticOrder S; S.init(MP, 1024, G, bid);
          epi::Merge2 E{ws}; pg8::gemm_phase<epi::Merge2, StaticOrder, true, true>(lds, g, S, E); }
    } }
    SEAM(8);
    if (IN(9)) { {
        for (int u = bid; u < 64; u += G) skinny_sample_unit<1>(args, u, wave, lane);
        Gemm g{(const bf16*)(ws + WS_MERGED), (const bf16*)(ws + WS_WOUT), MP, 1024, 1024}; StaticOrder S; S.init(MP, 1024, G, bid);
        epi::Resid E{INF(0), INF(1), nullptr, (float*)(ws + WS_X1), (const float*)(ws + WS_MOD), 2048};
        pg8::gemm_phase<epi::Resid, StaticOrder, true, true>(lds, g, S, E);
    } }
    SEAM(9);
    if (IN(10)) { { norm_mod_phase<1>(args, gw, NGW, lane); } }
    SEAM(10);
    if (IN(11)) { {
        Gemm g{(const bf16*)(ws + WS_H), (const bf16*)(ws + WS_WUP), MPAD, DFF2, 1024}; StaticOrder S; S.init(MPAD, DFF2, G, bid);
        epi::Up E{ws, args.out};
        pg8::gemm_phase<epi::Up, StaticOrder, true, true>(lds, g, S, E);
    } }
    SEAM(11);
    if (IN(12)) { { for (int it = gw; it < (MPAD / 32) * 11; it += NGW) ffn_act_item(args, it, lane); } }
    SEAM(12);
    if (IN(13)) { {
        for (int u = bid; u < 64; u += G) skinny_sample_unit<2>(args, u, wave, lane);
        Gemm g{(const bf16*)(ws + WS_ACT), (const bf16*)(ws + WS_WDN), MP, 1024, DFF}; StaticOrder S; S.init(MP, 1024, G, bid);
        epi::Resid E{INF(0), INF(1), (const float*)(ws + WS_X1), (float*)(ws + WS_X1), (const float*)(ws + WS_MOD), 5120};
        pg8::gemm_phase<epi::Resid, StaticOrder, true, true>(lds, g, S, E);
    } }
    SEAM(13);
    if (IN(14)) { { norm_mod_phase<2>(args, gw, NGW, lane); } }
#ifdef SELFCHECK
    if (IN(14) && bid == 0 && tid == 0 && ((volatile unsigned*)(ws + WS_CTL))[8] != 0u) args.out[O_YS] = __builtin_nanf("");
#endif
#undef IN
#undef SEAM
}

extern "C" void kernel_launch(void* const* d_in, const int* in_sizes, int n_in, void* d_out, int out_size, void* d_ws, size_t ws_size, hipStream_t stream) {
    static int grid = 0;
    if (grid == 0) {
        if (n_in != 35 || out_size != (int)O_END || ws_size < WS_END) { fprintf(stderr, "kernel_launch: unexpected shapes (n_in %d out %d ws %zu, need %zu)\n", n_in, out_size, ws_size, (size_t)WS_END); grid = -1; return; }
        int dev = 0, cus = 0, per_cu = 0;
        if (hipGetDevice(&dev) != hipSuccess || hipDeviceGetAttribute(&cus, hipDeviceAttributeMultiprocessorCount, dev) != hipSuccess) { grid = -1; return; }
        if (hipFuncSetAttribute((const void*)fwd_kernel, hipFuncAttributeMaxDynamicSharedMemorySize, LDS_BYTES) != hipSuccess) { fprintf(stderr, "kernel_launch: hipFuncSetAttribute failed\n"); grid = -1; return; }
        if (hipOccupancyMaxActiveBlocksPerMultiprocessor(&per_cu, (const void*)fwd_kernel, NTHR, LDS_BYTES) != hipSuccess || per_cu < 1) { fprintf(stderr, "kernel_launch: occupancy query says %d\n", per_cu); }
        (void)hipGetLastError();
        grid = cus;
    }
    if (grid < 0) return;
    (void)hipMemsetAsync((char*)d_ws + WS_CTL, 0, CTL_ZERO_BYTES, stream);
    Args a{};
    for (int i = 0; i < 35; ++i) a.in[i] = d_in[i];
    a.out = (float*)d_out; a.ws = (unsigned char*)d_ws;
    a.p7mask = 0xFFF; a.pad = 7;
#if MK_PER_PHASE
    for (int p = 0; p < N_PHASES; ++p) { a.ph_lo = p; a.ph_hi = p + 1; hipLaunchKernelGGL(fwd_kernel, dim3(grid), dim3(NTHR), LDS_BYTES, stream, a); }
#else
    a.ph_lo = 0; a.ph_hi = N_PHASES;
    hipLaunchKernelGGL(fwd_kernel, dim3(grid), dim3(NTHR), LDS_BYTES, stream, a);
#endif
#ifdef PROBE_LO
    a.ph_lo = PROBE_LO; a.ph_hi = PROBE_HI; a.p7mask = PROBE_P7MASK; a.pad = PROBE_P7MASK;
    hipLaunchKernelGGL(fwd_kernel, dim3(grid), dim3(NTHR), LDS_BYTES, stream, a);
#endif
}
```

```cpp
#include <hip/hip_runtime.h>
#include <cstdio>
#include <cstdint>
namespace pg8 {
#define PG8_LAS __attribute__((address_space(3)))
typedef unsigned short bf16_t;
typedef short bf16x8 __attribute__((ext_vector_type(8)));
typedef float f32x4 __attribute__((ext_vector_type(4)));
typedef unsigned u32x4 __attribute__((ext_vector_type(4)));
constexpr int BM = 256, BK = 64, HALF = 128, HTB = HALF * BK * 2  , STAGE_BYTES = 8 * HTB, NXCD = 8, WGM = 8;

__host__ __device__ __forceinline__ int lds_byte(int r, int c) { const int st = (r >> 4) * 2 + (c >> 5), rr = r & 15, cc = c & 31, ob = rr * 64 + cc * 2; return st * 1024 + (ob ^ (((ob >> 9) & 1) << 5)); }
__host__ __device__ __forceinline__ void stage_rc(int b, int& R, int& C) { const int st = b / 1024, sb = b % 1024, swz = sb ^ (((sb >> 9) & 1) << 5); R = (st >> 1) * 16 + swz / 64; C = (st & 1) * 32 + (swz % 64) / 2; }
__host__ __device__ __forceinline__ int perm32(int rho) { const int n = rho >> 4, i = rho & 15; return 8 * (i >> 2) + 4 * n + (i & 3); }

struct Unit { int pm, pn; };
struct Gemm { const bf16_t* A; const bf16_t* Bt; int M, N, K; };

struct StaticOrder {
    int nM, nN, nwg, G, c;
    __host__ __device__ void init(int M, int N, int G_, int c_) { nM = M / BM; nN = N / BM; nwg = nM * nN; G = G_; c = c_; }
    __host__ __device__ bool next(int i, Unit& u) const {
        const long L = (long)i * G + c; if (L >= nwg) return false;
        int wgid = (int)L; { const int q = nwg / NXCD, r = nwg % NXCD, xcd = wgid % NXCD, off = wgid / NXCD; wgid = (xcd < r ? xcd * (q + 1) : r * (q + 1) + (xcd - r) * q) + off; }
        const int nig = WGM * nN, gid = wgid / nig, fm = gid * WGM, gsz = (nM - fm) < WGM ? (nM - fm) : WGM;
        u.pm = fm + ((wgid % nig) % gsz); u.pn = (wgid % nig) / gsz; return true;
    }
    __device__ __forceinline__ void a_ready(const Unit&) const {}
    __device__ __forceinline__ void done(const Unit&) const {}
};
__device__ __forceinline__ unsigned cvt_pk_bf16(float lo, float hi) { unsigned r; asm volatile("v_cvt_pk_bf16_f32 %0, %1, %2" : "=v"(r) : "v"(lo), "v"(hi)); return r; }
typedef float f32x2 __attribute__((ext_vector_type(2)));
struct EpiF32 {
    static constexpr bool PERM = false, AFTER_DRAIN = false;
    float* C; int ldc; const float* bias;
    __device__ __forceinline__ void operator()(const f32x4 (&acc)[2][2][4][2], const Unit& u, int wr, int wc, int fr, int fq) const {
        const int row0 = u.pm * BM + wr * 64 + fr, col0 = u.pn * BM + wc * 32 + 4 * fq;
        f32x4 bv[2][2];
#pragma unroll
        for (int bj = 0; bj < 2; ++bj)
#pragma unroll
            for (int n = 0; n < 2; ++n) bv[bj][n] = bias ? *(const f32x4*)(bias + col0 + bj * HALF + n * 16) : (f32x4){0.f, 0.f, 0.f, 0.f};
#pragma unroll
        for (int ai = 0; ai < 2; ++ai)
#pragma unroll
            for (int m = 0; m < 4; ++m) { float* rowp = C + (size_t)(row0 + ai * HALF + m * 16) * ldc + col0;
#pragma unroll
                for (int bj = 0; bj < 2; ++bj)
#pragma unroll
                    for (int n = 0; n < 2; ++n) *(f32x4*)(rowp + bj * HALF + n * 16) = acc[ai][bj][m][n] + bv[bj][n]; }
    }
};
template <class Epi, class Sched, bool ALIGN_EPI = false, bool SP2 = false>
__device__ __forceinline__ void gemm_phase(PG8_LAS unsigned char* lds, const Gemm g, const Sched& S, const Epi& E) {
    const int tid = threadIdx.x, wid = __builtin_amdgcn_readfirstlane(tid >> 6), lane = tid & 63, wr = wid >> 2, wc = wid & 3, fr = lane & 15, fq = lane >> 4;
    const int K = g.K, nt = K / BK;
    unsigned voffA[2], voffB[2];
#pragma unroll
    for (int i = 0; i < 2; ++i) { int R, C; stage_rc(tid * 16 + i * 8192, R, C); const int Rb = Epi::PERM ? ((R & ~31) + perm32(R & 31)) : R;
        voffA[i] = (unsigned)(R * K + C) * 2u; voffB[i] = (unsigned)(Rb * K + C) * 2u; }
    const size_t kstep = (size_t)(BK * 2);
    const size_t hstep = (size_t)HALF * K * 2;
    const size_t tstep = 2 * hstep;
    const unsigned ldsw = (unsigned)wid * 1024u;
    const int aoff = lds_byte(wr * 64 + fr, fq * 8), boff = lds_byte(wc * 32 + fr, fq * 8);
#define PG8_SA(b, h) (((b) * 2 + (h)) * HTB)
#define PG8_SB(b, h) ((4 + (b) * 2 + (h)) * HTB)
#define PG8_STAGE(bufoff, gbase, voff) do { _Pragma("unroll") for (int _i = 0; _i < 2; ++_i) \
        __builtin_amdgcn_global_load_lds((const unsigned*)((const char*)(gbase) + (voff)[_i]), (PG8_LAS unsigned*)(lds + (bufoff) + ldsw + _i * 8192), 16, 0, 0); } while (0)
#define PG8_LDA(dst, b, h) do { _Pragma("unroll") for (int m = 0; m < 4; ++m) _Pragma("unroll") for (int k = 0; k < 2; ++k) dst[m][k] = *(const PG8_LAS bf16x8*)(lds + PG8_SA(b, h) + aoff + m * 2048 + k * 1024); } while (0)
#define PG8_LDB(dst, b, h) do { _Pragma("unroll") for (int n = 0; n < 2; ++n) _Pragma("unroll") for (int k = 0; k < 2; ++k) dst[n][k] = *(const PG8_LAS bf16x8*)(lds + PG8_SB(b, h) + boff + n * 2048 + k * 1024); } while (0)
#define PG8_MMA(ai, bj, At, Bt) do { __builtin_amdgcn_s_setprio(1); _Pragma("unroll") for (int m = 0; m < 4; ++m) _Pragma("unroll") for (int n = 0; n < 2; ++n) _Pragma("unroll") for (int k = 0; k < 2; ++k) \
        acc[ai][bj][m][n] = __builtin_amdgcn_mfma_f32_16x16x32_bf16(Bt[n][k], At[m][k], acc[ai][bj][m][n], 0, 0, 0); __builtin_amdgcn_s_setprio(0); } while (0)
#define PG8_WAIT_V(n) asm volatile("s_waitcnt vmcnt(" #n ")" ::: "memory")
#define PG8_WAIT_L(n) asm volatile("s_waitcnt lgkmcnt(" #n ")" ::: "memory")
#define PG8_BAR __builtin_amdgcn_s_barrier()
#define PG8_SCHED __builtin_amdgcn_sched_barrier(0)
    Unit cur, nxt; int ui = 0;
    if (!S.next(0, cur)) return;
    f32x4 acc[2][2][4][2];
#pragma unroll
    for (int a = 0; a < 2; ++a)
#pragma unroll
        for (int b = 0; b < 2; ++b)
#pragma unroll
            for (int m = 0; m < 4; ++m)
#pragma unroll
                for (int n = 0; n < 2; ++n) acc[a][b][m][n] = (f32x4){0.f, 0.f, 0.f, 0.f};
    bf16x8 At[4][2], B0[2][2], B1[2][2];
    const char* cA = (const char*)g.A + (size_t)cur.pm * tstep; const char* cB = (const char*)g.Bt + (size_t)cur.pn * tstep;
    S.a_ready(cur);
    if constexpr (SP2) {
        PG8_STAGE(PG8_SB(0, 0), cB, voffB); PG8_STAGE(PG8_SB(0, 1), cB + hstep, voffB); PG8_STAGE(PG8_SA(0, 0), cA, voffA); PG8_STAGE(PG8_SA(0, 1), cA + hstep, voffA);
        if (wr == 1) PG8_BAR;
        PG8_WAIT_V(2); PG8_BAR;
        PG8_STAGE(PG8_SB(1, 0), cB + kstep, voffB); PG8_STAGE(PG8_SA(1, 0), cA + kstep, voffA); PG8_STAGE(PG8_SB(1, 1), cB + hstep + kstep, voffB);
        PG8_WAIT_V(6); PG8_BAR;
    } else {
        PG8_STAGE(PG8_SB(0, 0), cB, voffB); PG8_STAGE(PG8_SA(0, 0), cA, voffA); PG8_STAGE(PG8_SB(0, 1), cB + hstep, voffB); PG8_STAGE(PG8_SA(0, 1), cA + hstep, voffA);
        if (wr == 1) PG8_BAR;
        PG8_WAIT_V(4); PG8_BAR;
        PG8_STAGE(PG8_SB(1, 0), cB + kstep, voffB); PG8_STAGE(PG8_SA(1, 0), cA + kstep, voffA); PG8_STAGE(PG8_SB(1, 1), cB + hstep + kstep, voffB);
        PG8_WAIT_V(6); PG8_BAR;
    }
    for (;;) {
        const bool has_next = S.next(ui + 1, nxt);
        const char* nA = has_next ? (const char*)g.A + (size_t)nxt.pm * tstep : cA; const char* nB = has_next ? (const char*)g.Bt + (size_t)nxt.pn * tstep : cB;
        for (int t = 0; t < nt; t += 2) {
            const bool last = (t == nt - 2);
            const char* a1 = cA + (size_t)(t + 1) * kstep;
            const char* a2 = last ? nA : cA + (size_t)(t + 2) * kstep; const char* b2 = last ? nB : cB + (size_t)(t + 2) * kstep;
            const char* a3 = a2 + kstep; const char* b3 = b2 + kstep;
            if (last && has_next) S.a_ready(nxt);
            if constexpr (SP2) {
            PG8_LDB(B0, 0, 0); PG8_LDB(B1, 0, 1); PG8_SCHED; PG8_LDA(At, 0, 0); PG8_STAGE(PG8_SA(1, 1), a1 + hstep, voffA);
            PG8_WAIT_V(8); PG8_WAIT_L(0); PG8_BAR; PG8_MMA(0, 0, At, B0); PG8_MMA(0, 1, At, B1); PG8_BAR; PG8_SCHED;
            PG8_LDA(At, 0, 1); PG8_STAGE(PG8_SB(0, 0), b2, voffB); PG8_STAGE(PG8_SB(0, 1), b2 + hstep, voffB); PG8_STAGE(PG8_SA(0, 0), a2, voffA);
            PG8_WAIT_V(8); PG8_WAIT_L(0); PG8_BAR; PG8_MMA(1, 0, At, B0); PG8_MMA(1, 1, At, B1); PG8_BAR; PG8_SCHED;
            PG8_LDB(B0, 1, 0); PG8_LDB(B1, 1, 1); PG8_SCHED; PG8_LDA(At, 1, 0); PG8_STAGE(PG8_SA(0, 1), a2 + hstep, voffA);
            PG8_WAIT_V(8); PG8_WAIT_L(0); PG8_BAR; PG8_MMA(0, 0, At, B0); PG8_MMA(0, 1, At, B1); PG8_BAR; PG8_SCHED;
            PG8_LDA(At, 1, 1); PG8_STAGE(PG8_SB(1, 0), b3, voffB); PG8_STAGE(PG8_SB(1, 1), b3 + hstep, voffB); PG8_STAGE(PG8_SA(1, 0), a3, voffA);
            PG8_WAIT_V(8); PG8_WAIT_L(0); PG8_BAR; PG8_MMA(1, 0, At, B0); PG8_MMA(1, 1, At, B1); PG8_BAR; PG8_SCHED;
            } else {
            PG8_LDB(B0, 0, 0); PG8_SCHED; PG8_LDA(At, 0, 0); PG8_STAGE(PG8_SA(1, 1), a1 + hstep, voffA);
            PG8_WAIT_L(8); PG8_BAR; PG8_WAIT_L(0); PG8_MMA(0, 0, At, B0); PG8_BAR; PG8_SCHED;
            PG8_LDB(B1, 0, 1); PG8_STAGE(PG8_SB(0, 0), b2, voffB);
            PG8_BAR; PG8_WAIT_L(0); PG8_MMA(0, 1, At, B1); PG8_BAR;
            PG8_LDA(At, 0, 1); PG8_STAGE(PG8_SA(0, 0), a2, voffA);
            PG8_BAR; PG8_WAIT_L(0); PG8_MMA(1, 0, At, B0); PG8_BAR; PG8_SCHED;
            PG8_STAGE(PG8_SB(0, 1), b2 + hstep, voffB);
            PG8_WAIT_V(6); PG8_BAR; PG8_MMA(1, 1, At, B1); PG8_BAR;
            PG8_LDB(B0, 1, 0); PG8_SCHED; PG8_LDA(At, 1, 0); PG8_STAGE(PG8_SA(0, 1), a2 + hstep, voffA);
            PG8_WAIT_L(8); PG8_BAR; PG8_WAIT_L(0); PG8_MMA(0, 0, At, B0); PG8_BAR; PG8_SCHED;
            PG8_LDB(B1, 1, 1); PG8_STAGE(PG8_SB(1, 0), b3, voffB);
            PG8_BAR; PG8_WAIT_L(0); PG8_MMA(0, 1, At, B1); PG8_BAR;
            PG8_LDA(At, 1, 1); PG8_STAGE(PG8_SA(1, 0), a3, voffA);
            PG8_BAR; PG8_WAIT_L(0); PG8_MMA(1, 0, At, B0); PG8_BAR; PG8_SCHED;
            PG8_STAGE(PG8_SB(1, 1), b3 + hstep, voffB);
            PG8_WAIT_V(6); PG8_BAR; PG8_MMA(1, 1, At, B1); PG8_BAR;
            }
        }
        if constexpr (ALIGN_EPI) { if (wr == 0) PG8_BAR; }
        if constexpr (!Epi::AFTER_DRAIN) { E(acc, cur, wr, wc, fr, fq); S.done(cur); }
        if (!has_next) break;
#pragma unroll
        for (int a = 0; a < 2; ++a)
#pragma unroll
            for (int b = 0; b < 2; ++b)
#pragma unroll
                for (int m = 0; m < 4; ++m)
#pragma unroll
                    for (int n = 0; n < 2; ++n) acc[a][b][m][n] = (f32x4){0.f, 0.f, 0.f, 0.f};
        cur = nxt; cA = nA; cB = nB; ++ui;
        if constexpr (ALIGN_EPI) { if (wr == 1) PG8_BAR; }
    }
    PG8_WAIT_V(0);
    if constexpr (!ALIGN_EPI) { if (wr == 0) PG8_BAR; }
    PG8_BAR;
    if constexpr (Epi::AFTER_DRAIN) { E.fused(acc, cur, wr, wc, fr, fq, lds, wid, lane); S.done(cur); }
#undef PG8_SA
#undef PG8_SB
#undef PG8_STAGE
#undef PG8_LDA
#undef PG8_LDB
#undef PG8_MMA
#undef PG8_WAIT_V
#undef PG8_WAIT_L
#undef PG8_BAR
#undef PG8_SCHED
}
}
#define GAS __attribute__((address_space(1)))
#define LAS __attribute__((address_space(3)))
typedef unsigned short bf16;
typedef float f32x4 __attribute__((ext_vector_type(4)));
typedef float f32x2 __attribute__((ext_vector_type(2)));
typedef short bf16x8 __attribute__((ext_vector_type(8)));
typedef short bf16x4 __attribute__((ext_vector_type(4)));
typedef unsigned u32x4 __attribute__((ext_vector_type(4)));
typedef unsigned u32x2 __attribute__((ext_vector_type(2)));
#define MFMA16(a, b, c) __builtin_amdgcn_mfma_f32_16x16x32_bf16((a), (b), (c), 0, 0, 0)

constexpr int NWAVES = 8, NTHR = 512;
constexpr int DM = 1024, SEQ = 4096, NB = 4, MP = NB * SEQ, MS = 128, MALL = MP + MS, MPAD = 16640;
constexpr int DI = 2048, CONVD = 3072, NH = 32, NG = 4, NST = 128;
constexpr int NPROJ = 9984;
constexpr int DFF = 2816, DFF2 = 5632;
constexpr int NPAGES = 16, PAST = 2048;
constexpr float EPS = 1e-6f, NEGF = -1e30f, BIGF = 1e30f, TINYF = 1e-30f;
constexpr int T_Z = 0, T_XBC = 8, T_Q = 20, T_KV = 24, T_MG = 30, T_MISC = 38;

constexpr size_t O_YP = 0;
constexpr size_t O_YS = O_YP + (size_t)MP * DM;
constexpr size_t O_KVP = O_YS + (size_t)MS * DM;
constexpr size_t O_KVS = O_KVP + (size_t)MP * 1024;
constexpr size_t O_WINP = O_KVS + (size_t)MS * 1024;
constexpr size_t O_WINS = O_WINP + (size_t)NB * 512 * 512;
constexpr size_t O_SSMP = O_WINS + (size_t)MS * 512 * 512;
constexpr size_t O_SSMS = O_SSMP + (size_t)NB * NH * 64 * 128;
constexpr size_t O_CONVP = O_SSMS + (size_t)MS * NH * 64 * 128;
constexpr size_t O_CONVS = O_CONVP + (size_t)NB * 3 * CONVD;
constexpr size_t O_FFNP = O_CONVS + (size_t)MS * 3 * CONVD;
constexpr size_t O_FFNS = O_FFNP + (size_t)NB * 2 * DFF2;
constexpr size_t O_END = O_FFNS + (size_t)MS * 2 * DFF2;
static_assert(O_END == 105725952, "output size");

constexpr size_t al256(size_t x) { return (x + 255) & ~(size_t)255; }
constexpr size_t WS_CTL = 0, CTL_ZERO_BYTES = 1u << 20;
constexpr size_t WS_WIN = CTL_ZERO_BYTES;
constexpr size_t WS_WSSM = WS_WIN + al256((size_t)NPROJ * 1024 * 2);
constexpr size_t WS_WATT = WS_WSSM + al256((size_t)1024 * 2048 * 2);
constexpr size_t WS_WOUT = WS_WATT + al256((size_t)1024 * 1024 * 2);
constexpr size_t WS_WUP = WS_WOUT + al256((size_t)1024 * 1024 * 2);
constexpr size_t WS_WDN = WS_WUP + al256((size_t)DFF2 * 1024 * 2);
constexpr size_t WS_WADA = WS_WDN + al256((size_t)1024 * DFF * 2);
constexpr size_t WS_W1K = WS_WADA + al256((size_t)6144 * 1024 * 2);
constexpr size_t WS_W1V = WS_W1K + al256((size_t)256 * 1024 * 2);
constexpr size_t WS_SC = WS_W1V + al256((size_t)256 * 1024 * 2);
constexpr size_t WS_MOD = WS_SC + al256((size_t)256 * 1024 * 2);
constexpr size_t WS_ROPE = WS_MOD + al256((size_t)256 * 6144 * 4);
constexpr size_t WS_PET = WS_ROPE + al256((size_t)4096 * 16 * 4);
constexpr size_t WS_H = WS_PET + al256(2 * 128 * 4);
constexpr size_t WS_Z = WS_H + al256((size_t)MPAD * 1024 * 2);
constexpr size_t WS_XBC = WS_Z + al256((size_t)MPAD * 2048 * 2);
constexpr size_t WS_Q = WS_XBC + al256((size_t)MPAD * 3072 * 2);
constexpr size_t WS_MG = WS_Q + al256((size_t)MPAD * 1024 * 2);
constexpr size_t WS_MISC = WS_MG + al256((size_t)MPAD * 2048 * 2);
constexpr size_t WS_KVH = WS_MISC + al256((size_t)MPAD * 128 * 4);
constexpr size_t WS_VT = WS_KVH + al256((size_t)6 * 16 * 4096 * 64 * 2);
constexpr size_t WS_XT = WS_VT + al256((size_t)2 * 16 * 64 * 4096 * 2);
constexpr size_t WS_BN = WS_XT + al256((size_t)4 * 32 * 64 * 4096 * 2);
constexpr size_t WS_CN = WS_BN + al256((size_t)16 * 4096 * 128 * 2);
constexpr size_t WS_BT = WS_CN + al256((size_t)16 * 4096 * 128 * 2);
constexpr size_t WS_DT = WS_BT + al256((size_t)16 * 4096 * 128 * 2);
constexpr size_t WS_CS = WS_DT + al256((size_t)128 * 4096 * 4);
constexpr size_t WS_STATES = WS_CS + al256((size_t)128 * 4096 * 4);
constexpr size_t WS_HPREV = WS_STATES + al256((size_t)4096 * 8192 * 4);
constexpr size_t WS_YSSM = WS_HPREV + al256((size_t)4096 * 8192 * 2);
constexpr size_t WS_SSQ = WS_YSSM + al256((size_t)MPAD * 2048 * 2);
constexpr size_t WS_PARTK = WS_SSQ + al256((size_t)MPAD * 4 * 4);
constexpr size_t WS_PARTV = WS_PARTK + al256((size_t)4096 * 256 * 4);
constexpr size_t WS_KC = WS_PARTV + al256((size_t)4096 * 256 * 4);
constexpr size_t WS_VCT = WS_KC + al256((size_t)16 * 256 * 64 * 2);
constexpr size_t WS_YATTF = WS_VCT + al256((size_t)16 * 256 * 64 * 2);
constexpr size_t WS_YATT = WS_YATTF + al256((size_t)MPAD * 1024 * 4);
constexpr size_t WS_TMPM = WS_YATT + al256((size_t)MPAD * 1024 * 2);
constexpr size_t WS_MERGED = WS_TMPM + al256((size_t)MPAD * 1024 * 4);
constexpr size_t WS_X1 = WS_MERGED + al256((size_t)MPAD * 1024 * 2);
constexpr size_t WS_U = WS_X1 + al256((size_t)MPAD * 1024 * 4);
constexpr size_t WS_ACT = WS_U + al256((size_t)MPAD * DFF2 * 2);
constexpr size_t WS_CKB = WS_ACT + al256((size_t)MPAD * DFF * 2);
constexpr size_t WS_CVB = WS_CKB + al256((size_t)128 * 4 * 2048 * 64 * 2);
constexpr size_t WS_PARTSK = WS_CVB + al256((size_t)128 * 4 * 2048 * 64 * 2);
constexpr size_t WS_PARTSV = WS_PARTSK + al256((size_t)65536 * 256 * 4);
constexpr size_t WS_KCS = WS_PARTSV + al256((size_t)65536 * 256 * 4);
constexpr size_t WS_VCS = WS_KCS + al256((size_t)128 * 4 * 128 * 64 * 4);
constexpr size_t WS_XCS = WS_VCS + al256((size_t)128 * 4 * 128 * 64 * 4);
constexpr size_t WS_DTS = WS_XCS + al256((size_t)128 * 3072 * 4);
constexpr size_t WS_W2T = WS_DTS + al256((size_t)128 * 32 * 4);
constexpr size_t WS_PARTB = WS_W2T + al256((size_t)2 * 64 * 128 * 2);
constexpr size_t WS_END = WS_PARTB + al256((size_t)2 * 128 * 4 * 4 * 2 * 128 * 2);

constexpr int CW_BAR = 4096;

constexpr int RING_BYTES = 131072;
constexpr int LDSCTL_OFF = RING_BYTES, MISC_OFF = LDSCTL_OFF + 320;
constexpr int LDS_BYTES = 147456;

__device__ __forceinline__ unsigned f2bf(float f) { unsigned u = __builtin_bit_cast(unsigned, f); return (u + 0x7fffu + ((u >> 16) & 1u)) >> 16; }
__device__ __forceinline__ unsigned pk2(float lo, float hi) { return pg8::cvt_pk_bf16(lo, hi); }
typedef __bf16 bf16x2_t __attribute__((ext_vector_type(2)));
__device__ __forceinline__ unsigned pk2c(float lo, float hi) { const f32x2 v = {lo, hi}; return __builtin_bit_cast(unsigned, __builtin_convertvector(v, bf16x2_t)); }
__device__ __forceinline__ float bf2f(unsigned h) { return __builtin_bit_cast(float, h << 16); }
__device__ __forceinline__ float bflo(unsigned w) { return __builtin_bit_cast(float, w << 16); }
__device__ __forceinline__ float bfhi(unsigned w) { return __builtin_bit_cast(float, w & 0xffff0000u); }
__device__ __forceinline__ float wave_sum(float v) {
#pragma unroll
    for (int o = 1; o < 64; o <<= 1) v += __shfl_xor(v, o);
    return v;
}
__device__ __forceinline__ float siluf(float x) { return x / (1.f + __expf(-x)); }
__device__ __forceinline__ float sigmf(float x) { return 1.f / (1.f + __expf(-x)); }
__device__ __forceinline__ float softplusf(float x) { return x > 20.f ? x : log1pf(__expf(x)); }
#define LDS_WAIT() asm volatile("s_waitcnt lgkmcnt(0)" ::: "memory")

struct Args { const void* in[35]; float* out; unsigned char* ws; int ph_lo, ph_hi, p7mask, pad; };
#define INF(i) ((const float*)args.in[i])
#define XB_TMO      128
#define XB_XCNT(j)  (256  + 64 * (j))
#define XB_XSUB(j)  (1280 + 64 * (j))
#define XB_XGEN(j)  (2304 + 64 * (j))
#define XB_TOP      3328
#define XB_TOPGEN   3392
#define XCD_BAR_WORDS 3456
#define XB_SPIN_CAP (1u << 18)

__device__ __forceinline__ unsigned xb_ld(unsigned* p)              { return __hip_atomic_load(p, __ATOMIC_RELAXED, __HIP_MEMORY_SCOPE_AGENT); }
__device__ __forceinline__ unsigned xb_add(unsigned* p, unsigned v) { return __hip_atomic_fetch_add(p, v, __ATOMIC_RELAXED, __HIP_MEMORY_SCOPE_AGENT); }
__device__ __forceinline__ unsigned xb_xcc_id() { return (unsigned)__builtin_amdgcn_s_getreg((3 << 11) | 20) & 0xFu; }
#define XB_SPIN(cond, bar) do { unsigned _sp = 0; while (cond) { __builtin_amdgcn_s_sleep(1); \
    if ((++_sp & 255u) == 0u) { if (xb_ld(&(bar)[XB_TMO])) break; if (_sp > XB_SPIN_CAP) { atomicAdd(&(bar)[XB_TMO], 1u); break; } } } } while (0)

struct XcdBarrier {
    unsigned* bar; unsigned x;
    volatile LAS unsigned* st;
};

__device__ __forceinline__ XcdBarrier xcd_barrier_post(unsigned* bar, volatile LAS unsigned* st) {
    XcdBarrier b; b.bar = bar; b.x = xb_xcc_id(); b.st = st;
    if (threadIdx.x == 0) (void)xb_add(&bar[XB_XCNT(b.x)], 1u);
    return b;
}
__device__ __forceinline__ void xcd_barrier_complete(unsigned* bar, unsigned x, unsigned& nloc, unsigned& nx) {
    const unsigned G = gridDim.x * gridDim.y * gridDim.z;
    unsigned sum, cnt, mine, sp = 0u;
    for (;;) {
        sum = 0u; cnt = 0u; mine = 0u;
#pragma unroll
        for (unsigned j = 0; j < 16; ++j) { const unsigned c = xb_ld(&bar[XB_XCNT(j)]); sum += c; cnt += (c > 0u) ? 1u : 0u; mine = (j == x) ? c : mine; }
        if (sum == G) break;
        __builtin_amdgcn_s_sleep(1);
        if ((++sp & 255u) == 0u) { if (xb_ld(&bar[XB_TMO])) break; if (sp > XB_SPIN_CAP) { atomicAdd(&bar[XB_TMO], 1u); break; } }
    }
    nloc = mine > 0u ? mine : 1u; nx = cnt > 0u ? cnt : 1u;
}

__device__ __forceinline__ void xcd_barrier(const XcdBarrier& b) {
    asm volatile("s_waitcnt vmcnt(0)" ::: "memory");
    __syncthreads();
    if (threadIdx.x == 0) {
        unsigned* bar = b.bar;
        __builtin_amdgcn_s_waitcnt(0);
        unsigned nloc = b.st[0], nx = b.st[1];
        if (nloc == 0u) { xcd_barrier_complete(bar, b.x, nloc, nx); b.st[0] = nloc; b.st[1] = nx; }
        const unsigned old = xb_add(&bar[XB_XSUB(b.x)], 1u);
        const unsigned gen = old / nloc;
        if (old + 1u == (gen + 1u) * nloc) {
            __builtin_amdgcn_fence(__ATOMIC_RELEASE, "agent");
            asm volatile("s_waitcnt vmcnt(0)" ::: "memory");
            const unsigned og = xb_add(&bar[XB_TOP], 1u);
            const unsigned tg = og / nx;
            if (og + 1u == (tg + 1u) * nx) xb_add(&bar[XB_TOPGEN], 1u);
            else XB_SPIN(xb_ld(&bar[XB_TOPGEN]) == tg, bar);
            __builtin_amdgcn_fence(__ATOMIC_ACQUIRE, "agent");
            xb_add(&bar[XB_XGEN(b.x)], 1u);
            asm volatile("s_waitcnt vmcnt(0)" ::: "memory");
        } else {
            XB_SPIN(xb_ld(&bar[XB_XGEN(b.x)]) == gen, bar);
            __builtin_amdgcn_fence(__ATOMIC_ACQUIRE, "agent");
            asm volatile("s_waitcnt vmcnt(0)" ::: "memory");
        }
    }
    __syncthreads();
}
__device__ __forceinline__ int inproj_src_col(int n) {
    if (n < 5120) return n;
    if (n < 6144) return n - 5120 + 5152;
    if (n < 7680) return n - 6144 + 6176;
    if (n < 9728) return n - 7680 + 7760;
    const int i = n - 9728;
    if (i < 32) return 5120 + i;
    if (i < 80) return 7712 + (i - 32);
    return -1;
}
template <int MODE>
__device__ __forceinline__ void transpose_item(const float* W, int K, int ldw, int nblk, bf16* WT, int row_off, LAS float* scr, int item, int lane) {
    const int kb = item / nblk, nb = item % nblk, k0 = 64 * kb, n0 = 32 * nb;
    const int n = n0 + (lane & 31);
    const int sc = (MODE == 1) ? inproj_src_col(n) : n;
#pragma unroll 8
    for (int i = 0; i < 32; ++i) { const int kk = 2 * i + (lane >> 5); scr[kk * 33 + (lane & 31)] = (sc >= 0) ? W[(size_t)(k0 + kk) * ldw + sc] : 0.f; }
    LDS_WAIT(); asm volatile("" ::: "memory");
    const int c = lane & 7;
#pragma unroll
    for (int j = 0; j < 4; ++j) { const int nn = (lane >> 3) + 8 * j; const LAS float* s = scr + (8 * c) * 33 + nn;
        u32x4 o; o.x = pk2(s[0 * 33], s[1 * 33]); o.y = pk2(s[2 * 33], s[3 * 33]); o.z = pk2(s[4 * 33], s[5 * 33]); o.w = pk2(s[6 * 33], s[7 * 33]);
        *(u32x4*)(WT + (size_t)(row_off + n0 + nn) * K + k0 + 8 * c) = o; }
    LDS_WAIT(); asm volatile("" ::: "memory");
}

__device__ __forceinline__ void p0_prologue(const Args& args, LAS unsigned char* lds, int gw, int NGW, int lane, int wave) {
    unsigned char* ws = args.ws;
    const int p0m = args.pad;
    LAS float* scr = (LAS float*)(lds + wave * 16384);
    constexpr int I_IN = 16 * (NPROJ / 32), I_SSM = 32 * 32, I_ATT = 16 * 32, I_OUT = 16 * 32, I_UP = 16 * (DFF2 / 32), I_DN = (DFF / 64) * 32, I_ADA = 16 * (6144 / 32), I_W1 = 16 * 4;
    constexpr int NITEMS = I_IN + I_SSM + I_ATT + I_OUT + I_UP + I_DN + I_ADA + 4 * I_W1;
    if (p0m & 1) for (int it = gw; it < NITEMS; it += NGW) {
        int r = it;
        if (r < I_ADA) { transpose_item<0>(INF(10), 1024, 6144, 6144 / 32, (bf16*)(ws + WS_WADA), 0, scr, r, lane); continue; } r -= I_ADA;
        if (r < I_IN) { transpose_item<1>(INF(15), 1024, 9808, NPROJ / 32, (bf16*)(ws + WS_WIN), 0, scr, r, lane); continue; } r -= I_IN;
        if (r < I_SSM) { transpose_item<0>(INF(28), 2048, 1024, 32, (bf16*)(ws + WS_WSSM), 0, scr, r, lane); continue; } r -= I_SSM;
        if (r < I_ATT) { transpose_item<0>(INF(29), 1024, 1024, 32, (bf16*)(ws + WS_WATT), 0, scr, r, lane); continue; } r -= I_ATT;
        if (r < I_OUT) { transpose_item<0>(INF(30), 1024, 1024, 32, (bf16*)(ws + WS_WOUT), 0, scr, r, lane); continue; } r -= I_OUT;
        if (r < I_UP) { transpose_item<0>(INF(31), 1024, DFF2, DFF2 / 32, (bf16*)(ws + WS_WUP), 0, scr, r, lane); continue; } r -= I_UP;
        if (r < I_DN) { transpose_item<0>(INF(34), DFF, 1024, 32, (bf16*)(ws + WS_WDN), 0, scr, r, lane); continue; } r -= I_DN;
        { const int which = r / I_W1, rr = r % I_W1; const int st = which >> 1, r2 = which & 1;
          transpose_item<0>(INF(st ? 26 : 23) + (size_t)r2 * 16 * 64 * 128, 1024, 128, 4, (bf16*)(ws + (st ? WS_W1V : WS_W1K)), r2 * 128, scr, rr, lane); }
    }
    if (p0m & 4) {
    for (int r = gw; r < 256; r += NGW) {
        bf16* o = (bf16*)(ws + WS_SC) + (size_t)r * 1024;
        const float* src = r < 4 ? INF(2) + (size_t)r * 1024 : (r < 132 ? INF(3) + (size_t)(r - 4) * 1024 : nullptr);
#pragma unroll
        for (int j = 0; j < 4; ++j) { const int c0 = (j * 64 + lane) * 4; f32x4 v = src ? *(const f32x4*)(src + c0) : (f32x4){0.f, 0.f, 0.f, 0.f};
            u32x2 w; w.x = pk2(src ? siluf(v.x) : 0.f, src ? siluf(v.y) : 0.f); w.y = pk2(src ? siluf(v.z) : 0.f, src ? siluf(v.w) : 0.f); *(u32x2*)(o + c0) = w; }
    }
    for (int i = gw * 64 + lane; i < 4096 * 8; i += NGW * 64) {
        const int pos = i >> 3, k = i & 7;
        const float invf[8] = {1.0f, 0.1939227432012558f, 0.03760603070259094f, 0.007292664609849453f, 0.0014142135623842478f, 0.00027424818836152554f, 5.318296098266728e-05f, 1.0313386155758053e-05f};
        float fr = 1.0f;
#pragma unroll
        for (int q = 0; q < 8; ++q) fr = (k == q) ? invf[q] : fr;
        const float ang = (float)pos * fr;
        const double ad = (double)ang, rev = ad * 0.15915494309189535;
        const float fracrev = (float)(rev - __builtin_floor(rev));
        float* o = (float*)(ws + WS_ROPE) + (size_t)pos * 16;
        o[k] = __builtin_amdgcn_cosf(fracrev); o[8 + k] = __builtin_amdgcn_sinf(fracrev);
    }
    for (int it = gw; it < 256; it += NGW) {
        const int st = it >> 7, e = it & 127; const float* pe = INF(st ? 25 : 22); const float* w1 = INF(st ? 26 : 23);
        float s = 0.f;
        for (int i = 0; i < 32; ++i) { const int idx = lane + 64 * i; s += pe[idx] * w1[(size_t)idx * 128 + e]; }
        s = wave_sum(s);
        if (lane == 0) ((float*)(ws + WS_PET))[it] = s;
    }
    }
    if (p0m & 4) for (int i = gw * 64 + lane; i < 2 * 64 * 128; i += NGW * 64) { const int st = i >> 13, d = (i >> 7) & 63, e = i & 127;
        ((bf16*)(ws + WS_W2T))[i] = (bf16)f2bf(INF(st ? 27 : 24)[e * 64 + d]); }
}

template <int WHICH>
__device__ __forceinline__ void norm_mod_phase(const Args& args, int gw, int NGW, int lane) {
    unsigned char* ws = args.ws; const float* MOD = (const float*)(ws + WS_MOD); bf16* H = (bf16*)(ws + WS_H);
    const float* nw = INF(WHICH == 0 ? 12 : (WHICH == 1 ? 13 : 14));
    constexpr int SH = WHICH ? 3072 : 0, SCo = WHICH ? 4096 : 1024;
    for (int grp = gw; grp < MPAD / 4; grp += NGW) {
        const int m0 = grp * 4;
        if (m0 >= MALL) {
            if (WHICH < 2) {
#pragma unroll
                for (int r = 0; r < 4; ++r)
#pragma unroll
                    for (int j = 0; j < 4; ++j) ((u32x2*)(H + (size_t)(m0 + r) * 1024))[j * 64 + lane] = (u32x2){0u, 0u};
            }
            continue; }
        f32x4 v[4][4]; float ss[4];
#pragma unroll
        for (int r = 0; r < 4; ++r) { const int m = m0 + r;
            const float* xr = WHICH ? (const float*)(ws + WS_X1) + (size_t)m * 1024 : (m < MP ? INF(0) + (size_t)m * 1024 : INF(1) + (size_t)(m - MP) * 1024);
            float s = 0.f;
#pragma unroll
            for (int j = 0; j < 4; ++j) { v[r][j] = *(const f32x4*)(xr + (j * 64 + lane) * 4); s += (v[r][j].x * v[r][j].x + v[r][j].y * v[r][j].y) + (v[r][j].z * v[r][j].z + v[r][j].w * v[r][j].w); }
            ss[r] = s; }
#pragma unroll
        for (int o = 1; o < 64; o <<= 1)
#pragma unroll
            for (int r = 0; r < 4; ++r) ss[r] += __shfl_xor(ss[r], o);
        f32x4 w[4];
#pragma unroll
        for (int j = 0; j < 4; ++j) w[j] = *(const f32x4*)(nw + (j * 64 + lane) * 4);
#pragma unroll
        for (int r = 0; r < 4; ++r) { const int m = m0 + r;
            const float rstd = 1.f / sqrtf(ss[r] * (1.f / 1024.f) + EPS);
            if (WHICH == 2) { float* o = args.out + (m < MP ? O_YP + (size_t)m * 1024 : O_YS + (size_t)(m - MP) * 1024);
#pragma unroll
                for (int j = 0; j < 4; ++j) *(f32x4*)(o + (j * 64 + lane) * 4) = (v[r][j] * rstd) * w[j];
            } else {
                const float* mr = MOD + (size_t)(m < MP ? (m >> 12) : 4 + (m - MP)) * 6144;
                u32x2* o = (u32x2*)(H + (size_t)m * 1024);
#pragma unroll
                for (int j = 0; j < 4; ++j) { const int c0 = (j * 64 + lane) * 4;
                    const f32x4 sc = *(const f32x4*)(mr + SCo + c0), sh = *(const f32x4*)(mr + SH + c0);
                    const f32x4 rr = (v[r][j] * rstd) * w[j] * (sc + 1.f) + sh;
                    u32x2 pk; pk.x = pk2(rr.x, rr.y); pk.y = pk2(rr.z, rr.w); o[j * 64 + lane] = pk; }
            }
        }
    }
}
namespace epi {
using pg8::Unit; using pg8::f32x4;
typedef unsigned u32x4 __attribute__((ext_vector_type(4)));
__device__ __forceinline__ u32x4 pack8(const f32x4& a, const f32x4& b) { u32x4 w; w.x = pg8::cvt_pk_bf16(a[0], a[1]); w.y = pg8::cvt_pk_bf16(a[2], a[3]); w.z = pg8::cvt_pk_bf16(b[0], b[1]); w.w = pg8::cvt_pk_bf16(b[2], b[3]); return w; }

struct InProj {
    static constexpr bool PERM = true, AFTER_DRAIN = false;
    unsigned char* ws; float* out;
    __device__ __forceinline__ void operator()(const f32x4 (&acc)[2][2][4][2], const Unit& u, int wr, int wc, int fr, int fq) const {
        const int pn = u.pn;
        const int rowb = u.pm * 256 + wr * 64 + fr;
        const int cl = wc * 32 + 8 * fq;
        if (pn < T_XBC || (pn >= T_MG && pn < T_MISC)) {
            bf16* base = pn < T_XBC ? (bf16*)(ws + WS_Z) : (bf16*)(ws + WS_MG);
            const int colt = (pn < T_XBC ? pn : pn - T_MG) * 256 + cl;
#pragma unroll
            for (int ai = 0; ai < 2; ++ai)
#pragma unroll
                for (int m = 0; m < 4; ++m) { const int row = rowb + ai * 128 + m * 16;
#pragma unroll
                    for (int bj = 0; bj < 2; ++bj) *(u32x4*)(base + (size_t)row * 2048 + colt + bj * 128) = pack8(acc[ai][bj][m][0], acc[ai][bj][m][1]); }
        } else if (pn < T_Q) {
            bf16* base = (bf16*)(ws + WS_XBC); const int colt = (pn - T_XBC) * 256 + cl;
#pragma unroll
            for (int ai = 0; ai < 2; ++ai)
#pragma unroll
                for (int m = 0; m < 4; ++m) { const int row = rowb + ai * 128 + m * 16;
                    float* fo = nullptr;
                    if (row < MP) { const int t = row & 4095; if (t >= 4093) fo = out + O_CONVP + ((size_t)(row >> 12) * 3 + (t - 4093)) * CONVD; }
                    else if (row < MALL) fo = out + O_CONVS + ((size_t)(row - MP) * 3 + 2) * CONVD;
#pragma unroll
                    for (int bj = 0; bj < 2; ++bj) { const int col = colt + bj * 128;
                        *(u32x4*)(base + (size_t)row * CONVD + col) = pack8(acc[ai][bj][m][0], acc[ai][bj][m][1]);
                        if (fo) { *(f32x4*)(fo + col) = acc[ai][bj][m][0]; *(f32x4*)(fo + col + 4) = acc[ai][bj][m][1]; } } }
        } else if (pn < T_MG) {
            const bool isq = pn < T_KV; const int s = pn - T_KV;
            const bool dorope = (isq || !(s & 1)) && !(wc & 1);
            const float* rope = (const float*)(ws + WS_ROPE);
#pragma unroll
            for (int ai = 0; ai < 2; ++ai)
#pragma unroll
                for (int m = 0; m < 4; ++m) { const int row = rowb + ai * 128 + m * 16;
                    const int pos = row < MP ? (row & 4095) : PAST;
#pragma unroll
                    for (int bj = 0; bj < 2; ++bj) {
                        f32x4 v0 = acc[ai][bj][m][0], v1 = acc[ai][bj][m][1];
                        if (dorope) {
                            f32x4 o0, o1;
#pragma unroll
                            for (int i = 0; i < 4; ++i) { o0[i] = __shfl_xor(v0[i], 16); o1[i] = __shfl_xor(v1[i], 16); }
                            if (fq < 2) {
                                const f32x4 c0 = *(const f32x4*)(rope + pos * 16), c1 = *(const f32x4*)(rope + pos * 16 + 4), s0 = *(const f32x4*)(rope + pos * 16 + 8), s1 = *(const f32x4*)(rope + pos * 16 + 12);
                                if (fq == 0) { v0 = v0 * c0 - o0 * s0; v1 = v1 * c1 - o1 * s1; }
                                else         { v0 = v0 * c0 + o0 * s0; v1 = v1 * c1 + o1 * s1; }
                            }
                        }
                        const int col = cl + bj * 128;
                        const u32x4 pk = pack8(v0, v1);
                        if (isq) { *(u32x4*)((bf16*)(ws + WS_Q) + (size_t)row * 1024 + (pn - T_Q) * 256 + col) = pk; }
                        else {
                            const int h = col >> 6, d = col & 63;
                            if (row < MP) {
                                const int b = row >> 12, t = row & 4095;
                                *(u32x4*)((bf16*)(ws + WS_KVH) + ((((size_t)s * 4 + b) * 4 + h) * 4096 + t) * 64 + d) = pk;
                                if (s < 4) { float* fo = out + O_KVP + ((size_t)row * 4 + s) * 256 + col; *(f32x4*)fo = v0; *(f32x4*)(fo + 4) = v1; }
                                else if (t >= 3584) { float* fo = out + O_WINP + (((size_t)b * 512 + (t - 3584)) * 2 + (s - 4)) * 256 + col; *(f32x4*)fo = v0; *(f32x4*)(fo + 4) = v1; }
                                if (s == 3 || s == 5) {
                                    const int kk = t & 31, kpos = 8 * ((kk & 15) >> 2) + 4 * (kk >> 4) + (kk & 3);
                                    bf16* vt = (bf16*)(ws + WS_VT) + ((((size_t)(s == 5) * 4 + b) * 4 + h) * 128 + (t >> 5)) * 2048 + d * 32 + kpos;
                                    vt[0 * 32] = (bf16)(pk.x & 0xffffu); vt[1 * 32] = (bf16)(pk.x >> 16); vt[2 * 32] = (bf16)(pk.y & 0xffffu); vt[3 * 32] = (bf16)(pk.y >> 16);
                                    vt[4 * 32] = (bf16)(pk.z & 0xffffu); vt[5 * 32] = (bf16)(pk.z >> 16); vt[6 * 32] = (bf16)(pk.w & 0xffffu); vt[7 * 32] = (bf16)(pk.w >> 16);
                                }
                            } else if (row < MALL) {
                                const int bs = row - MP;
                                float* fo = s < 4 ? out + O_KVS + ((size_t)bs * 4 + s) * 256 + col : out + O_WINS + (((size_t)bs * 512 + 511) * 2 + (s - 4)) * 256 + col;
                                *(f32x4*)fo = v0; *(f32x4*)(fo + 4) = v1;
                            }
                        }
                    } }
        } else {
            float* base = (float*)(ws + WS_MISC);
#pragma unroll
            for (int ai = 0; ai < 2; ++ai)
#pragma unroll
                for (int m = 0; m < 4; ++m) { const int row = rowb + ai * 128 + m * 16;
                    *(f32x4*)(base + (size_t)row * 128 + cl) = acc[ai][0][m][0]; *(f32x4*)(base + (size_t)row * 128 + cl + 4) = acc[ai][0][m][1]; }
        }
    }
};

struct Merge1 {
    static constexpr bool PERM = true, AFTER_DRAIN = false;
    unsigned char* ws;
    __device__ __forceinline__ void operator()(const f32x4 (&acc)[2][2][4][2], const Unit& u, int wr, int wc, int fr, int fq) const {
        const int rowb = u.pm * 256 + wr * 64 + fr, colb = u.pn * 256 + wc * 32 + 8 * fq;
        const bf16* MG = (const bf16*)(ws + WS_MG); const float* SSQ = (const float*)(ws + WS_SSQ); float* T = (float*)(ws + WS_TMPM);
#pragma unroll
        for (int ai = 0; ai < 2; ++ai)
#pragma unroll
            for (int m = 0; m < 4; ++m) { const int row = rowb + ai * 128 + m * 16;
                const f32x4 sq = *(const f32x4*)(SSQ + (size_t)row * 4);
                const float rstd = 1.f / sqrtf(((sq.x + sq.y) + (sq.z + sq.w)) * (1.f / 2048.f) + EPS);
#pragma unroll
                for (int bj = 0; bj < 2; ++bj) { const int col = colb + bj * 128;
                    const u32x4 g = *(const u32x4*)(MG + (size_t)row * 2048 + col);
                    f32x4 o0, o1;
                    o0[0] = sigmf(bflo(g.x)) * rstd * acc[ai][bj][m][0][0]; o0[1] = sigmf(bfhi(g.x)) * rstd * acc[ai][bj][m][0][1];
                    o0[2] = sigmf(bflo(g.y)) * rstd * acc[ai][bj][m][0][2]; o0[3] = sigmf(bfhi(g.y)) * rstd * acc[ai][bj][m][0][3];
                    o1[0] = sigmf(bflo(g.z)) * rstd * acc[ai][bj][m][1][0]; o1[1] = sigmf(bfhi(g.z)) * rstd * acc[ai][bj][m][1][1];
                    o1[2] = sigmf(bflo(g.w)) * rstd * acc[ai][bj][m][1][2]; o1[3] = sigmf(bfhi(g.w)) * rstd * acc[ai][bj][m][1][3];
                    *(f32x4*)(T + (size_t)row * 1024 + col) = o0; *(f32x4*)(T + (size_t)row * 1024 + col + 4) = o1; } }
    }
};
struct Merge2 {
    static constexpr bool PERM = true, AFTER_DRAIN = false;
    unsigned char* ws;
    __device__ __forceinline__ void operator()(const f32x4 (&acc)[2][2][4][2], const Unit& u, int wr, int wc, int fr, int fq) const {
        const int rowb = u.pm * 256 + wr * 64 + fr, colb = u.pn * 256 + wc * 32 + 8 * fq;
        const bf16* MG = (const bf16*)(ws + WS_MG); const float* T = (const float*)(ws + WS_TMPM); bf16* O = (bf16*)(ws + WS_MERGED);
#pragma unroll
        for (int ai = 0; ai < 2; ++ai)
#pragma unroll
            for (int m = 0; m < 4; ++m) { const int row = rowb + ai * 128 + m * 16;
#pragma unroll
                for (int bj = 0; bj < 2; ++bj) { const int col = colb + bj * 128;
                    const u32x4 g = *(const u32x4*)(MG + (size_t)row * 2048 + 1024 + col);
                    f32x4 o0 = *(const f32x4*)(T + (size_t)row * 1024 + col), o1 = *(const f32x4*)(T + (size_t)row * 1024 + col + 4);
                    o0[0] += sigmf(bflo(g.x)) * acc[ai][bj][m][0][0]; o0[1] += sigmf(bfhi(g.x)) * acc[ai][bj][m][0][1];
                    o0[2] += sigmf(bflo(g.y)) * acc[ai][bj][m][0][2]; o0[3] += sigmf(bfhi(g.y)) * acc[ai][bj][m][0][3];
                    o1[0] += sigmf(bflo(g.z)) * acc[ai][bj][m][1][0]; o1[1] += sigmf(bfhi(g.z)) * acc[ai][bj][m][1][1];
                    o1[2] += sigmf(bflo(g.w)) * acc[ai][bj][m][1][2]; o1[3] += sigmf(bfhi(g.w)) * acc[ai][bj][m][1][3];
                    *(u32x4*)(O + (size_t)row * 1024 + col) = pack8(o0, o1); } }
    }
};
struct Resid {
    static constexpr bool PERM = false, AFTER_DRAIN = false;
    const float* xp; const float* xs; const float* x1in; float* x1out; const float* MOD; int goff;
    __device__ __forceinline__ void operator()(const f32x4 (&acc)[2][2][4][2], const Unit& u, int wr, int wc, int fr, int fq) const {
        const int rowb = u.pm * 256 + wr * 64 + fr, colb = u.pn * 256 + wc * 32 + 4 * fq;
#pragma unroll
        for (int ai = 0; ai < 2; ++ai)
#pragma unroll
            for (int m = 0; m < 4; ++m) { const int row = rowb + ai * 128 + m * 16;
                if (row >= MALL) continue;
                const float* base = x1in ? x1in + (size_t)row * 1024 : (row < MP ? xp + (size_t)row * 1024 : xs + (size_t)(row - MP) * 1024);
                const float* gr = MOD + (size_t)(row < MP ? (row >> 12) : 4 + (row - MP)) * 6144 + goff;
#pragma unroll
                for (int bj = 0; bj < 2; ++bj)
#pragma unroll
                    for (int n = 0; n < 2; ++n) { const int col = colb + bj * 128 + n * 16;
                        *(f32x4*)(x1out + (size_t)row * 1024 + col) = *(const f32x4*)(base + col) + *(const f32x4*)(gr + col) * acc[ai][bj][m][n]; } }
    }
};
struct Up {
    static constexpr bool PERM = true, AFTER_DRAIN = false;
    unsigned char* ws; float* out;
    __device__ __forceinline__ void operator()(const f32x4 (&acc)[2][2][4][2], const Unit& u, int wr, int wc, int fr, int fq) const {
        const int rowb = u.pm * 256 + wr * 64 + fr, colb = u.pn * 256 + wc * 32 + 8 * fq;
        bf16* U = (bf16*)(ws + WS_U);
#pragma unroll
        for (int ai = 0; ai < 2; ++ai)
#pragma unroll
            for (int m = 0; m < 4; ++m) { const int row = rowb + ai * 128 + m * 16;
                float* fo = nullptr;
                if (row < MP) { const int t = row & 4095; if (t >= 4094) fo = out + O_FFNP + ((size_t)(row >> 12) * 2 + (t - 4094)) * DFF2; }
                else if (row < MALL) fo = out + O_FFNS + ((size_t)(row - MP) * 2 + 1) * DFF2;
#pragma unroll
                for (int bj = 0; bj < 2; ++bj) { const int col = colb + bj * 128;
                    *(u32x4*)(U + (size_t)row * DFF2 + col) = pack8(acc[ai][bj][m][0], acc[ai][bj][m][1]);
                    if (fo) { *(f32x4*)(fo + col) = acc[ai][bj][m][0]; *(f32x4*)(fo + col + 4) = acc[ai][bj][m][1]; } } }
    }
};
struct PartBf16 {
    static constexpr bool PERM = true, AFTER_DRAIN = false;
    bf16* P;
    __device__ __forceinline__ void operator()(const f32x4 (&acc)[2][2][4][2], const Unit& u, int wr, int wc, int fr, int fq) const {
        const int rowb = u.pm * 256 + wr * 64 + fr, colb = wc * 32 + 8 * fq;
#pragma unroll
        for (int ai = 0; ai < 2; ++ai)
#pragma unroll
            for (int m = 0; m < 4; ++m) { const int row = rowb + ai * 128 + m * 16;
#pragma unroll
                for (int bj = 0; bj < 2; ++bj) *(u32x4*)(P + (size_t)row * 256 + colb + bj * 128) = pack8(acc[ai][bj][m][0], acc[ai][bj][m][1]); }
    }
};
}
__device__ __forceinline__ void conv_prompt_item(const Args& args, int item, int lane) {
    unsigned char* ws = args.ws;
    const int tg = item / 48, cgp = item % 48, cg = lane & 7, rg = lane >> 3;
    const int m0 = tg * 64 + 8 * rg, b = m0 >> 12, t0 = m0 & 4095, ch0 = cgp * 64 + 8 * cg;
    const bf16* X = (const bf16*)(ws + WS_XBC);
    float x[11][8];
#pragma unroll
    for (int i = 0; i < 11; ++i) {
        const int t = t0 - 3 + i;
        u32x4 v = (u32x4){0u, 0u, 0u, 0u};
        if (t >= 0) v = *(const u32x4*)(X + (size_t)(m0 - 3 + i) * CONVD + ch0);
        x[i][0] = bflo(v.x); x[i][1] = bfhi(v.x); x[i][2] = bflo(v.y); x[i][3] = bfhi(v.y); x[i][4] = bflo(v.z); x[i][5] = bfhi(v.z); x[i][6] = bflo(v.w); x[i][7] = bfhi(v.w);
    }
    const float* cw = INF(16); const float* cb = INF(17);
    float w[4][8], bias[8];
#pragma unroll
    for (int k = 0; k < 4; ++k) { const f32x4 a = *(const f32x4*)(cw + k * CONVD + ch0), c = *(const f32x4*)(cw + k * CONVD + ch0 + 4);
        w[k][0] = a.x; w[k][1] = a.y; w[k][2] = a.z; w[k][3] = a.w; w[k][4] = c.x; w[k][5] = c.y; w[k][6] = c.z; w[k][7] = c.w; }
    { const f32x4 a = *(const f32x4*)(cb + ch0), c = *(const f32x4*)(cb + ch0 + 4); bias[0] = a.x; bias[1] = a.y; bias[2] = a.z; bias[3] = a.w; bias[4] = c.x; bias[5] = c.y; bias[6] = c.z; bias[7] = c.w; }
    float y[8][8];
#pragma unroll
    for (int i = 0; i < 8; ++i)
#pragma unroll
        for (int c = 0; c < 8; ++c) { const float a = bias[c] + w[0][c] * x[i][c] + w[1][c] * x[i + 1][c] + w[2][c] * x[i + 2][c] + w[3][c] * x[i + 3][c]; y[i][c] = siluf(a); }
    if (cgp < 32) {
        bf16* XT = (bf16*)(ws + WS_XT) + ((size_t)(b * 32 + cgp) * 128 + (t0 >> 5)) * 2048 + (8 * cg) * 32 + (t0 & 31);
#pragma unroll
        for (int c = 0; c < 8; ++c) { u32x4 o; o.x = pk2(y[0][c], y[1][c]); o.y = pk2(y[2][c], y[3][c]); o.z = pk2(y[4][c], y[5][c]); o.w = pk2(y[6][c], y[7][c]); *(u32x4*)(XT + (size_t)c * 32) = o; }
    } else {
        const int isC = cgp >= 40, gg = ((cgp - 32) & 7) >> 1, n0 = ((cgp - 32) & 1) * 64 + 8 * cg;
        bf16* N = (bf16*)(ws + (isC ? WS_CN : WS_BN)) + ((size_t)(b * 4 + gg) * 4096 + t0) * 128 + n0;
#pragma unroll
        for (int i = 0; i < 8; ++i) { u32x4 o; o.x = pk2(y[i][0], y[i][1]); o.y = pk2(y[i][2], y[i][3]); o.z = pk2(y[i][4], y[i][5]); o.w = pk2(y[i][6], y[i][7]); *(u32x4*)(N + (size_t)i * 128) = o; }
        if (!isC) {
            bf16* BT = (bf16*)(ws + WS_BT) + ((size_t)(b * 4 + gg) * 128 + (t0 >> 5)) * 4096 + n0 * 32 + (t0 & 31);
#pragma unroll
            for (int c = 0; c < 8; ++c) { u32x4 o; o.x = pk2(y[0][c], y[1][c]); o.y = pk2(y[2][c], y[3][c]); o.z = pk2(y[4][c], y[5][c]); o.w = pk2(y[6][c], y[7][c]); *(u32x4*)(BT + (size_t)c * 32) = o; }
        }
    }
}
__device__ __forceinline__ void dtcs_item(const Args& args, int item, int lane) {
    unsigned char* ws = args.ws;
    const int c = item & 31, h = (item >> 5) & 31, b = item >> 10;
    const float* MISC = (const float*)(ws + WS_MISC);
    const float bias = INF(18)[h], a = -__expf(INF(19)[h]);
    const int t = c * 128 + 2 * lane; const size_t m = (size_t)b * 4096 + t;
    const float d0 = softplusf(MISC[m * 128 + h] + bias), d1 = softplusf(MISC[(m + 1) * 128 + h] + bias);
    const float a0 = d0 * a, a1 = d1 * a;
    float s = a0 + a1;
#pragma unroll
    for (int o = 1; o < 64; o <<= 1) { const float v = __shfl_up(s, o); if (lane >= o) s += v; }
    const float c1 = s, c0 = s - a1;
    float* DT = (float*)(ws + WS_DT) + (size_t)(b * 32 + h) * 4096 + t; float* CS = (float*)(ws + WS_CS) + (size_t)(b * 32 + h) * 4096 + t;
    *(f32x2*)DT = (f32x2){d0, d1}; *(f32x2*)CS = (f32x2){c0, c1};
}
__device__ __forceinline__ void sample_conv(const Args& args, int gt, int NGT) {
    unsigned char* ws = args.ws; float* out = args.out;
    const float* st = INF(8); const float* cw = INF(16); const float* cb = INF(17);
    for (int i = gt; i < MS * CONVD; i += NGT) {
        const int bs = i / CONVD, ch = i % CONVD;
        const float s0 = st[((size_t)bs * 3 + 0) * CONVD + ch], s1 = st[((size_t)bs * 3 + 1) * CONVD + ch], s2 = st[((size_t)bs * 3 + 2) * CONVD + ch];
        const float xn = out[O_CONVS + ((size_t)bs * 3 + 2) * CONVD + ch];
        out[O_CONVS + ((size_t)bs * 3 + 0) * CONVD + ch] = s1; out[O_CONVS + ((size_t)bs * 3 + 1) * CONVD + ch] = s2;
        const float a = cb[ch] + cw[ch] * s0 + cw[CONVD + ch] * s1 + cw[2 * CONVD + ch] * s2 + cw[3 * CONVD + ch] * xn;
        ((float*)(ws + WS_XCS))[i] = siluf(a);
    }
    for (int i = gt; i < MS * NH; i += NGT) { const int bs = i >> 5, h = i & 31;
        ((float*)(ws + WS_DTS))[i] = softplusf(((const float*)(ws + WS_MISC))[(size_t)(MP + bs) * 128 + h] + INF(18)[h]); }
}

struct SFrag { u32x4 x[4]; bf16x8 b[4]; };
__device__ __forceinline__ void ssd_states_load(const bf16* XT, const bf16* BT, int nh, int ks, int q, int r16, SFrag& F) {
#pragma unroll
    for (int pt = 0; pt < 4; ++pt) F.x[pt] = *(const u32x4*)(XT + (size_t)ks * 2048 + (16 * pt + r16) * 32 + 8 * q);
#pragma unroll
    for (int nt = 0; nt < 4; ++nt) F.b[nt] = *(const bf16x8*)(BT + (size_t)ks * 4096 + (64 * nh + 16 * nt + r16) * 32 + 8 * q);
}
__device__ __forceinline__ void ssd_states_step(const LAS float* wl, int ks, int q, const SFrag& F, f32x4 (&acc)[4][4]) {
    const int s0 = 32 * ks + 8 * q;
    const f32x4 w0 = *(const LAS f32x4*)(wl + s0), w1 = *(const LAS f32x4*)(wl + s0 + 4);
    bf16x8 af[4];
#pragma unroll
    for (int pt = 0; pt < 4; ++pt) { const u32x4 v = F.x[pt];
        u32x4 o; o.x = pk2(bflo(v.x) * w0.x, bfhi(v.x) * w0.y); o.y = pk2(bflo(v.y) * w0.z, bfhi(v.y) * w0.w); o.z = pk2(bflo(v.z) * w1.x, bfhi(v.z) * w1.y); o.w = pk2(bflo(v.w) * w1.z, bfhi(v.w) * w1.w);
        af[pt] = __builtin_bit_cast(bf16x8, o); }
#pragma unroll
    for (int nt = 0; nt < 4; ++nt)
#pragma unroll
        for (int pt = 0; pt < 4; ++pt) acc[pt][nt] = MFMA16(af[pt], F.b[nt], acc[pt][nt]);
}
__device__ __forceinline__ void ssd_states_unit(const Args& args, LAS unsigned char* lds, int unit, int wave, int lane) {
    unsigned char* ws = args.ws;
    const int g = unit & 3, c = (unit >> 2) & 31, b = unit >> 7, h = g * 8 + wave, q = lane >> 4, r16 = lane & 15;
    LAS float* wl = (LAS float*)(lds + wave * 512);
    const float* DT = (const float*)(ws + WS_DT) + (size_t)(b * 32 + h) * 4096 + c * 128; const float* CS = (const float*)(ws + WS_CS) + (size_t)(b * 32 + h) * 4096 + c * 128;
    const float cl = CS[127];
    wl[lane] = DT[lane] * __expf(cl - CS[lane]); wl[lane + 64] = DT[lane + 64] * __expf(cl - CS[lane + 64]);
    LDS_WAIT(); asm volatile("" ::: "memory");
    const bf16* XT = (const bf16*)(ws + WS_XT) + ((size_t)(b * 32 + h) * 128 + c * 4) * 2048;
    const bf16* BT = (const bf16*)(ws + WS_BT) + ((size_t)(b * 4 + g) * 128 + c * 4) * 4096;
    float* ST = (float*)(ws + WS_STATES) + (((size_t)(b * 32 + c) * 32 + h) * 64) * 128;
    SFrag FA, FB;
    ssd_states_load(XT, BT, 0, 0, q, r16, FA);
#pragma unroll 1
    for (int nh = 0; nh < 2; ++nh) {
        f32x4 acc[4][4];
#pragma unroll
        for (int i = 0; i < 4; ++i)
#pragma unroll
            for (int j = 0; j < 4; ++j) acc[i][j] = (f32x4){0.f, 0.f, 0.f, 0.f};
        ssd_states_load(XT, BT, nh, 1, q, r16, FB); ssd_states_step(wl, 0, q, FA, acc);
        ssd_states_load(XT, BT, nh, 2, q, r16, FA); ssd_states_step(wl, 1, q, FB, acc);
        ssd_states_load(XT, BT, nh, 3, q, r16, FB); ssd_states_step(wl, 2, q, FA, acc);
        if (nh == 0) ssd_states_load(XT, BT, 1, 0, q, r16, FA);
        ssd_states_step(wl, 3, q, FB, acc);
#pragma unroll
        for (int pt = 0; pt < 4; ++pt)
#pragma unroll
            for (int nt = 0; nt < 4; ++nt)
#pragma unroll
                for (int r = 0; r < 4; ++r) ST[(size_t)(16 * pt + 4 * q + r) * 128 + 64 * nh + 16 * nt + r16] = acc[pt][nt][r];
    }
}

template <int SAMPLE>
__device__ __forceinline__ void compress2_item(const Args& args, int item, int lane) {
    unsigned char* ws = args.ws;
    const int q = lane >> 4, r16 = lane & 15;
    constexpr int NPB = SAMPLE ? 128 : 256;
    constexpr int NI = (SAMPLE ? 65536 : 4096) / 16;
    const int st = item / NI, row0 = (item % NI) * 16;
    const bf16* P = (const bf16*)(ws + (SAMPLE ? (st ? WS_PARTSV : WS_PARTSK) : (st ? WS_PARTV : WS_PARTK))) + (size_t)(row0 + r16) * 256;
    const float* pet = (const float*)(ws + WS_PET) + st * 128;
    const bf16* W2T = (const bf16*)(ws + WS_W2T) + st * 8192;
    f32x4 acc[4];
#pragma unroll
    for (int dt = 0; dt < 4; ++dt) acc[dt] = (f32x4){0.f, 0.f, 0.f, 0.f};
#pragma unroll
    for (int ks = 0; ks < 4; ++ks) {
        const int e0 = 32 * ks + 8 * q;
        const u32x4 pa = *(const u32x4*)(P + e0), pb = *(const u32x4*)(P + 256 + 128 + e0);
        const f32x4 a0 = (f32x4){bflo(pa.x), bfhi(pa.x), bflo(pa.y), bfhi(pa.y)}, a1 = (f32x4){bflo(pa.z), bfhi(pa.z), bflo(pa.w), bfhi(pa.w)};
        const f32x4 b0 = (f32x4){bflo(pb.x), bfhi(pb.x), bflo(pb.y), bfhi(pb.y)}, b1 = (f32x4){bflo(pb.z), bfhi(pb.z), bflo(pb.w), bfhi(pb.w)};
        const f32x4 p0 = *(const f32x4*)(pet + e0), p1 = *(const f32x4*)(pet + e0 + 4);
        const f32x4 h0 = a0 + b0 + p0, h1 = a1 + b1 + p1;
        u32x4 o; o.x = pk2(siluf(h0.x), siluf(h0.y)); o.y = pk2(siluf(h0.z), siluf(h0.w)); o.z = pk2(siluf(h1.x), siluf(h1.y)); o.w = pk2(siluf(h1.z), siluf(h1.w));
        const bf16x8 af = __builtin_bit_cast(bf16x8, o);
#pragma unroll
        for (int dt = 0; dt < 4; ++dt) { const bf16x8 bf = *(const bf16x8*)(W2T + (size_t)(16 * dt + r16) * 128 + e0); acc[dt] = MFMA16(af, bf, acc[dt]); }
    }
    const int bh = row0 / NPB, n0 = row0 % NPB + 4 * q;
#pragma unroll
    for (int dt = 0; dt < 4; ++dt) {
        const int d = 16 * dt + r16;
        float v[4];
#pragma unroll
        for (int r = 0; r < 4; ++r) v[r] = (n0 + r < NPB - 1) ? acc[dt][r] : 0.f;
        if (SAMPLE) {
            float* o = (float*)(ws + (st ? WS_VCS : WS_KCS)) + ((size_t)bh * 128 + n0) * 64 + d;
#pragma unroll
            for (int r = 0; r < 4; ++r) o[r * 64] = v[r];
        } else if (st == 0) {
            bf16* o = (bf16*)(ws + WS_KC) + ((size_t)bh * 256 + n0) * 64 + d;
#pragma unroll
            for (int r = 0; r < 4; ++r) o[r * 64] = (bf16)f2bf(v[r]);
        } else {
            u32x2 w; w.x = pk2(v[0], v[1]); w.y = pk2(v[2], v[3]);
            *(u32x2*)((bf16*)(ws + WS_VCT) + ((size_t)bh * 8 + (n0 >> 5)) * 2048 + d * 32 + 8 * ((n0 & 15) >> 2) + 4 * ((n0 & 31) >> 4)) = w;
        }
    }
}

__device__ __forceinline__ void sample_ssm_item(const Args& args, LAS unsigned char* lds, int item, int wave, int lane) {
    unsigned char* ws = args.ws; float* out = args.out;
    const int h = item & 31, bs = item >> 5, g = h >> 3, rs = lane >> 5, nc = lane & 31;
    const float* XC = (const float*)(ws + WS_XCS) + (size_t)bs * CONVD;
    const float dt = ((const float*)(ws + WS_DTS))[bs * 32 + h], a = -__expf(INF(19)[h]), dec = __expf(dt * a), Dh = INF(20)[h];
    const f32x4 Bv = *(const f32x4*)(XC + 2048 + g * 128 + 4 * nc) * dt, Cv = *(const f32x4*)(XC + 2560 + g * 128 + 4 * nc);
    const float xl = XC[h * 64 + lane];
    const size_t m = MP + bs;
    const float zl = bf2f(((const bf16*)(ws + WS_Z))[m * 2048 + h * 64 + lane]), nwl = INF(21)[h * 64 + lane];
    const float* H0 = INF(7) + ((size_t)(bs * 32 + h) * 64) * 128 + 4 * nc; float* HN = out + O_SSMS + ((size_t)(bs * 32 + h) * 64) * 128 + 4 * nc;
    const bool b4 = (lane & 16) != 0, b3 = (lane & 8) != 0, b2 = (lane & 4) != 0;
    float yl = 0.f;
#pragma unroll 1
    for (int bt = 0; bt < 4; ++bt) {
        f32x4 h0[8];
#pragma unroll
        for (int k = 0; k < 8; ++k) h0[k] = *(const f32x4*)(H0 + (size_t)(2 * (8 * bt + k) + rs) * 128);
        float v[8];
#pragma unroll
        for (int k = 0; k < 8; ++k) { const int p = 2 * (8 * bt + k) + rs;
            const float xp = __shfl(xl, p);
            const f32x4 hn = h0[k] * dec + Bv * xp;
            *(f32x4*)(HN + (size_t)p * 128) = hn;
            v[k] = (hn.x * Cv.x + hn.y * Cv.y) + (hn.z * Cv.z + hn.w * Cv.w); }
        float a4[4], a2[2];
#pragma unroll
        for (int i = 0; i < 4; ++i) a4[i] = (b4 ? v[4 + i] : v[i]) + __shfl_xor(b4 ? v[i] : v[4 + i], 16);
#pragma unroll
        for (int i = 0; i < 2; ++i) a2[i] = (b3 ? a4[2 + i] : a4[i]) + __shfl_xor(b3 ? a4[i] : a4[2 + i], 8);
        float c = (b2 ? a2[1] : a2[0]) + __shfl_xor(b2 ? a2[0] : a2[1], 4);
        c += __shfl_xor(c, 2); c += __shfl_xor(c, 1);
        const int pl = lane - 16 * bt;
        const int kk = (pl >> 1) & 7, src = ((pl & 1) << 5) | ((kk & 4) << 2) | ((kk & 2) << 2) | ((kk & 1) << 2);
        const float got = __shfl(c, src & 63);
        if (pl >= 0 && pl < 16) yl = got;
    }
    const float y = yl + Dh * xl;
    const float vv = y * siluf(zl);
    ((bf16*)(ws + WS_YSSM))[m * 2048 + h * 64 + lane] = (bf16)f2bf(vv * nwl);
    const float ss = wave_sum(vv * vv);
    if (lane == 0) ((float*)(ws + WS_MISC))[m * 128 + 80 + h] = ss;
}
constexpr int SC_PP = 264;
constexpr int SC_AP = 136;
__device__ __forceinline__ void sample_compress_unit(const Args& args, LAS unsigned char* lds, int unit, int tid_in, int wave, int lane_in) {
    int tid = tid_in, lane = lane_in; asm volatile("" : "+v"(tid), "+v"(lane));
    unsigned char* ws = args.ws;
    const int st = unit & 1, qd = (unit >> 1) & 3, b = unit >> 3, q = lane >> 4, r16 = lane & 15, wr = wave >> 2, wc = wave & 3;
    LAS bf16* As = (LAS bf16*)lds;
    LAS bf16* Pl = (LAS bf16*)lds;
    const bf16* W1T = (const bf16*)(ws + (st ? WS_W1V : WS_W1K));
    const int sj = tid >> 2, sc16 = tid & 3, sjj = 32 * qd + (sj >> 2), sh = sj & 3;
    const int page = ((const int*)args.in[5])[b * NPAGES + (sjj >> 3)];
    const float* asrc = INF(4) + (((size_t)page * 128 + 16 * (sjj & 7)) * 4 + st) * 256 + sh * 64 + 16 * sc16;
    LAS bf16* adst = As + sj * SC_AP + 16 * sc16;
    const bf16* bsrc = W1T + (size_t)(64 * wc + r16) * 1024 + 8 * q;
    f32x4 acc[4][4];
#pragma unroll
    for (int m = 0; m < 4; ++m)
#pragma unroll
        for (int n = 0; n < 4; ++n) acc[m][n] = (f32x4){0.f, 0.f, 0.f, 0.f};
    f32x4 ra[2][8];
#pragma unroll
    for (int c = 0; c < 8; ++c) ra[0][c] = *(const f32x4*)(asrc + (size_t)(c >> 2) * 1024 + 4 * (c & 3));
    { LAS bf16* d = adst;
#pragma unroll
      for (int h2 = 0; h2 < 2; ++h2) { u32x4 w0, w1; const int c = 4 * h2;
        w0.x = pk2c(ra[0][c].x, ra[0][c].y); w0.y = pk2c(ra[0][c].z, ra[0][c].w); w0.z = pk2c(ra[0][c + 1].x, ra[0][c + 1].y); w0.w = pk2c(ra[0][c + 1].z, ra[0][c + 1].w);
        w1.x = pk2c(ra[0][c + 2].x, ra[0][c + 2].y); w1.y = pk2c(ra[0][c + 2].z, ra[0][c + 2].w); w1.z = pk2c(ra[0][c + 3].x, ra[0][c + 3].y); w1.w = pk2c(ra[0][c + 3].z, ra[0][c + 3].w);
        *(LAS u32x4*)(d + 64 * h2) = w0; *(LAS u32x4*)(d + 64 * h2 + 8) = w1; } }
    __syncthreads();
#pragma unroll 1
    for (int s2 = 0; s2 < 8; s2 += 2) {
#pragma unroll
        for (int i = 0; i < 2; ++i) {
            const int s = s2 + i;
            bf16x8 rb[4][4];
#pragma unroll
            for (int k4 = 0; k4 < 4; ++k4)
#pragma unroll
                for (int n = 0; n < 4; ++n) rb[k4][n] = *(const bf16x8*)(bsrc + (size_t)(16 * n) * 1024 + 128 * s + 32 * k4);
            if (s + 1 < 8) {
#pragma unroll
                for (int c = 0; c < 8; ++c) ra[i ^ 1][c] = *(const f32x4*)(asrc + (size_t)(2 * (s + 1) + (c >> 2)) * 1024 + 4 * (c & 3)); }
#pragma unroll
            for (int k4 = 0; k4 < 4; ++k4) {
                bf16x8 afr[4];
#pragma unroll
                for (int m = 0; m < 4; ++m) afr[m] = *(const LAS bf16x8*)(As + i * (128 * SC_AP) + (64 * wr + 16 * m + r16) * SC_AP + 32 * k4 + 8 * q);
#pragma unroll
                for (int m = 0; m < 4; ++m)
#pragma unroll
                    for (int n = 0; n < 4; ++n) acc[m][n] = MFMA16(rb[k4][n], afr[m], acc[m][n]);
            }
            if (s + 1 < 8) { LAS bf16* d = adst + (i ^ 1) * (128 * SC_AP);
#pragma unroll
                for (int h2 = 0; h2 < 2; ++h2) { u32x4 w0, w1; const int c = 4 * h2;
                    w0.x = pk2c(ra[i ^ 1][c].x, ra[i ^ 1][c].y); w0.y = pk2c(ra[i ^ 1][c].z, ra[i ^ 1][c].w); w0.z = pk2c(ra[i ^ 1][c + 1].x, ra[i ^ 1][c + 1].y); w0.w = pk2c(ra[i ^ 1][c + 1].z, ra[i ^ 1][c + 1].w);
                    w1.x = pk2c(ra[i ^ 1][c + 2].x, ra[i ^ 1][c + 2].y); w1.y = pk2c(ra[i ^ 1][c + 2].z, ra[i ^ 1][c + 2].w); w1.z = pk2c(ra[i ^ 1][c + 3].x, ra[i ^ 1][c + 3].y); w1.w = pk2c(ra[i ^ 1][c + 3].z, ra[i ^ 1][c + 3].w);
                    *(LAS u32x4*)(d + 64 * h2) = w0; *(LAS u32x4*)(d + 64 * h2 + 8) = w1; } }
            __syncthreads();
        }
    }
#pragma unroll
    for (int m = 0; m < 4; ++m)
#pragma unroll
        for (int n = 0; n < 4; ++n) { u32x2 w; w.x = pk2(acc[m][n][0], acc[m][n][1]); w.y = pk2(acc[m][n][2], acc[m][n][3]);
            *(LAS u32x2*)(Pl + (64 * wr + 16 * m + r16) * SC_PP + 64 * wc + 16 * n + 4 * q) = w; }
    __syncthreads();
    {
        const float* pet = (const float*)(ws + WS_PET) + st * 128;
        const bf16* W2T = (const bf16*)(ws + WS_W2T) + st * 8192;
        const int nrow = 16 * wave + r16;
        f32x4 o[4];
#pragma unroll
        for (int dt = 0; dt < 4; ++dt) o[dt] = (f32x4){0.f, 0.f, 0.f, 0.f};
#pragma unroll
        for (int ks = 0; ks < 4; ++ks) {
            const int e0 = 32 * ks + 8 * q;
            const u32x4 pa = *(const LAS u32x4*)(Pl + nrow * SC_PP + e0), pb = *(const LAS u32x4*)(Pl + (nrow < 124 ? nrow + 4 : nrow) * SC_PP + 128 + e0);
            const f32x4 p0 = *(const f32x4*)(pet + e0), p1 = *(const f32x4*)(pet + e0 + 4);
            const f32x4 h0 = (f32x4){bflo(pa.x) + bflo(pb.x), bfhi(pa.x) + bfhi(pb.x), bflo(pa.y) + bflo(pb.y), bfhi(pa.y) + bfhi(pb.y)} + p0;
            const f32x4 h1 = (f32x4){bflo(pa.z) + bflo(pb.z), bfhi(pa.z) + bfhi(pb.z), bflo(pa.w) + bflo(pb.w), bfhi(pa.w) + bfhi(pb.w)} + p1;
            u32x4 w; w.x = pk2(siluf(h0.x), siluf(h0.y)); w.y = pk2(siluf(h0.z), siluf(h0.w)); w.z = pk2(siluf(h1.x), siluf(h1.y)); w.w = pk2(siluf(h1.z), siluf(h1.w));
            const bf16x8 af = __builtin_bit_cast(bf16x8, w);
#pragma unroll
            for (int dt = 0; dt < 4; ++dt) { const bf16x8 bf = *(const bf16x8*)(W2T + (size_t)(16 * dt + r16) * 128 + e0); o[dt] = MFMA16(af, bf, o[dt]); }
        }
        const int jj = 4 * wave + q, n = 32 * qd + jj;
        if (jj < 31) {
#pragma unroll
            for (int r = 0; r < 4; ++r) { float* dst = (float*)(ws + (st ? WS_VCS : WS_KCS)) + ((size_t)(b * 4 + r) * 128 + n) * 64;
#pragma unroll
                for (int dt = 0; dt < 4; ++dt) dst[16 * dt + r16] = o[dt][r]; }
        }
        if (tid < 256) { const int hh = tid >> 6, which = (tid >> 5) & 1, c4 = (tid & 31) * 4;
            const u32x2 v = *(const LAS u32x2*)(Pl + (which ? hh : 124 + hh) * SC_PP + which * 128 + c4);
            *(u32x2*)((bf16*)(ws + WS_PARTB) + ((((size_t)(st * 128 + b) * 4 + hh) * 4 + qd) * 2 + which) * 128 + c4) = v; }
        if (qd == 3 && tid < 256) { const int hh = tid >> 6; ((float*)(ws + (st ? WS_VCS : WS_KCS)))[((size_t)(b * 4 + hh) * 128 + 127) * 64 + (tid & 63)] = 0.f; }
    }
    __syncthreads();
}

__device__ __forceinline__ void compress_fixup_item(const Args& args, int item, int lane) {
    unsigned char* ws = args.ws;
    const int qd = item % 3, hh = (item / 3) & 3, b = (item / 12) & 127, st = item / (12 * 128);
    const bf16* PB = (const bf16*)(ws + WS_PARTB) + (((size_t)(st * 128 + b) * 4 + hh) * 4) * 2 * 128;
    const float* pet = (const float*)(ws + WS_PET) + st * 128; const float* w2 = INF(st ? 27 : 24);
    const float a0 = siluf(pet[lane] + bf2f(PB[(qd * 2 + 0) * 128 + lane]) + bf2f(PB[((qd + 1) * 2 + 1) * 128 + lane]));
    const float a1 = siluf(pet[64 + lane] + bf2f(PB[(qd * 2 + 0) * 128 + 64 + lane]) + bf2f(PB[((qd + 1) * 2 + 1) * 128 + 64 + lane]));
    float o = 0.f;
#pragma unroll 8
    for (int e = 0; e < 64; ++e) o += __shfl(a0, e) * w2[e * 64 + lane];
#pragma unroll 8
    for (int e = 0; e < 64; ++e) o += __shfl(a1, e) * w2[(64 + e) * 64 + lane];
    ((float*)(ws + (st ? WS_VCS : WS_KCS)))[((size_t)(b * 4 + hh) * 128 + 32 * qd + 31) * 64 + lane] = o;
}
#ifdef SELFCHECK
__device__ __forceinline__ void check_sample_compress(const Args& args, LAS unsigned char* lds, int bid, int tid) {
    unsigned char* ws = args.ws;
    const int st = bid & 1, bh = (bid * 37) % 512, n = (bid & 3) == 3 ? 32 * ((bid >> 2) % 3) + 31 : (bid * 11) % 127, b = bh >> 2, h = bh & 3;
    LAS float* hid = (LAS float*)lds;
    __syncthreads();
    if (tid < 128) {
        const float* pe = INF(st ? 25 : 22); const float* w1 = INF(st ? 26 : 23);
        float a = 0.f;
        for (int l = 0; l < 32; ++l) { const int t = 16 * n + l; const int page = ((const int*)args.in[5])[b * NPAGES + (t >> 7)];
            const float* row = INF(4) + (((size_t)page * 128 + (t & 127)) * 4 + st) * 256 + h * 64;
            for (int d = 0; d < 64; ++d) a += (row[d] + 0.f) * w1[((size_t)l * 64 + d) * 128 + tid] + pe[l * 64 + d] * w1[((size_t)l * 64 + d) * 128 + tid]; }
        hid[tid] = a / (1.f + __expf(-a));
    }
    __syncthreads();
    if (tid < 64) { const float* w2 = INF(st ? 27 : 24); float o = 0.f;
        for (int e = 0; e < 128; ++e) o += hid[e] * w2[e * 64 + tid];
        const float got = ((const float*)(ws + (st ? WS_VCS : WS_KCS)))[((size_t)bh * 128 + n) * 64 + tid];
        if (!(fabsf(got - o) <= 0.03f + 0.03f * fabsf(o))) atomicAdd((unsigned*)(ws + WS_CTL) + 8, 1u); }
    __syncthreads();
}
#endif
__device__ __forceinline__ void scan_phase(const Args& args, int gt, int NGT) {
    unsigned char* ws = args.ws; float* out = args.out;
    constexpr int NITEM = 4 * 32 * 64 * 32;
    for (int i0 = gt; i0 < NITEM; i0 += 2 * NGT) {
        const int i1 = i0 + NGT; const bool two = i1 < NITEM;
        const int ia[2] = {i0, two ? i1 : i0};
        size_t base[2]; const float* CSp[2]; f32x4 run[2];
#pragma unroll
        for (int k = 0; k < 2; ++k) { const int i = ia[k]; const int n4 = i & 31, p = (i >> 5) & 63, h = (i >> 11) & 31, b = i >> 16;
            base[k] = (((size_t)(b * 32) * 32 + h) * 64 + p) * 128 + 4 * n4; CSp[k] = (const float*)(ws + WS_CS) + (size_t)(b * 32 + h) * 4096; run[k] = (f32x4){0.f, 0.f, 0.f, 0.f}; }
#pragma unroll 1
        for (int c0 = 0; c0 < 32; c0 += 8) {
            f32x4 st[2][8]; float dec[2][8];
#pragma unroll
            for (int k = 0; k < 2; ++k)
#pragma unroll
                for (int j = 0; j < 8; ++j) { st[k][j] = *(const f32x4*)((const float*)(ws + WS_STATES) + base[k] + (size_t)(c0 + j) * (32 * 64 * 128)); dec[k][j] = CSp[k][(c0 + j) * 128 + 127]; }
#pragma unroll
            for (int j = 0; j < 8; ++j)
#pragma unroll
                for (int k = 0; k < 2; ++k) {
                    u32x2 o; o.x = pk2(run[k].x, run[k].y); o.y = pk2(run[k].z, run[k].w);
                    if (k == 0 || two) *(u32x2*)((bf16*)(ws + WS_HPREV) + base[k] + (size_t)(c0 + j) * (32 * 64 * 128)) = o;
                    run[k] = run[k] * __expf(dec[k][j]) + st[k][j];
                }
        }
#pragma unroll
        for (int k = 0; k < 2; ++k) if (k == 0 || two) { const int i = ia[k]; const int n4 = i & 31, p = (i >> 5) & 63, h = (i >> 11) & 31, b = i >> 16;
            *(f32x4*)(out + O_SSMP + (((size_t)(b * 32 + h) * 64 + p) * 128) + 4 * n4) = run[k]; }
    }
    for (int i = gt; i < MS * 4; i += NGT) { const int bs = i >> 2, g = i & 3; const float* p = (const float*)(ws + WS_MISC) + (size_t)(MP + bs) * 128 + 80 + g * 8;
        ((float*)(ws + WS_SSQ))[(size_t)(MP + bs) * 4 + g] = ((p[0] + p[1]) + (p[2] + p[3])) + ((p[4] + p[5]) + (p[6] + p[7])); }
}

constexpr int CNL_PITCH = 136;
struct DFrag { bf16x8 x[4]; f32x4 csa, csb, dta, dtb; };
__device__ __forceinline__ void ssd_out_load(const bf16* XT, const float* CS, const float* DT, int i, int q, int r16, DFrag& F) {
    const int sa = 32 * i + 4 * q, sb = sa + 16;
    F.csa = *(const f32x4*)(CS + sa); F.csb = *(const f32x4*)(CS + sb); F.dta = *(const f32x4*)(DT + sa); F.dtb = *(const f32x4*)(DT + sb);
#pragma unroll
    for (int pt = 0; pt < 4; ++pt) { const bf16* xr = XT + (size_t)i * 2048 + (16 * pt + r16) * 32 + 4 * q; const u32x2 lo = *(const u32x2*)xr, hi = *(const u32x2*)(xr + 16);
        F.x[pt] = __builtin_bit_cast(bf16x8, (u32x4){lo.x, lo.y, hi.x, hi.y}); }
}
template <int HL, int I>
__device__ __forceinline__ void ssd_out_diag(const LAS float* CBT, const DFrag& F, const float (&csl)[4], float Dh, int q, int r16, int lane, f32x4 (&acc)[4][4]) {
    const int sa = 32 * I + 4 * q, sb = sa + 16;
#pragma unroll
    for (int lt = 0; lt < 4; ++lt) {
        constexpr int dummy = 0; (void)dummy;
        const int LT = 4 * HL + lt;
        if (LT < 2 * I) continue;
        const int l = 16 * LT + r16;
        float ga[4], gb[4];
#pragma unroll
        for (int r = 0; r < 4; ++r) {
            const float va = CBT[(((2 * I) * 8 + LT) * 4 + r) * 64 + lane];
            const float vb = (LT >= 2 * I + 1) ? CBT[(((2 * I + 1) * 8 + LT) * 4 + r) * 64 + lane] : 0.f;
            const int s1 = sa + r, s2 = sb + r;
            float x1 = (l >= s1) ? va * __expf(csl[lt] - F.csa[r]) * F.dta[r] : 0.f;
            float x2 = (l >= s2) ? vb * __expf(csl[lt] - F.csb[r]) * F.dtb[r] : 0.f;
            if (l == s1) x1 += Dh;
            if (l == s2) x2 += Dh;
            ga[r] = x1; gb[r] = x2;
        }
        u32x4 o; o.x = pk2(ga[0], ga[1]); o.y = pk2(ga[2], ga[3]); o.z = pk2(gb[0], gb[1]); o.w = pk2(gb[2], gb[3]);
        const bf16x8 bf = __builtin_bit_cast(bf16x8, o);
#pragma unroll
        for (int pt = 0; pt < 4; ++pt) acc[pt][lt] = MFMA16(F.x[pt], bf, acc[pt][lt]);
    }
}
template <int HL>
__device__ __forceinline__ void ssd_out_half(const Args& args, const LAS float* CBT, const LAS bf16* CnL, LAS float* SQ, const bf16x8 (&hp)[16], const bf16* XT, const float* CS, const float* DT,
                                             float Dh, int b, int c, int h, int wave, int q, int r16, int lane) {
    unsigned char* ws = args.ws;
    float csl[4];
#pragma unroll
    for (int lt = 0; lt < 4; ++lt) csl[lt] = CS[64 * HL + 16 * lt + r16];
    DFrag FA, FB;
    ssd_out_load(XT, CS, DT, 0, q, r16, FA);
    f32x4 acc[4][4];
#pragma unroll
    for (int i = 0; i < 4; ++i)
#pragma unroll
        for (int j = 0; j < 4; ++j) acc[i][j] = (f32x4){0.f, 0.f, 0.f, 0.f};
#pragma unroll
    for (int ks = 0; ks < 4; ++ks)
#pragma unroll
        for (int lt = 0; lt < 4; ++lt) { const bf16x8 bf = *(const LAS bf16x8*)(CnL + (64 * HL + 16 * lt + r16) * CNL_PITCH + 32 * ks + 8 * q);
#pragma unroll
            for (int pt = 0; pt < 4; ++pt) acc[pt][lt] = MFMA16(hp[ks * 4 + pt], bf, acc[pt][lt]); }
#pragma unroll
    for (int lt = 0; lt < 4; ++lt) { const float e = __expf(csl[lt]);
#pragma unroll
        for (int pt = 0; pt < 4; ++pt) acc[pt][lt] = acc[pt][lt] * e; }
    ssd_out_load(XT, CS, DT, 1, q, r16, FB);
    ssd_out_diag<HL, 0>(CBT, FA, csl, Dh, q, r16, lane, acc);
    if (HL == 1) ssd_out_load(XT, CS, DT, 2, q, r16, FA);
    ssd_out_diag<HL, 1>(CBT, FB, csl, Dh, q, r16, lane, acc);
    if (HL == 1) {
        ssd_out_load(XT, CS, DT, 3, q, r16, FB);
        ssd_out_diag<HL, 2>(CBT, FA, csl, Dh, q, r16, lane, acc);
        ssd_out_diag<HL, 3>(CBT, FB, csl, Dh, q, r16, lane, acc);
    }
    const bf16* Z = (const bf16*)(ws + WS_Z); bf16* Y = (bf16*)(ws + WS_YSSM); const float* nw = INF(21) + h * 64;
    u32x2 zz[4][4];
#pragma unroll
    for (int lt = 0; lt < 4; ++lt)
#pragma unroll
        for (int pt = 0; pt < 4; ++pt) zz[lt][pt] = *(const u32x2*)(Z + ((size_t)b * 4096 + c * 128 + 64 * HL + 16 * lt + r16) * 2048 + h * 64 + 16 * pt + 4 * q);
#pragma unroll
    for (int lt = 0; lt < 4; ++lt) {
        const size_t m = (size_t)b * 4096 + c * 128 + 64 * HL + 16 * lt + r16;
        float ss = 0.f;
#pragma unroll
        for (int pt = 0; pt < 4; ++pt) {
            const int ch = 16 * pt + 4 * q;
            const f32x4 w = *(const f32x4*)(nw + ch);
            const float v0 = acc[pt][lt][0] * siluf(bflo(zz[lt][pt].x)), v1 = acc[pt][lt][1] * siluf(bfhi(zz[lt][pt].x)), v2 = acc[pt][lt][2] * siluf(bflo(zz[lt][pt].y)), v3 = acc[pt][lt][3] * siluf(bfhi(zz[lt][pt].y));
            ss += (v0 * v0 + v1 * v1) + (v2 * v2 + v3 * v3);
            u32x2 o; o.x = pk2(v0 * w.x, v1 * w.y); o.y = pk2(v2 * w.z, v3 * w.w);
            *(u32x2*)(Y + m * 2048 + h * 64 + ch) = o;
        }
        ss += __shfl_xor(ss, 16); ss += __shfl_xor(ss, 32);
        if (q == 0) SQ[wave * 128 + 64 * HL + 16 * lt + r16] = ss;
    }
}
__device__ __forceinline__ void ssd_out_unit(const Args& args, LAS unsigned char* lds, int unit, int wave, int lane_in, int tid) {
    int lane = lane_in; asm volatile("" : "+v"(lane));
    unsigned char* ws = args.ws;
    const int g = unit & 3, c = (unit >> 2) & 31, b = unit >> 7, h = g * 8 + wave, q = lane >> 4, r16 = lane & 15;
    LAS float* CBT = (LAS float*)lds; LAS bf16* CnL = (LAS bf16*)(lds + 65536); LAS float* SQ = (LAS float*)(lds + 65536 + 128 * CNL_PITCH * 2);
    const bf16* Bn = (const bf16*)(ws + WS_BN) + ((size_t)(b * 4 + g) * 4096 + c * 128) * 128;
    const bf16* Cn = (const bf16*)(ws + WS_CN) + ((size_t)(b * 4 + g) * 4096 + c * 128) * 128;
    {
        u32x4 cv[4];
#pragma unroll
        for (int i = 0; i < 4; ++i) cv[i] = *(const u32x4*)(Cn + (size_t)(wave * 64 + lane + 512 * i) * 8);
        bf16x8 bnf[4], hp[16];
#pragma unroll
        for (int ks = 0; ks < 4; ++ks) bnf[ks] = *(const bf16x8*)(Bn + (size_t)(16 * wave + r16) * 128 + 32 * ks + 8 * q);
        const bf16* HP = (const bf16*)(ws + WS_HPREV) + (((size_t)(b * 32 + c) * 32 + h) * 64) * 128;
#pragma unroll
        for (int ks = 0; ks < 4; ++ks)
#pragma unroll
            for (int pt = 0; pt < 4; ++pt) hp[ks * 4 + pt] = *(const bf16x8*)(HP + (size_t)(16 * pt + r16) * 128 + 32 * ks + 8 * q);
#pragma unroll
        for (int i = 0; i < 4; ++i) { const int id = wave * 64 + lane + 512 * i; *(LAS u32x4*)(CnL + (id >> 4) * CNL_PITCH + (id & 15) * 8) = cv[i]; }
        __syncthreads();
        for (int lt = wave; lt < 8; ++lt) {
            f32x4 d = (f32x4){0.f, 0.f, 0.f, 0.f};
#pragma unroll
            for (int ks = 0; ks < 4; ++ks) { const bf16x8 bf = *(const LAS bf16x8*)(CnL + (16 * lt + r16) * CNL_PITCH + 32 * ks + 8 * q); d = MFMA16(bnf[ks], bf, d); }
#pragma unroll
            for (int r = 0; r < 4; ++r) CBT[((wave * 8 + lt) * 4 + r) * 64 + lane] = d[r];
        }
        __syncthreads();
        const float* DT = (const float*)(ws + WS_DT) + (size_t)(b * 32 + h) * 4096 + c * 128; const float* CS = (const float*)(ws + WS_CS) + (size_t)(b * 32 + h) * 4096 + c * 128;
        const float Dh = INF(20)[h];
        const bf16* XT = (const bf16*)(ws + WS_XT) + ((size_t)(b * 32 + h) * 128 + c * 4) * 2048;
        ssd_out_half<0>(args, CBT, CnL, SQ, hp, XT, CS, DT, Dh, b, c, h, wave, q, r16, lane);
        ssd_out_half<1>(args, CBT, CnL, SQ, hp, XT, CS, DT, Dh, b, c, h, wave, q, r16, lane);
    }
    __syncthreads();
    if (tid < 128) { float s = 0.f;
#pragma unroll
        for (int w = 0; w < 8; ++w) s += SQ[w * 128 + tid];
        ((float*)(ws + WS_SSQ))[((size_t)b * 4096 + c * 128 + tid) * 4 + g] = s; }
    __syncthreads();
}
constexpr float SC2 = 0.125f * 1.4426950408889634f;
__device__ __forceinline__ float max3f(float a, float b, float c) { float r; asm("v_max3_f32 %0, %1, %2, %3" : "=v"(r) : "v"(a), "v"(b), "v"(c)); return r; }
template <class T> __device__ __forceinline__ T ldu(const void* ubase, unsigned lane_off) { return *(const T*)((const char*)ubase + lane_off); }
struct KFrag { bf16x8 kf[2][2]; };
__device__ __forceinline__ void flash_load(const bf16* Kp, int kb, unsigned koff, KFrag& F) {
#pragma unroll
    for (int kt = 0; kt < 2; ++kt) { const bf16* kr = Kp + (size_t)(kb + 16 * kt) * 64; F.kf[kt][0] = ldu<bf16x8>(kr, koff); F.kf[kt][1] = ldu<bf16x8>(kr + 32, koff); }
}
template <int MODE>
__device__ __forceinline__ void flash_step(const KFrag& F, const bf16* VTp, unsigned voff, int kb, int t0, int t, bool selbit, const LAS bf16x8* Qs,
                                           f32x4 (&O)[4][4], float (&mx)[4], f32x4 (&L)[4], int q) {
    const bf16x8 ones = __builtin_bit_cast(bf16x8, (u32x4){0x3f803f80u, 0x3f803f80u, 0x3f803f80u, 0x3f803f80u});
    const bool edge = (kb + 31 > t0) || (MODE == 1 && kb + 512 <= t0 + 15);
    bf16x8 vf[4];
#pragma unroll
    for (int dt = 0; dt < 4; ++dt) vf[dt] = ldu<bf16x8>(VTp + (size_t)(kb >> 5) * 2048 + (16 * dt) * 32, voff);
#pragma unroll
    for (int g = 0; g < 4; ++g) {
        asm volatile("" ::: "memory");
        __builtin_amdgcn_sched_barrier(0);
        const bf16x8 q0 = Qs[(g * 2 + 0) * 64], q1 = Qs[(g * 2 + 1) * 64];
        f32x4 S0 = MFMA16(F.kf[0][0], q0, ((f32x4){0.f, 0.f, 0.f, 0.f})), S1 = MFMA16(F.kf[1][0], q0, ((f32x4){0.f, 0.f, 0.f, 0.f}));
        S0 = MFMA16(F.kf[0][1], q1, S0); S1 = MFMA16(F.kf[1][1], q1, S1);
        float s[8];
#pragma unroll
        for (int r = 0; r < 4; ++r) { s[r] = S0[r]; s[4 + r] = S1[r]; }
        if (edge) {
#pragma unroll
            for (int i = 0; i < 8; ++i) { const int key = kb + 16 * (i >> 2) + 4 * q + (i & 3);
                const bool ok = (MODE == 0) ? (key <= t) : (key <= t && key + 512 > t); s[i] = ok ? s[i] : NEGF; }
        }
        float lm = max3f(max3f(s[0], s[1], s[2]), max3f(s[3], s[4], s[5]), fmaxf(s[6], s[7])) * SC2;
        if (MODE == 0) lm = selbit ? lm : NEGF;
        if (__builtin_amdgcn_ballot_w64(lm > mx[g] + 8.f) != 0ull) {
            float tmax = fmaxf(lm, __shfl_xor(lm, 16)); tmax = fmaxf(tmax, __shfl_xor(tmax, 32));
            const float mnew = fmaxf(mx[g], tmax), alpha = __builtin_amdgcn_exp2f(mx[g] - mnew); mx[g] = mnew; L[g] = L[g] * alpha;
#pragma unroll
            for (int dt = 0; dt < 4; ++dt) O[dt][g] = O[dt][g] * alpha;
        }
        float nmuse = -fmaxf(mx[g], -1e20f);
        if (MODE == 0) nmuse = selbit ? nmuse : NEGF;
#pragma unroll
        for (int i = 0; i < 8; ++i) s[i] = __builtin_amdgcn_exp2f(__builtin_fmaf(s[i], SC2, nmuse));
        u32x4 pw; pw.x = pk2(s[0], s[1]); pw.y = pk2(s[2], s[3]); pw.z = pk2(s[4], s[5]); pw.w = pk2(s[6], s[7]);
        const bf16x8 pf = __builtin_bit_cast(bf16x8, pw);
        L[g] = MFMA16(ones, pf, L[g]);
#pragma unroll
        for (int dt = 0; dt < 4; ++dt) O[dt][g] = MFMA16(vf[dt], pf, O[dt][g]);
    }
}
template <int MODE>
__device__ __forceinline__ void flash_branch(const bf16* Kp, const bf16* VTp, int jfirst, int jlast, unsigned ulo, unsigned uhi, unsigned mlo, unsigned mhi,
                                             int t0, int t, const LAS bf16x8* Qs, f32x4 (&O)[4][4], float (&mx)[4], f32x4 (&L)[4], int q, int r16) {
    const unsigned koff = (unsigned)(r16 * 64 + 8 * q) * 2u, voff = (unsigned)(r16 * 32 + 8 * q) * 2u;
    int jb = jfirst;
    while (jb <= jlast && !((jb < 32 ? (ulo >> jb) : (uhi >> (jb - 32))) & 1u)) ++jb;
    if (jb > jlast) return;
    KFrag A, B;
    flash_load(Kp, 64 * jb, koff, A);
    for (;;) {
        flash_load(Kp, 64 * jb + 32, koff, B);
        const bool selbit = ((jb < 32 ? (mlo >> jb) : (mhi >> (jb - 32))) & 1u) != 0u;
        flash_step<MODE>(A, VTp, voff, 64 * jb, t0, t, selbit, Qs, O, mx, L, q);
        int jn = jb + 1;
        while (jn <= jlast && !((jn < 32 ? (ulo >> jn) : (uhi >> (jn - 32))) & 1u)) ++jn;
        if (jn <= jlast) flash_load(Kp, 64 * jn, koff, A);
        flash_step<MODE>(B, VTp, voff, 64 * jb + 32, t0, t, selbit, Qs, O, mx, L, q);
        if (jn > jlast) break;
        jb = jn;
    }
}

template <int BR>
__device__ __forceinline__ void attn_finish(const Args& args, f32x4 (&O)[4][4], const f32x4 (&L)[4], bool normalise, size_t m, int hkv, int q) {
    unsigned char* ws = args.ws;
    const float* gates = (const float*)(ws + WS_MISC) + m * 128 + 32;
    const unsigned yoff = (unsigned)((m & 15) * 1024 + 4 * q) * 4u, yboff = yoff >> 1;
#pragma unroll
    for (int g = 0; g < 4; ++g) {
        float sc = sigmf(gates[(hkv * 4 + g) * 3 + BR]);
        if (normalise) sc *= 1.f / fmaxf(L[g][0], TINYF);
#pragma unroll
        for (int dt = 0; dt < 4; ++dt) {
            char* yfu = (char*)((float*)(ws + WS_YATTF) + (m & ~(size_t)15) * 1024 + (hkv * 4 + g) * 64 + 16 * dt);
            f32x4 v = O[dt][g] * sc;
            if (BR > 0) v = v + *(const f32x4*)(yfu + yoff);
            if (BR < 2) *(f32x4*)(yfu + yoff) = v;
            else { u32x2 o; o.x = pk2(v.x, v.y); o.y = pk2(v.z, v.w); *(u32x2*)((char*)((bf16*)(ws + WS_YATT) + (m & ~(size_t)15) * 1024 + (hkv * 4 + g) * 64 + 16 * dt) + yboff) = o; }
        }
    }
}

__device__ __forceinline__ void cmp_pass1_tile(const bf16x8& k0, const bf16x8& k1, int kt, const LAS bf16x8* Qs, int t, int q, float (&mx)[4], float (&ls)[4]) {
#pragma unroll
    for (int g = 0; g < 4; ++g) {
        f32x4 s = MFMA16(k0, Qs[(g * 2 + 0) * 64], ((f32x4){0.f, 0.f, 0.f, 0.f})); s = MFMA16(k1, Qs[(g * 2 + 1) * 64], s);
        float tmax = NEGF;
#pragma unroll
        for (int r = 0; r < 4; ++r) { const int n = 16 * kt + 4 * q + r; const bool ok = (16 * n + 31 <= t); s[r] = ok ? s[r] * 0.125f : NEGF; tmax = fmaxf(tmax, s[r]); }
        const float mnew = fmaxf(mx[g], tmax); float ps = 0.f;
#pragma unroll
        for (int r = 0; r < 4; ++r) ps += (s[r] > 0.5f * NEGF) ? __expf(s[r] - mnew) : 0.f;
        ls[g] = ls[g] * __expf(mx[g] - mnew) + ps; mx[g] = mnew;
    }
}
__device__ __forceinline__ void attn_prompt_unit(const Args& args, LAS float* impL, int unit, bool xcdmap, int lane_in) {
    int lane = lane_in; asm volatile("" : "+v"(lane));
    unsigned char* ws = args.ws;
    const int q = lane >> 4, r16 = lane & 15;
    const int pass = unit >> 11, gwv = unit & 2047, xcd = (gwv >> 3) & 7, wx = (gwv >> 6) * 8 + (gwv & 7);
    const int bh = xcdmap ? 2 * xcd + pass : (unit & 15), b = bh >> 2, hkv = bh & 3;
    const int tile = xcdmap ? (pass == 0 ? 255 - wx : wx) : (unit < 2048 ? 255 - (unit >> 4) : (unit - 2048) >> 4);
    const int t0 = tile * 16, t = t0 + r16; const size_t m = (size_t)b * 4096 + t;
    LAS bf16x8* Qs = (LAS bf16x8*)(impL + 1024) + lane;
#pragma unroll
    for (int g = 0; g < 4; ++g)
#pragma unroll
        for (int ks = 0; ks < 2; ++ks) Qs[(g * 2 + ks) * 64] = ldu<bf16x8>((const bf16*)(ws + WS_Q) + ((size_t)b * 4096 + t0) * 1024 + (hkv * 4 + g) * 64 + 32 * ks, (unsigned)(r16 * 1024 + 8 * q) * 2u);
    LDS_WAIT(); asm volatile("" ::: "memory");
    f32x4 O[4][4]; float mx[4], ls[4];
    const bf16* KCp = (const bf16*)(ws + WS_KC) + (size_t)bh * 256 * 64; const bf16* VCTp = (const bf16*)(ws + WS_VCT) + (size_t)bh * 64 * 256;
    const unsigned kcoff = (unsigned)(r16 * 64 + 8 * q) * 2u, vcoff = (unsigned)(r16 * 32 + 8 * q) * 2u;
    const int nmax = (t0 + 15 >= 31) ? ((t0 + 15 - 31) >> 4) : -1;
    const int NP = nmax < 0 ? 0 : (nmax / 32 + 2 < 8 ? nmax / 32 + 2 : 8);
#pragma unroll
    for (int g = 0; g < 4; ++g) { mx[g] = NEGF; ls[g] = 0.f; }
    {
        bf16x8 ka0, ka1, kb0, kb1;
        if (NP > 0) { ka0 = ldu<bf16x8>(KCp, kcoff); ka1 = ldu<bf16x8>(KCp + 32, kcoff); }
#pragma unroll 1
        for (int kt = 0; kt < 2 * NP; kt += 2) {
            { const bf16* kr = KCp + (size_t)(16 * (kt + 1)) * 64; kb0 = ldu<bf16x8>(kr, kcoff); kb1 = ldu<bf16x8>(kr + 32, kcoff); }
            cmp_pass1_tile(ka0, ka1, kt, Qs, t, q, mx, ls);
            if (kt + 2 < 2 * NP) { const bf16* kr = KCp + (size_t)(16 * (kt + 2)) * 64; ka0 = ldu<bf16x8>(kr, kcoff); ka1 = ldu<bf16x8>(kr + 32, kcoff); }
            cmp_pass1_tile(kb0, kb1, kt + 1, Qs, t, q, mx, ls);
        }
    }
    float invL[4];
#pragma unroll
    for (int g = 0; g < 4; ++g) {
        float M = fmaxf(mx[g], __shfl_xor(mx[g], 16)); M = fmaxf(M, __shfl_xor(M, 32));
        float l = ls[g] * __expf(mx[g] - M); l += __shfl_xor(l, 16); l += __shfl_xor(l, 32);
        mx[g] = M; invL[g] = 1.f / fmaxf(l, TINYF);
    }
#pragma unroll
    for (int dt = 0; dt < 4; ++dt)
#pragma unroll
        for (int g = 0; g < 4; ++g) O[dt][g] = (f32x4){0.f, 0.f, 0.f, 0.f};
    float prev3 = 0.f;
#pragma unroll
    for (int kt = 0; kt < 16; ++kt) impL[kt * 64 + lane] = 0.f;
    bf16x8 kc[2][2], vcf[4];
    if (NP > 0) {
#pragma unroll
        for (int kk = 0; kk < 2; ++kk) { const bf16* kr = KCp + (size_t)(16 * kk) * 64; kc[kk][0] = ldu<bf16x8>(kr, kcoff); kc[kk][1] = ldu<bf16x8>(kr + 32, kcoff); }
#pragma unroll
        for (int dt = 0; dt < 4; ++dt) vcf[dt] = ldu<bf16x8>(VCTp + (16 * dt) * 32, vcoff);
    }
#pragma unroll 1
    for (int i = 0; i < NP; ++i) {
        bf16x8 kn[2][2], vn[4];
        if (i + 1 < NP) {
#pragma unroll
            for (int kk = 0; kk < 2; ++kk) { const bf16* kr = KCp + (size_t)(16 * (2 * i + 2 + kk)) * 64; kn[kk][0] = ldu<bf16x8>(kr, kcoff); kn[kk][1] = ldu<bf16x8>(kr + 32, kcoff); }
#pragma unroll
            for (int dt = 0; dt < 4; ++dt) vn[dt] = ldu<bf16x8>(VCTp + (size_t)(i + 1) * 2048 + (16 * dt) * 32, vcoff);
        }
        f32x4 P[2][4];
#pragma unroll
        for (int kk = 0; kk < 2; ++kk) {
            const int kt = 2 * i + kk;
            const bf16x8 k0 = kc[kk][0], k1 = kc[kk][1];
            f32x4 psum = (f32x4){0.f, 0.f, 0.f, 0.f};
#pragma unroll
            for (int g = 0; g < 4; ++g) {
                f32x4 s = MFMA16(k0, Qs[(g * 2 + 0) * 64], ((f32x4){0.f, 0.f, 0.f, 0.f})); s = MFMA16(k1, Qs[(g * 2 + 1) * 64], s);
#pragma unroll
                for (int r = 0; r < 4; ++r) { const int n = 16 * kt + 4 * q + r; const bool ok = (16 * n + 31 <= t); s[r] = ok ? __expf(s[r] * 0.125f - mx[g]) * invL[g] : 0.f; }
                P[kk][g] = s; psum = psum + s;
            }
            const float a = __shfl(psum[3], (lane + 48) & 63), bb = __shfl(prev3, (lane + 48) & 63);
            impL[kt * 64 + lane] = 2.f * (psum[0] + psum[1] + psum[2]) + psum[3] + (q > 0 ? a : bb);
            prev3 = psum[3];
        }
#pragma unroll
        for (int g = 0; g < 4; ++g) {
            u32x4 pw; pw.x = pk2(P[0][g][0], P[0][g][1]); pw.y = pk2(P[0][g][2], P[0][g][3]); pw.z = pk2(P[1][g][0], P[1][g][1]); pw.w = pk2(P[1][g][2], P[1][g][3]);
            const bf16x8 pf = __builtin_bit_cast(bf16x8, pw);
#pragma unroll
            for (int dt = 0; dt < 4; ++dt) O[dt][g] = MFMA16(vcf[dt], pf, O[dt][g]);
        }
        if (i + 1 < NP) {
#pragma unroll
            for (int kk = 0; kk < 2; ++kk) { kc[kk][0] = kn[kk][0]; kc[kk][1] = kn[kk][1]; }
#pragma unroll
            for (int dt = 0; dt < 4; ++dt) vcf[dt] = vn[dt];
        }
    }
    f32x4 L[4];
#pragma unroll
    for (int g = 0; g < 4; ++g) L[g] = (f32x4){1.f, 1.f, 1.f, 1.f};
    attn_finish<0>(args, O, L, false, m, hkv, q);
    unsigned mlo = 0u, mhi = 0u;
    {
        const int cur = t >> 6;
        LDS_WAIT(); asm volatile("" ::: "memory");
        unsigned key[16];
#pragma unroll
        for (int kt = 0; kt < 16; ++kt) { const int j = 4 * kt + q; const bool valid = (64 * j <= t), forced = (j == 0) || (j == cur) || (j == cur - 1);
            const float val = valid ? (forced ? BIGF : impL[kt * 64 + lane]) : -BIGF; const unsigned u = __builtin_bit_cast(unsigned, val);
            key[kt] = (u & 0x80000000u) ? ~u : (u | 0x80000000u); }
        unsigned T = 0u;
#pragma unroll 1
        for (int bit = 31; bit >= 0; --bit) {
            const unsigned cand = T | (1u << bit);
            int cnt = 0;
#pragma unroll
            for (int kt = 0; kt < 16; ++kt) cnt += key[kt] >= cand ? 1 : 0;
            cnt += __shfl_xor(cnt, 16); cnt += __shfl_xor(cnt, 32);
            T = cnt >= 16 ? cand : T;
        }
        int cgt = 0;
#pragma unroll
        for (int kt = 0; kt < 16; ++kt) cgt += key[kt] > T ? 1 : 0;
        cgt += __shfl_xor(cgt, 16); cgt += __shfl_xor(cgt, 32);
        const int need = 16 - cgt;
        unsigned elo = 0u, ehi = 0u;
#pragma unroll
        for (int kt = 0; kt < 16; ++kt) { const int j = 4 * kt + q; const unsigned bit = key[kt] == T ? 1u : 0u; if (kt < 8) elo |= bit << j; else ehi |= bit << (j - 32); }
        elo |= __shfl_xor(elo, 16); elo |= __shfl_xor(elo, 32); ehi |= __shfl_xor(ehi, 16); ehi |= __shfl_xor(ehi, 32);
        const int pclo = __popc(elo);
#pragma unroll
        for (int kt = 0; kt < 16; ++kt) { const int j = 4 * kt + q;
            const int before = kt < 8 ? __popc(elo & ((1u << j) - 1u)) : pclo + __popc(ehi & ((1u << (j - 32)) - 1u));
            const unsigned bit = (key[kt] > T || (key[kt] == T && before < need)) ? 1u : 0u;
            if (kt < 8) mlo |= bit << j; else mhi |= bit << (j - 32); }
        mlo |= __shfl_xor(mlo, 16); mlo |= __shfl_xor(mlo, 32); mhi |= __shfl_xor(mhi, 16); mhi |= __shfl_xor(mhi, 32);
    }
    unsigned ulo = mlo, uhi = mhi;
#pragma unroll
    for (int o = 1; o < 16; o <<= 1) { ulo |= __shfl_xor(ulo, o); uhi |= __shfl_xor(uhi, o); }
    ulo = __builtin_amdgcn_readfirstlane(ulo); uhi = __builtin_amdgcn_readfirstlane(uhi);
    {
#pragma unroll
        for (int g = 0; g < 4; ++g) { mx[g] = NEGF; L[g] = (f32x4){0.f, 0.f, 0.f, 0.f}; }
#pragma unroll
        for (int dt = 0; dt < 4; ++dt)
#pragma unroll
            for (int g = 0; g < 4; ++g) O[dt][g] = (f32x4){0.f, 0.f, 0.f, 0.f};
        const bf16* Kp = (const bf16*)(ws + WS_KVH) + ((size_t)(2 * 4 + b) * 4 + hkv) * 4096 * 64;
        const bf16* VTp = (const bf16*)(ws + WS_VT) + ((size_t)(0 * 4 + b) * 4 + hkv) * 64 * 4096;
        flash_branch<0>(Kp, VTp, 0, (t0 + 15) >> 6, ulo, uhi, mlo, mhi, t0, t, Qs, O, mx, L, q, r16);
        attn_finish<1>(args, O, L, true, m, hkv, q);
    }
    {
#pragma unroll
        for (int g = 0; g < 4; ++g) { mx[g] = NEGF; L[g] = (f32x4){0.f, 0.f, 0.f, 0.f}; }
#pragma unroll
        for (int dt = 0; dt < 4; ++dt)
#pragma unroll
            for (int g = 0; g < 4; ++g) O[dt][g] = (f32x4){0.f, 0.f, 0.f, 0.f};
        const bf16* Kp = (const bf16*)(ws + WS_KVH) + ((size_t)(4 * 4 + b) * 4 + hkv) * 4096 * 64;
        const bf16* VTp = (const bf16*)(ws + WS_VT) + ((size_t)(1 * 4 + b) * 4 + hkv) * 64 * 4096;
        const int jbeg = t0 >= 511 ? (t0 - 511) >> 6 : 0, jend = (t0 + 15) >> 6;
        flash_branch<1>(Kp, VTp, jbeg, jend, 0xffffffffu, 0xffffffffu, 0xffffffffu, 0xffffffffu, t0, t, Qs, O, mx, L, q, r16);
        attn_finish<2>(args, O, L, true, m, hkv, q);
    }
}
#ifdef SELFCHECK
__device__ __forceinline__ void check_attn_prompt(const Args& args, LAS unsigned char* lds, int bid, int tid) {
    unsigned char* ws = args.ws;
    const int tl[12] = {0, 15, 30, 31, 63, 64, 127, 511, 512, 1023, 1024, 4095};
    int t = (bid * 997 + 13) % 4096;
#pragma unroll
    for (int i = 0; i < 12; ++i) t = (bid == i) ? tl[i] : t;
    const int b = bid & 3, hkv = (bid >> 2) & 3, bh = b * 4 + hkv; const size_t m = (size_t)b * 4096 + t;
    LAS float* qf = (LAS float*)lds;
    LAS float* sc = qf + 256;
    LAS float* imp = sc + 1024;
    LAS int* sel = (LAS int*)(imp + 64);
    LAS float* ss = (LAS float*)(sel + 16);
    LAS float* res = ss + 4096;
    LAS float* red = res + 256;
    const bf16* Q = (const bf16*)(ws + WS_Q) + m * 1024 + hkv * 256;
    const bf16* KC = (const bf16*)(ws + WS_KC) + (size_t)bh * 256 * 64;
    const bf16* VCT = (const bf16*)(ws + WS_VCT) + (size_t)bh * 64 * 256;
    const float* gates = (const float*)(ws + WS_MISC) + m * 128 + 32 + hkv * 12;
    __syncthreads();
    if (tid < 256) { qf[tid] = bf2f(Q[tid]); res[tid] = 0.f; }
    __syncthreads();
    for (int i = tid; i < 1024; i += 512) { const int g = i >> 8, n = i & 255; float s = NEGF;
        if (n < 255 && 16 * n + 31 <= t) { float a = 0.f; for (int d = 0; d < 64; ++d) a += qf[g * 64 + d] * bf2f(KC[n * 64 + d]); s = a * 0.125f; }
        sc[i] = s; }
    __syncthreads();
    if (tid < 4) { float mx = NEGF; for (int n = 0; n < 255; ++n) mx = fmaxf(mx, sc[tid * 256 + n]);
        float sum = 0.f; for (int n = 0; n < 255; ++n) { const float s = sc[tid * 256 + n]; const float e = (s > 0.5f * NEGF) ? __expf(s - mx) : 0.f; sc[tid * 256 + n] = e; sum += e; }
        const float inv = 1.f / fmaxf(sum, TINYF); for (int n = 0; n < 255; ++n) sc[tid * 256 + n] *= inv; sc[tid * 256 + 255] = 0.f; }
    __syncthreads();
    if (tid < 256) { const int g = tid >> 6, d = tid & 63; float o = 0.f;
        for (int n = 0; n < 255; ++n) { const int kk = n & 31, kpos = 8 * ((kk & 15) >> 2) + 4 * (kk >> 4) + (kk & 3);
            o += sc[g * 256 + n] * bf2f(VCT[(size_t)(n >> 5) * 2048 + d * 32 + kpos]); }
        res[tid] += sigmf(gates[g * 3 + 0]) * o; }
    if (tid >= 256 && tid < 320) { const int j = tid - 256; float a = 0.f;
        for (int i = 0; i < 255; ++i) { const int lo = max(16 * i, 64 * j), hi = min(16 * i + 32, 64 * j + 64); const int ov = hi > lo ? hi - lo : 0;
            a += ((sc[i] + sc[256 + i]) + (sc[512 + i] + sc[768 + i])) * ((float)ov * (1.f / 16.f)); }
        const int cur = t >> 6; const bool valid = 64 * j <= t, forced = (j == 0) || (j == cur) || (j == cur - 1);
        imp[j] = valid ? (forced ? BIGF : a) : -BIGF; }
    __syncthreads();
    if (tid == 0) { unsigned long long taken = 0ull;
        for (int k = 0; k < 16; ++k) { int best = -1; float bv = 0.f;
            for (int j = 0; j < 64; ++j) if (!((taken >> j) & 1ull) && (best < 0 || imp[j] > bv)) { best = j; bv = imp[j]; }
            taken |= 1ull << best; sel[k] = best; } }
    __syncthreads();
    for (int br = 1; br < 3; ++br) {
        const bf16* Kp = (const bf16*)(ws + WS_KVH) + ((size_t)((br == 1 ? 2 : 4) * 4 + b) * 4 + hkv) * 4096 * 64;
        const bf16* Vp = (const bf16*)(ws + WS_KVH) + ((size_t)((br == 1 ? 3 : 5) * 4 + b) * 4 + hkv) * 4096 * 64;
        const int nk = br == 1 ? 1024 : 512;
        for (int i = tid; i < 4 * nk; i += 512) { const int g = i / nk, k = i % nk;
            const int pos = br == 1 ? sel[k >> 6] * 64 + (k & 63) : t - 511 + k;
            float s = NEGF;
            if (pos >= 0 && pos <= t && pos < 4096) { float a = 0.f; for (int d = 0; d < 64; ++d) a += qf[g * 64 + d] * bf2f(Kp[(size_t)pos * 64 + d]); s = a * 0.125f; }
            ss[g * 1024 + k] = s; }
        __syncthreads();
        if (tid < 4) { float mx = NEGF; for (int k = 0; k < nk; ++k) mx = fmaxf(mx, ss[tid * 1024 + k]);
            float sum = 0.f; for (int k = 0; k < nk; ++k) { const float s = ss[tid * 1024 + k]; const float e = (s > 0.5f * NEGF) ? __expf(s - mx) : 0.f; ss[tid * 1024 + k] = e; sum += e; }
            red[tid] = 1.f / fmaxf(sum, TINYF); }
        __syncthreads();
        if (tid < 256) { const int g = tid >> 6, d = tid & 63; float o = 0.f;
            for (int k = 0; k < nk; ++k) { const float p = ss[g * 1024 + k]; if (p != 0.f) { const int pos = br == 1 ? sel[k >> 6] * 64 + (k & 63) : t - 511 + k; o += p * bf2f(Vp[(size_t)pos * 64 + d]); } }
            res[tid] += sigmf(gates[g * 3 + br]) * o * red[g]; }
        __syncthreads();
    }
    if (tid < 256) { const float ref = res[tid], got = bf2f(((const bf16*)(ws + WS_YATT))[m * 1024 + hkv * 256 + tid]);
        if (!(fabsf(got - ref) <= 0.003f + 0.03f * fabsf(ref))) atomicAdd((unsigned*)(ws + WS_CTL) + 8, 1u); }
    __syncthreads();
}
#endif
#ifdef SELFCHECK
__device__ __forceinline__ void check_attn_sample(const Args& args, LAS unsigned char* lds, int bid, int tid) {
    unsigned char* ws = args.ws; const float* out = args.out;
    const int u = (bid * 2 + 1) % 512, bs = u >> 2, hkv = u & 3; const size_t m = MP + bs;
    LAS float* qf = (LAS float*)lds; LAS float* sc = qf + 256; LAS float* imp = sc + 512; LAS int* sel = (LAS int*)(imp + 64);
    LAS float* ss = (LAS float*)(sel + 16); LAS float* res = ss + 4096; LAS float* red = res + 256;
    const bf16* Q = (const bf16*)(ws + WS_Q) + m * 1024 + hkv * 256;
    const float* KCS = (const float*)(ws + WS_KCS) + (size_t)(bs * 4 + hkv) * 128 * 64; const float* VCS = (const float*)(ws + WS_VCS) + (size_t)(bs * 4 + hkv) * 128 * 64;
    const float* gates = (const float*)(ws + WS_MISC) + m * 128 + 32 + hkv * 12;
    const int* pt = (const int*)args.in[5] + bs * NPAGES; const float* cache = INF(4); const float* cwin = INF(6);
    __syncthreads();
    if (tid < 256) { qf[tid] = bf2f(Q[tid]); res[tid] = 0.f; }
    __syncthreads();
    { const int g = tid >> 7, n = tid & 127; float s = NEGF;
      if (n < 127) { float a = 0.f; for (int d = 0; d < 64; ++d) a += qf[g * 64 + d] * KCS[n * 64 + d]; s = a * 0.125f; }
      sc[tid] = s; }
    __syncthreads();
    if (tid < 4) { float mx = NEGF; for (int n = 0; n < 127; ++n) mx = fmaxf(mx, sc[tid * 128 + n]);
        float sum = 0.f; for (int n = 0; n < 127; ++n) { const float e = __expf(sc[tid * 128 + n] - mx); sc[tid * 128 + n] = e; sum += e; }
        const float inv = 1.f / fmaxf(sum, TINYF); for (int n = 0; n < 127; ++n) sc[tid * 128 + n] *= inv; sc[tid * 128 + 127] = 0.f; }
    __syncthreads();
    if (tid < 256) { const int g = tid >> 6, d = tid & 63; float o = 0.f; for (int n = 0; n < 127; ++n) o += sc[g * 128 + n] * VCS[n * 64 + d]; res[tid] += sigmf(gates[g * 3 + 0]) * o; }
    if (tid >= 256 && tid < 256 + 33) { const int j = tid - 256; float a = 0.f;
        for (int i = 0; i < 127; ++i) { const int lo = max(16 * i, 64 * j), hi = min(16 * i + 32, 64 * j + 64); const int ov = hi > lo ? hi - lo : 0;
            a += ((sc[i] + sc[128 + i]) + (sc[256 + i] + sc[384 + i])) * ((float)ov * (1.f / 16.f)); }
        imp[j] = (j == 0 || j == 32 || j == 31) ? BIGF : a; }
    __syncthreads();
    if (tid == 0) { unsigned long long taken = 0ull;
        for (int k = 0; k < 16; ++k) { int best = -1; float bv = 0.f;
            for (int j = 0; j < 33; ++j) if (!((taken >> j) & 1ull) && (best < 0 || imp[j] > bv)) { best = j; bv = imp[j]; }
            taken |= 1ull << best; sel[k] = best; } }
    __syncthreads();
    for (int br = 1; br < 3; ++br) {
        const int nk = br == 1 ? 1024 : 513;
        for (int i = tid; i < 4 * nk; i += 512) { const int g = i / nk, k = i % nk; float s = NEGF; const float* kr = nullptr;
            if (br == 1) { const int pos = sel[k >> 6] * 64 + (k & 63);
                if (pos < 2048) kr = cache + (((size_t)pt[pos >> 7] * 128 + (pos & 127)) * 4 + 2) * 256 + hkv * 64;
                else if (pos == 2048) kr = out + O_KVS + ((size_t)bs * 4 + 2) * 256 + hkv * 64; }
            else { if (k >= 1 && k < 512) kr = cwin + (((size_t)bs * 512 + k) * 2 + 0) * 256 + hkv * 64;
                   else if (k == 512) kr = out + O_WINS + (((size_t)bs * 512 + 511) * 2 + 0) * 256 + hkv * 64; }
            if (kr) { float a = 0.f; for (int d = 0; d < 64; ++d) a += qf[g * 64 + d] * kr[d]; s = a * 0.125f; }
            ss[g * 1024 + k] = s; }
        __syncthreads();
        if (tid < 4) { float mx = NEGF; for (int k = 0; k < nk; ++k) mx = fmaxf(mx, ss[tid * 1024 + k]);
            float sum = 0.f; for (int k = 0; k < nk; ++k) { const float s = ss[tid * 1024 + k]; const float e = (s > 0.5f * NEGF) ? __expf(s - mx) : 0.f; ss[tid * 1024 + k] = e; sum += e; }
            red[tid] = 1.f / fmaxf(sum, TINYF); }
        __syncthreads();
        if (tid < 256) { const int g = tid >> 6, d = tid & 63; float o = 0.f;
            for (int k = 0; k < nk; ++k) { const float p = ss[g * 1024 + k]; if (p != 0.f) { const float* vr;
                if (br == 1) { const int pos = sel[k >> 6] * 64 + (k & 63);
                    vr = pos < 2048 ? cache + (((size_t)pt[pos >> 7] * 128 + (pos & 127)) * 4 + 3) * 256 + hkv * 64 : out + O_KVS + ((size_t)bs * 4 + 3) * 256 + hkv * 64; }
                else vr = k < 512 ? cwin + (((size_t)bs * 512 + k) * 2 + 1) * 256 + hkv * 64 : out + O_WINS + (((size_t)bs * 512 + 511) * 2 + 1) * 256 + hkv * 64;
                o += p * vr[d]; } }
            res[tid] += sigmf(gates[g * 3 + br]) * o * red[g]; }
        __syncthreads();
    }
    if (tid < 256) { const float ref = res[tid], got = bf2f(((const bf16*)(ws + WS_YATT))[m * 1024 + hkv * 256 + tid]);
        if (!(fabsf(got - ref) <= 0.003f + 0.03f * fabsf(ref))) atomicAdd((unsigned*)(ws + WS_CTL) + 8, 1u); }
    __syncthreads();
}
__device__ __forceinline__ void check_prompt_compress(const Args& args, LAS unsigned char* lds, int bid, int tid) {
    unsigned char* ws = args.ws;
    const int st = bid & 1, bh = (bid * 5) % 16, n = (bid * 11 + 3) % 255;
    LAS float* hid = (LAS float*)lds;
    const bf16* X = (const bf16*)(ws + WS_KVH) + ((size_t)st * 16 + bh) * 4096 * 64;
    __syncthreads();
    if (tid < 128) { const float* pe = INF(st ? 25 : 22); const float* w1 = INF(st ? 26 : 23); float a = 0.f;
        for (int l = 0; l < 32; ++l) for (int d = 0; d < 64; ++d) a += (bf2f(X[(size_t)(16 * n + l) * 64 + d]) + pe[l * 64 + d]) * w1[((size_t)l * 64 + d) * 128 + tid];
        hid[tid] = a / (1.f + __expf(-a)); }
    __syncthreads();
    if (tid < 64) { const float* w2 = INF(st ? 27 : 24); float o = 0.f;
        for (int e = 0; e < 128; ++e) o += hid[e] * w2[e * 64 + tid];
        const int kk = n & 31, kpos = 8 * ((kk & 15) >> 2) + 4 * (kk >> 4) + (kk & 3);
        const float got = st == 0 ? bf2f(((const bf16*)(ws + WS_KC))[((size_t)bh * 256 + n) * 64 + tid]) : bf2f(((const bf16*)(ws + WS_VCT))[((size_t)bh * 8 + (n >> 5)) * 2048 + tid * 32 + kpos]);
        if (!(fabsf(got - o) <= 0.03f + 0.03f * fabsf(o))) atomicAdd((unsigned*)(ws + WS_CTL) + 8, 1u); }
    __syncthreads();
}
#endif
__device__ __forceinline__ void dot4_reduce(const float (&qv)[4], float kx, int lane, float (&sg)[4]) {
    const float v0 = qv[0] * kx, v1 = qv[1] * kx, v2 = qv[2] * kx, v3 = qv[3] * kx;
    const bool up = (lane & 32) != 0, up2 = (lane & 16) != 0;
    const float r0 = (up ? v2 : v0) + __shfl_xor(up ? v0 : v2, 32), r1 = (up ? v3 : v1) + __shfl_xor(up ? v1 : v3, 32);
    float x = (up2 ? r1 : r0) + __shfl_xor(up2 ? r0 : r1, 16);
    x += __shfl_xor(x, 8); x += __shfl_xor(x, 4); x += __shfl_xor(x, 2); x += __shfl_xor(x, 1);
    const int xi = __builtin_bit_cast(int, x);
    sg[0] = __builtin_bit_cast(float, __builtin_amdgcn_readlane(xi, 0)); sg[1] = __builtin_bit_cast(float, __builtin_amdgcn_readlane(xi, 16));
    sg[2] = __builtin_bit_cast(float, __builtin_amdgcn_readlane(xi, 32)); sg[3] = __builtin_bit_cast(float, __builtin_amdgcn_readlane(xi, 48));
}
struct SampleRows { const float* cache; const float* cwin; float* out; const LAS int* selblk; const LAS int* selpage; int bs, hkv, rs, dc; };
template <int BR> __device__ __forceinline__ void srow_load(const SampleRows& R, int row, int nrows, f32x4& kx, f32x4& vx) {
    kx = (f32x4){0.f, 0.f, 0.f, 0.f}; vx = kx;
    if (row < nrows) {
        if (BR == 0) { const int k = row >> 6; const unsigned off = (((unsigned)R.selpage[k] * 128u + (unsigned)((R.selblk[k] & 1) * 64 + (row & 63))) * 4u + 2u) * 256u + (unsigned)(R.hkv * 64 + 4 * R.dc);
            kx = *(const f32x4*)(R.cache + off); vx = *(const f32x4*)(R.cache + off + 256u); }
        else { const unsigned off = (((unsigned)R.bs * 512u + (unsigned)(row + 1)) * 2u) * 256u + (unsigned)(R.hkv * 64 + 4 * R.dc);
            kx = *(const f32x4*)(R.cwin + off); vx = *(const f32x4*)(R.cwin + off + 256u); }
    }
}
__device__ __forceinline__ void srow_update(const f32x4 (&qv)[4], const f32x4& kx, const f32x4& vx, bool valid, float (&mx)[4], float (&ls)[4], f32x4 (&o)[4]) {
    float s[4];
#pragma unroll
    for (int g = 0; g < 4; ++g) s[g] = (qv[g].x * kx.x + qv[g].y * kx.y) + (qv[g].z * kx.z + qv[g].w * kx.w);
#pragma unroll
    for (int st = 8; st >= 1; st >>= 1)
#pragma unroll
        for (int g = 0; g < 4; ++g) s[g] += __shfl_xor(s[g], st);
#pragma unroll
    for (int g = 0; g < 4; ++g) {
        const float mnew = valid ? fmaxf(mx[g], s[g]) : mx[g], alpha = __expf(mx[g] - mnew), p = valid ? __expf(s[g] - mnew) : 0.f;
        ls[g] = ls[g] * alpha + p; o[g] = o[g] * alpha + vx * p; mx[g] = mnew;
    }
}
template <int BR>
__device__ __forceinline__ void sample_rows_branch(const SampleRows& R, int wave, const f32x4 (&qv)[4], LAS float* pm, LAS float* pl, LAS float* po) {
    float mx[4], ls[4]; f32x4 o[4];
#pragma unroll
    for (int g = 0; g < 4; ++g) { mx[g] = NEGF; ls[g] = 0.f; o[g] = (f32x4){0.f, 0.f, 0.f, 0.f}; }
    constexpr int nrows = BR == 0 ? 15 * 64 : 511;
    constexpr int ngroups = (nrows + 3) / 4;
#pragma unroll 1
    for (int g0 = wave; g0 < ngroups; g0 += 64) {
        f32x4 kx[8], vx[8];
#pragma unroll
        for (int k = 0; k < 8; ++k) srow_load<BR>(R, 4 * (g0 + 8 * k) + R.rs, (g0 + 8 * k) < ngroups ? nrows : 0, kx[k], vx[k]);
#pragma unroll
        for (int k = 0; k < 8; ++k) {
            const int grp = g0 + 8 * k, row = 4 * grp + R.rs;
            if (grp < ngroups) {
                const bool valid = row < nrows;
                if (BR == 1 && valid) { const unsigned off = (((unsigned)R.bs * 512u + (unsigned)row) * 2u) * 256u + (unsigned)(R.hkv * 64 + 4 * R.dc);
                    *(f32x4*)(R.out + O_WINS + off) = kx[k]; *(f32x4*)(R.out + O_WINS + off + 256u) = vx[k]; }
                srow_update(qv, kx[k], vx[k], valid, mx, ls, o);
            }
        }
    }
    if (wave == 0) {
        const float* src = BR == 0 ? R.out + O_KVS + ((size_t)R.bs * 4 + 2) * 256 + R.hkv * 64 + 4 * R.dc : R.out + O_WINS + (((size_t)R.bs * 512 + 511) * 2) * 256 + R.hkv * 64 + 4 * R.dc;
        const f32x4 kx = *(const f32x4*)src, vx = *(const f32x4*)(src + 256);
        srow_update(qv, kx, vx, R.rs == 0, mx, ls, o);
    }
    const int slot = (BR * 32 + wave * 4 + R.rs) * 4;
#pragma unroll
    for (int g = 0; g < 4; ++g) { if (R.dc == 0) { pm[slot + g] = mx[g]; pl[slot + g] = ls[g]; } *(LAS f32x4*)(po + (size_t)(slot + g) * 64 + 4 * R.dc) = o[g]; }
}

__device__ __forceinline__ void attn_sample_unit(const Args& args, LAS unsigned char* lds, int unit, int tid, int wave, int lane) {
    unsigned char* ws = args.ws; float* out = args.out;
    const int hkv = unit & 3, bs = unit >> 2; const size_t m = MP + bs;
    LAS float* sc = (LAS float*)lds; LAS float* impv = sc + 512; LAS int* selblk = (LAS int*)(impv + 64); LAS int* selpage = selblk + 16; LAS int* pg = selpage + 16;
    LAS float* pm = (LAS float*)(pg + 16); LAS float* pl = pm + 256; LAS float* po = pl + 256;
    LAS float* poc = po + 2 * 32 * 4 * 64;
    const bf16* Qr = (const bf16*)(ws + WS_Q) + m * 1024 + hkv * 256;
    const float* KCS = (const float*)(ws + WS_KCS) + (size_t)(bs * 4 + hkv) * 128 * 64; const float* VCS = (const float*)(ws + WS_VCS) + (size_t)(bs * 4 + hkv) * 128 * 64;
    float qv[4];
#pragma unroll
    for (int g = 0; g < 4; ++g) qv[g] = bf2f(Qr[g * 64 + lane]) * 0.125f;
    if (tid < 16) pg[tid] = ((const int*)args.in[5])[bs * NPAGES + tid];
    {
        float kr[16];
#pragma unroll
        for (int i = 0; i < 16; ++i) { const int n = wave + 8 * i; kr[i] = n < 127 ? KCS[n * 64 + lane] : 0.f; }
#pragma unroll
        for (int i = 0; i < 16; ++i) { const int n = wave + 8 * i; float sg[4]; dot4_reduce(qv, kr[i], lane, sg);
            if (lane < 4) sc[lane * 128 + n] = n < 127 ? (lane == 0 ? sg[0] : lane == 1 ? sg[1] : lane == 2 ? sg[2] : sg[3]) : NEGF; }
    }
    __syncthreads();
    if (wave < 4) { const float s0 = sc[wave * 128 + lane], s1 = sc[wave * 128 + 64 + lane];
        float mxv = fmaxf(s0, s1);
#pragma unroll
        for (int o = 1; o < 64; o <<= 1) mxv = fmaxf(mxv, __shfl_xor(mxv, o));
        const float e0 = __expf(s0 - mxv), e1 = (lane < 63) ? __expf(s1 - mxv) : 0.f;
        const float inv = 1.f / fmaxf(wave_sum(e0 + e1), TINYF);
        sc[wave * 128 + lane] = e0 * inv; sc[wave * 128 + 64 + lane] = e1 * inv; }
    __syncthreads();
    {
        float vr[16];
#pragma unroll
        for (int i = 0; i < 16; ++i) { const int n = wave + 8 * i; vr[i] = n < 127 ? VCS[n * 64 + lane] : 0.f; }
        float oc[4] = {0.f, 0.f, 0.f, 0.f};
#pragma unroll
        for (int i = 0; i < 16; ++i) { const int n = wave + 8 * i;
#pragma unroll
            for (int g = 0; g < 4; ++g) oc[g] += sc[g * 128 + n] * vr[i]; }
#pragma unroll
        for (int g = 0; g < 4; ++g) poc[(wave * 4 + g) * 64 + lane] = oc[g];
        if (wave == 4 && lane < 33) { const int j = lane; float acc = 0.f;
#pragma unroll
            for (int k = -1; k < 4; ++k) { const int n = 4 * j + k; if (n >= 0 && n < 127) { const float P = (sc[n] + sc[128 + n]) + (sc[256 + n] + sc[384 + n]); acc += (k == -1 || k == 3) ? P : 2.f * P; } }
            impv[j] = (j == 0 || j == 31 || j == 32) ? BIGF : acc; }
    }
    __syncthreads();
    if (tid < 64) { bool sel = false;
        if (tid < 33) { const float v = impv[tid]; int rank = 0;
            for (int k = 0; k < 33; ++k) { const float o = impv[k]; rank += ((o > v) || (o == v && k < tid)) ? 1 : 0; }
            sel = rank < 16 && tid < 32; }
        const unsigned long long bal = __ballot(sel);
        if (sel) { const int slot = __popcll(bal & ((1ull << tid) - 1ull)); selblk[slot] = tid; selpage[slot] = pg[tid >> 1]; } }
    __syncthreads();
    {
        f32x4 qv4[4];
#pragma unroll
        for (int g = 0; g < 4; ++g) { const u32x2 w = *(const u32x2*)(Qr + g * 64 + 4 * (lane & 15)); qv4[g] = (f32x4){bflo(w.x), bfhi(w.x), bflo(w.y), bfhi(w.y)} * 0.125f; }
        SampleRows R{INF(4), INF(6), out, selblk, selpage, bs, hkv, lane >> 4, lane & 15};
        sample_rows_branch<0>(R, wave, qv4, pm, pl, po);
        sample_rows_branch<1>(R, wave, qv4, pm, pl, po);
    }
    __syncthreads();
    if (tid < 256) { const int g = tid >> 6, d = tid & 63;
        const float* gates = (const float*)(ws + WS_MISC) + m * 128 + 32 + (hkv * 4 + g) * 3;
        float oc = 0.f;
#pragma unroll
        for (int w = 0; w < 8; ++w) oc += poc[(w * 4 + g) * 64 + d];
        float res = sigmf(gates[0]) * oc;
#pragma unroll
        for (int br = 0; br < 2; ++br) { float M = NEGF;
#pragma unroll 8
            for (int w = 0; w < 32; ++w) M = fmaxf(M, pm[(br * 32 + w) * 4 + g]);
            float L = 0.f, O = 0.f;
#pragma unroll 8
            for (int w = 0; w < 32; ++w) { const float e = __expf(pm[(br * 32 + w) * 4 + g] - M); L += pl[(br * 32 + w) * 4 + g] * e; O += po[((br * 32 + w) * 4 + g) * 64 + d] * e; }
            res += sigmf(gates[1 + br]) * O / fmaxf(L, TINYF); }
        ((bf16*)(ws + WS_YATT))[m * 1024 + (hkv * 4 + g) * 64 + d] = (bf16)f2bf(res); }
    __syncthreads();
}

__device__ __forceinline__ void ffn_act_item(const Args& args, int item, int lane) {
    unsigned char* ws = args.ws; float* out = args.out;
    const bf16* U = (const bf16*)(ws + WS_U); bf16* ACT = (bf16*)(ws + WS_ACT);
    const float* cw = INF(32); const float* cb = INF(33); const float* st = INF(9);
    const int slab = item % 11, chunk = item / 11, row0 = chunk * 32, c4 = slab * 256 + lane * 4;
    f32x4 w[2][3], bia[2];
#pragma unroll
    for (int hf = 0; hf < 2; ++hf) { bia[hf] = *(const f32x4*)(cb + hf * DFF + c4);
#pragma unroll
        for (int k = 0; k < 3; ++k) w[hf][k] = *(const f32x4*)(cw + k * DFF2 + hf * DFF + c4); }
    if (row0 >= MP) {
        for (int r = 0; r < 32; ++r) { const int bs = row0 - MP + r; if (bs >= MS) break;
            f32x4 cu[2];
#pragma unroll
            for (int hf = 0; hf < 2; ++hf) { const int col = hf * DFF + c4;
                const f32x4 u0 = *(const f32x4*)(st + ((size_t)bs * 2 + 0) * DFF2 + col), u1 = *(const f32x4*)(st + ((size_t)bs * 2 + 1) * DFF2 + col), u2 = *(const f32x4*)(out + O_FFNS + ((size_t)bs * 2 + 1) * DFF2 + col);
                *(f32x4*)(out + O_FFNS + ((size_t)bs * 2 + 0) * DFF2 + col) = u1;
                cu[hf] = bia[hf] + w[hf][0] * u0 + w[hf][1] * u1 + w[hf][2] * u2; }
            u32x2 o; o.x = pk2(siluf(cu[0].x) * cu[1].x, siluf(cu[0].y) * cu[1].y); o.y = pk2(siluf(cu[0].z) * cu[1].z, siluf(cu[0].w) * cu[1].w);
            *(u32x2*)(ACT + (size_t)(row0 + r) * DFF + c4) = o; }
        return;
    }
    const int t0 = row0 & 4095;
    f32x4 p2[2], p1[2];
#pragma unroll
    for (int hf = 0; hf < 2; ++hf) { const int col = hf * DFF + c4;
        const u32x2 a = t0 >= 2 ? *(const u32x2*)(U + (size_t)(row0 - 2) * DFF2 + col) : (u32x2){0u, 0u}, b = t0 >= 1 ? *(const u32x2*)(U + (size_t)(row0 - 1) * DFF2 + col) : (u32x2){0u, 0u};
        p2[hf] = (f32x4){bflo(a.x), bfhi(a.x), bflo(a.y), bfhi(a.y)}; p1[hf] = (f32x4){bflo(b.x), bfhi(b.x), bflo(b.y), bfhi(b.y)}; }
#pragma unroll 1
    for (int rb = 0; rb < 32; rb += 8) {
        u32x2 v[8][2];
#pragma unroll
        for (int r = 0; r < 8; ++r)
#pragma unroll
            for (int hf = 0; hf < 2; ++hf) v[r][hf] = *(const u32x2*)(U + (size_t)(row0 + rb + r) * DFF2 + hf * DFF + c4);
#pragma unroll
        for (int r = 0; r < 8; ++r) {
            f32x4 cu[2];
#pragma unroll
            for (int hf = 0; hf < 2; ++hf) { const f32x4 u2 = (f32x4){bflo(v[r][hf].x), bfhi(v[r][hf].x), bflo(v[r][hf].y), bfhi(v[r][hf].y)};
                cu[hf] = bia[hf] + w[hf][0] * p2[hf] + w[hf][1] * p1[hf] + w[hf][2] * u2; p2[hf] = p1[hf]; p1[hf] = u2; }
            u32x2 o; o.x = pk2(siluf(cu[0].x) * cu[1].x, siluf(cu[0].y) * cu[1].y); o.y = pk2(siluf(cu[0].z) * cu[1].z, siluf(cu[0].w) * cu[1].w);
            *(u32x2*)(ACT + (size_t)(row0 + rb + r) * DFF + c4) = o;
        }
    }
}
template <int KTOT>
__device__ __forceinline__ f32x4 skinny_acc(const bf16* A, int lda, const bf16* Bt, int ldb, int wave, int ct, int q, int r16) {
    const bf16* ap = A + (size_t)(16 * wave + r16) * lda + 8 * q;
    const bf16* bp = Bt + (size_t)(16 * ct + r16) * ldb + 8 * q;
    f32x4 acc = (f32x4){0.f, 0.f, 0.f, 0.f};
#pragma unroll 1
    for (int k0 = 0; k0 < KTOT; k0 += 256) {
        bf16x8 af[8], bf[8];
#pragma unroll
        for (int i = 0; i < 8; ++i) { af[i] = *(const bf16x8*)(ap + k0 + 32 * i); bf[i] = *(const bf16x8*)(bp + k0 + 32 * i); }
#pragma unroll
        for (int i = 0; i < 8; ++i) acc = MFMA16(af[i], bf[i], acc);
    }
    return acc;
}
template <int WHICH>
__device__ __forceinline__ void skinny_sample_unit(const Args& args, int ct, int wave, int lane) {
    unsigned char* ws = args.ws;
    const int q = lane >> 4, r16 = lane & 15, col = 16 * ct + r16;
    if (WHICH == 0) {
        const f32x4 a1 = skinny_acc<2048>((const bf16*)(ws + WS_YSSM) + (size_t)MP * 2048, 2048, (const bf16*)(ws + WS_WSSM), 2048, wave, ct, q, r16);
        const f32x4 a2 = skinny_acc<1024>((const bf16*)(ws + WS_YATT) + (size_t)MP * 1024, 1024, (const bf16*)(ws + WS_WATT), 1024, wave, ct, q, r16);
#pragma unroll
        for (int r = 0; r < 4; ++r) { const size_t row = MP + 16 * wave + 4 * q + r;
            const f32x4 sq = *(const f32x4*)((const float*)(ws + WS_SSQ) + row * 4);
            const float rstd = 1.f / sqrtf(((sq.x + sq.y) + (sq.z + sq.w)) * (1.f / 2048.f) + EPS);
            const bf16* mg = (const bf16*)(ws + WS_MG) + row * 2048;
            const float v = sigmf(bf2f(mg[col])) * rstd * a1[r] + sigmf(bf2f(mg[1024 + col])) * a2[r];
            ((bf16*)(ws + WS_MERGED))[row * 1024 + col] = (bf16)f2bf(v); }
    } else if (WHICH == 1) {
        const f32x4 a = skinny_acc<1024>((const bf16*)(ws + WS_MERGED) + (size_t)MP * 1024, 1024, (const bf16*)(ws + WS_WOUT), 1024, wave, ct, q, r16);
#pragma unroll
        for (int r = 0; r < 4; ++r) { const int bs = 16 * wave + 4 * q + r;
            ((float*)(ws + WS_X1))[(size_t)(MP + bs) * 1024 + col] = INF(1)[(size_t)bs * 1024 + col] + ((const float*)(ws + WS_MOD))[(size_t)(4 + bs) * 6144 + 2048 + col] * a[r]; }
    } else {
        const f32x4 a = skinny_acc<DFF>((const bf16*)(ws + WS_ACT) + (size_t)MP * DFF, DFF, (const bf16*)(ws + WS_WDN), DFF, wave, ct, q, r16);
#pragma unroll
        for (int r = 0; r < 4; ++r) { const int bs = 16 * wave + 4 * q + r; float* x = (float*)(ws + WS_X1) + (size_t)(MP + bs) * 1024 + col;
            *x = *x + ((const float*)(ws + WS_MOD))[(size_t)(4 + bs) * 6144 + 5120 + col] * a[r]; }
    }
}
constexpr int N_PHASES = 15;
#ifndef MK_PER_PHASE
#define MK_PER_PHASE 0
#endif

__global__ void __launch_bounds__(NTHR, 2) fwd_kernel(Args args) {
    extern __shared__ __attribute__((aligned(16))) unsigned char lds_raw[];
    LAS unsigned char* lds = (LAS unsigned char*)lds_raw;
    const int tid = threadIdx.x, lane = tid & 63, wave = __builtin_amdgcn_readfirstlane(tid >> 6);
    const int G = gridDim.x, bid = blockIdx.x, gw = bid * NWAVES + wave, NGW = G * NWAVES, gt = bid * NTHR + tid, NGT = G * NTHR;
    unsigned char* ws = args.ws;
    for (int u = tid; u < (LDS_BYTES - LDSCTL_OFF) / 4; u += NTHR) ((LAS unsigned*)(lds + LDSCTL_OFF))[u] = 0u;
    __syncthreads();
    XcdBarrier bar; bar.bar = (unsigned*)(ws + WS_CTL) + CW_BAR; bar.x = 0; bar.st = nullptr;
    if (!MK_PER_PHASE) bar = xcd_barrier_post((unsigned*)(ws + WS_CTL) + CW_BAR, (volatile LAS unsigned*)(lds + MISC_OFF) + 8);
    const int lo = args.ph_lo, hi = args.ph_hi;
#ifndef PHASE_MASK
#define PHASE_MASK 0x7fff
#endif
#define IN(k) ((((PHASE_MASK) >> (k)) & 1) && lo <= (k) && (k) < hi)
#define SEAM(k) do { if (IN(k) && IN((k) + 1)) xcd_barrier(bar); } while (0)
    using pg8::Gemm; using pg8::StaticOrder;

    if (IN(0)) { { p0_prologue(args, lds, gw, NGW, lane, wave); } }
    SEAM(0);
    if (IN(1)) { {
        Gemm g{(const bf16*)(ws + WS_SC), (const bf16*)(ws + WS_WADA), 256, 6144, 1024}; StaticOrder S; S.init(256, 6144, G, bid);
        pg8::EpiF32 E{(float*)(ws + WS_MOD), 6144, INF(11)};
        pg8::gemm_phase<pg8::EpiF32, StaticOrder, true, true>(lds, g, S, E);
    } }
    SEAM(1);
    if (IN(2)) { { norm_mod_phase<0>(args, gw, NGW, lane); } }
    SEAM(2);
    if (IN(3)) { {
        Gemm g{(const bf16*)(ws + WS_H), (const bf16*)(ws + WS_WIN), MPAD, NPROJ, 1024}; StaticOrder S; S.init(MPAD, NPROJ, G, bid);
        epi::InProj E{ws, args.out};
        pg8::gemm_phase<epi::InProj, StaticOrder, true, true>(lds, g, S, E);
    } }
    SEAM(3);
    if (IN(4)) { {
        const int p4 = args.p7mask >> 8;
        if (p4 & 1) for (int u = bid; u < 1024; u += G) sample_compress_unit(args, lds, u, tid, wave, lane);
        if (p4 & 2) {
        { Gemm g{(const bf16*)(ws + WS_KVH), (const bf16*)(ws + WS_W1K), 4096, 256, 1024}; StaticOrder S; S.init(4096, 256, G, bid);
          epi::PartBf16 E{(bf16*)(ws + WS_PARTK)}; pg8::gemm_phase<epi::PartBf16, StaticOrder, true, true>(lds, g, S, E); }
        { Gemm g{(const bf16*)(ws + WS_KVH) + (size_t)16 * 4096 * 64, (const bf16*)(ws + WS_W1V), 4096, 256, 1024}; StaticOrder S; S.init(4096, 256, G, (bid + G - 16) % G);
          epi::PartBf16 E{(bf16*)(ws + WS_PARTV)}; pg8::gemm_phase<epi::PartBf16, StaticOrder, true, true>(lds, g, S, E); }
        }
        if (p4 & 4) {
            if (G == 256) { if (bid >= 32) for (int it = gw - 32 * NWAVES; it < 256 * 48; it += NGW - 32 * NWAVES) conv_prompt_item(args, it, lane); }
            else for (int it = gw; it < 256 * 48; it += NGW) conv_prompt_item(args, it, lane);
        }
        if (p4 & 8) { for (int it = gw; it < 4096; it += NGW) dtcs_item(args, it, lane);
            sample_conv(args, gt, NGT); }
    } }
    SEAM(4);
    if (IN(5)) { {
        const int p5 = args.p7mask >> 4;
        if (p5 & 1) for (int u = bid; u < 512; u += G) ssd_states_unit(args, lds, u, wave, lane);
        if (p5 & 2) for (int it = gw; it < 2 * (4096 / 16); it += NGW) compress2_item<0>(args, it, lane);
        if (p5 & 2) for (int it = gw; it < 2 * 128 * 4 * 3; it += NGW) compress_fixup_item(args, it, lane);
        if (p5 & 4) for (int it = gw; it < MS * NH; it += NGW) sample_ssm_item(args, lds, it, wave, lane);
    } }
    SEAM(5);
    if (IN(6)) { { scan_phase(args, gt, NGT); } }
    SEAM(6);
    if (IN(7)) { {
#ifndef P7C
#define P7C 7
#endif
        const int p7 = args.p7mask & (P7C);
        if (p7 & 1) for (int u = bid; u < 512; u += G) ssd_out_unit(args, lds, u, wave, lane, tid);
        if (p7 & 2) for (int u = gw; u < 4096; u += NGW) attn_prompt_unit(args, (LAS float*)(lds + wave * 12288), u, NGW == 2048, lane);
        __syncthreads();
        if (p7 & 4) for (int u = bid; u < 512; u += G) attn_sample_unit(args, lds, u, tid, wave, lane);
    } }
    SEAM(7);
    if (IN(8)) { {
#ifdef SELFCHECK
        check_attn_prompt(args, lds, bid, tid); check_attn_sample(args, lds, bid, tid); check_prompt_compress(args, lds, bid, tid); check_sample_compress(args, lds, bid, tid);
#endif
        for (int u = bid; u < 64; u += G) skinny_sample_unit<0>(args, u, wave, lane);
        { Gemm g{(const bf16*)(ws + WS_YSSM), (const bf16*)(ws + WS_WSSM), MP, 1024, 2048}; StaticOrder S; S.init(MP, 1024, G, bid);
          epi::Merge1 E{ws}; pg8::gemm_phase<epi::Merge1, StaticOrder, true, true>(lds, g, S, E); }
        { Gemm g{(const bf16*)(ws + WS_YATT), (const bf16*)(ws + WS_WATT), MP, 1024, 1024}; StaticOrder S; S.init(MP, 1024, G, bid);
          epi::Merge2 E{ws}; pg8::gemm_phase<epi::Merge2, StaticOrder, true, true>(lds, g, S, E); }
    } }
    SEAM(8);
    if (IN(9)) { {
        for (int u = bid; u < 64; u += G) skinny_sample_unit<1>(args, u, wave, lane);
        Gemm g{(const bf16*)(ws + WS_MERGED), (const bf16*)(ws + WS_WOUT), MP, 1024, 1024}; StaticOrder S; S.init(MP, 1024, G, bid);
        epi::Resid E{INF(0), INF(1), nullptr, (float*)(ws + WS_X1), (const float*)(ws + WS_MOD), 2048};
        pg8::gemm_phase<epi::Resid, StaticOrder, true, true>(lds, g, S, E);
    } }
    SEAM(9);
    if (IN(10)) { { norm_mod_phase<1>(args, gw, NGW, lane); } }
    SEAM(10);
    if (IN(11)) { {
        Gemm g{(const bf16*)(ws + WS_H), (const bf16*)(ws + WS_WUP), MPAD, DFF2, 1024}; StaticOrder S; S.init(MPAD, DFF2, G, bid);
        epi::Up E{ws, args.out};
        pg8::gemm_phase<epi::Up, StaticOrder, true, true>(lds, g, S, E);
    } }
    SEAM(11);
    if (IN(12)) { { for (int it = gw; it < (MPAD / 32) * 11; it += NGW) ffn_act_item(args, it, lane); } }
    SEAM(12);
    if (IN(13)) { {
        for (int u = bid; u < 64; u += G) skinny_sample_unit<2>(args, u, wave, lane);
        Gemm g{(const bf16*)(ws + WS_ACT), (const bf16*)(ws + WS_WDN), MP, 1024, DFF}; StaticOrder S; S.init(MP, 1024, G, bid);
        epi::Resid E{INF(0), INF(1), (const float*)(ws + WS_X1), (float*)(ws + WS_X1), (const float*)(ws + WS_MOD), 5120};
        pg8::gemm_phase<epi::Resid, StaticOrder, true, true>(lds, g, S, E);
    } }
    SEAM(13);
    if (IN(14)) { { norm_mod_phase<2>(args, gw, NGW, lane); } }
#ifdef SELFCHECK
    if (IN(14) && bid == 0 && tid == 0 && ((volatile unsigned*)(ws + WS_CTL))[8] != 0u) args.out[O_YS] = __builtin_nanf("");
#endif
#undef IN
#undef SEAM
}

extern "C" void kernel_launch(void* const* d_in, const int* in_sizes, int n_in, void* d_out, int out_size, void* d_ws, size_t ws_size, hipStream_t stream) {
    static int grid = 0;
    if (grid == 0) {
        if (n_in != 35 || out_size != (int)O_END || ws_size < WS_END) { fprintf(stderr, "kernel_launch: unexpected shapes (n_in %d out %d ws %zu, need %zu)\n", n_in, out_size, ws_size, (size_t)WS_END); grid = -1; return; }
        int dev = 0, cus = 0, per_cu = 0;
        if (hipGetDevice(&dev) != hipSuccess || hipDeviceGetAttribute(&cus, hipDeviceAttributeMultiprocessorCount, dev) != hipSuccess) { grid = -1; return; }
        if (hipFuncSetAttribute((const void*)fwd_kernel, hipFuncAttributeMaxDynamicSharedMemorySize, LDS_BYTES) != hipSuccess) { fprintf(stderr, "kernel_launch: hipFuncSetAttribute failed\n"); grid = -1; return; }
        if (hipOccupancyMaxActiveBlocksPerMultiprocessor(&per_cu, (const void*)fwd_kernel, NTHR, LDS_BYTES) != hipSuccess || per_cu < 1) { fprintf(stderr, "kernel_launch: occupancy query says %d\n", per_cu); }
        (void)hipGetLastError();
        grid = cus;
    }
    if (grid < 0) return;
    (void)hipMemsetAsync((char*)d_ws + WS_CTL, 0, CTL_ZERO_BYTES, stream);
    Args a{};
    for (int i = 0; i < 35; ++i) a.in[i] = d_in[i];
    a.out = (float*)d_out; a.ws = (unsigned char*)d_ws;
    a.p7mask = 0xFFF; a.pad = 7;
#if MK_PER_PHASE
    for (int p = 0; p < N_PHASES; ++p) { a.ph_lo = p; a.ph_hi = p + 1; hipLaunchKernelGGL(fwd_kernel, dim3(grid), dim3(NTHR), LDS_BYTES, stream, a); }
#else
    a.ph_lo = 0; a.ph_hi = N_PHASES;
    hipLaunchKernelGGL(fwd_kernel, dim3(grid), dim3(NTHR), LDS_BYTES, stream, a);
#endif
#ifdef PROBE_LO
    a.ph_lo = PROBE_LO; a.ph_hi = PROBE_HI; a.p7mask = PROBE_P7MASK; a.pad = PROBE_P7MASK;
    hipLaunchKernelGGL(fwd_kernel, dim3(grid), dim3(NTHR), LDS_BYTES, stream, a);
#endif
}
```

```cpp
#include <hip/hip_runtime.h>
#include <cstdio>
#include <cstdint>
namespace pg8 {
#define PG8_LAS __attribute__((address_space(3)))
typedef unsigned short bf16_t;
typedef short bf16x8 __attribute__((ext_vector_type(8)));
typedef float f32x4 __attribute__((ext_vector_type(4)));
typedef unsigned u32x4 __attribute__((ext_vector_type(4)));
constexpr int BM = 256, BK = 64, HALF = 128, HTB = HALF * BK * 2  , STAGE_BYTES = 8 * HTB, NXCD = 8, WGM = 8;

__host__ __device__ __forceinline__ int lds_byte(int r, int c) { const int st = (r >> 4) * 2 + (c >> 5), rr = r & 15, cc = c & 31, ob = rr * 64 + cc * 2; return st * 1024 + (ob ^ (((ob >> 9) & 1) << 5)); }
__host__ __device__ __forceinline__ void stage_rc(int b, int& R, int& C) { const int st = b / 1024, sb = b % 1024, swz = sb ^ (((sb >> 9) & 1) << 5); R = (st >> 1) * 16 + swz / 64; C = (st & 1) * 32 + (swz % 64) / 2; }
__host__ __device__ __forceinline__ int perm32(int rho) { const int n = rho >> 4, i = rho & 15; return 8 * (i >> 2) + 4 * n + (i & 3); }

struct Unit { int pm, pn; };
struct Gemm { const bf16_t* A; const bf16_t* Bt; int M, N, K; };

struct StaticOrder {
    int nM, nN, nwg, G, c;
    __host__ __device__ void init(int M, int N, int G_, int c_) { nM = M / BM; nN = N / BM; nwg = nM * nN; G = G_; c = c_; }
    __host__ __device__ bool next(int i, Unit& u) const {
        const long L = (long)i * G + c; if (L >= nwg) return false;
        int wgid = (int)L; { const int q = nwg / NXCD, r = nwg % NXCD, xcd = wgid % NXCD, off = wgid / NXCD; wgid = (xcd < r ? xcd * (q + 1) : r * (q + 1) + (xcd - r) * q) + off; }
        const int nig = WGM * nN, gid = wgid / nig, fm = gid * WGM, gsz = (nM - fm) < WGM ? (nM - fm) : WGM;
        u.pm = fm + ((wgid % nig) % gsz); u.pn = (wgid % nig) / gsz; return true;
    }
    __device__ __forceinline__ void a_ready(const Unit&) const {}
    __device__ __forceinline__ void done(const Unit&) const {}
};
__device__ __forceinline__ unsigned cvt_pk_bf16(float lo, float hi) { unsigned r; asm volatile("v_cvt_pk_bf16_f32 %0, %1, %2" : "=v"(r) : "v"(lo), "v"(hi)); return r; }
typedef float f32x2 __attribute__((ext_vector_type(2)));
struct EpiF32 {
    static constexpr bool PERM = false, AFTER_DRAIN = false;
    float* C; int ldc; const float* bias;
    __device__ __forceinline__ void operator()(const f32x4 (&acc)[2][2][4][2], const Unit& u, int wr, int wc, int fr, int fq) const {
        const int row0 = u.pm * BM + wr * 64 + fr, col0 = u.pn * BM + wc * 32 + 4 * fq;
        f32x4 bv[2][2];
#pragma unroll
        for (int bj = 0; bj < 2; ++bj)
#pragma unroll
            for (int n = 0; n < 2; ++n) bv[bj][n] = bias ? *(const f32x4*)(bias + col0 + bj * HALF + n * 16) : (f32x4){0.f, 0.f, 0.f, 0.f};
#pragma unroll
        for (int ai = 0; ai < 2; ++ai)
#pragma unroll
            for (int m = 0; m < 4; ++m) { float* rowp = C + (size_t)(row0 + ai * HALF + m * 16) * ldc + col0;
#pragma unroll
                for (int bj = 0; bj < 2; ++bj)
#pragma unroll
                    for (int n = 0; n < 2; ++n) *(f32x4*)(rowp + bj * HALF + n * 16) = acc[ai][bj][m][n] + bv[bj][n]; }
    }
};
template <class Epi, class Sched, bool ALIGN_EPI = false, bool SP2 = false>
__device__ __forceinline__ void gemm_phase(PG8_LAS unsigned char* lds, const Gemm g, const Sched& S, const Epi& E) {
    const int tid = threadIdx.x, wid = __builtin_amdgcn_readfirstlane(tid >> 6), lane = tid & 63, wr = wid >> 2, wc = wid & 3, fr = lane & 15, fq = lane >> 4;
    const int K = g.K, nt = K / BK;
    unsigned voffA[2], voffB[2];
#pragma unroll
    for (int i = 0; i < 2; ++i) { int R, C; stage_rc(tid * 16 + i * 8192, R, C); const int Rb = Epi::PERM ? ((R & ~31) + perm32(R & 31)) : R;
        voffA[i] = (unsigned)(R * K + C) * 2u; voffB[i] = (unsigned)(Rb * K + C) * 2u; }
    const size_t kstep = (size_t)(BK * 2);
    const size_t hstep = (size_t)HALF * K * 2;
    const size_t tstep = 2 * hstep;
    const unsigned ldsw = (unsigned)wid * 1024u;
    const int aoff = lds_byte(wr * 64 + fr, fq * 8), boff = lds_byte(wc * 32 + fr, fq * 8);
#define PG8_SA(b, h) (((b) * 2 + (h)) * HTB)
#define PG8_SB(b, h) ((4 + (b) * 2 + (h)) * HTB)
#define PG8_STAGE(bufoff, gbase, voff) do { _Pragma("unroll") for (int _i = 0; _i < 2; ++_i) \
        __builtin_amdgcn_global_load_lds((const unsigned*)((const char*)(gbase) + (voff)[_i]), (PG8_LAS unsigned*)(lds + (bufoff) + ldsw + _i * 8192), 16, 0, 0); } while (0)
#define PG8_LDA(dst, b, h) do { _Pragma("unroll") for (int m = 0; m < 4; ++m) _Pragma("unroll") for (int k = 0; k < 2; ++k) dst[m][k] = *(const PG8_LAS bf16x8*)(lds + PG8_SA(b, h) + aoff + m * 2048 + k * 1024); } while (0)
#define PG8_LDB(dst, b, h) do { _Pragma("unroll") for (int n = 0; n < 2; ++n) _Pragma("unroll") for (int k = 0; k < 2; ++k) dst[n][k] = *(const PG8_LAS bf16x8*)(lds + PG8_SB(b, h) + boff + n * 2048 + k * 1024); } while (0)
#define PG8_MMA(ai, bj, At, Bt) do { __builtin_amdgcn_s_setprio(1); _Pragma("unroll") for (int m = 0; m < 4; ++m) _Pragma("unroll") for (int n = 0; n < 2; ++n) _Pragma("unroll") for (int k = 0; k < 2; ++k) \
        acc[ai][bj][m][n] = __builtin_amdgcn_mfma_f32_16x16x32_bf16(Bt[n][k], At[m][k], acc[ai][bj][m][n], 0, 0, 0); __builtin_amdgcn_s_setprio(0); } while (0)
#define PG8_WAIT_V(n) asm volatile("s_waitcnt vmcnt(" #n ")" ::: "memory")
#define PG8_WAIT_L(n) asm volatile("s_waitcnt lgkmcnt(" #n ")" ::: "memory")
#define PG8_BAR __builtin_amdgcn_s_barrier()
#define PG8_SCHED __builtin_amdgcn_sched_barrier(0)
    Unit cur, nxt; int ui = 0;
    if (!S.next(0, cur)) return;
    f32x4 acc[2][2][4][2];
#pragma unroll
    for (int a = 0; a < 2; ++a)
#pragma unroll
        for (int b = 0; b < 2; ++b)
#pragma unroll
            for (int m = 0; m < 4; ++m)
#pragma unroll
                for (int n = 0; n < 2; ++n) acc[a][b][m][n] = (f32x4){0.f, 0.f, 0.f, 0.f};
    bf16x8 At[4][2], B0[2][2], B1[2][2];
    const char* cA = (const char*)g.A + (size_t)cur.pm * tstep; const char* cB = (const char*)g.Bt + (size_t)cur.pn * tstep;
    S.a_ready(cur);
    if constexpr (SP2) {
        PG8_STAGE(PG8_SB(0, 0), cB, voffB); PG8_STAGE(PG8_SB(0, 1), cB + hstep, voffB); PG8_STAGE(PG8_SA(0, 0), cA, voffA); PG8_STAGE(PG8_SA(0, 1), cA + hstep, voffA);
        if (wr == 1) PG8_BAR;
        PG8_WAIT_V(2); PG8_BAR;
        PG8_STAGE(PG8_SB(1, 0), cB + kstep, voffB); PG8_STAGE(PG8_SA(1, 0), cA + kstep, voffA); PG8_STAGE(PG8_SB(1, 1), cB + hstep + kstep, voffB);
        PG8_WAIT_V(6); PG8_BAR;
    } else {
        PG8_STAGE(PG8_SB(0, 0), cB, voffB); PG8_STAGE(PG8_SA(0, 0), cA, voffA); PG8_STAGE(PG8_SB(0, 1), cB + hstep, voffB); PG8_STAGE(PG8_SA(0, 1), cA + hstep, voffA);
        if (wr == 1) PG8_BAR;
        PG8_WAIT_V(4); PG8_BAR;
        PG8_STAGE(PG8_SB(1, 0), cB + kstep, voffB); PG8_STAGE(PG8_SA(1, 0), cA + kstep, voffA); PG8_STAGE(PG8_SB(1, 1), cB + hstep + kstep, voffB);
        PG8_WAIT_V(6); PG8_BAR;
    }
    for (;;) {
        const bool has_next = S.next(ui + 1, nxt);
        const char* nA = has_next ? (const char*)g.A + (size_t)nxt.pm * tstep : cA; const char* nB = has_next ? (const char*)g.Bt + (size_t)nxt.pn * tstep : cB;
        for (int t = 0; t < nt; t += 2) {
            const bool last = (t == nt - 2);
            const char* a1 = cA + (size_t)(t + 1) * kstep;
            const char* a2 = last ? nA : cA + (size_t)(t + 2) * kstep; const char* b2 = last ? nB : cB + (size_t)(t + 2) * kstep;
            const char* a3 = a2 + kstep; const char* b3 = b2 + kstep;
            if (last && has_next) S.a_ready(nxt);
            if constexpr (SP2) {
            PG8_LDB(B0, 0, 0); PG8_LDB(B1, 0, 1); PG8_SCHED; PG8_LDA(At, 0, 0); PG8_STAGE(PG8_SA(1, 1), a1 + hstep, voffA);
            PG8_WAIT_V(8); PG8_WAIT_L(0); PG8_BAR; PG8_MMA(0, 0, At, B0); PG8_MMA(0, 1, At, B1); PG8_BAR; PG8_SCHED;
            PG8_LDA(At, 0, 1); PG8_STAGE(PG8_SB(0, 0), b2, voffB); PG8_STAGE(PG8_SB(0, 1), b2 + hstep, voffB); PG8_STAGE(PG8_SA(0, 0), a2, voffA);
            PG8_WAIT_V(8); PG8_WAIT_L(0); PG8_BAR; PG8_MMA(1, 0, At, B0); PG8_MMA(1, 1, At, B1); PG8_BAR; PG8_SCHED;
            PG8_LDB(B0, 1, 0); PG8_LDB(B1, 1, 1); PG8_SCHED; PG8_LDA(At, 1, 0); PG8_STAGE(PG8_SA(0, 1), a2 + hstep, voffA);
            PG8_WAIT_V(8); PG8_WAIT_L(0); PG8_BAR; PG8_MMA(0, 0, At, B0); PG8_MMA(0, 1, At, B1); PG8_BAR; PG8_SCHED;
            PG8_LDA(At, 1, 1); PG8_STAGE(PG8_SB(1, 0), b3, voffB); PG8_STAGE(PG8_SB(1, 1), b3 + hstep, voffB); PG8_STAGE(PG8_SA(1, 0), a3, voffA);
            PG8_WAIT_V(8); PG8_WAIT_L(0); PG8_BAR; PG8_MMA(1, 0, At, B0); PG8_MMA(1, 1, At, B1); PG8_BAR; PG8_SCHED;
            } else {
            PG8_LDB(B0, 0, 0); PG8_SCHED; PG8_LDA(At, 0, 0); PG8_STAGE(PG8_SA(1, 1), a1 + hstep, voffA);
            PG8_WAIT_L(8); PG8_BAR; PG8_WAIT_L(0); PG8_MMA(0, 0, At, B0); PG8_BAR; PG8_SCHED;
            PG8_LDB(B1, 0, 1); PG8_STAGE(PG8_SB(0, 0), b2, voffB);
            PG8_BAR; PG8_WAIT_L(0); PG8_MMA(0, 1, At, B1); PG8_BAR;
            PG8_LDA(At, 0, 1); PG8_STAGE(PG8_SA(0, 0), a2, voffA);
            PG8_BAR; PG8_WAIT_L(0); PG8_MMA(1, 0, At, B0); PG8_BAR; PG8_SCHED;
            PG8_STAGE(PG8_SB(0, 1), b2 + hstep, voffB);
            PG8_WAIT_V(6); PG8_BAR; PG8_MMA(1, 1, At, B1); PG8_BAR;
            PG8_LDB(B0, 1, 0); PG8_SCHED; PG8_LDA(At, 1, 0); PG8_STAGE(PG8_SA(0, 1), a2 + hstep, voffA);
            PG8_WAIT_L(8); PG8_BAR; PG8_WAIT_L(0); PG8_MMA(0, 0, At, B0); PG8_BAR; PG8_SCHED;
            PG8_LDB(B1, 1, 1); PG8_STAGE(PG8_SB(1, 0), b3, voffB);
            PG8_BAR; PG8_WAIT_L(0); PG8_MMA(0, 1, At, B1); PG8_BAR;
            PG8_LDA(At, 1, 1); PG8_STAGE(PG8_SA(1, 0), a3, voffA);
            PG8_BAR; PG8_WAIT_L(0); PG8_MMA(1, 0, At, B0); PG8_BAR; PG8_SCHED;
            PG8_STAGE(PG8_SB(1, 1), b3 + hstep, voffB);
            PG8_WAIT_V(6); PG8_BAR; PG8_MMA(1, 1, At, B1); PG8_BAR;
            }
        }
        if constexpr (ALIGN_EPI) { if (wr == 0) PG8_BAR; }
        if constexpr (!Epi::AFTER_DRAIN) { E(acc, cur, wr, wc, fr, fq); S.done(cur); }
        if (!has_next) break;
#pragma unroll
        for (int a = 0; a < 2; ++a)
#pragma unroll
            for (int b = 0; b < 2; ++b)
#pragma unroll
                for (int m = 0; m < 4; ++m)
#pragma unroll
                    for (int n = 0; n < 2; ++n) acc[a][b][m][n] = (f32x4){0.f, 0.f, 0.f, 0.f};
        cur = nxt; cA = nA; cB = nB; ++ui;
        if constexpr (ALIGN_EPI) { if (wr == 1) PG8_BAR; }
    }
    PG8_WAIT_V(0);
    if constexpr (!ALIGN_EPI) { if (wr == 0) PG8_BAR; }
    PG8_BAR;
    if constexpr (Epi::AFTER_DRAIN) { E.fused(acc, cur, wr, wc, fr, fq, lds, wid, lane); S.done(cur); }
#undef PG8_SA
#undef PG8_SB
#undef PG8_STAGE
#undef PG8_LDA
#undef PG8_LDB
#undef PG8_MMA
#undef PG8_WAIT_V
#undef PG8_WAIT_L
#undef PG8_BAR
#undef PG8_SCHED
}
}
#define GAS __attribute__((address_space(1)))
#define LAS __attribute__((address_space(3)))
typedef unsigned short bf16;
typedef float f32x4 __attribute__((ext_vector_type(4)));
typedef float f32x2 __attribute__((ext_vector_type(2)));
typedef short bf16x8 __attribute__((ext_vector_type(8)));
typedef short bf16x4 __attribute__((ext_vector_type(4)));
typedef unsigned u32x4 __attribute__((ext_vector_type(4)));
typedef unsigned u32x2 __attribute__((ext_vector_type(2)));
#define MFMA16(a, b, c) __builtin_amdgcn_mfma_f32_16x16x32_bf16((a), (b), (c), 0, 0, 0)

constexpr int NWAVES = 8, NTHR = 512;
constexpr int DM = 1024, SEQ = 4096, NB = 4, MP = NB * SEQ, MS = 128, MALL = MP + MS, MPAD = 16640;
constexpr int DI = 2048, CONVD = 3072, NH = 32, NG = 4, NST = 128;
constexpr int NPROJ = 9984;
constexpr int DFF = 2816, DFF2 = 5632;
constexpr int NPAGES = 16, PAST = 2048;
constexpr float EPS = 1e-6f, NEGF = -1e30f, BIGF = 1e30f, TINYF = 1e-30f;
constexpr int T_Z = 0, T_XBC = 8, T_Q = 20, T_KV = 24, T_MG = 30, T_MISC = 38;

constexpr size_t O_YP = 0;
constexpr size_t O_YS = O_YP + (size_t)MP * DM;
constexpr size_t O_KVP = O_YS + (size_t)MS * DM;
constexpr size_t O_KVS = O_KVP + (size_t)MP * 1024;
constexpr size_t O_WINP = O_KVS + (size_t)MS * 1024;
constexpr size_t O_WINS = O_WINP + (size_t)NB * 512 * 512;
constexpr size_t O_SSMP = O_WINS + (size_t)MS * 512 * 512;
constexpr size_t O_SSMS = O_SSMP + (size_t)NB * NH * 64 * 128;
constexpr size_t O_CONVP = O_SSMS + (size_t)MS * NH * 64 * 128;
constexpr size_t O_CONVS = O_CONVP + (size_t)NB * 3 * CONVD;
constexpr size_t O_FFNP = O_CONVS + (size_t)MS * 3 * CONVD;
constexpr size_t O_FFNS = O_FFNP + (size_t)NB * 2 * DFF2;
constexpr size_t O_END = O_FFNS + (size_t)MS * 2 * DFF2;
static_assert(O_END == 105725952, "output size");

constexpr size_t al256(size_t x) { return (x + 255) & ~(size_t)255; }
constexpr size_t WS_CTL = 0, CTL_ZERO_BYTES = 1u << 20;
constexpr size_t WS_WIN = CTL_ZERO_BYTES;
constexpr size_t WS_WSSM = WS_WIN + al256((size_t)NPROJ * 1024 * 2);
constexpr size_t WS_WATT = WS_WSSM + al256((size_t)1024 * 2048 * 2);
constexpr size_t WS_WOUT = WS_WATT + al256((size_t)1024 * 1024 * 2);
constexpr size_t WS_WUP = WS_WOUT + al256((size_t)1024 * 1024 * 2);
constexpr size_t WS_WDN = WS_WUP + al256((size_t)DFF2 * 1024 * 2);
constexpr size_t WS_WADA = WS_WDN + al256((size_t)1024 * DFF * 2);
constexpr size_t WS_W1K = WS_WADA + al256((size_t)6144 * 1024 * 2);
constexpr size_t WS_W1V = WS_W1K + al256((size_t)256 * 1024 * 2);
constexpr size_t WS_SC = WS_W1V + al256((size_t)256 * 1024 * 2);
constexpr size_t WS_MOD = WS_SC + al256((size_t)256 * 1024 * 2);
constexpr size_t WS_ROPE = WS_MOD + al256((size_t)256 * 6144 * 4);
constexpr size_t WS_PET = WS_ROPE + al256((size_t)4096 * 16 * 4);
constexpr size_t WS_H = WS_PET + al256(2 * 128 * 4);
constexpr size_t WS_Z = WS_H + al256((size_t)MPAD * 1024 * 2);
constexpr size_t WS_XBC = WS_Z + al256((size_t)MPAD * 2048 * 2);
constexpr size_t WS_Q = WS_XBC + al256((size_t)MPAD * 3072 * 2);
constexpr size_t WS_MG = WS_Q + al256((size_t)MPAD * 1024 * 2);
constexpr size_t WS_MISC = WS_MG + al256((size_t)MPAD * 2048 * 2);
constexpr size_t WS_KVH = WS_MISC + al256((size_t)MPAD * 128 * 4);
constexpr size_t WS_VT = WS_KVH + al256((size_t)6 * 16 * 4096 * 64 * 2);
constexpr size_t WS_XT = WS_VT + al256((size_t)2 * 16 * 64 * 4096 * 2);
constexpr size_t WS_BN = WS_XT + al256((size_t)4 * 32 * 64 * 4096 * 2);
constexpr size_t WS_CN = WS_BN + al256((size_t)16 * 4096 * 128 * 2);
constexpr size_t WS_BT = WS_CN + al256((size_t)16 * 4096 * 128 * 2);
constexpr size_t WS_DT = WS_BT + al256((size_t)16 * 4096 * 128 * 2);
constexpr size_t WS_CS = WS_DT + al256((size_t)128 * 4096 * 4);
constexpr size_t WS_STATES = WS_CS + al256((size_t)128 * 4096 * 4);
constexpr size_t WS_HPREV = WS_STATES + al256((size_t)4096 * 8192 * 4);
constexpr size_t WS_YSSM = WS_HPREV + al256((size_t)4096 * 8192 * 2);
constexpr size_t WS_SSQ = WS_YSSM + al256((size_t)MPAD * 2048 * 2);
constexpr size_t WS_PARTK = WS_SSQ + al256((size_t)MPAD * 4 * 4);
constexpr size_t WS_PARTV = WS_PARTK + al256((size_t)4096 * 256 * 4);
constexpr size_t WS_KC = WS_PARTV + al256((size_t)4096 * 256 * 4);
constexpr size_t WS_VCT = WS_KC + al256((size_t)16 * 256 * 64 * 2);
constexpr size_t WS_YATTF = WS_VCT + al256((size_t)16 * 256 * 64 * 2);
constexpr size_t WS_YATT = WS_YATTF + al256((size_t)MPAD * 1024 * 4);
constexpr size_t WS_TMPM = WS_YATT + al256((size_t)MPAD * 1024 * 2);
constexpr size_t WS_MERGED = WS_TMPM + al256((size_t)MPAD * 1024 * 4);
constexpr size_t WS_X1 = WS_MERGED + al256((size_t)MPAD * 1024 * 2);
constexpr size_t WS_U = WS_X1 + al256((size_t)MPAD * 1024 * 4);
constexpr size_t WS_ACT = WS_U + al256((size_t)MPAD * DFF2 * 2);
constexpr size_t WS_CKB = WS_ACT + al256((size_t)MPAD * DFF * 2);
constexpr size_t WS_CVB = WS_CKB + al256((size_t)128 * 4 * 2048 * 64 * 2);
constexpr size_t WS_PARTSK = WS_CVB + al256((size_t)128 * 4 * 2048 * 64 * 2);
constexpr size_t WS_PARTSV = WS_PARTSK + al256((size_t)65536 * 256 * 4);
constexpr size_t WS_KCS = WS_PARTSV + al256((size_t)65536 * 256 * 4);
constexpr size_t WS_VCS = WS_KCS + al256((size_t)128 * 4 * 128 * 64 * 4);
constexpr size_t WS_XCS = WS_VCS + al256((size_t)128 * 4 * 128 * 64 * 4);
constexpr size_t WS_DTS = WS_XCS + al256((size_t)128 * 3072 * 4);
constexpr size_t WS_W2T = WS_DTS + al256((size_t)128 * 32 * 4);
constexpr size_t WS_PARTB = WS_W2T + al256((size_t)2 * 64 * 128 * 2);
constexpr size_t WS_END = WS_PARTB + al256((size_t)2 * 128 * 4 * 4 * 2 * 128 * 2);

constexpr int CW_BAR = 4096;

constexpr int RING_BYTES = 131072;
constexpr int LDSCTL_OFF = RING_BYTES, MISC_OFF = LDSCTL_OFF + 320;
constexpr int LDS_BYTES = 147456;

__device__ __forceinline__ unsigned f2bf(float f) { unsigned u = __builtin_bit_cast(unsigned, f); return (u + 0x7fffu + ((u >> 16) & 1u)) >> 16; }
__device__ __forceinline__ unsigned pk2(float lo, float hi) { return pg8::cvt_pk_bf16(lo, hi); }
typedef __bf16 bf16x2_t __attribute__((ext_vector_type(2)));
__device__ __forceinline__ unsigned pk2c(float lo, float hi) { const f32x2 v = {lo, hi}; return __builtin_bit_cast(unsigned, __builtin_convertvector(v, bf16x2_t)); }
__device__ __forceinline__ float bf2f(unsigned h) { return __builtin_bit_cast(float, h << 16); }
__device__ __forceinline__ float bflo(unsigned w) { return __builtin_bit_cast(float, w << 16); }
__device__ __forceinline__ float bfhi(unsigned w) { return __builtin_bit_cast(float, w & 0xffff0000u); }
__device__ __forceinline__ float wave_sum(float v) {
#pragma unroll
    for (int o = 1; o < 64; o <<= 1) v += __shfl_xor(v, o);
    return v;
}
__device__ __forceinline__ float siluf(float x) { return x / (1.f + __expf(-x)); }
__device__ __forceinline__ float sigmf(float x) { return 1.f / (1.f + __expf(-x)); }
__device__ __forceinline__ float softplusf(float x) { return x > 20.f ? x : log1pf(__expf(x)); }
#define LDS_WAIT() asm volatile("s_waitcnt lgkmcnt(0)" ::: "memory")

struct Args { const void* in[35]; float* out; unsigned char* ws; int ph_lo, ph_hi, p7mask, pad; };
#define INF(i) ((const float*)args.in[i])
#define XB_TMO      128
#define XB_XCNT(j)  (256  + 64 * (j))
#define XB_XSUB(j)  (1280 + 64 * (j))
#define XB_XGEN(j)  (2304 + 64 * (j))
#define XB_TOP      3328
#define XB_TOPGEN   3392
#define XCD_BAR_WORDS 3456
#define XB_SPIN_CAP (1u << 18)

__device__ __forceinline__ unsigned xb_ld(unsigned* p)              { return __hip_atomic_load(p, __ATOMIC_RELAXED, __HIP_MEMORY_SCOPE_AGENT); }
__device__ __forceinline__ unsigned xb_add(unsigned* p, unsigned v) { return __hip_atomic_fetch_add(p, v, __ATOMIC_RELAXED, __HIP_MEMORY_SCOPE_AGENT); }
__device__ __forceinline__ unsigned xb_xcc_id() { return (unsigned)__builtin_amdgcn_s_getreg((3 << 11) | 20) & 0xFu; }
#define XB_SPIN(cond, bar) do { unsigned _sp = 0; while (cond) { __builtin_amdgcn_s_sleep(1); \
    if ((++_sp & 255u) == 0u) { if (xb_ld(&(bar)[XB_TMO])) break; if (_sp > XB_SPIN_CAP) { atomicAdd(&(bar)[XB_TMO], 1u); break; } } } } while (0)

struct XcdBarrier {
    unsigned* bar; unsigned x;
    volatile LAS unsigned* st;
};

__device__ __forceinline__ XcdBarrier xcd_barrier_post(unsigned* bar, volatile LAS unsigned* st) {
    XcdBarrier b; b.bar = bar; b.x = xb_xcc_id(); b.st = st;
    if (threadIdx.x == 0) (void)xb_add(&bar[XB_XCNT(b.x)], 1u);
    return b;
}
__device__ __forceinline__ void xcd_barrier_complete(unsigned* bar, unsigned x, unsigned& nloc, unsigned& nx) {
    const unsigned G = gridDim.x * gridDim.y * gridDim.z;
    unsigned sum, cnt, mine, sp = 0u;
    for (;;) {
        sum = 0u; cnt = 0u; mine = 0u;
#pragma unroll
        for (unsigned j = 0; j < 16; ++j) { const unsigned c = xb_ld(&bar[XB_XCNT(j)]); sum += c; cnt += (c > 0u) ? 1u : 0u; mine = (j == x) ? c : mine; }
        if (sum == G) break;
        __builtin_amdgcn_s_sleep(1);
        if ((++sp & 255u) == 0u) { if (xb_ld(&bar[XB_TMO])) break; if (sp > XB_SPIN_CAP) { atomicAdd(&bar[XB_TMO], 1u); break; } }
    }
    nloc = mine > 0u ? mine : 1u; nx = cnt > 0u ? cnt : 1u;
}

__device__ __forceinline__ void xcd_barrier(const XcdBarrier& b) {
    asm volatile("s_waitcnt vmcnt(0)" ::: "memory");
    __syncthreads();
    if (threadIdx.x == 0) {
        unsigned* bar = b.bar;
        __builtin_amdgcn_s_waitcnt(0);
        unsigned nloc = b.st[0], nx = b.st[1];
        if (nloc == 0u) { xcd_barrier_complete(bar, b.x, nloc, nx); b.st[0] = nloc; b.st[1] = nx; }
        const unsigned old = xb_add(&bar[XB_XSUB(b.x)], 1u);
        const unsigned gen = old / nloc;
        if (old + 1u == (gen + 1u) * nloc) {
            __builtin_amdgcn_fence(__ATOMIC_RELEASE, "agent");
            asm volatile("s_waitcnt vmcnt(0)" ::: "memory");
            const unsigned og = xb_add(&bar[XB_TOP], 1u);
            const unsigned tg = og / nx;
            if (og + 1u == (tg + 1u) * nx) xb_add(&bar[XB_TOPGEN], 1u);
            else XB_SPIN(xb_ld(&bar[XB_TOPGEN]) == tg, bar);
            __builtin_amdgcn_fence(__ATOMIC_ACQUIRE, "agent");
            xb_add(&bar[XB_XGEN(b.x)], 1u);
            asm volatile("s_waitcnt vmcnt(0)" ::: "memory");
        } else {
            XB_SPIN(xb_ld(&bar[XB_XGEN(b.x)]) == gen, bar);
            __builtin_amdgcn_fence(__ATOMIC_ACQUIRE, "agent");
            asm volatile("s_waitcnt vmcnt(0)" ::: "memory");
        }
    }
    __syncthreads();
}
__device__ __forceinline__ int inproj_src_col(int n) {
    if (n < 5120) return n;
    if (n < 6144) return n - 5120 + 5152;
    if (n < 7680) return n - 6144 + 6176;
    if (n < 9728) return n - 7680 + 7760;
    const int i = n - 9728;
    if (i < 32) return 5120 + i;
    if (i < 80) return 7712 + (i - 32);
    return -1;
}
template <int MODE>
__device__ __forceinline__ void transpose_item(const float* W, int K, int ldw, int nblk, bf16* WT, int row_off, LAS float* scr, int item, int lane) {
    const int kb = item / nblk, nb = item % nblk, k0 = 32 * kb, n0 = 64 * nb;
    const int kr = lane >> 4, nc = lane & 15, n = n0 + 4 * nc;
    const int sc = (MODE == 1) ? inproj_src_col(n) : n;
    f32x4 v[8];
#pragma unroll
    for (int i = 0; i < 8; ++i) v[i] = (sc >= 0) ? *(const f32x4*)(W + (size_t)(k0 + 4 * i + kr) * ldw + sc) : (f32x4){0.f, 0.f, 0.f, 0.f};
#pragma unroll
    for (int i = 0; i < 8; ++i) { LAS float* d = scr + (4 * i + kr) * 65 + 4 * nc; d[0] = v[i].x; d[1] = v[i].y; d[2] = v[i].z; d[3] = v[i].w; }
    LDS_WAIT(); asm volatile("" ::: "memory");
    const int c = lane & 3;
#pragma unroll
    for (int j = 0; j < 4; ++j) { const int nn = (lane >> 2) + 16 * j; const LAS float* s = scr + (8 * c) * 65 + nn;
        u32x4 o; o.x = pk2(s[0 * 65], s[1 * 65]); o.y = pk2(s[2 * 65], s[3 * 65]); o.z = pk2(s[4 * 65], s[5 * 65]); o.w = pk2(s[6 * 65], s[7 * 65]);
        *(u32x4*)(WT + (size_t)(row_off + n0 + nn) * K + k0 + 8 * c) = o; }
    LDS_WAIT(); asm volatile("" ::: "memory");
}

__device__ __forceinline__ void p0_prologue(const Args& args, LAS unsigned char* lds, int gw, int NGW, int lane, int wave) {
    unsigned char* ws = args.ws;
    const int p0m = args.pad;
    LAS float* scr = (LAS float*)(lds + wave * 16384);
    constexpr int I_IN = 16 * (NPROJ / 32), I_SSM = 32 * 32, I_ATT = 16 * 32, I_OUT = 16 * 32, I_UP = 16 * (DFF2 / 32), I_DN = (DFF / 64) * 32, I_ADA = 16 * (6144 / 32), I_W1 = 16 * 4;
    constexpr int NITEMS = I_IN + I_SSM + I_ATT + I_OUT + I_UP + I_DN + I_ADA + 4 * I_W1;
    if (p0m & 1) for (int it = gw; it < NITEMS; it += NGW) {
        int r = it;
        if (r < I_ADA) { transpose_item<0>(INF(10), 1024, 6144, 6144 / 64, (bf16*)(ws + WS_WADA), 0, scr, r, lane); continue; } r -= I_ADA;
        if (r < I_IN) { transpose_item<1>(INF(15), 1024, 9808, NPROJ / 64, (bf16*)(ws + WS_WIN), 0, scr, r, lane); continue; } r -= I_IN;
        if (r < I_SSM) { transpose_item<0>(INF(28), 2048, 1024, 16, (bf16*)(ws + WS_WSSM), 0, scr, r, lane); continue; } r -= I_SSM;
        if (r < I_ATT) { transpose_item<0>(INF(29), 1024, 1024, 16, (bf16*)(ws + WS_WATT), 0, scr, r, lane); continue; } r -= I_ATT;
        if (r < I_OUT) { transpose_item<0>(INF(30), 1024, 1024, 16, (bf16*)(ws + WS_WOUT), 0, scr, r, lane); continue; } r -= I_OUT;
        if (r < I_UP) { transpose_item<0>(INF(31), 1024, DFF2, DFF2 / 64, (bf16*)(ws + WS_WUP), 0, scr, r, lane); continue; } r -= I_UP;
        if (r < I_DN) { transpose_item<0>(INF(34), DFF, 1024, 16, (bf16*)(ws + WS_WDN), 0, scr, r, lane); continue; } r -= I_DN;
        { const int which = r / I_W1, rr = r % I_W1; const int st = which >> 1, r2 = which & 1;
          transpose_item<0>(INF(st ? 26 : 23) + (size_t)r2 * 16 * 64 * 128, 1024, 128, 2, (bf16*)(ws + (st ? WS_W1V : WS_W1K)), r2 * 128, scr, rr, lane); }
    }
    if (p0m & 4) {
    for (int r = gw; r < 256; r += NGW) {
        bf16* o = (bf16*)(ws + WS_SC) + (size_t)r * 1024;
        const float* src = r < 4 ? INF(2) + (size_t)r * 1024 : (r < 132 ? INF(3) + (size_t)(r - 4) * 1024 : nullptr);
#pragma unroll
        for (int j = 0; j < 4; ++j) { const int c0 = (j * 64 + lane) * 4; f32x4 v = src ? *(const f32x4*)(src + c0) : (f32x4){0.f, 0.f, 0.f, 0.f};
            u32x2 w; w.x = pk2(src ? siluf(v.x) : 0.f, src ? siluf(v.y) : 0.f); w.y = pk2(src ? siluf(v.z) : 0.f, src ? siluf(v.w) : 0.f); *(u32x2*)(o + c0) = w; }
    }
    for (int i = gw * 64 + lane; i < 4096 * 8; i += NGW * 64) {
        const int pos = i >> 3, k = i & 7;
        const float invf[8] = {1.0f, 0.1939227432012558f, 0.03760603070259094f, 0.007292664609849453f, 0.0014142135623842478f, 0.00027424818836152554f, 5.318296098266728e-05f, 1.0313386155758053e-05f};
        float fr = 1.0f;
#pragma unroll
        for (int q = 0; q < 8; ++q) fr = (k == q) ? invf[q] : fr;
        const float ang = (float)pos * fr;
        const double ad = (double)ang, rev = ad * 0.15915494309189535;
        const float fracrev = (float)(rev - __builtin_floor(rev));
        float* o = (float*)(ws + WS_ROPE) + (size_t)pos * 16;
        o[k] = __builtin_amdgcn_cosf(fracrev); o[8 + k] = __builtin_amdgcn_sinf(fracrev);
    }
    for (int it = gw; it < 256; it += NGW) {
        const int st = it >> 7, e = it & 127; const float* pe = INF(st ? 25 : 22); const float* w1 = INF(st ? 26 : 23);
        float s = 0.f;
        for (int i = 0; i < 32; ++i) { const int idx = lane + 64 * i; s += pe[idx] * w1[(size_t)idx * 128 + e]; }
        s = wave_sum(s);
        if (lane == 0) ((float*)(ws + WS_PET))[it] = s;
    }
    }
    if (p0m & 4) for (int i = gw * 64 + lane; i < 2 * 64 * 128; i += NGW * 64) { const int st = i >> 13, d = (i >> 7) & 63, e = i & 127;
        ((bf16*)(ws + WS_W2T))[i] = (bf16)f2bf(INF(st ? 27 : 24)[e * 64 + d]); }
}

template <int WHICH>
__device__ __forceinline__ void norm_mod_phase(const Args& args, int gw, int NGW, int lane) {
    unsigned char* ws = args.ws; const float* MOD = (const float*)(ws + WS_MOD); bf16* H = (bf16*)(ws + WS_H);
    const float* nw = INF(WHICH == 0 ? 12 : (WHICH == 1 ? 13 : 14));
    constexpr int SH = WHICH ? 3072 : 0, SCo = WHICH ? 4096 : 1024;
    for (int grp = gw; grp < MPAD / 4; grp += NGW) {
        const int m0 = grp * 4;
        if (m0 >= MALL) {
            if (WHICH < 2) {
#pragma unroll
                for (int r = 0; r < 4; ++r)
#pragma unroll
                    for (int j = 0; j < 4; ++j) ((u32x2*)(H + (size_t)(m0 + r) * 1024))[j * 64 + lane] = (u32x2){0u, 0u};
            }
            continue; }
        f32x4 v[4][4]; float ss[4];
#pragma unroll
        for (int r = 0; r < 4; ++r) { const int m = m0 + r;
            const float* xr = WHICH ? (const float*)(ws + WS_X1) + (size_t)m * 1024 : (m < MP ? INF(0) + (size_t)m * 1024 : INF(1) + (size_t)(m - MP) * 1024);
            float s = 0.f;
#pragma unroll
            for (int j = 0; j < 4; ++j) { v[r][j] = *(const f32x4*)(xr + (j * 64 + lane) * 4); s += (v[r][j].x * v[r][j].x + v[r][j].y * v[r][j].y) + (v[r][j].z * v[r][j].z + v[r][j].w * v[r][j].w); }
            ss[r] = s; }
#pragma unroll
        for (int o = 1; o < 64; o <<= 1)
#pragma unroll
            for (int r = 0; r < 4; ++r) ss[r] += __shfl_xor(ss[r], o);
        f32x4 w[4];
#pragma unroll
        for (int j = 0; j < 4; ++j) w[j] = *(const f32x4*)(nw + (j * 64 + lane) * 4);
#pragma unroll
        for (int r = 0; r < 4; ++r) { const int m = m0 + r;
            const float rstd = 1.f / sqrtf(ss[r] * (1.f / 1024.f) + EPS);
            if (WHICH == 2) { float* o = args.out + (m < MP ? O_YP + (size_t)m * 1024 : O_YS + (size_t)(m - MP) * 1024);
#pragma unroll
                for (int j = 0; j < 4; ++j) *(f32x4*)(o + (j * 64 + lane) * 4) = (v[r][j] * rstd) * w[j];
            } else {
                const float* mr = MOD + (size_t)(m < MP ? (m >> 12) : 4 + (m - MP)) * 6144;
                u32x2* o = (u32x2*)(H + (size_t)m * 1024);
#pragma unroll
                for (int j = 0; j < 4; ++j) { const int c0 = (j * 64 + lane) * 4;
                    const f32x4 sc = *(const f32x4*)(mr + SCo + c0), sh = *(const f32x4*)(mr + SH + c0);
                    const f32x4 rr = (v[r][j] * rstd) * w[j] * (sc + 1.f) + sh;
                    u32x2 pk; pk.x = pk2(rr.x, rr.y); pk.y = pk2(rr.z, rr.w); o[j * 64 + lane] = pk; }
            }
        }
    }
}
namespace epi {
using pg8::Unit; using pg8::f32x4;
typedef unsigned u32x4 __attribute__((ext_vector_type(4)));
__device__ __forceinline__ u32x4 pack8(const f32x4& a, const f32x4& b) { u32x4 w; w.x = pg8::cvt_pk_bf16(a[0], a[1]); w.y = pg8::cvt_pk_bf16(a[2], a[3]); w.z = pg8::cvt_pk_bf16(b[0], b[1]); w.w = pg8::cvt_pk_bf16(b[2], b[3]); return w; }

struct InProj {
    static constexpr bool PERM = true, AFTER_DRAIN = false;
    unsigned char* ws; float* out;
    __device__ __forceinline__ void operator()(const f32x4 (&acc)[2][2][4][2], const Unit& u, int wr, int wc, int fr, int fq) const {
        const int pn = u.pn;
        const int rowb = u.pm * 256 + wr * 64 + fr;
        const int cl = wc * 32 + 8 * fq;
        if (pn < T_XBC || (pn >= T_MG && pn < T_MISC)) {
            bf16* base = pn < T_XBC ? (bf16*)(ws + WS_Z) : (bf16*)(ws + WS_MG);
            const int colt = (pn < T_XBC ? pn : pn - T_MG) * 256 + cl;
#pragma unroll
            for (int ai = 0; ai < 2; ++ai)
#pragma unroll
                for (int m = 0; m < 4; ++m) { const int row = rowb + ai * 128 + m * 16;
#pragma unroll
                    for (int bj = 0; bj < 2; ++bj) *(u32x4*)(base + (size_t)row * 2048 + colt + bj * 128) = pack8(acc[ai][bj][m][0], acc[ai][bj][m][1]); }
        } else if (pn < T_Q) {
            bf16* base = (bf16*)(ws + WS_XBC); const int colt = (pn - T_XBC) * 256 + cl;
#pragma unroll
            for (int ai = 0; ai < 2; ++ai)
#pragma unroll
                for (int m = 0; m < 4; ++m) { const int row = rowb + ai * 128 + m * 16;
                    float* fo = nullptr;
                    if (row < MP) { const int t = row & 4095; if (t >= 4093) fo = out + O_CONVP + ((size_t)(row >> 12) * 3 + (t - 4093)) * CONVD; }
                    else if (row < MALL) fo = out + O_CONVS + ((size_t)(row - MP) * 3 + 2) * CONVD;
#pragma unroll
                    for (int bj = 0; bj < 2; ++bj) { const int col = colt + bj * 128;
                        *(u32x4*)(base + (size_t)row * CONVD + col) = pack8(acc[ai][bj][m][0], acc[ai][bj][m][1]);
                        if (fo) { *(f32x4*)(fo + col) = acc[ai][bj][m][0]; *(f32x4*)(fo + col + 4) = acc[ai][bj][m][1]; } } }
        } else if (pn < T_MG) {
            const bool isq = pn < T_KV; const int s = pn - T_KV;
            const bool dorope = (isq || !(s & 1)) && !(wc & 1);
            const float* rope = (const float*)(ws + WS_ROPE);
#pragma unroll
            for (int ai = 0; ai < 2; ++ai)
#pragma unroll
                for (int m = 0; m < 4; ++m) { const int row = rowb + ai * 128 + m * 16;
                    const int pos = row < MP ? (row & 4095) : PAST;
#pragma unroll
                    for (int bj = 0; bj < 2; ++bj) {
                        f32x4 v0 = acc[ai][bj][m][0], v1 = acc[ai][bj][m][1];
                        if (dorope) {
                            f32x4 o0, o1;
#pragma unroll
                            for (int i = 0; i < 4; ++i) { o0[i] = __shfl_xor(v0[i], 16); o1[i] = __shfl_xor(v1[i], 16); }
                            if (fq < 2) {
                                const f32x4 c0 = *(const f32x4*)(rope + pos * 16), c1 = *(const f32x4*)(rope + pos * 16 + 4), s0 = *(const f32x4*)(rope + pos * 16 + 8), s1 = *(const f32x4*)(rope + pos * 16 + 12);
                                if (fq == 0) { v0 = v0 * c0 - o0 * s0; v1 = v1 * c1 - o1 * s1; }
                                else         { v0 = v0 * c0 + o0 * s0; v1 = v1 * c1 + o1 * s1; }
                            }
                        }
                        const int col = cl + bj * 128;
                        const u32x4 pk = pack8(v0, v1);
                        if (isq) { *(u32x4*)((bf16*)(ws + WS_Q) + (size_t)row * 1024 + (pn - T_Q) * 256 + col) = pk; }
                        else {
                            const int h = col >> 6, d = col & 63;
                            if (row < MP) {
                                const int b = row >> 12, t = row & 4095;
                                *(u32x4*)((bf16*)(ws + WS_KVH) + ((((size_t)s * 4 + b) * 4 + h) * 4096 + t) * 64 + d) = pk;
                                if (s < 4) { float* fo = out + O_KVP + ((size_t)row * 4 + s) * 256 + col; *(f32x4*)fo = v0; *(f32x4*)(fo + 4) = v1; }
                                else if (t >= 3584) { float* fo = out + O_WINP + (((size_t)b * 512 + (t - 3584)) * 2 + (s - 4)) * 256 + col; *(f32x4*)fo = v0; *(f32x4*)(fo + 4) = v1; }
                                if (s == 3 || s == 5) {
                                    const int kk = t & 31, kpos = 8 * ((kk & 15) >> 2) + 4 * (kk >> 4) + (kk & 3);
                                    bf16* vt = (bf16*)(ws + WS_VT) + ((((size_t)(s == 5) * 4 + b) * 4 + h) * 128 + (t >> 5)) * 2048 + d * 32 + kpos;
                                    vt[0 * 32] = (bf16)(pk.x & 0xffffu); vt[1 * 32] = (bf16)(pk.x >> 16); vt[2 * 32] = (bf16)(pk.y & 0xffffu); vt[3 * 32] = (bf16)(pk.y >> 16);
                                    vt[4 * 32] = (bf16)(pk.z & 0xffffu); vt[5 * 32] = (bf16)(pk.z >> 16); vt[6 * 32] = (bf16)(pk.w & 0xffffu); vt[7 * 32] = (bf16)(pk.w >> 16);
                                }
                            } else if (row < MALL) {
                                const int bs = row - MP;
                                float* fo = s < 4 ? out + O_KVS + ((size_t)bs * 4 + s) * 256 + col : out + O_WINS + (((size_t)bs * 512 + 511) * 2 + (s - 4)) * 256 + col;
                                *(f32x4*)fo = v0; *(f32x4*)(fo + 4) = v1;
                            }
                        }
                    } }
        } else {
            float* base = (float*)(ws + WS_MISC);
#pragma unroll
            for (int ai = 0; ai < 2; ++ai)
#pragma unroll
                for (int m = 0; m < 4; ++m) { const int row = rowb + ai * 128 + m * 16;
                    *(f32x4*)(base + (size_t)row * 128 + cl) = acc[ai][0][m][0]; *(f32x4*)(base + (size_t)row * 128 + cl + 4) = acc[ai][0][m][1]; }
        }
    }
};

struct Merge1 {
    static constexpr bool PERM = true, AFTER_DRAIN = false;
    unsigned char* ws;
    __device__ __forceinline__ void operator()(const f32x4 (&acc)[2][2][4][2], const Unit& u, int wr, int wc, int fr, int fq) const {
        const int rowb = u.pm * 256 + wr * 64 + fr, colb = u.pn * 256 + wc * 32 + 8 * fq;
        const bf16* MG = (const bf16*)(ws + WS_MG); const float* SSQ = (const float*)(ws + WS_SSQ); float* T = (float*)(ws + WS_TMPM);
#pragma unroll
        for (int ai = 0; ai < 2; ++ai)
#pragma unroll
            for (int m = 0; m < 4; ++m) { const int row = rowb + ai * 128 + m * 16;
                const f32x4 sq = *(const f32x4*)(SSQ + (size_t)row * 4);
                const float rstd = 1.f / sqrtf(((sq.x + sq.y) + (sq.z + sq.w)) * (1.f / 2048.f) + EPS);
#pragma unroll
                for (int bj = 0; bj < 2; ++bj) { const int col = colb + bj * 128;
                    const u32x4 g = *(const u32x4*)(MG + (size_t)row * 2048 + col);
                    f32x4 o0, o1;
                    o0[0] = sigmf(bflo(g.x)) * rstd * acc[ai][bj][m][0][0]; o0[1] = sigmf(bfhi(g.x)) * rstd * acc[ai][bj][m][0][1];
                    o0[2] = sigmf(bflo(g.y)) * rstd * acc[ai][bj][m][0][2]; o0[3] = sigmf(bfhi(g.y)) * rstd * acc[ai][bj][m][0][3];
                    o1[0] = sigmf(bflo(g.z)) * rstd * acc[ai][bj][m][1][0]; o1[1] = sigmf(bfhi(g.z)) * rstd * acc[ai][bj][m][1][1];
                    o1[2] = sigmf(bflo(g.w)) * rstd * acc[ai][bj][m][1][2]; o1[3] = sigmf(bfhi(g.w)) * rstd * acc[ai][bj][m][1][3];
                    *(f32x4*)(T + (size_t)row * 1024 + col) = o0; *(f32x4*)(T + (size_t)row * 1024 + col + 4) = o1; } }
    }
};
struct Merge2 {
    static constexpr bool PERM = true, AFTER_DRAIN = false;
    unsigned char* ws;
    __device__ __forceinline__ void operator()(const f32x4 (&acc)[2][2][4][2], const Unit& u, int wr, int wc, int fr, int fq) const {
        const int rowb = u.pm * 256 + wr * 64 + fr, colb = u.pn * 256 + wc * 32 + 8 * fq;
        const bf16* MG = (const bf16*)(ws + WS_MG); const float* T = (const float*)(ws + WS_TMPM); bf16* O = (bf16*)(ws + WS_MERGED);
#pragma unroll
        for (int ai = 0; ai < 2; ++ai)
#pragma unroll
            for (int m = 0; m < 4; ++m) { const int row = rowb + ai * 128 + m * 16;
#pragma unroll
                for (int bj = 0; bj < 2; ++bj) { const int col = colb + bj * 128;
                    const u32x4 g = *(const u32x4*)(MG + (size_t)row * 2048 + 1024 + col);
                    f32x4 o0 = *(const f32x4*)(T + (size_t)row * 1024 + col), o1 = *(const f32x4*)(T + (size_t)row * 1024 + col + 4);
                    o0[0] += sigmf(bflo(g.x)) * acc[ai][bj][m][0][0]; o0[1] += sigmf(bfhi(g.x)) * acc[ai][bj][m][0][1];
                    o0[2] += sigmf(bflo(g.y)) * acc[ai][bj][m][0][2]; o0[3] += sigmf(bfhi(g.y)) * acc[ai][bj][m][0][3];
                    o1[0] += sigmf(bflo(g.z)) * acc[ai][bj][m][1][0]; o1[1] += sigmf(bfhi(g.z)) * acc[ai][bj][m][1][1];
                    o1[2] += sigmf(bflo(g.w)) * acc[ai][bj][m][1][2]; o1[3] += sigmf(bfhi(g.w)) * acc[ai][bj][m][1][3];
                    *(u32x4*)(O + (size_t)row * 1024 + col) = pack8(o0, o1); } }
    }
};
struct Resid {
    static constexpr bool PERM = false, AFTER_DRAIN = false;
    const float* xp; const float* xs; const float* x1in; float* x1out; const float* MOD; int goff;
    __device__ __forceinline__ void operator()(const f32x4 (&acc)[2][2][4][2], const Unit& u, int wr, int wc, int fr, int fq) const {
        const int rowb = u.pm * 256 + wr * 64 + fr, colb = u.pn * 256 + wc * 32 + 4 * fq;
#pragma unroll
        for (int ai = 0; ai < 2; ++ai)
#pragma unroll
            for (int m = 0; m < 4; ++m) { const int row = rowb + ai * 128 + m * 16;
                if (row >= MALL) continue;
                const float* base = x1in ? x1in + (size_t)row * 1024 : (row < MP ? xp + (size_t)row * 1024 : xs + (size_t)(row - MP) * 1024);
                const float* gr = MOD + (size_t)(row < MP ? (row >> 12) : 4 + (row - MP)) * 6144 + goff;
#pragma unroll
                for (int bj = 0; bj < 2; ++bj)
#pragma unroll
                    for (int n = 0; n < 2; ++n) { const int col = colb + bj * 128 + n * 16;
                        *(f32x4*)(x1out + (size_t)row * 1024 + col) = *(const f32x4*)(base + col) + *(const f32x4*)(gr + col) * acc[ai][bj][m][n]; } }
    }
};
struct Up {
    static constexpr bool PERM = true, AFTER_DRAIN = false;
    unsigned char* ws; float* out;
    __device__ __forceinline__ void operator()(const f32x4 (&acc)[2][2][4][2], const Unit& u, int wr, int wc, int fr, int fq) const {
        const int rowb = u.pm * 256 + wr * 64 + fr, colb = u.pn * 256 + wc * 32 + 8 * fq;
        bf16* U = (bf16*)(ws + WS_U);
#pragma unroll
        for (int ai = 0; ai < 2; ++ai)
#pragma unroll
            for (int m = 0; m < 4; ++m) { const int row = rowb + ai * 128 + m * 16;
                float* fo = nullptr;
                if (row < MP) { const int t = row & 4095; if (t >= 4094) fo = out + O_FFNP + ((size_t)(row >> 12) * 2 + (t - 4094)) * DFF2; }
                else if (row < MALL) fo = out + O_FFNS + ((size_t)(row - MP) * 2 + 1) * DFF2;
#pragma unroll
                for (int bj = 0; bj < 2; ++bj) { const int col = colb + bj * 128;
                    *(u32x4*)(U + (size_t)row * DFF2 + col) = pack8(acc[ai][bj][m][0], acc[ai][bj][m][1]);
                    if (fo) { *(f32x4*)(fo + col) = acc[ai][bj][m][0]; *(f32x4*)(fo + col + 4) = acc[ai][bj][m][1]; } } }
    }
};
struct PartBf16 {
    static constexpr bool PERM = true, AFTER_DRAIN = false;
    bf16* P;
    __device__ __forceinline__ void operator()(const f32x4 (&acc)[2][2][4][2], const Unit& u, int wr, int wc, int fr, int fq) const {
        const int rowb = u.pm * 256 + wr * 64 + fr, colb = wc * 32 + 8 * fq;
#pragma unroll
        for (int ai = 0; ai < 2; ++ai)
#pragma unroll
            for (int m = 0; m < 4; ++m) { const int row = rowb + ai * 128 + m * 16;
#pragma unroll
                for (int bj = 0; bj < 2; ++bj) *(u32x4*)(P + (size_t)row * 256 + colb + bj * 128) = pack8(acc[ai][bj][m][0], acc[ai][bj][m][1]); }
    }
};
}
__device__ __forceinline__ void conv_prompt_item(const Args& args, int item, int lane) {
    unsigned char* ws = args.ws;
    const int tg = item / 48, cgp = item % 48, cg = lane & 7, rg = lane >> 3;
    const int m0 = tg * 64 + 8 * rg, b = m0 >> 12, t0 = m0 & 4095, ch0 = cgp * 64 + 8 * cg;
    const bf16* X = (const bf16*)(ws + WS_XBC);
    float x[11][8];
#pragma unroll
    for (int i = 0; i < 11; ++i) {
        const int t = t0 - 3 + i;
        u32x4 v = (u32x4){0u, 0u, 0u, 0u};
        if (t >= 0) v = *(const u32x4*)(X + (size_t)(m0 - 3 + i) * CONVD + ch0);
        x[i][0] = bflo(v.x); x[i][1] = bfhi(v.x); x[i][2] = bflo(v.y); x[i][3] = bfhi(v.y); x[i][4] = bflo(v.z); x[i][5] = bfhi(v.z); x[i][6] = bflo(v.w); x[i][7] = bfhi(v.w);
    }
    const float* cw = INF(16); const float* cb = INF(17);
    float w[4][8], bias[8];
#pragma unroll
    for (int k = 0; k < 4; ++k) { const f32x4 a = *(const f32x4*)(cw + k * CONVD + ch0), c = *(const f32x4*)(cw + k * CONVD + ch0 + 4);
        w[k][0] = a.x; w[k][1] = a.y; w[k][2] = a.z; w[k][3] = a.w; w[k][4] = c.x; w[k][5] = c.y; w[k][6] = c.z; w[k][7] = c.w; }
    { const f32x4 a = *(const f32x4*)(cb + ch0), c = *(const f32x4*)(cb + ch0 + 4); bias[0] = a.x; bias[1] = a.y; bias[2] = a.z; bias[3] = a.w; bias[4] = c.x; bias[5] = c.y; bias[6] = c.z; bias[7] = c.w; }
    float y[8][8];
#pragma unroll
    for (int i = 0; i < 8; ++i)
#pragma unroll
        for (int c = 0; c < 8; ++c) { const float a = bias[c] + w[0][c] * x[i][c] + w[1][c] * x[i + 1][c] + w[2][c] * x[i + 2][c] + w[3][c] * x[i + 3][c]; y[i][c] = siluf(a); }
    if (cgp < 32) {
        bf16* XT = (bf16*)(ws + WS_XT) + ((size_t)(b * 32 + cgp) * 128 + (t0 >> 5)) * 2048 + (8 * cg) * 32 + (t0 & 31);
#pragma unroll
        for (int c = 0; c < 8; ++c) { u32x4 o; o.x = pk2(y[0][c], y[1][c]); o.y = pk2(y[2][c], y[3][c]); o.z = pk2(y[4][c], y[5][c]); o.w = pk2(y[6][c], y[7][c]); *(u32x4*)(XT + (size_t)c * 32) = o; }
    } else {
        const int isC = cgp >= 40, gg = ((cgp - 32) & 7) >> 1, n0 = ((cgp - 32) & 1) * 64 + 8 * cg;
        bf16* N = (bf16*)(ws + (isC ? WS_CN : WS_BN)) + ((size_t)(b * 4 + gg) * 4096 + t0) * 128 + n0;
#pragma unroll
        for (int i = 0; i < 8; ++i) { u32x4 o; o.x = pk2(y[i][0], y[i][1]); o.y = pk2(y[i][2], y[i][3]); o.z = pk2(y[i][4], y[i][5]); o.w = pk2(y[i][6], y[i][7]); *(u32x4*)(N + (size_t)i * 128) = o; }
        if (!isC) {
            bf16* BT = (bf16*)(ws + WS_BT) + ((size_t)(b * 4 + gg) * 128 + (t0 >> 5)) * 4096 + n0 * 32 + (t0 & 31);
#pragma unroll
            for (int c = 0; c < 8; ++c) { u32x4 o; o.x = pk2(y[0][c], y[1][c]); o.y = pk2(y[2][c], y[3][c]); o.z = pk2(y[4][c], y[5][c]); o.w = pk2(y[6][c], y[7][c]); *(u32x4*)(BT + (size_t)c * 32) = o; }
        }
    }
}
__device__ __forceinline__ void dtcs_item(const Args& args, int item, int lane) {
    unsigned char* ws = args.ws;
    const int c = item & 31, h = (item >> 5) & 31, b = item >> 10;
    const float* MISC = (const float*)(ws + WS_MISC);
    const float bias = INF(18)[h], a = -__expf(INF(19)[h]);
    const int t = c * 128 + 2 * lane; const size_t m = (size_t)b * 4096 + t;
    const float d0 = softplusf(MISC[m * 128 + h] + bias), d1 = softplusf(MISC[(m + 1) * 128 + h] + bias);
    const float a0 = d0 * a, a1 = d1 * a;
    float s = a0 + a1;
#pragma unroll
    for (int o = 1; o < 64; o <<= 1) { const float v = __shfl_up(s, o); if (lane >= o) s += v; }
    const float c1 = s, c0 = s - a1;
    float* DT = (float*)(ws + WS_DT) + (size_t)(b * 32 + h) * 4096 + t; float* CS = (float*)(ws + WS_CS) + (size_t)(b * 32 + h) * 4096 + t;
    *(f32x2*)DT = (f32x2){d0, d1}; *(f32x2*)CS = (f32x2){c0, c1};
}
__device__ __forceinline__ void sample_conv(const Args& args, int gt, int NGT) {
    unsigned char* ws = args.ws; float* out = args.out;
    const float* st = INF(8); const float* cw = INF(16); const float* cb = INF(17);
    for (int i = gt; i < MS * CONVD; i += NGT) {
        const int bs = i / CONVD, ch = i % CONVD;
        const float s0 = st[((size_t)bs * 3 + 0) * CONVD + ch], s1 = st[((size_t)bs * 3 + 1) * CONVD + ch], s2 = st[((size_t)bs * 3 + 2) * CONVD + ch];
        const float xn = out[O_CONVS + ((size_t)bs * 3 + 2) * CONVD + ch];
        out[O_CONVS + ((size_t)bs * 3 + 0) * CONVD + ch] = s1; out[O_CONVS + ((size_t)bs * 3 + 1) * CONVD + ch] = s2;
        const float a = cb[ch] + cw[ch] * s0 + cw[CONVD + ch] * s1 + cw[2 * CONVD + ch] * s2 + cw[3 * CONVD + ch] * xn;
        ((float*)(ws + WS_XCS))[i] = siluf(a);
    }
    for (int i = gt; i < MS * NH; i += NGT) { const int bs = i >> 5, h = i & 31;
        ((float*)(ws + WS_DTS))[i] = softplusf(((const float*)(ws + WS_MISC))[(size_t)(MP + bs) * 128 + h] + INF(18)[h]); }
}

struct SFrag { u32x4 x[4]; bf16x8 b[4]; };
__device__ __forceinline__ void ssd_states_load(const bf16* XT, const bf16* BT, int nh, int ks, int q, int r16, SFrag& F) {
#pragma unroll
    for (int pt = 0; pt < 4; ++pt) F.x[pt] = *(const u32x4*)(XT + (size_t)ks * 2048 + (16 * pt + r16) * 32 + 8 * q);
#pragma unroll
    for (int nt = 0; nt < 4; ++nt) F.b[nt] = *(const bf16x8*)(BT + (size_t)ks * 4096 + (64 * nh + 16 * nt + r16) * 32 + 8 * q);
}
__device__ __forceinline__ void ssd_states_step(const LAS float* wl, int ks, int q, const SFrag& F, f32x4 (&acc)[4][4]) {
    const int s0 = 32 * ks + 8 * q;
    const f32x4 w0 = *(const LAS f32x4*)(wl + s0), w1 = *(const LAS f32x4*)(wl + s0 + 4);
    bf16x8 af[4];
#pragma unroll
    for (int pt = 0; pt < 4; ++pt) { const u32x4 v = F.x[pt];
        u32x4 o; o.x = pk2(bflo(v.x) * w0.x, bfhi(v.x) * w0.y); o.y = pk2(bflo(v.y) * w0.z, bfhi(v.y) * w0.w); o.z = pk2(bflo(v.z) * w1.x, bfhi(v.z) * w1.y); o.w = pk2(bflo(v.w) * w1.z, bfhi(v.w) * w1.w);
        af[pt] = __builtin_bit_cast(bf16x8, o); }
#pragma unroll
    for (int nt = 0; nt < 4; ++nt)
#pragma unroll
        for (int pt = 0; pt < 4; ++pt) acc[pt][nt] = MFMA16(af[pt], F.b[nt], acc[pt][nt]);
}
__device__ __forceinline__ void ssd_states_unit(const Args& args, LAS unsigned char* lds, int unit, int wave, int lane) {
    unsigned char* ws = args.ws;
    const int g = unit & 3, c = (unit >> 2) & 31, b = unit >> 7, h = g * 8 + wave, q = lane >> 4, r16 = lane & 15;
    LAS float* wl = (LAS float*)(lds + wave * 512);
    const float* DT = (const float*)(ws + WS_DT) + (size_t)(b * 32 + h) * 4096 + c * 128; const float* CS = (const float*)(ws + WS_CS) + (size_t)(b * 32 + h) * 4096 + c * 128;
    const float cl = CS[127];
    wl[lane] = DT[lane] * __expf(cl - CS[lane]); wl[lane + 64] = DT[lane + 64] * __expf(cl - CS[lane + 64]);
    LDS_WAIT(); asm volatile("" ::: "memory");
    const bf16* XT = (const bf16*)(ws + WS_XT) + ((size_t)(b * 32 + h) * 128 + c * 4) * 2048;
    const bf16* BT = (const bf16*)(ws + WS_BT) + ((size_t)(b * 4 + g) * 128 + c * 4) * 4096;
    float* ST = (float*)(ws + WS_STATES) + (((size_t)(b * 32 + c) * 32 + h) * 64) * 128;
    SFrag FA, FB;
    ssd_states_load(XT, BT, 0, 0, q, r16, FA);
#pragma unroll 1
    for (int nh = 0; nh < 2; ++nh) {
        f32x4 acc[4][4];
#pragma unroll
        for (int i = 0; i < 4; ++i)
#pragma unroll
            for (int j = 0; j < 4; ++j) acc[i][j] = (f32x4){0.f, 0.f, 0.f, 0.f};
        ssd_states_load(XT, BT, nh, 1, q, r16, FB); ssd_states_step(wl, 0, q, FA, acc);
        ssd_states_load(XT, BT, nh, 2, q, r16, FA); ssd_states_step(wl, 1, q, FB, acc);
        ssd_states_load(XT, BT, nh, 3, q, r16, FB); ssd_states_step(wl, 2, q, FA, acc);
        if (nh == 0) ssd_states_load(XT, BT, 1, 0, q, r16, FA);
        ssd_states_step(wl, 3, q, FB, acc);
#pragma unroll
        for (int pt = 0; pt < 4; ++pt)
#pragma unroll
            for (int nt = 0; nt < 4; ++nt)
#pragma unroll
                for (int r = 0; r < 4; ++r) ST[(size_t)(16 * pt + 4 * q + r) * 128 + 64 * nh + 16 * nt + r16] = acc[pt][nt][r];
    }
}

template <int SAMPLE>
__device__ __forceinline__ void compress2_item(const Args& args, int item, int lane) {
    unsigned char* ws = args.ws;
    const int q = lane >> 4, r16 = lane & 15;
    constexpr int NPB = SAMPLE ? 128 : 256;
    constexpr int NI = (SAMPLE ? 65536 : 4096) / 16;
    const int st = item / NI, row0 = (item % NI) * 16;
    const bf16* P = (const bf16*)(ws + (SAMPLE ? (st ? WS_PARTSV : WS_PARTSK) : (st ? WS_PARTV : WS_PARTK))) + (size_t)(row0 + r16) * 256;
    const float* pet = (const float*)(ws + WS_PET) + st * 128;
    const bf16* W2T = (const bf16*)(ws + WS_W2T) + st * 8192;
    f32x4 acc[4];
#pragma unroll
    for (int dt = 0; dt < 4; ++dt) acc[dt] = (f32x4){0.f, 0.f, 0.f, 0.f};
#pragma unroll
    for (int ks = 0; ks < 4; ++ks) {
        const int e0 = 32 * ks + 8 * q;
        const u32x4 pa = *(const u32x4*)(P + e0), pb = *(const u32x4*)(P + 256 + 128 + e0);
        const f32x4 a0 = (f32x4){bflo(pa.x), bfhi(pa.x), bflo(pa.y), bfhi(pa.y)}, a1 = (f32x4){bflo(pa.z), bfhi(pa.z), bflo(pa.w), bfhi(pa.w)};
        const f32x4 b0 = (f32x4){bflo(pb.x), bfhi(pb.x), bflo(pb.y), bfhi(pb.y)}, b1 = (f32x4){bflo(pb.z), bfhi(pb.z), bflo(pb.w), bfhi(pb.w)};
        const f32x4 p0 = *(const f32x4*)(pet + e0), p1 = *(const f32x4*)(pet + e0 + 4);
        const f32x4 h0 = a0 + b0 + p0, h1 = a1 + b1 + p1;
        u32x4 o; o.x = pk2(siluf(h0.x), siluf(h0.y)); o.y = pk2(siluf(h0.z), siluf(h0.w)); o.z = pk2(siluf(h1.x), siluf(h1.y)); o.w = pk2(siluf(h1.z), siluf(h1.w));
        const bf16x8 af = __builtin_bit_cast(bf16x8, o);
#pragma unroll
        for (int dt = 0; dt < 4; ++dt) { const bf16x8 bf = *(const bf16x8*)(W2T + (size_t)(16 * dt + r16) * 128 + e0); acc[dt] = MFMA16(af, bf, acc[dt]); }
    }
    const int bh = row0 / NPB, n0 = row0 % NPB + 4 * q;
#pragma unroll
    for (int dt = 0; dt < 4; ++dt) {
        const int d = 16 * dt + r16;
        float v[4];
#pragma unroll
        for (int r = 0; r < 4; ++r) v[r] = (n0 + r < NPB - 1) ? acc[dt][r] : 0.f;
        if (SAMPLE) {
            float* o = (float*)(ws + (st ? WS_VCS : WS_KCS)) + ((size_t)bh * 128 + n0) * 64 + d;
#pragma unroll
            for (int r = 0; r < 4; ++r) o[r * 64] = v[r];
        } else if (st == 0) {
            bf16* o = (bf16*)(ws + WS_KC) + ((size_t)bh * 256 + n0) * 64 + d;
#pragma unroll
            for (int r = 0; r < 4; ++r) o[r * 64] = (bf16)f2bf(v[r]);
        } else {
            u32x2 w; w.x = pk2(v[0], v[1]); w.y = pk2(v[2], v[3]);
            *(u32x2*)((bf16*)(ws + WS_VCT) + ((size_t)bh * 8 + (n0 >> 5)) * 2048 + d * 32 + 8 * ((n0 & 15) >> 2) + 4 * ((n0 & 31) >> 4)) = w;
        }
    }
}

__device__ __forceinline__ void sample_ssm_item(const Args& args, LAS unsigned char* lds, int item, int wave, int lane) {
    unsigned char* ws = args.ws; float* out = args.out;
    const int h = item & 31, bs = item >> 5, g = h >> 3, rs = lane >> 5, nc = lane & 31;
    const float* XC = (const float*)(ws + WS_XCS) + (size_t)bs * CONVD;
    const float dt = ((const float*)(ws + WS_DTS))[bs * 32 + h], a = -__expf(INF(19)[h]), dec = __expf(dt * a), Dh = INF(20)[h];
    const f32x4 Bv = *(const f32x4*)(XC + 2048 + g * 128 + 4 * nc) * dt, Cv = *(const f32x4*)(XC + 2560 + g * 128 + 4 * nc);
    const float xl = XC[h * 64 + lane];
    const size_t m = MP + bs;
    const float zl = bf2f(((const bf16*)(ws + WS_Z))[m * 2048 + h * 64 + lane]), nwl = INF(21)[h * 64 + lane];
    const float* H0 = INF(7) + ((size_t)(bs * 32 + h) * 64) * 128 + 4 * nc; float* HN = out + O_SSMS + ((size_t)(bs * 32 + h) * 64) * 128 + 4 * nc;
    const bool b4 = (lane & 16) != 0, b3 = (lane & 8) != 0, b2 = (lane & 4) != 0;
    float yl = 0.f;
#pragma unroll 1
    for (int bt = 0; bt < 4; ++bt) {
        f32x4 h0[8];
#pragma unroll
        for (int k = 0; k < 8; ++k) h0[k] = *(const f32x4*)(H0 + (size_t)(2 * (8 * bt + k) + rs) * 128);
        float v[8];
#pragma unroll
        for (int k = 0; k < 8; ++k) { const int p = 2 * (8 * bt + k) + rs;
            const float xp = __shfl(xl, p);
            const f32x4 hn = h0[k] * dec + Bv * xp;
            *(f32x4*)(HN + (size_t)p * 128) = hn;
            v[k] = (hn.x * Cv.x + hn.y * Cv.y) + (hn.z * Cv.z + hn.w * Cv.w); }
        float a4[4], a2[2];
#pragma unroll
        for (int i = 0; i < 4; ++i) a4[i] = (b4 ? v[4 + i] : v[i]) + __shfl_xor(b4 ? v[i] : v[4 + i], 16);
#pragma unroll
        for (int i = 0; i < 2; ++i) a2[i] = (b3 ? a4[2 + i] : a4[i]) + __shfl_xor(b3 ? a4[i] : a4[2 + i], 8);
        float c = (b2 ? a2[1] : a2[0]) + __shfl_xor(b2 ? a2[0] : a2[1], 4);
        c += __shfl_xor(c, 2); c += __shfl_xor(c, 1);
        const int pl = lane - 16 * bt;
        const int kk = (pl >> 1) & 7, src = ((pl & 1) << 5) | ((kk & 4) << 2) | ((kk & 2) << 2) | ((kk & 1) << 2);
        const float got = __shfl(c, src & 63);
        if (pl >= 0 && pl < 16) yl = got;
    }
    const float y = yl + Dh * xl;
    const float vv = y * siluf(zl);
    ((bf16*)(ws + WS_YSSM))[m * 2048 + h * 64 + lane] = (bf16)f2bf(vv * nwl);
    const float ss = wave_sum(vv * vv);
    if (lane == 0) ((float*)(ws + WS_MISC))[m * 128 + 80 + h] = ss;
}
constexpr int SC_PP = 264;
constexpr int SC_AP = 136;
__device__ __forceinline__ void sample_compress_unit(const Args& args, LAS unsigned char* lds, int unit, int tid_in, int wave, int lane_in) {
    int tid = tid_in, lane = lane_in; asm volatile("" : "+v"(tid), "+v"(lane));
    unsigned char* ws = args.ws;
    const int st = unit & 1, qd = (unit >> 1) & 3, b = unit >> 3, q = lane >> 4, r16 = lane & 15, wr = wave >> 2, wc = wave & 3;
    LAS bf16* As = (LAS bf16*)lds;
    LAS bf16* Pl = (LAS bf16*)lds;
    const bf16* W1T = (const bf16*)(ws + (st ? WS_W1V : WS_W1K));
    const int sj = tid >> 2, sc16 = tid & 3, sjj = 32 * qd + (sj >> 2), sh = sj & 3;
    const int page = ((const int*)args.in[5])[b * NPAGES + (sjj >> 3)];
    const float* asrc = INF(4) + (((size_t)page * 128 + 16 * (sjj & 7)) * 4 + st) * 256 + sh * 64 + 16 * sc16;
    LAS bf16* adst = As + sj * SC_AP + 16 * sc16;
    const bf16* bsrc = W1T + (size_t)(64 * wc + r16) * 1024 + 8 * q;
    f32x4 acc[4][4];
#pragma unroll
    for (int m = 0; m < 4; ++m)
#pragma unroll
        for (int n = 0; n < 4; ++n) acc[m][n] = (f32x4){0.f, 0.f, 0.f, 0.f};
    f32x4 ra[2][8];
#pragma unroll
    for (int c = 0; c < 8; ++c) ra[0][c] = *(const f32x4*)(asrc + (size_t)(c >> 2) * 1024 + 4 * (c & 3));
    { LAS bf16* d = adst;
#pragma unroll
      for (int h2 = 0; h2 < 2; ++h2) { u32x4 w0, w1; const int c = 4 * h2;
        w0.x = pk2c(ra[0][c].x, ra[0][c].y); w0.y = pk2c(ra[0][c].z, ra[0][c].w); w0.z = pk2c(ra[0][c + 1].x, ra[0][c + 1].y); w0.w = pk2c(ra[0][c + 1].z, ra[0][c + 1].w);
        w1.x = pk2c(ra[0][c + 2].x, ra[0][c + 2].y); w1.y = pk2c(ra[0][c + 2].z, ra[0][c + 2].w); w1.z = pk2c(ra[0][c + 3].x, ra[0][c + 3].y); w1.w = pk2c(ra[0][c + 3].z, ra[0][c + 3].w);
        *(LAS u32x4*)(d + 64 * h2) = w0; *(LAS u32x4*)(d + 64 * h2 + 8) = w1; } }
    __syncthreads();
#pragma unroll 1
    for (int s2 = 0; s2 < 8; s2 += 2) {
#pragma unroll
        for (int i = 0; i < 2; ++i) {
            const int s = s2 + i;
            bf16x8 rb[4][4];
#pragma unroll
            for (int k4 = 0; k4 < 4; ++k4)
#pragma unroll
                for (int n = 0; n < 4; ++n) rb[k4][n] = *(const bf16x8*)(bsrc + (size_t)(16 * n) * 1024 + 128 * s + 32 * k4);
            if (s + 1 < 8) {
#pragma unroll
                for (int c = 0; c < 8; ++c) ra[i ^ 1][c] = *(const f32x4*)(asrc + (size_t)(2 * (s + 1) + (c >> 2)) * 1024 + 4 * (c & 3)); }
#pragma unroll
            for (int k4 = 0; k4 < 4; ++k4) {
                bf16x8 afr[4];
#pragma unroll
                for (int m = 0; m < 4; ++m) afr[m] = *(const LAS bf16x8*)(As + i * (128 * SC_AP) + (64 * wr + 16 * m + r16) * SC_AP + 32 * k4 + 8 * q);
#pragma unroll
                for (int m = 0; m < 4; ++m)
#pragma unroll
                    for (int n = 0; n < 4; ++n) acc[m][n] = MFMA16(rb[k4][n], afr[m], acc[m][n]);
            }
            if (s + 1 < 8) { LAS bf16* d = adst + (i ^ 1) * (128 * SC_AP);
#pragma unroll
                for (int h2 = 0; h2 < 2; ++h2) { u32x4 w0, w1; const int c = 4 * h2;
                    w0.x = pk2c(ra[i ^ 1][c].x, ra[i ^ 1][c].y); w0.y = pk2c(ra[i ^ 1][c].z, ra[i ^ 1][c].w); w0.z = pk2c(ra[i ^ 1][c + 1].x, ra[i ^ 1][c + 1].y); w0.w = pk2c(ra[i ^ 1][c + 1].z, ra[i ^ 1][c + 1].w);
                    w1.x = pk2c(ra[i ^ 1][c + 2].x, ra[i ^ 1][c + 2].y); w1.y = pk2c(ra[i ^ 1][c + 2].z, ra[i ^ 1][c + 2].w); w1.z = pk2c(ra[i ^ 1][c + 3].x, ra[i ^ 1][c + 3].y); w1.w = pk2c(ra[i ^ 1][c + 3].z, ra[i ^ 1][c + 3].w);
                    *(LAS u32x4*)(d + 64 * h2) = w0; *(LAS u32x4*)(d + 64 * h2 + 8) = w1; } }
            __syncthreads();
        }
    }
#pragma unroll
    for (int m = 0; m < 4; ++m)
#pragma unroll
        for (int n = 0; n < 4; ++n) { u32x2 w; w.x = pk2(acc[m][n][0], acc[m][n][1]); w.y = pk2(acc[m][n][2], acc[m][n][3]);
            *(LAS u32x2*)(Pl + (64 * wr + 16 * m + r16) * SC_PP + 64 * wc + 16 * n + 4 * q) = w; }
    __syncthreads();
    {
        const float* pet = (const float*)(ws + WS_PET) + st * 128;
        const bf16* W2T = (const bf16*)(ws + WS_W2T) + st * 8192;
        const int nrow = 16 * wave + r16;
        f32x4 o[4];
#pragma unroll
        for (int dt = 0; dt < 4; ++dt) o[dt] = (f32x4){0.f, 0.f, 0.f, 0.f};
#pragma unroll
        for (int ks = 0; ks < 4; ++ks) {
            const int e0 = 32 * ks + 8 * q;
            const u32x4 pa = *(const LAS u32x4*)(Pl + nrow * SC_PP + e0), pb = *(const LAS u32x4*)(Pl + (nrow < 124 ? nrow + 4 : nrow) * SC_PP + 128 + e0);
            const f32x4 p0 = *(const f32x4*)(pet + e0), p1 = *(const f32x4*)(pet + e0 + 4);
            const f32x4 h0 = (f32x4){bflo(pa.x) + bflo(pb.x), bfhi(pa.x) + bfhi(pb.x), bflo(pa.y) + bflo(pb.y), bfhi(pa.y) + bfhi(pb.y)} + p0;
            const f32x4 h1 = (f32x4){bflo(pa.z) + bflo(pb.z), bfhi(pa.z) + bfhi(pb.z), bflo(pa.w) + bflo(pb.w), bfhi(pa.w) + bfhi(pb.w)} + p1;
            u32x4 w; w.x = pk2(siluf(h0.x), siluf(h0.y)); w.y = pk2(siluf(h0.z), siluf(h0.w)); w.z = pk2(siluf(h1.x), siluf(h1.y)); w.w = pk2(siluf(h1.z), siluf(h1.w));
            const bf16x8 af = __builtin_bit_cast(bf16x8, w);
#pragma unroll
            for (int dt = 0; dt < 4; ++dt) { const bf16x8 bf = *(const bf16x8*)(W2T + (size_t)(16 * dt + r16) * 128 + e0); o[dt] = MFMA16(af, bf, o[dt]); }
        }
        const int jj = 4 * wave + q, n = 32 * qd + jj;
        if (jj < 31) {
#pragma unroll
            for (int r = 0; r < 4; ++r) { float* dst = (float*)(ws + (st ? WS_VCS : WS_KCS)) + ((size_t)(b * 4 + r) * 128 + n) * 64;
#pragma unroll
                for (int dt = 0; dt < 4; ++dt) dst[16 * dt + r16] = o[dt][r]; }
        }
        if (tid < 256) { const int hh = tid >> 6, which = (tid >> 5) & 1, c4 = (tid & 31) * 4;
            const u32x2 v = *(const LAS u32x2*)(Pl + (which ? hh : 124 + hh) * SC_PP + which * 128 + c4);
            *(u32x2*)((bf16*)(ws + WS_PARTB) + ((((size_t)(st * 128 + b) * 4 + hh) * 4 + qd) * 2 + which) * 128 + c4) = v; }
        if (qd == 3 && tid < 256) { const int hh = tid >> 6; ((float*)(ws + (st ? WS_VCS : WS_KCS)))[((size_t)(b * 4 + hh) * 128 + 127) * 64 + (tid & 63)] = 0.f; }
    }
    __syncthreads();
}

__device__ __forceinline__ void compress_fixup_item(const Args& args, int item, int lane) {
    unsigned char* ws = args.ws;
    const int qd = item % 3, hh = (item / 3) & 3, b = (item / 12) & 127, st = item / (12 * 128);
    const bf16* PB = (const bf16*)(ws + WS_PARTB) + (((size_t)(st * 128 + b) * 4 + hh) * 4) * 2 * 128;
    const float* pet = (const float*)(ws + WS_PET) + st * 128; const float* w2 = INF(st ? 27 : 24);
    const float a0 = siluf(pet[lane] + bf2f(PB[(qd * 2 + 0) * 128 + lane]) + bf2f(PB[((qd + 1) * 2 + 1) * 128 + lane]));
    const float a1 = siluf(pet[64 + lane] + bf2f(PB[(qd * 2 + 0) * 128 + 64 + lane]) + bf2f(PB[((qd + 1) * 2 + 1) * 128 + 64 + lane]));
    float o = 0.f;
#pragma unroll 8
    for (int e = 0; e < 64; ++e) o += __shfl(a0, e) * w2[e * 64 + lane];
#pragma unroll 8
    for (int e = 0; e < 64; ++e) o += __shfl(a1, e) * w2[(64 + e) * 64 + lane];
    ((float*)(ws + (st ? WS_VCS : WS_KCS)))[((size_t)(b * 4 + hh) * 128 + 32 * qd + 31) * 64 + lane] = o;
}
#ifdef SELFCHECK
__device__ __forceinline__ void check_sample_compress(const Args& args, LAS unsigned char* lds, int bid, int tid) {
    unsigned char* ws = args.ws;
    const int st = bid & 1, bh = (bid * 37) % 512, n = (bid & 3) == 3 ? 32 * ((bid >> 2) % 3) + 31 : (bid * 11) % 127, b = bh >> 2, h = bh & 3;
    LAS float* hid = (LAS float*)lds;
    __syncthreads();
    if (tid < 128) {
        const float* pe = INF(st ? 25 : 22); const float* w1 = INF(st ? 26 : 23);
        float a = 0.f;
        for (int l = 0; l < 32; ++l) { const int t = 16 * n + l; const int page = ((const int*)args.in[5])[b * NPAGES + (t >> 7)];
            const float* row = INF(4) + (((size_t)page * 128 + (t & 127)) * 4 + st) * 256 + h * 64;
            for (int d = 0; d < 64; ++d) a += (row[d] + 0.f) * w1[((size_t)l * 64 + d) * 128 + tid] + pe[l * 64 + d] * w1[((size_t)l * 64 + d) * 128 + tid]; }
        hid[tid] = a / (1.f + __expf(-a));
    }
    __syncthreads();
    if (tid < 64) { const float* w2 = INF(st ? 27 : 24); float o = 0.f;
        for (int e = 0; e < 128; ++e) o += hid[e] * w2[e * 64 + tid];
        const float got = ((const float*)(ws + (st ? WS_VCS : WS_KCS)))[((size_t)bh * 128 + n) * 64 + tid];
        if (!(fabsf(got - o) <= 0.03f + 0.03f * fabsf(o))) atomicAdd((unsigned*)(ws + WS_CTL) + 8, 1u); }
    __syncthreads();
}
#endif
__device__ __forceinline__ void scan_phase(const Args& args, int gt, int NGT) {
    unsigned char* ws = args.ws; float* out = args.out;
    constexpr int NITEM = 4 * 32 * 64 * 32;
    for (int i0 = gt; i0 < NITEM; i0 += 2 * NGT) {
        const int i1 = i0 + NGT; const bool two = i1 < NITEM;
        const int ia[2] = {i0, two ? i1 : i0};
        size_t base[2]; const float* CSp[2]; f32x4 run[2];
#pragma unroll
        for (int k = 0; k < 2; ++k) { const int i = ia[k]; const int n4 = i & 31, p = (i >> 5) & 63, h = (i >> 11) & 31, b = i >> 16;
            base[k] = (((size_t)(b * 32) * 32 + h) * 64 + p) * 128 + 4 * n4; CSp[k] = (const float*)(ws + WS_CS) + (size_t)(b * 32 + h) * 4096; run[k] = (f32x4){0.f, 0.f, 0.f, 0.f}; }
#pragma unroll 1
        for (int c0 = 0; c0 < 32; c0 += 8) {
            f32x4 st[2][8]; float dec[2][8];
#pragma unroll
            for (int k = 0; k < 2; ++k)
#pragma unroll
                for (int j = 0; j < 8; ++j) { st[k][j] = *(const f32x4*)((const float*)(ws + WS_STATES) + base[k] + (size_t)(c0 + j) * (32 * 64 * 128)); dec[k][j] = CSp[k][(c0 + j) * 128 + 127]; }
#pragma unroll
            for (int j = 0; j < 8; ++j)
#pragma unroll
                for (int k = 0; k < 2; ++k) {
                    u32x2 o; o.x = pk2(run[k].x, run[k].y); o.y = pk2(run[k].z, run[k].w);
                    if (k == 0 || two) *(u32x2*)((bf16*)(ws + WS_HPREV) + base[k] + (size_t)(c0 + j) * (32 * 64 * 128)) = o;
                    run[k] = run[k] * __expf(dec[k][j]) + st[k][j];
                }
        }
#pragma unroll
        for (int k = 0; k < 2; ++k) if (k == 0 || two) { const int i = ia[k]; const int n4 = i & 31, p = (i >> 5) & 63, h = (i >> 11) & 31, b = i >> 16;
            *(f32x4*)(out + O_SSMP + (((size_t)(b * 32 + h) * 64 + p) * 128) + 4 * n4) = run[k]; }
    }
    for (int i = gt; i < MS * 4; i += NGT) { const int bs = i >> 2, g = i & 3; const float* p = (const float*)(ws + WS_MISC) + (size_t)(MP + bs) * 128 + 80 + g * 8;
        ((float*)(ws + WS_SSQ))[(size_t)(MP + bs) * 4 + g] = ((p[0] + p[1]) + (p[2] + p[3])) + ((p[4] + p[5]) + (p[6] + p[7])); }
}

constexpr int CNL_PITCH = 136;
struct DFrag { bf16x8 x[4]; f32x4 csa, csb, dta, dtb; };
__device__ __forceinline__ void ssd_out_load(const bf16* XT, const float* CS, const float* DT, int i, int q, int r16, DFrag& F) {
    const int sa = 32 * i + 4 * q, sb = sa + 16;
    F.csa = *(const f32x4*)(CS + sa); F.csb = *(const f32x4*)(CS + sb); F.dta = *(const f32x4*)(DT + sa); F.dtb = *(const f32x4*)(DT + sb);
#pragma unroll
    for (int pt = 0; pt < 4; ++pt) { const bf16* xr = XT + (size_t)i * 2048 + (16 * pt + r16) * 32 + 4 * q; const u32x2 lo = *(const u32x2*)xr, hi = *(const u32x2*)(xr + 16);
        F.x[pt] = __builtin_bit_cast(bf16x8, (u32x4){lo.x, lo.y, hi.x, hi.y}); }
}
template <int HL, int I>
__device__ __forceinline__ void ssd_out_diag(const LAS float* CBT, const DFrag& F, const float (&csl)[4], float Dh, int q, int r16, int lane, f32x4 (&acc)[4][4]) {
    const int sa = 32 * I + 4 * q, sb = sa + 16;
#pragma unroll
    for (int lt = 0; lt < 4; ++lt) {
        constexpr int dummy = 0; (void)dummy;
        const int LT = 4 * HL + lt;
        if (LT < 2 * I) continue;
        const int l = 16 * LT + r16;
        float ga[4], gb[4];
#pragma unroll
        for (int r = 0; r < 4; ++r) {
            const float va = CBT[(((2 * I) * 8 + LT) * 4 + r) * 64 + lane];
            const float vb = (LT >= 2 * I + 1) ? CBT[(((2 * I + 1) * 8 + LT) * 4 + r) * 64 + lane] : 0.f;
            const int s1 = sa + r, s2 = sb + r;
            float x1 = (l >= s1) ? va * __expf(csl[lt] - F.csa[r]) * F.dta[r] : 0.f;
            float x2 = (l >= s2) ? vb * __expf(csl[lt] - F.csb[r]) * F.dtb[r] : 0.f;
            if (l == s1) x1 += Dh;
            if (l == s2) x2 += Dh;
            ga[r] = x1; gb[r] = x2;
        }
        u32x4 o; o.x = pk2(ga[0], ga[1]); o.y = pk2(ga[2], ga[3]); o.z = pk2(gb[0], gb[1]); o.w = pk2(gb[2], gb[3]);
        const bf16x8 bf = __builtin_bit_cast(bf16x8, o);
#pragma unroll
        for (int pt = 0; pt < 4; ++pt) acc[pt][lt] = MFMA16(F.x[pt], bf, acc[pt][lt]);
    }
}
template <int HL>
__device__ __forceinline__ void ssd_out_half(const Args& args, const LAS float* CBT, const LAS bf16* CnL, LAS float* SQ, const bf16x8 (&hp)[16], const bf16* XT, const float* CS, const float* DT,
                                             float Dh, int b, int c, int h, int wave, int q, int r16, int lane) {
    unsigned char* ws = args.ws;
    float csl[4];
#pragma unroll
    for (int lt = 0; lt < 4; ++lt) csl[lt] = CS[64 * HL + 16 * lt + r16];
    DFrag FA, FB;
    ssd_out_load(XT, CS, DT, 0, q, r16, FA);
    f32x4 acc[4][4];
#pragma unroll
    for (int i = 0; i < 4; ++i)
#pragma unroll
        for (int j = 0; j < 4; ++j) acc[i][j] = (f32x4){0.f, 0.f, 0.f, 0.f};
#pragma unroll
    for (int ks = 0; ks < 4; ++ks)
#pragma unroll
        for (int lt = 0; lt < 4; ++lt) { const bf16x8 bf = *(const LAS bf16x8*)(CnL + (64 * HL + 16 * lt + r16) * CNL_PITCH + 32 * ks + 8 * q);
#pragma unroll
            for (int pt = 0; pt < 4; ++pt) acc[pt][lt] = MFMA16(hp[ks * 4 + pt], bf, acc[pt][lt]); }
#pragma unroll
    for (int lt = 0; lt < 4; ++lt) { const float e = __expf(csl[lt]);
#pragma unroll
        for (int pt = 0; pt < 4; ++pt) acc[pt][lt] = acc[pt][lt] * e; }
    ssd_out_load(XT, CS, DT, 1, q, r16, FB);
    ssd_out_diag<HL, 0>(CBT, FA, csl, Dh, q, r16, lane, acc);
    if (HL == 1) ssd_out_load(XT, CS, DT, 2, q, r16, FA);
    ssd_out_diag<HL, 1>(CBT, FB, csl, Dh, q, r16, lane, acc);
    if (HL == 1) {
        ssd_out_load(XT, CS, DT, 3, q, r16, FB);
        ssd_out_diag<HL, 2>(CBT, FA, csl, Dh, q, r16, lane, acc);
        ssd_out_diag<HL, 3>(CBT, FB, csl, Dh, q, r16, lane, acc);
    }
    const bf16* Z = (const bf16*)(ws + WS_Z); bf16* Y = (bf16*)(ws + WS_YSSM); const float* nw = INF(21) + h * 64;
    u32x2 zz[4][4];
#pragma unroll
    for (int lt = 0; lt < 4; ++lt)
#pragma unroll
        for (int pt = 0; pt < 4; ++pt) zz[lt][pt] = *(const u32x2*)(Z + ((size_t)b * 4096 + c * 128 + 64 * HL + 16 * lt + r16) * 2048 + h * 64 + 16 * pt + 4 * q);
#pragma unroll
    for (int lt = 0; lt < 4; ++lt) {
        const size_t m = (size_t)b * 4096 + c * 128 + 64 * HL + 16 * lt + r16;
        float ss = 0.f;
#pragma unroll
        for (int pt = 0; pt < 4; ++pt) {
            const int ch = 16 * pt + 4 * q;
            const f32x4 w = *(const f32x4*)(nw + ch);
            const float v0 = acc[pt][lt][0] * siluf(bflo(zz[lt][pt].x)), v1 = acc[pt][lt][1] * siluf(bfhi(zz[lt][pt].x)), v2 = acc[pt][lt][2] * siluf(bflo(zz[lt][pt].y)), v3 = acc[pt][lt][3] * siluf(bfhi(zz[lt][pt].y));
            ss += (v0 * v0 + v1 * v1) + (v2 * v2 + v3 * v3);
            u32x2 o; o.x = pk2(v0 * w.x, v1 * w.y); o.y = pk2(v2 * w.z, v3 * w.w);
            *(u32x2*)(Y + m * 2048 + h * 64 + ch) = o;
        }
        ss += __shfl_xor(ss, 16); ss += __shfl_xor(ss, 32);
        if (q == 0) SQ[wave * 128 + 64 * HL + 16 * lt + r16] = ss;
    }
}
__device__ __forceinline__ void ssd_out_unit(const Args& args, LAS unsigned char* lds, int unit, int wave, int lane_in, int tid) {
    int lane = lane_in; asm volatile("" : "+v"(lane));
    unsigned char* ws = args.ws;
    const int g = unit & 3, c = (unit >> 2) & 31, b = unit >> 7, h = g * 8 + wave, q = lane >> 4, r16 = lane & 15;
    LAS float* CBT = (LAS float*)lds; LAS bf16* CnL = (LAS bf16*)(lds + 65536); LAS float* SQ = (LAS float*)(lds + 65536 + 128 * CNL_PITCH * 2);
    const bf16* Bn = (const bf16*)(ws + WS_BN) + ((size_t)(b * 4 + g) * 4096 + c * 128) * 128;
    const bf16* Cn = (const bf16*)(ws + WS_CN) + ((size_t)(b * 4 + g) * 4096 + c * 128) * 128;
    {
        u32x4 cv[4];
#pragma unroll
        for (int i = 0; i < 4; ++i) cv[i] = *(const u32x4*)(Cn + (size_t)(wave * 64 + lane + 512 * i) * 8);
        bf16x8 bnf[4], hp[16];
#pragma unroll
        for (int ks = 0; ks < 4; ++ks) bnf[ks] = *(const bf16x8*)(Bn + (size_t)(16 * wave + r16) * 128 + 32 * ks + 8 * q);
        const bf16* HP = (const bf16*)(ws + WS_HPREV) + (((size_t)(b * 32 + c) * 32 + h) * 64) * 128;
#pragma unroll
        for (int ks = 0; ks < 4; ++ks)
#pragma unroll
            for (int pt = 0; pt < 4; ++pt) hp[ks * 4 + pt] = *(const bf16x8*)(HP + (size_t)(16 * pt + r16) * 128 + 32 * ks + 8 * q);
#pragma unroll
        for (int i = 0; i < 4; ++i) { const int id = wave * 64 + lane + 512 * i; *(LAS u32x4*)(CnL + (id >> 4) * CNL_PITCH + (id & 15) * 8) = cv[i]; }
        __syncthreads();
        for (int lt = wave; lt < 8; ++lt) {
            f32x4 d = (f32x4){0.f, 0.f, 0.f, 0.f};
#pragma unroll
            for (int ks = 0; ks < 4; ++ks) { const bf16x8 bf = *(const LAS bf16x8*)(CnL + (16 * lt + r16) * CNL_PITCH + 32 * ks + 8 * q); d = MFMA16(bnf[ks], bf, d); }
#pragma unroll
            for (int r = 0; r < 4; ++r) CBT[((wave * 8 + lt) * 4 + r) * 64 + lane] = d[r];
        }
        __syncthreads();
        const float* DT = (const float*)(ws + WS_DT) + (size_t)(b * 32 + h) * 4096 + c * 128; const float* CS = (const float*)(ws + WS_CS) + (size_t)(b * 32 + h) * 4096 + c * 128;
        const float Dh = INF(20)[h];
        const bf16* XT = (const bf16*)(ws + WS_XT) + ((size_t)(b * 32 + h) * 128 + c * 4) * 2048;
        ssd_out_half<0>(args, CBT, CnL, SQ, hp, XT, CS, DT, Dh, b, c, h, wave, q, r16, lane);
        ssd_out_half<1>(args, CBT, CnL, SQ, hp, XT, CS, DT, Dh, b, c, h, wave, q, r16, lane);
    }
    __syncthreads();
    if (tid < 128) { float s = 0.f;
#pragma unroll
        for (int w = 0; w < 8; ++w) s += SQ[w * 128 + tid];
        ((float*)(ws + WS_SSQ))[((size_t)b * 4096 + c * 128 + tid) * 4 + g] = s; }
    __syncthreads();
}
constexpr float SC2 = 0.125f * 1.4426950408889634f;
__device__ __forceinline__ float max3f(float a, float b, float c) { float r; asm("v_max3_f32 %0, %1, %2, %3" : "=v"(r) : "v"(a), "v"(b), "v"(c)); return r; }
template <class T> __device__ __forceinline__ T ldu(const void* ubase, unsigned lane_off) { return *(const T*)((const char*)ubase + lane_off); }
struct KFrag { bf16x8 kf[2][2]; };
__device__ __forceinline__ void flash_load(const bf16* Kp, int kb, unsigned koff, KFrag& F) {
#pragma unroll
    for (int kt = 0; kt < 2; ++kt) { const bf16* kr = Kp + (size_t)(kb + 16 * kt) * 64; F.kf[kt][0] = ldu<bf16x8>(kr, koff); F.kf[kt][1] = ldu<bf16x8>(kr + 32, koff); }
}
template <int MODE>
__device__ __forceinline__ void flash_step(const KFrag& F, const bf16* VTp, unsigned voff, int kb, int t0, int t, bool selbit, const LAS bf16x8* Qs,
                                           f32x4 (&O)[4][4], float (&mx)[4], f32x4 (&L)[4], int q) {
    const bf16x8 ones = __builtin_bit_cast(bf16x8, (u32x4){0x3f803f80u, 0x3f803f80u, 0x3f803f80u, 0x3f803f80u});
    const bool edge = (kb + 31 > t0) || (MODE == 1 && kb + 512 <= t0 + 15);
    bf16x8 vf[4];
#pragma unroll
    for (int dt = 0; dt < 4; ++dt) vf[dt] = ldu<bf16x8>(VTp + (size_t)(kb >> 5) * 2048 + (16 * dt) * 32, voff);
#pragma unroll
    for (int g = 0; g < 4; ++g) {
        asm volatile("" ::: "memory");
        __builtin_amdgcn_sched_barrier(0);
        const bf16x8 q0 = Qs[(g * 2 + 0) * 64], q1 = Qs[(g * 2 + 1) * 64];
        f32x4 S0 = MFMA16(F.kf[0][0], q0, ((f32x4){0.f, 0.f, 0.f, 0.f})), S1 = MFMA16(F.kf[1][0], q0, ((f32x4){0.f, 0.f, 0.f, 0.f}));
        S0 = MFMA16(F.kf[0][1], q1, S0); S1 = MFMA16(F.kf[1][1], q1, S1);
        float s[8];
#pragma unroll
        for (int r = 0; r < 4; ++r) { s[r] = S0[r]; s[4 + r] = S1[r]; }
        if (edge) {
#pragma unroll
            for (int i = 0; i < 8; ++i) { const int key = kb + 16 * (i >> 2) + 4 * q + (i & 3);
                const bool ok = (MODE == 0) ? (key <= t) : (key <= t && key + 512 > t); s[i] = ok ? s[i] : NEGF; }
        }
        float lm = max3f(max3f(s[0], s[1], s[2]), max3f(s[3], s[4], s[5]), fmaxf(s[6], s[7])) * SC2;
        if (MODE == 0) lm = selbit ? lm : NEGF;
        if (__builtin_amdgcn_ballot_w64(lm > mx[g] + 8.f) != 0ull) {
            float tmax = fmaxf(lm, __shfl_xor(lm, 16)); tmax = fmaxf(tmax, __shfl_xor(tmax, 32));
            const float mnew = fmaxf(mx[g], tmax), alpha = __builtin_amdgcn_exp2f(mx[g] - mnew); mx[g] = mnew; L[g] = L[g] * alpha;
#pragma unroll
            for (int dt = 0; dt < 4; ++dt) O[dt][g] = O[dt][g] * alpha;
        }
        float nmuse = -fmaxf(mx[g], -1e20f);
        if (MODE == 0) nmuse = selbit ? nmuse : NEGF;
#pragma unroll
        for (int i = 0; i < 8; ++i) s[i] = __builtin_amdgcn_exp2f(__builtin_fmaf(s[i], SC2, nmuse));
        u32x4 pw; pw.x = pk2(s[0], s[1]); pw.y = pk2(s[2], s[3]); pw.z = pk2(s[4], s[5]); pw.w = pk2(s[6], s[7]);
        const bf16x8 pf = __builtin_bit_cast(bf16x8, pw);
        L[g] = MFMA16(ones, pf, L[g]);
#pragma unroll
        for (int dt = 0; dt < 4; ++dt) O[dt][g] = MFMA16(vf[dt], pf, O[dt][g]);
    }
}
template <int MODE>
__device__ __forceinline__ void flash_branch(const bf16* Kp, const bf16* VTp, int jfirst, int jlast, unsigned ulo, unsigned uhi, unsigned mlo, unsigned mhi,
                                             int t0, int t, const LAS bf16x8* Qs, f32x4 (&O)[4][4], float (&mx)[4], f32x4 (&L)[4], int q, int r16) {
    const unsigned koff = (unsigned)(r16 * 64 + 8 * q) * 2u, voff = (unsigned)(r16 * 32 + 8 * q) * 2u;
    int jb = jfirst;
    while (jb <= jlast && !((jb < 32 ? (ulo >> jb) : (uhi >> (jb - 32))) & 1u)) ++jb;
    if (jb > jlast) return;
    KFrag A, B;
    flash_load(Kp, 64 * jb, koff, A);
    for (;;) {
        flash_load(Kp, 64 * jb + 32, koff, B);
        const bool selbit = ((jb < 32 ? (mlo >> jb) : (mhi >> (jb - 32))) & 1u) != 0u;
        flash_step<MODE>(A, VTp, voff, 64 * jb, t0, t, selbit, Qs, O, mx, L, q);
        int jn = jb + 1;
        while (jn <= jlast && !((jn < 32 ? (ulo >> jn) : (uhi >> (jn - 32))) & 1u)) ++jn;
        if (jn <= jlast) flash_load(Kp, 64 * jn, koff, A);
        flash_step<MODE>(B, VTp, voff, 64 * jb + 32, t0, t, selbit, Qs, O, mx, L, q);
        if (jn > jlast) break;
        jb = jn;
    }
}

template <int BR>
__device__ __forceinline__ void attn_finish(const Args& args, f32x4 (&O)[4][4], const f32x4 (&L)[4], bool normalise, size_t m, int hkv, int q) {
    unsigned char* ws = args.ws;
    const float* gates = (const float*)(ws + WS_MISC) + m * 128 + 32;
    const unsigned yoff = (unsigned)((m & 15) * 1024 + 4 * q) * 4u, yboff = yoff >> 1;
#pragma unroll
    for (int g = 0; g < 4; ++g) {
        float sc = sigmf(gates[(hkv * 4 + g) * 3 + BR]);
        if (normalise) sc *= 1.f / fmaxf(L[g][0], TINYF);
#pragma unroll
        for (int dt = 0; dt < 4; ++dt) {
            char* yfu = (char*)((float*)(ws + WS_YATTF) + (m & ~(size_t)15) * 1024 + (hkv * 4 + g) * 64 + 16 * dt);
            f32x4 v = O[dt][g] * sc;
            if (BR > 0) v = v + *(const f32x4*)(yfu + yoff);
            if (BR < 2) *(f32x4*)(yfu + yoff) = v;
            else { u32x2 o; o.x = pk2(v.x, v.y); o.y = pk2(v.z, v.w); *(u32x2*)((char*)((bf16*)(ws + WS_YATT) + (m & ~(size_t)15) * 1024 + (hkv * 4 + g) * 64 + 16 * dt) + yboff) = o; }
        }
    }
}

__device__ __forceinline__ void cmp_pass1_tile(const bf16x8& k0, const bf16x8& k1, int kt, const LAS bf16x8* Qs, int t, int q, float (&mx)[4], float (&ls)[4]) {
#pragma unroll
    for (int g = 0; g < 4; ++g) {
        f32x4 s = MFMA16(k0, Qs[(g * 2 + 0) * 64], ((f32x4){0.f, 0.f, 0.f, 0.f})); s = MFMA16(k1, Qs[(g * 2 + 1) * 64], s);
        float tmax = NEGF;
#pragma unroll
        for (int r = 0; r < 4; ++r) { const int n = 16 * kt + 4 * q + r; const bool ok = (16 * n + 31 <= t); s[r] = ok ? s[r] * 0.125f : NEGF; tmax = fmaxf(tmax, s[r]); }
        const float mnew = fmaxf(mx[g], tmax); float ps = 0.f;
#pragma unroll
        for (int r = 0; r < 4; ++r) ps += (s[r] > 0.5f * NEGF) ? __expf(s[r] - mnew) : 0.f;
        ls[g] = ls[g] * __expf(mx[g] - mnew) + ps; mx[g] = mnew;
    }
}
__device__ __forceinline__ void attn_prompt_unit(const Args& args, LAS float* impL, int unit, bool xcdmap, int lane_in) {
    int lane = lane_in; asm volatile("" : "+v"(lane));
    unsigned char* ws = args.ws;
    const int q = lane >> 4, r16 = lane & 15;
    const int pass = unit >> 11, gwv = unit & 2047, xcd = (gwv >> 3) & 7, wx = (gwv >> 6) * 8 + (gwv & 7);
    const int bh = xcdmap ? 2 * xcd + pass : (unit & 15), b = bh >> 2, hkv = bh & 3;
    const int tile = xcdmap ? (pass == 0 ? 255 - wx : wx) : (unit < 2048 ? 255 - (unit >> 4) : (unit - 2048) >> 4);
    const int t0 = tile * 16, t = t0 + r16; const size_t m = (size_t)b * 4096 + t;
    LAS bf16x8* Qs = (LAS bf16x8*)(impL + 1024) + lane;
#pragma unroll
    for (int g = 0; g < 4; ++g)
#pragma unroll
        for (int ks = 0; ks < 2; ++ks) Qs[(g * 2 + ks) * 64] = ldu<bf16x8>((const bf16*)(ws + WS_Q) + ((size_t)b * 4096 + t0) * 1024 + (hkv * 4 + g) * 64 + 32 * ks, (unsigned)(r16 * 1024 + 8 * q) * 2u);
    LDS_WAIT(); asm volatile("" ::: "memory");
    f32x4 O[4][4]; float mx[4], ls[4];
    const bf16* KCp = (const bf16*)(ws + WS_KC) + (size_t)bh * 256 * 64; const bf16* VCTp = (const bf16*)(ws + WS_VCT) + (size_t)bh * 64 * 256;
    const unsigned kcoff = (unsigned)(r16 * 64 + 8 * q) * 2u, vcoff = (unsigned)(r16 * 32 + 8 * q) * 2u;
    const int nmax = (t0 + 15 >= 31) ? ((t0 + 15 - 31) >> 4) : -1;
    const int NP = nmax < 0 ? 0 : (nmax / 32 + 2 < 8 ? nmax / 32 + 2 : 8);
#pragma unroll
    for (int g = 0; g < 4; ++g) { mx[g] = NEGF; ls[g] = 0.f; }
    {
        bf16x8 ka0, ka1, kb0, kb1;
        if (NP > 0) { ka0 = ldu<bf16x8>(KCp, kcoff); ka1 = ldu<bf16x8>(KCp + 32, kcoff); }
#pragma unroll 1
        for (int kt = 0; kt < 2 * NP; kt += 2) {
            { const bf16* kr = KCp + (size_t)(16 * (kt + 1)) * 64; kb0 = ldu<bf16x8>(kr, kcoff); kb1 = ldu<bf16x8>(kr + 32, kcoff); }
            cmp_pass1_tile(ka0, ka1, kt, Qs, t, q, mx, ls);
            if (kt + 2 < 2 * NP) { const bf16* kr = KCp + (size_t)(16 * (kt + 2)) * 64; ka0 = ldu<bf16x8>(kr, kcoff); ka1 = ldu<bf16x8>(kr + 32, kcoff); }
            cmp_pass1_tile(kb0, kb1, kt + 1, Qs, t, q, mx, ls);
        }
    }
    float invL[4];
#pragma unroll
    for (int g = 0; g < 4; ++g) {
        float M = fmaxf(mx[g], __shfl_xor(mx[g], 16)); M = fmaxf(M, __shfl_xor(M, 32));
        float l = ls[g] * __expf(mx[g] - M); l += __shfl_xor(l, 16); l += __shfl_xor(l, 32);
        mx[g] = M; invL[g] = 1.f / fmaxf(l, TINYF);
    }
#pragma unroll
    for (int dt = 0; dt < 4; ++dt)
#pragma unroll
        for (int g = 0; g < 4; ++g) O[dt][g] = (f32x4){0.f, 0.f, 0.f, 0.f};
    float prev3 = 0.f;
#pragma unroll
    for (int kt = 0; kt < 16; ++kt) impL[kt * 64 + lane] = 0.f;
    bf16x8 kc[2][2], vcf[4];
    if (NP > 0) {
#pragma unroll
        for (int kk = 0; kk < 2; ++kk) { const bf16* kr = KCp + (size_t)(16 * kk) * 64; kc[kk][0] = ldu<bf16x8>(kr, kcoff); kc[kk][1] = ldu<bf16x8>(kr + 32, kcoff); }
#pragma unroll
        for (int dt = 0; dt < 4; ++dt) vcf[dt] = ldu<bf16x8>(VCTp + (16 * dt) * 32, vcoff);
    }
#pragma unroll 1
    for (int i = 0; i < NP; ++i) {
        bf16x8 kn[2][2], vn[4];
        if (i + 1 < NP) {
#pragma unroll
            for (int kk = 0; kk < 2; ++kk) { const bf16* kr = KCp + (size_t)(16 * (2 * i + 2 + kk)) * 64; kn[kk][0] = ldu<bf16x8>(kr, kcoff); kn[kk][1] = ldu<bf16x8>(kr + 32, kcoff); }
#pragma unroll
            for (int dt = 0; dt < 4; ++dt) vn[dt] = ldu<bf16x8>(VCTp + (size_t)(i + 1) * 2048 + (16 * dt) * 32, vcoff);
        }
        f32x4 P[2][4];
#pragma unroll
        for (int kk = 0; kk < 2; ++kk) {
            const int kt = 2 * i + kk;
            const bf16x8 k0 = kc[kk][0], k1 = kc[kk][1];
            f32x4 psum = (f32x4){0.f, 0.f, 0.f, 0.f};
#pragma unroll
            for (int g = 0; g < 4; ++g) {
                f32x4 s = MFMA16(k0, Qs[(g * 2 + 0) * 64], ((f32x4){0.f, 0.f, 0.f, 0.f})); s = MFMA16(k1, Qs[(g * 2 + 1) * 64], s);
#pragma unroll
                for (int r = 0; r < 4; ++r) { const int n = 16 * kt + 4 * q + r; const bool ok = (16 * n + 31 <= t); s[r] = ok ? __expf(s[r] * 0.125f - mx[g]) * invL[g] : 0.f; }
                P[kk][g] = s; psum = psum + s;
            }
            const float a = __shfl(psum[3], (lane + 48) & 63), bb = __shfl(prev3, (lane + 48) & 63);
            impL[kt * 64 + lane] = 2.f * (psum[0] + psum[1] + psum[2]) + psum[3] + (q > 0 ? a : bb);
            prev3 = psum[3];
        }
#pragma unroll
        for (int g = 0; g < 4; ++g) {
            u32x4 pw; pw.x = pk2(P[0][g][0], P[0][g][1]); pw.y = pk2(P[0][g][2], P[0][g][3]); pw.z = pk2(P[1][g][0], P[1][g][1]); pw.w = pk2(P[1][g][2], P[1][g][3]);
            const bf16x8 pf = __builtin_bit_cast(bf16x8, pw);
#pragma unroll
            for (int dt = 0; dt < 4; ++dt) O[dt][g] = MFMA16(vcf[dt], pf, O[dt][g]);
        }
        if (i + 1 < NP) {
#pragma unroll
            for (int kk = 0; kk < 2; ++kk) { kc[kk][0] = kn[kk][0]; kc[kk][1] = kn[kk][1]; }
#pragma unroll
            for (int dt = 0; dt < 4; ++dt) vcf[dt] = vn[dt];
        }
    }
    f32x4 L[4];
#pragma unroll
    for (int g = 0; g < 4; ++g) L[g] = (f32x4){1.f, 1.f, 1.f, 1.f};
    attn_finish<0>(args, O, L, false, m, hkv, q);
    unsigned mlo = 0u, mhi = 0u;
    {
        const int cur = t >> 6;
        LDS_WAIT(); asm volatile("" ::: "memory");
        unsigned key[16];
#pragma unroll
        for (int kt = 0; kt < 16; ++kt) { const int j = 4 * kt + q; const bool valid = (64 * j <= t), forced = (j == 0) || (j == cur) || (j == cur - 1);
            const float val = valid ? (forced ? BIGF : impL[kt * 64 + lane]) : -BIGF; const unsigned u = __builtin_bit_cast(unsigned, val);
            key[kt] = (u & 0x80000000u) ? ~u : (u | 0x80000000u); }
        unsigned T = 0u;
#pragma unroll 1
        for (int bit = 31; bit >= 0; --bit) {
            const unsigned cand = T | (1u << bit);
            int cnt = 0;
#pragma unroll
            for (int kt = 0; kt < 16; ++kt) cnt += key[kt] >= cand ? 1 : 0;
            cnt += __shfl_xor(cnt, 16); cnt += __shfl_xor(cnt, 32);
            T = cnt >= 16 ? cand : T;
        }
        int cgt = 0;
#pragma unroll
        for (int kt = 0; kt < 16; ++kt) cgt += key[kt] > T ? 1 : 0;
        cgt += __shfl_xor(cgt, 16); cgt += __shfl_xor(cgt, 32);
        const int need = 16 - cgt;
        unsigned elo = 0u, ehi = 0u;
#pragma unroll
        for (int kt = 0; kt < 16; ++kt) { const int j = 4 * kt + q; const unsigned bit = key[kt] == T ? 1u : 0u; if (kt < 8) elo |= bit << j; else ehi |= bit << (j - 32); }
        elo |= __shfl_xor(elo, 16); elo |= __shfl_xor(elo, 32); ehi |= __shfl_xor(ehi, 16); ehi |= __shfl_xor(ehi, 32);
        const int pclo = __popc(elo);
#pragma unroll
        for (int kt = 0; kt < 16; ++kt) { const int j = 4 * kt + q;
            const int before = kt < 8 ? __popc(elo & ((1u << j) - 1u)) : pclo + __popc(ehi & ((1u << (j - 32)) - 1u));
            const unsigned bit = (key[kt] > T || (key[kt] == T && before < need)) ? 1u : 0u;
            if (kt < 8) mlo |= bit << j; else mhi |= bit << (j - 32); }
        mlo |= __shfl_xor(mlo, 16); mlo |= __shfl_xor(mlo, 32); mhi |= __shfl_xor(mhi, 16); mhi |= __shfl_xor(mhi, 32);
    }
    unsigned ulo = mlo, uhi = mhi;
#pragma unroll
    for (int o = 1; o < 16; o <<= 1) { ulo |= __shfl_xor(ulo, o); uhi |= __shfl_xor(uhi, o); }
    ulo = __builtin_amdgcn_readfirstlane(ulo); uhi = __builtin_amdgcn_readfirstlane(uhi);
    {
#pragma unroll
        for (int g = 0; g < 4; ++g) { mx[g] = NEGF; L[g] = (f32x4){0.f, 0.f, 0.f, 0.f}; }
#pragma unroll
        for (int dt = 0; dt < 4; ++dt)
#pragma unroll
            for (int g = 0; g < 4; ++g) O[dt][g] = (f32x4){0.f, 0.f, 0.f, 0.f};
        const bf16* Kp = (const bf16*)(ws + WS_KVH) + ((size_t)(2 * 4 + b) * 4 + hkv) * 4096 * 64;
        const bf16* VTp = (const bf16*)(ws + WS_VT) + ((size_t)(0 * 4 + b) * 4 + hkv) * 64 * 4096;
        flash_branch<0>(Kp, VTp, 0, (t0 + 15) >> 6, ulo, uhi, mlo, mhi, t0, t, Qs, O, mx, L, q, r16);
        attn_finish<1>(args, O, L, true, m, hkv, q);
    }
    {
#pragma unroll
        for (int g = 0; g < 4; ++g) { mx[g] = NEGF; L[g] = (f32x4){0.f, 0.f, 0.f, 0.f}; }
#pragma unroll
        for (int dt = 0; dt < 4; ++dt)
#pragma unroll
            for (int g = 0; g < 4; ++g) O[dt][g] = (f32x4){0.f, 0.f, 0.f, 0.f};
        const bf16* Kp = (const bf16*)(ws + WS_KVH) + ((size_t)(4 * 4 + b) * 4 + hkv) * 4096 * 64;
        const bf16* VTp = (const bf16*)(ws + WS_VT) + ((size_t)(1 * 4 + b) * 4 + hkv) * 64 * 4096;
        const int jbeg = t0 >= 511 ? (t0 - 511) >> 6 : 0, jend = (t0 + 15) >> 6;
        flash_branch<1>(Kp, VTp, jbeg, jend, 0xffffffffu, 0xffffffffu, 0xffffffffu, 0xffffffffu, t0, t, Qs, O, mx, L, q, r16);
        attn_finish<2>(args, O, L, true, m, hkv, q);
    }
}
#ifdef SELFCHECK
__device__ __forceinline__ void check_attn_prompt(const Args& args, LAS unsigned char* lds, int bid, int tid) {
    unsigned char* ws = args.ws;
    const int tl[12] = {0, 15, 30, 31, 63, 64, 127, 511, 512, 1023, 1024, 4095};
    int t = (bid * 997 + 13) % 4096;
#pragma unroll
    for (int i = 0; i < 12; ++i) t = (bid == i) ? tl[i] : t;
    const int b = bid & 3, hkv = (bid >> 2) & 3, bh = b * 4 + hkv; const size_t m = (size_t)b * 4096 + t;
    LAS float* qf = (LAS float*)lds;
    LAS float* sc = qf + 256;
    LAS float* imp = sc + 1024;
    LAS int* sel = (LAS int*)(imp + 64);
    LAS float* ss = (LAS float*)(sel + 16);
    LAS float* res = ss + 4096;
    LAS float* red = res + 256;
    const bf16* Q = (const bf16*)(ws + WS_Q) + m * 1024 + hkv * 256;
    const bf16* KC = (const bf16*)(ws + WS_KC) + (size_t)bh * 256 * 64;
    const bf16* VCT = (const bf16*)(ws + WS_VCT) + (size_t)bh * 64 * 256;
    const float* gates = (const float*)(ws + WS_MISC) + m * 128 + 32 + hkv * 12;
    __syncthreads();
    if (tid < 256) { qf[tid] = bf2f(Q[tid]); res[tid] = 0.f; }
    __syncthreads();
    for (int i = tid; i < 1024; i += 512) { const int g = i >> 8, n = i & 255; float s = NEGF;
        if (n < 255 && 16 * n + 31 <= t) { float a = 0.f; for (int d = 0; d < 64; ++d) a += qf[g * 64 + d] * bf2f(KC[n * 64 + d]); s = a * 0.125f; }
        sc[i] = s; }
    __syncthreads();
    if (tid < 4) { float mx = NEGF; for (int n = 0; n < 255; ++n) mx = fmaxf(mx, sc[tid * 256 + n]);
        float sum = 0.f; for (int n = 0; n < 255; ++n) { const float s = sc[tid * 256 + n]; const float e = (s > 0.5f * NEGF) ? __expf(s - mx) : 0.f; sc[tid * 256 + n] = e; sum += e; }
        const float inv = 1.f / fmaxf(sum, TINYF); for (int n = 0; n < 255; ++n) sc[tid * 256 + n] *= inv; sc[tid * 256 + 255] = 0.f; }
    __syncthreads();
    if (tid < 256) { const int g = tid >> 6, d = tid & 63; float o = 0.f;
        for (int n = 0; n < 255; ++n) { const int kk = n & 31, kpos = 8 * ((kk & 15) >> 2) + 4 * (kk >> 4) + (kk & 3);
            o += sc[g * 256 + n] * bf2f(VCT[(size_t)(n >> 5) * 2048 + d * 32 + kpos]); }
        res[tid] += sigmf(gates[g * 3 + 0]) * o; }
    if (tid >= 256 && tid < 320) { const int j = tid - 256; float a = 0.f;
        for (int i = 0; i < 255; ++i) { const int lo = max(16 * i, 64 * j), hi = min(16 * i + 32, 64 * j + 64); const int ov = hi > lo ? hi - lo : 0;
            a += ((sc[i] + sc[256 + i]) + (sc[512 + i] + sc[768 + i])) * ((float)ov * (1.f / 16.f)); }
        const int cur = t >> 6; const bool valid = 64 * j <= t, forced = (j == 0) || (j == cur) || (j == cur - 1);
        imp[j] = valid ? (forced ? BIGF : a) : -BIGF; }
    __syncthreads();
    if (tid == 0) { unsigned long long taken = 0ull;
        for (int k = 0; k < 16; ++k) { int best = -1; float bv = 0.f;
            for (int j = 0; j < 64; ++j) if (!((taken >> j) & 1ull) && (best < 0 || imp[j] > bv)) { best = j; bv = imp[j]; }
            taken |= 1ull << best; sel[k] = best; } }
    __syncthreads();
    for (int br = 1; br < 3; ++br) {
        const bf16* Kp = (const bf16*)(ws + WS_KVH) + ((size_t)((br == 1 ? 2 : 4) * 4 + b) * 4 + hkv) * 4096 * 64;
        const bf16* Vp = (const bf16*)(ws + WS_KVH) + ((size_t)((br == 1 ? 3 : 5) * 4 + b) * 4 + hkv) * 4096 * 64;
        const int nk = br == 1 ? 1024 : 512;
        for (int i = tid; i < 4 * nk; i += 512) { const int g = i / nk, k = i % nk;
            const int pos = br == 1 ? sel[k >> 6] * 64 + (k & 63) : t - 511 + k;
            float s = NEGF;
            if (pos >= 0 && pos <= t && pos < 4096) { float a = 0.f; for (int d = 0; d < 64; ++d) a += qf[g * 64 + d] * bf2f(Kp[(size_t)pos * 64 + d]); s = a * 0.125f; }
            ss[g * 1024 + k] = s; }
        __syncthreads();
        if (tid < 4) { float mx = NEGF; for (int k = 0; k < nk; ++k) mx = fmaxf(mx, ss[tid * 1024 + k]);
            float sum = 0.f; for (int k = 0; k < nk; ++k) { const float s = ss[tid * 1024 + k]; const float e = (s > 0.5f * NEGF) ? __expf(s - mx) : 0.f; ss[tid * 1024 + k] = e; sum += e; }
            red[tid] = 1.f / fmaxf(sum, TINYF); }
        __syncthreads();
        if (tid < 256) { const int g = tid >> 6, d = tid & 63; float o = 0.f;
            for (int k = 0; k < nk; ++k) { const float p = ss[g * 1024 + k]; if (p != 0.f) { const int pos = br == 1 ? sel[k >> 6] * 64 + (k & 63) : t - 511 + k; o += p * bf2f(Vp[(size_t)pos * 64 + d]); } }
            res[tid] += sigmf(gates[g * 3 + br]) * o * red[g]; }
        __syncthreads();
    }
    if (tid < 256) { const float ref = res[tid], got = bf2f(((const bf16*)(ws + WS_YATT))[m * 1024 + hkv * 256 + tid]);
        if (!(fabsf(got - ref) <= 0.003f + 0.03f * fabsf(ref))) atomicAdd((unsigned*)(ws + WS_CTL) + 8, 1u); }
    __syncthreads();
}
#endif
#ifdef SELFCHECK
__device__ __forceinline__ void check_attn_sample(const Args& args, LAS unsigned char* lds, int bid, int tid) {
    unsigned char* ws = args.ws; const float* out = args.out;
    const int u = (bid * 2 + 1) % 512, bs = u >> 2, hkv = u & 3; const size_t m = MP + bs;
    LAS float* qf = (LAS float*)lds; LAS float* sc = qf + 256; LAS float* imp = sc + 512; LAS int* sel = (LAS int*)(imp + 64);
    LAS float* ss = (LAS float*)(sel + 16); LAS float* res = ss + 4096; LAS float* red = res + 256;
    const bf16* Q = (const bf16*)(ws + WS_Q) + m * 1024 + hkv * 256;
    const float* KCS = (const float*)(ws + WS_KCS) + (size_t)(bs * 4 + hkv) * 128 * 64; const float* VCS = (const float*)(ws + WS_VCS) + (size_t)(bs * 4 + hkv) * 128 * 64;
    const float* gates = (const float*)(ws + WS_MISC) + m * 128 + 32 + hkv * 12;
    const int* pt = (const int*)args.in[5] + bs * NPAGES; const float* cache = INF(4); const float* cwin = INF(6);
    __syncthreads();
    if (tid < 256) { qf[tid] = bf2f(Q[tid]); res[tid] = 0.f; }
    __syncthreads();
    { const int g = tid >> 7, n = tid & 127; float s = NEGF;
      if (n < 127) { float a = 0.f; for (int d = 0; d < 64; ++d) a += qf[g * 64 + d] * KCS[n * 64 + d]; s = a * 0.125f; }
      sc[tid] = s; }
    __syncthreads();
    if (tid < 4) { float mx = NEGF; for (int n = 0; n < 127; ++n) mx = fmaxf(mx, sc[tid * 128 + n]);
        float sum = 0.f; for (int n = 0; n < 127; ++n) { const float e = __expf(sc[tid * 128 + n] - mx); sc[tid * 128 + n] = e; sum += e; }
        const float inv = 1.f / fmaxf(sum, TINYF); for (int n = 0; n < 127; ++n) sc[tid * 128 + n] *= inv; sc[tid * 128 + 127] = 0.f; }
    __syncthreads();
    if (tid < 256) { const int g = tid >> 6, d = tid & 63; float o = 0.f; for (int n = 0; n < 127; ++n) o += sc[g * 128 + n] * VCS[n * 64 + d]; res[tid] += sigmf(gates[g * 3 + 0]) * o; }
    if (tid >= 256 && tid < 256 + 33) { const int j = tid - 256; float a = 0.f;
        for (int i = 0; i < 127; ++i) { const int lo = max(16 * i, 64 * j), hi = min(16 * i + 32, 64 * j + 64); const int ov = hi > lo ? hi - lo : 0;
            a += ((sc[i] + sc[128 + i]) + (sc[256 + i] + sc[384 + i])) * ((float)ov * (1.f / 16.f)); }
        imp[j] = (j == 0 || j == 32 || j == 31) ? BIGF : a; }
    __syncthreads();
    if (tid == 0) { unsigned long long taken = 0ull;
        for (int k = 0; k < 16; ++k) { int best = -1; float bv = 0.f;
            for (int j = 0; j < 33; ++j) if (!((taken >> j) & 1ull) && (best < 0 || imp[j] > bv)) { best = j; bv = imp[j]; }
            taken |= 1ull << best; sel[k] = best; } }
    __syncthreads();
    for (int br = 1; br < 3; ++br) {
        const int nk = br == 1 ? 1024 : 513;
        for (int i = tid; i < 4 * nk; i += 512) { const int g = i / nk, k = i % nk; float s = NEGF; const float* kr = nullptr;
            if (br == 1) { const int pos = sel[k >> 6] * 64 + (k & 63);
                if (pos < 2048) kr = cache + (((size_t)pt[pos >> 7] * 128 + (pos & 127)) * 4 + 2) * 256 + hkv * 64;
                else if (pos == 2048) kr = out + O_KVS + ((size_t)bs * 4 + 2) * 256 + hkv * 64; }
            else { if (k >= 1 && k < 512) kr = cwin + (((size_t)bs * 512 + k) * 2 + 0) * 256 + hkv * 64;
                   else if (k == 512) kr = out + O_WINS + (((size_t)bs * 512 + 511) * 2 + 0) * 256 + hkv * 64; }
            if (kr) { float a = 0.f; for (int d = 0; d < 64; ++d) a += qf[g * 64 + d] * kr[d]; s = a * 0.125f; }
            ss[g * 1024 + k] = s; }
        __syncthreads();
        if (tid < 4) { float mx = NEGF; for (int k = 0; k < nk; ++k) mx = fmaxf(mx, ss[tid * 1024 + k]);
            float sum = 0.f; for (int k = 0; k < nk; ++k) { const float s = ss[tid * 1024 + k]; const float e = (s > 0.5f * NEGF) ? __expf(s - mx) : 0.f; ss[tid * 1024 + k] = e; sum += e; }
            red[tid] = 1.f / fmaxf(sum, TINYF); }
        __syncthreads();
        if (tid < 256) { const int g = tid >> 6, d = tid & 63; float o = 0.f;
            for (int k = 0; k < nk; ++k) { const float p = ss[g * 1024 + k]; if (p != 0.f) { const float* vr;
                if (br == 1) { const int pos = sel[k >> 6] * 64 + (k & 63);
                    vr = pos < 2048 ? cache + (((size_t)pt[pos >> 7] * 128 + (pos & 127)) * 4 + 3) * 256 + hkv * 64 : out + O_KVS + ((size_t)bs * 4 + 3) * 256 + hkv * 64; }
                else vr = k < 512 ? cwin + (((size_t)bs * 512 + k) * 2 + 1) * 256 + hkv * 64 : out + O_WINS + (((size_t)bs * 512 + 511) * 2 + 1) * 256 + hkv * 64;
                o += p * vr[d]; } }
            res[tid] += sigmf(gates[g * 3 + br]) * o * red[g]; }
        __syncthreads();
    }
    if (tid < 256) { const float ref = res[tid], got = bf2f(((const bf16*)(ws + WS_YATT))[m * 1024 + hkv * 256 + tid]);
        if (!(fabsf(got - ref) <= 0.003f + 0.03f * fabsf(ref))) atomicAdd((unsigned*)(ws + WS_CTL) + 8, 1u); }
    __syncthreads();
}
__device__ __forceinline__ void check_prompt_compress(const Args& args, LAS unsigned char* lds, int bid, int tid) {
    unsigned char* ws = args.ws;
    const int st = bid & 1, bh = (bid * 5) % 16, n = (bid * 11 + 3) % 255;
    LAS float* hid = (LAS float*)lds;
    const bf16* X = (const bf16*)(ws + WS_KVH) + ((size_t)st * 16 + bh) * 4096 * 64;
    __syncthreads();
    if (tid < 128) { const float* pe = INF(st ? 25 : 22); const float* w1 = INF(st ? 26 : 23); float a = 0.f;
        for (int l = 0; l < 32; ++l) for (int d = 0; d < 64; ++d) a += (bf2f(X[(size_t)(16 * n + l) * 64 + d]) + pe[l * 64 + d]) * w1[((size_t)l * 64 + d) * 128 + tid];
        hid[tid] = a / (1.f + __expf(-a)); }
    __syncthreads();
    if (tid < 64) { const float* w2 = INF(st ? 27 : 24); float o = 0.f;
        for (int e = 0; e < 128; ++e) o += hid[e] * w2[e * 64 + tid];
        const int kk = n & 31, kpos = 8 * ((kk & 15) >> 2) + 4 * (kk >> 4) + (kk & 3);
        const float got = st == 0 ? bf2f(((const bf16*)(ws + WS_KC))[((size_t)bh * 256 + n) * 64 + tid]) : bf2f(((const bf16*)(ws + WS_VCT))[((size_t)bh * 8 + (n >> 5)) * 2048 + tid * 32 + kpos]);
        if (!(fabsf(got - o) <= 0.03f + 0.03f * fabsf(o))) atomicAdd((unsigned*)(ws + WS_CTL) + 8, 1u); }
    __syncthreads();
}
#endif
__device__ __forceinline__ void dot4_reduce(const float (&qv)[4], float kx, int lane, float (&sg)[4]) {
    const float v0 = qv[0] * kx, v1 = qv[1] * kx, v2 = qv[2] * kx, v3 = qv[3] * kx;
    const bool up = (lane & 32) != 0, up2 = (lane & 16) != 0;
    const float r0 = (up ? v2 : v0) + __shfl_xor(up ? v0 : v2, 32), r1 = (up ? v3 : v1) + __shfl_xor(up ? v1 : v3, 32);
    float x = (up2 ? r1 : r0) + __shfl_xor(up2 ? r0 : r1, 16);
    x += __shfl_xor(x, 8); x += __shfl_xor(x, 4); x += __shfl_xor(x, 2); x += __shfl_xor(x, 1);
    const int xi = __builtin_bit_cast(int, x);
    sg[0] = __builtin_bit_cast(float, __builtin_amdgcn_readlane(xi, 0)); sg[1] = __builtin_bit_cast(float, __builtin_amdgcn_readlane(xi, 16));
    sg[2] = __builtin_bit_cast(float, __builtin_amdgcn_readlane(xi, 32)); sg[3] = __builtin_bit_cast(float, __builtin_amdgcn_readlane(xi, 48));
}
struct SampleRows { const float* cache; const float* cwin; float* out; const LAS int* selblk; const LAS int* selpage; int bs, hkv, rs, dc; };
template <int BR> __device__ __forceinline__ void srow_load(const SampleRows& R, int row, int nrows, f32x4& kx, f32x4& vx) {
    kx = (f32x4){0.f, 0.f, 0.f, 0.f}; vx = kx;
    if (row < nrows) {
        if (BR == 0) { const int k = row >> 6; const unsigned off = (((unsigned)R.selpage[k] * 128u + (unsigned)((R.selblk[k] & 1) * 64 + (row & 63))) * 4u + 2u) * 256u + (unsigned)(R.hkv * 64 + 4 * R.dc);
            kx = *(const f32x4*)(R.cache + off); vx = *(const f32x4*)(R.cache + off + 256u); }
        else { const unsigned off = (((unsigned)R.bs * 512u + (unsigned)(row + 1)) * 2u) * 256u + (unsigned)(R.hkv * 64 + 4 * R.dc);
            kx = *(const f32x4*)(R.cwin + off); vx = *(const f32x4*)(R.cwin + off + 256u); }
    }
}
__device__ __forceinline__ void srow_update(const f32x4 (&qv)[4], const f32x4& kx, const f32x4& vx, bool valid, float (&mx)[4], float (&ls)[4], f32x4 (&o)[4]) {
    float s[4];
#pragma unroll
    for (int g = 0; g < 4; ++g) s[g] = (qv[g].x * kx.x + qv[g].y * kx.y) + (qv[g].z * kx.z + qv[g].w * kx.w);
#pragma unroll
    for (int st = 8; st >= 1; st >>= 1)
#pragma unroll
        for (int g = 0; g < 4; ++g) s[g] += __shfl_xor(s[g], st);
#pragma unroll
    for (int g = 0; g < 4; ++g) {
        const float mnew = valid ? fmaxf(mx[g], s[g]) : mx[g], alpha = __expf(mx[g] - mnew), p = valid ? __expf(s[g] - mnew) : 0.f;
        ls[g] = ls[g] * alpha + p; o[g] = o[g] * alpha + vx * p; mx[g] = mnew;
    }
}
template <int BR>
__device__ __forceinline__ void sample_rows_branch(const SampleRows& R, int wave, const f32x4 (&qv)[4], LAS float* pm, LAS float* pl, LAS float* po) {
    float mx[4], ls[4]; f32x4 o[4];
#pragma unroll
    for (int g = 0; g < 4; ++g) { mx[g] = NEGF; ls[g] = 0.f; o[g] = (f32x4){0.f, 0.f, 0.f, 0.f}; }
    constexpr int nrows = BR == 0 ? 15 * 64 : 511;
    constexpr int ngroups = (nrows + 3) / 4;
#pragma unroll 1
    for (int g0 = wave; g0 < ngroups; g0 += 64) {
        f32x4 kx[8], vx[8];
#pragma unroll
        for (int k = 0; k < 8; ++k) srow_load<BR>(R, 4 * (g0 + 8 * k) + R.rs, (g0 + 8 * k) < ngroups ? nrows : 0, kx[k], vx[k]);
#pragma unroll
        for (int k = 0; k < 8; ++k) {
            const int grp = g0 + 8 * k, row = 4 * grp + R.rs;
            if (grp < ngroups) {
                const bool valid = row < nrows;
                if (BR == 1 && valid) { const unsigned off = (((unsigned)R.bs * 512u + (unsigned)row) * 2u) * 256u + (unsigned)(R.hkv * 64 + 4 * R.dc);
                    *(f32x4*)(R.out + O_WINS + off) = kx[k]; *(f32x4*)(R.out + O_WINS + off + 256u) = vx[k]; }
                srow_update(qv, kx[k], vx[k], valid, mx, ls, o);
            }
        }
    }
    if (wave == 0) {
        const float* src = BR == 0 ? R.out + O_KVS + ((size_t)R.bs * 4 + 2) * 256 + R.hkv * 64 + 4 * R.dc : R.out + O_WINS + (((size_t)R.bs * 512 + 511) * 2) * 256 + R.hkv * 64 + 4 * R.dc;
        const f32x4 kx = *(const f32x4*)src, vx = *(const f32x4*)(src + 256);
        srow_update(qv, kx, vx, R.rs == 0, mx, ls, o);
    }
    const int slot = (BR * 32 + wave * 4 + R.rs) * 4;
#pragma unroll
    for (int g = 0; g < 4; ++g) { if (R.dc == 0) { pm[slot + g] = mx[g]; pl[slot + g] = ls[g]; } *(LAS f32x4*)(po + (size_t)(slot + g) * 64 + 4 * R.dc) = o[g]; }
}

__device__ __forceinline__ void attn_sample_unit(const Args& args, LAS unsigned char* lds, int unit, int tid, int wave, int lane) {
    unsigned char* ws = args.ws; float* out = args.out;
    const int hkv = unit & 3, bs = unit >> 2; const size_t m = MP + bs;
    LAS float* sc = (LAS float*)lds; LAS float* impv = sc + 512; LAS int* selblk = (LAS int*)(impv + 64); LAS int* selpage = selblk + 16; LAS int* pg = selpage + 16;
    LAS float* pm = (LAS float*)(pg + 16); LAS float* pl = pm + 256; LAS float* po = pl + 256;
    LAS float* poc = po + 2 * 32 * 4 * 64;
    const bf16* Qr = (const bf16*)(ws + WS_Q) + m * 1024 + hkv * 256;
    const float* KCS = (const float*)(ws + WS_KCS) + (size_t)(bs * 4 + hkv) * 128 * 64; const float* VCS = (const float*)(ws + WS_VCS) + (size_t)(bs * 4 + hkv) * 128 * 64;
    float qv[4];
#pragma unroll
    for (int g = 0; g < 4; ++g) qv[g] = bf2f(Qr[g * 64 + lane]) * 0.125f;
    if (tid < 16) pg[tid] = ((const int*)args.in[5])[bs * NPAGES + tid];
    {
        float kr[16];
#pragma unroll
        for (int i = 0; i < 16; ++i) { const int n = wave + 8 * i; kr[i] = n < 127 ? KCS[n * 64 + lane] : 0.f; }
#pragma unroll
        for (int i = 0; i < 16; ++i) { const int n = wave + 8 * i; float sg[4]; dot4_reduce(qv, kr[i], lane, sg);
            if (lane < 4) sc[lane * 128 + n] = n < 127 ? (lane == 0 ? sg[0] : lane == 1 ? sg[1] : lane == 2 ? sg[2] : sg[3]) : NEGF; }
    }
    __syncthreads();
    if (wave < 4) { const float s0 = sc[wave * 128 + lane], s1 = sc[wave * 128 + 64 + lane];
        float mxv = fmaxf(s0, s1);
#pragma unroll
        for (int o = 1; o < 64; o <<= 1) mxv = fmaxf(mxv, __shfl_xor(mxv, o));
        const float e0 = __expf(s0 - mxv), e1 = (lane < 63) ? __expf(s1 - mxv) : 0.f;
        const float inv = 1.f / fmaxf(wave_sum(e0 + e1), TINYF);
        sc[wave * 128 + lane] = e0 * inv; sc[wave * 128 + 64 + lane] = e1 * inv; }
    __syncthreads();
    {
        float vr[16];
#pragma unroll
        for (int i = 0; i < 16; ++i) { const int n = wave + 8 * i; vr[i] = n < 127 ? VCS[n * 64 + lane] : 0.f; }
        float oc[4] = {0.f, 0.f, 0.f, 0.f};
#pragma unroll
        for (int i = 0; i < 16; ++i) { const int n = wave + 8 * i;
#pragma unroll
            for (int g = 0; g < 4; ++g) oc[g] += sc[g * 128 + n] * vr[i]; }
#pragma unroll
        for (int g = 0; g < 4; ++g) poc[(wave * 4 + g) * 64 + lane] = oc[g];
        if (wave == 4 && lane < 33) { const int j = lane; float acc = 0.f;
#pragma unroll
            for (int k = -1; k < 4; ++k) { const int n = 4 * j + k; if (n >= 0 && n < 127) { const float P = (sc[n] + sc[128 + n]) + (sc[256 + n] + sc[384 + n]); acc += (k == -1 || k == 3) ? P : 2.f * P; } }
            impv[j] = (j == 0 || j == 31 || j == 32) ? BIGF : acc; }
    }
    __syncthreads();
    if (tid < 64) { bool sel = false;
        if (tid < 33) { const float v = impv[tid]; int rank = 0;
            for (int k = 0; k < 33; ++k) { const float o = impv[k]; rank += ((o > v) || (o == v && k < tid)) ? 1 : 0; }
            sel = rank < 16 && tid < 32; }
        const unsigned long long bal = __ballot(sel);
        if (sel) { const int slot = __popcll(bal & ((1ull << tid) - 1ull)); selblk[slot] = tid; selpage[slot] = pg[tid >> 1]; } }
    __syncthreads();
    {
        f32x4 qv4[4];
#pragma unroll
        for (int g = 0; g < 4; ++g) { const u32x2 w = *(const u32x2*)(Qr + g * 64 + 4 * (lane & 15)); qv4[g] = (f32x4){bflo(w.x), bfhi(w.x), bflo(w.y), bfhi(w.y)} * 0.125f; }
        SampleRows R{INF(4), INF(6), out, selblk, selpage, bs, hkv, lane >> 4, lane & 15};
        sample_rows_branch<0>(R, wave, qv4, pm, pl, po);
        sample_rows_branch<1>(R, wave, qv4, pm, pl, po);
    }
    __syncthreads();
    if (tid < 256) { const int g = tid >> 6, d = tid & 63;
        const float* gates = (const float*)(ws + WS_MISC) + m * 128 + 32 + (hkv * 4 + g) * 3;
        float oc = 0.f;
#pragma unroll
        for (int w = 0; w < 8; ++w) oc += poc[(w * 4 + g) * 64 + d];
        float res = sigmf(gates[0]) * oc;
#pragma unroll
        for (int br = 0; br < 2; ++br) { float M = NEGF;
#pragma unroll 8
            for (int w = 0; w < 32; ++w) M = fmaxf(M, pm[(br * 32 + w) * 4 + g]);
            float L = 0.f, O = 0.f;
#pragma unroll 8
            for (int w = 0; w < 32; ++w) { const float e = __expf(pm[(br * 32 + w) * 4 + g] - M); L += pl[(br * 32 + w) * 4 + g] * e; O += po[((br * 32 + w) * 4 + g) * 64 + d] * e; }
            res += sigmf(gates[1 + br]) * O / fmaxf(L, TINYF); }
        ((bf16*)(ws + WS_YATT))[m * 1024 + (hkv * 4 + g) * 64 + d] = (bf16)f2bf(res); }
    __syncthreads();
}

__device__ __forceinline__ void ffn_act_item(const Args& args, int item, int lane) {
    unsigned char* ws = args.ws; float* out = args.out;
    const bf16* U = (const bf16*)(ws + WS_U); bf16* ACT = (bf16*)(ws + WS_ACT);
    const float* cw = INF(32); const float* cb = INF(33); const float* st = INF(9);
    const int slab = item % 11, chunk = item / 11, row0 = chunk * 32, c4 = slab * 256 + lane * 4;
    f32x4 w[2][3], bia[2];
#pragma unroll
    for (int hf = 0; hf < 2; ++hf) { bia[hf] = *(const f32x4*)(cb + hf * DFF + c4);
#pragma unroll
        for (int k = 0; k < 3; ++k) w[hf][k] = *(const f32x4*)(cw + k * DFF2 + hf * DFF + c4); }
    if (row0 >= MP) {
        for (int r = 0; r < 32; ++r) { const int bs = row0 - MP + r; if (bs >= MS) break;
            f32x4 cu[2];
#pragma unroll
            for (int hf = 0; hf < 2; ++hf) { const int col = hf * DFF + c4;
                const f32x4 u0 = *(const f32x4*)(st + ((size_t)bs * 2 + 0) * DFF2 + col), u1 = *(const f32x4*)(st + ((size_t)bs * 2 + 1) * DFF2 + col), u2 = *(const f32x4*)(out + O_FFNS + ((size_t)bs * 2 + 1) * DFF2 + col);
                *(f32x4*)(out + O_FFNS + ((size_t)bs * 2 + 0) * DFF2 + col) = u1;
                cu[hf] = bia[hf] + w[hf][0] * u0 + w[hf][1] * u1 + w[hf][2] * u2; }
            u32x2 o; o.x = pk2(siluf(cu[0].x) * cu[1].x, siluf(cu[0].y) * cu[1].y); o.y = pk2(siluf(cu[0].z) * cu[1].z, siluf(cu[0].w) * cu[1].w);
            *(u32x2*)(ACT + (size_t)(row0 + r) * DFF + c4) = o; }
        return;
    }
    const int t0 = row0 & 4095;
    f32x4 p2[2], p1[2];
#pragma unroll
    for (int hf = 0; hf < 2; ++hf) { const int col = hf * DFF + c4;
        const u32x2 a = t0 >= 2 ? *(const u32x2*)(U + (size_t)(row0 - 2) * DFF2 + col) : (u32x2){0u, 0u}, b = t0 >= 1 ? *(const u32x2*)(U + (size_t)(row0 - 1) * DFF2 + col) : (u32x2){0u, 0u};
        p2[hf] = (f32x4){bflo(a.x), bfhi(a.x), bflo(a.y), bfhi(a.y)}; p1[hf] = (f32x4){bflo(b.x), bfhi(b.x), bflo(b.y), bfhi(b.y)}; }
#pragma unroll 1
    for (int rb = 0; rb < 32; rb += 8) {
        u32x2 v[8][2];
#pragma unroll
        for (int r = 0; r < 8; ++r)
#pragma unroll
            for (int hf = 0; hf < 2; ++hf) v[r][hf] = *(const u32x2*)(U + (size_t)(row0 + rb + r) * DFF2 + hf * DFF + c4);
#pragma unroll
        for (int r = 0; r < 8; ++r) {
            f32x4 cu[2];
#pragma unroll
            for (int hf = 0; hf < 2; ++hf) { const f32x4 u2 = (f32x4){bflo(v[r][hf].x), bfhi(v[r][hf].x), bflo(v[r][hf].y), bfhi(v[r][hf].y)};
                cu[hf] = bia[hf] + w[hf][0] * p2[hf] + w[hf][1] * p1[hf] + w[hf][2] * u2; p2[hf] = p1[hf]; p1[hf] = u2; }
            u32x2 o; o.x = pk2(siluf(cu[0].x) * cu[1].x, siluf(cu[0].y) * cu[1].y); o.y = pk2(siluf(cu[0].z) * cu[1].z, siluf(cu[0].w) * cu[1].w);
            *(u32x2*)(ACT + (size_t)(row0 + rb + r) * DFF + c4) = o;
        }
    }
}
template <int KTOT>
__device__ __forceinline__ f32x4 skinny_acc(const bf16* A, int lda, const bf16* Bt, int ldb, int wave, int ct, int q, int r16) {
    const bf16* ap = A + (size_t)(16 * wave + r16) * lda + 8 * q;
    const bf16* bp = Bt + (size_t)(16 * ct + r16) * ldb + 8 * q;
    f32x4 acc = (f32x4){0.f, 0.f, 0.f, 0.f};
#pragma unroll 1
    for (int k0 = 0; k0 < KTOT; k0 += 256) {
        bf16x8 af[8], bf[8];
#pragma unroll
        for (int i = 0; i < 8; ++i) { af[i] = *(const bf16x8*)(ap + k0 + 32 * i); bf[i] = *(const bf16x8*)(bp + k0 + 32 * i); }
#pragma unroll
        for (int i = 0; i < 8; ++i) acc = MFMA16(af[i], bf[i], acc);
    }
    return acc;
}
template <int WHICH>
__device__ __forceinline__ void skinny_sample_unit(const Args& args, int ct, int wave, int lane) {
    unsigned char* ws = args.ws;
    const int q = lane >> 4, r16 = lane & 15, col = 16 * ct + r16;
    if (WHICH == 0) {
        const f32x4 a1 = skinny_acc<2048>((const bf16*)(ws + WS_YSSM) + (size_t)MP * 2048, 2048, (const bf16*)(ws + WS_WSSM), 2048, wave, ct, q, r16);
        const f32x4 a2 = skinny_acc<1024>((const bf16*)(ws + WS_YATT) + (size_t)MP * 1024, 1024, (const bf16*)(ws + WS_WATT), 1024, wave, ct, q, r16);
#pragma unroll
        for (int r = 0; r < 4; ++r) { const size_t row = MP + 16 * wave + 4 * q + r;
            const f32x4 sq = *(const f32x4*)((const float*)(ws + WS_SSQ) + row * 4);
            const float rstd = 1.f / sqrtf(((sq.x + sq.y) + (sq.z + sq.w)) * (1.f / 2048.f) + EPS);
            const bf16* mg = (const bf16*)(ws + WS_MG) + row * 2048;
            const float v = sigmf(bf2f(mg[col])) * rstd * a1[r] + sigmf(bf2f(mg[1024 + col])) * a2[r];
            ((bf16*)(ws + WS_MERGED))[row * 1024 + col] = (bf16)f2bf(v); }
    } else if (WHICH == 1) {
        const f32x4 a = skinny_acc<1024>((const bf16*)(ws + WS_MERGED) + (size_t)MP * 1024, 1024, (const bf16*)(ws + WS_WOUT), 1024, wave, ct, q, r16);
#pragma unroll
        for (int r = 0; r < 4; ++r) { const int bs = 16 * wave + 4 * q + r;
            ((float*)(ws + WS_X1))[(size_t)(MP + bs) * 1024 + col] = INF(1)[(size_t)bs * 1024 + col] + ((const float*)(ws + WS_MOD))[(size_t)(4 + bs) * 6144 + 2048 + col] * a[r]; }
    } else {
        const f32x4 a = skinny_acc<DFF>((const bf16*)(ws + WS_ACT) + (size_t)MP * DFF, DFF, (const bf16*)(ws + WS_WDN), DFF, wave, ct, q, r16);
#pragma unroll
        for (int r = 0; r < 4; ++r) { const int bs = 16 * wave + 4 * q + r; float* x = (float*)(ws + WS_X1) + (size_t)(MP + bs) * 1024 + col;
            *x = *x + ((const float*)(ws + WS_MOD))[(size_t)(4 + bs) * 6144 + 5120 + col] * a[r]; }
    }
}
constexpr int N_PHASES = 15;
#ifndef MK_PER_PHASE
#define MK_PER_PHASE 0
#endif

__global__ void __launch_bounds__(NTHR, 2) fwd_kernel(Args args) {
    extern __shared__ __attribute__((aligned(16))) unsigned char lds_raw[];
    LAS unsigned char* lds = (LAS unsigned char*)lds_raw;
    const int tid = threadIdx.x, lane = tid & 63, wave = __builtin_amdgcn_readfirstlane(tid >> 6);
    const int G = gridDim.x, bid = blockIdx.x, gw = bid * NWAVES + wave, NGW = G * NWAVES, gt = bid * NTHR + tid, NGT = G * NTHR;
    unsigned char* ws = args.ws;
    for (int u = tid; u < (LDS_BYTES - LDSCTL_OFF) / 4; u += NTHR) ((LAS unsigned*)(lds + LDSCTL_OFF))[u] = 0u;
    __syncthreads();
    XcdBarrier bar; bar.bar = (unsigned*)(ws + WS_CTL) + CW_BAR; bar.x = 0; bar.st = nullptr;
    if (!MK_PER_PHASE) bar = xcd_barrier_post((unsigned*)(ws + WS_CTL) + CW_BAR, (volatile LAS unsigned*)(lds + MISC_OFF) + 8);
    const int lo = args.ph_lo, hi = args.ph_hi;
#ifndef PHASE_MASK
#define PHASE_MASK 0x7fff
#endif
#define IN(k) ((((PHASE_MASK) >> (k)) & 1) && lo <= (k) && (k) < hi)
#define SEAM(k) do { if (IN(k) && IN((k) + 1)) xcd_barrier(bar); } while (0)
    using pg8::Gemm; using pg8::StaticOrder;

    if (IN(0)) { { p0_prologue(args, lds, gw, NGW, lane, wave); } }
    SEAM(0);
    if (IN(1)) { {
        Gemm g{(const bf16*)(ws + WS_SC), (const bf16*)(ws + WS_WADA), 256, 6144, 1024}; StaticOrder S; S.init(256, 6144, G, bid);
        pg8::EpiF32 E{(float*)(ws + WS_MOD), 6144, INF(11)};
        pg8::gemm_phase<pg8::EpiF32, StaticOrder, true, true>(lds, g, S, E);
    } }
    SEAM(1);
    if (IN(2)) { { norm_mod_phase<0>(args, gw, NGW, lane); } }
    SEAM(2);
    if (IN(3)) { {
        Gemm g{(const bf16*)(ws + WS_H), (const bf16*)(ws + WS_WIN), MPAD, NPROJ, 1024}; StaticOrder S; S.init(MPAD, NPROJ, G, bid);
        epi::InProj E{ws, args.out};
        pg8::gemm_phase<epi::InProj, StaticOrder, true, true>(lds, g, S, E);
    } }
    SEAM(3);
    if (IN(4)) { {
        const int p4 = args.p7mask >> 8;
        if (p4 & 1) for (int u = bid; u < 1024; u += G) sample_compress_unit(args, lds, u, tid, wave, lane);
        if (p4 & 2) {
        { Gemm g{(const bf16*)(ws + WS_KVH), (const bf16*)(ws + WS_W1K), 4096, 256, 1024}; StaticOrder S; S.init(4096, 256, G, bid);
          epi::PartBf16 E{(bf16*)(ws + WS_PARTK)}; pg8::gemm_phase<epi::PartBf16, StaticOrder, true, true>(lds, g, S, E); }
        { Gemm g{(const bf16*)(ws + WS_KVH) + (size_t)16 * 4096 * 64, (const bf16*)(ws + WS_W1V), 4096, 256, 1024}; StaticOrder S; S.init(4096, 256, G, (bid + G - 16) % G);
          epi::PartBf16 E{(bf16*)(ws + WS_PARTV)}; pg8::gemm_phase<epi::PartBf16, StaticOrder, true, true>(lds, g, S, E); }
        }
        if (p4 & 4) {
            if (G == 256) { if (bid >= 32) for (int it = gw - 32 * NWAVES; it < 256 * 48; it += NGW - 32 * NWAVES) conv_prompt_item(args, it, lane); }
            else for (int it = gw; it < 256 * 48; it += NGW) conv_prompt_item(args, it, lane);
        }
        if (p4 & 8) { for (int it = gw; it < 4096; it += NGW) dtcs_item(args, it, lane);
            sample_conv(args, gt, NGT); }
    } }
    SEAM(4);
    if (IN(5)) { {
        const int p5 = args.p7mask >> 4;
        if (p5 & 1) for (int u = bid; u < 512; u += G) ssd_states_unit(args, lds, u, wave, lane);
        if (p5 & 2) for (int it = gw; it < 2 * (4096 / 16); it += NGW) compress2_item<0>(args, it, lane);
        if (p5 & 2) for (int it = gw; it < 2 * 128 * 4 * 3; it += NGW) compress_fixup_item(args, it, lane);
        if (p5 & 4) for (int it = gw; it < MS * NH; it += NGW) sample_ssm_item(args, lds, it, wave, lane);
    } }
    SEAM(5);
    if (IN(6)) { { scan_phase(args, gt, NGT); } }
    SEAM(6);
    if (IN(7)) { {
#ifndef P7C
#define P7C 7
#endif
        const int p7 = args.p7mask & (P7C);
        if (p7 & 1) for (int u = bid; u < 512; u += G) ssd_out_unit(args, lds, u, wave, lane, tid);
        if (p7 & 2) for (int u = gw; u < 4096; u += NGW) attn_prompt_unit(args, (LAS float*)(lds + wave * 12288), u, NGW == 2048, lane);
        __syncthreads();
        if (p7 & 4) for (int u = bid; u < 512; u += G) attn_sample_unit(args, lds, u, tid, wave, lane);
    } }
    SEAM(7);
    if (IN(8)) { {
#ifdef SELFCHECK
        check_attn_prompt(args, lds, bid, tid); check_attn_sample(args, lds, bid, tid); check_prompt_compress(args, lds, bid, tid); check_sample_compress(args, lds, bid, tid);
#endif
        for (int u = bid; u < 64; u += G) skinny_sample_unit<0>(args, u, wave, lane);
        { Gemm g{(const bf16*)(ws + WS_YSSM), (const bf16*)(ws + WS_WSSM), MP, 1024, 2048}; StaticOrder S; S.init(MP, 1024, G, bid);
          epi::Merge1 E{ws}; pg8::gemm_phase<epi::Merge1, StaticOrder, true, true>(lds, g, S, E); }
        { Gemm g{(const bf16*)(ws + WS_YATT), (const bf16*)(ws + WS_WATT), MP, 1024, 1024}; StaticOrder S; S.init(MP, 1024, G, bid);
          epi::Merge2 E{ws}; pg8::gemm_phase<epi::Merge2, StaticOrder, true, true>(lds, g, S, E); }
    } }
    SEAM(8);
    if (IN(9)) { {
        for (int u = bid; u < 64; u += G) skinny_sample_unit<1>(args, u, wave, lane);
        Gemm g{(const bf16*)(ws + WS_MERGED), (const bf16*)(ws + WS_WOUT), MP, 1024, 1024}; StaticOrder S; S.init(MP, 1024, G, bid);
        epi::Resid E{INF(0), INF(1), nullptr, (float*)(ws + WS_X1), (const float*)(ws + WS_MOD), 2048};
        pg8::gemm_phase<epi::Resid, StaticOrder, true, true>(lds, g, S, E);
    } }
    SEAM(9);
    if (IN(10)) { { norm_mod_phase<1>(args, gw, NGW, lane); } }
    SEAM(10);
    if (IN(11)) { {
        Gemm g{(const bf16*)(ws + WS_H), (const bf16*)(ws + WS_WUP), MPAD, DFF2, 1024}; StaticOrder S; S.init(MPAD, DFF2, G, bid);
        epi::Up E{ws, args.out};
        pg8::gemm_phase<epi::Up, StaticOrder, true, true>(lds, g, S, E);
    } }
    SEAM(11);
    if (IN(12)) { { for (int it = gw; it < (MPAD / 32) * 11; it += NGW) ffn_act_item(args, it, lane); } }
    SEAM(12);
    if (IN(13)) { {
        for (int u = bid; u < 64; u += G) skinny_sample_unit<2>(args, u, wave, lane);
        Gemm g{(const bf16*)(ws + WS_ACT), (const bf16*)(ws + WS_WDN), MP, 1024, DFF}; StaticOrder S; S.init(MP, 1024, G, bid);
        epi::Resid E{INF(0), INF(1), (const float*)(ws + WS_X1), (float*)(ws + WS_X1), (const float*)(ws + WS_MOD), 5120};
        pg8::gemm_phase<epi::Resid, StaticOrder, true, true>(lds, g, S, E);
    } }
    SEAM(13);
    if (IN(14)) { { norm_mod_phase<2>(args, gw, NGW, lane); } }
#ifdef SELFCHECK
    if (IN(14) && bid == 0 && tid == 0 && ((volatile unsigned*)(ws + WS_CTL))[8] != 0u) args.out[O_YS] = __builtin_nanf("");
#endif
#undef IN
#undef SEAM
}

extern "C" void kernel_launch(void* const* d_in, const int* in_sizes, int n_in, void* d_out, int out_size, void* d_ws, size_t ws_size, hipStream_t stream) {
    static int grid = 0;
    if (grid == 0) {
        if (n_in != 35 || out_size != (int)O_END || ws_size < WS_END) { fprintf(stderr, "kernel_launch: unexpected shapes (n_in %d out %d ws %zu, need %zu)\n", n_in, out_size, ws_size, (size_t)WS_END); grid = -1; return; }
        int dev = 0, cus = 0, per_cu = 0;
        if (hipGetDevice(&dev) != hipSuccess || hipDeviceGetAttribute(&cus, hipDeviceAttributeMultiprocessorCount, dev) != hipSuccess) { grid = -1; return; }
        if (hipFuncSetAttribute((const void*)fwd_kernel, hipFuncAttributeMaxDynamicSharedMemorySize, LDS_BYTES) != hipSuccess) { fprintf(stderr, "kernel_launch: hipFuncSetAttribute failed\n"); grid = -1; return; }
        if (hipOccupancyMaxActiveBlocksPerMultiprocessor(&per_cu, (const void*)fwd_kernel, NTHR, LDS_BYTES) != hipSuccess || per_cu < 1) { fprintf(stderr, "kernel_launch: occupancy query says %d\n", per_cu); }
        (void)hipGetLastError();
        grid = cus;
    }
    if (grid < 0) return;
    (void)hipMemsetAsync((char*)d_ws + WS_CTL, 0, CTL_ZERO_BYTES, stream);
    Args a{};
    for (int i = 0; i < 35; ++i) a.in[i] = d_in[i];
    a.out = (float*)d_out; a.ws = (unsigned char*)d_ws;
    a.p7mask = 0xFFF; a.pad = 7;
#if MK_PER_PHASE
    for (int p = 0; p < N_PHASES; ++p) { a.ph_lo = p; a.ph_hi = p + 1; hipLaunchKernelGGL(fwd_kernel, dim3(grid), dim3(NTHR), LDS_BYTES, stream, a); }
#else
    a.ph_lo = 0; a.ph_hi = N_PHASES;
    hipLaunchKernelGGL(fwd_kernel, dim3(grid), dim3(NTHR), LDS_BYTES, stream, a);
#endif
#ifdef PROBE_LO
    a.ph_lo = PROBE_LO; a.ph_hi = PROBE_HI; a.p7mask = PROBE_P7MASK; a.pad = PROBE_P7MASK;
    hipLaunchKernelGGL(fwd_kernel, dim3(grid), dim3(NTHR), LDS_BYTES, stream, a);
#endif
}
```
